# Optimizing an MI355X kernel written in HIP

```python
import math
import jax
import jax.numpy as jnp
from jax import lax
import numpy as np

D_MODEL = 1024
BATCH = 8
SEQ = 2048
DEPTH = 2

HEAD_DIM = 64
HEADS_PER_MIXER = 4
GROUP_W = HEADS_PER_MIXER * HEAD_DIM
DIFF_QK_DIM = HEAD_DIM // 2
IDX_HEADS = 8
IDX_DIM = 32
TOPK_MAX = 256
Q_BLOCK = 128
N_GROUPS = 4
EXPERTS_PER_GROUP = 8
EXPERT_FF = 256
EXPERT_TOPK = 2
N_ALIBI_HEADS = 2 * HEADS_PER_MIXER
RMS_EPS = 1e-6
NEG_INF = -1e30

IN_SPLITS = (GROUP_W, GROUP_W, GROUP_W, HEADS_PER_MIXER,
             GROUP_W, GROUP_W, GROUP_W,
             GROUP_W, GROUP_W, GROUP_W,
             GROUP_W, HEAD_DIM, HEAD_DIM,
             IDX_HEADS * IDX_DIM, IDX_DIM, IDX_HEADS)
P_IN = sum(IN_SPLITS)

kernel_name = 'hybrid_fox_stickbreak_diff_dsa_hmoe_adaln'


def rms_norm(x, g):
    xf = x.astype(jnp.float32)
    y = xf * lax.rsqrt(jnp.mean(xf * xf, axis=-1, keepdims=True) + RMS_EPS)
    return (y * g.astype(jnp.float32)).astype(x.dtype)


def sweep_query_blocks(fn, *q_side):
    B, S = q_side[0].shape[:2]
    nb = S // Q_BLOCK
    blocks = tuple(a.reshape(B, nb, Q_BLOCK, *a.shape[2:]).swapaxes(0, 1) for a in q_side)
    out = lax.map(lambda args: fn(args[0] * Q_BLOCK + jnp.arange(Q_BLOCK), *args[1:]),
                  (jnp.arange(nb),) + blocks)
    return out.swapaxes(0, 1).reshape(B, S, *out.shape[3:])


def forgetting_attention(q, k, v, log_f):
    S, d = q.shape[1], q.shape[-1]
    kpos = jnp.arange(S)
    kf = k.astype(jnp.float32)
    cum_bsh = jnp.cumsum(log_f, axis=1)
    cum = cum_bsh.transpose(0, 2, 1)

    def block(qpos, qb, cb):
        s = jnp.einsum('bqhd,bkhd->bhqk', qb.astype(jnp.float32), kf) * d ** -0.5
        s = s + cb.transpose(0, 2, 1)[..., None] - cum[:, :, None, :]
        s = jnp.where(qpos[:, None] >= kpos[None, :], s, NEG_INF)
        p = jax.nn.softmax(s, axis=-1)
        return jnp.einsum('bhqk,bkhd->bqhd', p.astype(v.dtype), v)

    return sweep_query_blocks(block, q, cum_bsh)


def stick_breaking_attention(q, k, v):
    S, d = q.shape[1], q.shape[-1]
    kpos = jnp.arange(S)
    kf = k.astype(jnp.float32)

    def block(qpos, qb):
        z = jnp.einsum('bqhd,bkhd->bhqk', qb.astype(jnp.float32), kf) * d ** -0.5
        strict = qpos[:, None] > kpos[None, :]
        log_beta = jax.nn.log_sigmoid(z)
        log_1m = jnp.where(strict, jax.nn.log_sigmoid(-z), 0.0)
        suffix = lax.cumsum(log_1m, axis=3, reverse=True) - log_1m
        w = jnp.where(strict, jnp.exp(log_beta + suffix), 0.0)
        return jnp.einsum('bhqk,bkhd->bqhd', w.astype(v.dtype), v)

    return sweep_query_blocks(block, q)


def differential_attention(q, k, v, slopes, lam, subln_g, lambda_init):
    S, dq = q.shape[1], q.shape[-1]
    kpos = jnp.arange(S)
    kf = k.astype(jnp.float32)

    def block(qpos, qb):
        dist = (qpos[:, None] - kpos[None, :]).astype(jnp.float32)
        s = jnp.einsum('bqhcd,bkhcd->bhcqk', qb.astype(jnp.float32), kf) * dq ** -0.5
        s = s - slopes[:, None, None, None] * dist
        s = jnp.where(dist >= 0, s, NEG_INF)
        p = jax.nn.softmax(s, axis=-1)
        a = p[:, :, 0] - lam * p[:, :, 1]
        return jnp.einsum('bhqk,bkhd->bqhd', a.astype(v.dtype), v)

    o = sweep_query_blocks(block, q)
    return rms_norm(o, subln_g) * (1.0 - lambda_init)


def indexed_sparse_attention(q, k, v, iq, ik, iw, slopes, topk):
    S, d = q.shape[1], q.shape[-1]
    kpos = jnp.arange(S)
    ikf = ik.astype(jnp.float32)
    gather = jax.vmap(lambda t, i: t[i])

    def block(qpos, qb, iqb, iwb):
        rel = jax.nn.relu(jnp.einsum('bqhe,bse->bqhs', iqb.astype(jnp.float32), ikf) * IDX_DIM ** -0.5)
        score = jnp.einsum('bqh,bqhs->bqs', iwb.astype(jnp.float32) * IDX_HEADS ** -0.5, rel)
        score = jnp.where(qpos[:, None] >= kpos[None, :], score, NEG_INF)
        _, idx = lax.top_k(score, topk)
        ks = gather(k, idx).astype(jnp.float32)
        vs = gather(v, idx)
        dist = (qpos[None, :, None] - idx).astype(jnp.float32)
        s = jnp.einsum('bqhd,bqkd->bhqk', qb.astype(jnp.float32), ks) * d ** -0.5
        s = s - slopes[None, :, None, None] * dist[:, None]
        s = jnp.where(dist[:, None] >= 0, s, NEG_INF)
        p = jax.nn.softmax(s, axis=-1)
        return jnp.einsum('bhqk,bqkd->bqhd', p.astype(vs.dtype), vs)

    return sweep_query_blocks(block, q, iq, iw)


def hierarchical_moe(h, w_group, b_group, w_expert, b_expert, w1, w3, w2):
    B, S, D = h.shape
    t = h.reshape(B * S, D)
    g_logits = jnp.einsum('nd,dg->ng', t, w_group).astype(jnp.float32) + b_group.astype(jnp.float32)
    g_onehot = jax.nn.one_hot(jnp.argmax(g_logits, axis=-1), N_GROUPS, dtype=jnp.float32)
    g_prob = jnp.sum(jax.nn.softmax(g_logits, axis=-1) * g_onehot, axis=-1, keepdims=True)
    e_logits = (jnp.einsum('nd,de->ne', t, w_expert).astype(jnp.float32)
                + b_expert.astype(jnp.float32)).reshape(-1, N_GROUPS, EXPERTS_PER_GROUP)
    e_sel = jnp.einsum('nge,ng->ne', e_logits, g_onehot)
    top_val, top_idx = lax.top_k(e_sel, EXPERT_TOPK)
    top_w = jax.nn.softmax(top_val, axis=-1) * g_prob
    in_group = jnp.sum(jax.nn.one_hot(top_idx, EXPERTS_PER_GROUP, dtype=jnp.float32) * top_w[..., None], axis=1)
    comb = (g_onehot[:, :, None] * in_group[:, None, :]).astype(t.dtype)
    out = jnp.zeros_like(t)
    for g in range(N_GROUPS):
        hid = jax.nn.silu(jnp.einsum('nd,edf->nef', t, w1[g])) * jnp.einsum('nd,edf->nef', t, w3[g])
        out = out + jnp.einsum('nef,efd->nd', hid * comb[:, g, :, None], w2[g])
    return out.reshape(B, S, D)


def setup_inputs(seed: int = 0) -> dict:
    key = jax.random.key(seed)
    ks = jax.random.split(key, 32)
    L, D = DEPTH, D_MODEL
    G, E, F = N_GROUPS, EXPERTS_PER_GROUP, EXPERT_FF

    def nrm(k, shape, s):
        return jax.random.normal(k, shape, jnp.float32) * s

    return {
        'x': nrm(ks[0], (BATCH, SEQ, D), 1.0),
        'c': nrm(ks[1], (BATCH, D), 1.0),
        'ada_w': nrm(ks[2], (L, D, 6 * D), 0.5 * D ** -0.5),
        'ada_b': nrm(ks[3], (L, 6 * D), 0.02),
        'norm1_g': 1.0 + nrm(ks[4], (L, D), 0.02),
        'norm2_g': 1.0 + nrm(ks[5], (L, D), 0.02),
        'w_in': nrm(ks[6], (L, D, P_IN), D ** -0.5),
        'b_f': 3.0 + nrm(ks[7], (L, HEADS_PER_MIXER), 0.5),
        'qn_a': 1.0 + nrm(ks[8], (L, HEAD_DIM), 0.02),
        'kn_a': 1.0 + nrm(ks[9], (L, HEAD_DIM), 0.02),
        'qn_c': 1.0 + nrm(ks[10], (L, DIFF_QK_DIM), 0.02),
        'kn_c': 1.0 + nrm(ks[11], (L, DIFF_QK_DIM), 0.02),
        'lam_q1': nrm(ks[12], (L, DIFF_QK_DIM), 0.1),
        'lam_k1': nrm(ks[13], (L, DIFF_QK_DIM), 0.1),
        'lam_q2': nrm(ks[14], (L, DIFF_QK_DIM), 0.1),
        'lam_k2': nrm(ks[15], (L, DIFF_QK_DIM), 0.1),
        'subln_g': 1.0 + nrm(ks[16], (L, HEAD_DIM), 0.02),
        'qn_d': 1.0 + nrm(ks[17], (L, HEAD_DIM), 0.02),
        'kn_d': 1.0 + nrm(ks[18], (L, HEAD_DIM), 0.02),
        'mix_beta': 1.0 + nrm(ks[19], (L, D), 0.02),
        'w_out': nrm(ks[20], (L, D, D), D ** -0.5),
        'w_group': nrm(ks[21], (L, D, G), D ** -0.5),
        'b_group': nrm(ks[22], (L, G), 0.01),
        'w_expert': nrm(ks[23], (L, D, G * E), D ** -0.5),
        'b_expert': nrm(ks[24], (L, G * E), 0.01),
        'w1': nrm(ks[25], (L, G, E, D, F), D ** -0.5),
        'w3': nrm(ks[26], (L, G, E, D, F), D ** -0.5),
        'w2': nrm(ks[27], (L, G, E, F, D), F ** -0.5),
    }


def reference(x, c, ada_w, ada_b, norm1_g, norm2_g, w_in, b_f, qn_a, kn_a, qn_c, kn_c,
              lam_q1, lam_k1, lam_q2, lam_k2, subln_g, qn_d, kn_d, mix_beta, w_out,
              w_group, b_group, w_expert, b_expert, w1, w3, w2):
    B, S, _ = x.shape
    H = HEADS_PER_MIXER
    topk = min(TOPK_MAX, S // 4)
    offsets = tuple(np.cumsum(IN_SPLITS)[:-1].tolist())
    slopes = jnp.exp2(-8.0 * jnp.arange(1, N_ALIBI_HEADS + 1, dtype=jnp.float32) / N_ALIBI_HEADS)
    slopes_c, slopes_d = slopes[0::2], slopes[1::2]
    c_act = jax.nn.silu(c)

    def heads(t):
        return t.reshape(B, S, H, -1)

    for l in range(DEPTH):
        mod = jnp.einsum('bd,de->be', c_act, ada_w[l]) + ada_b[l]
        shift1, scale1, gate1, shift2, scale2, gate2 = jnp.split(mod[:, None, :], 6, axis=-1)

        h = rms_norm(x, norm1_g[l]) * (1.0 + scale1) + shift1
        (a_q, a_k, a_v, a_f, b_q, b_k, b_v, c_q, c_k, c_v,
         d_q, d_k, d_v, i_q, i_k, i_w) = jnp.split(h @ w_in[l], offsets, axis=-1)

        log_f = jax.nn.log_sigmoid(a_f.astype(jnp.float32) + b_f[l].astype(jnp.float32))
        o_a = forgetting_attention(rms_norm(heads(a_q), qn_a[l]), rms_norm(heads(a_k), kn_a[l]),
                                   heads(a_v), log_f)

        o_b = stick_breaking_attention(heads(b_q), heads(b_k), heads(b_v))

        lambda_init = 0.8 - 0.6 * math.exp(-0.3 * l)
        lam = (jnp.exp(jnp.sum(lam_q1[l].astype(jnp.float32) * lam_k1[l].astype(jnp.float32)))
               - jnp.exp(jnp.sum(lam_q2[l].astype(jnp.float32) * lam_k2[l].astype(jnp.float32)))
               + lambda_init)
        cq = rms_norm(c_q.reshape(B, S, H, 2, DIFF_QK_DIM), qn_c[l])
        ck = rms_norm(c_k.reshape(B, S, H, 2, DIFF_QK_DIM), kn_c[l])
        o_c = differential_attention(cq, ck, heads(c_v), slopes_c, lam, subln_g[l], lambda_init)

        o_d = indexed_sparse_attention(rms_norm(heads(d_q), qn_d[l]), rms_norm(d_k, kn_d[l]), d_v,
                                       i_q.reshape(B, S, IDX_HEADS, IDX_DIM), i_k, i_w,
                                       slopes_d, topk)

        mix = jnp.concatenate([o.reshape(B, S, GROUP_W) for o in (o_a, o_b, o_c, o_d)],
                              axis=-1) * mix_beta[l]
        x = x + gate1 * (mix @ w_out[l])

        h = rms_norm(x, norm2_g[l]) * (1.0 + scale2) + shift2
        x = x + gate2 * hierarchical_moe(h, w_group[l], b_group[l], w_expert[l], b_expert[l],
                                         w1[l], w3[l], w2[l])
    return x
```

```cpp
#include <hip/hip_runtime.h>
#include <cstdio>
#include <cstdint>

#ifndef MK_PER_PHASE
#define MK_PER_PHASE 0
#endif

#ifndef PROBE_P3_PART
#define PROBE_P3_PART 0
#endif
#ifndef PROBE_ATT_VAR
#define PROBE_ATT_VAR -1
#endif
#ifndef BG_CONVERT
#define BG_CONVERT 1
#endif
#ifndef GAP_CONVERT
#define GAP_CONVERT 1
#endif
#ifndef PROBE_ATT_MODE
#define PROBE_ATT_MODE 0
#endif
#ifndef PROBE_REP_K
#define PROBE_REP_K -1
#endif
#define LAS __attribute__((address_space(3)))
#define GAS __attribute__((address_space(1)))
typedef unsigned short bf16;
typedef short bf16x8 __attribute__((ext_vector_type(8)));
typedef short s16x4 __attribute__((ext_vector_type(4)));
typedef float f32x4 __attribute__((ext_vector_type(4)));
typedef float f32x2 __attribute__((ext_vector_type(2)));
typedef float f32x16 __attribute__((ext_vector_type(16)));
typedef unsigned u32x4 __attribute__((ext_vector_type(4)));
typedef unsigned u32x2 __attribute__((ext_vector_type(2)));

constexpr int BATCH = 8, SEQ = 2048, DM = 1024, M = BATCH * SEQ, DEPTH = 2;
constexpr int NP = 3072;
constexpr int P_IN = 2988;
constexpr int C_AQ = 0, C_AK = 256, C_AV = 512, C_BQ = 768, C_BK = 1024, C_BV = 1280, C_CQ = 1536, C_CK = 1792, C_CV = 2048,
              C_DQ = 2304, C_DK = 2560, C_DV = 2624, C_IQ = 2688, C_IK = 2944, C_IW = 2976, C_AF = 2984;
constexpr int NEXP = 32, FF = 256, MAXSLOT = M * 2 + NEXP * 256, MAXTILE = MAXSLOT / 256;
constexpr float LOG2E = 1.4426950408889634f;
constexpr float RMS_EPS = 1e-6f;

constexpr size_t MiB = 1u << 20;
constexpr size_t WS_CTL = 0, CTL_ZERO_BYTES = 1 * MiB;
constexpr size_t WS_WR = 1 * MiB;
constexpr size_t WS_MOD = 2 * MiB;
constexpr size_t WS_CUM = 3 * MiB;
constexpr size_t WS_TOK = 4 * MiB;
constexpr size_t WS_MISC = 5 * MiB;
constexpr size_t WS_MASK = 6 * MiB;
constexpr size_t WS_WIN = 10 * MiB;
constexpr size_t WS_WOUT = 22 * MiB;
constexpr size_t WS_WUP = 26 * MiB;
constexpr size_t WS_WDN = 90 * MiB;
constexpr size_t WS_X1 = 122 * MiB;
constexpr size_t WS_H = 186 * MiB;
constexpr size_t WS_MIX = WS_H;

constexpr size_t WS_PROJ = 218 * MiB;
constexpr size_t WS_Y = WS_PROJ;
constexpr size_t WS_HID = WS_PROJ + 80 * MiB;
constexpr size_t WS_ELIST = 322 * MiB;
constexpr size_t WS_END = 324 * MiB;
constexpr int CW_AQ = 256;
constexpr int CW_CNT = 1024;
constexpr int CW_BAR = 8192;
constexpr int CW_DNQ = 208;
constexpr int CW_UPF = 65536;

constexpr int RING_BYTES = 143360;
constexpr int LDSCTL_OFF = RING_BYTES, MISC_OFF = LDSCTL_OFF + 320, CNTS_OFF = LDSCTL_OFF + 512, BASE_OFF = LDSCTL_OFF + 640, TAB_OFF = LDSCTL_OFF + 768;
constexpr int ROWL_OFF = 131072;
constexpr int LDS_BYTES = 147456;
constexpr int NWAVES = 8;

#define LDS_WAIT() asm volatile("s_waitcnt lgkmcnt(0)" ::: "memory")
#define VM_WAIT() asm volatile("s_waitcnt vmcnt(0)" ::: "memory")
#define RLX_AGENT __ATOMIC_RELAXED, __HIP_MEMORY_SCOPE_AGENT

__device__ __forceinline__ float bf2f(unsigned short u) { return __builtin_bit_cast(float, (unsigned)u << 16); }
__device__ __forceinline__ unsigned f2bf(float f) { unsigned u = __builtin_bit_cast(unsigned, f); return (u + 0x7fffu + ((u >> 16) & 1u)) >> 16; }
__device__ __forceinline__ unsigned pk2(float lo, float hi) { return f2bf(lo) | (f2bf(hi) << 16); }
template <int O> __device__ __forceinline__ float shx(float x) { static_assert(O >= 1 && O <= 16, "swizzle xor"); return __builtin_bit_cast(float, __builtin_amdgcn_ds_swizzle(__builtin_bit_cast(int, x), (O << 10) | 0x1f)); }
__device__ __forceinline__ float half_sum(float x) { return __builtin_bit_cast(float, __builtin_amdgcn_readlane(__builtin_bit_cast(int, x), 0)) + __builtin_bit_cast(float, __builtin_amdgcn_readlane(__builtin_bit_cast(int, x), 32)); }
__device__ __forceinline__ float half_max(float x) { return fmaxf(__builtin_bit_cast(float, __builtin_amdgcn_readlane(__builtin_bit_cast(int, x), 0)), __builtin_bit_cast(float, __builtin_amdgcn_readlane(__builtin_bit_cast(int, x), 32))); }
__device__ __forceinline__ float shup(float x, int o, int lane) { return __builtin_bit_cast(float, __builtin_amdgcn_ds_bpermute((lane - o) << 2, __builtin_bit_cast(int, x))); }
__device__ __forceinline__ int shup_i(int x, int o, int lane) { return __builtin_amdgcn_ds_bpermute((lane - o) << 2, x); }
__device__ __forceinline__ float wave_sum(float v) { v += shx<1>(v); v += shx<2>(v); v += shx<4>(v); v += shx<8>(v); v += shx<16>(v); return half_sum(v); }

namespace pg8 {
constexpr int BM = 256, BK = 64, HALF = 128, HTB = HALF * BK * 2, STAGE_BYTES = 8 * HTB, NXCD = 8, WGM = 8;
__host__ __device__ __forceinline__ int lds_byte(int r, int c) { const int st = (r >> 4) * 2 + (c >> 5), rr = r & 15, cc = c & 31, ob = rr * 64 + cc * 2; return st * 1024 + (ob ^ (((ob >> 9) & 1) << 5)); }
__host__ __device__ __forceinline__ void stage_rc(int b, int& R, int& C) { const int st = b / 1024, sb = b % 1024, swz = sb ^ (((sb >> 9) & 1) << 5); R = (st >> 1) * 16 + swz / 64; C = (st & 1) * 32 + (swz % 64) / 2; }
__host__ __device__ __forceinline__ int perm32(int rho) { const int n = rho >> 4, i = rho & 15; return 8 * (i >> 2) + 4 * n + (i & 3); }

struct Unit { int pm, pn; size_t bo; };
struct Gemm { const bf16* A; const bf16* Bt; int M, N, K; };

struct StaticOrder {
    int nM, nN, nwg, G, c;
    __host__ __device__ void init(int M_, int N_, int G_, int c_) { nM = M_ / BM; nN = N_ / BM; nwg = nM * nN; G = G_; c = c_; }
    __host__ __device__ bool next(int i, Unit& u) const {
        const long L = (long)i * G + c; if (L >= nwg) return false;
        int wgid = (int)L; { const int q = nwg / NXCD, r = nwg % NXCD, xcd = wgid % NXCD, off = wgid / NXCD; wgid = (xcd < r ? xcd * (q + 1) : r * (q + 1) + (xcd - r) * q) + off; }
        const int nig = WGM * nN, gid = wgid / nig, fm = gid * WGM, gsz = (nM - fm) < WGM ? (nM - fm) : WGM;
        u.pm = fm + ((wgid % nig) % gsz); u.pn = (wgid % nig) / gsz; u.bo = 0; return true;
    }
};
struct GroupOrder {
    const LAS int* tab; int ntile, ncol, G, c; size_t ebytes;
    __device__ __forceinline__ bool next(int i, Unit& u) const {
        const long L = (long)i * G + c; if (L >= (long)ntile * ncol) return false;
        u.pm = (int)(L / ncol); u.pn = (int)(L % ncol);
        const int e = __builtin_amdgcn_readfirstlane(tab[u.pm]); u.bo = (size_t)e * ebytes; return true;
    }
};

struct OneUnit { Unit u; __device__ __forceinline__ bool next(int i, Unit& o) const { if (i != 0) return false; o = u; return true; } };
struct DynOrder {
    unsigned* dq; unsigned* upf; const LAS int* tab; volatile LAS unsigned* M; int nd; size_t ebytes; int tid;
    mutable unsigned ppop, pflag;
    __device__ __forceinline__ void issue(unsigned idnext) const {
        ppop = __builtin_amdgcn_atomic_inc32(dq, 0xFFFFFFFFu, __ATOMIC_RELAXED, "agent");
        pflag = 2u; if ((int)idnext < nd) pflag = __hip_atomic_load(upf + (idnext >> 2) * 16, __ATOMIC_RELAXED, __HIP_MEMORY_SCOPE_AGENT);
    }
    __device__ __forceinline__ void unit(int id, Unit& u) const { u.pm = id >> 2; u.pn = id & 3; u.bo = (size_t)__builtin_amdgcn_readfirstlane(tab[id >> 2]) * ebytes; }
    __device__ __forceinline__ bool next(int i, Unit& u) const {
        if (i == 0) { const int id = __builtin_amdgcn_readfirstlane((int)M[4]); if (id >= nd) return false; unit(id, u); return true; }
        if (tid == 0) {
            const unsigned idn = M[5]; const bool ready = (int)idn < nd && pflag >= 2u;
            M[6] = ready ? 1u : 0u;
            if (ready) { asm volatile("buffer_inv sc1" ::: "memory"); M[4] = idn; const unsigned idn2 = ppop; M[5] = idn2; issue(idn2); }
        }
        asm volatile("s_waitcnt lgkmcnt(0)\n\ts_barrier" ::: "memory");
        if (__builtin_amdgcn_readfirstlane((int)M[6]) == 0) return false;
        unit(__builtin_amdgcn_readfirstlane((int)M[4]), u); return true;
    }
};

__device__ __forceinline__ unsigned cvt_pk_bf16(float lo, float hi) { unsigned r; asm volatile("v_cvt_pk_bf16_f32 %0, %1, %2" : "=v"(r) : "v"(lo), "v"(hi)); return r; }

struct EpiBf16 {
    static constexpr bool PERM = true, PUBLISH = false;
    bf16* O; int ldc;
    __device__ __forceinline__ void operator()(const f32x4 (&acc)[2][2][4][2], const Unit& u, int wr, int wc, int fr, int fq) const {
        const int row0 = u.pm * BM + wr * 64 + fr; const int col0 = u.pn * BM + wc * 32 + 8 * fq;
#pragma unroll
        for (int ai = 0; ai < 2; ++ai)
#pragma unroll
            for (int m = 0; m < 4; ++m) { bf16* rowp = O + (size_t)(row0 + ai * HALF + m * 16) * ldc + col0;
#pragma unroll
                for (int bj = 0; bj < 2; ++bj) { const f32x4 v0 = acc[ai][bj][m][0], v1 = acc[ai][bj][m][1];
                    u32x4 w; w.x = cvt_pk_bf16(v0[0], v0[1]); w.y = cvt_pk_bf16(v0[2], v0[3]); w.z = cvt_pk_bf16(v1[0], v1[1]); w.w = cvt_pk_bf16(v1[2], v1[3]);
                    *(u32x4*)(rowp + bj * HALF) = w; } }
    }
};
struct EpiResGate {
    static constexpr bool PERM = false, PUBLISH = false;
    const float* base; float* out; const float* gate;
    __device__ __forceinline__ void operator()(const f32x4 (&acc)[2][2][4][2], const Unit& u, int wr, int wc, int fr, int fq) const {
        const int col0 = u.pn * BM + wc * 32 + 4 * fq; const float* g = gate + (size_t)(u.pm >> 3) * 6144 + col0;
        f32x4 gv[2][2];
#pragma unroll
        for (int bj = 0; bj < 2; ++bj)
#pragma unroll
            for (int n = 0; n < 2; ++n) gv[bj][n] = *(const f32x4*)(g + bj * HALF + n * 16);
#pragma unroll
        for (int ai = 0; ai < 2; ++ai)
#pragma unroll
            for (int m = 0; m < 4; ++m) { const size_t off = (size_t)(u.pm * BM + ai * HALF + wr * 64 + m * 16 + fr) * DM + col0;
#pragma unroll
                for (int bj = 0; bj < 2; ++bj)
#pragma unroll
                    for (int n = 0; n < 2; ++n) { const f32x4 bs = *(const f32x4*)(base + off + bj * HALF + n * 16);
                        *(f32x4*)(out + off + bj * HALF + n * 16) = bs + gv[bj][n] * acc[ai][bj][m][n]; } }
    }
};
struct EpiSwiglu {
    static constexpr bool PERM = true, PUBLISH = true;
    bf16* O; unsigned* flag;
    __device__ __forceinline__ void operator()(const f32x4 (&acc)[2][2][4][2], const Unit& u, int wr, int wc, int fr, int fq) const {
        const int row0 = u.pm * BM + wr * 64 + fr; const int col0 = u.pn * HALF + wc * 32 + 8 * fq;
#pragma unroll
        for (int ai = 0; ai < 2; ++ai)
#pragma unroll
            for (int m = 0; m < 4; ++m) { bf16* rowp = O + (size_t)(row0 + ai * HALF + m * 16) * FF + col0;
                float hv[8];
#pragma unroll
                for (int n = 0; n < 2; ++n)
#pragma unroll
                    for (int i = 0; i < 4; ++i) { const float a = acc[ai][0][m][n][i], b = acc[ai][1][m][n][i];
                        const float sg = __builtin_amdgcn_rcpf(1.f + __builtin_amdgcn_exp2f(-a * LOG2E)); hv[n * 4 + i] = a * sg * b; }
                u32x4 w; w.x = cvt_pk_bf16(hv[0], hv[1]); w.y = cvt_pk_bf16(hv[2], hv[3]); w.z = cvt_pk_bf16(hv[4], hv[5]); w.w = cvt_pk_bf16(hv[6], hv[7]);
                asm volatile("global_store_dwordx4 %0, %1, off sc1\n\ts_nop 2" :: "v"((const GAS bf16*)rowp), "v"(w) : "memory"); }
    }
};

template <class Epi, class Sched, bool ALIGN_EPI = false, bool SP2 = false, bool GATHER = false>
__device__ __forceinline__ void gemm_phase(LAS unsigned char* lds, const Gemm g, const Sched& S, const Epi& E, const int tid, const LAS int* rowl = nullptr) {
    static_assert(!GATHER || SP2, "gather mode is written for the SP2 loop");
    const int wid = __builtin_amdgcn_readfirstlane(tid >> 6), lane = tid & 63, wr = wid >> 2, wc = wid & 3, fr = lane & 15, fq = lane >> 4;
    const int K = g.K, nt = K / BK;
    unsigned voffA[2], voffB[2];
#pragma unroll
    for (int i = 0; i < 2; ++i) { int R, C; stage_rc(tid * 16 + i * 8192, R, C); const int Rb = Epi::PERM ? ((R & ~31) + perm32(R & 31)) : R;
        voffA[i] = (unsigned)(R * K + C) * 2u; voffB[i] = (unsigned)(Rb * K + C) * 2u; }
    const size_t kstep = (size_t)(BK * 2);
    const size_t hstep = (size_t)HALF * K * 2;
    const size_t tstep = 2 * hstep;
    const size_t hstepA = GATHER ? 0 : hstep, tstepA = GATHER ? 0 : tstep;
    unsigned voffGc[2][2], voffGn[2][2];
    int gR[2], gC[2];
#pragma unroll
    for (int i = 0; i < 2; ++i) stage_rc(tid * 16 + i * 8192, gR[i], gC[i]);
#define PG8_GOFF(dst, ui_) do { _Pragma("unroll") for (int h_ = 0; h_ < 2; ++h_) _Pragma("unroll") for (int i_ = 0; i_ < 2; ++i_) \
        dst[h_][i_] = (unsigned)rowl[(ui_) * 256 + h_ * HALF + gR[i_]] * (unsigned)(K * 2) + (unsigned)gC[i_] * 2u; } while (0)
    const unsigned ldsw = (unsigned)wid * 1024u;
    const int aoff = lds_byte(wr * 64 + fr, fq * 8), boff = lds_byte(wc * 32 + fr, fq * 8);
#define PG8_SA(b, h) (((b) * 2 + (h)) * HTB)
#define PG8_SB(b, h) ((4 + (b) * 2 + (h)) * HTB)
#define PG8_STAGE(bufoff, gbase, voff) do { _Pragma("unroll") for (int _i = 0; _i < 2; ++_i) \
        __builtin_amdgcn_global_load_lds((const unsigned*)((const char*)(gbase) + (voff)[_i]), (LAS unsigned*)(lds + (bufoff) + ldsw + _i * 8192), 16, 0, 0); } while (0)
#define PG8_STAGE_A(bufoff, gbase, H, NXT) do { if constexpr (GATHER) { unsigned vo_[2]; vo_[0] = (NXT) ? voffGn[H][0] : voffGc[H][0]; vo_[1] = (NXT) ? voffGn[H][1] : voffGc[H][1]; PG8_STAGE(bufoff, gbase, vo_); } \
        else { PG8_STAGE(bufoff, (const char*)(gbase) + (H) * hstep, voffA); } } while (0)
#define PG8_LDA(dst, b, h) do { _Pragma("unroll") for (int m = 0; m < 4; ++m) _Pragma("unroll") for (int k = 0; k < 2; ++k) dst[m][k] = *(const LAS bf16x8*)(lds + PG8_SA(b, h) + aoff + m * 2048 + k * 1024); } while (0)
#define PG8_LDB(dst, b, h) do { _Pragma("unroll") for (int n = 0; n < 2; ++n) _Pragma("unroll") for (int k = 0; k < 2; ++k) dst[n][k] = *(const LAS bf16x8*)(lds + PG8_SB(b, h) + boff + n * 2048 + k * 1024); } while (0)
#define PG8_MMA(ai, bj, At, Bt) do { __builtin_amdgcn_s_setprio(1); _Pragma("unroll") for (int m = 0; m < 4; ++m) _Pragma("unroll") for (int n = 0; n < 2; ++n) _Pragma("unroll") for (int k = 0; k < 2; ++k) \
        acc[ai][bj][m][n] = __builtin_amdgcn_mfma_f32_16x16x32_bf16(Bt[n][k], At[m][k], acc[ai][bj][m][n], 0, 0, 0); __builtin_amdgcn_s_setprio(0); } while (0)
#define PG8_WAIT_V(n) asm volatile("s_waitcnt vmcnt(" #n ")" ::: "memory")
#define PG8_WAIT_L(n) asm volatile("s_waitcnt lgkmcnt(" #n ")" ::: "memory")
#define PG8_BAR __builtin_amdgcn_s_barrier()
#define PG8_SCHED __builtin_amdgcn_sched_barrier(0)
    Unit cur, nxt; int ui = 0;
    if (!S.next(0, cur)) return;
    f32x4 acc[2][2][4][2];
#pragma unroll
    for (int a = 0; a < 2; ++a)
#pragma unroll
        for (int b = 0; b < 2; ++b)
#pragma unroll
            for (int m = 0; m < 4; ++m)
#pragma unroll
                for (int n = 0; n < 2; ++n) acc[a][b][m][n] = (f32x4){0.f, 0.f, 0.f, 0.f};
    bf16x8 At[4][2], B0[2][2], B1[2][2];
    const char* cA = (const char*)g.A + (size_t)cur.pm * tstepA; const char* cB = (const char*)g.Bt + cur.bo + (size_t)cur.pn * tstep;
    if constexpr (GATHER) { PG8_GOFF(voffGc, 0); PG8_GOFF(voffGn, 0); }
    if constexpr (SP2) {
        PG8_STAGE(PG8_SB(0, 0), cB, voffB); PG8_STAGE(PG8_SB(0, 1), cB + hstep, voffB); PG8_STAGE_A(PG8_SA(0, 0), cA, 0, false); PG8_STAGE_A(PG8_SA(0, 1), cA, 1, false);
        if (wr == 1) PG8_BAR;
        PG8_WAIT_V(2); PG8_BAR;
        PG8_STAGE(PG8_SB(1, 0), cB + kstep, voffB); PG8_STAGE_A(PG8_SA(1, 0), cA + kstep, 0, false); PG8_STAGE(PG8_SB(1, 1), cB + hstep + kstep, voffB);
        PG8_WAIT_V(6); PG8_BAR;
    } else {
        PG8_STAGE(PG8_SB(0, 0), cB, voffB); PG8_STAGE(PG8_SA(0, 0), cA, voffA); PG8_STAGE(PG8_SB(0, 1), cB + hstep, voffB); PG8_STAGE(PG8_SA(0, 1), cA + hstep, voffA);
        if (wr == 1) PG8_BAR;
        PG8_WAIT_V(4); PG8_BAR;
        PG8_STAGE(PG8_SB(1, 0), cB + kstep, voffB); PG8_STAGE(PG8_SA(1, 0), cA + kstep, voffA); PG8_STAGE(PG8_SB(1, 1), cB + hstep + kstep, voffB);
        PG8_WAIT_V(6); PG8_BAR;
    }
    for (;;) {
        const bool has_next = S.next(ui + 1, nxt);
        if constexpr (GATHER) { if (has_next) PG8_GOFF(voffGn, ui + 1); }
        const char* nA = has_next ? (const char*)g.A + (size_t)nxt.pm * tstepA : cA; const char* nB = has_next ? (const char*)g.Bt + nxt.bo + (size_t)nxt.pn * tstep : cB;
#pragma unroll 1
        for (int t = 0; t < nt; t += 2) {
            const bool last = (t == nt - 2);
            const char* a1 = cA + (size_t)(t + 1) * kstep;
            const char* a2 = last ? nA : cA + (size_t)(t + 2) * kstep; const char* b2 = last ? nB : cB + (size_t)(t + 2) * kstep;
            const char* a3 = a2 + kstep; const char* b3 = b2 + kstep;
            if constexpr (SP2) {
            PG8_LDB(B0, 0, 0); PG8_LDB(B1, 0, 1); PG8_SCHED; PG8_LDA(At, 0, 0); PG8_STAGE_A(PG8_SA(1, 1), a1, 1, false);
            PG8_WAIT_V(8); PG8_WAIT_L(0); PG8_BAR; PG8_MMA(0, 0, At, B0); PG8_MMA(0, 1, At, B1); PG8_BAR; PG8_SCHED;
            PG8_LDA(At, 0, 1); PG8_STAGE(PG8_SB(0, 0), b2, voffB); PG8_STAGE(PG8_SB(0, 1), b2 + hstep, voffB); PG8_STAGE_A(PG8_SA(0, 0), a2, 0, last);
            PG8_WAIT_V(8); PG8_WAIT_L(0); PG8_BAR; PG8_MMA(1, 0, At, B0); PG8_MMA(1, 1, At, B1); PG8_BAR; PG8_SCHED;
            PG8_LDB(B0, 1, 0); PG8_LDB(B1, 1, 1); PG8_SCHED; PG8_LDA(At, 1, 0); PG8_STAGE_A(PG8_SA(0, 1), a2, 1, last);
            PG8_WAIT_V(8); PG8_WAIT_L(0); PG8_BAR; PG8_MMA(0, 0, At, B0); PG8_MMA(0, 1, At, B1); PG8_BAR; PG8_SCHED;
            PG8_LDA(At, 1, 1); PG8_STAGE(PG8_SB(1, 0), b3, voffB); PG8_STAGE(PG8_SB(1, 1), b3 + hstep, voffB); PG8_STAGE_A(PG8_SA(1, 0), a3, 0, last);
            PG8_WAIT_V(8); PG8_WAIT_L(0); PG8_BAR; PG8_MMA(1, 0, At, B0); PG8_MMA(1, 1, At, B1); PG8_BAR; PG8_SCHED;
            } else {
            PG8_LDB(B0, 0, 0); PG8_SCHED; PG8_LDA(At, 0, 0); PG8_STAGE(PG8_SA(1, 1), a1 + hstep, voffA);
            PG8_WAIT_L(8); PG8_BAR; PG8_WAIT_L(0); PG8_MMA(0, 0, At, B0); PG8_BAR; PG8_SCHED;
            PG8_LDB(B1, 0, 1); PG8_STAGE(PG8_SB(0, 0), b2, voffB);
            PG8_BAR; PG8_WAIT_L(0); PG8_MMA(0, 1, At, B1); PG8_BAR;
            PG8_LDA(At, 0, 1); PG8_STAGE(PG8_SA(0, 0), a2, voffA);
            PG8_BAR; PG8_WAIT_L(0); PG8_MMA(1, 0, At, B0); PG8_BAR; PG8_SCHED;
            PG8_STAGE(PG8_SB(0, 1), b2 + hstep, voffB);
            PG8_WAIT_V(6); PG8_BAR; PG8_MMA(1, 1, At, B1); PG8_BAR;
            PG8_LDB(B0, 1, 0); PG8_SCHED; PG8_LDA(At, 1, 0); PG8_STAGE(PG8_SA(0, 1), a2 + hstep, voffA);
            PG8_WAIT_L(8); PG8_BAR; PG8_WAIT_L(0); PG8_MMA(0, 0, At, B0); PG8_BAR; PG8_SCHED;
            PG8_LDB(B1, 1, 1); PG8_STAGE(PG8_SB(1, 0), b3, voffB);
            PG8_BAR; PG8_WAIT_L(0); PG8_MMA(0, 1, At, B1); PG8_BAR;
            PG8_LDA(At, 1, 1); PG8_STAGE(PG8_SA(1, 0), a3, voffA);
            PG8_BAR; PG8_WAIT_L(0); PG8_MMA(1, 0, At, B0); PG8_BAR; PG8_SCHED;
            PG8_STAGE(PG8_SB(1, 1), b3 + hstep, voffB);
            PG8_WAIT_V(6); PG8_BAR; PG8_MMA(1, 1, At, B1); PG8_BAR;
            }
        }
        if constexpr (ALIGN_EPI) { if (wr == 0) PG8_BAR; }
        E(acc, cur, wr, wc, fr, fq);
        if constexpr (Epi::PUBLISH) {
            asm volatile("s_waitcnt vmcnt(0)" ::: "memory"); PG8_BAR;
            if (tid == 0) __hip_atomic_fetch_add(E.flag + cur.pm * 16, 1u, __ATOMIC_RELAXED, __HIP_MEMORY_SCOPE_AGENT);
        }
        if (!has_next) break;
#pragma unroll
        for (int a = 0; a < 2; ++a)
#pragma unroll
            for (int b = 0; b < 2; ++b)
#pragma unroll
                for (int m = 0; m < 4; ++m)
#pragma unroll
                    for (int n = 0; n < 2; ++n) acc[a][b][m][n] = (f32x4){0.f, 0.f, 0.f, 0.f};
        cur = nxt; cA = nA; cB = nB; ++ui;
        if constexpr (GATHER) { _Pragma("unroll") for (int h_ = 0; h_ < 2; ++h_) _Pragma("unroll") for (int i_ = 0; i_ < 2; ++i_) voffGc[h_][i_] = voffGn[h_][i_]; }
        if constexpr (ALIGN_EPI) { if (wr == 1) PG8_BAR; }
    }
    PG8_WAIT_V(0);
    if constexpr (!ALIGN_EPI) { if (wr == 0) PG8_BAR; }
    PG8_BAR;
#undef PG8_SA
#undef PG8_STAGE_A
#undef PG8_GOFF
#undef PG8_SB
#undef PG8_STAGE
#undef PG8_LDA
#undef PG8_LDB
#undef PG8_MMA
#undef PG8_WAIT_V
#undef PG8_WAIT_L
#undef PG8_BAR
#undef PG8_SCHED
}
}

#define XB_TMO      128
#define XB_XCNT(j)  (256  + 64 * (j))
#define XB_XSUB(j)  (1280 + 64 * (j))
#define XB_XGEN(j)  (2304 + 64 * (j))
#define XB_TOP      3328
#define XB_TOPGEN   3392
#define XCD_BAR_WORDS 3456
#define XB_SPIN_CAP (1u << 18)
__device__ __forceinline__ unsigned xb_ld(unsigned* p)              { return __hip_atomic_load(p, __ATOMIC_RELAXED, __HIP_MEMORY_SCOPE_AGENT); }
__device__ __forceinline__ unsigned xb_add(unsigned* p, unsigned v) { return __hip_atomic_fetch_add(p, v, __ATOMIC_RELAXED, __HIP_MEMORY_SCOPE_AGENT); }
__device__ __forceinline__ unsigned xb_xcc_id() { return (unsigned)__builtin_amdgcn_s_getreg((3 << 11) | 20) & 0xFu; }
#define XB_SPIN(cond, bar) do { unsigned _sp = 0; while (cond) { __builtin_amdgcn_s_sleep(1); \
    if ((++_sp & 255u) == 0u) { if (xb_ld(&(bar)[XB_TMO])) break; if (_sp > XB_SPIN_CAP) { atomicAdd(&(bar)[XB_TMO], 1u); break; } } } } while (0)
struct XcdBarrier { unsigned* bar; unsigned x; volatile LAS unsigned* st; };
__device__ __forceinline__ XcdBarrier xcd_barrier_post(unsigned* bar, volatile LAS unsigned* st) {
    XcdBarrier b; b.bar = bar; b.x = xb_xcc_id(); b.st = st;
    if (threadIdx.x == 0) (void)xb_add(&bar[XB_XCNT(b.x)], 1u);
    return b;
}
__device__ __forceinline__ void xcd_barrier_complete(unsigned* bar, unsigned x, unsigned& nloc, unsigned& nx) {
    const unsigned G = gridDim.x * gridDim.y * gridDim.z;
    unsigned sum, cnt, mine, sp = 0u;
    for (;;) {
        sum = 0u; cnt = 0u; mine = 0u;
#pragma unroll 1
        for (unsigned j = 0; j < 16; ++j) { const unsigned c = xb_ld(&bar[XB_XCNT(j)]); sum += c; cnt += (c > 0u) ? 1u : 0u; mine = (j == x) ? c : mine; }
        if (sum == G) break;
        __builtin_amdgcn_s_sleep(1);
        if ((++sp & 255u) == 0u) { if (xb_ld(&bar[XB_TMO])) break; if (sp > XB_SPIN_CAP) { atomicAdd(&bar[XB_TMO], 1u); break; } }
    }
    nloc = mine > 0u ? mine : 1u; nx = cnt > 0u ? cnt : 1u;
}
__device__ __forceinline__ void xcd_barrier(const XcdBarrier& b, const int tid) {
    asm volatile("s_waitcnt vmcnt(0)" ::: "memory");
    __syncthreads();
    if (tid == 0) {
        unsigned* bar = b.bar;
        __builtin_amdgcn_s_waitcnt(0);
        unsigned nloc = b.st[0], nx = b.st[1];
        if (nloc == 0u) { xcd_barrier_complete(bar, b.x, nloc, nx); b.st[0] = nloc; b.st[1] = nx; }
        const unsigned old = xb_add(&bar[XB_XSUB(b.x)], 1u);
        const unsigned gen = old / nloc;
        if (old + 1u == (gen + 1u) * nloc) {
            __builtin_amdgcn_fence(__ATOMIC_RELEASE, "agent");
            asm volatile("s_waitcnt vmcnt(0)" ::: "memory");
            const unsigned og = xb_add(&bar[XB_TOP], 1u);
            const unsigned tg = og / nx;
            if (og + 1u == (tg + 1u) * nx) xb_add(&bar[XB_TOPGEN], 1u);
            else XB_SPIN(xb_ld(&bar[XB_TOPGEN]) == tg, bar);
            __builtin_amdgcn_fence(__ATOMIC_ACQUIRE, "agent");
            xb_add(&bar[XB_XGEN(b.x)], 1u);
            asm volatile("s_waitcnt vmcnt(0)" ::: "memory");
        } else {
            XB_SPIN(xb_ld(&bar[XB_XGEN(b.x)]) == gen, bar);
            __builtin_amdgcn_fence(__ATOMIC_ACQUIRE, "agent");
            asm volatile("s_waitcnt vmcnt(0)" ::: "memory");
        }
    }
    __syncthreads();
}

struct Frame {
    LAS unsigned char* lds;
    volatile LAS unsigned* MISC;
    unsigned* ctl;
    int tid, lane, wave, vcu, G, bx;
    float* out; unsigned char* ws;
};
struct Args { const float* in[28]; float* out; unsigned char* ws; int ph_lo, ph_hi; };
enum { I_X = 0, I_C, I_ADAW, I_ADAB, I_N1G, I_N2G, I_WIN, I_BF, I_QNA, I_KNA, I_QNC, I_KNC, I_LQ1, I_LK1, I_LQ2, I_LK2, I_SUBLN, I_QND, I_KND, I_MIXB, I_WOUT,
       I_WG, I_BG, I_WE, I_BE, I_W1, I_W3, I_W2 };
template <int I> __device__ __forceinline__ const float* inp() {
    auto ka = __builtin_amdgcn_kernarg_segment_ptr(); unsigned long long raw;
    asm volatile("s_load_dwordx2 %0, %1, %2\n\ts_waitcnt lgkmcnt(0)" : "=s"(raw) : "s"(ka), "i"(I * 8));
    return (const float*)(const GAS float*)raw;
}


struct TItem { const float* W; bf16* WT; const float* rs; int ldw, K, dst_row0, src_n0, kb, mapin; };
__device__ __forceinline__ int colmap_in(int n) { return n < 768 ? n : (n < 2984 ? n + 4 : (n < 2988 ? n - 2984 + 768 : -1)); }
__device__ __forceinline__ void t_load(const TItem& T, f32x4 (&v)[8], int lane) {
    const int k0 = 64 * T.kb, r8 = lane >> 3, c4 = (lane & 7) * 4; const int sc = T.mapin ? colmap_in(T.src_n0 + c4) : T.src_n0 + c4;
#pragma unroll
    for (int i = 0; i < 8; ++i) { v[i] = (f32x4){0.f, 0.f, 0.f, 0.f}; if (sc >= 0) v[i] = *(const f32x4*)(T.W + (size_t)(k0 + 8 * r8 + i) * T.ldw + sc); }
}
__device__ __forceinline__ void t_store(const TItem& T, f32x4 (&v)[8], LAS float* scr, int lane) {
    (void)scr;
    const int k0 = 64 * T.kb, r8 = lane >> 3, c4 = (lane & 7) * 4;
    if (T.rs) {
#pragma unroll
        for (int i = 0; i < 8; ++i) v[i] = v[i] * T.rs[k0 + 8 * r8 + i]; }
#pragma unroll
    for (int c = 0; c < 4; ++c) { u32x4 o; o.x = pg8::cvt_pk_bf16(v[0][c], v[1][c]); o.y = pg8::cvt_pk_bf16(v[2][c], v[3][c]); o.z = pg8::cvt_pk_bf16(v[4][c], v[5][c]); o.w = pg8::cvt_pk_bf16(v[6][c], v[7][c]);
        *(GAS u32x4*)(T.WT + (size_t)(T.dst_row0 + c4 + c) * T.K + k0 + 8 * r8) = o; }
}
__device__ __forceinline__ float lambda_init(int l) { return l == 0 ? 0.2f : (0.8f - 0.6f * 0.7408182206817179f); }

constexpr int CI_IN = 16 * 96, CI_OUT = 16 * 32, CI_UP1 = 16 * 8, CI_DN = 4 * 32, CN_UP = 32 * 2 * CI_UP1, CN_DN = 32 * CI_DN, NITEMS_L = CI_IN + CI_OUT + CN_UP + CN_DN;
__device__ __forceinline__ void fill_rowscale(Frame& F, const Args& A, int l, LAS float* rsl) {
    for (int k = F.tid; k < DM; k += 512) { float v = inp<I_MIXB>()[l * DM + k];
        if (k >= 512 && k < 768) v *= inp<I_SUBLN>()[l * 64 + ((k - 512) & 63)] * (1.f - lambda_init(l)); rsl[k] = v; }
}
__device__ __forceinline__ void convert_items(Frame& F, const Args& A, int l, int first, int stride, int limit, LAS float* rsl) {
    LAS float* scr = (LAS float*)(F.lds + F.wave * 8704);
    bf16* WIN = (bf16*)(F.ws + WS_WIN); bf16* WOUT = (bf16*)(F.ws + WS_WOUT); bf16* WUP = (bf16*)(F.ws + WS_WUP); bf16* WDN = (bf16*)(F.ws + WS_WDN);
    auto decode = [&](int it, TItem& T) {
        int r = it; T.rs = nullptr; T.mapin = 0;
        if (r < CI_IN) { T.kb = r / 96; const int nb = r % 96;
            T.W = inp<I_WIN>() + (size_t)l * DM * P_IN; T.ldw = P_IN; T.K = DM; T.WT = WIN + (size_t)l * NP * DM; T.dst_row0 = 32 * nb; T.src_n0 = 32 * nb; T.mapin = 1; return; }
        r -= CI_IN;
        if (r < CI_OUT) { T.kb = r / 32; const int nb = r % 32;
            T.W = inp<I_WOUT>() + (size_t)l * DM * DM; T.ldw = DM; T.K = DM; T.WT = WOUT + (size_t)l * DM * DM; T.dst_row0 = 32 * nb; T.src_n0 = 32 * nb; T.rs = (const float*)rsl; return; }
        r -= CI_OUT;
        if (r < CN_UP) { const int le = l * 32 + r / (2 * CI_UP1), q = r % (2 * CI_UP1), which = q / CI_UP1, q2 = q % CI_UP1; T.kb = q2 / 8; const int nb = q2 % 8;
            T.W = (which == 0 ? inp<I_W1>() : inp<I_W3>()) + (size_t)le * DM * FF; T.ldw = FF; T.K = DM; T.WT = WUP + (size_t)le * 512 * DM;
            const int n0 = 32 * nb, pn = n0 >> 7, j = n0 & 127; T.dst_row0 = 256 * pn + 128 * which + j; T.src_n0 = n0; return; }
        r -= CN_UP;
        { const int le = l * 32 + r / CI_DN, q = r % CI_DN; T.kb = q / 32; const int nb = q % 32;
          T.W = inp<I_W2>() + (size_t)le * FF * DM; T.ldw = DM; T.K = FF; T.WT = WDN + (size_t)le * DM * FF; T.dst_row0 = 32 * nb; T.src_n0 = 32 * nb; }
    };
    TItem T0, T1, T2; f32x4 v0[8], v1[8], v2[8]; int it = first;
    if (it < limit) { decode(it, T0); t_load(T0, v0, F.lane); }
    if (it + stride < limit) { decode(it + stride, T1); t_load(T1, v1, F.lane); }
    while (it < limit) {
        if (it + 2 * stride < limit) { decode(it + 2 * stride, T2); t_load(T2, v2, F.lane); }
        t_store(T0, v0, scr, F.lane); it += stride; if (it >= limit) break;
        if (it + 2 * stride < limit) { decode(it + 2 * stride, T0); t_load(T0, v0, F.lane); }
        t_store(T1, v1, scr, F.lane); it += stride; if (it >= limit) break;
        if (it + 2 * stride < limit) { decode(it + 2 * stride, T1); t_load(T1, v1, F.lane); }
        t_store(T2, v2, scr, F.lane); it += stride;
    }
}
constexpr int CV_L0 = NITEMS_L - CI_IN, CV_TOTAL = CV_L0 + NITEMS_L, CV_CHUNK = 64, CW_CVQ = 192;
__device__ __forceinline__ void convert_chunk(Frame& F, const Args& A, int gbase, LAS float* rsl2  ) {
    const int g0 = gbase + F.wave * (CV_CHUNK / NWAVES);
#pragma unroll 1
    for (int l = 0; l < 2; ++l) {
        const int lo = g0 > (l ? CV_L0 : 0) ? g0 : (l ? CV_L0 : 0), hi0 = g0 + CV_CHUNK / NWAVES, hi = hi0 < (l ? CV_TOTAL : CV_L0) ? hi0 : (l ? CV_TOTAL : CV_L0);
        if (lo < hi) { const int off = l ? -CV_L0 : CI_IN; convert_items(F, A, l, lo + off, 1, hi + off, rsl2 + l * DM); }
    }
}
__device__ __forceinline__ void convert_layer1_in_gap(Frame& F, const Args& A, int n2  ) {
    LAS float* rsl = (LAS float*)(F.lds + 8 * 8704);
    if (n2 < 0) n2 = 0; if (n2 > F.G - 32) n2 = F.G - 32;
    if (F.bx < n2) return;
    fill_rowscale(F, A, 1, rsl);
    __syncthreads();
    const int nw = (F.G - n2) * NWAVES;
    convert_items(F, A, 1, (F.bx - n2) * NWAVES + F.wave, nw, NITEMS_L, rsl);
    __syncthreads();
}

__device__ __forceinline__ void p0_prologue(Frame& F, const Args& A) {
    LAS float* rsl = (LAS float*)(F.lds + 8 * 8704);
    fill_rowscale(F, A, 0, rsl);
    __syncthreads();
    const int gw = F.vcu * NWAVES + F.wave, NGW = F.G * NWAVES;
    convert_items(F, A, 0, gw, NGW, BG_CONVERT ? CI_IN : NITEMS_L, rsl);
    if (!GAP_CONVERT && !BG_CONVERT) { __syncthreads(); fill_rowscale(F, A, 1, rsl); __syncthreads(); convert_items(F, A, 1, gw, NGW, NITEMS_L, rsl); }
    { bf16* WRH = (bf16*)(F.ws + WS_WR); bf16* WRL = WRH + 2 * 48 * DM;
      for (int i = gw * 64 + F.lane; i < 2 * 48 * DM; i += NGW * 64) { const int l = i / (48 * DM), r = i % (48 * DM), o = r >> 10, k = r & 1023;
          float w = 0.f; if (o < 4) w = inp<I_WG>()[((size_t)l * DM + k) * 4 + o]; else if (o < 36) w = inp<I_WE>()[((size_t)l * DM + k) * 32 + (o - 4)];
          const unsigned hi = f2bf(w); WRH[i] = (bf16)hi; WRL[i] = (bf16)f2bf(w - bf2f((unsigned short)hi)); } }
    if (F.bx == 0 && F.wave == 0) {
        for (int l = 0; l < 2; ++l) { float a = 0.f, b = 0.f; if (F.lane < 32) { a = inp<I_LQ1>()[l * 32 + F.lane] * inp<I_LK1>()[l * 32 + F.lane]; b = inp<I_LQ2>()[l * 32 + F.lane] * inp<I_LK2>()[l * 32 + F.lane]; }
            a = wave_sum(a); b = wave_sum(b); if (F.lane == 0) ((float*)(F.ws + WS_MISC))[l] = __expf(a) - __expf(b) + lambda_init(l); }
    }
    __syncthreads();
    LAS float* cact = (LAS float*)F.lds;
    LAS float* red = (LAS float*)(F.lds + 32768);
    for (int i = F.tid; i < BATCH * DM; i += 512) { const float c = inp<I_C>()[i]; cact[i] = c / (1.f + __expf(-c)); }
    __syncthreads();
    for (int item = F.bx; item < 2 * 96; item += F.G) {
        const int l = item / 96, nb = item % 96, n = nb * 64 + F.lane; const float* aw = inp<I_ADAW>() + (size_t)l * DM * 6144 + n;
        float acc[8];
#pragma unroll
        for (int b = 0; b < 8; ++b) acc[b] = 0.f;
        const int k0 = F.wave * 128;
#pragma unroll 32
        for (int k = 0; k < 128; ++k) { const float w = aw[(size_t)(k0 + k) * 6144];
#pragma unroll
            for (int b = 0; b < 8; ++b) acc[b] += cact[b * DM + k0 + k] * w; }
#pragma unroll
        for (int b = 0; b < 8; ++b) red[(F.wave * 8 + b) * 64 + F.lane] = acc[b];
        __syncthreads();
        { const int b = F.wave; float s = inp<I_ADAB>()[l * 6144 + n];
#pragma unroll
          for (int w = 0; w < 8; ++w) s += red[(w * 8 + b) * 64 + F.lane];
          ((float*)(F.ws + WS_MOD))[((size_t)l * 8 + b) * 6144 + n] = s; }
        __syncthreads();
    }
}

__device__ __forceinline__ void build_tables(Frame& F, int l) {
    volatile LAS int* cnts = (volatile LAS int*)(F.lds + CNTS_OFF); volatile LAS int* base = (volatile LAS int*)(F.lds + BASE_OFF); volatile LAS int* tab = (volatile LAS int*)(F.lds + TAB_OFF);
    __syncthreads();
    if (F.tid < 64) {
        const int e = F.tid; int cnt = 0; if (e < 32) cnt = (int)__hip_atomic_load(F.ctl + CW_CNT + (l * 32 + e) * 16, RLX_AGENT);
        const int n = (cnt + 255) >> 8; int incl = n;
#pragma unroll
        for (int o = 1; o < 32; o <<= 1) { const int u = shup_i(incl, o, e); if (e >= o) incl += u; }
        const int t0 = incl - n;
        if (e < 32) { cnts[e] = cnt; base[e] = t0; for (int j = 0; j < n && t0 + j < MAXTILE; ++j) tab[t0 + j] = e; }
        if (e == 31) F.MISC[1] = (unsigned)(incl < MAXTILE ? incl : MAXTILE);
    }
    __syncthreads();
}
__device__ __forceinline__ void row_pass(Frame& F, const Args& A, int mode, int l) {
    const int gw = F.vcu * NWAVES + F.wave; const int lane = F.lane;
    const float* MOD = (const float*)(F.ws + WS_MOD);
    float* X1 = (float*)(F.ws + WS_X1); bf16* H = (bf16*)(F.ws + WS_H); const bf16* Y = (const bf16*)(F.ws + WS_Y);
    const int* tok_e = (const int*)(F.ws + WS_TOK); const int* tok_pos = (const int*)(F.ws + WS_TOK) + 4 * M; const float* tok_w = (const float*)(F.ws + WS_TOK) + 2 * M;
    volatile LAS int* basel = (volatile LAS int*)(F.lds + BASE_OFF);
    if (mode != 0) build_tables(F, mode == 1 ? 0 : 1);
    const int b = (gw * 8) >> 11; const int lp = (mode == 1) ? 0 : 1;
    f32x4 g2v[4], gm[4], shv[4];
#pragma unroll
    for (int j = 0; j < 4; ++j) { const int col = 256 * j + 4 * lane;
        g2v[j] = (f32x4){0.f, 0.f, 0.f, 0.f}; gm[j] = g2v[j]; shv[j] = g2v[j];
        if (mode != 0) g2v[j] = *(const f32x4*)(MOD + ((size_t)lp * 8 + b) * 6144 + 5 * DM + col);
        if (mode != 2) { const float* md = MOD + ((size_t)l * 8 + b) * 6144; gm[j] = *(const f32x4*)(inp<I_N1G>() + l * DM + col) * (*(const f32x4*)(md + DM + col) + 1.0f); shv[j] = *(const f32x4*)(md + col); } }
    for (int m0 = gw * 8; m0 < gw * 8 + 8; m0 += 4) {
        f32x4 v[4][4]; u32x2 ya[4][4], yb[4][4]; float wa[4], wb[4];
        if (mode != 0) {
            int sa[4], sb[4];
#pragma unroll
            for (int r = 0; r < 4; ++r) { const int m = m0 + r; sa[r] = 256 * basel[tok_e[m]] + tok_pos[m]; sb[r] = 256 * basel[tok_e[M + m]] + tok_pos[M + m]; wa[r] = tok_w[m]; wb[r] = tok_w[M + m]; }
#pragma unroll
            for (int r = 0; r < 4; ++r)
#pragma unroll
                for (int j = 0; j < 4; ++j) { const int col = 256 * j + 4 * lane; ya[r][j] = *(const u32x2*)(Y + (size_t)sa[r] * DM + col); yb[r][j] = *(const u32x2*)(Y + (size_t)sb[r] * DM + col); }
        }
#pragma unroll
        for (int r = 0; r < 4; ++r) { const int m = m0 + r; const float* xr = (mode == 0) ? inp<I_X>() + (size_t)m * DM : X1 + (size_t)m * DM;
#pragma unroll
            for (int j = 0; j < 4; ++j) v[r][j] = *(const f32x4*)(xr + 256 * j + 4 * lane); }
#pragma unroll
        for (int r = 0; r < 4; ++r) { const int m = m0 + r;
            if (mode != 0) {
#pragma unroll
                for (int j = 0; j < 4; ++j) { const u32x2 a = ya[r][j], c = yb[r][j];
                    f32x4 mo; mo[0] = wa[r] * bf2f(a.x & 0xffff) + wb[r] * bf2f(c.x & 0xffff); mo[1] = wa[r] * bf2f(a.x >> 16) + wb[r] * bf2f(c.x >> 16);
                    mo[2] = wa[r] * bf2f(a.y & 0xffff) + wb[r] * bf2f(c.y & 0xffff); mo[3] = wa[r] * bf2f(a.y >> 16) + wb[r] * bf2f(c.y >> 16);
                    v[r][j] = v[r][j] + g2v[j] * mo; }
                float* orow = (mode == 1) ? X1 + (size_t)m * DM : F.out + (size_t)m * DM;
#pragma unroll
                for (int j = 0; j < 4; ++j) *(f32x4*)(orow + 256 * j + 4 * lane) = v[r][j];
            }
            if (mode != 2) {
                float ss = 0.f;
#pragma unroll
                for (int j = 0; j < 4; ++j) ss += (v[r][j][0] * v[r][j][0] + v[r][j][1] * v[r][j][1]) + (v[r][j][2] * v[r][j][2] + v[r][j][3] * v[r][j][3]);
                const float rstd = 1.0f / sqrtf(wave_sum(ss) * (1.f / DM) + RMS_EPS);
#pragma unroll
                for (int j = 0; j < 4; ++j) { const f32x4 hv = v[r][j] * rstd * gm[j] + shv[j]; u32x2 w; w.x = pk2(hv[0], hv[1]); w.y = pk2(hv[2], hv[3]);
                    *(u32x2*)(H + (size_t)m * DM + 256 * j + 4 * lane) = w; }
            }
        }
    }
}

__device__ __forceinline__ void knorm_seg(bf16* p, int lane, int nlanes_active, int group_lanes, const float* gain, int gmask, float inv_n) {
    u32x2 raw = (u32x2){0u, 0u}; if (lane < nlanes_active) raw = *(const u32x2*)(p + 4 * lane);
    float x0 = bf2f(raw.x & 0xffff), x1 = bf2f(raw.x >> 16), x2 = bf2f(raw.y & 0xffff), x3 = bf2f(raw.y >> 16);
    float ss = (x0 * x0 + x1 * x1) + (x2 * x2 + x3 * x3);
    for (int o = 1; o < group_lanes; o <<= 1) ss += __shfl_xor(ss, o);
    const float rstd = 1.0f / sqrtf(ss * inv_n + RMS_EPS);
    const int c = (4 * lane) & gmask;
    x0 *= rstd * gain[c]; x1 *= rstd * gain[c + 1]; x2 *= rstd * gain[c + 2]; x3 *= rstd * gain[c + 3];
    if (lane < nlanes_active) { u32x2 w; w.x = pk2(x0, x1); w.y = pk2(x2, x3); *(u32x2*)(p + 4 * lane) = w; }
}
__device__ __forceinline__ unsigned sortable(float f) { const unsigned u = __builtin_bit_cast(unsigned, f); return (u & 0x80000000u) ? ~u : (u | 0x80000000u); }


__device__ __forceinline__ int wave_sum_i(int v) {
    v += __builtin_amdgcn_update_dpp(0, v, 0xB1, 0xF, 0xF, true);
    v += __builtin_amdgcn_update_dpp(0, v, 0x4E, 0xF, 0xF, true);
    v += __builtin_amdgcn_update_dpp(0, v, 0x141, 0xF, 0xF, true);
    v += __builtin_amdgcn_update_dpp(0, v, 0x140, 0xF, 0xF, true);
    return __builtin_amdgcn_readlane(v, 0) + __builtin_amdgcn_readlane(v, 16) + __builtin_amdgcn_readlane(v, 32) + __builtin_amdgcn_readlane(v, 48);
}
__device__ __forceinline__ void transpose32(unsigned (&a)[32]) {
#define TSTAGE(S, MSK) _Pragma("unroll") for (int i = 0; i < 32; ++i) if (!(i & S)) { const unsigned x = a[i], y = a[i + S]; a[i] = (x & MSK) | ((y << S) & ~MSK); a[i + S] = ((x >> S) & MSK) | (y & ~MSK); }
    TSTAGE(16, 0x0000FFFFu) TSTAGE(8, 0x00FF00FFu) TSTAGE(4, 0x0F0F0F0Fu) TSTAGE(2, 0x33333333u) TSTAGE(1, 0x55555555u)
#undef TSTAGE
}
__device__ __forceinline__ void sel_step(unsigned T, unsigned& cand, unsigned& above, int& na, int& nc, bool& done, bool& exact) {
    const unsigned ones = cand & T; const int s1 = wave_sum_i(__builtin_popcount(ones));
    if (na + s1 >= 256) { cand = ones; nc = s1; }
    else { above |= ones; na += s1; cand &= ~T; nc -= s1; }
    if (na + nc == 256) { done = true; exact = true; }
}
__device__ __forceinline__ unsigned sel_finish(unsigned cand, unsigned above, int na, bool exact, int lane) {
    if (exact) return above | cand;
    const int need = 256 - na; const int pc = __builtin_popcount(cand); int incl = pc;
#pragma unroll
    for (int o = 1; o < 64; o <<= 1) { const int t = shup_i(incl, o, lane); if (lane >= o) incl += t; }
    int take = need - (incl - pc); take = take < 0 ? 0 : (take > pc ? pc : take);
    unsigned w = cand, res = above;
    for (int k = 0; k < take; ++k) { const unsigned low = w & (0u - w); res |= low; w ^= low; }
    return res;
}

__device__ __forceinline__ void p3_prep(Frame& F, const Args& A, int l, int rep) {
    const int gw = F.vcu * NWAVES + F.wave, NGW = F.G * NWAVES;
    bf16* PROJ = (bf16*)(F.ws + WS_PROJ);
    if (!(rep > 0 && PROBE_P3_PART == 2)) { const float* ga = inp<I_KNA>() + l * 64; const float* gc = inp<I_KNC>() + l * 32; const float* gd = inp<I_KND>() + l * 64;
      const int la = F.lane; const int ca = (4 * la) & 63, cc = (4 * la) & 31;
      const f32x4 gva = *(const f32x4*)(ga + ca), gvc = *(const f32x4*)(gc + cc), gvd = *(const f32x4*)(gd + ca);
      for (int mb = gw * 8; mb < gw * 8 + 8; mb += 8) {
        u32x2 ra[8], rc[8], rd[8];
#pragma unroll
        for (int i = 0; i < 8; ++i) { bf16* row = PROJ + (size_t)(mb + i) * NP; ra[i] = *(const u32x2*)(row + C_AK + 4 * la); rc[i] = *(const u32x2*)(row + C_CK + 4 * la);
            rd[i] = (u32x2){0u, 0u}; if (la < 16) rd[i] = *(const u32x2*)(row + C_DK + 4 * la); }
#pragma unroll
        for (int i = 0; i < 8; ++i) { bf16* row = PROJ + (size_t)(mb + i) * NP;
            { float x0 = bf2f(ra[i].x & 0xffff), x1 = bf2f(ra[i].x >> 16), x2 = bf2f(ra[i].y & 0xffff), x3 = bf2f(ra[i].y >> 16); float ss = (x0 * x0 + x1 * x1) + (x2 * x2 + x3 * x3);
              ss += shx<1>(ss); ss += shx<2>(ss); ss += shx<4>(ss); ss += shx<8>(ss); const float rs = 1.0f / sqrtf(ss * (1.f / 64.f) + RMS_EPS);
              u32x2 w; w.x = pk2(x0 * rs * gva[0], x1 * rs * gva[1]); w.y = pk2(x2 * rs * gva[2], x3 * rs * gva[3]); *(u32x2*)(row + C_AK + 4 * la) = w; }
            { float x0 = bf2f(rc[i].x & 0xffff), x1 = bf2f(rc[i].x >> 16), x2 = bf2f(rc[i].y & 0xffff), x3 = bf2f(rc[i].y >> 16); float ss = (x0 * x0 + x1 * x1) + (x2 * x2 + x3 * x3);
              ss += shx<1>(ss); ss += shx<2>(ss); ss += shx<4>(ss); const float rs = 1.0f / sqrtf(ss * (1.f / 32.f) + RMS_EPS);
              u32x2 w; w.x = pk2(x0 * rs * gvc[0], x1 * rs * gvc[1]); w.y = pk2(x2 * rs * gvc[2], x3 * rs * gvc[3]); *(u32x2*)(row + C_CK + 4 * la) = w; }
            { float x0 = bf2f(rd[i].x & 0xffff), x1 = bf2f(rd[i].x >> 16), x2 = bf2f(rd[i].y & 0xffff), x3 = bf2f(rd[i].y >> 16); float ss = (x0 * x0 + x1 * x1) + (x2 * x2 + x3 * x3);
              ss += shx<1>(ss); ss += shx<2>(ss); ss += shx<4>(ss); ss += shx<8>(ss); const float rs = 1.0f / sqrtf(ss * (1.f / 64.f) + RMS_EPS);
              u32x2 w; w.x = pk2(x0 * rs * gvd[0], x1 * rs * gvd[1]); w.y = pk2(x2 * rs * gvd[2], x3 * rs * gvd[3]); if (la < 16) *(u32x2*)(row + C_DK + 4 * la) = w; }
        }
      }
    }
    if (!(rep > 0 && PROBE_P3_PART == 2)) {
        const int bh = gw >> 6, ck = gw & 63, b = bh >> 2, h = bh & 3; const float bfv = inp<I_BF>()[l * 4 + h];
        const int t = 32 * ck + (F.lane & 31);
        const float x = bf2f(PROJ[((size_t)b * SEQ + t) * NP + C_AF + h]) + bfv;
        float incl = fminf(x, 0.f) - log1pf(__expf(-fabsf(x)));
#pragma unroll
        for (int o = 1; o < 32; o <<= 1) { const float u = shup(incl, o, F.lane); if ((F.lane & 31) >= o) incl += u; }
        float* cum = (float*)(F.ws + WS_CUM);
        if (F.lane < 32) cum[(size_t)bh * SEQ + t] = incl;
        if (F.lane == 31) cum[32 * SEQ + bh * 64 + ck] = incl;
    }
    LAS float* sc = (LAS float*)F.lds;
    unsigned* MASK = (unsigned*)(F.ws + WS_MASK);
    constexpr int SCP = 2052;
    const int lane = F.lane, kq = lane >> 4, qi = lane & 15;
    __syncthreads();
    bf16x8 bq[8], wvr, akv[16];
    const auto unit_geom = [&](int i, int& b, int& t0, int& nkt) { const int u = F.bx + 256 * i; b = u >> 7; const int tqr = u & 127, tq = (i & 1) ? 127 - tqr : tqr; t0 = tq * 16; nkt = tq + 1; };
    const auto unit_load_q = [&](int i) { int b, t0, nkt; unit_geom(i, b, t0, nkt); const bf16* qrow = PROJ + (size_t)b * SEQ * NP + (size_t)(t0 + qi) * NP;
#pragma unroll
        for (int h = 0; h < 8; ++h) bq[h] = *(const bf16x8*)(qrow + C_IQ + h * 32 + 8 * kq);
        wvr = *(const bf16x8*)(qrow + C_IW); };
    const auto unit_load_k = [&](int i) { int b, t0, nkt; unit_geom(i, b, t0, nkt); const bf16* pb = PROJ + (size_t)b * SEQ * NP;
#pragma unroll
        for (int j = 0; j < 16; ++j) { const int kt = F.wave + 8 * j; akv[j] = (bf16x8){0, 0, 0, 0, 0, 0, 0, 0}; if (kt < nkt) akv[j] = *(const bf16x8*)(pb + (size_t)(kt * 16 + qi) * NP + C_IK + 8 * kq); } };
    const bool do_c = !(rep > 0 && PROBE_P3_PART == 1);
    if (do_c) unit_load_q(0);
    for (int i = 0; i < 4; ++i) {
        if (!do_c) break;
        int b, t0, nkt; unit_geom(i, b, t0, nkt);
        unit_load_k(i);
        float wq[8];
#pragma unroll
        for (int h = 0; h < 8; ++h) wq[h] = bf2f((unsigned short)wvr[h]) * (0.35355339059327373f * 0.17677669529663687f);
#pragma unroll
        for (int j = 0; j < 16; ++j) { const int kt = F.wave + 8 * j;
            if (kt < nkt) {
            f32x4 a4 = (f32x4){0.f, 0.f, 0.f, 0.f};
#pragma unroll
            for (int h = 0; h < 8; ++h) { const f32x4 s = __builtin_amdgcn_mfma_f32_16x16x32_bf16(akv[j], bq[h], (f32x4){0.f, 0.f, 0.f, 0.f}, 0, 0, 0);
#pragma unroll
                for (int r = 0; r < 4; ++r) a4[r] += wq[h] * fmaxf(s[r], 0.f); }
#pragma unroll
            for (int r = 0; r < 4; ++r) a4[r] += 0.f;
            { const int ci = kt * 4 + kq, L = ci >> 3, c = ci & 7;
              *(LAS f32x4*)(sc + qi * SCP + 4 * (L * 8 + (c ^ (L & 7)))) = a4; }
            } }
        if (i + 1 < 4) unit_load_q(i + 1);
        LDS_WAIT(); __syncthreads();
        if (rep > 0 && PROBE_P3_PART == 2) { }
        else if (t0 < 256) {
            for (int rr = 0; rr < 2; ++rr) { const int t = t0 + 2 * F.wave + rr; const int nb = t - 32 * lane + 1;
                MASK[((size_t)b * SEQ + t) * 64 + lane] = nb >= 32 ? 0xffffffffu : (nb <= 0 ? 0u : ((1u << nb) - 1u)); }
        } else {
            const int rA = 2 * F.wave, tA = t0 + rA, tB = tA + 1;
            unsigned ua[32], ub[32];
#pragma unroll
            for (int c = 0; c < 8; ++c) { const int off = 4 * (lane * 8 + (c ^ (lane & 7)));
                const f32x4 fa = *(const LAS f32x4*)(sc + rA * SCP + off), fb = *(const LAS f32x4*)(sc + (rA + 1) * SCP + off);
#pragma unroll
                for (int i = 0; i < 4; ++i) { ua[c * 4 + i] = sortable(fa[i]); ub[c * 4 + i] = sortable(fb[i]); } }
            transpose32(ua); transpose32(ub);
            unsigned candA, candB, abA = 0u, abB = 0u; int naA = 0, naB = 0, ncA = tA + 1, ncB = tB + 1; bool dA = false, dB = false, eA = false, eB = false;
            { const int nbA = tA - 32 * lane + 1, nbB = tB - 32 * lane + 1;
              candA = nbA >= 32 ? 0xffffffffu : (nbA <= 0 ? 0u : ((1u << nbA) - 1u)); candB = nbB >= 32 ? 0xffffffffu : (nbB <= 0 ? 0u : ((1u << nbB) - 1u)); }
#pragma unroll
            for (int bit = 31; bit >= 0; --bit) {
                if (!dA) sel_step(ua[bit], candA, abA, naA, ncA, dA, eA);
                if (!dB) sel_step(ub[bit], candB, abB, naB, ncB, dB, eB);
                if (dA && dB) break;
            }
            MASK[((size_t)b * SEQ + tA) * 64 + lane] = sel_finish(candA, abA, naA, eA, lane);
            MASK[((size_t)b * SEQ + tB) * 64 + lane] = sel_finish(candB, abB, naB, eB, lane);
        }
        __syncthreads();
    }
}

namespace att {
template <bool B> struct BoolC { static constexpr bool value = B; };
constexpr int SLOTB = 8192, L_K = 0, L_V = 3 * SLOTB, L_WS = 6 * SLOTB, L_OST = L_WS + 2048, L_CUM = L_OST + 8 * 8192, L_END = L_CUM + 8192;
constexpr int MROW = 66;
static_assert(L_OST + 256 * MROW * 4 <= L_END && L_END <= RING_BYTES, "attention LDS map");
constexpr float THR = 8.0f;
__device__ __forceinline__ int crow(int r, int hi) { return (r & 3) + 8 * (r >> 2) + 4 * hi; }
__device__ __forceinline__ void glds16(const void* gsrc, unsigned lds_dst) { unsigned keep;
    asm volatile("s_mov_b32 %0, m0\n\ts_mov_b32 m0, %2\n\ts_nop 0\n\tglobal_load_lds_dwordx4 %1, off\n\ts_mov_b32 m0, %0" : "=&s"(keep) : "v"(gsrc), "s"(lds_dst) : "memory"); }
#define ATT_WAIT_BAR() asm volatile("s_waitcnt vmcnt(0) lgkmcnt(0)\n\ts_barrier" ::: "memory")
__device__ __forceinline__ unsigned cvtpk_s(float lo, float hi) { typedef __bf16 bf16x2_t __attribute__((ext_vector_type(2))); f32x2 v = {lo, hi}; bf16x2_t b = __builtin_convertvector(v, bf16x2_t); return __builtin_bit_cast(unsigned, b); }
__device__ __forceinline__ float xhalf(float x, int hi) { auto rr = __builtin_amdgcn_permlane32_swap(__builtin_bit_cast(unsigned, x), __builtin_bit_cast(unsigned, x), false, false);
    return __builtin_bit_cast(float, hi ? rr[0] : rr[1]); }
template <int DA, int DB>
__device__ __forceinline__ void qkt(f32x16& p0, f32x16& p1, const LAS char* Kslot, const bf16x8* qr, const f32x16& cin, int r32, int hi) {
    const LAS char* kb = Kslot + hi * 1024 + r32 * 16;
#pragma unroll
    for (int d0 = DA; d0 < DB; ++d0) {
        const bf16x8 b0 = *(const LAS bf16x8*)(kb + d0 * 2048), b1 = *(const LAS bf16x8*)(kb + d0 * 2048 + 512);
        if (d0 == DA) { p0 = __builtin_amdgcn_mfma_f32_32x32x16_bf16(b0, qr[d0], cin, 0, 0, 0); p1 = __builtin_amdgcn_mfma_f32_32x32x16_bf16(b1, qr[d0], cin, 0, 0, 0); }
        else { p0 = __builtin_amdgcn_mfma_f32_32x32x16_bf16(b0, qr[d0], p0, 0, 0, 0); p1 = __builtin_amdgcn_mfma_f32_32x32x16_bf16(b1, qr[d0], p1, 0, 0, 0); } }
}
__device__ __forceinline__ void pv(f32x16* o, int vb, bf16x8 pa0, bf16x8 pa1, bf16x8 pa2, bf16x8 pa3) {
    s16x4 lo[2][4], hi[2][4];
#pragma unroll
    for (int d0 = 0; d0 < 2; ++d0)
#pragma unroll
        for (int ks = 0; ks < 4; ++ks) {
            asm volatile("ds_read_b64_tr_b16 %0,%1 offset:%c2" : "=&v"(lo[d0][ks]) : "v"(vb), "i"(d0 * 4096 + ks * 1024) : "memory");
            asm volatile("ds_read_b64_tr_b16 %0,%1 offset:%c2" : "=&v"(hi[d0][ks]) : "v"(vb), "i"(d0 * 4096 + ks * 1024 + 512) : "memory"); }
    asm volatile("s_waitcnt lgkmcnt(0)" ::: "memory"); __builtin_amdgcn_sched_barrier(0);
#define PK(d, k) (bf16x8){lo[d][k][0], lo[d][k][1], lo[d][k][2], lo[d][k][3], hi[d][k][0], hi[d][k][1], hi[d][k][2], hi[d][k][3]}
    o[0] = __builtin_amdgcn_mfma_f32_32x32x16_bf16(pa0, PK(0, 0), o[0], 0, 0, 0); o[1] = __builtin_amdgcn_mfma_f32_32x32x16_bf16(pa0, PK(1, 0), o[1], 0, 0, 0);
    o[0] = __builtin_amdgcn_mfma_f32_32x32x16_bf16(pa1, PK(0, 1), o[0], 0, 0, 0); o[1] = __builtin_amdgcn_mfma_f32_32x32x16_bf16(pa1, PK(1, 1), o[1], 0, 0, 0);
    o[0] = __builtin_amdgcn_mfma_f32_32x32x16_bf16(pa2, PK(0, 2), o[0], 0, 0, 0); o[1] = __builtin_amdgcn_mfma_f32_32x32x16_bf16(pa2, PK(1, 2), o[1], 0, 0, 0);
    o[0] = __builtin_amdgcn_mfma_f32_32x32x16_bf16(pa3, PK(0, 3), o[0], 0, 0, 0); o[1] = __builtin_amdgcn_mfma_f32_32x32x16_bf16(pa3, PK(1, 3), o[1], 0, 0, 0);
#undef PK
}
__device__ __forceinline__ float rowmax(const f32x16& p0, const f32x16& p1, int hi) {
    float a = fmaxf(fmaxf(p0[0], p0[1]), p1[0]), b = fmaxf(fmaxf(p0[2], p0[3]), p1[1]); a = fmaxf(fmaxf(a, p1[2]), p1[3]);
#pragma unroll
    for (int r = 4; r < 16; r += 4) { a = fmaxf(fmaxf(a, p0[r]), p0[r + 1]); b = fmaxf(fmaxf(b, p0[r + 2]), p0[r + 3]); a = fmaxf(fmaxf(a, p1[r]), p1[r + 1]); b = fmaxf(fmaxf(b, p1[r + 2]), p1[r + 3]); }
    const float m = fmaxf(a, b); return fmaxf(m, xhalf(m, hi));
}
struct AttnP { const bf16* proj; bf16* mix; const float* cum; const unsigned* mask; const float* qgain[4]; const float* kgain[4]; float lam; };

template <int VAR>
__device__ __forceinline__ void attn_unit(const AttnP& P, int b, int h, int qb, LAS char* sh, const int tid_in, const int pm, unsigned* qctr, volatile LAS unsigned* qslot) {
    int tid = tid_in; asm volatile("" : "+v"(tid));
    const int lane = tid & 63, r32 = lane & 31, hi = lane >> 5; const int wid = __builtin_amdgcn_readfirstlane(tid >> 6);
    const long rowbase = (long)b * SEQ; const int q0 = qb * 256, NT = 4 * (qb + 1);
    const int qrel = wid * 32 + r32, tq = q0 + qrel;
    constexpr bool REV = VAR != 0;
    constexpr int QCB = VAR == 0 ? C_AQ : VAR == 1 ? C_BQ : VAR == 2 ? C_CQ : C_DQ;
    constexpr int KCB = VAR == 0 ? C_AK : VAR == 1 ? C_BK : VAR == 2 ? C_CK : C_DK;
    constexpr int VCB = VAR == 0 ? C_AV : VAR == 1 ? C_BV : VAR == 2 ? C_CV : C_DV;
    const int Qc = QCB + 64 * h, Kc = VAR == 3 ? KCB : KCB + 64 * h, Vc = VAR == 3 ? VCB : VCB + 64 * h;
    const bf16* PR = P.proj;
    LAS float* wsf = (LAS float*)(sh + L_WS) + wid * 64;
    LAS float* stg = (LAS float*)(sh + L_OST) + wid * 2048;
    LAS float* cumL = (LAS float*)(sh + L_CUM);
    LAS unsigned* maskL = (LAS unsigned*)(sh + L_OST);
    const unsigned lds0 = (unsigned)(uintptr_t)sh;
    const bf16* ksrc = PR + (size_t)(rowbase + lane) * NP + Kc + wid * 8;
    const bf16* vsrc = PR + (size_t)(rowbase + 16 * (wid & 3) + (lane >> 2)) * NP + Vc + (wid >> 2) * 32 + (lane & 3) * 8;
    const unsigned kdst = lds0 + L_K + wid * 1024, vdst = lds0 + L_V + wid * 1024;
#define DMA_KV(t, slot) do { glds16(ksrc + (size_t)(t) * 64 * NP, (unsigned)__builtin_amdgcn_readfirstlane(kdst + (slot))); glds16(vsrc + (size_t)(t) * 64 * NP, (unsigned)__builtin_amdgcn_readfirstlane(vdst + (slot))); } while (0)
    DMA_KV(REV ? NT - 1 : 0, 0); DMA_KV(REV ? NT - 2 : 1, SLOTB);
    if (VAR == 0) {
        LAS float* pref = (LAS float*)(sh + L_WS);
        if (tid < 64) { const float ct = P.cum[32 * SEQ + (b * 4 + h) * 64 + tid]; float incl = ct;
#pragma unroll
            for (int o = 1; o < 64; o <<= 1) { const float u = shup(incl, o, tid); if (tid >= o) incl += u; }
            pref[tid] = incl - ct; }
        asm volatile("s_waitcnt lgkmcnt(0)\n\ts_barrier" ::: "memory");
        const float* cg = P.cum + (size_t)(b * 4 + h) * SEQ; for (int i = tid; i < q0 + 256; i += 512) cumL[i] = (cg[i] + pref[i >> 5]) * LOG2E;
        asm volatile("s_waitcnt lgkmcnt(0)\n\ts_barrier" ::: "memory");
    }
    if (VAR == 3) { const unsigned* mg = P.mask + (size_t)(rowbase + q0) * 64; const int nw = 2 * NT;
        for (int i = tid; i < 256 * 64; i += 512) { const int row = i >> 6, w = i & 63; if (w < nw) maskL[row * MROW + w] = mg[i]; } }
    asm volatile("s_waitcnt vmcnt(0) lgkmcnt(0)\n\ts_barrier" ::: "memory");
    const int vb0 = (int)(lds0 + L_V) + ((lane >> 4) & 1) * 32 + (lane & 3) * 8 + (4 * hi + ((lane & 15) >> 2)) * 64;
    float slope2 = 0.f;
    if (VAR == 2) slope2 = __builtin_amdgcn_exp2f(-(float)(2 * h + 1)) * LOG2E;
    if (VAR == 3) slope2 = __builtin_amdgcn_exp2f(-(float)(2 * h + 2)) * LOG2E;
    float cumt = 0.f; if (VAR == 0) cumt = cumL[tq];
    constexpr int NPASS = VAR == 2 ? 2 : 1;
    unsigned nxt_u = 0u;
    for (int pass = 0; pass < NPASS; ++pass) {
        bf16x8 qa[4]; float sb0 = 0.f;
        { const bf16* Qw = PR + (size_t)(rowbase + tq) * NP + Qc;
          constexpr int ND0 = VAR == 2 ? 2 : 4; const int dbase = VAR == 2 ? 2 * pass : 0;
          float qf[8 * ND0];
#pragma unroll
          for (int d0 = 0; d0 < ND0; ++d0) { const bf16x8 raw = *(const bf16x8*)(Qw + (dbase + d0) * 16 + hi * 8);
#pragma unroll
              for (int j = 0; j < 8; ++j) qf[d0 * 8 + j] = bf2f((unsigned short)raw[j]); }
          constexpr float SC = (VAR == 2 ? 0.17677669529663687f : 0.125f) * LOG2E;
          if (VAR != 1) {
              float ss = 0.f;
#pragma unroll
              for (int i = 0; i < 8 * ND0; ++i) ss += qf[i] * qf[i];
              ss += xhalf(ss, hi); const float rstd = 1.0f / sqrtf(ss * (VAR == 2 ? 1.f / 32.f : 1.f / 64.f) + RMS_EPS);
              const float* g = P.qgain[VAR];
#pragma unroll
              for (int d0 = 0; d0 < ND0; ++d0)
#pragma unroll
                  for (int j = 0; j < 8; ++j) qf[d0 * 8 + j] *= rstd * g[16 * d0 + 8 * hi + j] * SC;
          } else {
#pragma unroll
              for (int i = 0; i < 8 * ND0; ++i) qf[i] *= SC;
          }
          if (VAR == 2 || VAR == 3) {
              float n0 = 0.f;
#pragma unroll
              for (int i = 0; i < 8 * ND0; ++i) n0 += qf[i] * qf[i];
              n0 += xhalf(n0, hi);
              float gk = fabsf(P.kgain[VAR][lane & (VAR == 2 ? 31 : 63)]);
              gk = fmaxf(gk, shx<1>(gk)); gk = fmaxf(gk, shx<2>(gk)); gk = fmaxf(gk, shx<4>(gk)); gk = fmaxf(gk, shx<8>(gk)); gk = fmaxf(gk, shx<16>(gk)); gk = half_max(gk);
              sb0 = 1.02f * sqrtf(n0) * (VAR == 2 ? 5.656854249f : 8.0f) * gk;
          }
#pragma unroll
          for (int d0 = 0; d0 < ND0; ++d0) { u32x4 w; w.x = cvtpk_s(qf[d0 * 8 + 0], qf[d0 * 8 + 1]); w.y = cvtpk_s(qf[d0 * 8 + 2], qf[d0 * 8 + 3]); w.z = cvtpk_s(qf[d0 * 8 + 4], qf[d0 * 8 + 5]); w.w = cvtpk_s(qf[d0 * 8 + 6], qf[d0 * 8 + 7]);
              qa[d0] = __builtin_bit_cast(bf16x8, w); }
          if (VAR == 2) { qa[2] = qa[0]; qa[3] = qa[1]; }
        }
        float mhat = -1e30f, l_reg = 0.f, Rp = 1.f; f32x16 o[2]; const float sbound = sb0;
#pragma unroll
        for (int r = 0; r < 16; ++r) { o[0][r] = 0.f; o[1][r] = 0.f; }
        if (pass > 0) { DMA_KV(REV ? NT - 1 : 0, 0); DMA_KV(REV ? NT - 2 : 1, SLOTB); }
        int cur = 0, sl1 = SLOTB, sl2 = 2 * SLOTB;
        auto step = [&](auto band_c, const int it) -> bool {
            constexpr bool BAND = decltype(band_c)::value;
            const int t = REV ? NT - 1 - it : it;
            if (pm == 7) { }
            else if (it + 1 < NT) asm volatile("s_waitcnt vmcnt(2) lgkmcnt(0)\n\ts_barrier" ::: "memory");
            else ATT_WAIT_BAR();
            if (REV && it > 0) {
                const LAS unsigned* wz = (const LAS unsigned*)(sh + L_END) + ((it - 1) & 1) * 8;
                const u32x4 z0 = *(const LAS u32x4*)wz, z1 = *(const LAS u32x4*)(wz + 4);
                if (__builtin_amdgcn_readfirstlane((int)(z0.x & z0.y & z0.z & z0.w & z1.x & z1.y & z1.z & z1.w)) != 0) return true;
            }
            if (it + 2 < NT && pm != 7) DMA_KV(REV ? t - 2 : t + 2, sl2);
            const int jb = t - (NT - 4);
            float cinv = 0.f;
            if (VAR == 0) cinv = cumt;
            if (VAR == 2 || VAR == 3) cinv = slope2 * (float)(t * 64 + 4 * hi - tq);
            f32x16 cin;
#pragma unroll
            for (int r = 0; r < 16; ++r) cin[r] = cinv;
            f32x16 p0, p1;
            const LAS char* Ks = sh + L_K + cur;
            if (VAR == 2) { if (pass == 0) { const bf16x8 qq[4] = {qa[0], qa[1], qa[0], qa[1]}; qkt<0, 2>(p0, p1, Ks, qq, cin, r32, hi); }
                            else { const bf16x8 qq[4] = {qa[0], qa[1], qa[0], qa[1]}; qkt<2, 4>(p0, p1, Ks, qq, cin, r32, hi); } }
            else qkt<0, 4>(p0, p1, Ks, qa, cin, r32, hi);
            if (VAR != 1) {
                if (VAR == 0) { const LAS float* cp = cumL + t * 64 + 4 * hi;
#pragma unroll
                    for (int g = 0; g < 4; ++g) { const f32x4 c0 = *(const LAS f32x4*)(cp + 8 * g), c1 = *(const LAS f32x4*)(cp + 32 + 8 * g);
#pragma unroll
                        for (int i = 0; i < 4; ++i) { p0[4 * g + i] -= c0[i]; p1[4 * g + i] -= c1[i]; } } }
                if (VAR == 2 || VAR == 3) {
#pragma unroll
                    for (int r = 0; r < 16; ++r) { const float kc = (float)((r & 3) + 8 * (r >> 2)); p0[r] += slope2 * kc; p1[r] += slope2 * (kc + 32.f); } }
                if (VAR != 3) { if constexpr (BAND) { const int kb = 64 * jb + 4 * hi;
#pragma unroll
                    for (int r = 0; r < 16; ++r) { const int kv = kb + (r & 3) + 8 * (r >> 2); if (kv > qrel) p0[r] = -INFINITY; if (kv + 32 > qrel) p1[r] = -INFINITY; } } }
                else { const u32x2 mw = *(const LAS u32x2*)(maskL + qrel * MROW + 2 * t); const unsigned w0 = mw.x >> (4 * hi), w1 = mw.y >> (4 * hi);
#pragma unroll
                    for (int r = 0; r < 16; ++r) { const int c = (r & 3) + 8 * (r >> 2); if (!((w0 >> c) & 1u)) p0[r] = -INFINITY; if (!((w1 >> c) & 1u)) p1[r] = -INFINITY; } }
                const float rm = rowmax(p0, p1, hi);
                if (__any(rm - mhat > THR)) {
                    const float mn = fmaxf(mhat, rm); const float f = __builtin_amdgcn_exp2f(mhat - mn); mhat = mn; l_reg *= f;
                    if (hi == 0) wsf[r32] = f;
#pragma unroll
                    for (int r = 0; r < 16; ++r) { const float fr = wsf[crow(r, hi)]; o[0][r] *= fr; o[1][r] *= fr; }
                }
                float sa4[4] = {0.f, 0.f, 0.f, 0.f};
#pragma unroll
                for (int r = 0; r < 16; ++r) { p0[r] = __builtin_amdgcn_exp2f(p0[r] - mhat); p1[r] = __builtin_amdgcn_exp2f(p1[r] - mhat); sa4[r & 3] += p0[r] + p1[r]; }
                l_reg += (sa4[0] + sa4[1]) + (sa4[2] + sa4[3]);
                if (VAR == 2 || VAR == 3) {
                    const float ub = sbound - slope2 * (float)(tq - 64 * t + 1) - mhat;
                    const bool dead = __all(ub < -150.f); if (lane == 0) ((LAS unsigned*)(sh + L_END))[(it & 1) * 8 + wid] = dead ? 1u : 0u;
                }
            } else {
                f32x16 m0, m1;
#pragma unroll
                for (int r = 0; r < 16; ++r) {
                    { const float s = __builtin_amdgcn_fmed3f(p0[r], -64.f, 64.f); const float e = __builtin_amdgcn_exp2f(-s); const float bt = __builtin_amdgcn_rcpf(1.f + e); p0[r] = bt; m0[r] = e * bt; }
                    { const float s = __builtin_amdgcn_fmed3f(p1[r], -64.f, 64.f); const float e = __builtin_amdgcn_exp2f(-s); const float bt = __builtin_amdgcn_rcpf(1.f + e); p1[r] = bt; m1[r] = e * bt; } }
                if constexpr (BAND) { const int kb = 64 * jb + 4 * hi;
#pragma unroll
                    for (int r = 0; r < 16; ++r) { const int kv = kb + (r & 3) + 8 * (r >> 2);
                        if (kv >= qrel) { p0[r] = 0.f; m0[r] = 1.f; } if (kv + 32 >= qrel) { p1[r] = 0.f; m1[r] = 1.f; } } }
                float gp[8], gq[8], ex[8];
#pragma unroll
                for (int g = 0; g < 4; ++g) { gp[g] = (m0[4 * g] * m0[4 * g + 1]) * (m0[4 * g + 2] * m0[4 * g + 3]); gp[4 + g] = (m1[4 * g] * m1[4 * g + 1]) * (m1[4 * g + 2] * m1[4 * g + 3]); }
#pragma unroll
                for (int g = 0; g < 8; ++g) gq[g] = xhalf(gp[g], hi);
                float sp = Rp;
#pragma unroll
                for (int g = 7; g >= 0; --g) { ex[g] = hi ? sp : sp * gq[g]; sp *= gp[g] * gq[g]; }
                Rp = sp;
                { const bool allz = !__any(Rp != 0.f); if (lane == 0) ((LAS unsigned*)(sh + L_END))[(it & 1) * 8 + wid] = allz ? 1u : 0u; }
#pragma unroll
                for (int g = 0; g < 4; ++g) {
                    { float c = ex[g]; const float w3 = p0[4 * g + 3] * c; c *= m0[4 * g + 3]; const float w2 = p0[4 * g + 2] * c; c *= m0[4 * g + 2]; const float w1 = p0[4 * g + 1] * c; c *= m0[4 * g + 1]; const float w0 = p0[4 * g] * c;
                      p0[4 * g] = w0; p0[4 * g + 1] = w1; p0[4 * g + 2] = w2; p0[4 * g + 3] = w3; }
                    { float c = ex[4 + g]; const float w3 = p1[4 * g + 3] * c; c *= m1[4 * g + 3]; const float w2 = p1[4 * g + 2] * c; c *= m1[4 * g + 2]; const float w1 = p1[4 * g + 1] * c; c *= m1[4 * g + 1]; const float w0 = p1[4 * g] * c;
                      p1[4 * g] = w0; p1[4 * g + 1] = w1; p1[4 * g + 2] = w2; p1[4 * g + 3] = w3; } }
            }
            u32x4 pw0, pw1, pw2, pw3;
            pw0 = (u32x4){cvtpk_s(p0[0], p0[1]), cvtpk_s(p0[2], p0[3]), cvtpk_s(p0[4], p0[5]), cvtpk_s(p0[6], p0[7])};
            pw1 = (u32x4){cvtpk_s(p0[8], p0[9]), cvtpk_s(p0[10], p0[11]), cvtpk_s(p0[12], p0[13]), cvtpk_s(p0[14], p0[15])};
            pw2 = (u32x4){cvtpk_s(p1[0], p1[1]), cvtpk_s(p1[2], p1[3]), cvtpk_s(p1[4], p1[5]), cvtpk_s(p1[6], p1[7])};
            pw3 = (u32x4){cvtpk_s(p1[8], p1[9]), cvtpk_s(p1[10], p1[11]), cvtpk_s(p1[12], p1[13]), cvtpk_s(p1[14], p1[15])};
            pv(o, vb0 + cur, __builtin_bit_cast(bf16x8, pw0), __builtin_bit_cast(bf16x8, pw1), __builtin_bit_cast(bf16x8, pw2), __builtin_bit_cast(bf16x8, pw3));
            { const int tmp = cur; cur = sl1; sl1 = sl2; sl2 = tmp; }
            return false;
        };
        if (REV) { bool ex = false; int it = 0;
            for (; it < 4 && !ex; ++it) ex = step(BoolC<true>{}, it);
            for (; it < NT && !ex; ++it) ex = step(BoolC<false>{}, it); }
        else { int it = 0;
            for (; it < NT - 4; ++it) (void)step(BoolC<false>{}, it);
            for (; it < NT; ++it) (void)step(BoolC<true>{}, it); }
        ATT_WAIT_BAR();
        if (pass == NPASS - 1 && tid == 0) nxt_u = __hip_atomic_fetch_add(qctr, 1u, RLX_AGENT);
        float rli[16];
        if (VAR != 1) {
            l_reg += xhalf(l_reg, hi);
            if (hi == 0) wsf[32 + r32] = l_reg;
#pragma unroll
            for (int r = 0; r < 16; ++r) rli[r] = __builtin_amdgcn_rcpf(wsf[32 + crow(r, hi)]);
        } else {
#pragma unroll
            for (int r = 0; r < 16; ++r) rli[r] = 1.f;
        }
#pragma unroll
        for (int r = 0; r < 16; ++r) { const int orow = crow(r, hi);
#pragma unroll
            for (int d0 = 0; d0 < 2; ++d0) { const float val = o[d0][r] * rli[r]; LAS float* sp = stg + orow * 64 + d0 * 32 + r32;
                if (VAR == 2 && pass == 1) *sp = *sp - P.lam * val; else *sp = val; } }
    }
    LDS_WAIT();
    bf16* Ow = P.mix + (size_t)(rowbase + q0 + wid * 32) * DM + VAR * 256 + h * 64;
#pragma unroll
    for (int i = 0; i < 4; ++i) { const int row = i * 8 + (lane >> 3), ch = lane & 7;
        const f32x4 a = *(const LAS f32x4*)(stg + row * 64 + ch * 8), c = *(const LAS f32x4*)(stg + row * 64 + ch * 8 + 4);
        float sc = 1.f;
        if (VAR == 2) { float ss = (a[0] * a[0] + a[1] * a[1]) + (a[2] * a[2] + a[3] * a[3]) + (c[0] * c[0] + c[1] * c[1]) + (c[2] * c[2] + c[3] * c[3]);
            ss += shx<1>(ss); ss += shx<2>(ss); ss += shx<4>(ss); sc = 1.0f / sqrtf(ss * (1.f / 64.f) + RMS_EPS); }
        u32x4 w; w.x = cvtpk_s(a[0] * sc, a[1] * sc); w.y = cvtpk_s(a[2] * sc, a[3] * sc); w.z = cvtpk_s(c[0] * sc, c[1] * sc); w.w = cvtpk_s(c[2] * sc, c[3] * sc);
        if (pm == 0 || (w.x == 0x12345678u && w.y == 0x9abcdef0u)) *(u32x4*)(Ow + (size_t)row * DM + ch * 8) = w; }
    if (tid == 0) *qslot = nxt_u;
    asm volatile("s_waitcnt lgkmcnt(0)\n\ts_barrier" ::: "memory");
#undef DMA_KV
}
typedef __attribute__((address_space(3))) const char* lds_cptr;
typedef short v4i16_t __attribute__((ext_vector_type(4)));
__device__ __forceinline__ s16x4 vtr(lds_cptr p) { return __builtin_bit_cast(s16x4, __builtin_amdgcn_ds_read_tr16_b64_v4i16((__attribute__((address_space(3))) v4i16_t*)p)); }
template <int VAR>
__device__ __forceinline__ void attn_unit2(const AttnP& P, int b, int h, int qb, LAS char* sh, const int tid_in, unsigned* qctr, volatile LAS unsigned* qslot) {
    static_assert(VAR == 0 || VAR == 2 || VAR == 3, "softmax mixers only");
    int tid = tid_in; asm volatile("" : "+v"(tid));
    const int lane = tid & 63, r32 = lane & 31, hi = lane >> 5; const int wid = __builtin_amdgcn_readfirstlane(tid >> 6);
    const long rowbase = (long)b * SEQ; const int q0 = qb * 256, NT = 4 * (qb + 1);
    const int qrel = wid * 32 + r32, tq = q0 + qrel;
    constexpr int QCB = VAR == 0 ? C_AQ : VAR == 1 ? C_BQ : VAR == 2 ? C_CQ : C_DQ;
    constexpr int KCB = VAR == 0 ? C_AK : VAR == 1 ? C_BK : VAR == 2 ? C_CK : C_DK;
    constexpr int VCB = VAR == 0 ? C_AV : VAR == 1 ? C_BV : VAR == 2 ? C_CV : C_DV;
    const int Qc = QCB + 64 * h, Kc = VAR == 3 ? KCB : KCB + 64 * h, Vc = VAR == 3 ? VCB : VCB + 64 * h;
    const bf16* PR = P.proj;
    LAS float* wsf = (LAS float*)(sh + L_WS) + wid * 64;
    LAS float* stg = (LAS float*)(sh + L_OST) + wid * 2048;
    LAS float* cumL = (LAS float*)(sh + L_CUM);
    LAS unsigned* maskL = (LAS unsigned*)(sh + L_OST);
    const unsigned lds0 = (unsigned)(uintptr_t)sh;
    const bf16* ksrc = PR + (size_t)(rowbase + lane) * NP + Kc + wid * 8;
    const bf16* vsrc = PR + (size_t)(rowbase + 16 * (wid & 3) + (lane >> 2)) * NP + Vc + (wid >> 2) * 32 + (lane & 3) * 8;
    const unsigned kdst = lds0 + L_K + wid * 1024, vdst = lds0 + L_V + wid * 1024;
#define TILE2(j) (NT - 1 - (j))
#define DMA_K2(j, slot) glds16(ksrc + (size_t)TILE2(j) * 64 * NP, (unsigned)__builtin_amdgcn_readfirstlane(kdst + (slot)))
#define DMA_V2(j, slot) glds16(vsrc + (size_t)TILE2(j) * 64 * NP, (unsigned)__builtin_amdgcn_readfirstlane(vdst + (slot)))
    DMA_K2(0, 0); DMA_K2(1, SLOTB); DMA_V2(0, 0);
    if (VAR == 0) {
        LAS float* pref = (LAS float*)(sh + L_WS);
        if (tid < 64) { const float ct = P.cum[32 * SEQ + (b * 4 + h) * 64 + tid]; float incl = ct;
#pragma unroll
            for (int o = 1; o < 64; o <<= 1) { const float u = shup(incl, o, tid); if (tid >= o) incl += u; }
            pref[tid] = incl - ct; }
        asm volatile("s_waitcnt lgkmcnt(0)\n\ts_barrier" ::: "memory");
        const float* cg = P.cum + (size_t)(b * 4 + h) * SEQ; for (int i = tid; i < q0 + 256; i += 512) cumL[i] = (cg[i] + pref[i >> 5]) * LOG2E;
        asm volatile("s_waitcnt lgkmcnt(0)\n\ts_barrier" ::: "memory");
    }
    if (VAR == 3) { const unsigned* mg = P.mask + (size_t)(rowbase + q0) * 64; const int nw = 2 * NT;
        for (int i = tid; i < 256 * 64; i += 512) { const int row = i >> 6, w = i & 63; if (w < nw) maskL[row * MROW + w] = mg[i]; } }
    asm volatile("s_waitcnt vmcnt(0) lgkmcnt(0)\n\ts_barrier" ::: "memory");
    const lds_cptr shc = (lds_cptr)sh;
    const lds_cptr kp0 = shc + L_K + hi * 1024 + r32 * 16;
    const lds_cptr vp0 = shc + L_V + ((lane >> 4) & 1) * 32 + (lane & 3) * 8 + (4 * hi + ((lane & 15) >> 2)) * 64;
    float slope2 = 0.f;
    if (VAR == 2) slope2 = __builtin_amdgcn_exp2f(-(float)(2 * h + 1)) * LOG2E;
    if (VAR == 3) slope2 = __builtin_amdgcn_exp2f(-(float)(2 * h + 2)) * LOG2E;
    float cumt = 0.f; if (VAR == 0) cumt = cumL[tq];
    constexpr int NPASS = VAR == 2 ? 2 : 1;
    unsigned nxt_u = 0u;
    const auto slot3 = [](int j) { return (j % 3) * SLOTB; };
#define SB2() __builtin_amdgcn_sched_barrier(0)
#define PINV(x) asm volatile("" : "+v"(x))
#define MF32(a, b, c) __builtin_amdgcn_mfma_f32_32x32x16_bf16(a, b, c, 0, 0, 0)
#define ATT_BARN(N) do { asm volatile("s_waitcnt vmcnt(" #N ") lgkmcnt(0)\n\ts_barrier" ::: "memory"); SB2(); } while (0)
#define PKW(Pv, i) cvtpk_s(Pv[i], Pv[(i) + 1])
#define PAF(k) __builtin_bit_cast(bf16x8, pw##k)
#define VFR(i) (bf16x8){vlo[i][0], vlo[i][1], vlo[i][2], vlo[i][3], vhi[i][0], vhi[i][1], vhi[i][2], vhi[i][3]}
#define VRD(i) do { vlo[i] = vtr(vp_ + (((i) >> 2) * 4096 + ((i) & 3) * 1024)); vhi[i] = vtr(vp_ + (((i) >> 2) * 4096 + ((i) & 3) * 1024 + 512)); } while (0)
#define EX2(v) __builtin_amdgcn_exp2f(v)
#define GAPA(MF, Pv, i, PW, w) do { MF; sacc += Pv[i]; sacc += Pv[(i) + 1]; sacc += Pv[(i) + 2]; sacc += Pv[(i) + 3]; PINV(sacc); PW[w] = PKW(Pv, i); PW[(w) + 1] = PKW(Pv, (i) + 2); PINV(PW); SB2(); } while (0)
#define GAPA8(MF, Pv, i, PW) do { MF; sacc += Pv[i]; sacc += Pv[(i) + 1]; sacc += Pv[(i) + 2]; sacc += Pv[(i) + 3]; sacc += Pv[(i) + 4]; sacc += Pv[(i) + 5]; sacc += Pv[(i) + 6]; sacc += Pv[(i) + 7]; PINV(sacc); \
        PW[0] = PKW(Pv, i); PW[1] = PKW(Pv, (i) + 2); PW[2] = PKW(Pv, (i) + 4); PW[3] = PKW(Pv, (i) + 6); PINV(PW); SB2(); } while (0)
#define GAPB(MF, X, i) do { MF; X[i] = EX2(X[i]); X[(i) + 1] = EX2(X[(i) + 1]); X[(i) + 2] = EX2(X[(i) + 2]); X[(i) + 3] = EX2(X[(i) + 3]); PINV(X); SB2(); } while (0)
    for (int pass = 0; pass < NPASS; ++pass) {
        bf16x8 qa[4]; float sb0 = 0.f;
        { const bf16* Qw = PR + (size_t)(rowbase + tq) * NP + Qc;
          constexpr int ND0 = VAR == 2 ? 2 : 4; const int dbase = VAR == 2 ? 2 * pass : 0;
          float qf[8 * ND0];
#pragma unroll
          for (int d0 = 0; d0 < ND0; ++d0) { const bf16x8 raw = *(const bf16x8*)(Qw + (dbase + d0) * 16 + hi * 8);
#pragma unroll
              for (int j = 0; j < 8; ++j) qf[d0 * 8 + j] = bf2f((unsigned short)raw[j]); }
          constexpr float SC = (VAR == 2 ? 0.17677669529663687f : 0.125f) * LOG2E;
          if (VAR != 1) {
              float ss = 0.f;
#pragma unroll
              for (int i = 0; i < 8 * ND0; ++i) ss += qf[i] * qf[i];
              ss += xhalf(ss, hi); const float rstd = 1.0f / sqrtf(ss * (VAR == 2 ? 1.f / 32.f : 1.f / 64.f) + RMS_EPS);
              const float* g = P.qgain[VAR];
#pragma unroll
              for (int d0 = 0; d0 < ND0; ++d0)
#pragma unroll
                  for (int j = 0; j < 8; ++j) qf[d0 * 8 + j] *= rstd * g[16 * d0 + 8 * hi + j] * SC;
          } else {
#pragma unroll
              for (int i = 0; i < 8 * ND0; ++i) qf[i] *= SC;
          }
          if (VAR == 2 || VAR == 3) {
              float n0 = 0.f;
#pragma unroll
              for (int i = 0; i < 8 * ND0; ++i) n0 += qf[i] * qf[i];
              n0 += xhalf(n0, hi);
              float gk = fabsf(P.kgain[VAR][lane & (VAR == 2 ? 31 : 63)]);
              gk = fmaxf(gk, shx<1>(gk)); gk = fmaxf(gk, shx<2>(gk)); gk = fmaxf(gk, shx<4>(gk)); gk = fmaxf(gk, shx<8>(gk)); gk = fmaxf(gk, shx<16>(gk)); gk = half_max(gk);
              sb0 = 1.02f * sqrtf(n0) * (VAR == 2 ? 5.656854249f : 8.0f) * gk;
          }
#pragma unroll
          for (int d0 = 0; d0 < ND0; ++d0) { u32x4 w; w.x = cvtpk_s(qf[d0 * 8 + 0], qf[d0 * 8 + 1]); w.y = cvtpk_s(qf[d0 * 8 + 2], qf[d0 * 8 + 3]); w.z = cvtpk_s(qf[d0 * 8 + 4], qf[d0 * 8 + 5]); w.w = cvtpk_s(qf[d0 * 8 + 6], qf[d0 * 8 + 7]);
              qa[d0] = __builtin_bit_cast(bf16x8, w); }
          if (VAR == 2) { qa[2] = qa[0]; qa[3] = qa[1]; }
        }
        const float sbound = sb0;
        if (pass > 0) { DMA_K2(0, 0); DMA_K2(1, SLOTB); DMA_V2(0, 0); }
        float mhat = 0.f, l_reg = 0.f; bool hasref = false, resc = false; f32x16 o[2], negm;
#pragma unroll
        for (int r = 0; r < 16; ++r) { o[0][r] = 0.f; o[1][r] = 0.f; }
        f32x16 pA0, pA1, pB0, pB1; u32x4 pw0, pw1, pw2, pw3;
#pragma unroll
        for (int r = 0; r < 16; ++r) { pB0[r] = 0.f; pB1[r] = 0.f; }
        const auto setneg = [&](int t) __attribute__((always_inline)) { float v = -mhat; if (VAR == 0) v += cumt; else v += slope2 * (float)(t * 64 + 4 * hi - tq);
#pragma unroll
            for (int r = 0; r < 16; ++r) negm[r] = v;
            PINV(negm); };
        const auto mid = [&](f32x16& C0, f32x16& C1, const int it) __attribute__((always_inline)) {
            const int t = NT - 1 - it;
            if (VAR == 0) { const LAS float* cp = cumL + t * 64 + 4 * hi;
#pragma unroll
                for (int g = 0; g < 4; ++g) { const f32x4 c0 = *(const LAS f32x4*)(cp + 8 * g), c1 = *(const LAS f32x4*)(cp + 32 + 8 * g);
#pragma unroll
                    for (int i = 0; i < 4; ++i) { C0[4 * g + i] -= c0[i]; C1[4 * g + i] -= c1[i]; } } }
            else {
#pragma unroll
                for (int r = 0; r < 16; ++r) { const float kc = (float)((r & 3) + 8 * (r >> 2)); C0[r] += slope2 * kc; C1[r] += slope2 * (kc + 32.f); } }
            if (VAR != 3) { if (it < 4) { asm volatile("" ::: "memory");
                const int kb = 64 * (3 - it) + 4 * hi;
#pragma unroll
                for (int r = 0; r < 16; ++r) { const int kv = kb + (r & 3) + 8 * (r >> 2); if (kv > qrel) C0[r] = -INFINITY; if (kv + 32 > qrel) C1[r] = -INFINITY; } } }
            else { const u32x2 mw = *(const LAS u32x2*)(maskL + qrel * MROW + 2 * t); const unsigned w0 = mw.x >> (4 * hi), w1 = mw.y >> (4 * hi);
#pragma unroll
                for (int r = 0; r < 16; ++r) { const int c = (r & 3) + 8 * (r >> 2); if (!((w0 >> c) & 1u)) C0[r] = -INFINITY; if (!((w1 >> c) & 1u)) C1[r] = -INFINITY; } }
            const float rm = rowmax(C0, C1, hi);
            const bool need = hasref ? (rm > THR) : (rm > -INFINITY);
            resc = false;
            if (__any(need)) {
                const bool fin = rm > -INFINITY;
                const float dl = hasref ? fmaxf(rm, 0.f) : (fin ? rm : 0.f);
                const float f = hasref ? EX2(-dl) : 1.f;
                mhat += dl; l_reg *= f;
#pragma unroll
                for (int r = 0; r < 16; ++r) { C0[r] -= dl; C1[r] -= dl; }
                if (hi == 0) wsf[r32] = f;
                resc = true; hasref = hasref || fin;
            }
            if (VAR != 0) {
                const bool dead = hasref && (sbound - slope2 * (float)(tq - 64 * t + 1) - mhat < -150.f);
                const bool alld = __all(dead); if (lane == 0) ((LAS unsigned*)(sh + L_END))[(it & 1) * 8 + wid] = alld ? 1u : 0u;
            }
        };
#define KLD(dst0, dst1, d0) do { dst0 = *(const LAS bf16x8*)(kp_ + (d0) * 2048); dst1 = *(const LAS bf16x8*)(kp_ + (d0) * 2048 + 512); } while (0)
#define VLD(lo, hi_, i) do { lo = vtr(vp_ + (((i) >> 2) * 4096 + ((i) & 3) * 1024)); hi_ = vtr(vp_ + (((i) >> 2) * 4096 + ((i) & 3) * 1024 + 512)); } while (0)
#define VF(lo, hi_) (bf16x8){lo[0], lo[1], lo[2], lo[3], hi_[0], hi_[1], hi_[2], hi_[3]}
        const auto step = [&](f32x16& C0, f32x16& C1, f32x16& P0, f32x16& P1, const int it) __attribute__((always_inline)) -> bool {
            if (it + 1 < NT) ATT_BARN(2); else ATT_BARN(1);
            if (VAR != 0 && it >= 1) { const LAS unsigned* wz = (const LAS unsigned*)(sh + L_END) + ((it - 1) & 1) * 8;
                const u32x4 z0 = *(const LAS u32x4*)wz, z1 = *(const LAS u32x4*)(wz + 4);
                if (__builtin_amdgcn_readfirstlane((int)(z0.x & z0.y & z0.z & z0.w & z1.x & z1.y & z1.z & z1.w)) != 0) return true; }
            if (it + 2 < NT) DMA_K2(it + 2, slot3(it + 2));
            if (it + 1 < NT) DMA_V2(it + 1, slot3(it + 1));
            setneg(NT - 1 - it);
            int ko_ = slot3(it), vo_ = slot3(it + 2);
            asm volatile("" : "+s"(ko_), "+s"(vo_));
            const lds_cptr kp_ = kp0 + ko_; const lds_cptr vp_ = vp0 + vo_;
            bf16x8 ka0, ka1, kb0, kb1; s16x4 va0, va1, vb0, vb1;
            float sacc = 0.f;
            if (VAR == 2) {
                KLD(ka0, ka1, 2 * pass); KLD(kb0, kb1, 2 * pass + 1); SB2();
                GAPA8(C0 = MF32(ka0, qa[0], negm), P0, 0, pw0);
                GAPA8(C1 = MF32(ka1, qa[0], negm), P0, 8, pw1);
                GAPA8(C0 = MF32(kb0, qa[1], C0), P1, 0, pw2);
                GAPA8(C1 = MF32(kb1, qa[1], C1), P1, 8, pw3);
            } else {
                KLD(ka0, ka1, 0); KLD(kb0, kb1, 1); SB2();
                GAPA(C0 = MF32(ka0, qa[0], negm), P0, 0, pw0, 0);
                GAPA(C1 = MF32(ka1, qa[0], negm), P0, 4, pw0, 2);
                KLD(ka0, ka1, 2); SB2();
                GAPA(C0 = MF32(kb0, qa[1], C0), P0, 8, pw1, 0);
                GAPA(C1 = MF32(kb1, qa[1], C1), P0, 12, pw1, 2);
                KLD(kb0, kb1, 3); SB2();
                GAPA(C0 = MF32(ka0, qa[2], C0), P1, 0, pw2, 0);
                GAPA(C1 = MF32(ka1, qa[2], C1), P1, 4, pw2, 2);
                GAPA(C0 = MF32(kb0, qa[3], C0), P1, 8, pw3, 0);
                GAPA(C1 = MF32(kb1, qa[3], C1), P1, 12, pw3, 2);
            }
            l_reg += sacc;
            mid(C0, C1, it);
            SB2();
            if (it > 0) {
                VLD(va0, va1, 0); VLD(vb0, vb1, 4); SB2();
                GAPB(o[0] = MF32(PAF(0), VF(va0, va1), o[0]), C0, 0);  VLD(va0, va1, 1); SB2();
                GAPB(o[1] = MF32(PAF(0), VF(vb0, vb1), o[1]), C0, 4);  VLD(vb0, vb1, 5); SB2();
                GAPB(o[0] = MF32(PAF(1), VF(va0, va1), o[0]), C0, 8);  VLD(va0, va1, 2); SB2();
                GAPB(o[1] = MF32(PAF(1), VF(vb0, vb1), o[1]), C0, 12); VLD(vb0, vb1, 6); SB2();
                GAPB(o[0] = MF32(PAF(2), VF(va0, va1), o[0]), C1, 0);  VLD(va0, va1, 3); SB2();
                GAPB(o[1] = MF32(PAF(2), VF(vb0, vb1), o[1]), C1, 4);  VLD(vb0, vb1, 7); SB2();
                GAPB(o[0] = MF32(PAF(3), VF(va0, va1), o[0]), C1, 8);
                GAPB(o[1] = MF32(PAF(3), VF(vb0, vb1), o[1]), C1, 12);
                if (resc) {
#pragma unroll
                    for (int r = 0; r < 16; ++r) { const float fr = wsf[crow(r, hi)]; o[0][r] *= fr; o[1][r] *= fr; } }
            } else {
#pragma unroll
                for (int r = 0; r < 16; ++r) { C0[r] = EX2(C0[r]); C1[r] = EX2(C1[r]); }
            }
            return false;
        };
        bool ex = false, pendA = true; int it = 0;
        for (; it < NT; it += 2) {
            ex = step(pA0, pA1, pB0, pB1, it); if (ex) { pendA = false; break; }
            ex = step(pB0, pB1, pA0, pA1, it + 1); if (ex) { pendA = true; ++it; break; }
        }
        if (!ex) pendA = false;
        if (!ex) ATT_BARN(0);
        { int vo_ = slot3(it + 2); asm volatile("" : "+s"(vo_)); const lds_cptr vp_ = vp0 + vo_; s16x4 vlo[8], vhi[8];
#pragma unroll
          for (int i = 0; i < 8; ++i) VRD(i);
          float sacc = 0.f;
          if (pendA) {
#pragma unroll
              for (int r = 0; r < 16; ++r) sacc += pA0[r] + pA1[r];
              pw0 = (u32x4){PKW(pA0, 0), PKW(pA0, 2), PKW(pA0, 4), PKW(pA0, 6)}; pw1 = (u32x4){PKW(pA0, 8), PKW(pA0, 10), PKW(pA0, 12), PKW(pA0, 14)};
              pw2 = (u32x4){PKW(pA1, 0), PKW(pA1, 2), PKW(pA1, 4), PKW(pA1, 6)}; pw3 = (u32x4){PKW(pA1, 8), PKW(pA1, 10), PKW(pA1, 12), PKW(pA1, 14)};
          } else {
#pragma unroll
              for (int r = 0; r < 16; ++r) sacc += pB0[r] + pB1[r];
              pw0 = (u32x4){PKW(pB0, 0), PKW(pB0, 2), PKW(pB0, 4), PKW(pB0, 6)}; pw1 = (u32x4){PKW(pB0, 8), PKW(pB0, 10), PKW(pB0, 12), PKW(pB0, 14)};
              pw2 = (u32x4){PKW(pB1, 0), PKW(pB1, 2), PKW(pB1, 4), PKW(pB1, 6)}; pw3 = (u32x4){PKW(pB1, 8), PKW(pB1, 10), PKW(pB1, 12), PKW(pB1, 14)};
          }
          l_reg += sacc;
          o[0] = MF32(PAF(0), VFR(0), o[0]); o[1] = MF32(PAF(0), VFR(4), o[1]); o[0] = MF32(PAF(1), VFR(1), o[0]); o[1] = MF32(PAF(1), VFR(5), o[1]);
          o[0] = MF32(PAF(2), VFR(2), o[0]); o[1] = MF32(PAF(2), VFR(6), o[1]); o[0] = MF32(PAF(3), VFR(3), o[0]); o[1] = MF32(PAF(3), VFR(7), o[1]); }
        ATT_WAIT_BAR();
        if (pass == NPASS - 1 && tid == 0) nxt_u = __hip_atomic_fetch_add(qctr, 1u, RLX_AGENT);
        int lane_e = lane; asm volatile("" : "+v"(lane_e)); const int r32e = lane_e & 31, hie = lane_e >> 5;
        LAS float* wsfe = (LAS float*)(sh + L_WS) + wid * 64; LAS float* stge = (LAS float*)(sh + L_OST) + wid * 2048;
        float rli[16];
        l_reg += xhalf(l_reg, hie);
        if (hie == 0) wsfe[32 + r32e] = l_reg;
#pragma unroll
        for (int r = 0; r < 16; ++r) rli[r] = __builtin_amdgcn_rcpf(wsfe[32 + crow(r, hie)]);
#pragma unroll
        for (int r = 0; r < 16; ++r) { const int orow = crow(r, hie);
#pragma unroll
            for (int d0 = 0; d0 < 2; ++d0) { const float val = o[d0][r] * rli[r]; LAS float* sp = stge + orow * 64 + d0 * 32 + r32e;
                if (VAR == 2 && pass == 1) *sp = *sp - P.lam * val; else *sp = val; } }
    }
    LDS_WAIT();
    int lane_o = tid & 63; asm volatile("" : "+v"(lane_o));
    bf16* Ow = P.mix + (size_t)(rowbase + q0 + wid * 32) * DM + VAR * 256 + h * 64;
    { const int lane = lane_o; LAS float* stg = (LAS float*)(sh + L_OST) + wid * 2048;
#pragma unroll
    for (int i = 0; i < 4; ++i) { const int row = i * 8 + (lane >> 3), ch = lane & 7;
        const f32x4 a = *(const LAS f32x4*)(stg + row * 64 + ch * 8), c = *(const LAS f32x4*)(stg + row * 64 + ch * 8 + 4);
        float sc = 1.f;
        if (VAR == 2) { float ss = (a[0] * a[0] + a[1] * a[1]) + (a[2] * a[2] + a[3] * a[3]) + (c[0] * c[0] + c[1] * c[1]) + (c[2] * c[2] + c[3] * c[3]);
            ss += shx<1>(ss); ss += shx<2>(ss); ss += shx<4>(ss); sc = 1.0f / sqrtf(ss * (1.f / 64.f) + RMS_EPS); }
        u32x4 w; w.x = cvtpk_s(a[0] * sc, a[1] * sc); w.y = cvtpk_s(a[2] * sc, a[3] * sc); w.z = cvtpk_s(c[0] * sc, c[1] * sc); w.w = cvtpk_s(c[2] * sc, c[3] * sc);
        *(u32x4*)(Ow + (size_t)row * DM + ch * 8) = w; } }
    if (tid == 0) *qslot = nxt_u;
    asm volatile("s_waitcnt lgkmcnt(0)\n\ts_barrier" ::: "memory");
#undef DMA_K2
#undef DMA_V2
#undef TILE2
}
#undef SB2
#undef PINV
#undef MF32
#undef ATT_BARN
#undef PKW
#undef PAF
#undef VFR
#undef VRD
#undef EX2
#undef GAPA
#undef GAPA8
#undef GAPB
#undef KLD
#undef VLD
#undef VF
}

__device__ __forceinline__ void p4_attention(Frame& F, const Args& A, int l, int qsel) {
    att::AttnP P; P.proj = (const bf16*)(F.ws + WS_PROJ); P.mix = (bf16*)(F.ws + WS_MIX); P.cum = (const float*)(F.ws + WS_CUM); P.mask = (const unsigned*)(F.ws + WS_MASK);
    P.qgain[0] = inp<I_QNA>() + l * 64; P.qgain[1] = nullptr; P.qgain[2] = inp<I_QNC>() + l * 32; P.qgain[3] = inp<I_QND>() + l * 64; P.kgain[0] = nullptr; P.kgain[1] = nullptr; P.kgain[2] = inp<I_KNC>() + l * 32; P.kgain[3] = inp<I_KND>() + l * 64; P.lam = ((const float*)(F.ws + WS_MISC))[l];
    LAS char* sh = (LAS char*)F.lds;
    LAS float* rsl2 = (LAS float*)(F.lds + 126976);
    bool cv = BG_CONVERT && (qsel == 0);
    if (cv) { fill_rowscale(F, A, 0, rsl2); fill_rowscale(F, A, 1, rsl2 + DM); }
    if (F.tid == 0) F.MISC[0] = __hip_atomic_fetch_add(F.ctl + CW_AQ + 64 * qsel, 1u, RLX_AGENT);
    __syncthreads();
    for (;;) {
        const int u = (int)F.MISC[0];
        if (u >= 1024) break;
        const int qb = 7 - (u >> 7), r = u & 127, var = r >> 5, bh = r & 31, b = bh >> 2, h = bh & 3;
        const int tv = var == 0 ? 2 : var == 1 ? 1 : var == 2 ? 3 : 0;
        if (qsel >= 2 && PROBE_ATT_VAR >= 0 && tv != PROBE_ATT_VAR) { __syncthreads(); if (F.tid == 0) F.MISC[0] = __hip_atomic_fetch_add(F.ctl + CW_AQ + 64 * qsel, 1u, RLX_AGENT); __syncthreads(); continue; }
#ifdef ONLY_VAR2
        att::attn_unit2<ONLY_VAR2>(P, b, h, qb, sh, F.tid, F.ctl + CW_AQ + 64 * qsel, F.MISC);
#else
        if (tv == 2) att::attn_unit<2>(P, b, h, qb, sh, F.tid, qsel >= 2 ? PROBE_ATT_MODE : 0, F.ctl + CW_AQ + 64 * qsel, F.MISC);
        else if (tv == 1) att::attn_unit<1>(P, b, h, qb, sh, F.tid, qsel >= 2 ? PROBE_ATT_MODE : 0, F.ctl + CW_AQ + 64 * qsel, F.MISC);
        else if (tv == 3) att::attn_unit<3>(P, b, h, qb, sh, F.tid, qsel >= 2 ? PROBE_ATT_MODE : 0, F.ctl + CW_AQ + 64 * qsel, F.MISC);
        else att::attn_unit2<0>(P, b, h, qb, sh, F.tid, F.ctl + CW_AQ + 64 * qsel, F.MISC);
#endif
        if (cv) {
            if (F.tid == 0) F.MISC[3] = __hip_atomic_fetch_add(F.ctl + CW_CVQ, (unsigned)CV_CHUNK, RLX_AGENT);
            __syncthreads();
            const int gb = (int)F.MISC[3];
            if (gb >= CV_TOTAL) cv = false; else convert_chunk(F, A, gb, rsl2);
            __syncthreads();
        }
    }
    while (cv) {
        __syncthreads();
        if (F.tid == 0) F.MISC[3] = __hip_atomic_fetch_add(F.ctl + CW_CVQ, (unsigned)CV_CHUNK, RLX_AGENT);
        __syncthreads();
        const int gb = (int)F.MISC[3];
        if (gb >= CV_TOTAL) cv = false; else convert_chunk(F, A, gb, rsl2);
    }
    __syncthreads();
}

template <int N, int Dd> __device__ __forceinline__ void bfly(float (&p)[32], int lane) { const bool up = (lane & Dd) != 0;
#pragma unroll
    for (int j = 0; j < N / 2; ++j) { const float a = p[2 * j], bb = p[2 * j + 1]; const float send = up ? a : bb, keep = up ? bb : a; p[j] = keep + __shfl_xor(send, Dd); } }
__device__ __forceinline__ void p6_router(Frame& F, const Args& A, int l, int rep) {
    const float* MOD = (const float*)(F.ws + WS_MOD); const float* X1 = (const float*)(F.ws + WS_X1); bf16* H = (bf16*)(F.ws + WS_H);
    const bf16* WRH = (const bf16*)(F.ws + WS_WR) + (size_t)l * 48 * DM; const bf16* WRL = WRH + 2 * 48 * DM;
    int* tok_e = (int*)(F.ws + WS_TOK); float* tok_w = (float*)(F.ws + WS_TOK) + 2 * M; int* tok_pos = (int*)(F.ws + WS_TOK) + 4 * M;
    constexpr int AP = 528;
    LAS unsigned char* Ahi = F.lds; LAS unsigned char* Alo = F.lds + 64 * AP; LAS unsigned char* Bhi = F.lds + 128 * AP; LAS unsigned char* Blo = F.lds + 176 * AP;
    LAS float* PL = (LAS float*)F.lds;
    const int lane = F.lane, w = F.wave; const int mw = (F.vcu * NWAVES + w) * 8; const int b = mw >> 11;
    const float* md = MOD + ((size_t)l * 8 + b) * 6144;
    f32x4 hv[8][4];
#pragma unroll
    for (int r = 0; r < 8; ++r) {
        const float* xr = X1 + (size_t)(mw + r) * DM;
#pragma unroll
        for (int j = 0; j < 4; ++j) hv[r][j] = *(const f32x4*)(xr + 256 * j + 4 * lane);
    }
    { f32x4 gm[4], sc[4], sh[4]; const float* n2 = inp<I_N2G>() + l * DM;
#pragma unroll
      for (int j = 0; j < 4; ++j) { const int col = 256 * j + 4 * lane; gm[j] = *(const f32x4*)(n2 + col); sc[j] = *(const f32x4*)(md + 4 * DM + col); sh[j] = *(const f32x4*)(md + 3 * DM + col); gm[j] = gm[j] * (sc[j] + 1.0f); }
#pragma unroll
      for (int r = 0; r < 8; ++r) { float ss = 0.f;
#pragma unroll
        for (int j = 0; j < 4; ++j) ss += (hv[r][j][0] * hv[r][j][0] + hv[r][j][1] * hv[r][j][1]) + (hv[r][j][2] * hv[r][j][2] + hv[r][j][3] * hv[r][j][3]);
        const float rstd = 1.0f / sqrtf(wave_sum(ss) * (1.f / DM) + RMS_EPS);
#pragma unroll
        for (int j = 0; j < 4; ++j) { hv[r][j] = hv[r][j] * rstd * gm[j] + sh[j]; u32x2 pk; pk.x = pk2(hv[r][j][0], hv[r][j][1]); pk.y = pk2(hv[r][j][2], hv[r][j][3]);
            *(u32x2*)(H + (size_t)(mw + r) * DM + 256 * j + 4 * lane) = pk; } } }
    const int rt = w & 3, kh = w >> 2, arow = lane & 15, kg = lane >> 4;
    f32x4 acc[3];
#pragma unroll
    for (int c = 0; c < 3; ++c) acc[c] = (f32x4){0.f, 0.f, 0.f, 0.f};
#pragma unroll
    for (int j = 0; j < 4; ++j) {
        __syncthreads();
#pragma unroll
        for (int r = 0; r < 8; ++r) { const f32x4 x = hv[r][j]; unsigned h0 = f2bf(x[0]), h1 = f2bf(x[1]), h2 = f2bf(x[2]), h3 = f2bf(x[3]);
            u32x2 hi; hi.x = h0 | (h1 << 16); hi.y = h2 | (h3 << 16);
            u32x2 lo; lo.x = pk2(x[0] - bf2f((unsigned short)h0), x[1] - bf2f((unsigned short)h1)); lo.y = pk2(x[2] - bf2f((unsigned short)h2), x[3] - bf2f((unsigned short)h3));
            *(LAS u32x2*)(Ahi + (w * 8 + r) * AP + lane * 8) = hi; *(LAS u32x2*)(Alo + (w * 8 + r) * AP + lane * 8) = lo; }
        for (int i = F.tid; i < 48 * 32; i += 512) { const int o = i >> 5, c16 = i & 31;
            *(LAS u32x4*)(Bhi + o * AP + c16 * 16) = *(const u32x4*)(WRH + (size_t)o * DM + 256 * j + 8 * c16);
            *(LAS u32x4*)(Blo + o * AP + c16 * 16) = *(const u32x4*)(WRL + (size_t)o * DM + 256 * j + 8 * c16); }
        LDS_WAIT(); __syncthreads();
#pragma unroll
        for (int ks = 0; ks < 4; ++ks) { const int kb = ((4 * kh + ks) * 32 + 8 * kg) * 2;
            const bf16x8 ah = *(const LAS bf16x8*)(Ahi + (16 * rt + arow) * AP + kb), al = *(const LAS bf16x8*)(Alo + (16 * rt + arow) * AP + kb);
#pragma unroll
            for (int c = 0; c < 3; ++c) { const bf16x8 bh = *(const LAS bf16x8*)(Bhi + (16 * c + arow) * AP + kb), bl = *(const LAS bf16x8*)(Blo + (16 * c + arow) * AP + kb);
                acc[c] = __builtin_amdgcn_mfma_f32_16x16x32_bf16(ah, bh, acc[c], 0, 0, 0);
                acc[c] = __builtin_amdgcn_mfma_f32_16x16x32_bf16(al, bh, acc[c], 0, 0, 0);
                acc[c] = __builtin_amdgcn_mfma_f32_16x16x32_bf16(ah, bl, acc[c], 0, 0, 0); } }
    }
    __syncthreads();
#pragma unroll
    for (int c = 0; c < 3; ++c)
#pragma unroll
        for (int r = 0; r < 4; ++r) PL[(kh * 64 + 16 * rt + kg * 4 + r) * 48 + 16 * c + arow] = acc[c][r];
    LDS_WAIT(); __syncthreads();
    if (F.tid < 64 && rep == 0) {
        const int m = F.vcu * 64 + F.tid; const LAS float* q0 = PL + F.tid * 48; const LAS float* q1 = PL + (64 + F.tid) * 48;
        float gl[4]; int gi = 0; float gm;
#pragma unroll
        for (int g = 0; g < 4; ++g) gl[g] = (q0[g] + q1[g]) + inp<I_BG>()[l * 4 + g];
        gm = gl[0];
#pragma unroll
        for (int g = 1; g < 4; ++g) if (gl[g] > gm) { gm = gl[g]; gi = g; }
        float den = 0.f;
#pragma unroll
        for (int g = 0; g < 4; ++g) den += __expf(gl[g] - gm);
        const float gprob = 1.0f / den;
        float v1 = -INFINITY, v2 = -INFINITY; int i1 = 0, i2 = 0;
        for (int e = 0; e < 8; ++e) { const float v = (q0[4 + gi * 8 + e] + q1[4 + gi * 8 + e]) + inp<I_BE>()[l * 32 + gi * 8 + e];
            if (v > v1) { v2 = v1; i2 = i1; v1 = v; i1 = e; } else if (v > v2) { v2 = v; i2 = e; } }
        const float e2 = __expf(v2 - v1); const float w1 = gprob / (1.f + e2), w2 = gprob * e2 / (1.f + e2);
        const int ea = gi * 8 + i1, eb = gi * 8 + i2;
        tok_e[m] = ea; tok_e[M + m] = eb; tok_w[m] = w1; tok_w[M + m] = w2;
        const int pa = (int)__hip_atomic_fetch_add(F.ctl + CW_CNT + (l * 32 + ea) * 16, 1u, RLX_AGENT);
        const int pb = (int)__hip_atomic_fetch_add(F.ctl + CW_CNT + (l * 32 + eb) * 16, 1u, RLX_AGENT);
        tok_pos[m] = pa; tok_pos[M + m] = pb;
        int* elist = (int*)(F.ws + WS_ELIST); elist[ea * M + pa] = m; elist[eb * M + pb] = m;
    }
}

__device__ __forceinline__ void build_rowlists(Frame& F, int l) {
    volatile LAS int* base = (volatile LAS int*)(F.lds + BASE_OFF); volatile LAS int* cnts = (volatile LAS int*)(F.lds + CNTS_OFF); volatile LAS int* tab = (volatile LAS int*)(F.lds + TAB_OFF);
    LAS int* rowl = (LAS int*)(F.lds + ROWL_OFF); const int* elist = (const int*)(F.ws + WS_ELIST);
    const int ntile = (int)F.MISC[1];
    const int i = F.tid >> 8, r = F.tid & 255; const long L = (long)i * F.G + F.bx;
    int tok = 0;
    if (L < 2L * ntile) { const int tile = (int)(L >> 1), e = tab[tile], pos = 256 * (tile - base[e]) + r; if (pos < cnts[e]) tok = elist[e * M + pos]; }
    rowl[F.tid] = tok;
    __syncthreads();
}

constexpr int NPL = 7, NPH = 2 + 2 * NPL;
__global__ void __launch_bounds__(NWAVES * 64, 2) mk_fwd(Args args) {
    extern __shared__ __attribute__((aligned(16))) unsigned char lds[];
    Frame F;
    F.lds = (LAS unsigned char*)lds;
    F.MISC = (volatile LAS unsigned*)(F.lds + MISC_OFF);
    F.tid = threadIdx.x; F.lane = F.tid & 63; F.wave = __builtin_amdgcn_readfirstlane(F.tid >> 6);
    const int wave0 = F.wave;
    F.G = gridDim.x; F.bx = blockIdx.x; F.vcu = 0;
    F.ws = args.ws; F.out = args.out; F.ctl = (unsigned*)(args.ws + WS_CTL);
    for (int u = F.tid; u < (LDS_BYTES - LDSCTL_OFF) / 4; u += NWAVES * 64) ((LAS unsigned*)(F.lds + LDSCTL_OFF))[u] = 0u;
    __syncthreads();
    XcdBarrier bar; bar.bar = F.ctl + CW_BAR; bar.x = 0; bar.st = nullptr;
    if (!MK_PER_PHASE) bar = xcd_barrier_post(F.ctl + CW_BAR, F.MISC + 8);
    const int lo = args.ph_lo, hi = args.ph_hi;
#pragma unroll 1
    for (int ph = lo; ph < hi; ++ph) {
#if PROBE_REP_K >= 0
        const int ptype = ph == 0 ? 0 : (ph == NPH - 1 ? 10 : 1 + (ph - 1) % NPL);
        const int nrep = (ptype == PROBE_REP_K && (ph <= NPL || (PROBE_REP_K != 1 && PROBE_REP_K != 5))) ? 1 : 0;
#pragma unroll 1
        for (int rep = 0; rep <= nrep; ++rep) {
#else
        constexpr int rep = 0;
#endif
        { int w_ = wave0; asm volatile("" : "+s"(w_)); unsigned on_ = ~0u; asm volatile("" : "+s"(on_)); int ln_ = (int)__builtin_amdgcn_mbcnt_hi(on_, __builtin_amdgcn_mbcnt_lo(on_, 0u)); asm volatile("" : "+v"(ln_));
          F.wave = w_; F.lane = ln_; F.tid = w_ * 64 + ln_;
          unsigned long long ws_ = (unsigned long long)args.ws; asm volatile("" : "+s"(ws_)); F.ws = (unsigned char*)(GAS unsigned char*)ws_; F.ctl = (unsigned*)(F.ws + WS_CTL);
          int bx_ = blockIdx.x; asm volatile("" : "+s"(bx_)); F.bx = bx_; F.vcu = (F.G % 8 == 0) ? (bx_ % 8) * (F.G / 8) + bx_ / 8 : bx_; }
        if (ph == 0) {
#ifndef SKIP_P0
            p0_prologue(F, args);
#endif
        } else if (ph == NPH - 1) {
            row_pass(F, args, 2, 1);
        } else {
            const int l = (ph - 1) / NPL, k = (ph - 1) % NPL;
            if (k == 0) { row_pass(F, args, l == 0 ? 0 : 1, l); }
            else if (k == 1) {
                pg8::Gemm g{(const bf16*)(F.ws + WS_H), (const bf16*)(F.ws + WS_WIN) + (size_t)l * NP * DM, M, NP, DM}; pg8::StaticOrder S; S.init(M, NP, F.G, F.bx);
                pg8::EpiBf16 E{(bf16*)(F.ws + WS_PROJ), NP};
#ifndef SKIP_G1
                pg8::gemm_phase<pg8::EpiBf16, pg8::StaticOrder, true, true>(F.lds, g, S, E, F.tid);
#endif
            } else if (k == 2) {
#ifndef SKIP_P3
                p3_prep(F, args, l, rep);
#endif
            } else if (k == 3) {
#ifndef SKIP_P4
                p4_attention(F, args, l, l + 2 * rep);
#endif
            } else if (k == 4) {
                pg8::Gemm g{(const bf16*)(F.ws + WS_MIX), (const bf16*)(F.ws + WS_WOUT) + (size_t)l * DM * DM, M, DM, DM}; pg8::StaticOrder S; S.init(M, DM, F.G, F.bx);
                pg8::EpiResGate E{l == 0 ? inp<I_X>() : (const float*)(F.ws + WS_X1), (float*)(F.ws + WS_X1), (const float*)(F.ws + WS_MOD) + (size_t)l * 8 * 6144 + 2 * DM};
#ifndef SKIP_G2
                pg8::gemm_phase<pg8::EpiResGate, pg8::StaticOrder, false, true>(F.lds, g, S, E, F.tid);
#endif
            } else if (k == 5) {
#ifndef SKIP_P6
                p6_router(F, args, l, rep);
#endif
            } else {
                build_tables(F, l); build_rowlists(F, l);
                unsigned* upf = F.ctl + CW_UPF + l * 8192; unsigned* dq = F.ctl + CW_DNQ + 16 * l;
                { pg8::Gemm g{(const bf16*)(F.ws + WS_H), (const bf16*)(F.ws + WS_WUP) + (size_t)l * NEXP * 512 * DM, MAXSLOT, 512, DM};
                  pg8::GroupOrder S{(const LAS int*)(F.lds + TAB_OFF), (int)F.MISC[1], 2, F.G, F.bx, (size_t)512 * DM * 2};
                  pg8::EpiSwiglu E{(bf16*)(F.ws + WS_HID), upf};
#ifndef SKIP_G3
                  pg8::gemm_phase<pg8::EpiSwiglu, pg8::GroupOrder, true, true, true>(F.lds, g, S, E, F.tid, (const LAS int*)(F.lds + ROWL_OFF));
#endif
                }
                if (GAP_CONVERT && !BG_CONVERT && l == 0 && rep == 0) convert_layer1_in_gap(F, args, 2 * (int)F.MISC[1] - F.G);
                { const pg8::Gemm g{(const bf16*)(F.ws + WS_HID), (const bf16*)(F.ws + WS_WDN) + (size_t)l * NEXP * DM * FF, MAXSLOT, DM, FF};
                  const pg8::EpiBf16 E{(bf16*)(F.ws + WS_Y), DM};
                  const LAS int* tab = (const LAS int*)(F.lds + TAB_OFF);
                  const int nd = 4 * __builtin_amdgcn_readfirstlane((int)F.MISC[1]);
                  pg8::DynOrder S{dq, upf, tab, F.MISC, nd, (size_t)DM * FF * 2, F.tid, 0u, 2u};
                  if (F.tid == 0) { const unsigned a = __hip_atomic_fetch_add(dq, 1u, RLX_AGENT), b = __hip_atomic_fetch_add(dq, 1u, RLX_AGENT); F.MISC[4] = a; F.MISC[5] = b;
                      if ((int)a < nd) while (__hip_atomic_load(upf + (a >> 2) * 16, RLX_AGENT) < 2u) __builtin_amdgcn_s_sleep(8);
                      __builtin_amdgcn_fence(__ATOMIC_ACQUIRE, "agent"); asm volatile("s_waitcnt vmcnt(0)" ::: "memory"); S.issue(b); }
                  __syncthreads();
                  for (;;) {
                      if (__builtin_amdgcn_readfirstlane((int)F.MISC[4]) >= nd) break;
#ifndef SKIP_G4
                      pg8::gemm_phase<pg8::EpiBf16, pg8::DynOrder, true, true>(F.lds, g, S, E, F.tid);
#endif
                      if (F.tid == 0) {
                          const unsigned idn = F.MISC[5];
                          if ((int)idn < nd) { unsigned f = S.pflag; while (f < 2u) { __builtin_amdgcn_s_sleep(8); f = __hip_atomic_load(upf + (idn >> 2) * 16, RLX_AGENT); }
                              __builtin_amdgcn_fence(__ATOMIC_ACQUIRE, "agent"); asm volatile("s_waitcnt vmcnt(0)" ::: "memory"); }
                          const unsigned idn2 = S.ppop; F.MISC[4] = idn; F.MISC[5] = idn2; S.issue(idn2); }
                      __syncthreads();
                  }
                }
            }
        }
#if PROBE_REP_K >= 0
        if (rep < nrep) xcd_barrier(bar, F.tid);
        }
#endif
        if (ph + 1 < hi) xcd_barrier(bar, F.tid);
#ifdef PROBE_DOUBLE_BAR
        if (ph + 1 < hi) xcd_barrier(bar, F.tid);
#endif
    }
}

extern "C" void kernel_launch(void* const* d_in, const int* in_sizes, int n_in, void* d_out, int out_size, void* d_ws, size_t ws_size, hipStream_t stream) {
    static int grid = 0;
    if (grid == 0) {
        if (n_in != 28 || out_size != M * DM || ws_size < WS_END) { fprintf(stderr, "kernel_launch: unexpected shapes (n_in %d, out %d, ws %zu)\n", n_in, out_size, ws_size); grid = -1; return; }
        int dev = 0, cus = 0, per_cu = 0;
        if (hipGetDevice(&dev) != hipSuccess || hipDeviceGetAttribute(&cus, hipDeviceAttributeMultiprocessorCount, dev) != hipSuccess) { grid = -1; return; }
        if (hipFuncSetAttribute((const void*)mk_fwd, hipFuncAttributeMaxDynamicSharedMemorySize, LDS_BYTES) != hipSuccess) { fprintf(stderr, "kernel_launch: hipFuncSetAttribute failed\n"); grid = -1; return; }
        if (hipOccupancyMaxActiveBlocksPerMultiprocessor(&per_cu, (const void*)mk_fwd, NWAVES * 64, LDS_BYTES) != hipSuccess || per_cu < 1)
            fprintf(stderr, "kernel_launch: occupancy query reports %d workgroups per CU\n", per_cu);
        (void)hipGetLastError();
        grid = cus;
    }
    if (grid < 0) return;
    if (hipMemsetAsync((char*)d_ws + WS_CTL, 0, CTL_ZERO_BYTES, stream) != hipSuccess) return;
    Args a{};
    for (int i = 0; i < 28; ++i) a.in[i] = (const float*)d_in[i];
    a.out = (float*)d_out; a.ws = (unsigned char*)d_ws;
#if MK_PER_PHASE
    for (int p = 0; p < NPH; ++p) { a.ph_lo = p; a.ph_hi = p + 1; hipLaunchKernelGGL(mk_fwd, dim3(grid), dim3(NWAVES * 64), LDS_BYTES, stream, a); }
#else
    a.ph_lo = 0; a.ph_hi = NPH; hipLaunchKernelGGL(mk_fwd, dim3(grid), dim3(NWAVES * 64), LDS_BYTES, stream, a);
#endif
}
```

```cpp
#include <hip/hip_runtime.h>
#include <cstdio>
#include <cstdint>

#ifndef MK_PER_PHASE
#define MK_PER_PHASE 0
#endif

#ifndef PROBE_P3_PART
#define PROBE_P3_PART 0
#endif
#ifndef PROBE_ATT_VAR
#define PROBE_ATT_VAR -1
#endif
#ifndef BG_CONVERT
#define BG_CONVERT 1
#endif
#ifndef GAP_CONVERT
#define GAP_CONVERT 1
#endif
#ifndef PROBE_ATT_MODE
#define PROBE_ATT_MODE 0
#endif
#ifndef PROBE_REP_K
#define PROBE_REP_K -1
#endif
#define LAS __attribute__((address_space(3)))
#define GAS __attribute__((address_space(1)))
typedef unsigned short bf16;
typedef short bf16x8 __attribute__((ext_vector_type(8)));
typedef short s16x4 __attribute__((ext_vector_type(4)));
typedef float f32x4 __attribute__((ext_vector_type(4)));
typedef float f32x2 __attribute__((ext_vector_type(2)));
typedef float f32x16 __attribute__((ext_vector_type(16)));
typedef unsigned u32x4 __attribute__((ext_vector_type(4)));
typedef unsigned u32x2 __attribute__((ext_vector_type(2)));

constexpr int BATCH = 8, SEQ = 2048, DM = 1024, M = BATCH * SEQ, DEPTH = 2;
constexpr int NP = 3072;
constexpr int P_IN = 2988;
constexpr int C_AQ = 0, C_AK = 256, C_AV = 512, C_BQ = 768, C_BK = 1024, C_BV = 1280, C_CQ = 1536, C_CK = 1792, C_CV = 2048,
              C_DQ = 2304, C_DK = 2560, C_DV = 2624, C_IQ = 2688, C_IK = 2944, C_IW = 2976, C_AF = 2984;
constexpr int NEXP = 32, FF = 256, MAXSLOT = M * 2 + NEXP * 256, MAXTILE = MAXSLOT / 256;
constexpr float LOG2E = 1.4426950408889634f;
constexpr float RMS_EPS = 1e-6f;

constexpr size_t MiB = 1u << 20;
constexpr size_t WS_CTL = 0, CTL_ZERO_BYTES = 1 * MiB;
constexpr size_t WS_WR = 1 * MiB;
constexpr size_t WS_MOD = 2 * MiB;
constexpr size_t WS_CUM = 3 * MiB;
constexpr size_t WS_TOK = 4 * MiB;
constexpr size_t WS_MISC = 5 * MiB;
constexpr size_t WS_MASK = 6 * MiB;
constexpr size_t WS_WIN = 10 * MiB;
constexpr size_t WS_WOUT = 22 * MiB;
constexpr size_t WS_WUP = 26 * MiB;
constexpr size_t WS_WDN = 90 * MiB;
constexpr size_t WS_X1 = 122 * MiB;
constexpr size_t WS_H = 186 * MiB;
constexpr size_t WS_MIX = WS_H;

constexpr size_t WS_PROJ = 218 * MiB;
constexpr size_t WS_Y = WS_PROJ;
constexpr size_t WS_HID = WS_PROJ + 80 * MiB;
constexpr size_t WS_ELIST = 322 * MiB;
constexpr size_t WS_END = 324 * MiB;
constexpr int CW_AQ = 256;
constexpr int CW_CNT = 1024;
constexpr int CW_BAR = 8192;
constexpr int CW_DNQ = 208;
constexpr int CW_UPF = 65536;

constexpr int RING_BYTES = 143360;
constexpr int LDSCTL_OFF = RING_BYTES, MISC_OFF = LDSCTL_OFF + 320, CNTS_OFF = LDSCTL_OFF + 512, BASE_OFF = LDSCTL_OFF + 640, TAB_OFF = LDSCTL_OFF + 768;
constexpr int ROWL_OFF = 131072;
constexpr int LDS_BYTES = 147456;
constexpr int NWAVES = 8;

#define LDS_WAIT() asm volatile("s_waitcnt lgkmcnt(0)" ::: "memory")
#define VM_WAIT() asm volatile("s_waitcnt vmcnt(0)" ::: "memory")
#define RLX_AGENT __ATOMIC_RELAXED, __HIP_MEMORY_SCOPE_AGENT

__device__ __forceinline__ float bf2f(unsigned short u) { return __builtin_bit_cast(float, (unsigned)u << 16); }
__device__ __forceinline__ unsigned f2bf(float f) { unsigned u = __builtin_bit_cast(unsigned, f); return (u + 0x7fffu + ((u >> 16) & 1u)) >> 16; }
__device__ __forceinline__ unsigned pk2(float lo, float hi) { return f2bf(lo) | (f2bf(hi) << 16); }
template <int O> __device__ __forceinline__ float shx(float x) { static_assert(O >= 1 && O <= 16, "swizzle xor"); return __builtin_bit_cast(float, __builtin_amdgcn_ds_swizzle(__builtin_bit_cast(int, x), (O << 10) | 0x1f)); }
__device__ __forceinline__ float half_sum(float x) { return __builtin_bit_cast(float, __builtin_amdgcn_readlane(__builtin_bit_cast(int, x), 0)) + __builtin_bit_cast(float, __builtin_amdgcn_readlane(__builtin_bit_cast(int, x), 32)); }
__device__ __forceinline__ float half_max(float x) { return fmaxf(__builtin_bit_cast(float, __builtin_amdgcn_readlane(__builtin_bit_cast(int, x), 0)), __builtin_bit_cast(float, __builtin_amdgcn_readlane(__builtin_bit_cast(int, x), 32))); }
__device__ __forceinline__ float shup(float x, int o, int lane) { return __builtin_bit_cast(float, __builtin_amdgcn_ds_bpermute((lane - o) << 2, __builtin_bit_cast(int, x))); }
__device__ __forceinline__ int shup_i(int x, int o, int lane) { return __builtin_amdgcn_ds_bpermute((lane - o) << 2, x); }
__device__ __forceinline__ float wave_sum(float v) { v += shx<1>(v); v += shx<2>(v); v += shx<4>(v); v += shx<8>(v); v += shx<16>(v); return half_sum(v); }

namespace pg8 {
constexpr int BM = 256, BK = 64, HALF = 128, HTB = HALF * BK * 2, STAGE_BYTES = 8 * HTB, NXCD = 8, WGM = 8;
__host__ __device__ __forceinline__ int lds_byte(int r, int c) { const int st = (r >> 4) * 2 + (c >> 5), rr = r & 15, cc = c & 31, ob = rr * 64 + cc * 2; return st * 1024 + (ob ^ (((ob >> 9) & 1) << 5)); }
__host__ __device__ __forceinline__ void stage_rc(int b, int& R, int& C) { const int st = b / 1024, sb = b % 1024, swz = sb ^ (((sb >> 9) & 1) << 5); R = (st >> 1) * 16 + swz / 64; C = (st & 1) * 32 + (swz % 64) / 2; }
__host__ __device__ __forceinline__ int perm32(int rho) { const int n = rho >> 4, i = rho & 15; return 8 * (i >> 2) + 4 * n + (i & 3); }

struct Unit { int pm, pn; size_t bo; };
struct Gemm { const bf16* A; const bf16* Bt; int M, N, K; };

struct StaticOrder {
    int nM, nN, nwg, G, c;
    __host__ __device__ void init(int M_, int N_, int G_, int c_) { nM = M_ / BM; nN = N_ / BM; nwg = nM * nN; G = G_; c = c_; }
    __host__ __device__ bool next(int i, Unit& u) const {
        const long L = (long)i * G + c; if (L >= nwg) return false;
        int wgid = (int)L; { const int q = nwg / NXCD, r = nwg % NXCD, xcd = wgid % NXCD, off = wgid / NXCD; wgid = (xcd < r ? xcd * (q + 1) : r * (q + 1) + (xcd - r) * q) + off; }
        const int nig = WGM * nN, gid = wgid / nig, fm = gid * WGM, gsz = (nM - fm) < WGM ? (nM - fm) : WGM;
        u.pm = fm + ((wgid % nig) % gsz); u.pn = (wgid % nig) / gsz; u.bo = 0; return true;
    }
};
struct GroupOrder {
    const LAS int* tab; int ntile, ncol, G, c; size_t ebytes;
    __device__ __forceinline__ bool next(int i, Unit& u) const {
        const long L = (long)i * G + c; if (L >= (long)ntile * ncol) return false;
        u.pm = (int)(L / ncol); u.pn = (int)(L % ncol);
        const int e = __builtin_amdgcn_readfirstlane(tab[u.pm]); u.bo = (size_t)e * ebytes; return true;
    }
};

struct OneUnit { Unit u; __device__ __forceinline__ bool next(int i, Unit& o) const { if (i != 0) return false; o = u; return true; } };
struct DynOrder {
    unsigned* dq; unsigned* upf; const LAS int* tab; volatile LAS unsigned* M; int nd; size_t ebytes; int tid;
    mutable unsigned ppop, pflag;
    __device__ __forceinline__ void issue(unsigned idnext) const {
        ppop = __builtin_amdgcn_atomic_inc32(dq, 0xFFFFFFFFu, __ATOMIC_RELAXED, "agent");
        pflag = 2u; if ((int)idnext < nd) pflag = __hip_atomic_load(upf + (idnext >> 2) * 16, __ATOMIC_RELAXED, __HIP_MEMORY_SCOPE_AGENT);
    }
    __device__ __forceinline__ void unit(int id, Unit& u) const { u.pm = id >> 2; u.pn = id & 3; u.bo = (size_t)__builtin_amdgcn_readfirstlane(tab[id >> 2]) * ebytes; }
    __device__ __forceinline__ bool next(int i, Unit& u) const {
        if (i == 0) { const int id = __builtin_amdgcn_readfirstlane((int)M[4]); if (id >= nd) return false; unit(id, u); return true; }
        if (tid == 0) {
            const unsigned idn = M[5]; const bool ready = (int)idn < nd && pflag >= 2u;
            M[6] = ready ? 1u : 0u;
            if (ready) { asm volatile("buffer_inv sc1" ::: "memory"); M[4] = idn; const unsigned idn2 = ppop; M[5] = idn2; issue(idn2); }
        }
        asm volatile("s_waitcnt lgkmcnt(0)\n\ts_barrier" ::: "memory");
        if (__builtin_amdgcn_readfirstlane((int)M[6]) == 0) return false;
        unit(__builtin_amdgcn_readfirstlane((int)M[4]), u); return true;
    }
};

__device__ __forceinline__ unsigned cvt_pk_bf16(float lo, float hi) { unsigned r; asm volatile("v_cvt_pk_bf16_f32 %0, %1, %2" : "=v"(r) : "v"(lo), "v"(hi)); return r; }

struct EpiBf16 {
    static constexpr bool PERM = true, PUBLISH = false;
    bf16* O; int ldc;
    __device__ __forceinline__ void operator()(const f32x4 (&acc)[2][2][4][2], const Unit& u, int wr, int wc, int fr, int fq) const {
        const int row0 = u.pm * BM + wr * 64 + fr; const int col0 = u.pn * BM + wc * 32 + 8 * fq;
#pragma unroll
        for (int ai = 0; ai < 2; ++ai)
#pragma unroll
            for (int m = 0; m < 4; ++m) { bf16* rowp = O + (size_t)(row0 + ai * HALF + m * 16) * ldc + col0;
#pragma unroll
                for (int bj = 0; bj < 2; ++bj) { const f32x4 v0 = acc[ai][bj][m][0], v1 = acc[ai][bj][m][1];
                    u32x4 w; w.x = cvt_pk_bf16(v0[0], v0[1]); w.y = cvt_pk_bf16(v0[2], v0[3]); w.z = cvt_pk_bf16(v1[0], v1[1]); w.w = cvt_pk_bf16(v1[2], v1[3]);
                    *(u32x4*)(rowp + bj * HALF) = w; } }
    }
};
struct EpiResGate {
    static constexpr bool PERM = true, PUBLISH = false;
    const float* base32; const bf16* base16; bf16* out; const float* gate;
    __device__ __forceinline__ void operator()(const f32x4 (&acc)[2][2][4][2], const Unit& u, int wr, int wc, int fr, int fq) const {
        const int col0 = u.pn * BM + wc * 32 + 8 * fq; const float* g = gate + (size_t)(u.pm >> 3) * 6144 + col0;
        f32x4 gv[2][2];
#pragma unroll
        for (int bj = 0; bj < 2; ++bj)
#pragma unroll
            for (int n = 0; n < 2; ++n) gv[bj][n] = *(const f32x4*)(g + bj * HALF + n * 4);
#pragma unroll
        for (int ai = 0; ai < 2; ++ai)
#pragma unroll
            for (int m = 0; m < 4; ++m) { const size_t off = (size_t)(u.pm * BM + ai * HALF + wr * 64 + m * 16 + fr) * DM + col0;
#pragma unroll
                for (int bj = 0; bj < 2; ++bj) { f32x4 b0, b1;
                    if (base32) { b0 = *(const f32x4*)(base32 + off + bj * HALF); b1 = *(const f32x4*)(base32 + off + bj * HALF + 4); }
                    else { const u32x4 r = *(const u32x4*)(base16 + off + bj * HALF);
                        b0 = (f32x4){bf2f(r.x & 0xffff), bf2f(r.x >> 16), bf2f(r.y & 0xffff), bf2f(r.y >> 16)}; b1 = (f32x4){bf2f(r.z & 0xffff), bf2f(r.z >> 16), bf2f(r.w & 0xffff), bf2f(r.w >> 16)}; }
                    const f32x4 v0 = b0 + gv[bj][0] * acc[ai][bj][m][0], v1 = b1 + gv[bj][1] * acc[ai][bj][m][1];
                    u32x4 w; w.x = cvt_pk_bf16(v0[0], v0[1]); w.y = cvt_pk_bf16(v0[2], v0[3]); w.z = cvt_pk_bf16(v1[0], v1[1]); w.w = cvt_pk_bf16(v1[2], v1[3]);
                    *(u32x4*)(out + off + bj * HALF) = w; } }
    }
};
struct EpiSwiglu {
    static constexpr bool PERM = true, PUBLISH = true;
    bf16* O; unsigned* flag;
    __device__ __forceinline__ void operator()(const f32x4 (&acc)[2][2][4][2], const Unit& u, int wr, int wc, int fr, int fq) const {
        const int row0 = u.pm * BM + wr * 64 + fr; const int col0 = u.pn * HALF + wc * 32 + 8 * fq;
#pragma unroll
        for (int ai = 0; ai < 2; ++ai)
#pragma unroll
            for (int m = 0; m < 4; ++m) { bf16* rowp = O + (size_t)(row0 + ai * HALF + m * 16) * FF + col0;
                float hv[8];
#pragma unroll
                for (int n = 0; n < 2; ++n)
#pragma unroll
                    for (int i = 0; i < 4; ++i) { const float a = acc[ai][0][m][n][i], b = acc[ai][1][m][n][i];
                        const float sg = __builtin_amdgcn_rcpf(1.f + __builtin_amdgcn_exp2f(-a * LOG2E)); hv[n * 4 + i] = a * sg * b; }
                u32x4 w; w.x = cvt_pk_bf16(hv[0], hv[1]); w.y = cvt_pk_bf16(hv[2], hv[3]); w.z = cvt_pk_bf16(hv[4], hv[5]); w.w = cvt_pk_bf16(hv[6], hv[7]);
                asm volatile("global_store_dwordx4 %0, %1, off sc1\n\ts_nop 2" :: "v"((const GAS bf16*)rowp), "v"(w) : "memory"); }
    }
};

template <class Epi, class Sched, bool ALIGN_EPI = false, bool SP2 = false, bool GATHER = false>
__device__ __forceinline__ void gemm_phase(LAS unsigned char* lds, const Gemm g, const Sched& S, const Epi& E, const int tid, const LAS int* rowl = nullptr) {
    static_assert(!GATHER || SP2, "gather mode is written for the SP2 loop");
    const int wid = __builtin_amdgcn_readfirstlane(tid >> 6), lane = tid & 63, wr = wid >> 2, wc = wid & 3, fr = lane & 15, fq = lane >> 4;
    const int K = g.K, nt = K / BK;
    unsigned voffA[2], voffB[2];
#pragma unroll
    for (int i = 0; i < 2; ++i) { int R, C; stage_rc(tid * 16 + i * 8192, R, C); const int Rb = Epi::PERM ? ((R & ~31) + perm32(R & 31)) : R;
        voffA[i] = (unsigned)(R * K + C) * 2u; voffB[i] = (unsigned)(Rb * K + C) * 2u; }
    const size_t kstep = (size_t)(BK * 2);
    const size_t hstep = (size_t)HALF * K * 2;
    const size_t tstep = 2 * hstep;
    const size_t hstepA = GATHER ? 0 : hstep, tstepA = GATHER ? 0 : tstep;
    unsigned voffGc[2][2], voffGn[2][2];
    int gR[2], gC[2];
#pragma unroll
    for (int i = 0; i < 2; ++i) stage_rc(tid * 16 + i * 8192, gR[i], gC[i]);
#define PG8_GOFF(dst, ui_) do { _Pragma("unroll") for (int h_ = 0; h_ < 2; ++h_) _Pragma("unroll") for (int i_ = 0; i_ < 2; ++i_) \
        dst[h_][i_] = (unsigned)rowl[(ui_) * 256 + h_ * HALF + gR[i_]] * (unsigned)(K * 2) + (unsigned)gC[i_] * 2u; } while (0)
    const unsigned ldsw = (unsigned)wid * 1024u;
    const int aoff = lds_byte(wr * 64 + fr, fq * 8), boff = lds_byte(wc * 32 + fr, fq * 8);
#define PG8_SA(b, h) (((b) * 2 + (h)) * HTB)
#define PG8_SB(b, h) ((4 + (b) * 2 + (h)) * HTB)
#define PG8_STAGE(bufoff, gbase, voff) do { _Pragma("unroll") for (int _i = 0; _i < 2; ++_i) \
        __builtin_amdgcn_global_load_lds((const unsigned*)((const char*)(gbase) + (voff)[_i]), (LAS unsigned*)(lds + (bufoff) + ldsw + _i * 8192), 16, 0, 0); } while (0)
#define PG8_STAGE_A(bufoff, gbase, H, NXT) do { if constexpr (GATHER) { unsigned vo_[2]; vo_[0] = (NXT) ? voffGn[H][0] : voffGc[H][0]; vo_[1] = (NXT) ? voffGn[H][1] : voffGc[H][1]; PG8_STAGE(bufoff, gbase, vo_); } \
        else { PG8_STAGE(bufoff, (const char*)(gbase) + (H) * hstep, voffA); } } while (0)
#define PG8_LDA(dst, b, h) do { _Pragma("unroll") for (int m = 0; m < 4; ++m) _Pragma("unroll") for (int k = 0; k < 2; ++k) dst[m][k] = *(const LAS bf16x8*)(lds + PG8_SA(b, h) + aoff + m * 2048 + k * 1024); } while (0)
#define PG8_LDB(dst, b, h) do { _Pragma("unroll") for (int n = 0; n < 2; ++n) _Pragma("unroll") for (int k = 0; k < 2; ++k) dst[n][k] = *(const LAS bf16x8*)(lds + PG8_SB(b, h) + boff + n * 2048 + k * 1024); } while (0)
#define PG8_MMA(ai, bj, At, Bt) do { __builtin_amdgcn_s_setprio(1); _Pragma("unroll") for (int m = 0; m < 4; ++m) _Pragma("unroll") for (int n = 0; n < 2; ++n) _Pragma("unroll") for (int k = 0; k < 2; ++k) \
        acc[ai][bj][m][n] = __builtin_amdgcn_mfma_f32_16x16x32_bf16(Bt[n][k], At[m][k], acc[ai][bj][m][n], 0, 0, 0); __builtin_amdgcn_s_setprio(0); } while (0)
#define PG8_WAIT_V(n) asm volatile("s_waitcnt vmcnt(" #n ")" ::: "memory")
#define PG8_WAIT_L(n) asm volatile("s_waitcnt lgkmcnt(" #n ")" ::: "memory")
#define PG8_BAR __builtin_amdgcn_s_barrier()
#define PG8_SCHED __builtin_amdgcn_sched_barrier(0)
    Unit cur, nxt; int ui = 0;
    if (!S.next(0, cur)) return;
    f32x4 acc[2][2][4][2];
#pragma unroll
    for (int a = 0; a < 2; ++a)
#pragma unroll
        for (int b = 0; b < 2; ++b)
#pragma unroll
            for (int m = 0; m < 4; ++m)
#pragma unroll
                for (int n = 0; n < 2; ++n) acc[a][b][m][n] = (f32x4){0.f, 0.f, 0.f, 0.f};
    bf16x8 At[4][2], B0[2][2], B1[2][2];
    const char* cA = (const char*)g.A + (size_t)cur.pm * tstepA; const char* cB = (const char*)g.Bt + cur.bo + (size_t)cur.pn * tstep;
    if constexpr (GATHER) { PG8_GOFF(voffGc, 0); PG8_GOFF(voffGn, 0); }
    if constexpr (SP2) {
        PG8_STAGE(PG8_SB(0, 0), cB, voffB); PG8_STAGE(PG8_SB(0, 1), cB + hstep, voffB); PG8_STAGE_A(PG8_SA(0, 0), cA, 0, false); PG8_STAGE_A(PG8_SA(0, 1), cA, 1, false);
        if (wr == 1) PG8_BAR;
        PG8_WAIT_V(2); PG8_BAR;
        PG8_STAGE(PG8_SB(1, 0), cB + kstep, voffB); PG8_STAGE_A(PG8_SA(1, 0), cA + kstep, 0, false); PG8_STAGE(PG8_SB(1, 1), cB + hstep + kstep, voffB);
        PG8_WAIT_V(6); PG8_BAR;
    } else {
        PG8_STAGE(PG8_SB(0, 0), cB, voffB); PG8_STAGE(PG8_SA(0, 0), cA, voffA); PG8_STAGE(PG8_SB(0, 1), cB + hstep, voffB); PG8_STAGE(PG8_SA(0, 1), cA + hstep, voffA);
        if (wr == 1) PG8_BAR;
        PG8_WAIT_V(4); PG8_BAR;
        PG8_STAGE(PG8_SB(1, 0), cB + kstep, voffB); PG8_STAGE(PG8_SA(1, 0), cA + kstep, voffA); PG8_STAGE(PG8_SB(1, 1), cB + hstep + kstep, voffB);
        PG8_WAIT_V(6); PG8_BAR;
    }
    for (;;) {
        const bool has_next = S.next(ui + 1, nxt);
        if constexpr (GATHER) { if (has_next) PG8_GOFF(voffGn, ui + 1); }
        const char* nA = has_next ? (const char*)g.A + (size_t)nxt.pm * tstepA : cA; const char* nB = has_next ? (const char*)g.Bt + nxt.bo + (size_t)nxt.pn * tstep : cB;
#pragma unroll 1
        for (int t = 0; t < nt; t += 2) {
            const bool last = (t == nt - 2);
            const char* a1 = cA + (size_t)(t + 1) * kstep;
            const char* a2 = last ? nA : cA + (size_t)(t + 2) * kstep; const char* b2 = last ? nB : cB + (size_t)(t + 2) * kstep;
            const char* a3 = a2 + kstep; const char* b3 = b2 + kstep;
            if constexpr (SP2) {
            PG8_LDB(B0, 0, 0); PG8_LDB(B1, 0, 1); PG8_SCHED; PG8_LDA(At, 0, 0); PG8_STAGE_A(PG8_SA(1, 1), a1, 1, false);
            PG8_WAIT_V(8); PG8_WAIT_L(0); PG8_BAR; PG8_MMA(0, 0, At, B0); PG8_MMA(0, 1, At, B1); PG8_BAR; PG8_SCHED;
            PG8_LDA(At, 0, 1); PG8_STAGE(PG8_SB(0, 0), b2, voffB); PG8_STAGE(PG8_SB(0, 1), b2 + hstep, voffB); PG8_STAGE_A(PG8_SA(0, 0), a2, 0, last);
            PG8_WAIT_V(8); PG8_WAIT_L(0); PG8_BAR; PG8_MMA(1, 0, At, B0); PG8_MMA(1, 1, At, B1); PG8_BAR; PG8_SCHED;
            PG8_LDB(B0, 1, 0); PG8_LDB(B1, 1, 1); PG8_SCHED; PG8_LDA(At, 1, 0); PG8_STAGE_A(PG8_SA(0, 1), a2, 1, last);
            PG8_WAIT_V(8); PG8_WAIT_L(0); PG8_BAR; PG8_MMA(0, 0, At, B0); PG8_MMA(0, 1, At, B1); PG8_BAR; PG8_SCHED;
            PG8_LDA(At, 1, 1); PG8_STAGE(PG8_SB(1, 0), b3, voffB); PG8_STAGE(PG8_SB(1, 1), b3 + hstep, voffB); PG8_STAGE_A(PG8_SA(1, 0), a3, 0, last);
            PG8_WAIT_V(8); PG8_WAIT_L(0); PG8_BAR; PG8_MMA(1, 0, At, B0); PG8_MMA(1, 1, At, B1); PG8_BAR; PG8_SCHED;
            } else {
            PG8_LDB(B0, 0, 0); PG8_SCHED; PG8_LDA(At, 0, 0); PG8_STAGE(PG8_SA(1, 1), a1 + hstep, voffA);
            PG8_WAIT_L(8); PG8_BAR; PG8_WAIT_L(0); PG8_MMA(0, 0, At, B0); PG8_BAR; PG8_SCHED;
            PG8_LDB(B1, 0, 1); PG8_STAGE(PG8_SB(0, 0), b2, voffB);
            PG8_BAR; PG8_WAIT_L(0); PG8_MMA(0, 1, At, B1); PG8_BAR;
            PG8_LDA(At, 0, 1); PG8_STAGE(PG8_SA(0, 0), a2, voffA);
            PG8_BAR; PG8_WAIT_L(0); PG8_MMA(1, 0, At, B0); PG8_BAR; PG8_SCHED;
            PG8_STAGE(PG8_SB(0, 1), b2 + hstep, voffB);
            PG8_WAIT_V(6); PG8_BAR; PG8_MMA(1, 1, At, B1); PG8_BAR;
            PG8_LDB(B0, 1, 0); PG8_SCHED; PG8_LDA(At, 1, 0); PG8_STAGE(PG8_SA(0, 1), a2 + hstep, voffA);
            PG8_WAIT_L(8); PG8_BAR; PG8_WAIT_L(0); PG8_MMA(0, 0, At, B0); PG8_BAR; PG8_SCHED;
            PG8_LDB(B1, 1, 1); PG8_STAGE(PG8_SB(1, 0), b3, voffB);
            PG8_BAR; PG8_WAIT_L(0); PG8_MMA(0, 1, At, B1); PG8_BAR;
            PG8_LDA(At, 1, 1); PG8_STAGE(PG8_SA(1, 0), a3, voffA);
            PG8_BAR; PG8_WAIT_L(0); PG8_MMA(1, 0, At, B0); PG8_BAR; PG8_SCHED;
            PG8_STAGE(PG8_SB(1, 1), b3 + hstep, voffB);
            PG8_WAIT_V(6); PG8_BAR; PG8_MMA(1, 1, At, B1); PG8_BAR;
            }
        }
        if constexpr (ALIGN_EPI) { if (wr == 0) PG8_BAR; }
        E(acc, cur, wr, wc, fr, fq);
        if constexpr (Epi::PUBLISH) {
            asm volatile("s_waitcnt vmcnt(0)" ::: "memory"); PG8_BAR;
            if (tid == 0) __hip_atomic_fetch_add(E.flag + cur.pm * 16, 1u, __ATOMIC_RELAXED, __HIP_MEMORY_SCOPE_AGENT);
        }
        if (!has_next) break;
#pragma unroll
        for (int a = 0; a < 2; ++a)
#pragma unroll
            for (int b = 0; b < 2; ++b)
#pragma unroll
                for (int m = 0; m < 4; ++m)
#pragma unroll
                    for (int n = 0; n < 2; ++n) acc[a][b][m][n] = (f32x4){0.f, 0.f, 0.f, 0.f};
        cur = nxt; cA = nA; cB = nB; ++ui;
        if constexpr (GATHER) { _Pragma("unroll") for (int h_ = 0; h_ < 2; ++h_) _Pragma("unroll") for (int i_ = 0; i_ < 2; ++i_) voffGc[h_][i_] = voffGn[h_][i_]; }
        if constexpr (ALIGN_EPI) { if (wr == 1) PG8_BAR; }
    }
    PG8_WAIT_V(0);
    if constexpr (!ALIGN_EPI) { if (wr == 0) PG8_BAR; }
    PG8_BAR;
#undef PG8_SA
#undef PG8_STAGE_A
#undef PG8_GOFF
#undef PG8_SB
#undef PG8_STAGE
#undef PG8_LDA
#undef PG8_LDB
#undef PG8_MMA
#undef PG8_WAIT_V
#undef PG8_WAIT_L
#undef PG8_BAR
#undef PG8_SCHED
}
}

#define XB_TMO      128
#define XB_XCNT(j)  (256  + 64 * (j))
#define XB_XSUB(j)  (1280 + 64 * (j))
#define XB_XGEN(j)  (2304 + 64 * (j))
#define XB_TOP      3328
#define XB_TOPGEN   3392
#define XCD_BAR_WORDS 3456
#define XB_SPIN_CAP (1u << 18)
__device__ __forceinline__ unsigned xb_ld(unsigned* p)              { return __hip_atomic_load(p, __ATOMIC_RELAXED, __HIP_MEMORY_SCOPE_AGENT); }
__device__ __forceinline__ unsigned xb_add(unsigned* p, unsigned v) { return __hip_atomic_fetch_add(p, v, __ATOMIC_RELAXED, __HIP_MEMORY_SCOPE_AGENT); }
__device__ __forceinline__ unsigned xb_xcc_id() { return (unsigned)__builtin_amdgcn_s_getreg((3 << 11) | 20) & 0xFu; }
#define XB_SPIN(cond, bar) do { unsigned _sp = 0; while (cond) { __builtin_amdgcn_s_sleep(1); \
    if ((++_sp & 255u) == 0u) { if (xb_ld(&(bar)[XB_TMO])) break; if (_sp > XB_SPIN_CAP) { atomicAdd(&(bar)[XB_TMO], 1u); break; } } } } while (0)
struct XcdBarrier { unsigned* bar; unsigned x; volatile LAS unsigned* st; };
__device__ __forceinline__ XcdBarrier xcd_barrier_post(unsigned* bar, volatile LAS unsigned* st) {
    XcdBarrier b; b.bar = bar; b.x = xb_xcc_id(); b.st = st;
    if (threadIdx.x == 0) (void)xb_add(&bar[XB_XCNT(b.x)], 1u);
    return b;
}
__device__ __forceinline__ void xcd_barrier_complete(unsigned* bar, unsigned x, unsigned& nloc, unsigned& nx) {
    const unsigned G = gridDim.x * gridDim.y * gridDim.z;
    unsigned sum, cnt, mine, sp = 0u;
    for (;;) {
        sum = 0u; cnt = 0u; mine = 0u;
#pragma unroll 1
        for (unsigned j = 0; j < 16; ++j) { const unsigned c = xb_ld(&bar[XB_XCNT(j)]); sum += c; cnt += (c > 0u) ? 1u : 0u; mine = (j == x) ? c : mine; }
        if (sum == G) break;
        __builtin_amdgcn_s_sleep(1);
        if ((++sp & 255u) == 0u) { if (xb_ld(&bar[XB_TMO])) break; if (sp > XB_SPIN_CAP) { atomicAdd(&bar[XB_TMO], 1u); break; } }
    }
    nloc = mine > 0u ? mine : 1u; nx = cnt > 0u ? cnt : 1u;
}
__device__ __forceinline__ void xcd_barrier(const XcdBarrier& b, const int tid) {
    asm volatile("s_waitcnt vmcnt(0)" ::: "memory");
    __syncthreads();
    if (tid == 0) {
        unsigned* bar = b.bar;
        __builtin_amdgcn_s_waitcnt(0);
        unsigned nloc = b.st[0], nx = b.st[1];
        if (nloc == 0u) { xcd_barrier_complete(bar, b.x, nloc, nx); b.st[0] = nloc; b.st[1] = nx; }
        const unsigned old = xb_add(&bar[XB_XSUB(b.x)], 1u);
        const unsigned gen = old / nloc;
        if (old + 1u == (gen + 1u) * nloc) {
            __builtin_amdgcn_fence(__ATOMIC_RELEASE, "agent");
            asm volatile("s_waitcnt vmcnt(0)" ::: "memory");
            const unsigned og = xb_add(&bar[XB_TOP], 1u);
            const unsigned tg = og / nx;
            if (og + 1u == (tg + 1u) * nx) xb_add(&bar[XB_TOPGEN], 1u);
            else XB_SPIN(xb_ld(&bar[XB_TOPGEN]) == tg, bar);
            __builtin_amdgcn_fence(__ATOMIC_ACQUIRE, "agent");
            xb_add(&bar[XB_XGEN(b.x)], 1u);
            asm volatile("s_waitcnt vmcnt(0)" ::: "memory");
        } else {
            XB_SPIN(xb_ld(&bar[XB_XGEN(b.x)]) == gen, bar);
            __builtin_amdgcn_fence(__ATOMIC_ACQUIRE, "agent");
            asm volatile("s_waitcnt vmcnt(0)" ::: "memory");
        }
    }
    __syncthreads();
}

struct Frame {
    LAS unsigned char* lds;
    volatile LAS unsigned* MISC;
    unsigned* ctl;
    int tid, lane, wave, vcu, G, bx;
    float* out; unsigned char* ws;
};
struct Args { const float* in[28]; float* out; unsigned char* ws; int ph_lo, ph_hi; };
enum { I_X = 0, I_C, I_ADAW, I_ADAB, I_N1G, I_N2G, I_WIN, I_BF, I_QNA, I_KNA, I_QNC, I_KNC, I_LQ1, I_LK1, I_LQ2, I_LK2, I_SUBLN, I_QND, I_KND, I_MIXB, I_WOUT,
       I_WG, I_BG, I_WE, I_BE, I_W1, I_W3, I_W2 };
template <int I> __device__ __forceinline__ const float* inp() {
    auto ka = __builtin_amdgcn_kernarg_segment_ptr(); unsigned long long raw;
    asm volatile("s_load_dwordx2 %0, %1, %2\n\ts_waitcnt lgkmcnt(0)" : "=s"(raw) : "s"(ka), "i"(I * 8));
    return (const float*)(const GAS float*)raw;
}


struct TItem { const float* W; bf16* WT; const float* rs; int ldw, K, dst_row0, src_n0, kb, mapin; };
__device__ __forceinline__ int colmap_in(int n) { return n < 768 ? n : (n < 2984 ? n + 4 : (n < 2988 ? n - 2984 + 768 : -1)); }
__device__ __forceinline__ void t_load(const TItem& T, f32x4 (&v)[8], int lane) {
    const int k0 = 64 * T.kb, r8 = lane >> 3, c4 = (lane & 7) * 4; const int sc = T.mapin ? colmap_in(T.src_n0 + c4) : T.src_n0 + c4;
#pragma unroll
    for (int i = 0; i < 8; ++i) { v[i] = (f32x4){0.f, 0.f, 0.f, 0.f}; if (sc >= 0) v[i] = *(const f32x4*)(T.W + (size_t)(k0 + 8 * r8 + i) * T.ldw + sc); }
}
__device__ __forceinline__ void t_store(const TItem& T, f32x4 (&v)[8], LAS float* scr, int lane) {
    (void)scr;
    const int k0 = 64 * T.kb, r8 = lane >> 3, c4 = (lane & 7) * 4;
    if (T.rs) {
#pragma unroll
        for (int i = 0; i < 8; ++i) v[i] = v[i] * T.rs[k0 + 8 * r8 + i]; }
#pragma unroll
    for (int c = 0; c < 4; ++c) { u32x4 o; o.x = pg8::cvt_pk_bf16(v[0][c], v[1][c]); o.y = pg8::cvt_pk_bf16(v[2][c], v[3][c]); o.z = pg8::cvt_pk_bf16(v[4][c], v[5][c]); o.w = pg8::cvt_pk_bf16(v[6][c], v[7][c]);
        *(GAS u32x4*)(T.WT + (size_t)(T.dst_row0 + c4 + c) * T.K + k0 + 8 * r8) = o; }
}
__device__ __forceinline__ float lambda_init(int l) { return l == 0 ? 0.2f : (0.8f - 0.6f * 0.7408182206817179f); }

constexpr int CI_IN = 16 * 96, CI_OUT = 16 * 32, CI_UP1 = 16 * 8, CI_DN = 4 * 32, CN_UP = 32 * 2 * CI_UP1, CN_DN = 32 * CI_DN, NITEMS_L = CI_IN + CI_OUT + CN_UP + CN_DN;
__device__ __forceinline__ void fill_rowscale(Frame& F, const Args& A, int l, LAS float* rsl) {
    for (int k = F.tid; k < DM; k += 512) { float v = inp<I_MIXB>()[l * DM + k];
        if (k >= 512 && k < 768) v *= inp<I_SUBLN>()[l * 64 + ((k - 512) & 63)] * (1.f - lambda_init(l)); rsl[k] = v; }
}
__device__ __forceinline__ void convert_items(Frame& F, const Args& A, int l, int first, int stride, int limit, LAS float* rsl) {
    LAS float* scr = (LAS float*)(F.lds + F.wave * 8704);
    bf16* WIN = (bf16*)(F.ws + WS_WIN); bf16* WOUT = (bf16*)(F.ws + WS_WOUT); bf16* WUP = (bf16*)(F.ws + WS_WUP); bf16* WDN = (bf16*)(F.ws + WS_WDN);
    auto decode = [&](int it, TItem& T) {
        int r = it; T.rs = nullptr; T.mapin = 0;
        if (r < CI_IN) { T.kb = r / 96; const int nb = r % 96;
            T.W = inp<I_WIN>() + (size_t)l * DM * P_IN; T.ldw = P_IN; T.K = DM; T.WT = WIN + (size_t)l * NP * DM; T.dst_row0 = 32 * nb; T.src_n0 = 32 * nb; T.mapin = 1; return; }
        r -= CI_IN;
        if (r < CI_OUT) { T.kb = r / 32; const int nb = r % 32;
            T.W = inp<I_WOUT>() + (size_t)l * DM * DM; T.ldw = DM; T.K = DM; T.WT = WOUT + (size_t)l * DM * DM; T.dst_row0 = 32 * nb; T.src_n0 = 32 * nb; T.rs = (const float*)rsl; return; }
        r -= CI_OUT;
        if (r < CN_UP) { const int le = l * 32 + r / (2 * CI_UP1), q = r % (2 * CI_UP1), which = q / CI_UP1, q2 = q % CI_UP1; T.kb = q2 / 8; const int nb = q2 % 8;
            T.W = (which == 0 ? inp<I_W1>() : inp<I_W3>()) + (size_t)le * DM * FF; T.ldw = FF; T.K = DM; T.WT = WUP + (size_t)le * 512 * DM;
            const int n0 = 32 * nb, pn = n0 >> 7, j = n0 & 127; T.dst_row0 = 256 * pn + 128 * which + j; T.src_n0 = n0; return; }
        r -= CN_UP;
        { const int le = l * 32 + r / CI_DN, q = r % CI_DN; T.kb = q / 32; const int nb = q % 32;
          T.W = inp<I_W2>() + (size_t)le * FF * DM; T.ldw = DM; T.K = FF; T.WT = WDN + (size_t)le * DM * FF; T.dst_row0 = 32 * nb; T.src_n0 = 32 * nb; }
    };
    TItem T0, T1, T2; f32x4 v0[8], v1[8], v2[8]; int it = first;
    if (it < limit) { decode(it, T0); t_load(T0, v0, F.lane); }
    if (it + stride < limit) { decode(it + stride, T1); t_load(T1, v1, F.lane); }
    while (it < limit) {
        if (it + 2 * stride < limit) { decode(it + 2 * stride, T2); t_load(T2, v2, F.lane); }
        t_store(T0, v0, scr, F.lane); it += stride; if (it >= limit) break;
        if (it + 2 * stride < limit) { decode(it + 2 * stride, T0); t_load(T0, v0, F.lane); }
        t_store(T1, v1, scr, F.lane); it += stride; if (it >= limit) break;
        if (it + 2 * stride < limit) { decode(it + 2 * stride, T1); t_load(T1, v1, F.lane); }
        t_store(T2, v2, scr, F.lane); it += stride;
    }
}
constexpr int CV_L0 = NITEMS_L - CI_IN, CV_TOTAL = CV_L0 + NITEMS_L, CV_CHUNK = 64, CW_CVQ = 192;
__device__ __forceinline__ void convert_chunk(Frame& F, const Args& A, int gbase, LAS float* rsl2  ) {
    const int g0 = gbase + F.wave * (CV_CHUNK / NWAVES);
#pragma unroll 1
    for (int l = 0; l < 2; ++l) {
        const int lo = g0 > (l ? CV_L0 : 0) ? g0 : (l ? CV_L0 : 0), hi0 = g0 + CV_CHUNK / NWAVES, hi = hi0 < (l ? CV_TOTAL : CV_L0) ? hi0 : (l ? CV_TOTAL : CV_L0);
        if (lo < hi) { const int off = l ? -CV_L0 : CI_IN; convert_items(F, A, l, lo + off, 1, hi + off, rsl2 + l * DM); }
    }
}
__device__ __forceinline__ void convert_layer1_in_gap(Frame& F, const Args& A, int n2  ) {
    LAS float* rsl = (LAS float*)(F.lds + 8 * 8704);
    if (n2 < 0) n2 = 0; if (n2 > F.G - 32) n2 = F.G - 32;
    if (F.bx < n2) return;
    fill_rowscale(F, A, 1, rsl);
    __syncthreads();
    const int nw = (F.G - n2) * NWAVES;
    convert_items(F, A, 1, (F.bx - n2) * NWAVES + F.wave, nw, NITEMS_L, rsl);
    __syncthreads();
}

__device__ __forceinline__ void p0_prologue(Frame& F, const Args& A) {
    LAS float* rsl = (LAS float*)(F.lds + 8 * 8704);
    fill_rowscale(F, A, 0, rsl);
    __syncthreads();
    const int gw = F.vcu * NWAVES + F.wave, NGW = F.G * NWAVES;
    convert_items(F, A, 0, gw, NGW, BG_CONVERT ? CI_IN : NITEMS_L, rsl);
    if (!GAP_CONVERT && !BG_CONVERT) { __syncthreads(); fill_rowscale(F, A, 1, rsl); __syncthreads(); convert_items(F, A, 1, gw, NGW, NITEMS_L, rsl); }
    { bf16* WRH = (bf16*)(F.ws + WS_WR); bf16* WRL = WRH + 2 * 48 * DM;
      for (int i = gw * 64 + F.lane; i < 2 * 48 * DM; i += NGW * 64) { const int l = i / (48 * DM), r = i % (48 * DM), o = r >> 10, k = r & 1023;
          float w = 0.f; if (o < 4) w = inp<I_WG>()[((size_t)l * DM + k) * 4 + o]; else if (o < 36) w = inp<I_WE>()[((size_t)l * DM + k) * 32 + (o - 4)];
          const unsigned hi = f2bf(w); WRH[i] = (bf16)hi; WRL[i] = (bf16)f2bf(w - bf2f((unsigned short)hi)); } }
    if (F.bx == 0 && F.wave == 0) {
        for (int l = 0; l < 2; ++l) { float a = 0.f, b = 0.f; if (F.lane < 32) { a = inp<I_LQ1>()[l * 32 + F.lane] * inp<I_LK1>()[l * 32 + F.lane]; b = inp<I_LQ2>()[l * 32 + F.lane] * inp<I_LK2>()[l * 32 + F.lane]; }
            a = wave_sum(a); b = wave_sum(b); if (F.lane == 0) ((float*)(F.ws + WS_MISC))[l] = __expf(a) - __expf(b) + lambda_init(l); }
    }
    __syncthreads();
    LAS float* cact = (LAS float*)F.lds;
    LAS float* red = (LAS float*)(F.lds + 32768);
    for (int i = F.tid; i < BATCH * DM; i += 512) { const float c = inp<I_C>()[i]; cact[i] = c / (1.f + __expf(-c)); }
    __syncthreads();
    for (int item = F.bx; item < 2 * 96; item += F.G) {
        const int l = item / 96, nb = item % 96, n = nb * 64 + F.lane; const float* aw = inp<I_ADAW>() + (size_t)l * DM * 6144 + n;
        float acc[8];
#pragma unroll
        for (int b = 0; b < 8; ++b) acc[b] = 0.f;
        const int k0 = F.wave * 128;
#pragma unroll 32
        for (int k = 0; k < 128; ++k) { const float w = aw[(size_t)(k0 + k) * 6144];
#pragma unroll
            for (int b = 0; b < 8; ++b) acc[b] += cact[b * DM + k0 + k] * w; }
#pragma unroll
        for (int b = 0; b < 8; ++b) red[(F.wave * 8 + b) * 64 + F.lane] = acc[b];
        __syncthreads();
        { const int b = F.wave; float s = inp<I_ADAB>()[l * 6144 + n];
#pragma unroll
          for (int w = 0; w < 8; ++w) s += red[(w * 8 + b) * 64 + F.lane];
          ((float*)(F.ws + WS_MOD))[((size_t)l * 8 + b) * 6144 + n] = s; }
        __syncthreads();
    }
}

__device__ __forceinline__ void build_tables(Frame& F, int l) {
    volatile LAS int* cnts = (volatile LAS int*)(F.lds + CNTS_OFF); volatile LAS int* base = (volatile LAS int*)(F.lds + BASE_OFF); volatile LAS int* tab = (volatile LAS int*)(F.lds + TAB_OFF);
    __syncthreads();
    if (F.tid < 64) {
        const int e = F.tid; int cnt = 0; if (e < 32) cnt = (int)__hip_atomic_load(F.ctl + CW_CNT + (l * 32 + e) * 16, RLX_AGENT);
        const int n = (cnt + 255) >> 8; int incl = n;
#pragma unroll
        for (int o = 1; o < 32; o <<= 1) { const int u = shup_i(incl, o, e); if (e >= o) incl += u; }
        const int t0 = incl - n;
        if (e < 32) { cnts[e] = cnt; base[e] = t0; for (int j = 0; j < n && t0 + j < MAXTILE; ++j) tab[t0 + j] = e; }
        if (e == 31) F.MISC[1] = (unsigned)(incl < MAXTILE ? incl : MAXTILE);
    }
    __syncthreads();
}
__device__ __forceinline__ void row_pass(Frame& F, const Args& A, int mode, int l) {
    const int gw = F.vcu * NWAVES + F.wave; const int lane = F.lane;
    const float* MOD = (const float*)(F.ws + WS_MOD);
    bf16* X1 = (bf16*)(F.ws + WS_X1); bf16* H = (bf16*)(F.ws + WS_H); const bf16* Y = (const bf16*)(F.ws + WS_Y);
    const int* tok_e = (const int*)(F.ws + WS_TOK); const int* tok_pos = (const int*)(F.ws + WS_TOK) + 4 * M; const float* tok_w = (const float*)(F.ws + WS_TOK) + 2 * M;
    volatile LAS int* basel = (volatile LAS int*)(F.lds + BASE_OFF);
    if (mode != 0) build_tables(F, mode == 1 ? 0 : 1);
    const int b = (gw * 8) >> 11; const int lp = (mode == 1) ? 0 : 1;
    f32x4 g2v[4], gm[4], shv[4];
#pragma unroll
    for (int j = 0; j < 4; ++j) { const int col = 256 * j + 4 * lane;
        g2v[j] = (f32x4){0.f, 0.f, 0.f, 0.f}; gm[j] = g2v[j]; shv[j] = g2v[j];
        if (mode != 0) g2v[j] = *(const f32x4*)(MOD + ((size_t)lp * 8 + b) * 6144 + 5 * DM + col);
        if (mode != 2) { const float* md = MOD + ((size_t)l * 8 + b) * 6144; gm[j] = *(const f32x4*)(inp<I_N1G>() + l * DM + col) * (*(const f32x4*)(md + DM + col) + 1.0f); shv[j] = *(const f32x4*)(md + col); } }
    for (int m0 = gw * 8; m0 < gw * 8 + 8; m0 += 4) {
        f32x4 v[4][4]; u32x2 ya[4][4], yb[4][4]; float wa[4], wb[4];
        if (mode != 0) {
            int sa[4], sb[4];
#pragma unroll
            for (int r = 0; r < 4; ++r) { const int m = m0 + r; sa[r] = 256 * basel[tok_e[m]] + tok_pos[m]; sb[r] = 256 * basel[tok_e[M + m]] + tok_pos[M + m]; wa[r] = tok_w[m]; wb[r] = tok_w[M + m]; }
#pragma unroll
            for (int r = 0; r < 4; ++r)
#pragma unroll
                for (int j = 0; j < 4; ++j) { const int col = 256 * j + 4 * lane; ya[r][j] = *(const u32x2*)(Y + (size_t)sa[r] * DM + col); yb[r][j] = *(const u32x2*)(Y + (size_t)sb[r] * DM + col); }
        }
#pragma unroll
        for (int r = 0; r < 4; ++r) { const int m = m0 + r;
            if (mode == 0) { const float* xr = inp<I_X>() + (size_t)m * DM;
#pragma unroll
                for (int j = 0; j < 4; ++j) v[r][j] = *(const f32x4*)(xr + 256 * j + 4 * lane); }
            else { const bf16* xr = X1 + (size_t)m * DM;
#pragma unroll
                for (int j = 0; j < 4; ++j) { const u32x2 q = *(const u32x2*)(xr + 256 * j + 4 * lane); v[r][j] = (f32x4){bf2f(q.x & 0xffff), bf2f(q.x >> 16), bf2f(q.y & 0xffff), bf2f(q.y >> 16)}; } } }
#pragma unroll
        for (int r = 0; r < 4; ++r) { const int m = m0 + r;
            if (mode != 0) {
#pragma unroll
                for (int j = 0; j < 4; ++j) { const u32x2 a = ya[r][j], c = yb[r][j];
                    f32x4 mo; mo[0] = wa[r] * bf2f(a.x & 0xffff) + wb[r] * bf2f(c.x & 0xffff); mo[1] = wa[r] * bf2f(a.x >> 16) + wb[r] * bf2f(c.x >> 16);
                    mo[2] = wa[r] * bf2f(a.y & 0xffff) + wb[r] * bf2f(c.y & 0xffff); mo[3] = wa[r] * bf2f(a.y >> 16) + wb[r] * bf2f(c.y >> 16);
                    v[r][j] = v[r][j] + g2v[j] * mo; }
                if (mode == 1) {
#pragma unroll
                    for (int j = 0; j < 4; ++j) { u32x2 q; q.x = pk2(v[r][j][0], v[r][j][1]); q.y = pk2(v[r][j][2], v[r][j][3]); *(u32x2*)(X1 + (size_t)m * DM + 256 * j + 4 * lane) = q; }
                } else { float* orow = F.out + (size_t)m * DM;
#pragma unroll
                    for (int j = 0; j < 4; ++j) *(f32x4*)(orow + 256 * j + 4 * lane) = v[r][j]; }
            }
            if (mode != 2) {
                float ss = 0.f;
#pragma unroll
                for (int j = 0; j < 4; ++j) ss += (v[r][j][0] * v[r][j][0] + v[r][j][1] * v[r][j][1]) + (v[r][j][2] * v[r][j][2] + v[r][j][3] * v[r][j][3]);
                const float rstd = 1.0f / sqrtf(wave_sum(ss) * (1.f / DM) + RMS_EPS);
#pragma unroll
                for (int j = 0; j < 4; ++j) { const f32x4 hv = v[r][j] * rstd * gm[j] + shv[j]; u32x2 w; w.x = pk2(hv[0], hv[1]); w.y = pk2(hv[2], hv[3]);
                    *(u32x2*)(H + (size_t)m * DM + 256 * j + 4 * lane) = w; }
            }
        }
    }
}

__device__ __forceinline__ void knorm_seg(bf16* p, int lane, int nlanes_active, int group_lanes, const float* gain, int gmask, float inv_n) {
    u32x2 raw = (u32x2){0u, 0u}; if (lane < nlanes_active) raw = *(const u32x2*)(p + 4 * lane);
    float x0 = bf2f(raw.x & 0xffff), x1 = bf2f(raw.x >> 16), x2 = bf2f(raw.y & 0xffff), x3 = bf2f(raw.y >> 16);
    float ss = (x0 * x0 + x1 * x1) + (x2 * x2 + x3 * x3);
    for (int o = 1; o < group_lanes; o <<= 1) ss += __shfl_xor(ss, o);
    const float rstd = 1.0f / sqrtf(ss * inv_n + RMS_EPS);
    const int c = (4 * lane) & gmask;
    x0 *= rstd * gain[c]; x1 *= rstd * gain[c + 1]; x2 *= rstd * gain[c + 2]; x3 *= rstd * gain[c + 3];
    if (lane < nlanes_active) { u32x2 w; w.x = pk2(x0, x1); w.y = pk2(x2, x3); *(u32x2*)(p + 4 * lane) = w; }
}
__device__ __forceinline__ unsigned sortable(float f) { const unsigned u = __builtin_bit_cast(unsigned, f); return (u & 0x80000000u) ? ~u : (u | 0x80000000u); }


__device__ __forceinline__ int wave_sum_i(int v) {
    v += __builtin_amdgcn_update_dpp(0, v, 0xB1, 0xF, 0xF, true);
    v += __builtin_amdgcn_update_dpp(0, v, 0x4E, 0xF, 0xF, true);
    v += __builtin_amdgcn_update_dpp(0, v, 0x141, 0xF, 0xF, true);
    v += __builtin_amdgcn_update_dpp(0, v, 0x140, 0xF, 0xF, true);
    return __builtin_amdgcn_readlane(v, 0) + __builtin_amdgcn_readlane(v, 16) + __builtin_amdgcn_readlane(v, 32) + __builtin_amdgcn_readlane(v, 48);
}
__device__ __forceinline__ void transpose32(unsigned (&a)[32]) {
#define TSTAGE(S, MSK) _Pragma("unroll") for (int i = 0; i < 32; ++i) if (!(i & S)) { const unsigned x = a[i], y = a[i + S]; a[i] = (x & MSK) | ((y << S) & ~MSK); a[i + S] = ((x >> S) & MSK) | (y & ~MSK); }
    TSTAGE(16, 0x0000FFFFu) TSTAGE(8, 0x00FF00FFu) TSTAGE(4, 0x0F0F0F0Fu) TSTAGE(2, 0x33333333u) TSTAGE(1, 0x55555555u)
#undef TSTAGE
}
__device__ __forceinline__ void sel_step(unsigned T, unsigned& cand, unsigned& above, int& na, int& nc, bool& done, bool& exact) {
    const unsigned ones = cand & T; const int s1 = wave_sum_i(__builtin_popcount(ones));
    if (na + s1 >= 256) { cand = ones; nc = s1; }
    else { above |= ones; na += s1; cand &= ~T; nc -= s1; }
    if (na + nc == 256) { done = true; exact = true; }
}
__device__ __forceinline__ unsigned sel_finish(unsigned cand, unsigned above, int na, bool exact, int lane) {
    if (exact) return above | cand;
    const int need = 256 - na; const int pc = __builtin_popcount(cand); int incl = pc;
#pragma unroll
    for (int o = 1; o < 64; o <<= 1) { const int t = shup_i(incl, o, lane); if (lane >= o) incl += t; }
    int take = need - (incl - pc); take = take < 0 ? 0 : (take > pc ? pc : take);
    unsigned w = cand, res = above;
    for (int k = 0; k < take; ++k) { const unsigned low = w & (0u - w); res |= low; w ^= low; }
    return res;
}

__device__ __forceinline__ void p3_prep(Frame& F, const Args& A, int l, int rep) {
    const int gw = F.vcu * NWAVES + F.wave, NGW = F.G * NWAVES;
    bf16* PROJ = (bf16*)(F.ws + WS_PROJ);
    if (!(rep > 0 && PROBE_P3_PART == 2)) { const float* ga = inp<I_KNA>() + l * 64; const float* gc = inp<I_KNC>() + l * 32; const float* gd = inp<I_KND>() + l * 64;
      const int la = F.lane; const int ca = (4 * la) & 63, cc = (4 * la) & 31;
      const f32x4 gva = *(const f32x4*)(ga + ca), gvc = *(const f32x4*)(gc + cc), gvd = *(const f32x4*)(gd + ca);
      for (int mb = gw * 8; mb < gw * 8 + 8; mb += 8) {
        u32x2 ra[8], rc[8], rd[8];
#pragma unroll
        for (int i = 0; i < 8; ++i) { bf16* row = PROJ + (size_t)(mb + i) * NP; ra[i] = *(const u32x2*)(row + C_AK + 4 * la); rc[i] = *(const u32x2*)(row + C_CK + 4 * la);
            rd[i] = (u32x2){0u, 0u}; if (la < 16) rd[i] = *(const u32x2*)(row + C_DK + 4 * la); }
#pragma unroll
        for (int i = 0; i < 8; ++i) { bf16* row = PROJ + (size_t)(mb + i) * NP;
            { float x0 = bf2f(ra[i].x & 0xffff), x1 = bf2f(ra[i].x >> 16), x2 = bf2f(ra[i].y & 0xffff), x3 = bf2f(ra[i].y >> 16); float ss = (x0 * x0 + x1 * x1) + (x2 * x2 + x3 * x3);
              ss += shx<1>(ss); ss += shx<2>(ss); ss += shx<4>(ss); ss += shx<8>(ss); const float rs = 1.0f / sqrtf(ss * (1.f / 64.f) + RMS_EPS);
              u32x2 w; w.x = pk2(x0 * rs * gva[0], x1 * rs * gva[1]); w.y = pk2(x2 * rs * gva[2], x3 * rs * gva[3]); *(u32x2*)(row + C_AK + 4 * la) = w; }
            { float x0 = bf2f(rc[i].x & 0xffff), x1 = bf2f(rc[i].x >> 16), x2 = bf2f(rc[i].y & 0xffff), x3 = bf2f(rc[i].y >> 16); float ss = (x0 * x0 + x1 * x1) + (x2 * x2 + x3 * x3);
              ss += shx<1>(ss); ss += shx<2>(ss); ss += shx<4>(ss); const float rs = 1.0f / sqrtf(ss * (1.f / 32.f) + RMS_EPS);
              u32x2 w; w.x = pk2(x0 * rs * gvc[0], x1 * rs * gvc[1]); w.y = pk2(x2 * rs * gvc[2], x3 * rs * gvc[3]); *(u32x2*)(row + C_CK + 4 * la) = w; }
            { float x0 = bf2f(rd[i].x & 0xffff), x1 = bf2f(rd[i].x >> 16), x2 = bf2f(rd[i].y & 0xffff), x3 = bf2f(rd[i].y >> 16); float ss = (x0 * x0 + x1 * x1) + (x2 * x2 + x3 * x3);
              ss += shx<1>(ss); ss += shx<2>(ss); ss += shx<4>(ss); ss += shx<8>(ss); const float rs = 1.0f / sqrtf(ss * (1.f / 64.f) + RMS_EPS);
              u32x2 w; w.x = pk2(x0 * rs * gvd[0], x1 * rs * gvd[1]); w.y = pk2(x2 * rs * gvd[2], x3 * rs * gvd[3]); if (la < 16) *(u32x2*)(row + C_DK + 4 * la) = w; }
        }
      }
    }
    if (!(rep > 0 && PROBE_P3_PART == 2)) {
        const int bh = gw >> 6, ck = gw & 63, b = bh >> 2, h = bh & 3; const float bfv = inp<I_BF>()[l * 4 + h];
        const int t = 32 * ck + (F.lane & 31);
        const float x = bf2f(PROJ[((size_t)b * SEQ + t) * NP + C_AF + h]) + bfv;
        float incl = fminf(x, 0.f) - log1pf(__expf(-fabsf(x)));
#pragma unroll
        for (int o = 1; o < 32; o <<= 1) { const float u = shup(incl, o, F.lane); if ((F.lane & 31) >= o) incl += u; }
        float* cum = (float*)(F.ws + WS_CUM);
        if (F.lane < 32) cum[(size_t)bh * SEQ + t] = incl;
        if (F.lane == 31) cum[32 * SEQ + bh * 64 + ck] = incl;
    }
    LAS float* sc = (LAS float*)F.lds;
    unsigned* MASK = (unsigned*)(F.ws + WS_MASK);
    constexpr int SCP = 2052;
    const int lane = F.lane, kq = lane >> 4, qi = lane & 15;
    __syncthreads();
    bf16x8 bq[8], wvr, akv[16];
    const auto unit_geom = [&](int i, int& b, int& t0, int& nkt) { const int u = F.bx + 256 * i; b = u >> 7; const int tqr = u & 127, tq = (i & 1) ? 127 - tqr : tqr; t0 = tq * 16; nkt = tq + 1; };
    const auto unit_load_q = [&](int i) { int b, t0, nkt; unit_geom(i, b, t0, nkt); const bf16* qrow = PROJ + (size_t)b * SEQ * NP + (size_t)(t0 + qi) * NP;
#pragma unroll
        for (int h = 0; h < 8; ++h) bq[h] = *(const bf16x8*)(qrow + C_IQ + h * 32 + 8 * kq);
        wvr = *(const bf16x8*)(qrow + C_IW); };
    const auto unit_load_k = [&](int i) { int b, t0, nkt; unit_geom(i, b, t0, nkt); const bf16* pb = PROJ + (size_t)b * SEQ * NP;
#pragma unroll
        for (int j = 0; j < 16; ++j) { const int kt = F.wave + 8 * j; akv[j] = (bf16x8){0, 0, 0, 0, 0, 0, 0, 0}; if (kt < nkt) akv[j] = *(const bf16x8*)(pb + (size_t)(kt * 16 + qi) * NP + C_IK + 8 * kq); } };
    const bool do_c = !(rep > 0 && PROBE_P3_PART == 1);
    if (do_c) unit_load_q(0);
    for (int i = 0; i < 4; ++i) {
        if (!do_c) break;
        int b, t0, nkt; unit_geom(i, b, t0, nkt);
        unit_load_k(i);
        float wq[8];
#pragma unroll
        for (int h = 0; h < 8; ++h) wq[h] = bf2f((unsigned short)wvr[h]) * (0.35355339059327373f * 0.17677669529663687f);
#pragma unroll
        for (int j = 0; j < 16; ++j) { const int kt = F.wave + 8 * j;
            if (kt < nkt) {
            f32x4 a4 = (f32x4){0.f, 0.f, 0.f, 0.f};
#pragma unroll
            for (int h = 0; h < 8; ++h) { const f32x4 s = __builtin_amdgcn_mfma_f32_16x16x32_bf16(akv[j], bq[h], (f32x4){0.f, 0.f, 0.f, 0.f}, 0, 0, 0);
#pragma unroll
                for (int r = 0; r < 4; ++r) a4[r] += wq[h] * fmaxf(s[r], 0.f); }
#pragma unroll
            for (int r = 0; r < 4; ++r) a4[r] += 0.f;
            { const int ci = kt * 4 + kq, L = ci >> 3, c = ci & 7;
              *(LAS f32x4*)(sc + qi * SCP + 4 * (L * 8 + (c ^ (L & 7)))) = a4; }
            } }
        if (i + 1 < 4) unit_load_q(i + 1);
        LDS_WAIT(); __syncthreads();
        if (rep > 0 && PROBE_P3_PART == 2) { }
        else if (t0 < 256) {
            for (int rr = 0; rr < 2; ++rr) { const int t = t0 + 2 * F.wave + rr; const int nb = t - 32 * lane + 1;
                MASK[((size_t)b * SEQ + t) * 64 + lane] = nb >= 32 ? 0xffffffffu : (nb <= 0 ? 0u : ((1u << nb) - 1u)); }
        } else {
            const int rA = 2 * F.wave, tA = t0 + rA, tB = tA + 1;
            unsigned ua[32], ub[32];
#pragma unroll
            for (int c = 0; c < 8; ++c) { const int off = 4 * (lane * 8 + (c ^ (lane & 7)));
                const f32x4 fa = *(const LAS f32x4*)(sc + rA * SCP + off), fb = *(const LAS f32x4*)(sc + (rA + 1) * SCP + off);
#pragma unroll
                for (int i = 0; i < 4; ++i) { ua[c * 4 + i] = sortable(fa[i]); ub[c * 4 + i] = sortable(fb[i]); } }
            transpose32(ua); transpose32(ub);
            unsigned candA, candB, abA = 0u, abB = 0u; int naA = 0, naB = 0, ncA = tA + 1, ncB = tB + 1; bool dA = false, dB = false, eA = false, eB = false;
            { const int nbA = tA - 32 * lane + 1, nbB = tB - 32 * lane + 1;
              candA = nbA >= 32 ? 0xffffffffu : (nbA <= 0 ? 0u : ((1u << nbA) - 1u)); candB = nbB >= 32 ? 0xffffffffu : (nbB <= 0 ? 0u : ((1u << nbB) - 1u)); }
#pragma unroll
            for (int bit = 31; bit >= 0; --bit) {
                if (!dA) sel_step(ua[bit], candA, abA, naA, ncA, dA, eA);
                if (!dB) sel_step(ub[bit], candB, abB, naB, ncB, dB, eB);
                if (dA && dB) break;
            }
            MASK[((size_t)b * SEQ + tA) * 64 + lane] = sel_finish(candA, abA, naA, eA, lane);
            MASK[((size_t)b * SEQ + tB) * 64 + lane] = sel_finish(candB, abB, naB, eB, lane);
        }
        __syncthreads();
    }
}

namespace att {
template <bool B> struct BoolC { static constexpr bool value = B; };
constexpr int SLOTB = 8192, L_K = 0, L_V = 3 * SLOTB, L_WS = 6 * SLOTB, L_OST = L_WS + 2048, L_CUM = L_OST + 8 * 8192, L_END = L_CUM + 8192;
constexpr int MROW = 66;
static_assert(L_OST + 256 * MROW * 4 <= L_END && L_END <= RING_BYTES, "attention LDS map");
constexpr float THR = 8.0f;
__device__ __forceinline__ int crow(int r, int hi) { return (r & 3) + 8 * (r >> 2) + 4 * hi; }
__device__ __forceinline__ void glds16(const void* gsrc, unsigned lds_dst) { unsigned keep;
    asm volatile("s_mov_b32 %0, m0\n\ts_mov_b32 m0, %2\n\ts_nop 0\n\tglobal_load_lds_dwordx4 %1, off\n\ts_mov_b32 m0, %0" : "=&s"(keep) : "v"(gsrc), "s"(lds_dst) : "memory"); }
#define ATT_WAIT_BAR() asm volatile("s_waitcnt vmcnt(0) lgkmcnt(0)\n\ts_barrier" ::: "memory")
__device__ __forceinline__ unsigned cvtpk_s(float lo, float hi) { typedef __bf16 bf16x2_t __attribute__((ext_vector_type(2))); f32x2 v = {lo, hi}; bf16x2_t b = __builtin_convertvector(v, bf16x2_t); return __builtin_bit_cast(unsigned, b); }
__device__ __forceinline__ float xhalf(float x, int hi) { auto rr = __builtin_amdgcn_permlane32_swap(__builtin_bit_cast(unsigned, x), __builtin_bit_cast(unsigned, x), false, false);
    return __builtin_bit_cast(float, hi ? rr[0] : rr[1]); }
template <int DA, int DB>
__device__ __forceinline__ void qkt(f32x16& p0, f32x16& p1, const LAS char* Kslot, const bf16x8* qr, const f32x16& cin, int r32, int hi) {
    const LAS char* kb = Kslot + hi * 1024 + r32 * 16;
#pragma unroll
    for (int d0 = DA; d0 < DB; ++d0) {
        const bf16x8 b0 = *(const LAS bf16x8*)(kb + d0 * 2048), b1 = *(const LAS bf16x8*)(kb + d0 * 2048 + 512);
        if (d0 == DA) { p0 = __builtin_amdgcn_mfma_f32_32x32x16_bf16(b0, qr[d0], cin, 0, 0, 0); p1 = __builtin_amdgcn_mfma_f32_32x32x16_bf16(b1, qr[d0], cin, 0, 0, 0); }
        else { p0 = __builtin_amdgcn_mfma_f32_32x32x16_bf16(b0, qr[d0], p0, 0, 0, 0); p1 = __builtin_amdgcn_mfma_f32_32x32x16_bf16(b1, qr[d0], p1, 0, 0, 0); } }
}
__device__ __forceinline__ void pv(f32x16* o, int vb, bf16x8 pa0, bf16x8 pa1, bf16x8 pa2, bf16x8 pa3) {
    s16x4 lo[2][4], hi[2][4];
#pragma unroll
    for (int d0 = 0; d0 < 2; ++d0)
#pragma unroll
        for (int ks = 0; ks < 4; ++ks) {
            asm volatile("ds_read_b64_tr_b16 %0,%1 offset:%c2" : "=&v"(lo[d0][ks]) : "v"(vb), "i"(d0 * 4096 + ks * 1024) : "memory");
            asm volatile("ds_read_b64_tr_b16 %0,%1 offset:%c2" : "=&v"(hi[d0][ks]) : "v"(vb), "i"(d0 * 4096 + ks * 1024 + 512) : "memory"); }
    asm volatile("s_waitcnt lgkmcnt(0)" ::: "memory"); __builtin_amdgcn_sched_barrier(0);
#define PK(d, k) (bf16x8){lo[d][k][0], lo[d][k][1], lo[d][k][2], lo[d][k][3], hi[d][k][0], hi[d][k][1], hi[d][k][2], hi[d][k][3]}
    o[0] = __builtin_amdgcn_mfma_f32_32x32x16_bf16(pa0, PK(0, 0), o[0], 0, 0, 0); o[1] = __builtin_amdgcn_mfma_f32_32x32x16_bf16(pa0, PK(1, 0), o[1], 0, 0, 0);
    o[0] = __builtin_amdgcn_mfma_f32_32x32x16_bf16(pa1, PK(0, 1), o[0], 0, 0, 0); o[1] = __builtin_amdgcn_mfma_f32_32x32x16_bf16(pa1, PK(1, 1), o[1], 0, 0, 0);
    o[0] = __builtin_amdgcn_mfma_f32_32x32x16_bf16(pa2, PK(0, 2), o[0], 0, 0, 0); o[1] = __builtin_amdgcn_mfma_f32_32x32x16_bf16(pa2, PK(1, 2), o[1], 0, 0, 0);
    o[0] = __builtin_amdgcn_mfma_f32_32x32x16_bf16(pa3, PK(0, 3), o[0], 0, 0, 0); o[1] = __builtin_amdgcn_mfma_f32_32x32x16_bf16(pa3, PK(1, 3), o[1], 0, 0, 0);
#undef PK
}
__device__ __forceinline__ float rowmax(const f32x16& p0, const f32x16& p1, int hi) {
    float a = fmaxf(fmaxf(p0[0], p0[1]), p1[0]), b = fmaxf(fmaxf(p0[2], p0[3]), p1[1]); a = fmaxf(fmaxf(a, p1[2]), p1[3]);
#pragma unroll
    for (int r = 4; r < 16; r += 4) { a = fmaxf(fmaxf(a, p0[r]), p0[r + 1]); b = fmaxf(fmaxf(b, p0[r + 2]), p0[r + 3]); a = fmaxf(fmaxf(a, p1[r]), p1[r + 1]); b = fmaxf(fmaxf(b, p1[r + 2]), p1[r + 3]); }
    const float m = fmaxf(a, b); return fmaxf(m, xhalf(m, hi));
}
struct AttnP { const bf16* proj; bf16* mix; const float* cum; const unsigned* mask; const float* qgain[4]; const float* kgain[4]; float lam; };

template <int VAR>
__device__ __forceinline__ void attn_unit(const AttnP& P, int b, int h, int qb, LAS char* sh, const int tid_in, const int pm, unsigned* qctr, volatile LAS unsigned* qslot) {
    int tid = tid_in; asm volatile("" : "+v"(tid));
    const int lane = tid & 63, r32 = lane & 31, hi = lane >> 5; const int wid = __builtin_amdgcn_readfirstlane(tid >> 6);
    const long rowbase = (long)b * SEQ; const int q0 = qb * 256, NT = 4 * (qb + 1);
    const int qrel = wid * 32 + r32, tq = q0 + qrel;
    constexpr bool REV = VAR != 0;
    constexpr int QCB = VAR == 0 ? C_AQ : VAR == 1 ? C_BQ : VAR == 2 ? C_CQ : C_DQ;
    constexpr int KCB = VAR == 0 ? C_AK : VAR == 1 ? C_BK : VAR == 2 ? C_CK : C_DK;
    constexpr int VCB = VAR == 0 ? C_AV : VAR == 1 ? C_BV : VAR == 2 ? C_CV : C_DV;
    const int Qc = QCB + 64 * h, Kc = VAR == 3 ? KCB : KCB + 64 * h, Vc = VAR == 3 ? VCB : VCB + 64 * h;
    const bf16* PR = P.proj;
    LAS float* wsf = (LAS float*)(sh + L_WS) + wid * 64;
    LAS float* stg = (LAS float*)(sh + L_OST) + wid * 2048;
    LAS float* cumL = (LAS float*)(sh + L_CUM);
    LAS unsigned* maskL = (LAS unsigned*)(sh + L_OST);
    const unsigned lds0 = (unsigned)(uintptr_t)sh;
    const bf16* ksrc = PR + (size_t)(rowbase + lane) * NP + Kc + wid * 8;
    const bf16* vsrc = PR + (size_t)(rowbase + 16 * (wid & 3) + (lane >> 2)) * NP + Vc + (wid >> 2) * 32 + (lane & 3) * 8;
    const unsigned kdst = lds0 + L_K + wid * 1024, vdst = lds0 + L_V + wid * 1024;
#define DMA_KV(t, slot) do { glds16(ksrc + (size_t)(t) * 64 * NP, (unsigned)__builtin_amdgcn_readfirstlane(kdst + (slot))); glds16(vsrc + (size_t)(t) * 64 * NP, (unsigned)__builtin_amdgcn_readfirstlane(vdst + (slot))); } while (0)
    DMA_KV(REV ? NT - 1 : 0, 0); DMA_KV(REV ? NT - 2 : 1, SLOTB);
    if (VAR == 0) {
        LAS float* pref = (LAS float*)(sh + L_WS);
        if (tid < 64) { const float ct = P.cum[32 * SEQ + (b * 4 + h) * 64 + tid]; float incl = ct;
#pragma unroll
            for (int o = 1; o < 64; o <<= 1) { const float u = shup(incl, o, tid); if (tid >= o) incl += u; }
            pref[tid] = incl - ct; }
        asm volatile("s_waitcnt lgkmcnt(0)\n\ts_barrier" ::: "memory");
        const float* cg = P.cum + (size_t)(b * 4 + h) * SEQ; for (int i = tid; i < q0 + 256; i += 512) cumL[i] = (cg[i] + pref[i >> 5]) * LOG2E;
        asm volatile("s_waitcnt lgkmcnt(0)\n\ts_barrier" ::: "memory");
    }
    if (VAR == 3) { const unsigned* mg = P.mask + (size_t)(rowbase + q0) * 64; const int nw = 2 * NT;
        for (int i = tid; i < 256 * 64; i += 512) { const int row = i >> 6, w = i & 63; if (w < nw) maskL[row * MROW + w] = mg[i]; } }
    asm volatile("s_waitcnt vmcnt(0) lgkmcnt(0)\n\ts_barrier" ::: "memory");
    const int vb0 = (int)(lds0 + L_V) + ((lane >> 4) & 1) * 32 + (lane & 3) * 8 + (4 * hi + ((lane & 15) >> 2)) * 64;
    float slope2 = 0.f;
    if (VAR == 2) slope2 = __builtin_amdgcn_exp2f(-(float)(2 * h + 1)) * LOG2E;
    if (VAR == 3) slope2 = __builtin_amdgcn_exp2f(-(float)(2 * h + 2)) * LOG2E;
    float cumt = 0.f; if (VAR == 0) cumt = cumL[tq];
    constexpr int NPASS = VAR == 2 ? 2 : 1;
    unsigned nxt_u = 0u;
    for (int pass = 0; pass < NPASS; ++pass) {
        bf16x8 qa[4]; float sb0 = 0.f;
        { const bf16* Qw = PR + (size_t)(rowbase + tq) * NP + Qc;
          constexpr int ND0 = VAR == 2 ? 2 : 4; const int dbase = VAR == 2 ? 2 * pass : 0;
          float qf[8 * ND0];
#pragma unroll
          for (int d0 = 0; d0 < ND0; ++d0) { const bf16x8 raw = *(const bf16x8*)(Qw + (dbase + d0) * 16 + hi * 8);
#pragma unroll
              for (int j = 0; j < 8; ++j) qf[d0 * 8 + j] = bf2f((unsigned short)raw[j]); }
          constexpr float SC = (VAR == 2 ? 0.17677669529663687f : 0.125f) * LOG2E;
          if (VAR != 1) {
              float ss = 0.f;
#pragma unroll
              for (int i = 0; i < 8 * ND0; ++i) ss += qf[i] * qf[i];
              ss += xhalf(ss, hi); const float rstd = 1.0f / sqrtf(ss * (VAR == 2 ? 1.f / 32.f : 1.f / 64.f) + RMS_EPS);
              const float* g = P.qgain[VAR];
#pragma unroll
              for (int d0 = 0; d0 < ND0; ++d0)
#pragma unroll
                  for (int j = 0; j < 8; ++j) qf[d0 * 8 + j] *= rstd * g[16 * d0 + 8 * hi + j] * SC;
          } else {
#pragma unroll
              for (int i = 0; i < 8 * ND0; ++i) qf[i] *= SC;
          }
          if (VAR == 2 || VAR == 3) {
              float n0 = 0.f;
#pragma unroll
              for (int i = 0; i < 8 * ND0; ++i) n0 += qf[i] * qf[i];
              n0 += xhalf(n0, hi);
              float gk = fabsf(P.kgain[VAR][lane & (VAR == 2 ? 31 : 63)]);
              gk = fmaxf(gk, shx<1>(gk)); gk = fmaxf(gk, shx<2>(gk)); gk = fmaxf(gk, shx<4>(gk)); gk = fmaxf(gk, shx<8>(gk)); gk = fmaxf(gk, shx<16>(gk)); gk = half_max(gk);
              sb0 = 1.02f * sqrtf(n0) * (VAR == 2 ? 5.656854249f : 8.0f) * gk;
          }
#pragma unroll
          for (int d0 = 0; d0 < ND0; ++d0) { u32x4 w; w.x = cvtpk_s(qf[d0 * 8 + 0], qf[d0 * 8 + 1]); w.y = cvtpk_s(qf[d0 * 8 + 2], qf[d0 * 8 + 3]); w.z = cvtpk_s(qf[d0 * 8 + 4], qf[d0 * 8 + 5]); w.w = cvtpk_s(qf[d0 * 8 + 6], qf[d0 * 8 + 7]);
              qa[d0] = __builtin_bit_cast(bf16x8, w); }
          if (VAR == 2) { qa[2] = qa[0]; qa[3] = qa[1]; }
        }
        float mhat = -1e30f, l_reg = 0.f, Rp = 1.f; f32x16 o[2]; const float sbound = sb0;
#pragma unroll
        for (int r = 0; r < 16; ++r) { o[0][r] = 0.f; o[1][r] = 0.f; }
        if (pass > 0) { DMA_KV(REV ? NT - 1 : 0, 0); DMA_KV(REV ? NT - 2 : 1, SLOTB); }
        int cur = 0, sl1 = SLOTB, sl2 = 2 * SLOTB;
        auto step = [&](auto band_c, const int it) -> bool {
            constexpr bool BAND = decltype(band_c)::value;
            const int t = REV ? NT - 1 - it : it;
            if (pm == 7) { }
            else if (it + 1 < NT) asm volatile("s_waitcnt vmcnt(2) lgkmcnt(0)\n\ts_barrier" ::: "memory");
            else ATT_WAIT_BAR();
            if (REV && it > 0) {
                const LAS unsigned* wz = (const LAS unsigned*)(sh + L_END) + ((it - 1) & 1) * 8;
                const u32x4 z0 = *(const LAS u32x4*)wz, z1 = *(const LAS u32x4*)(wz + 4);
                if (__builtin_amdgcn_readfirstlane((int)(z0.x & z0.y & z0.z & z0.w & z1.x & z1.y & z1.z & z1.w)) != 0) return true;
            }
            if (it + 2 < NT && pm != 7) DMA_KV(REV ? t - 2 : t + 2, sl2);
            const int jb = t - (NT - 4);
            float cinv = 0.f;
            if (VAR == 0) cinv = cumt;
            if (VAR == 2 || VAR == 3) cinv = slope2 * (float)(t * 64 + 4 * hi - tq);
            f32x16 cin;
#pragma unroll
            for (int r = 0; r < 16; ++r) cin[r] = cinv;
            f32x16 p0, p1;
            const LAS char* Ks = sh + L_K + cur;
            if (VAR == 2) { if (pass == 0) { const bf16x8 qq[4] = {qa[0], qa[1], qa[0], qa[1]}; qkt<0, 2>(p0, p1, Ks, qq, cin, r32, hi); }
                            else { const bf16x8 qq[4] = {qa[0], qa[1], qa[0], qa[1]}; qkt<2, 4>(p0, p1, Ks, qq, cin, r32, hi); } }
            else qkt<0, 4>(p0, p1, Ks, qa, cin, r32, hi);
            if (VAR != 1) {
                if (VAR == 0) { const LAS float* cp = cumL + t * 64 + 4 * hi;
#pragma unroll
                    for (int g = 0; g < 4; ++g) { const f32x4 c0 = *(const LAS f32x4*)(cp + 8 * g), c1 = *(const LAS f32x4*)(cp + 32 + 8 * g);
#pragma unroll
                        for (int i = 0; i < 4; ++i) { p0[4 * g + i] -= c0[i]; p1[4 * g + i] -= c1[i]; } } }
                if (VAR == 2 || VAR == 3) {
#pragma unroll
                    for (int r = 0; r < 16; ++r) { const float kc = (float)((r & 3) + 8 * (r >> 2)); p0[r] += slope2 * kc; p1[r] += slope2 * (kc + 32.f); } }
                if (VAR != 3) { if constexpr (BAND) { const int kb = 64 * jb + 4 * hi;
#pragma unroll
                    for (int r = 0; r < 16; ++r) { const int kv = kb + (r & 3) + 8 * (r >> 2); if (kv > qrel) p0[r] = -INFINITY; if (kv + 32 > qrel) p1[r] = -INFINITY; } } }
                else { const u32x2 mw = *(const LAS u32x2*)(maskL + qrel * MROW + 2 * t); const unsigned w0 = mw.x >> (4 * hi), w1 = mw.y >> (4 * hi);
#pragma unroll
                    for (int r = 0; r < 16; ++r) { const int c = (r & 3) + 8 * (r >> 2); if (!((w0 >> c) & 1u)) p0[r] = -INFINITY; if (!((w1 >> c) & 1u)) p1[r] = -INFINITY; } }
                const float rm = rowmax(p0, p1, hi);
                if (__any(rm - mhat > THR)) {
                    const float mn = fmaxf(mhat, rm); const float f = __builtin_amdgcn_exp2f(mhat - mn); mhat = mn; l_reg *= f;
                    if (hi == 0) wsf[r32] = f;
#pragma unroll
                    for (int r = 0; r < 16; ++r) { const float fr = wsf[crow(r, hi)]; o[0][r] *= fr; o[1][r] *= fr; }
                }
                float sa4[4] = {0.f, 0.f, 0.f, 0.f};
#pragma unroll
                for (int r = 0; r < 16; ++r) { p0[r] = __builtin_amdgcn_exp2f(p0[r] - mhat); p1[r] = __builtin_amdgcn_exp2f(p1[r] - mhat); sa4[r & 3] += p0[r] + p1[r]; }
                l_reg += (sa4[0] + sa4[1]) + (sa4[2] + sa4[3]);
                if (VAR == 2 || VAR == 3) {
                    const float ub = sbound - slope2 * (float)(tq - 64 * t + 1) - mhat;
                    const bool dead = __all(ub < -150.f); if (lane == 0) ((LAS unsigned*)(sh + L_END))[(it & 1) * 8 + wid] = dead ? 1u : 0u;
                }
            } else {
                f32x16 m0, m1;
#pragma unroll
                for (int r = 0; r < 16; ++r) {
                    { const float s = __builtin_amdgcn_fmed3f(p0[r], -64.f, 64.f); const float e = __builtin_amdgcn_exp2f(-s); const float bt = __builtin_amdgcn_rcpf(1.f + e); p0[r] = bt; m0[r] = e * bt; }
                    { const float s = __builtin_amdgcn_fmed3f(p1[r], -64.f, 64.f); const float e = __builtin_amdgcn_exp2f(-s); const float bt = __builtin_amdgcn_rcpf(1.f + e); p1[r] = bt; m1[r] = e * bt; } }
                if constexpr (BAND) { const int kb = 64 * jb + 4 * hi;
#pragma unroll
                    for (int r = 0; r < 16; ++r) { const int kv = kb + (r & 3) + 8 * (r >> 2);
                        if (kv >= qrel) { p0[r] = 0.f; m0[r] = 1.f; } if (kv + 32 >= qrel) { p1[r] = 0.f; m1[r] = 1.f; } } }
                float gp[8], gq[8], ex[8];
#pragma unroll
                for (int g = 0; g < 4; ++g) { gp[g] = (m0[4 * g] * m0[4 * g + 1]) * (m0[4 * g + 2] * m0[4 * g + 3]); gp[4 + g] = (m1[4 * g] * m1[4 * g + 1]) * (m1[4 * g + 2] * m1[4 * g + 3]); }
#pragma unroll
                for (int g = 0; g < 8; ++g) gq[g] = xhalf(gp[g], hi);
                float sp = Rp;
#pragma unroll
                for (int g = 7; g >= 0; --g) { ex[g] = hi ? sp : sp * gq[g]; sp *= gp[g] * gq[g]; }
                Rp = sp;
                { const bool allz = !__any(Rp != 0.f); if (lane == 0) ((LAS unsigned*)(sh + L_END))[(it & 1) * 8 + wid] = allz ? 1u : 0u; }
#pragma unroll
                for (int g = 0; g < 4; ++g) {
                    { float c = ex[g]; const float w3 = p0[4 * g + 3] * c; c *= m0[4 * g + 3]; const float w2 = p0[4 * g + 2] * c; c *= m0[4 * g + 2]; const float w1 = p0[4 * g + 1] * c; c *= m0[4 * g + 1]; const float w0 = p0[4 * g] * c;
                      p0[4 * g] = w0; p0[4 * g + 1] = w1; p0[4 * g + 2] = w2; p0[4 * g + 3] = w3; }
                    { float c = ex[4 + g]; const float w3 = p1[4 * g + 3] * c; c *= m1[4 * g + 3]; const float w2 = p1[4 * g + 2] * c; c *= m1[4 * g + 2]; const float w1 = p1[4 * g + 1] * c; c *= m1[4 * g + 1]; const float w0 = p1[4 * g] * c;
                      p1[4 * g] = w0; p1[4 * g + 1] = w1; p1[4 * g + 2] = w2; p1[4 * g + 3] = w3; } }
            }
            u32x4 pw0, pw1, pw2, pw3;
            pw0 = (u32x4){cvtpk_s(p0[0], p0[1]), cvtpk_s(p0[2], p0[3]), cvtpk_s(p0[4], p0[5]), cvtpk_s(p0[6], p0[7])};
            pw1 = (u32x4){cvtpk_s(p0[8], p0[9]), cvtpk_s(p0[10], p0[11]), cvtpk_s(p0[12], p0[13]), cvtpk_s(p0[14], p0[15])};
            pw2 = (u32x4){cvtpk_s(p1[0], p1[1]), cvtpk_s(p1[2], p1[3]), cvtpk_s(p1[4], p1[5]), cvtpk_s(p1[6], p1[7])};
            pw3 = (u32x4){cvtpk_s(p1[8], p1[9]), cvtpk_s(p1[10], p1[11]), cvtpk_s(p1[12], p1[13]), cvtpk_s(p1[14], p1[15])};
            pv(o, vb0 + cur, __builtin_bit_cast(bf16x8, pw0), __builtin_bit_cast(bf16x8, pw1), __builtin_bit_cast(bf16x8, pw2), __builtin_bit_cast(bf16x8, pw3));
            { const int tmp = cur; cur = sl1; sl1 = sl2; sl2 = tmp; }
            return false;
        };
        if (REV) { bool ex = false; int it = 0;
            for (; it < 4 && !ex; ++it) ex = step(BoolC<true>{}, it);
            for (; it < NT && !ex; ++it) ex = step(BoolC<false>{}, it); }
        else { int it = 0;
            for (; it < NT - 4; ++it) (void)step(BoolC<false>{}, it);
            for (; it < NT; ++it) (void)step(BoolC<true>{}, it); }
        ATT_WAIT_BAR();
        if (pass == NPASS - 1 && tid == 0) nxt_u = __hip_atomic_fetch_add(qctr, 1u, RLX_AGENT);
        float rli[16];
        if (VAR != 1) {
            l_reg += xhalf(l_reg, hi);
            if (hi == 0) wsf[32 + r32] = l_reg;
#pragma unroll
            for (int r = 0; r < 16; ++r) rli[r] = __builtin_amdgcn_rcpf(wsf[32 + crow(r, hi)]);
        } else {
#pragma unroll
            for (int r = 0; r < 16; ++r) rli[r] = 1.f;
        }
#pragma unroll
        for (int r = 0; r < 16; ++r) { const int orow = crow(r, hi);
#pragma unroll
            for (int d0 = 0; d0 < 2; ++d0) { const float val = o[d0][r] * rli[r]; LAS float* sp = stg + orow * 64 + d0 * 32 + r32;
                if (VAR == 2 && pass == 1) *sp = *sp - P.lam * val; else *sp = val; } }
    }
    LDS_WAIT();
    bf16* Ow = P.mix + (size_t)(rowbase + q0 + wid * 32) * DM + VAR * 256 + h * 64;
#pragma unroll
    for (int i = 0; i < 4; ++i) { const int row = i * 8 + (lane >> 3), ch = lane & 7;
        const f32x4 a = *(const LAS f32x4*)(stg + row * 64 + ch * 8), c = *(const LAS f32x4*)(stg + row * 64 + ch * 8 + 4);
        float sc = 1.f;
        if (VAR == 2) { float ss = (a[0] * a[0] + a[1] * a[1]) + (a[2] * a[2] + a[3] * a[3]) + (c[0] * c[0] + c[1] * c[1]) + (c[2] * c[2] + c[3] * c[3]);
            ss += shx<1>(ss); ss += shx<2>(ss); ss += shx<4>(ss); sc = 1.0f / sqrtf(ss * (1.f / 64.f) + RMS_EPS); }
        u32x4 w; w.x = cvtpk_s(a[0] * sc, a[1] * sc); w.y = cvtpk_s(a[2] * sc, a[3] * sc); w.z = cvtpk_s(c[0] * sc, c[1] * sc); w.w = cvtpk_s(c[2] * sc, c[3] * sc);
        if (pm == 0 || (w.x == 0x12345678u && w.y == 0x9abcdef0u)) *(u32x4*)(Ow + (size_t)row * DM + ch * 8) = w; }
    if (tid == 0) *qslot = nxt_u;
    asm volatile("s_waitcnt lgkmcnt(0)\n\ts_barrier" ::: "memory");
#undef DMA_KV
}
typedef __attribute__((address_space(3))) const char* lds_cptr;
typedef short v4i16_t __attribute__((ext_vector_type(4)));
__device__ __forceinline__ s16x4 vtr(lds_cptr p) { return __builtin_bit_cast(s16x4, __builtin_amdgcn_ds_read_tr16_b64_v4i16((__attribute__((address_space(3))) v4i16_t*)p)); }
template <int VAR>
__device__ __forceinline__ void attn_unit2(const AttnP& P, int b, int h, int qb, LAS char* sh, const int tid_in, unsigned* qctr, volatile LAS unsigned* qslot) {
    static_assert(VAR == 0 || VAR == 2 || VAR == 3, "softmax mixers only");
    int tid = tid_in; asm volatile("" : "+v"(tid));
    const int lane = tid & 63, r32 = lane & 31, hi = lane >> 5; const int wid = __builtin_amdgcn_readfirstlane(tid >> 6);
    const long rowbase = (long)b * SEQ; const int q0 = qb * 256, NT = 4 * (qb + 1);
    const int qrel = wid * 32 + r32, tq = q0 + qrel;
    constexpr int QCB = VAR == 0 ? C_AQ : VAR == 1 ? C_BQ : VAR == 2 ? C_CQ : C_DQ;
    constexpr int KCB = VAR == 0 ? C_AK : VAR == 1 ? C_BK : VAR == 2 ? C_CK : C_DK;
    constexpr int VCB = VAR == 0 ? C_AV : VAR == 1 ? C_BV : VAR == 2 ? C_CV : C_DV;
    const int Qc = QCB + 64 * h, Kc = VAR == 3 ? KCB : KCB + 64 * h, Vc = VAR == 3 ? VCB : VCB + 64 * h;
    const bf16* PR = P.proj;
    LAS float* wsf = (LAS float*)(sh + L_WS) + wid * 64;
    LAS float* stg = (LAS float*)(sh + L_OST) + wid * 2048;
    LAS float* cumL = (LAS float*)(sh + L_CUM);
    LAS unsigned* maskL = (LAS unsigned*)(sh + L_OST);
    const unsigned lds0 = (unsigned)(uintptr_t)sh;
    const bf16* ksrc = PR + (size_t)(rowbase + lane) * NP + Kc + wid * 8;
    const bf16* vsrc = PR + (size_t)(rowbase + 16 * (wid & 3) + (lane >> 2)) * NP + Vc + (wid >> 2) * 32 + (lane & 3) * 8;
    const unsigned kdst = lds0 + L_K + wid * 1024, vdst = lds0 + L_V + wid * 1024;
#define TILE2(j) (NT - 1 - (j))
#define DMA_K2(j, slot) glds16(ksrc + (size_t)TILE2(j) * 64 * NP, (unsigned)__builtin_amdgcn_readfirstlane(kdst + (slot)))
#define DMA_V2(j, slot) glds16(vsrc + (size_t)TILE2(j) * 64 * NP, (unsigned)__builtin_amdgcn_readfirstlane(vdst + (slot)))
    DMA_K2(0, 0); DMA_K2(1, SLOTB); DMA_V2(0, 0);
    if (VAR == 0) {
        LAS float* pref = (LAS float*)(sh + L_WS);
        if (tid < 64) { const float ct = P.cum[32 * SEQ + (b * 4 + h) * 64 + tid]; float incl = ct;
#pragma unroll
            for (int o = 1; o < 64; o <<= 1) { const float u = shup(incl, o, tid); if (tid >= o) incl += u; }
            pref[tid] = incl - ct; }
        asm volatile("s_waitcnt lgkmcnt(0)\n\ts_barrier" ::: "memory");
        const float* cg = P.cum + (size_t)(b * 4 + h) * SEQ; for (int i = tid; i < q0 + 256; i += 512) cumL[i] = (cg[i] + pref[i >> 5]) * LOG2E;
        asm volatile("s_waitcnt lgkmcnt(0)\n\ts_barrier" ::: "memory");
    }
    if (VAR == 3) { const unsigned* mg = P.mask + (size_t)(rowbase + q0) * 64; const int nw = 2 * NT;
        for (int i = tid; i < 256 * 64; i += 512) { const int row = i >> 6, w = i & 63; if (w < nw) maskL[row * MROW + w] = mg[i]; } }
    asm volatile("s_waitcnt vmcnt(0) lgkmcnt(0)\n\ts_barrier" ::: "memory");
    const lds_cptr shc = (lds_cptr)sh;
    const lds_cptr kp0 = shc + L_K + hi * 1024 + r32 * 16;
    const lds_cptr vp0 = shc + L_V + ((lane >> 4) & 1) * 32 + (lane & 3) * 8 + (4 * hi + ((lane & 15) >> 2)) * 64;
    float slope2 = 0.f;
    if (VAR == 2) slope2 = __builtin_amdgcn_exp2f(-(float)(2 * h + 1)) * LOG2E;
    if (VAR == 3) slope2 = __builtin_amdgcn_exp2f(-(float)(2 * h + 2)) * LOG2E;
    float cumt = 0.f; if (VAR == 0) cumt = cumL[tq];
    constexpr int NPASS = VAR == 2 ? 2 : 1;
    unsigned nxt_u = 0u;
    const auto slot3 = [](int j) { return (j % 3) * SLOTB; };
#define SB2() __builtin_amdgcn_sched_barrier(0)
#define PINV(x) asm volatile("" : "+v"(x))
#define MF32(a, b, c) __builtin_amdgcn_mfma_f32_32x32x16_bf16(a, b, c, 0, 0, 0)
#define ATT_BARN(N) do { asm volatile("s_waitcnt vmcnt(" #N ") lgkmcnt(0)\n\ts_barrier" ::: "memory"); SB2(); } while (0)
#define PKW(Pv, i) cvtpk_s(Pv[i], Pv[(i) + 1])
#define PAF(k) __builtin_bit_cast(bf16x8, pw##k)
#define VFR(i) (bf16x8){vlo[i][0], vlo[i][1], vlo[i][2], vlo[i][3], vhi[i][0], vhi[i][1], vhi[i][2], vhi[i][3]}
#define VRD(i) do { vlo[i] = vtr(vp_ + (((i) >> 2) * 4096 + ((i) & 3) * 1024)); vhi[i] = vtr(vp_ + (((i) >> 2) * 4096 + ((i) & 3) * 1024 + 512)); } while (0)
#define EX2(v) __builtin_amdgcn_exp2f(v)
#define GAPA(MF, Pv, i, PW, w) do { MF; sacc += Pv[i]; sacc += Pv[(i) + 1]; sacc += Pv[(i) + 2]; sacc += Pv[(i) + 3]; PINV(sacc); PW[w] = PKW(Pv, i); PW[(w) + 1] = PKW(Pv, (i) + 2); PINV(PW); SB2(); } while (0)
#define GAPA8(MF, Pv, i, PW) do { MF; sacc += Pv[i]; sacc += Pv[(i) + 1]; sacc += Pv[(i) + 2]; sacc += Pv[(i) + 3]; sacc += Pv[(i) + 4]; sacc += Pv[(i) + 5]; sacc += Pv[(i) + 6]; sacc += Pv[(i) + 7]; PINV(sacc); \
        PW[0] = PKW(Pv, i); PW[1] = PKW(Pv, (i) + 2); PW[2] = PKW(Pv, (i) + 4); PW[3] = PKW(Pv, (i) + 6); PINV(PW); SB2(); } while (0)
#define GAPB(MF, X, i) do { MF; X[i] = EX2(X[i]); X[(i) + 1] = EX2(X[(i) + 1]); X[(i) + 2] = EX2(X[(i) + 2]); X[(i) + 3] = EX2(X[(i) + 3]); PINV(X); SB2(); } while (0)
    for (int pass = 0; pass < NPASS; ++pass) {
        bf16x8 qa[4]; float sb0 = 0.f;
        { const bf16* Qw = PR + (size_t)(rowbase + tq) * NP + Qc;
          constexpr int ND0 = VAR == 2 ? 2 : 4; const int dbase = VAR == 2 ? 2 * pass : 0;
          float qf[8 * ND0];
#pragma unroll
          for (int d0 = 0; d0 < ND0; ++d0) { const bf16x8 raw = *(const bf16x8*)(Qw + (dbase + d0) * 16 + hi * 8);
#pragma unroll
              for (int j = 0; j < 8; ++j) qf[d0 * 8 + j] = bf2f((unsigned short)raw[j]); }
          constexpr float SC = (VAR == 2 ? 0.17677669529663687f : 0.125f) * LOG2E;
          if (VAR != 1) {
              float ss = 0.f;
#pragma unroll
              for (int i = 0; i < 8 * ND0; ++i) ss += qf[i] * qf[i];
              ss += xhalf(ss, hi); const float rstd = 1.0f / sqrtf(ss * (VAR == 2 ? 1.f / 32.f : 1.f / 64.f) + RMS_EPS);
              const float* g = P.qgain[VAR];
#pragma unroll
              for (int d0 = 0; d0 < ND0; ++d0)
#pragma unroll
                  for (int j = 0; j < 8; ++j) qf[d0 * 8 + j] *= rstd * g[16 * d0 + 8 * hi + j] * SC;
          } else {
#pragma unroll
              for (int i = 0; i < 8 * ND0; ++i) qf[i] *= SC;
          }
          if (VAR == 2 || VAR == 3) {
              float n0 = 0.f;
#pragma unroll
              for (int i = 0; i < 8 * ND0; ++i) n0 += qf[i] * qf[i];
              n0 += xhalf(n0, hi);
              float gk = fabsf(P.kgain[VAR][lane & (VAR == 2 ? 31 : 63)]);
              gk = fmaxf(gk, shx<1>(gk)); gk = fmaxf(gk, shx<2>(gk)); gk = fmaxf(gk, shx<4>(gk)); gk = fmaxf(gk, shx<8>(gk)); gk = fmaxf(gk, shx<16>(gk)); gk = half_max(gk);
              sb0 = 1.02f * sqrtf(n0) * (VAR == 2 ? 5.656854249f : 8.0f) * gk;
          }
#pragma unroll
          for (int d0 = 0; d0 < ND0; ++d0) { u32x4 w; w.x = cvtpk_s(qf[d0 * 8 + 0], qf[d0 * 8 + 1]); w.y = cvtpk_s(qf[d0 * 8 + 2], qf[d0 * 8 + 3]); w.z = cvtpk_s(qf[d0 * 8 + 4], qf[d0 * 8 + 5]); w.w = cvtpk_s(qf[d0 * 8 + 6], qf[d0 * 8 + 7]);
              qa[d0] = __builtin_bit_cast(bf16x8, w); }
          if (VAR == 2) { qa[2] = qa[0]; qa[3] = qa[1]; }
        }
        const float sbound = sb0;
        if (pass > 0) { DMA_K2(0, 0); DMA_K2(1, SLOTB); DMA_V2(0, 0); }
        float mhat = 0.f, l_reg = 0.f; bool hasref = false, resc = false; f32x16 o[2], negm;
#pragma unroll
        for (int r = 0; r < 16; ++r) { o[0][r] = 0.f; o[1][r] = 0.f; }
        f32x16 pA0, pA1, pB0, pB1; u32x4 pw0, pw1, pw2, pw3;
#pragma unroll
        for (int r = 0; r < 16; ++r) { pB0[r] = 0.f; pB1[r] = 0.f; }
        const auto setneg = [&](int t) __attribute__((always_inline)) { float v = -mhat; if (VAR == 0) v += cumt; else v += slope2 * (float)(t * 64 + 4 * hi - tq);
#pragma unroll
            for (int r = 0; r < 16; ++r) negm[r] = v;
            PINV(negm); };
        const auto mid = [&](f32x16& C0, f32x16& C1, const int it) __attribute__((always_inline)) {
            const int t = NT - 1 - it;
            if (VAR == 0) { const LAS float* cp = cumL + t * 64 + 4 * hi;
#pragma unroll
                for (int g = 0; g < 4; ++g) { const f32x4 c0 = *(const LAS f32x4*)(cp + 8 * g), c1 = *(const LAS f32x4*)(cp + 32 + 8 * g);
#pragma unroll
                    for (int i = 0; i < 4; ++i) { C0[4 * g + i] -= c0[i]; C1[4 * g + i] -= c1[i]; } } }
            else {
#pragma unroll
                for (int r = 0; r < 16; ++r) { const float kc = (float)((r & 3) + 8 * (r >> 2)); C0[r] += slope2 * kc; C1[r] += slope2 * (kc + 32.f); } }
            if (VAR != 3) { if (it < 4) { asm volatile("" ::: "memory");
                const int kb = 64 * (3 - it) + 4 * hi;
#pragma unroll
                for (int r = 0; r < 16; ++r) { const int kv = kb + (r & 3) + 8 * (r >> 2); if (kv > qrel) C0[r] = -INFINITY; if (kv + 32 > qrel) C1[r] = -INFINITY; } } }
            else { const u32x2 mw = *(const LAS u32x2*)(maskL + qrel * MROW + 2 * t); const unsigned w0 = mw.x >> (4 * hi), w1 = mw.y >> (4 * hi);
#pragma unroll
                for (int r = 0; r < 16; ++r) { const int c = (r & 3) + 8 * (r >> 2); if (!((w0 >> c) & 1u)) C0[r] = -INFINITY; if (!((w1 >> c) & 1u)) C1[r] = -INFINITY; } }
            const float rm = rowmax(C0, C1, hi);
            const bool need = hasref ? (rm > THR) : (rm > -INFINITY);
            resc = false;
            if (__any(need)) {
                const bool fin = rm > -INFINITY;
                const float dl = hasref ? fmaxf(rm, 0.f) : (fin ? rm : 0.f);
                const float f = hasref ? EX2(-dl) : 1.f;
                mhat += dl; l_reg *= f;
#pragma unroll
                for (int r = 0; r < 16; ++r) { C0[r] -= dl; C1[r] -= dl; }
                if (hi == 0) wsf[r32] = f;
                resc = true; hasref = hasref || fin;
            }
            if (VAR != 0) {
                const bool dead = hasref && (sbound - slope2 * (float)(tq - 64 * t + 1) - mhat < -150.f);
                const bool alld = __all(dead); if (lane == 0) ((LAS unsigned*)(sh + L_END))[(it & 1) * 8 + wid] = alld ? 1u : 0u;
            }
        };
#define KLD(dst0, dst1, d0) do { dst0 = *(const LAS bf16x8*)(kp_ + (d0) * 2048); dst1 = *(const LAS bf16x8*)(kp_ + (d0) * 2048 + 512); } while (0)
#define VLD(lo, hi_, i) do { lo = vtr(vp_ + (((i) >> 2) * 4096 + ((i) & 3) * 1024)); hi_ = vtr(vp_ + (((i) >> 2) * 4096 + ((i) & 3) * 1024 + 512)); } while (0)
#define VF(lo, hi_) (bf16x8){lo[0], lo[1], lo[2], lo[3], hi_[0], hi_[1], hi_[2], hi_[3]}
        const auto step = [&](f32x16& C0, f32x16& C1, f32x16& P0, f32x16& P1, const int it) __attribute__((always_inline)) -> bool {
            if (it + 1 < NT) ATT_BARN(2); else ATT_BARN(1);
            if (VAR != 0 && it >= 1) { const LAS unsigned* wz = (const LAS unsigned*)(sh + L_END) + ((it - 1) & 1) * 8;
                const u32x4 z0 = *(const LAS u32x4*)wz, z1 = *(const LAS u32x4*)(wz + 4);
                if (__builtin_amdgcn_readfirstlane((int)(z0.x & z0.y & z0.z & z0.w & z1.x & z1.y & z1.z & z1.w)) != 0) return true; }
            if (it + 2 < NT) DMA_K2(it + 2, slot3(it + 2));
            if (it + 1 < NT) DMA_V2(it + 1, slot3(it + 1));
            setneg(NT - 1 - it);
            int ko_ = slot3(it), vo_ = slot3(it + 2);
            asm volatile("" : "+s"(ko_), "+s"(vo_));
            const lds_cptr kp_ = kp0 + ko_; const lds_cptr vp_ = vp0 + vo_;
            bf16x8 ka0, ka1, kb0, kb1; s16x4 va0, va1, vb0, vb1;
            float sacc = 0.f;
            if (VAR == 2) {
                KLD(ka0, ka1, 2 * pass); KLD(kb0, kb1, 2 * pass + 1); SB2();
                GAPA8(C0 = MF32(ka0, qa[0], negm), P0, 0, pw0);
                GAPA8(C1 = MF32(ka1, qa[0], negm), P0, 8, pw1);
                GAPA8(C0 = MF32(kb0, qa[1], C0), P1, 0, pw2);
                GAPA8(C1 = MF32(kb1, qa[1], C1), P1, 8, pw3);
            } else {
                KLD(ka0, ka1, 0); KLD(kb0, kb1, 1); SB2();
                GAPA(C0 = MF32(ka0, qa[0], negm), P0, 0, pw0, 0);
                GAPA(C1 = MF32(ka1, qa[0], negm), P0, 4, pw0, 2);
                KLD(ka0, ka1, 2); SB2();
                GAPA(C0 = MF32(kb0, qa[1], C0), P0, 8, pw1, 0);
                GAPA(C1 = MF32(kb1, qa[1], C1), P0, 12, pw1, 2);
                KLD(kb0, kb1, 3); SB2();
                GAPA(C0 = MF32(ka0, qa[2], C0), P1, 0, pw2, 0);
                GAPA(C1 = MF32(ka1, qa[2], C1), P1, 4, pw2, 2);
                GAPA(C0 = MF32(kb0, qa[3], C0), P1, 8, pw3, 0);
                GAPA(C1 = MF32(kb1, qa[3], C1), P1, 12, pw3, 2);
            }
            l_reg += sacc;
            mid(C0, C1, it);
            SB2();
            if (it > 0) {
                VLD(va0, va1, 0); VLD(vb0, vb1, 4); SB2();
                GAPB(o[0] = MF32(PAF(0), VF(va0, va1), o[0]), C0, 0);  VLD(va0, va1, 1); SB2();
                GAPB(o[1] = MF32(PAF(0), VF(vb0, vb1), o[1]), C0, 4);  VLD(vb0, vb1, 5); SB2();
                GAPB(o[0] = MF32(PAF(1), VF(va0, va1), o[0]), C0, 8);  VLD(va0, va1, 2); SB2();
                GAPB(o[1] = MF32(PAF(1), VF(vb0, vb1), o[1]), C0, 12); VLD(vb0, vb1, 6); SB2();
                GAPB(o[0] = MF32(PAF(2), VF(va0, va1), o[0]), C1, 0);  VLD(va0, va1, 3); SB2();
                GAPB(o[1] = MF32(PAF(2), VF(vb0, vb1), o[1]), C1, 4);  VLD(vb0, vb1, 7); SB2();
                GAPB(o[0] = MF32(PAF(3), VF(va0, va1), o[0]), C1, 8);
                GAPB(o[1] = MF32(PAF(3), VF(vb0, vb1), o[1]), C1, 12);
                if (resc) {
#pragma unroll
                    for (int r = 0; r < 16; ++r) { const float fr = wsf[crow(r, hi)]; o[0][r] *= fr; o[1][r] *= fr; } }
            } else {
#pragma unroll
                for (int r = 0; r < 16; ++r) { C0[r] = EX2(C0[r]); C1[r] = EX2(C1[r]); }
            }
            return false;
        };
        bool ex = false, pendA = true; int it = 0;
        for (; it < NT; it += 2) {
            ex = step(pA0, pA1, pB0, pB1, it); if (ex) { pendA = false; break; }
            ex = step(pB0, pB1, pA0, pA1, it + 1); if (ex) { pendA = true; ++it; break; }
        }
        if (!ex) pendA = false;
        if (!ex) ATT_BARN(0);
        { int vo_ = slot3(it + 2); asm volatile("" : "+s"(vo_)); const lds_cptr vp_ = vp0 + vo_; s16x4 vlo[8], vhi[8];
#pragma unroll
          for (int i = 0; i < 8; ++i) VRD(i);
          float sacc = 0.f;
          if (pendA) {
#pragma unroll
              for (int r = 0; r < 16; ++r) sacc += pA0[r] + pA1[r];
              pw0 = (u32x4){PKW(pA0, 0), PKW(pA0, 2), PKW(pA0, 4), PKW(pA0, 6)}; pw1 = (u32x4){PKW(pA0, 8), PKW(pA0, 10), PKW(pA0, 12), PKW(pA0, 14)};
              pw2 = (u32x4){PKW(pA1, 0), PKW(pA1, 2), PKW(pA1, 4), PKW(pA1, 6)}; pw3 = (u32x4){PKW(pA1, 8), PKW(pA1, 10), PKW(pA1, 12), PKW(pA1, 14)};
          } else {
#pragma unroll
              for (int r = 0; r < 16; ++r) sacc += pB0[r] + pB1[r];
              pw0 = (u32x4){PKW(pB0, 0), PKW(pB0, 2), PKW(pB0, 4), PKW(pB0, 6)}; pw1 = (u32x4){PKW(pB0, 8), PKW(pB0, 10), PKW(pB0, 12), PKW(pB0, 14)};
              pw2 = (u32x4){PKW(pB1, 0), PKW(pB1, 2), PKW(pB1, 4), PKW(pB1, 6)}; pw3 = (u32x4){PKW(pB1, 8), PKW(pB1, 10), PKW(pB1, 12), PKW(pB1, 14)};
          }
          l_reg += sacc;
          o[0] = MF32(PAF(0), VFR(0), o[0]); o[1] = MF32(PAF(0), VFR(4), o[1]); o[0] = MF32(PAF(1), VFR(1), o[0]); o[1] = MF32(PAF(1), VFR(5), o[1]);
          o[0] = MF32(PAF(2), VFR(2), o[0]); o[1] = MF32(PAF(2), VFR(6), o[1]); o[0] = MF32(PAF(3), VFR(3), o[0]); o[1] = MF32(PAF(3), VFR(7), o[1]); }
        ATT_WAIT_BAR();
        if (pass == NPASS - 1 && tid == 0) nxt_u = __hip_atomic_fetch_add(qctr, 1u, RLX_AGENT);
        int lane_e = lane; asm volatile("" : "+v"(lane_e)); const int r32e = lane_e & 31, hie = lane_e >> 5;
        LAS float* wsfe = (LAS float*)(sh + L_WS) + wid * 64; LAS float* stge = (LAS float*)(sh + L_OST) + wid * 2048;
        float rli[16];
        l_reg += xhalf(l_reg, hie);
        if (hie == 0) wsfe[32 + r32e] = l_reg;
#pragma unroll
        for (int r = 0; r < 16; ++r) rli[r] = __builtin_amdgcn_rcpf(wsfe[32 + crow(r, hie)]);
#pragma unroll
        for (int r = 0; r < 16; ++r) { const int orow = crow(r, hie);
#pragma unroll
            for (int d0 = 0; d0 < 2; ++d0) { const float val = o[d0][r] * rli[r]; LAS float* sp = stge + orow * 64 + d0 * 32 + r32e;
                if (VAR == 2 && pass == 1) *sp = *sp - P.lam * val; else *sp = val; } }
    }
    LDS_WAIT();
    int lane_o = tid & 63; asm volatile("" : "+v"(lane_o));
    bf16* Ow = P.mix + (size_t)(rowbase + q0 + wid * 32) * DM + VAR * 256 + h * 64;
    { const int lane = lane_o; LAS float* stg = (LAS float*)(sh + L_OST) + wid * 2048;
#pragma unroll
    for (int i = 0; i < 4; ++i) { const int row = i * 8 + (lane >> 3), ch = lane & 7;
        const f32x4 a = *(const LAS f32x4*)(stg + row * 64 + ch * 8), c = *(const LAS f32x4*)(stg + row * 64 + ch * 8 + 4);
        float sc = 1.f;
        if (VAR == 2) { float ss = (a[0] * a[0] + a[1] * a[1]) + (a[2] * a[2] + a[3] * a[3]) + (c[0] * c[0] + c[1] * c[1]) + (c[2] * c[2] + c[3] * c[3]);
            ss += shx<1>(ss); ss += shx<2>(ss); ss += shx<4>(ss); sc = 1.0f / sqrtf(ss * (1.f / 64.f) + RMS_EPS); }
        u32x4 w; w.x = cvtpk_s(a[0] * sc, a[1] * sc); w.y = cvtpk_s(a[2] * sc, a[3] * sc); w.z = cvtpk_s(c[0] * sc, c[1] * sc); w.w = cvtpk_s(c[2] * sc, c[3] * sc);
        *(u32x4*)(Ow + (size_t)row * DM + ch * 8) = w; } }
    if (tid == 0) *qslot = nxt_u;
    asm volatile("s_waitcnt lgkmcnt(0)\n\ts_barrier" ::: "memory");
#undef DMA_K2
#undef DMA_V2
#undef TILE2
}
#undef SB2
#undef PINV
#undef MF32
#undef ATT_BARN
#undef PKW
#undef PAF
#undef VFR
#undef VRD
#undef EX2
#undef GAPA
#undef GAPA8
#undef GAPB
#undef KLD
#undef VLD
#undef VF
}

__device__ __forceinline__ void p4_attention(Frame& F, const Args& A, int l, int qsel) {
    att::AttnP P; P.proj = (const bf16*)(F.ws + WS_PROJ); P.mix = (bf16*)(F.ws + WS_MIX); P.cum = (const float*)(F.ws + WS_CUM); P.mask = (const unsigned*)(F.ws + WS_MASK);
    P.qgain[0] = inp<I_QNA>() + l * 64; P.qgain[1] = nullptr; P.qgain[2] = inp<I_QNC>() + l * 32; P.qgain[3] = inp<I_QND>() + l * 64; P.kgain[0] = nullptr; P.kgain[1] = nullptr; P.kgain[2] = inp<I_KNC>() + l * 32; P.kgain[3] = inp<I_KND>() + l * 64; P.lam = ((const float*)(F.ws + WS_MISC))[l];
    LAS char* sh = (LAS char*)F.lds;
    LAS float* rsl2 = (LAS float*)(F.lds + 126976);
    bool cv = BG_CONVERT && (qsel == 0);
    if (cv) { fill_rowscale(F, A, 0, rsl2); fill_rowscale(F, A, 1, rsl2 + DM); }
    if (F.tid == 0) F.MISC[0] = __hip_atomic_fetch_add(F.ctl + CW_AQ + 64 * qsel, 1u, RLX_AGENT);
    __syncthreads();
    for (;;) {
        const int u = (int)F.MISC[0];
        if (u >= 1024) break;
        const int qb = 7 - (u >> 7), r = u & 127, var = r >> 5, bh = r & 31, b = bh >> 2, h = bh & 3;
        const int tv = var == 0 ? 2 : var == 1 ? 1 : var == 2 ? 3 : 0;
        if (qsel >= 2 && PROBE_ATT_VAR >= 0 && tv != PROBE_ATT_VAR) { __syncthreads(); if (F.tid == 0) F.MISC[0] = __hip_atomic_fetch_add(F.ctl + CW_AQ + 64 * qsel, 1u, RLX_AGENT); __syncthreads(); continue; }
#ifdef ONLY_VAR2
        att::attn_unit2<ONLY_VAR2>(P, b, h, qb, sh, F.tid, F.ctl + CW_AQ + 64 * qsel, F.MISC);
#else
        if (tv == 2) att::attn_unit<2>(P, b, h, qb, sh, F.tid, qsel >= 2 ? PROBE_ATT_MODE : 0, F.ctl + CW_AQ + 64 * qsel, F.MISC);
        else if (tv == 1) att::attn_unit<1>(P, b, h, qb, sh, F.tid, qsel >= 2 ? PROBE_ATT_MODE : 0, F.ctl + CW_AQ + 64 * qsel, F.MISC);
        else if (tv == 3) att::attn_unit<3>(P, b, h, qb, sh, F.tid, qsel >= 2 ? PROBE_ATT_MODE : 0, F.ctl + CW_AQ + 64 * qsel, F.MISC);
        else att::attn_unit2<0>(P, b, h, qb, sh, F.tid, F.ctl + CW_AQ + 64 * qsel, F.MISC);
#endif
        if (cv) {
            if (F.tid == 0) F.MISC[3] = __hip_atomic_fetch_add(F.ctl + CW_CVQ, (unsigned)CV_CHUNK, RLX_AGENT);
            __syncthreads();
            const int gb = (int)F.MISC[3];
            if (gb >= CV_TOTAL) cv = false; else convert_chunk(F, A, gb, rsl2);
            __syncthreads();
        }
    }
    while (cv) {
        __syncthreads();
        if (F.tid == 0) F.MISC[3] = __hip_atomic_fetch_add(F.ctl + CW_CVQ, (unsigned)CV_CHUNK, RLX_AGENT);
        __syncthreads();
        const int gb = (int)F.MISC[3];
        if (gb >= CV_TOTAL) cv = false; else convert_chunk(F, A, gb, rsl2);
    }
    __syncthreads();
}

template <int N, int Dd> __device__ __forceinline__ void bfly(float (&p)[32], int lane) { const bool up = (lane & Dd) != 0;
#pragma unroll
    for (int j = 0; j < N / 2; ++j) { const float a = p[2 * j], bb = p[2 * j + 1]; const float send = up ? a : bb, keep = up ? bb : a; p[j] = keep + __shfl_xor(send, Dd); } }
__device__ __forceinline__ void p6_router(Frame& F, const Args& A, int l, int rep) {
    const float* MOD = (const float*)(F.ws + WS_MOD); const bf16* X1 = (const bf16*)(F.ws + WS_X1); bf16* H = (bf16*)(F.ws + WS_H);
    const bf16* WRH = (const bf16*)(F.ws + WS_WR) + (size_t)l * 48 * DM; const bf16* WRL = WRH + 2 * 48 * DM;
    int* tok_e = (int*)(F.ws + WS_TOK); float* tok_w = (float*)(F.ws + WS_TOK) + 2 * M; int* tok_pos = (int*)(F.ws + WS_TOK) + 4 * M;
    constexpr int AP = 528;
    LAS unsigned char* Ahi = F.lds; LAS unsigned char* Alo = F.lds + 64 * AP; LAS unsigned char* Bhi = F.lds + 128 * AP; LAS unsigned char* Blo = F.lds + 176 * AP;
    LAS float* PL = (LAS float*)F.lds;
    const int lane = F.lane, w = F.wave; const int mw = (F.vcu * NWAVES + w) * 8; const int b = mw >> 11;
    const float* md = MOD + ((size_t)l * 8 + b) * 6144;
    f32x4 hv[8][4];
#pragma unroll
    for (int r = 0; r < 8; ++r) {
        const bf16* xr = X1 + (size_t)(mw + r) * DM;
#pragma unroll
        for (int j = 0; j < 4; ++j) { const u32x2 q = *(const u32x2*)(xr + 256 * j + 4 * lane); hv[r][j] = (f32x4){bf2f(q.x & 0xffff), bf2f(q.x >> 16), bf2f(q.y & 0xffff), bf2f(q.y >> 16)}; }
    }
    { f32x4 gm[4], sc[4], sh[4]; const float* n2 = inp<I_N2G>() + l * DM;
#pragma unroll
      for (int j = 0; j < 4; ++j) { const int col = 256 * j + 4 * lane; gm[j] = *(const f32x4*)(n2 + col); sc[j] = *(const f32x4*)(md + 4 * DM + col); sh[j] = *(const f32x4*)(md + 3 * DM + col); gm[j] = gm[j] * (sc[j] + 1.0f); }
#pragma unroll
      for (int r = 0; r < 8; ++r) { float ss = 0.f;
#pragma unroll
        for (int j = 0; j < 4; ++j) ss += (hv[r][j][0] * hv[r][j][0] + hv[r][j][1] * hv[r][j][1]) + (hv[r][j][2] * hv[r][j][2] + hv[r][j][3] * hv[r][j][3]);
        const float rstd = 1.0f / sqrtf(wave_sum(ss) * (1.f / DM) + RMS_EPS);
#pragma unroll
        for (int j = 0; j < 4; ++j) { hv[r][j] = hv[r][j] * rstd * gm[j] + sh[j]; u32x2 pk; pk.x = pk2(hv[r][j][0], hv[r][j][1]); pk.y = pk2(hv[r][j][2], hv[r][j][3]);
            *(u32x2*)(H + (size_t)(mw + r) * DM + 256 * j + 4 * lane) = pk; } } }
    const int rt = w & 3, kh = w >> 2, arow = lane & 15, kg = lane >> 4;
    f32x4 acc[3];
#pragma unroll
    for (int c = 0; c < 3; ++c) acc[c] = (f32x4){0.f, 0.f, 0.f, 0.f};
#pragma unroll
    for (int j = 0; j < 4; ++j) {
        __syncthreads();
#pragma unroll
        for (int r = 0; r < 8; ++r) { const f32x4 x = hv[r][j]; unsigned h0 = f2bf(x[0]), h1 = f2bf(x[1]), h2 = f2bf(x[2]), h3 = f2bf(x[3]);
            u32x2 hi; hi.x = h0 | (h1 << 16); hi.y = h2 | (h3 << 16);
            u32x2 lo; lo.x = pk2(x[0] - bf2f((unsigned short)h0), x[1] - bf2f((unsigned short)h1)); lo.y = pk2(x[2] - bf2f((unsigned short)h2), x[3] - bf2f((unsigned short)h3));
            *(LAS u32x2*)(Ahi + (w * 8 + r) * AP + lane * 8) = hi; *(LAS u32x2*)(Alo + (w * 8 + r) * AP + lane * 8) = lo; }
        for (int i = F.tid; i < 48 * 32; i += 512) { const int o = i >> 5, c16 = i & 31;
            *(LAS u32x4*)(Bhi + o * AP + c16 * 16) = *(const u32x4*)(WRH + (size_t)o * DM + 256 * j + 8 * c16);
            *(LAS u32x4*)(Blo + o * AP + c16 * 16) = *(const u32x4*)(WRL + (size_t)o * DM + 256 * j + 8 * c16); }
        LDS_WAIT(); __syncthreads();
#pragma unroll
        for (int ks = 0; ks < 4; ++ks) { const int kb = ((4 * kh + ks) * 32 + 8 * kg) * 2;
            const bf16x8 ah = *(const LAS bf16x8*)(Ahi + (16 * rt + arow) * AP + kb), al = *(const LAS bf16x8*)(Alo + (16 * rt + arow) * AP + kb);
#pragma unroll
            for (int c = 0; c < 3; ++c) { const bf16x8 bh = *(const LAS bf16x8*)(Bhi + (16 * c + arow) * AP + kb), bl = *(const LAS bf16x8*)(Blo + (16 * c + arow) * AP + kb);
                acc[c] = __builtin_amdgcn_mfma_f32_16x16x32_bf16(ah, bh, acc[c], 0, 0, 0);
                acc[c] = __builtin_amdgcn_mfma_f32_16x16x32_bf16(al, bh, acc[c], 0, 0, 0);
                acc[c] = __builtin_amdgcn_mfma_f32_16x16x32_bf16(ah, bl, acc[c], 0, 0, 0); } }
    }
    __syncthreads();
#pragma unroll
    for (int c = 0; c < 3; ++c)
#pragma unroll
        for (int r = 0; r < 4; ++r) PL[(kh * 64 + 16 * rt + kg * 4 + r) * 48 + 16 * c + arow] = acc[c][r];
    LDS_WAIT(); __syncthreads();
    if (F.tid < 64 && rep == 0) {
        const int m = F.vcu * 64 + F.tid; const LAS float* q0 = PL + F.tid * 48; const LAS float* q1 = PL + (64 + F.tid) * 48;
        float gl[4]; int gi = 0; float gm;
#pragma unroll
        for (int g = 0; g < 4; ++g) gl[g] = (q0[g] + q1[g]) + inp<I_BG>()[l * 4 + g];
        gm = gl[0];
#pragma unroll
        for (int g = 1; g < 4; ++g) if (gl[g] > gm) { gm = gl[g]; gi = g; }
        float den = 0.f;
#pragma unroll
        for (int g = 0; g < 4; ++g) den += __expf(gl[g] - gm);
        const float gprob = 1.0f / den;
        float v1 = -INFINITY, v2 = -INFINITY; int i1 = 0, i2 = 0;
        for (int e = 0; e < 8; ++e) { const float v = (q0[4 + gi * 8 + e] + q1[4 + gi * 8 + e]) + inp<I_BE>()[l * 32 + gi * 8 + e];
            if (v > v1) { v2 = v1; i2 = i1; v1 = v; i1 = e; } else if (v > v2) { v2 = v; i2 = e; } }
        const float e2 = __expf(v2 - v1); const float w1 = gprob / (1.f + e2), w2 = gprob * e2 / (1.f + e2);
        const int ea = gi * 8 + i1, eb = gi * 8 + i2;
        tok_e[m] = ea; tok_e[M + m] = eb; tok_w[m] = w1; tok_w[M + m] = w2;
        const int pa = (int)__hip_atomic_fetch_add(F.ctl + CW_CNT + (l * 32 + ea) * 16, 1u, RLX_AGENT);
        const int pb = (int)__hip_atomic_fetch_add(F.ctl + CW_CNT + (l * 32 + eb) * 16, 1u, RLX_AGENT);
        tok_pos[m] = pa; tok_pos[M + m] = pb;
        int* elist = (int*)(F.ws + WS_ELIST); elist[ea * M + pa] = m; elist[eb * M + pb] = m;
    }
}

__device__ __forceinline__ void build_rowlists(Frame& F, int l) {
    volatile LAS int* base = (volatile LAS int*)(F.lds + BASE_OFF); volatile LAS int* cnts = (volatile LAS int*)(F.lds + CNTS_OFF); volatile LAS int* tab = (volatile LAS int*)(F.lds + TAB_OFF);
    LAS int* rowl = (LAS int*)(F.lds + ROWL_OFF); const int* elist = (const int*)(F.ws + WS_ELIST);
    const int ntile = (int)F.MISC[1];
    const int i = F.tid >> 8, r = F.tid & 255; const long L = (long)i * F.G + F.bx;
    int tok = 0;
    if (L < 2L * ntile) { const int tile = (int)(L >> 1), e = tab[tile], pos = 256 * (tile - base[e]) + r; if (pos < cnts[e]) tok = elist[e * M + pos]; }
    rowl[F.tid] = tok;
    __syncthreads();
}

constexpr int NPL = 7, NPH = 2 + 2 * NPL;
__global__ void __launch_bounds__(NWAVES * 64, 2) mk_fwd(Args args) {
    extern __shared__ __attribute__((aligned(16))) unsigned char lds[];
    Frame F;
    F.lds = (LAS unsigned char*)lds;
    F.MISC = (volatile LAS unsigned*)(F.lds + MISC_OFF);
    F.tid = threadIdx.x; F.lane = F.tid & 63; F.wave = __builtin_amdgcn_readfirstlane(F.tid >> 6);
    const int wave0 = F.wave;
    F.G = gridDim.x; F.bx = blockIdx.x; F.vcu = 0;
    F.ws = args.ws; F.out = args.out; F.ctl = (unsigned*)(args.ws + WS_CTL);
    for (int u = F.tid; u < (LDS_BYTES - LDSCTL_OFF) / 4; u += NWAVES * 64) ((LAS unsigned*)(F.lds + LDSCTL_OFF))[u] = 0u;
    __syncthreads();
    XcdBarrier bar; bar.bar = F.ctl + CW_BAR; bar.x = 0; bar.st = nullptr;
    if (!MK_PER_PHASE) bar = xcd_barrier_post(F.ctl + CW_BAR, F.MISC + 8);
    const int lo = args.ph_lo, hi = args.ph_hi;
#pragma unroll 1
    for (int ph = lo; ph < hi; ++ph) {
#if PROBE_REP_K >= 0
        const int ptype = ph == 0 ? 0 : (ph == NPH - 1 ? 10 : 1 + (ph - 1) % NPL);
        const int nrep = (ptype == PROBE_REP_K && (ph <= NPL || (PROBE_REP_K != 1 && PROBE_REP_K != 5))) ? 1 : 0;
#pragma unroll 1
        for (int rep = 0; rep <= nrep; ++rep) {
#else
        constexpr int rep = 0;
#endif
        { int w_ = wave0; asm volatile("" : "+s"(w_)); unsigned on_ = ~0u; asm volatile("" : "+s"(on_)); int ln_ = (int)__builtin_amdgcn_mbcnt_hi(on_, __builtin_amdgcn_mbcnt_lo(on_, 0u)); asm volatile("" : "+v"(ln_));
          F.wave = w_; F.lane = ln_; F.tid = w_ * 64 + ln_;
          unsigned long long ws_ = (unsigned long long)args.ws; asm volatile("" : "+s"(ws_)); F.ws = (unsigned char*)(GAS unsigned char*)ws_; F.ctl = (unsigned*)(F.ws + WS_CTL);
          int bx_ = blockIdx.x; asm volatile("" : "+s"(bx_)); F.bx = bx_; F.vcu = (F.G % 8 == 0) ? (bx_ % 8) * (F.G / 8) + bx_ / 8 : bx_; }
        if (ph == 0) {
#ifndef SKIP_P0
            p0_prologue(F, args);
#endif
        } else if (ph == NPH - 1) {
            row_pass(F, args, 2, 1);
        } else {
            const int l = (ph - 1) / NPL, k = (ph - 1) % NPL;
            if (k == 0) { row_pass(F, args, l == 0 ? 0 : 1, l); }
            else if (k == 1) {
                pg8::Gemm g{(const bf16*)(F.ws + WS_H), (const bf16*)(F.ws + WS_WIN) + (size_t)l * NP * DM, M, NP, DM}; pg8::StaticOrder S; S.init(M, NP, F.G, F.bx);
                pg8::EpiBf16 E{(bf16*)(F.ws + WS_PROJ), NP};
#ifndef SKIP_G1
                pg8::gemm_phase<pg8::EpiBf16, pg8::StaticOrder, true, true>(F.lds, g, S, E, F.tid);
#endif
            } else if (k == 2) {
#ifndef SKIP_P3
                p3_prep(F, args, l, rep);
#endif
            } else if (k == 3) {
#ifndef SKIP_P4
                p4_attention(F, args, l, l + 2 * rep);
#endif
            } else if (k == 4) {
                pg8::Gemm g{(const bf16*)(F.ws + WS_MIX), (const bf16*)(F.ws + WS_WOUT) + (size_t)l * DM * DM, M, DM, DM}; pg8::StaticOrder S; S.init(M, DM, F.G, F.bx);
                pg8::EpiResGate E{l == 0 ? inp<I_X>() : nullptr, (const bf16*)(F.ws + WS_X1), (bf16*)(F.ws + WS_X1), (const float*)(F.ws + WS_MOD) + (size_t)l * 8 * 6144 + 2 * DM};
#ifndef SKIP_G2
                pg8::gemm_phase<pg8::EpiResGate, pg8::StaticOrder, false, true>(F.lds, g, S, E, F.tid);
#endif
            } else if (k == 5) {
#ifndef SKIP_P6
                p6_router(F, args, l, rep);
#endif
            } else {
                build_tables(F, l); build_rowlists(F, l);
                unsigned* upf = F.ctl + CW_UPF + l * 8192; unsigned* dq = F.ctl + CW_DNQ + 16 * l;
                { pg8::Gemm g{(const bf16*)(F.ws + WS_H), (const bf16*)(F.ws + WS_WUP) + (size_t)l * NEXP * 512 * DM, MAXSLOT, 512, DM};
                  pg8::GroupOrder S{(const LAS int*)(F.lds + TAB_OFF), (int)F.MISC[1], 2, F.G, F.bx, (size_t)512 * DM * 2};
                  pg8::EpiSwiglu E{(bf16*)(F.ws + WS_HID), upf};
#ifndef SKIP_G3
                  pg8::gemm_phase<pg8::EpiSwiglu, pg8::GroupOrder, true, true, true>(F.lds, g, S, E, F.tid, (const LAS int*)(F.lds + ROWL_OFF));
#endif
                }
                if (GAP_CONVERT && !BG_CONVERT && l == 0 && rep == 0) convert_layer1_in_gap(F, args, 2 * (int)F.MISC[1] - F.G);
                { const pg8::Gemm g{(const bf16*)(F.ws + WS_HID), (const bf16*)(F.ws + WS_WDN) + (size_t)l * NEXP * DM * FF, MAXSLOT, DM, FF};
                  const pg8::EpiBf16 E{(bf16*)(F.ws + WS_Y), DM};
                  const LAS int* tab = (const LAS int*)(F.lds + TAB_OFF);
                  const int nd = 4 * __builtin_amdgcn_readfirstlane((int)F.MISC[1]);
                  pg8::DynOrder S{dq, upf, tab, F.MISC, nd, (size_t)DM * FF * 2, F.tid, 0u, 2u};
                  if (F.tid == 0) { const unsigned a = __hip_atomic_fetch_add(dq, 1u, RLX_AGENT), b = __hip_atomic_fetch_add(dq, 1u, RLX_AGENT); F.MISC[4] = a; F.MISC[5] = b;
                      if ((int)a < nd) while (__hip_atomic_load(upf + (a >> 2) * 16, RLX_AGENT) < 2u) __builtin_amdgcn_s_sleep(8);
                      __builtin_amdgcn_fence(__ATOMIC_ACQUIRE, "agent"); asm volatile("s_waitcnt vmcnt(0)" ::: "memory"); S.issue(b); }
                  __syncthreads();
                  for (;;) {
                      if (__builtin_amdgcn_readfirstlane((int)F.MISC[4]) >= nd) break;
#ifndef SKIP_G4
                      pg8::gemm_phase<pg8::EpiBf16, pg8::DynOrder, true, true>(F.lds, g, S, E, F.tid);
#endif
                      if (F.tid == 0) {
                          const unsigned idn = F.MISC[5];
                          if ((int)idn < nd) { unsigned f = S.pflag; while (f < 2u) { __builtin_amdgcn_s_sleep(8); f = __hip_atomic_load(upf + (idn >> 2) * 16, RLX_AGENT); }
                              __builtin_amdgcn_fence(__ATOMIC_ACQUIRE, "agent"); asm volatile("s_waitcnt vmcnt(0)" ::: "memory"); }
                          const unsigned idn2 = S.ppop; F.MISC[4] = idn; F.MISC[5] = idn2; S.issue(idn2); }
                      __syncthreads();
                  }
                }
            }
        }
#if PROBE_REP_K >= 0
        if (rep < nrep) xcd_barrier(bar, F.tid);
        }
#endif
        if (ph + 1 < hi) xcd_barrier(bar, F.tid);
#ifdef PROBE_DOUBLE_BAR
        if (ph + 1 < hi) xcd_barrier(bar, F.tid);
#endif
    }
}

extern "C" void kernel_launch(void* const* d_in, const int* in_sizes, int n_in, void* d_out, int out_size, void* d_ws, size_t ws_size, hipStream_t stream) {
    static int grid = 0;
    if (grid == 0) {
        if (n_in != 28 || out_size != M * DM || ws_size < WS_END) { fprintf(stderr, "kernel_launch: unexpected shapes (n_in %d, out %d, ws %zu)\n", n_in, out_size, ws_size); grid = -1; return; }
        int dev = 0, cus = 0, per_cu = 0;
        if (hipGetDevice(&dev) != hipSuccess || hipDeviceGetAttribute(&cus, hipDeviceAttributeMultiprocessorCount, dev) != hipSuccess) { grid = -1; return; }
        if (hipFuncSetAttribute((const void*)mk_fwd, hipFuncAttributeMaxDynamicSharedMemorySize, LDS_BYTES) != hipSuccess) { fprintf(stderr, "kernel_launch: hipFuncSetAttribute failed\n"); grid = -1; return; }
        if (hipOccupancyMaxActiveBlocksPerMultiprocessor(&per_cu, (const void*)mk_fwd, NWAVES * 64, LDS_BYTES) != hipSuccess || per_cu < 1)
            fprintf(stderr, "kernel_launch: occupancy query reports %d workgroups per CU\n", per_cu);
        (void)hipGetLastError();
        grid = cus;
    }
    if (grid < 0) return;
    if (hipMemsetAsync((char*)d_ws + WS_CTL, 0, CTL_ZERO_BYTES, stream) != hipSuccess) return;
    Args a{};
    for (int i = 0; i < 28; ++i) a.in[i] = (const float*)d_in[i];
    a.out = (float*)d_out; a.ws = (unsigned char*)d_ws;
#if MK_PER_PHASE
    for (int p = 0; p < NPH; ++p) { a.ph_lo = p; a.ph_hi = p + 1; hipLaunchKernelGGL(mk_fwd, dim3(grid), dim3(NWAVES * 64), LDS_BYTES, stream, a); }
#else
    a.ph_lo = 0; a.ph_hi = NPH; hipLaunchKernelGGL(mk_fwd, dim3(grid), dim3(NWAVES * 64), LDS_BYTES, stream, a);
#endif
}
```

```cpp
#include <hip/hip_runtime.h>
#include <cstdio>
#include <cstdint>

#ifndef MK_PER_PHASE
#define MK_PER_PHASE 0
#endif

#ifndef PROBE_P3_PART
#define PROBE_P3_PART 0
#endif
#ifndef PROBE_ATT_VAR
#define PROBE_ATT_VAR -1
#endif
#ifndef BG_CONVERT
#define BG_CONVERT 1
#endif
#ifndef GAP_CONVERT
#define GAP_CONVERT 1
#endif
#ifndef PROBE_ATT_MODE
#define PROBE_ATT_MODE 0
#endif
#ifndef PROBE_REP_K
#define PROBE_REP_K -1
#endif
#define LAS __attribute__((address_space(3)))
#define GAS __attribute__((address_space(1)))
typedef unsigned short bf16;
typedef short bf16x8 __attribute__((ext_vector_type(8)));
typedef short s16x4 __attribute__((ext_vector_type(4)));
typedef float f32x4 __attribute__((ext_vector_type(4)));
typedef float f32x2 __attribute__((ext_vector_type(2)));
typedef float f32x16 __attribute__((ext_vector_type(16)));
typedef unsigned u32x4 __attribute__((ext_vector_type(4)));
typedef unsigned u32x2 __attribute__((ext_vector_type(2)));

constexpr int BATCH = 8, SEQ = 2048, DM = 1024, M = BATCH * SEQ, DEPTH = 2;
constexpr int NP = 3072;
constexpr int P_IN = 2988;
constexpr int C_AQ = 0, C_AK = 256, C_AV = 512, C_BQ = 768, C_BK = 1024, C_BV = 1280, C_CQ = 1536, C_CK = 1792, C_CV = 2048,
              C_DQ = 2304, C_DK = 2560, C_DV = 2624, C_IQ = 2688, C_IK = 2944, C_IW = 2976, C_AF = 2984;
constexpr int NEXP = 32, FF = 256, MAXSLOT = M * 2 + NEXP * 256, MAXTILE = MAXSLOT / 256;
constexpr float LOG2E = 1.4426950408889634f;
constexpr float RMS_EPS = 1e-6f;

constexpr size_t MiB = 1u << 20;
constexpr size_t WS_CTL = 0, CTL_ZERO_BYTES = 1 * MiB;
constexpr size_t WS_WR = 1 * MiB;
constexpr size_t WS_MOD = 2 * MiB;
constexpr size_t WS_CUM = 3 * MiB;
constexpr size_t WS_TOK = 4 * MiB;
constexpr size_t WS_MISC = 5 * MiB;
constexpr size_t WS_MASK = 6 * MiB;
constexpr size_t WS_WIN = 10 * MiB;
constexpr size_t WS_WOUT = 22 * MiB;
constexpr size_t WS_WUP = 26 * MiB;
constexpr size_t WS_WDN = 90 * MiB;
constexpr size_t WS_X1 = 122 * MiB;
constexpr size_t WS_H = 186 * MiB;
constexpr size_t WS_MIX = WS_H;

constexpr size_t WS_PROJ = 218 * MiB;
constexpr size_t WS_Y = WS_PROJ;
constexpr size_t WS_HID = WS_PROJ + 80 * MiB;
constexpr size_t WS_ELIST = 322 * MiB;
constexpr size_t WS_END = 324 * MiB;
constexpr int CW_AQ = 256;
constexpr int CW_CNT = 1024;
constexpr int CW_BAR = 8192;
constexpr int CW_DNQ = 208;
constexpr int CW_UPF = 65536;

constexpr int RING_BYTES = 143360;
constexpr int LDSCTL_OFF = RING_BYTES, MISC_OFF = LDSCTL_OFF + 320, CNTS_OFF = LDSCTL_OFF + 512, BASE_OFF = LDSCTL_OFF + 640, TAB_OFF = LDSCTL_OFF + 768;
constexpr int ROWL_OFF = 131072;
constexpr int LDS_BYTES = 147456;
constexpr int NWAVES = 8;

#define LDS_WAIT() asm volatile("s_waitcnt lgkmcnt(0)" ::: "memory")
#define VM_WAIT() asm volatile("s_waitcnt vmcnt(0)" ::: "memory")
#define RLX_AGENT __ATOMIC_RELAXED, __HIP_MEMORY_SCOPE_AGENT

__device__ __forceinline__ float bf2f(unsigned short u) { return __builtin_bit_cast(float, (unsigned)u << 16); }
__device__ __forceinline__ unsigned f2bf(float f) { unsigned u = __builtin_bit_cast(unsigned, f); return (u + 0x7fffu + ((u >> 16) & 1u)) >> 16; }
__device__ __forceinline__ unsigned pk2(float lo, float hi) { return f2bf(lo) | (f2bf(hi) << 16); }
template <int O> __device__ __forceinline__ float shx(float x) { static_assert(O >= 1 && O <= 16, "swizzle xor"); return __builtin_bit_cast(float, __builtin_amdgcn_ds_swizzle(__builtin_bit_cast(int, x), (O << 10) | 0x1f)); }
__device__ __forceinline__ float half_sum(float x) { return __builtin_bit_cast(float, __builtin_amdgcn_readlane(__builtin_bit_cast(int, x), 0)) + __builtin_bit_cast(float, __builtin_amdgcn_readlane(__builtin_bit_cast(int, x), 32)); }
__device__ __forceinline__ float half_max(float x) { return fmaxf(__builtin_bit_cast(float, __builtin_amdgcn_readlane(__builtin_bit_cast(int, x), 0)), __builtin_bit_cast(float, __builtin_amdgcn_readlane(__builtin_bit_cast(int, x), 32))); }
__device__ __forceinline__ float shup(float x, int o, int lane) { return __builtin_bit_cast(float, __builtin_amdgcn_ds_bpermute((lane - o) << 2, __builtin_bit_cast(int, x))); }
__device__ __forceinline__ int shup_i(int x, int o, int lane) { return __builtin_amdgcn_ds_bpermute((lane - o) << 2, x); }
__device__ __forceinline__ float wave_sum(float v) { v += shx<1>(v); v += shx<2>(v); v += shx<4>(v); v += shx<8>(v); v += shx<16>(v); return half_sum(v); }

namespace pg8 {
constexpr int BM = 256, BK = 64, HALF = 128, HTB = HALF * BK * 2, STAGE_BYTES = 8 * HTB, NXCD = 8, WGM = 8;
__host__ __device__ __forceinline__ int lds_byte(int r, int c) { const int st = (r >> 4) * 2 + (c >> 5), rr = r & 15, cc = c & 31, ob = rr * 64 + cc * 2; return st * 1024 + (ob ^ (((ob >> 9) & 1) << 5)); }
__host__ __device__ __forceinline__ void stage_rc(int b, int& R, int& C) { const int st = b / 1024, sb = b % 1024, swz = sb ^ (((sb >> 9) & 1) << 5); R = (st >> 1) * 16 + swz / 64; C = (st & 1) * 32 + (swz % 64) / 2; }
__host__ __device__ __forceinline__ int perm32(int rho) { const int n = rho >> 4, i = rho & 15; return 8 * (i >> 2) + 4 * n + (i & 3); }

struct Unit { int pm, pn; size_t bo; };
struct Gemm { const bf16* A; const bf16* Bt; int M, N, K; };

struct StaticOrder {
    int nM, nN, nwg, G, c;
    __host__ __device__ void init(int M_, int N_, int G_, int c_) { nM = M_ / BM; nN = N_ / BM; nwg = nM * nN; G = G_; c = c_; }
    __host__ __device__ bool next(int i, Unit& u) const {
        const long L = (long)i * G + c; if (L >= nwg) return false;
        int wgid = (int)L; { const int q = nwg / NXCD, r = nwg % NXCD, xcd = wgid % NXCD, off = wgid / NXCD; wgid = (xcd < r ? xcd * (q + 1) : r * (q + 1) + (xcd - r) * q) + off; }
        const int nig = WGM * nN, gid = wgid / nig, fm = gid * WGM, gsz = (nM - fm) < WGM ? (nM - fm) : WGM;
        u.pm = fm + ((wgid % nig) % gsz); u.pn = (wgid % nig) / gsz; u.bo = 0; return true;
    }
};
struct GroupOrder {
    const LAS int* tab; int ntile, ncol, G, c; size_t ebytes;
    __device__ __forceinline__ bool next(int i, Unit& u) const {
        const long L = (long)i * G + c; if (L >= (long)ntile * ncol) return false;
        u.pm = (int)(L / ncol); u.pn = (int)(L % ncol);
        const int e = __builtin_amdgcn_readfirstlane(tab[u.pm]); u.bo = (size_t)e * ebytes; return true;
    }
};

struct OneUnit { Unit u; __device__ __forceinline__ bool next(int i, Unit& o) const { if (i != 0) return false; o = u; return true; } };
struct DynOrder {
    unsigned* dq; unsigned* upf; const LAS int* tab; volatile LAS unsigned* M; int nd; size_t ebytes; int tid;
    mutable unsigned ppop, pflag;
    __device__ __forceinline__ void issue(unsigned idnext) const {
        ppop = __builtin_amdgcn_atomic_inc32(dq, 0xFFFFFFFFu, __ATOMIC_RELAXED, "agent");
        pflag = 2u; if ((int)idnext < nd) pflag = __hip_atomic_load(upf + (idnext >> 2) * 16, __ATOMIC_RELAXED, __HIP_MEMORY_SCOPE_AGENT);
    }
    __device__ __forceinline__ void unit(int id, Unit& u) const { u.pm = id >> 2; u.pn = id & 3; u.bo = (size_t)__builtin_amdgcn_readfirstlane(tab[id >> 2]) * ebytes; }
    __device__ __forceinline__ bool next(int i, Unit& u) const {
        if (i == 0) { const int id = __builtin_amdgcn_readfirstlane((int)M[4]); if (id >= nd) return false; unit(id, u); return true; }
        if (tid == 0) {
            const unsigned idn = M[5]; const bool ready = (int)idn < nd && pflag >= 2u;
            M[6] = ready ? 1u : 0u;
            if (ready) { asm volatile("buffer_inv sc1" ::: "memory"); M[4] = idn; const unsigned idn2 = ppop; M[5] = idn2; issue(idn2); }
        }
        asm volatile("s_waitcnt lgkmcnt(0)\n\ts_barrier" ::: "memory");
        if (__builtin_amdgcn_readfirstlane((int)M[6]) == 0) return false;
        unit(__builtin_amdgcn_readfirstlane((int)M[4]), u); return true;
    }
};

__device__ __forceinline__ unsigned cvt_pk_bf16(float lo, float hi) { unsigned r; asm volatile("v_cvt_pk_bf16_f32 %0, %1, %2" : "=v"(r) : "v"(lo), "v"(hi)); return r; }

struct EpiBf16 {
    static constexpr bool PERM = true, PUBLISH = false;
    bf16* O; int ldc;
    __device__ __forceinline__ void operator()(const f32x4 (&acc)[2][2][4][2], const Unit& u, int wr, int wc, int fr, int fq) const {
        const int row0 = u.pm * BM + wr * 64 + fr; const int col0 = u.pn * BM + wc * 32 + 8 * fq;
#pragma unroll
        for (int ai = 0; ai < 2; ++ai)
#pragma unroll
            for (int m = 0; m < 4; ++m) { bf16* rowp = O + (size_t)(row0 + ai * HALF + m * 16) * ldc + col0;
#pragma unroll
                for (int bj = 0; bj < 2; ++bj) { const f32x4 v0 = acc[ai][bj][m][0], v1 = acc[ai][bj][m][1];
                    u32x4 w; w.x = cvt_pk_bf16(v0[0], v0[1]); w.y = cvt_pk_bf16(v0[2], v0[3]); w.z = cvt_pk_bf16(v1[0], v1[1]); w.w = cvt_pk_bf16(v1[2], v1[3]);
                    *(u32x4*)(rowp + bj * HALF) = w; } }
    }
};
struct EpiResGate {
    static constexpr bool PERM = true, PUBLISH = false;
    const float* base32; const bf16* base16; bf16* out; const float* gate;
    __device__ __forceinline__ void operator()(const f32x4 (&acc)[2][2][4][2], const Unit& u, int wr, int wc, int fr, int fq) const {
        const int col0 = u.pn * BM + wc * 32 + 8 * fq; const float* g = gate + (size_t)(u.pm >> 3) * 6144 + col0;
        f32x4 gv[2][2];
#pragma unroll
        for (int bj = 0; bj < 2; ++bj)
#pragma unroll
            for (int n = 0; n < 2; ++n) gv[bj][n] = *(const f32x4*)(g + bj * HALF + n * 4);
#pragma unroll
        for (int ai = 0; ai < 2; ++ai)
#pragma unroll
            for (int m = 0; m < 4; ++m) { const size_t off = (size_t)(u.pm * BM + ai * HALF + wr * 64 + m * 16 + fr) * DM + col0;
#pragma unroll
                for (int bj = 0; bj < 2; ++bj) { f32x4 b0, b1;
                    if (base32) { b0 = *(const f32x4*)(base32 + off + bj * HALF); b1 = *(const f32x4*)(base32 + off + bj * HALF + 4); }
                    else { const u32x4 r = *(const u32x4*)(base16 + off + bj * HALF);
                        b0 = (f32x4){bf2f(r.x & 0xffff), bf2f(r.x >> 16), bf2f(r.y & 0xffff), bf2f(r.y >> 16)}; b1 = (f32x4){bf2f(r.z & 0xffff), bf2f(r.z >> 16), bf2f(r.w & 0xffff), bf2f(r.w >> 16)}; }
                    const f32x4 v0 = b0 + gv[bj][0] * acc[ai][bj][m][0], v1 = b1 + gv[bj][1] * acc[ai][bj][m][1];
                    u32x4 w; w.x = cvt_pk_bf16(v0[0], v0[1]); w.y = cvt_pk_bf16(v0[2], v0[3]); w.z = cvt_pk_bf16(v1[0], v1[1]); w.w = cvt_pk_bf16(v1[2], v1[3]);
                    *(u32x4*)(out + off + bj * HALF) = w; } }
    }
};
struct EpiSwiglu {
    static constexpr bool PERM = true, PUBLISH = true;
    bf16* O; unsigned* flag;
    __device__ __forceinline__ void operator()(const f32x4 (&acc)[2][2][4][2], const Unit& u, int wr, int wc, int fr, int fq) const {
        const int row0 = u.pm * BM + wr * 64 + fr; const int col0 = u.pn * HALF + wc * 32 + 8 * fq;
#pragma unroll
        for (int ai = 0; ai < 2; ++ai)
#pragma unroll
            for (int m = 0; m < 4; ++m) { bf16* rowp = O + (size_t)(row0 + ai * HALF + m * 16) * FF + col0;
                float hv[8];
#pragma unroll
                for (int n = 0; n < 2; ++n)
#pragma unroll
                    for (int i = 0; i < 4; ++i) { const float a = acc[ai][0][m][n][i], b = acc[ai][1][m][n][i];
                        const float sg = __builtin_amdgcn_rcpf(1.f + __builtin_amdgcn_exp2f(-a * LOG2E)); hv[n * 4 + i] = a * sg * b; }
                u32x4 w; w.x = cvt_pk_bf16(hv[0], hv[1]); w.y = cvt_pk_bf16(hv[2], hv[3]); w.z = cvt_pk_bf16(hv[4], hv[5]); w.w = cvt_pk_bf16(hv[6], hv[7]);
                asm volatile("global_store_dwordx4 %0, %1, off sc1\n\ts_nop 2" :: "v"((const GAS bf16*)rowp), "v"(w) : "memory"); }
    }
};

template <class Epi, class Sched, bool ALIGN_EPI = false, bool SP2 = false, bool GATHER = false>
__device__ __forceinline__ void gemm_phase(LAS unsigned char* lds, const Gemm g, const Sched& S, const Epi& E, const int tid, const LAS int* rowl = nullptr) {
    static_assert(!GATHER || SP2, "gather mode is written for the SP2 loop");
    const int wid = __builtin_amdgcn_readfirstlane(tid >> 6), lane = tid & 63, wr = wid >> 2, wc = wid & 3, fr = lane & 15, fq = lane >> 4;
    const int K = g.K, nt = K / BK;
    unsigned voffA[2], voffB[2];
#pragma unroll
    for (int i = 0; i < 2; ++i) { int R, C; stage_rc(tid * 16 + i * 8192, R, C); const int Rb = Epi::PERM ? ((R & ~31) + perm32(R & 31)) : R;
        voffA[i] = (unsigned)(R * K + C) * 2u; voffB[i] = (unsigned)(Rb * K + C) * 2u; }
    const size_t kstep = (size_t)(BK * 2);
    const size_t hstep = (size_t)HALF * K * 2;
    const size_t tstep = 2 * hstep;
    const size_t hstepA = GATHER ? 0 : hstep, tstepA = GATHER ? 0 : tstep;
    unsigned voffGc[2][2], voffGn[2][2];
    int gR[2], gC[2];
#pragma unroll
    for (int i = 0; i < 2; ++i) stage_rc(tid * 16 + i * 8192, gR[i], gC[i]);
#define PG8_GOFF(dst, ui_) do { _Pragma("unroll") for (int h_ = 0; h_ < 2; ++h_) _Pragma("unroll") for (int i_ = 0; i_ < 2; ++i_) \
        dst[h_][i_] = (unsigned)rowl[(ui_) * 256 + h_ * HALF + gR[i_]] * (unsigned)(K * 2) + (unsigned)gC[i_] * 2u; } while (0)
    const unsigned ldsw = (unsigned)wid * 1024u;
    const int aoff = lds_byte(wr * 64 + fr, fq * 8), boff = lds_byte(wc * 32 + fr, fq * 8);
#define PG8_SA(b, h) (((b) * 2 + (h)) * HTB)
#define PG8_SB(b, h) ((4 + (b) * 2 + (h)) * HTB)
#define PG8_STAGE(bufoff, gbase, voff) do { _Pragma("unroll") for (int _i = 0; _i < 2; ++_i) \
        __builtin_amdgcn_global_load_lds((const unsigned*)((const char*)(gbase) + (voff)[_i]), (LAS unsigned*)(lds + (bufoff) + ldsw + _i * 8192), 16, 0, 0); } while (0)
#define PG8_STAGE_A(bufoff, gbase, H, NXT) do { if constexpr (GATHER) { unsigned vo_[2]; vo_[0] = (NXT) ? voffGn[H][0] : voffGc[H][0]; vo_[1] = (NXT) ? voffGn[H][1] : voffGc[H][1]; PG8_STAGE(bufoff, gbase, vo_); } \
        else { PG8_STAGE(bufoff, (const char*)(gbase) + (H) * hstep, voffA); } } while (0)
#define PG8_LDA(dst, b, h) do { _Pragma("unroll") for (int m = 0; m < 4; ++m) _Pragma("unroll") for (int k = 0; k < 2; ++k) dst[m][k] = *(const LAS bf16x8*)(lds + PG8_SA(b, h) + aoff + m * 2048 + k * 1024); } while (0)
#define PG8_LDB(dst, b, h) do { _Pragma("unroll") for (int n = 0; n < 2; ++n) _Pragma("unroll") for (int k = 0; k < 2; ++k) dst[n][k] = *(const LAS bf16x8*)(lds + PG8_SB(b, h) + boff + n * 2048 + k * 1024); } while (0)
#define PG8_MMA(ai, bj, At, Bt) do { __builtin_amdgcn_s_setprio(1); _Pragma("unroll") for (int m = 0; m < 4; ++m) _Pragma("unroll") for (int n = 0; n < 2; ++n) _Pragma("unroll") for (int k = 0; k < 2; ++k) \
        acc[ai][bj][m][n] = __builtin_amdgcn_mfma_f32_16x16x32_bf16(Bt[n][k], At[m][k], acc[ai][bj][m][n], 0, 0, 0); __builtin_amdgcn_s_setprio(0); } while (0)
#define PG8_WAIT_V(n) asm volatile("s_waitcnt vmcnt(" #n ")" ::: "memory")
#define PG8_WAIT_L(n) asm volatile("s_waitcnt lgkmcnt(" #n ")" ::: "memory")
#define PG8_BAR __builtin_amdgcn_s_barrier()
#define PG8_SCHED __builtin_amdgcn_sched_barrier(0)
    Unit cur, nxt; int ui = 0;
    if (!S.next(0, cur)) return;
    f32x4 acc[2][2][4][2];
#pragma unroll
    for (int a = 0; a < 2; ++a)
#pragma unroll
        for (int b = 0; b < 2; ++b)
#pragma unroll
            for (int m = 0; m < 4; ++m)
#pragma unroll
                for (int n = 0; n < 2; ++n) acc[a][b][m][n] = (f32x4){0.f, 0.f, 0.f, 0.f};
    bf16x8 At[4][2], B0[2][2], B1[2][2];
    const char* cA = (const char*)g.A + (size_t)cur.pm * tstepA; const char* cB = (const char*)g.Bt + cur.bo + (size_t)cur.pn * tstep;
    if constexpr (GATHER) { PG8_GOFF(voffGc, 0); PG8_GOFF(voffGn, 0); }
    if constexpr (SP2) {
        PG8_STAGE(PG8_SB(0, 0), cB, voffB); PG8_STAGE(PG8_SB(0, 1), cB + hstep, voffB); PG8_STAGE_A(PG8_SA(0, 0), cA, 0, false); PG8_STAGE_A(PG8_SA(0, 1), cA, 1, false);
        if (wr == 1) PG8_BAR;
        PG8_WAIT_V(2); PG8_BAR;
        PG8_STAGE(PG8_SB(1, 0), cB + kstep, voffB); PG8_STAGE_A(PG8_SA(1, 0), cA + kstep, 0, false); PG8_STAGE(PG8_SB(1, 1), cB + hstep + kstep, voffB);
        PG8_WAIT_V(6); PG8_BAR;
    } else {
        PG8_STAGE(PG8_SB(0, 0), cB, voffB); PG8_STAGE(PG8_SA(0, 0), cA, voffA); PG8_STAGE(PG8_SB(0, 1), cB + hstep, voffB); PG8_STAGE(PG8_SA(0, 1), cA + hstep, voffA);
        if (wr == 1) PG8_BAR;
        PG8_WAIT_V(4); PG8_BAR;
        PG8_STAGE(PG8_SB(1, 0), cB + kstep, voffB); PG8_STAGE(PG8_SA(1, 0), cA + kstep, voffA); PG8_STAGE(PG8_SB(1, 1), cB + hstep + kstep, voffB);
        PG8_WAIT_V(6); PG8_BAR;
    }
    for (;;) {
        const bool has_next = S.next(ui + 1, nxt);
        if constexpr (GATHER) { if (has_next) PG8_GOFF(voffGn, ui + 1); }
        const char* nA = has_next ? (const char*)g.A + (size_t)nxt.pm * tstepA : cA; const char* nB = has_next ? (const char*)g.Bt + nxt.bo + (size_t)nxt.pn * tstep : cB;
#pragma unroll 1
        for (int t = 0; t < nt; t += 2) {
            const bool last = (t == nt - 2);
            const char* a1 = cA + (size_t)(t + 1) * kstep;
            const char* a2 = last ? nA : cA + (size_t)(t + 2) * kstep; const char* b2 = last ? nB : cB + (size_t)(t + 2) * kstep;
            const char* a3 = a2 + kstep; const char* b3 = b2 + kstep;
            if constexpr (SP2) {
            PG8_LDB(B0, 0, 0); PG8_LDB(B1, 0, 1); PG8_SCHED; PG8_LDA(At, 0, 0); PG8_STAGE_A(PG8_SA(1, 1), a1, 1, false);
            PG8_WAIT_V(8); PG8_WAIT_L(0); PG8_BAR; PG8_MMA(0, 0, At, B0); PG8_MMA(0, 1, At, B1); PG8_BAR; PG8_SCHED;
            PG8_LDA(At, 0, 1); PG8_STAGE(PG8_SB(0, 0), b2, voffB); PG8_STAGE(PG8_SB(0, 1), b2 + hstep, voffB); PG8_STAGE_A(PG8_SA(0, 0), a2, 0, last);
            PG8_WAIT_V(8); PG8_WAIT_L(0); PG8_BAR; PG8_MMA(1, 0, At, B0); PG8_MMA(1, 1, At, B1); PG8_BAR; PG8_SCHED;
            PG8_LDB(B0, 1, 0); PG8_LDB(B1, 1, 1); PG8_SCHED; PG8_LDA(At, 1, 0); PG8_STAGE_A(PG8_SA(0, 1), a2, 1, last);
            PG8_WAIT_V(8); PG8_WAIT_L(0); PG8_BAR; PG8_MMA(0, 0, At, B0); PG8_MMA(0, 1, At, B1); PG8_BAR; PG8_SCHED;
            PG8_LDA(At, 1, 1); PG8_STAGE(PG8_SB(1, 0), b3, voffB); PG8_STAGE(PG8_SB(1, 1), b3 + hstep, voffB); PG8_STAGE_A(PG8_SA(1, 0), a3, 0, last);
            PG8_WAIT_V(8); PG8_WAIT_L(0); PG8_BAR; PG8_MMA(1, 0, At, B0); PG8_MMA(1, 1, At, B1); PG8_BAR; PG8_SCHED;
            } else {
            PG8_LDB(B0, 0, 0); PG8_SCHED; PG8_LDA(At, 0, 0); PG8_STAGE(PG8_SA(1, 1), a1 + hstep, voffA);
            PG8_WAIT_L(8); PG8_BAR; PG8_WAIT_L(0); PG8_MMA(0, 0, At, B0); PG8_BAR; PG8_SCHED;
            PG8_LDB(B1, 0, 1); PG8_STAGE(PG8_SB(0, 0), b2, voffB);
            PG8_BAR; PG8_WAIT_L(0); PG8_MMA(0, 1, At, B1); PG8_BAR;
            PG8_LDA(At, 0, 1); PG8_STAGE(PG8_SA(0, 0), a2, voffA);
            PG8_BAR; PG8_WAIT_L(0); PG8_MMA(1, 0, At, B0); PG8_BAR; PG8_SCHED;
            PG8_STAGE(PG8_SB(0, 1), b2 + hstep, voffB);
            PG8_WAIT_V(6); PG8_BAR; PG8_MMA(1, 1, At, B1); PG8_BAR;
            PG8_LDB(B0, 1, 0); PG8_SCHED; PG8_LDA(At, 1, 0); PG8_STAGE(PG8_SA(0, 1), a2 + hstep, voffA);
            PG8_WAIT_L(8); PG8_BAR; PG8_WAIT_L(0); PG8_MMA(0, 0, At, B0); PG8_BAR; PG8_SCHED;
            PG8_LDB(B1, 1, 1); PG8_STAGE(PG8_SB(1, 0), b3, voffB);
            PG8_BAR; PG8_WAIT_L(0); PG8_MMA(0, 1, At, B1); PG8_BAR;
            PG8_LDA(At, 1, 1); PG8_STAGE(PG8_SA(1, 0), a3, voffA);
            PG8_BAR; PG8_WAIT_L(0); PG8_MMA(1, 0, At, B0); PG8_BAR; PG8_SCHED;
            PG8_STAGE(PG8_SB(1, 1), b3 + hstep, voffB);
            PG8_WAIT_V(6); PG8_BAR; PG8_MMA(1, 1, At, B1); PG8_BAR;
            }
        }
        if constexpr (ALIGN_EPI) { if (wr == 0) PG8_BAR; }
        E(acc, cur, wr, wc, fr, fq);
        if constexpr (Epi::PUBLISH) {
            asm volatile("s_waitcnt vmcnt(0)" ::: "memory"); PG8_BAR;
            if (tid == 0) __hip_atomic_fetch_add(E.flag + cur.pm * 16, 1u, __ATOMIC_RELAXED, __HIP_MEMORY_SCOPE_AGENT);
        }
        if (!has_next) break;
#pragma unroll
        for (int a = 0; a < 2; ++a)
#pragma unroll
            for (int b = 0; b < 2; ++b)
#pragma unroll
                for (int m = 0; m < 4; ++m)
#pragma unroll
                    for (int n = 0; n < 2; ++n) acc[a][b][m][n] = (f32x4){0.f, 0.f, 0.f, 0.f};
        cur = nxt; cA = nA; cB = nB; ++ui;
        if constexpr (GATHER) { _Pragma("unroll") for (int h_ = 0; h_ < 2; ++h_) _Pragma("unroll") for (int i_ = 0; i_ < 2; ++i_) voffGc[h_][i_] = voffGn[h_][i_]; }
        if constexpr (ALIGN_EPI) { if (wr == 1) PG8_BAR; }
    }
    PG8_WAIT_V(0);
    if constexpr (!ALIGN_EPI) { if (wr == 0) PG8_BAR; }
    PG8_BAR;
#undef PG8_SA
#undef PG8_STAGE_A
#undef PG8_GOFF
#undef PG8_SB
#undef PG8_STAGE
#undef PG8_LDA
#undef PG8_LDB
#undef PG8_MMA
#undef PG8_WAIT_V
#undef PG8_WAIT_L
#undef PG8_BAR
#undef PG8_SCHED
}
}

#define XB_TMO      128
#define XB_XCNT(j)  (256  + 64 * (j))
#define XB_XSUB(j)  (1280 + 64 * (j))
#define XB_XGEN(j)  (2304 + 64 * (j))
#define XB_TOP      3328
#define XB_TOPGEN   3392
#define XCD_BAR_WORDS 3456
#define XB_SPIN_CAP (1u << 18)
__device__ __forceinline__ unsigned xb_ld(unsigned* p)              { return __hip_atomic_load(p, __ATOMIC_RELAXED, __HIP_MEMORY_SCOPE_AGENT); }
__device__ __forceinline__ unsigned xb_add(unsigned* p, unsigned v) { return __hip_atomic_fetch_add(p, v, __ATOMIC_RELAXED, __HIP_MEMORY_SCOPE_AGENT); }
__device__ __forceinline__ unsigned xb_xcc_id() { return (unsigned)__builtin_amdgcn_s_getreg((3 << 11) | 20) & 0xFu; }
#define XB_SPIN(cond, bar) do { unsigned _sp = 0; while (cond) { __builtin_amdgcn_s_sleep(1); \
    if ((++_sp & 255u) == 0u) { if (xb_ld(&(bar)[XB_TMO])) break; if (_sp > XB_SPIN_CAP) { atomicAdd(&(bar)[XB_TMO], 1u); break; } } } } while (0)
struct XcdBarrier { unsigned* bar; unsigned x; volatile LAS unsigned* st; };
__device__ __forceinline__ XcdBarrier xcd_barrier_post(unsigned* bar, volatile LAS unsigned* st) {
    XcdBarrier b; b.bar = bar; b.x = xb_xcc_id(); b.st = st;
    if (threadIdx.x == 0) (void)xb_add(&bar[XB_XCNT(b.x)], 1u);
    return b;
}
__device__ __forceinline__ void xcd_barrier_complete(unsigned* bar, unsigned x, unsigned& nloc, unsigned& nx) {
    const unsigned G = gridDim.x * gridDim.y * gridDim.z;
    unsigned sum, cnt, mine, sp = 0u;
    for (;;) {
        sum = 0u; cnt = 0u; mine = 0u;
#pragma unroll 1
        for (unsigned j = 0; j < 16; ++j) { const unsigned c = xb_ld(&bar[XB_XCNT(j)]); sum += c; cnt += (c > 0u) ? 1u : 0u; mine = (j == x) ? c : mine; }
        if (sum == G) break;
        __builtin_amdgcn_s_sleep(1);
        if ((++sp & 255u) == 0u) { if (xb_ld(&bar[XB_TMO])) break; if (sp > XB_SPIN_CAP) { atomicAdd(&bar[XB_TMO], 1u); break; } }
    }
    nloc = mine > 0u ? mine : 1u; nx = cnt > 0u ? cnt : 1u;
}
__device__ __forceinline__ void xcd_barrier(const XcdBarrier& b, const int tid) {
    asm volatile("s_waitcnt vmcnt(0)" ::: "memory");
    __syncthreads();
    if (tid == 0) {
        unsigned* bar = b.bar;
        __builtin_amdgcn_s_waitcnt(0);
        unsigned nloc = b.st[0], nx = b.st[1];
        if (nloc == 0u) { xcd_barrier_complete(bar, b.x, nloc, nx); b.st[0] = nloc; b.st[1] = nx; }
        const unsigned old = xb_add(&bar[XB_XSUB(b.x)], 1u);
        const unsigned gen = old / nloc;
        if (old + 1u == (gen + 1u) * nloc) {
            __builtin_amdgcn_fence(__ATOMIC_RELEASE, "agent");
            asm volatile("s_waitcnt vmcnt(0)" ::: "memory");
            const unsigned og = xb_add(&bar[XB_TOP], 1u);
            const unsigned tg = og / nx;
            if (og + 1u == (tg + 1u) * nx) xb_add(&bar[XB_TOPGEN], 1u);
            else XB_SPIN(xb_ld(&bar[XB_TOPGEN]) == tg, bar);
            __builtin_amdgcn_fence(__ATOMIC_ACQUIRE, "agent");
            xb_add(&bar[XB_XGEN(b.x)], 1u);
            asm volatile("s_waitcnt vmcnt(0)" ::: "memory");
        } else {
            XB_SPIN(xb_ld(&bar[XB_XGEN(b.x)]) == gen, bar);
            __builtin_amdgcn_fence(__ATOMIC_ACQUIRE, "agent");
            asm volatile("s_waitcnt vmcnt(0)" ::: "memory");
        }
    }
    __syncthreads();
}

struct Frame {
    LAS unsigned char* lds;
    volatile LAS unsigned* MISC;
    unsigned* ctl;
    int tid, lane, wave, vcu, G, bx;
    float* out; unsigned char* ws;
};
struct Args { const float* in[28]; float* out; unsigned char* ws; int ph_lo, ph_hi; };
enum { I_X = 0, I_C, I_ADAW, I_ADAB, I_N1G, I_N2G, I_WIN, I_BF, I_QNA, I_KNA, I_QNC, I_KNC, I_LQ1, I_LK1, I_LQ2, I_LK2, I_SUBLN, I_QND, I_KND, I_MIXB, I_WOUT,
       I_WG, I_BG, I_WE, I_BE, I_W1, I_W3, I_W2 };
template <int I> __device__ __forceinline__ const float* inp() {
    auto ka = __builtin_amdgcn_kernarg_segment_ptr(); unsigned long long raw;
    asm volatile("s_load_dwordx2 %0, %1, %2\n\ts_waitcnt lgkmcnt(0)" : "=s"(raw) : "s"(ka), "i"(I * 8));
    return (const float*)(const GAS float*)raw;
}


struct TItem { const float* W; bf16* WT; const float* rs; int ldw, K, dst_row0, src_n0, kb, mapin; };
__device__ __forceinline__ int colmap_in(int n) { return n < 768 ? n : (n < 2984 ? n + 4 : (n < 2988 ? n - 2984 + 768 : -1)); }
__device__ __forceinline__ void t_load(const TItem& T, f32x4 (&v)[8], int lane) {
    const int k0 = 64 * T.kb, r8 = lane >> 3, c4 = (lane & 7) * 4; const int sc = T.mapin ? colmap_in(T.src_n0 + c4) : T.src_n0 + c4;
#pragma unroll
    for (int i = 0; i < 8; ++i) { v[i] = (f32x4){0.f, 0.f, 0.f, 0.f}; if (sc >= 0) v[i] = *(const f32x4*)(T.W + (size_t)(k0 + 8 * r8 + i) * T.ldw + sc); }
}
__device__ __forceinline__ void t_store(const TItem& T, f32x4 (&v)[8], LAS float* scr, int lane) {
    (void)scr;
    const int k0 = 64 * T.kb, r8 = lane >> 3, c4 = (lane & 7) * 4;
    if (T.rs) {
#pragma unroll
        for (int i = 0; i < 8; ++i) v[i] = v[i] * T.rs[k0 + 8 * r8 + i]; }
#pragma unroll
    for (int c = 0; c < 4; ++c) { u32x4 o; o.x = pg8::cvt_pk_bf16(v[0][c], v[1][c]); o.y = pg8::cvt_pk_bf16(v[2][c], v[3][c]); o.z = pg8::cvt_pk_bf16(v[4][c], v[5][c]); o.w = pg8::cvt_pk_bf16(v[6][c], v[7][c]);
        *(GAS u32x4*)(T.WT + (size_t)(T.dst_row0 + c4 + c) * T.K + k0 + 8 * r8) = o; }
}
__device__ __forceinline__ float lambda_init(int l) { return l == 0 ? 0.2f : (0.8f - 0.6f * 0.7408182206817179f); }

constexpr int CI_IN = 16 * 96, CI_OUT = 16 * 32, CI_UP1 = 16 * 8, CI_DN = 4 * 32, CN_UP = 32 * 2 * CI_UP1, CN_DN = 32 * CI_DN, NITEMS_L = CI_IN + CI_OUT + CN_UP + CN_DN;
__device__ __forceinline__ void fill_rowscale(Frame& F, const Args& A, int l, LAS float* rsl) {
    for (int k = F.tid; k < DM; k += 512) { float v = inp<I_MIXB>()[l * DM + k];
        if (k >= 512 && k < 768) v *= inp<I_SUBLN>()[l * 64 + ((k - 512) & 63)] * (1.f - lambda_init(l)); rsl[k] = v; }
}
__device__ __forceinline__ void convert_items(Frame& F, const Args& A, int l, int first, int stride, int limit, LAS float* rsl) {
    LAS float* scr = (LAS float*)(F.lds + F.wave * 8704);
    bf16* WIN = (bf16*)(F.ws + WS_WIN); bf16* WOUT = (bf16*)(F.ws + WS_WOUT); bf16* WUP = (bf16*)(F.ws + WS_WUP); bf16* WDN = (bf16*)(F.ws + WS_WDN);
    auto decode = [&](int it, TItem& T) {
        int r = it; T.rs = nullptr; T.mapin = 0;
        if (r < CI_IN) { T.kb = r / 96; const int nb = r % 96;
            T.W = inp<I_WIN>() + (size_t)l * DM * P_IN; T.ldw = P_IN; T.K = DM; T.WT = WIN + (size_t)l * NP * DM; T.dst_row0 = 32 * nb; T.src_n0 = 32 * nb; T.mapin = 1; return; }
        r -= CI_IN;
        if (r < CI_OUT) { T.kb = r / 32; const int nb = r % 32;
            T.W = inp<I_WOUT>() + (size_t)l * DM * DM; T.ldw = DM; T.K = DM; T.WT = WOUT + (size_t)l * DM * DM; T.dst_row0 = 32 * nb; T.src_n0 = 32 * nb; T.rs = (const float*)rsl; return; }
        r -= CI_OUT;
        if (r < CN_UP) { const int le = l * 32 + r / (2 * CI_UP1), q = r % (2 * CI_UP1), which = q / CI_UP1, q2 = q % CI_UP1; T.kb = q2 / 8; const int nb = q2 % 8;
            T.W = (which == 0 ? inp<I_W1>() : inp<I_W3>()) + (size_t)le * DM * FF; T.ldw = FF; T.K = DM; T.WT = WUP + (size_t)le * 512 * DM;
            const int n0 = 32 * nb, pn = n0 >> 7, j = n0 & 127; T.dst_row0 = 256 * pn + 128 * which + j; T.src_n0 = n0; return; }
        r -= CN_UP;
        { const int le = l * 32 + r / CI_DN, q = r % CI_DN; T.kb = q / 32; const int nb = q % 32;
          T.W = inp<I_W2>() + (size_t)le * FF * DM; T.ldw = DM; T.K = FF; T.WT = WDN + (size_t)le * DM * FF; T.dst_row0 = 32 * nb; T.src_n0 = 32 * nb; }
    };
    TItem T0, T1, T2; f32x4 v0[8], v1[8], v2[8]; int it = first;
    if (it < limit) { decode(it, T0); t_load(T0, v0, F.lane); }
    if (it + stride < limit) { decode(it + stride, T1); t_load(T1, v1, F.lane); }
    while (it < limit) {
        if (it + 2 * stride < limit) { decode(it + 2 * stride, T2); t_load(T2, v2, F.lane); }
        t_store(T0, v0, scr, F.lane); it += stride; if (it >= limit) break;
        if (it + 2 * stride < limit) { decode(it + 2 * stride, T0); t_load(T0, v0, F.lane); }
        t_store(T1, v1, scr, F.lane); it += stride; if (it >= limit) break;
        if (it + 2 * stride < limit) { decode(it + 2 * stride, T1); t_load(T1, v1, F.lane); }
        t_store(T2, v2, scr, F.lane); it += stride;
    }
}
constexpr int CV_L0 = NITEMS_L - CI_IN, CV_TOTAL = CV_L0 + NITEMS_L, CV_CHUNK = 64, CW_CVQ = 192;
__device__ __forceinline__ void convert_chunk(Frame& F, const Args& A, int gbase, LAS float* rsl2  ) {
    const int g0 = gbase + F.wave * (CV_CHUNK / NWAVES);
#pragma unroll 1
    for (int l = 0; l < 2; ++l) {
        const int lo = g0 > (l ? CV_L0 : 0) ? g0 : (l ? CV_L0 : 0), hi0 = g0 + CV_CHUNK / NWAVES, hi = hi0 < (l ? CV_TOTAL : CV_L0) ? hi0 : (l ? CV_TOTAL : CV_L0);
        if (lo < hi) { const int off = l ? -CV_L0 : CI_IN; convert_items(F, A, l, lo + off, 1, hi + off, rsl2 + l * DM); }
    }
}
__device__ __forceinline__ void convert_layer1_in_gap(Frame& F, const Args& A, int n2  ) {
    LAS float* rsl = (LAS float*)(F.lds + 8 * 8704);
    if (n2 < 0) n2 = 0; if (n2 > F.G - 32) n2 = F.G - 32;
    if (F.bx < n2) return;
    fill_rowscale(F, A, 1, rsl);
    __syncthreads();
    const int nw = (F.G - n2) * NWAVES;
    convert_items(F, A, 1, (F.bx - n2) * NWAVES + F.wave, nw, NITEMS_L, rsl);
    __syncthreads();
}

__device__ __forceinline__ void p0_prologue(Frame& F, const Args& A) {
    LAS float* rsl = (LAS float*)(F.lds + 8 * 8704);
    fill_rowscale(F, A, 0, rsl);
    __syncthreads();
    const int gw = F.vcu * NWAVES + F.wave, NGW = F.G * NWAVES;
    convert_items(F, A, 0, gw, NGW, BG_CONVERT ? CI_IN : NITEMS_L, rsl);
    if (!GAP_CONVERT && !BG_CONVERT) { __syncthreads(); fill_rowscale(F, A, 1, rsl); __syncthreads(); convert_items(F, A, 1, gw, NGW, NITEMS_L, rsl); }
    { bf16* WRH = (bf16*)(F.ws + WS_WR); bf16* WRL = WRH + 2 * 48 * DM;
      for (int i = gw * 64 + F.lane; i < 2 * 48 * DM; i += NGW * 64) { const int l = i / (48 * DM), r = i % (48 * DM), o = r >> 10, k = r & 1023;
          float w = 0.f; if (o < 4) w = inp<I_WG>()[((size_t)l * DM + k) * 4 + o]; else if (o < 36) w = inp<I_WE>()[((size_t)l * DM + k) * 32 + (o - 4)];
          const unsigned hi = f2bf(w); WRH[i] = (bf16)hi; WRL[i] = (bf16)f2bf(w - bf2f((unsigned short)hi)); } }
    if (F.bx == 0 && F.wave == 0) {
        for (int l = 0; l < 2; ++l) { float a = 0.f, b = 0.f; if (F.lane < 32) { a = inp<I_LQ1>()[l * 32 + F.lane] * inp<I_LK1>()[l * 32 + F.lane]; b = inp<I_LQ2>()[l * 32 + F.lane] * inp<I_LK2>()[l * 32 + F.lane]; }
            a = wave_sum(a); b = wave_sum(b); if (F.lane == 0) ((float*)(F.ws + WS_MISC))[l] = __expf(a) - __expf(b) + lambda_init(l); }
    }
    __syncthreads();
    LAS float* cact = (LAS float*)F.lds;
    LAS float* red = (LAS float*)(F.lds + 32768);
    for (int i = F.tid; i < BATCH * DM; i += 512) { const float c = inp<I_C>()[i]; cact[i] = c / (1.f + __expf(-c)); }
    __syncthreads();
    for (int item = F.bx; item < 2 * 96; item += F.G) {
        const int l = item / 96, nb = item % 96, n = nb * 64 + F.lane; const float* aw = inp<I_ADAW>() + (size_t)l * DM * 6144 + n;
        float acc[8];
#pragma unroll
        for (int b = 0; b < 8; ++b) acc[b] = 0.f;
        const int k0 = F.wave * 128;
#pragma unroll 32
        for (int k = 0; k < 128; ++k) { const float w = aw[(size_t)(k0 + k) * 6144];
#pragma unroll
            for (int b = 0; b < 8; ++b) acc[b] += cact[b * DM + k0 + k] * w; }
#pragma unroll
        for (int b = 0; b < 8; ++b) red[(F.wave * 8 + b) * 64 + F.lane] = acc[b];
        __syncthreads();
        { const int b = F.wave; float s = inp<I_ADAB>()[l * 6144 + n];
#pragma unroll
          for (int w = 0; w < 8; ++w) s += red[(w * 8 + b) * 64 + F.lane];
          ((float*)(F.ws + WS_MOD))[((size_t)l * 8 + b) * 6144 + n] = s; }
        __syncthreads();
    }
}

__device__ __forceinline__ void build_tables(Frame& F, int l) {
    volatile LAS int* cnts = (volatile LAS int*)(F.lds + CNTS_OFF); volatile LAS int* base = (volatile LAS int*)(F.lds + BASE_OFF); volatile LAS int* tab = (volatile LAS int*)(F.lds + TAB_OFF);
    __syncthreads();
    if (F.tid < 64) {
        const int e = F.tid; int cnt = 0; if (e < 32) cnt = (int)__hip_atomic_load(F.ctl + CW_CNT + (l * 32 + e) * 16, RLX_AGENT);
        const int n = (cnt + 255) >> 8; int incl = n;
#pragma unroll
        for (int o = 1; o < 32; o <<= 1) { const int u = shup_i(incl, o, e); if (e >= o) incl += u; }
        const int t0 = incl - n;
        if (e < 32) { cnts[e] = cnt; base[e] = t0; for (int j = 0; j < n && t0 + j < MAXTILE; ++j) tab[t0 + j] = e; }
        if (e == 31) F.MISC[1] = (unsigned)(incl < MAXTILE ? incl : MAXTILE);
    }
    __syncthreads();
}
__device__ __forceinline__ void row_pass(Frame& F, const Args& A, int mode, int l) {
    const int gw = F.vcu * NWAVES + F.wave; const int lane = F.lane;
    const float* MOD = (const float*)(F.ws + WS_MOD);
    bf16* X1 = (bf16*)(F.ws + WS_X1); bf16* H = (bf16*)(F.ws + WS_H); const bf16* Y = (const bf16*)(F.ws + WS_Y);
    const int* tok_e = (const int*)(F.ws + WS_TOK); const int* tok_pos = (const int*)(F.ws + WS_TOK) + 4 * M; const float* tok_w = (const float*)(F.ws + WS_TOK) + 2 * M;
    volatile LAS int* basel = (volatile LAS int*)(F.lds + BASE_OFF);
    if (mode != 0) build_tables(F, mode == 1 ? 0 : 1);
    const int b = (gw * 8) >> 11; const int lp = (mode == 1) ? 0 : 1;
    f32x4 g2v[4], gm[4], shv[4];
#pragma unroll
    for (int j = 0; j < 4; ++j) { const int col = 256 * j + 4 * lane;
        g2v[j] = (f32x4){0.f, 0.f, 0.f, 0.f}; gm[j] = g2v[j]; shv[j] = g2v[j];
        if (mode != 0) g2v[j] = *(const f32x4*)(MOD + ((size_t)lp * 8 + b) * 6144 + 5 * DM + col);
        if (mode != 2) { const float* md = MOD + ((size_t)l * 8 + b) * 6144; gm[j] = *(const f32x4*)(inp<I_N1G>() + l * DM + col) * (*(const f32x4*)(md + DM + col) + 1.0f); shv[j] = *(const f32x4*)(md + col); } }
    for (int m0 = gw * 8; m0 < gw * 8 + 8; m0 += 4) {
        f32x4 v[4][4]; u32x2 ya[4][4], yb[4][4]; float wa[4], wb[4];
        if (mode != 0) {
            int sa[4], sb[4];
#pragma unroll
            for (int r = 0; r < 4; ++r) { const int m = m0 + r; sa[r] = 256 * basel[tok_e[m]] + tok_pos[m]; sb[r] = 256 * basel[tok_e[M + m]] + tok_pos[M + m]; wa[r] = tok_w[m]; wb[r] = tok_w[M + m]; }
#pragma unroll
            for (int r = 0; r < 4; ++r)
#pragma unroll
                for (int j = 0; j < 4; ++j) { const int col = 256 * j + 4 * lane; ya[r][j] = *(const u32x2*)(Y + (size_t)sa[r] * DM + col); yb[r][j] = *(const u32x2*)(Y + (size_t)sb[r] * DM + col); }
        }
#pragma unroll
        for (int r = 0; r < 4; ++r) { const int m = m0 + r;
            if (mode == 0) { const float* xr = inp<I_X>() + (size_t)m * DM;
#pragma unroll
                for (int j = 0; j < 4; ++j) v[r][j] = *(const f32x4*)(xr + 256 * j + 4 * lane); }
            else { const bf16* xr = X1 + (size_t)m * DM;
#pragma unroll
                for (int j = 0; j < 4; ++j) { const u32x2 q = *(const u32x2*)(xr + 256 * j + 4 * lane); v[r][j] = (f32x4){bf2f(q.x & 0xffff), bf2f(q.x >> 16), bf2f(q.y & 0xffff), bf2f(q.y >> 16)}; } } }
#pragma unroll
        for (int r = 0; r < 4; ++r) { const int m = m0 + r;
            if (mode != 0) {
#pragma unroll
                for (int j = 0; j < 4; ++j) { const u32x2 a = ya[r][j], c = yb[r][j];
                    f32x4 mo; mo[0] = wa[r] * bf2f(a.x & 0xffff) + wb[r] * bf2f(c.x & 0xffff); mo[1] = wa[r] * bf2f(a.x >> 16) + wb[r] * bf2f(c.x >> 16);
                    mo[2] = wa[r] * bf2f(a.y & 0xffff) + wb[r] * bf2f(c.y & 0xffff); mo[3] = wa[r] * bf2f(a.y >> 16) + wb[r] * bf2f(c.y >> 16);
                    v[r][j] = v[r][j] + g2v[j] * mo; }
                if (mode == 1) {
#pragma unroll
                    for (int j = 0; j < 4; ++j) { u32x2 q; q.x = pk2(v[r][j][0], v[r][j][1]); q.y = pk2(v[r][j][2], v[r][j][3]); *(u32x2*)(X1 + (size_t)m * DM + 256 * j + 4 * lane) = q; }
                } else { float* orow = F.out + (size_t)m * DM;
#pragma unroll
                    for (int j = 0; j < 4; ++j) *(f32x4*)(orow + 256 * j + 4 * lane) = v[r][j]; }
            }
            if (mode != 2) {
                float ss = 0.f;
#pragma unroll
                for (int j = 0; j < 4; ++j) ss += (v[r][j][0] * v[r][j][0] + v[r][j][1] * v[r][j][1]) + (v[r][j][2] * v[r][j][2] + v[r][j][3] * v[r][j][3]);
                const float rstd = 1.0f / sqrtf(wave_sum(ss) * (1.f / DM) + RMS_EPS);
#pragma unroll
                for (int j = 0; j < 4; ++j) { const f32x4 hv = v[r][j] * rstd * gm[j] + shv[j]; u32x2 w; w.x = pk2(hv[0], hv[1]); w.y = pk2(hv[2], hv[3]);
                    *(u32x2*)(H + (size_t)m * DM + 256 * j + 4 * lane) = w; }
            }
        }
    }
}

__device__ __forceinline__ void knorm_seg(bf16* p, int lane, int nlanes_active, int group_lanes, const float* gain, int gmask, float inv_n) {
    u32x2 raw = (u32x2){0u, 0u}; if (lane < nlanes_active) raw = *(const u32x2*)(p + 4 * lane);
    float x0 = bf2f(raw.x & 0xffff), x1 = bf2f(raw.x >> 16), x2 = bf2f(raw.y & 0xffff), x3 = bf2f(raw.y >> 16);
    float ss = (x0 * x0 + x1 * x1) + (x2 * x2 + x3 * x3);
    for (int o = 1; o < group_lanes; o <<= 1) ss += __shfl_xor(ss, o);
    const float rstd = 1.0f / sqrtf(ss * inv_n + RMS_EPS);
    const int c = (4 * lane) & gmask;
    x0 *= rstd * gain[c]; x1 *= rstd * gain[c + 1]; x2 *= rstd * gain[c + 2]; x3 *= rstd * gain[c + 3];
    if (lane < nlanes_active) { u32x2 w; w.x = pk2(x0, x1); w.y = pk2(x2, x3); *(u32x2*)(p + 4 * lane) = w; }
}
__device__ __forceinline__ unsigned sortable(float f) { const unsigned u = __builtin_bit_cast(unsigned, f); return (u & 0x80000000u) ? ~u : (u | 0x80000000u); }


__device__ __forceinline__ int wave_sum_i(int v) {
    v += __builtin_amdgcn_update_dpp(0, v, 0xB1, 0xF, 0xF, true);
    v += __builtin_amdgcn_update_dpp(0, v, 0x4E, 0xF, 0xF, true);
    v += __builtin_amdgcn_update_dpp(0, v, 0x141, 0xF, 0xF, true);
    v += __builtin_amdgcn_update_dpp(0, v, 0x140, 0xF, 0xF, true);
    return __builtin_amdgcn_readlane(v, 0) + __builtin_amdgcn_readlane(v, 16) + __builtin_amdgcn_readlane(v, 32) + __builtin_amdgcn_readlane(v, 48);
}
__device__ __forceinline__ void transpose32(unsigned (&a)[32]) {
#define TSTAGE(S, MSK) _Pragma("unroll") for (int i = 0; i < 32; ++i) if (!(i & S)) { const unsigned x = a[i], y = a[i + S]; a[i] = (x & MSK) | ((y << S) & ~MSK); a[i + S] = ((x >> S) & MSK) | (y & ~MSK); }
    TSTAGE(16, 0x0000FFFFu) TSTAGE(8, 0x00FF00FFu) TSTAGE(4, 0x0F0F0F0Fu) TSTAGE(2, 0x33333333u) TSTAGE(1, 0x55555555u)
#undef TSTAGE
}
__device__ __forceinline__ void sel_step(unsigned T, unsigned& cand, unsigned& above, int& na, int& nc, bool& done, bool& exact) {
    const unsigned ones = cand & T; const int s1 = wave_sum_i(__builtin_popcount(ones));
    if (na + s1 >= 256) { cand = ones; nc = s1; }
    else { above |= ones; na += s1; cand &= ~T; nc -= s1; }
    if (na + nc == 256) { done = true; exact = true; }
}
__device__ __forceinline__ unsigned sel_finish(unsigned cand, unsigned above, int na, bool exact, int lane) {
    if (exact) return above | cand;
    const int need = 256 - na; const int pc = __builtin_popcount(cand); int incl = pc;
#pragma unroll
    for (int o = 1; o < 64; o <<= 1) { const int t = shup_i(incl, o, lane); if (lane >= o) incl += t; }
    int take = need - (incl - pc); take = take < 0 ? 0 : (take > pc ? pc : take);
    unsigned w = cand, res = above;
    for (int k = 0; k < take; ++k) { const unsigned low = w & (0u - w); res |= low; w ^= low; }
    return res;
}

__device__ __forceinline__ void p3_prep(Frame& F, const Args& A, int l, int rep) {
    const int gw = F.vcu * NWAVES + F.wave, NGW = F.G * NWAVES;
    bf16* PROJ = (bf16*)(F.ws + WS_PROJ);
    if (!(rep > 0 && PROBE_P3_PART == 2)) { const float* ga = inp<I_KNA>() + l * 64; const float* gc = inp<I_KNC>() + l * 32; const float* gd = inp<I_KND>() + l * 64;
      const int la = F.lane; const int ca = (4 * la) & 63, cc = (4 * la) & 31;
      const f32x4 gva = *(const f32x4*)(ga + ca), gvc = *(const f32x4*)(gc + cc), gvd = *(const f32x4*)(gd + ca);
      for (int mb = gw * 8; mb < gw * 8 + 8; mb += 8) {
        u32x2 ra[8], rc[8], rd[8];
#pragma unroll
        for (int i = 0; i < 8; ++i) { bf16* row = PROJ + (size_t)(mb + i) * NP; ra[i] = *(const u32x2*)(row + C_AK + 4 * la); rc[i] = *(const u32x2*)(row + C_CK + 4 * la);
            rd[i] = (u32x2){0u, 0u}; if (la < 16) rd[i] = *(const u32x2*)(row + C_DK + 4 * la); }
#pragma unroll
        for (int i = 0; i < 8; ++i) { bf16* row = PROJ + (size_t)(mb + i) * NP;
            { float x0 = bf2f(ra[i].x & 0xffff), x1 = bf2f(ra[i].x >> 16), x2 = bf2f(ra[i].y & 0xffff), x3 = bf2f(ra[i].y >> 16); float ss = (x0 * x0 + x1 * x1) + (x2 * x2 + x3 * x3);
              ss += shx<1>(ss); ss += shx<2>(ss); ss += shx<4>(ss); ss += shx<8>(ss); const float rs = 1.0f / sqrtf(ss * (1.f / 64.f) + RMS_EPS);
              u32x2 w; w.x = pk2(x0 * rs * gva[0], x1 * rs * gva[1]); w.y = pk2(x2 * rs * gva[2], x3 * rs * gva[3]); *(u32x2*)(row + C_AK + 4 * la) = w; }
            { float x0 = bf2f(rc[i].x & 0xffff), x1 = bf2f(rc[i].x >> 16), x2 = bf2f(rc[i].y & 0xffff), x3 = bf2f(rc[i].y >> 16); float ss = (x0 * x0 + x1 * x1) + (x2 * x2 + x3 * x3);
              ss += shx<1>(ss); ss += shx<2>(ss); ss += shx<4>(ss); const float rs = 1.0f / sqrtf(ss * (1.f / 32.f) + RMS_EPS);
              u32x2 w; w.x = pk2(x0 * rs * gvc[0], x1 * rs * gvc[1]); w.y = pk2(x2 * rs * gvc[2], x3 * rs * gvc[3]); *(u32x2*)(row + C_CK + 4 * la) = w; }
            { float x0 = bf2f(rd[i].x & 0xffff), x1 = bf2f(rd[i].x >> 16), x2 = bf2f(rd[i].y & 0xffff), x3 = bf2f(rd[i].y >> 16); float ss = (x0 * x0 + x1 * x1) + (x2 * x2 + x3 * x3);
              ss += shx<1>(ss); ss += shx<2>(ss); ss += shx<4>(ss); ss += shx<8>(ss); const float rs = 1.0f / sqrtf(ss * (1.f / 64.f) + RMS_EPS);
              u32x2 w; w.x = pk2(x0 * rs * gvd[0], x1 * rs * gvd[1]); w.y = pk2(x2 * rs * gvd[2], x3 * rs * gvd[3]); if (la < 16) *(u32x2*)(row + C_DK + 4 * la) = w; }
        }
      }
    }
    if (!(rep > 0 && PROBE_P3_PART == 2)) {
        const int bh = gw >> 6, ck = gw & 63, b = bh >> 2, h = bh & 3; const float bfv = inp<I_BF>()[l * 4 + h];
        const int t = 32 * ck + (F.lane & 31);
        const float x = bf2f(PROJ[((size_t)b * SEQ + t) * NP + C_AF + h]) + bfv;
        float incl = fminf(x, 0.f) - log1pf(__expf(-fabsf(x)));
#pragma unroll
        for (int o = 1; o < 32; o <<= 1) { const float u = shup(incl, o, F.lane); if ((F.lane & 31) >= o) incl += u; }
        float* cum = (float*)(F.ws + WS_CUM);
        if (F.lane < 32) cum[(size_t)bh * SEQ + t] = incl;
        if (F.lane == 31) cum[32 * SEQ + bh * 64 + ck] = incl;
    }
    LAS float* sc = (LAS float*)F.lds;
    unsigned* MASK = (unsigned*)(F.ws + WS_MASK);
    constexpr int SCP = 2052;
    const int lane = F.lane, kq = lane >> 4, qi = lane & 15;
    __syncthreads();
    bf16x8 bq[8], wvr, akv[16];
    const auto unit_geom = [&](int i, int& b, int& t0, int& nkt) { const int u = F.bx + 256 * i; b = u >> 7; const int tqr = u & 127, tq = (i & 1) ? 127 - tqr : tqr; t0 = tq * 16; nkt = tq + 1; };
    const auto unit_load_q = [&](int i) { int b, t0, nkt; unit_geom(i, b, t0, nkt); const bf16* qrow = PROJ + (size_t)b * SEQ * NP + (size_t)(t0 + qi) * NP;
#pragma unroll
        for (int h = 0; h < 8; ++h) bq[h] = *(const bf16x8*)(qrow + C_IQ + h * 32 + 8 * kq);
        wvr = *(const bf16x8*)(qrow + C_IW); };
    const auto unit_load_k = [&](int i) { int b, t0, nkt; unit_geom(i, b, t0, nkt); const bf16* pb = PROJ + (size_t)b * SEQ * NP;
#pragma unroll
        for (int j = 0; j < 16; ++j) { const int kt = F.wave + 8 * j; akv[j] = (bf16x8){0, 0, 0, 0, 0, 0, 0, 0}; if (kt < nkt) akv[j] = *(const bf16x8*)(pb + (size_t)(kt * 16 + qi) * NP + C_IK + 8 * kq); } };
    const bool do_c = !(rep > 0 && PROBE_P3_PART == 1);
    if (do_c) unit_load_q(0);
    for (int i = 0; i < 4; ++i) {
        if (!do_c) break;
        int b, t0, nkt; unit_geom(i, b, t0, nkt);
        unit_load_k(i);
        float wq[8];
#pragma unroll
        for (int h = 0; h < 8; ++h) wq[h] = bf2f((unsigned short)wvr[h]) * (0.35355339059327373f * 0.17677669529663687f);
#pragma unroll
        for (int j = 0; j < 16; ++j) { const int kt = F.wave + 8 * j;
            if (kt < nkt) {
            f32x4 a4 = (f32x4){0.f, 0.f, 0.f, 0.f};
#pragma unroll
            for (int h = 0; h < 8; ++h) { const f32x4 s = __builtin_amdgcn_mfma_f32_16x16x32_bf16(akv[j], bq[h], (f32x4){0.f, 0.f, 0.f, 0.f}, 0, 0, 0);
#pragma unroll
                for (int r = 0; r < 4; ++r) a4[r] += wq[h] * fmaxf(s[r], 0.f); }
#pragma unroll
            for (int r = 0; r < 4; ++r) a4[r] += 0.f;
            { const int ci = kt * 4 + kq, L = ci >> 3, c = ci & 7;
              *(LAS f32x4*)(sc + qi * SCP + 4 * (L * 8 + (c ^ (L & 7)))) = a4; }
            } }
        if (i + 1 < 4) unit_load_q(i + 1);
        LDS_WAIT(); __syncthreads();
        if (rep > 0 && PROBE_P3_PART == 2) { }
        else if (t0 < 256) {
            for (int rr = 0; rr < 2; ++rr) { const int t = t0 + 2 * F.wave + rr; const int nb = t - 32 * lane + 1;
                MASK[((size_t)b * SEQ + t) * 64 + lane] = nb >= 32 ? 0xffffffffu : (nb <= 0 ? 0u : ((1u << nb) - 1u)); }
        } else {
            const int rA = 2 * F.wave, tA = t0 + rA, tB = tA + 1;
            unsigned ua[32], ub[32];
#pragma unroll
            for (int c = 0; c < 8; ++c) { const int off = 4 * (lane * 8 + (c ^ (lane & 7)));
                const f32x4 fa = *(const LAS f32x4*)(sc + rA * SCP + off), fb = *(const LAS f32x4*)(sc + (rA + 1) * SCP + off);
#pragma unroll
                for (int i = 0; i < 4; ++i) { ua[c * 4 + i] = sortable(fa[i]); ub[c * 4 + i] = sortable(fb[i]); } }
            transpose32(ua); transpose32(ub);
            unsigned candA, candB, abA = 0u, abB = 0u; int naA = 0, naB = 0, ncA = tA + 1, ncB = tB + 1; bool dA = false, dB = false, eA = false, eB = false;
            { const int nbA = tA - 32 * lane + 1, nbB = tB - 32 * lane + 1;
              candA = nbA >= 32 ? 0xffffffffu : (nbA <= 0 ? 0u : ((1u << nbA) - 1u)); candB = nbB >= 32 ? 0xffffffffu : (nbB <= 0 ? 0u : ((1u << nbB) - 1u)); }
#pragma unroll
            for (int bit = 31; bit >= 0; --bit) {
                if (!dA) sel_step(ua[bit], candA, abA, naA, ncA, dA, eA);
                if (!dB) sel_step(ub[bit], candB, abB, naB, ncB, dB, eB);
                if (dA && dB) break;
            }
            MASK[((size_t)b * SEQ + tA) * 64 + lane] = sel_finish(candA, abA, naA, eA, lane);
            MASK[((size_t)b * SEQ + tB) * 64 + lane] = sel_finish(candB, abB, naB, eB, lane);
        }
        __syncthreads();
    }
}

namespace att {
template <bool B> struct BoolC { static constexpr bool value = B; };
constexpr int SLOTB = 8192, L_K = 0, L_V = 3 * SLOTB, L_WS = 6 * SLOTB, L_OST = L_WS + 2048, L_CUM = L_OST + 8 * 8192, L_END = L_CUM + 8192;
constexpr int MROW = 66;
static_assert(L_OST + 256 * MROW * 4 <= L_END && L_END <= RING_BYTES, "attention LDS map");
constexpr float THR = 8.0f;
__device__ __forceinline__ int crow(int r, int hi) { return (r & 3) + 8 * (r >> 2) + 4 * hi; }
__device__ __forceinline__ void glds16(const void* gsrc, unsigned lds_dst) { unsigned keep;
    asm volatile("s_mov_b32 %0, m0\n\ts_mov_b32 m0, %2\n\ts_nop 0\n\tglobal_load_lds_dwordx4 %1, off\n\ts_mov_b32 m0, %0" : "=&s"(keep) : "v"(gsrc), "s"(lds_dst) : "memory"); }
#define ATT_WAIT_BAR() asm volatile("s_waitcnt vmcnt(0) lgkmcnt(0)\n\ts_barrier" ::: "memory")
__device__ __forceinline__ unsigned cvtpk_s(float lo, float hi) { typedef __bf16 bf16x2_t __attribute__((ext_vector_type(2))); f32x2 v = {lo, hi}; bf16x2_t b = __builtin_convertvector(v, bf16x2_t); return __builtin_bit_cast(unsigned, b); }
__device__ __forceinline__ float xhalf(float x, int hi) { auto rr = __builtin_amdgcn_permlane32_swap(__builtin_bit_cast(unsigned, x), __builtin_bit_cast(unsigned, x), false, false);
    return __builtin_bit_cast(float, hi ? rr[0] : rr[1]); }
template <int DA, int DB>
__device__ __forceinline__ void qkt(f32x16& p0, f32x16& p1, const LAS char* Kslot, const bf16x8* qr, const f32x16& cin, int r32, int hi) {
    const LAS char* kb = Kslot + hi * 1024 + r32 * 16;
#pragma unroll
    for (int d0 = DA; d0 < DB; ++d0) {
        const bf16x8 b0 = *(const LAS bf16x8*)(kb + d0 * 2048), b1 = *(const LAS bf16x8*)(kb + d0 * 2048 + 512);
        if (d0 == DA) { p0 = __builtin_amdgcn_mfma_f32_32x32x16_bf16(b0, qr[d0], cin, 0, 0, 0); p1 = __builtin_amdgcn_mfma_f32_32x32x16_bf16(b1, qr[d0], cin, 0, 0, 0); }
        else { p0 = __builtin_amdgcn_mfma_f32_32x32x16_bf16(b0, qr[d0], p0, 0, 0, 0); p1 = __builtin_amdgcn_mfma_f32_32x32x16_bf16(b1, qr[d0], p1, 0, 0, 0); } }
}
__device__ __forceinline__ void pv(f32x16* o, int vb, bf16x8 pa0, bf16x8 pa1, bf16x8 pa2, bf16x8 pa3) {
    s16x4 lo[2][4], hi[2][4];
#pragma unroll
    for (int d0 = 0; d0 < 2; ++d0)
#pragma unroll
        for (int ks = 0; ks < 4; ++ks) {
            asm volatile("ds_read_b64_tr_b16 %0,%1 offset:%c2" : "=&v"(lo[d0][ks]) : "v"(vb), "i"(d0 * 4096 + ks * 1024) : "memory");
            asm volatile("ds_read_b64_tr_b16 %0,%1 offset:%c2" : "=&v"(hi[d0][ks]) : "v"(vb), "i"(d0 * 4096 + ks * 1024 + 512) : "memory"); }
    asm volatile("s_waitcnt lgkmcnt(0)" ::: "memory"); __builtin_amdgcn_sched_barrier(0);
#define PK(d, k) (bf16x8){lo[d][k][0], lo[d][k][1], lo[d][k][2], lo[d][k][3], hi[d][k][0], hi[d][k][1], hi[d][k][2], hi[d][k][3]}
    o[0] = __builtin_amdgcn_mfma_f32_32x32x16_bf16(pa0, PK(0, 0), o[0], 0, 0, 0); o[1] = __builtin_amdgcn_mfma_f32_32x32x16_bf16(pa0, PK(1, 0), o[1], 0, 0, 0);
    o[0] = __builtin_amdgcn_mfma_f32_32x32x16_bf16(pa1, PK(0, 1), o[0], 0, 0, 0); o[1] = __builtin_amdgcn_mfma_f32_32x32x16_bf16(pa1, PK(1, 1), o[1], 0, 0, 0);
    o[0] = __builtin_amdgcn_mfma_f32_32x32x16_bf16(pa2, PK(0, 2), o[0], 0, 0, 0); o[1] = __builtin_amdgcn_mfma_f32_32x32x16_bf16(pa2, PK(1, 2), o[1], 0, 0, 0);
    o[0] = __builtin_amdgcn_mfma_f32_32x32x16_bf16(pa3, PK(0, 3), o[0], 0, 0, 0); o[1] = __builtin_amdgcn_mfma_f32_32x32x16_bf16(pa3, PK(1, 3), o[1], 0, 0, 0);
#undef PK
}
__device__ __forceinline__ float rowmax(const f32x16& p0, const f32x16& p1, int hi) {
    float a = fmaxf(fmaxf(p0[0], p0[1]), p1[0]), b = fmaxf(fmaxf(p0[2], p0[3]), p1[1]); a = fmaxf(fmaxf(a, p1[2]), p1[3]);
#pragma unroll
    for (int r = 4; r < 16; r += 4) { a = fmaxf(fmaxf(a, p0[r]), p0[r + 1]); b = fmaxf(fmaxf(b, p0[r + 2]), p0[r + 3]); a = fmaxf(fmaxf(a, p1[r]), p1[r + 1]); b = fmaxf(fmaxf(b, p1[r + 2]), p1[r + 3]); }
    const float m = fmaxf(a, b); return fmaxf(m, xhalf(m, hi));
}
struct AttnP { const bf16* proj; bf16* mix; const float* cum; const unsigned* mask; const float* qgain[4]; const float* kgain[4]; float lam; };

template <int VAR>
__device__ __forceinline__ void attn_unit(const AttnP& P, int b, int h, int qb, LAS char* sh, const int tid_in, const int pm, unsigned* qctr, volatile LAS unsigned* qslot) {
    int tid = tid_in; asm volatile("" : "+v"(tid));
    const int lane = tid & 63, r32 = lane & 31, hi = lane >> 5; const int wid = __builtin_amdgcn_readfirstlane(tid >> 6);
    const long rowbase = (long)b * SEQ; const int q0 = qb * 256, NT = 4 * (qb + 1);
    const int qrel = wid * 32 + r32, tq = q0 + qrel;
    constexpr bool REV = VAR != 0;
    constexpr int QCB = VAR == 0 ? C_AQ : VAR == 1 ? C_BQ : VAR == 2 ? C_CQ : C_DQ;
    constexpr int KCB = VAR == 0 ? C_AK : VAR == 1 ? C_BK : VAR == 2 ? C_CK : C_DK;
    constexpr int VCB = VAR == 0 ? C_AV : VAR == 1 ? C_BV : VAR == 2 ? C_CV : C_DV;
    const int Qc = QCB + 64 * h, Kc = VAR == 3 ? KCB : KCB + 64 * h, Vc = VAR == 3 ? VCB : VCB + 64 * h;
    const bf16* PR = P.proj;
    LAS float* wsf = (LAS float*)(sh + L_WS) + wid * 64;
    LAS float* stg = (LAS float*)(sh + L_OST) + wid * 2048;
    LAS float* cumL = (LAS float*)(sh + L_CUM);
    LAS unsigned* maskL = (LAS unsigned*)(sh + L_OST);
    const unsigned lds0 = (unsigned)(uintptr_t)sh;
    const bf16* ksrc = PR + (size_t)(rowbase + lane) * NP + Kc + wid * 8;
    const bf16* vsrc = PR + (size_t)(rowbase + 16 * (wid & 3) + (lane >> 2)) * NP + Vc + (wid >> 2) * 32 + (lane & 3) * 8;
    const unsigned kdst = lds0 + L_K + wid * 1024, vdst = lds0 + L_V + wid * 1024;
#define DMA_KV(t, slot) do { glds16(ksrc + (size_t)(t) * 64 * NP, (unsigned)__builtin_amdgcn_readfirstlane(kdst + (slot))); glds16(vsrc + (size_t)(t) * 64 * NP, (unsigned)__builtin_amdgcn_readfirstlane(vdst + (slot))); } while (0)
    DMA_KV(REV ? NT - 1 : 0, 0); DMA_KV(REV ? NT - 2 : 1, SLOTB);
    if (VAR == 0) {
        LAS float* pref = (LAS float*)(sh + L_WS);
        if (tid < 64) { const float ct = P.cum[32 * SEQ + (b * 4 + h) * 64 + tid]; float incl = ct;
#pragma unroll
            for (int o = 1; o < 64; o <<= 1) { const float u = shup(incl, o, tid); if (tid >= o) incl += u; }
            pref[tid] = incl - ct; }
        asm volatile("s_waitcnt lgkmcnt(0)\n\ts_barrier" ::: "memory");
        const float* cg = P.cum + (size_t)(b * 4 + h) * SEQ; for (int i = tid; i < q0 + 256; i += 512) cumL[i] = (cg[i] + pref[i >> 5]) * LOG2E;
        asm volatile("s_waitcnt lgkmcnt(0)\n\ts_barrier" ::: "memory");
    }
    if (VAR == 3) { const unsigned* mg = P.mask + (size_t)(rowbase + q0) * 64; const int nw = 2 * NT;
        for (int i = tid; i < 256 * 64; i += 512) { const int row = i >> 6, w = i & 63; if (w < nw) maskL[row * MROW + w] = mg[i]; } }
    asm volatile("s_waitcnt vmcnt(0) lgkmcnt(0)\n\ts_barrier" ::: "memory");
    const int vb0 = (int)(lds0 + L_V) + ((lane >> 4) & 1) * 32 + (lane & 3) * 8 + (4 * hi + ((lane & 15) >> 2)) * 64;
    float slope2 = 0.f;
    if (VAR == 2) slope2 = __builtin_amdgcn_exp2f(-(float)(2 * h + 1)) * LOG2E;
    if (VAR == 3) slope2 = __builtin_amdgcn_exp2f(-(float)(2 * h + 2)) * LOG2E;
    float cumt = 0.f; if (VAR == 0) cumt = cumL[tq];
    constexpr int NPASS = VAR == 2 ? 2 : 1;
    unsigned nxt_u = 0u;
    for (int pass = 0; pass < NPASS; ++pass) {
        bf16x8 qa[4]; float sb0 = 0.f;
        { const bf16* Qw = PR + (size_t)(rowbase + tq) * NP + Qc;
          constexpr int ND0 = VAR == 2 ? 2 : 4; const int dbase = VAR == 2 ? 2 * pass : 0;
          float qf[8 * ND0];
#pragma unroll
          for (int d0 = 0; d0 < ND0; ++d0) { const bf16x8 raw = *(const bf16x8*)(Qw + (dbase + d0) * 16 + hi * 8);
#pragma unroll
              for (int j = 0; j < 8; ++j) qf[d0 * 8 + j] = bf2f((unsigned short)raw[j]); }
          constexpr float SC = (VAR == 2 ? 0.17677669529663687f : 0.125f) * LOG2E;
          if (VAR != 1) {
              float ss = 0.f;
#pragma unroll
              for (int i = 0; i < 8 * ND0; ++i) ss += qf[i] * qf[i];
              ss += xhalf(ss, hi); const float rstd = 1.0f / sqrtf(ss * (VAR == 2 ? 1.f / 32.f : 1.f / 64.f) + RMS_EPS);
              const float* g = P.qgain[VAR];
#pragma unroll
              for (int d0 = 0; d0 < ND0; ++d0)
#pragma unroll
                  for (int j = 0; j < 8; ++j) qf[d0 * 8 + j] *= rstd * g[16 * d0 + 8 * hi + j] * SC;
          } else {
#pragma unroll
              for (int i = 0; i < 8 * ND0; ++i) qf[i] *= SC;
          }
          if (VAR == 2 || VAR == 3) {
              float n0 = 0.f;
#pragma unroll
              for (int i = 0; i < 8 * ND0; ++i) n0 += qf[i] * qf[i];
              n0 += xhalf(n0, hi);
              float gk = fabsf(P.kgain[VAR][lane & (VAR == 2 ? 31 : 63)]);
              gk = fmaxf(gk, shx<1>(gk)); gk = fmaxf(gk, shx<2>(gk)); gk = fmaxf(gk, shx<4>(gk)); gk = fmaxf(gk, shx<8>(gk)); gk = fmaxf(gk, shx<16>(gk)); gk = half_max(gk);
              sb0 = 1.02f * sqrtf(n0) * (VAR == 2 ? 5.656854249f : 8.0f) * gk;
          }
#pragma unroll
          for (int d0 = 0; d0 < ND0; ++d0) { u32x4 w; w.x = cvtpk_s(qf[d0 * 8 + 0], qf[d0 * 8 + 1]); w.y = cvtpk_s(qf[d0 * 8 + 2], qf[d0 * 8 + 3]); w.z = cvtpk_s(qf[d0 * 8 + 4], qf[d0 * 8 + 5]); w.w = cvtpk_s(qf[d0 * 8 + 6], qf[d0 * 8 + 7]);
              qa[d0] = __builtin_bit_cast(bf16x8, w); }
          if (VAR == 2) { qa[2] = qa[0]; qa[3] = qa[1]; }
        }
        float mhat = -1e30f, l_reg = 0.f, Rp = 1.f; f32x16 o[2]; const float sbound = sb0;
#pragma unroll
        for (int r = 0; r < 16; ++r) { o[0][r] = 0.f; o[1][r] = 0.f; }
        if (pass > 0) { DMA_KV(REV ? NT - 1 : 0, 0); DMA_KV(REV ? NT - 2 : 1, SLOTB); }
        int cur = 0, sl1 = SLOTB, sl2 = 2 * SLOTB;
        auto step = [&](auto band_c, const int it) -> bool {
            constexpr bool BAND = decltype(band_c)::value;
            const int t = REV ? NT - 1 - it : it;
            if (pm == 7) { }
            else if (it + 1 < NT) asm volatile("s_waitcnt vmcnt(2) lgkmcnt(0)\n\ts_barrier" ::: "memory");
            else ATT_WAIT_BAR();
            if (REV && it > 0) {
                const LAS unsigned* wz = (const LAS unsigned*)(sh + L_END) + ((it - 1) & 1) * 8;
                const u32x4 z0 = *(const LAS u32x4*)wz, z1 = *(const LAS u32x4*)(wz + 4);
                if (__builtin_amdgcn_readfirstlane((int)(z0.x & z0.y & z0.z & z0.w & z1.x & z1.y & z1.z & z1.w)) != 0) return true;
            }
            if (it + 2 < NT && pm != 7) DMA_KV(REV ? t - 2 : t + 2, sl2);
            const int jb = t - (NT - 4);
            float cinv = 0.f;
            if (VAR == 0) cinv = cumt;
            if (VAR == 2 || VAR == 3) cinv = slope2 * (float)(t * 64 + 4 * hi - tq);
            f32x16 cin;
#pragma unroll
            for (int r = 0; r < 16; ++r) cin[r] = cinv;
            f32x16 p0, p1;
            const LAS char* Ks = sh + L_K + cur;
            if (VAR == 2) { if (pass == 0) { const bf16x8 qq[4] = {qa[0], qa[1], qa[0], qa[1]}; qkt<0, 2>(p0, p1, Ks, qq, cin, r32, hi); }
                            else { const bf16x8 qq[4] = {qa[0], qa[1], qa[0], qa[1]}; qkt<2, 4>(p0, p1, Ks, qq, cin, r32, hi); } }
            else qkt<0, 4>(p0, p1, Ks, qa, cin, r32, hi);
            if (VAR != 1) {
                if (VAR == 0) { const LAS float* cp = cumL + t * 64 + 4 * hi;
#pragma unroll
                    for (int g = 0; g < 4; ++g) { const f32x4 c0 = *(const LAS f32x4*)(cp + 8 * g), c1 = *(const LAS f32x4*)(cp + 32 + 8 * g);
#pragma unroll
                        for (int i = 0; i < 4; ++i) { p0[4 * g + i] -= c0[i]; p1[4 * g + i] -= c1[i]; } } }
                if (VAR == 2 || VAR == 3) {
#pragma unroll
                    for (int r = 0; r < 16; ++r) { const float kc = (float)((r & 3) + 8 * (r >> 2)); p0[r] += slope2 * kc; p1[r] += slope2 * (kc + 32.f); } }
                if (VAR != 3) { if constexpr (BAND) { const int kb = 64 * jb + 4 * hi;
#pragma unroll
                    for (int r = 0; r < 16; ++r) { const int kv = kb + (r & 3) + 8 * (r >> 2); if (kv > qrel) p0[r] = -INFINITY; if (kv + 32 > qrel) p1[r] = -INFINITY; } } }
                else { const u32x2 mw = *(const LAS u32x2*)(maskL + qrel * MROW + 2 * t); const unsigned w0 = mw.x >> (4 * hi), w1 = mw.y >> (4 * hi);
#pragma unroll
                    for (int r = 0; r < 16; ++r) { const int c = (r & 3) + 8 * (r >> 2); if (!((w0 >> c) & 1u)) p0[r] = -INFINITY; if (!((w1 >> c) & 1u)) p1[r] = -INFINITY; } }
                const float rm = rowmax(p0, p1, hi);
                if (__any(rm - mhat > THR)) {
                    const float mn = fmaxf(mhat, rm); const float f = __builtin_amdgcn_exp2f(mhat - mn); mhat = mn; l_reg *= f;
                    if (hi == 0) wsf[r32] = f;
#pragma unroll
                    for (int r = 0; r < 16; ++r) { const float fr = wsf[crow(r, hi)]; o[0][r] *= fr; o[1][r] *= fr; }
                }
                float sa4[4] = {0.f, 0.f, 0.f, 0.f};
#pragma unroll
                for (int r = 0; r < 16; ++r) { p0[r] = __builtin_amdgcn_exp2f(p0[r] - mhat); p1[r] = __builtin_amdgcn_exp2f(p1[r] - mhat); sa4[r & 3] += p0[r] + p1[r]; }
                l_reg += (sa4[0] + sa4[1]) + (sa4[2] + sa4[3]);
                if (VAR == 2 || VAR == 3) {
                    const float ub = sbound - slope2 * (float)(tq - 64 * t + 1) - mhat;
                    const bool dead = __all(ub < -150.f); if (lane == 0) ((LAS unsigned*)(sh + L_END))[(it & 1) * 8 + wid] = dead ? 1u : 0u;
                }
            } else {
                f32x16 m0, m1;
#pragma unroll
                for (int r = 0; r < 16; ++r) {
                    { const float s = __builtin_amdgcn_fmed3f(p0[r], -64.f, 64.f); const float e = __builtin_amdgcn_exp2f(-s); const float bt = __builtin_amdgcn_rcpf(1.f + e); p0[r] = bt; m0[r] = e * bt; }
                    { const float s = __builtin_amdgcn_fmed3f(p1[r], -64.f, 64.f); const float e = __builtin_amdgcn_exp2f(-s); const float bt = __builtin_amdgcn_rcpf(1.f + e); p1[r] = bt; m1[r] = e * bt; } }
                if constexpr (BAND) { const int kb = 64 * jb + 4 * hi;
#pragma unroll
                    for (int r = 0; r < 16; ++r) { const int kv = kb + (r & 3) + 8 * (r >> 2);
                        if (kv >= qrel) { p0[r] = 0.f; m0[r] = 1.f; } if (kv + 32 >= qrel) { p1[r] = 0.f; m1[r] = 1.f; } } }
                float gp[8], gq[8], ex[8];
#pragma unroll
                for (int g = 0; g < 4; ++g) { gp[g] = (m0[4 * g] * m0[4 * g + 1]) * (m0[4 * g + 2] * m0[4 * g + 3]); gp[4 + g] = (m1[4 * g] * m1[4 * g + 1]) * (m1[4 * g + 2] * m1[4 * g + 3]); }
#pragma unroll
                for (int g = 0; g < 8; ++g) gq[g] = xhalf(gp[g], hi);
                float sp = Rp;
#pragma unroll
                for (int g = 7; g >= 0; --g) { ex[g] = hi ? sp : sp * gq[g]; sp *= gp[g] * gq[g]; }
                Rp = sp;
                { const bool allz = !__any(Rp != 0.f); if (lane == 0) ((LAS unsigned*)(sh + L_END))[(it & 1) * 8 + wid] = allz ? 1u : 0u; }
#pragma unroll
                for (int g = 0; g < 4; ++g) {
                    { float c = ex[g]; const float w3 = p0[4 * g + 3] * c; c *= m0[4 * g + 3]; const float w2 = p0[4 * g + 2] * c; c *= m0[4 * g + 2]; const float w1 = p0[4 * g + 1] * c; c *= m0[4 * g + 1]; const float w0 = p0[4 * g] * c;
                      p0[4 * g] = w0; p0[4 * g + 1] = w1; p0[4 * g + 2] = w2; p0[4 * g + 3] = w3; }
                    { float c = ex[4 + g]; const float w3 = p1[4 * g + 3] * c; c *= m1[4 * g + 3]; const float w2 = p1[4 * g + 2] * c; c *= m1[4 * g + 2]; const float w1 = p1[4 * g + 1] * c; c *= m1[4 * g + 1]; const float w0 = p1[4 * g] * c;
                      p1[4 * g] = w0; p1[4 * g + 1] = w1; p1[4 * g + 2] = w2; p1[4 * g + 3] = w3; } }
            }
            u32x4 pw0, pw1, pw2, pw3;
            pw0 = (u32x4){cvtpk_s(p0[0], p0[1]), cvtpk_s(p0[2], p0[3]), cvtpk_s(p0[4], p0[5]), cvtpk_s(p0[6], p0[7])};
            pw1 = (u32x4){cvtpk_s(p0[8], p0[9]), cvtpk_s(p0[10], p0[11]), cvtpk_s(p0[12], p0[13]), cvtpk_s(p0[14], p0[15])};
            pw2 = (u32x4){cvtpk_s(p1[0], p1[1]), cvtpk_s(p1[2], p1[3]), cvtpk_s(p1[4], p1[5]), cvtpk_s(p1[6], p1[7])};
            pw3 = (u32x4){cvtpk_s(p1[8], p1[9]), cvtpk_s(p1[10], p1[11]), cvtpk_s(p1[12], p1[13]), cvtpk_s(p1[14], p1[15])};
            pv(o, vb0 + cur, __builtin_bit_cast(bf16x8, pw0), __builtin_bit_cast(bf16x8, pw1), __builtin_bit_cast(bf16x8, pw2), __builtin_bit_cast(bf16x8, pw3));
            { const int tmp = cur; cur = sl1; sl1 = sl2; sl2 = tmp; }
            return false;
        };
        if (REV) { bool ex = false; int it = 0;
            for (; it < 4 && !ex; ++it) ex = step(BoolC<true>{}, it);
            for (; it < NT && !ex; ++it) ex = step(BoolC<false>{}, it); }
        else { int it = 0;
            for (; it < NT - 4; ++it) (void)step(BoolC<false>{}, it);
            for (; it < NT; ++it) (void)step(BoolC<true>{}, it); }
        ATT_WAIT_BAR();
        if (pass == NPASS - 1 && tid == 0) nxt_u = __hip_atomic_fetch_add(qctr, 1u, RLX_AGENT);
        float rli[16];
        if (VAR != 1) {
            l_reg += xhalf(l_reg, hi);
            if (hi == 0) wsf[32 + r32] = l_reg;
#pragma unroll
            for (int r = 0; r < 16; ++r) rli[r] = __builtin_amdgcn_rcpf(wsf[32 + crow(r, hi)]);
        } else {
#pragma unroll
            for (int r = 0; r < 16; ++r) rli[r] = 1.f;
        }
#pragma unroll
        for (int r = 0; r < 16; ++r) { const int orow = crow(r, hi);
#pragma unroll
            for (int d0 = 0; d0 < 2; ++d0) { const float val = o[d0][r] * rli[r]; LAS float* sp = stg + orow * 64 + d0 * 32 + r32;
                if (VAR == 2 && pass == 1) *sp = *sp - P.lam * val; else *sp = val; } }
    }
    LDS_WAIT();
    bf16* Ow = P.mix + (size_t)(rowbase + q0 + wid * 32) * DM + VAR * 256 + h * 64;
#pragma unroll
    for (int i = 0; i < 4; ++i) { const int row = i * 8 + (lane >> 3), ch = lane & 7;
        const f32x4 a = *(const LAS f32x4*)(stg + row * 64 + ch * 8), c = *(const LAS f32x4*)(stg + row * 64 + ch * 8 + 4);
        float sc = 1.f;
        if (VAR == 2) { float ss = (a[0] * a[0] + a[1] * a[1]) + (a[2] * a[2] + a[3] * a[3]) + (c[0] * c[0] + c[1] * c[1]) + (c[2] * c[2] + c[3] * c[3]);
            ss += shx<1>(ss); ss += shx<2>(ss); ss += shx<4>(ss); sc = 1.0f / sqrtf(ss * (1.f / 64.f) + RMS_EPS); }
        u32x4 w; w.x = cvtpk_s(a[0] * sc, a[1] * sc); w.y = cvtpk_s(a[2] * sc, a[3] * sc); w.z = cvtpk_s(c[0] * sc, c[1] * sc); w.w = cvtpk_s(c[2] * sc, c[3] * sc);
        if (pm == 0 || (w.x == 0x12345678u && w.y == 0x9abcdef0u)) *(u32x4*)(Ow + (size_t)row * DM + ch * 8) = w; }
    if (tid == 0) *qslot = nxt_u;
    asm volatile("s_waitcnt lgkmcnt(0)\n\ts_barrier" ::: "memory");
#undef DMA_KV
}
typedef __attribute__((address_space(3))) const char* lds_cptr;
typedef short v4i16_t __attribute__((ext_vector_type(4)));
__device__ __forceinline__ s16x4 vtr(lds_cptr p) { return __builtin_bit_cast(s16x4, __builtin_amdgcn_ds_read_tr16_b64_v4i16((__attribute__((address_space(3))) v4i16_t*)p)); }
template <int VAR>
__device__ __forceinline__ void attn_unit2(const AttnP& P, int b, int h, int qb, LAS char* sh, const int tid_in, unsigned* qctr, volatile LAS unsigned* qslot) {
    static_assert(VAR == 0 || VAR == 2 || VAR == 3, "softmax mixers only");
    int tid = tid_in; asm volatile("" : "+v"(tid));
    const int lane = tid & 63, r32 = lane & 31, hi = lane >> 5; const int wid = __builtin_amdgcn_readfirstlane(tid >> 6);
    const long rowbase = (long)b * SEQ; const int q0 = qb * 256, NT = 4 * (qb + 1);
    const int qrel = wid * 32 + r32, tq = q0 + qrel;
    constexpr int QCB = VAR == 0 ? C_AQ : VAR == 1 ? C_BQ : VAR == 2 ? C_CQ : C_DQ;
    constexpr int KCB = VAR == 0 ? C_AK : VAR == 1 ? C_BK : VAR == 2 ? C_CK : C_DK;
    constexpr int VCB = VAR == 0 ? C_AV : VAR == 1 ? C_BV : VAR == 2 ? C_CV : C_DV;
    const int Qc = QCB + 64 * h, Kc = VAR == 3 ? KCB : KCB + 64 * h, Vc = VAR == 3 ? VCB : VCB + 64 * h;
    const bf16* PR = P.proj;
    LAS float* wsf = (LAS float*)(sh + L_WS) + wid * 64;
    LAS float* stg = (LAS float*)(sh + L_OST) + wid * 2048;
    LAS float* cumL = (LAS float*)(sh + L_CUM);
    LAS unsigned* maskL = (LAS unsigned*)(sh + L_OST);
    const unsigned lds0 = (unsigned)(uintptr_t)sh;
    const bf16* ksrc = PR + (size_t)(rowbase + lane) * NP + Kc + wid * 8;
    const bf16* vsrc = PR + (size_t)(rowbase + 16 * (wid & 3) + (lane >> 2)) * NP + Vc + (wid >> 2) * 32 + (lane & 3) * 8;
    const unsigned kdst = lds0 + L_K + wid * 1024, vdst = lds0 + L_V + wid * 1024;
#define TILE2(j) (NT - 1 - (j))
#define DMA_K2(j, slot) glds16(ksrc + (size_t)TILE2(j) * 64 * NP, (unsigned)__builtin_amdgcn_readfirstlane(kdst + (slot)))
#define DMA_V2(j, slot) glds16(vsrc + (size_t)TILE2(j) * 64 * NP, (unsigned)__builtin_amdgcn_readfirstlane(vdst + (slot)))
    DMA_K2(0, 0); DMA_K2(1, SLOTB); DMA_V2(0, 0);
    if (VAR == 0) {
        LAS float* pref = (LAS float*)(sh + L_WS);
        if (tid < 64) { const float ct = P.cum[32 * SEQ + (b * 4 + h) * 64 + tid]; float incl = ct;
#pragma unroll
            for (int o = 1; o < 64; o <<= 1) { const float u = shup(incl, o, tid); if (tid >= o) incl += u; }
            pref[tid] = incl - ct; }
        asm volatile("s_waitcnt lgkmcnt(0)\n\ts_barrier" ::: "memory");
        const float* cg = P.cum + (size_t)(b * 4 + h) * SEQ; for (int i = tid; i < q0 + 256; i += 512) cumL[i] = (cg[i] + pref[i >> 5]) * LOG2E;
        asm volatile("s_waitcnt lgkmcnt(0)\n\ts_barrier" ::: "memory");
    }
    if (VAR == 3) { const unsigned* mg = P.mask + (size_t)(rowbase + q0) * 64; const int nw = 2 * NT;
        for (int i = tid; i < 256 * 64; i += 512) { const int row = i >> 6, w = i & 63; if (w < nw) maskL[row * MROW + w] = mg[i]; } }
    asm volatile("s_waitcnt vmcnt(0) lgkmcnt(0)\n\ts_barrier" ::: "memory");
    const lds_cptr shc = (lds_cptr)sh;
    const lds_cptr kp0 = shc + L_K + hi * 1024 + r32 * 16;
    const lds_cptr vp0 = shc + L_V + ((lane >> 4) & 1) * 32 + (lane & 3) * 8 + (4 * hi + ((lane & 15) >> 2)) * 64;
    float slope2 = 0.f;
    if (VAR == 2) slope2 = __builtin_amdgcn_exp2f(-(float)(2 * h + 1)) * LOG2E;
    if (VAR == 3) slope2 = __builtin_amdgcn_exp2f(-(float)(2 * h + 2)) * LOG2E;
    float cumt = 0.f; if (VAR == 0) cumt = cumL[tq];
    constexpr int NPASS = VAR == 2 ? 2 : 1;
    unsigned nxt_u = 0u;
    const auto slot3 = [](int j) { return (j % 3) * SLOTB; };
#define SB2() __builtin_amdgcn_sched_barrier(0)
#define PINV(x) asm volatile("" : "+v"(x))
#define MF32(a, b, c) __builtin_amdgcn_mfma_f32_32x32x16_bf16(a, b, c, 0, 0, 0)
#define ATT_BARN(N) do { asm volatile("s_waitcnt vmcnt(" #N ") lgkmcnt(0)\n\ts_barrier" ::: "memory"); SB2(); } while (0)
#define PKW(Pv, i) cvtpk_s(Pv[i], Pv[(i) + 1])
#define PAF(k) __builtin_bit_cast(bf16x8, pw##k)
#define VFR(i) (bf16x8){vlo[i][0], vlo[i][1], vlo[i][2], vlo[i][3], vhi[i][0], vhi[i][1], vhi[i][2], vhi[i][3]}
#define VRD(i) do { vlo[i] = vtr(vp_ + (((i) >> 2) * 4096 + ((i) & 3) * 1024)); vhi[i] = vtr(vp_ + (((i) >> 2) * 4096 + ((i) & 3) * 1024 + 512)); } while (0)
#define EX2(v) __builtin_amdgcn_exp2f(v)
#define GAPA(MF, Pv, i, PW, w) do { MF; sacc += Pv[i]; sacc += Pv[(i) + 1]; sacc += Pv[(i) + 2]; sacc += Pv[(i) + 3]; PINV(sacc); PW[w] = PKW(Pv, i); PW[(w) + 1] = PKW(Pv, (i) + 2); PINV(PW); SB2(); } while (0)
#define GAPA8(MF, Pv, i, PW) do { MF; sacc += Pv[i]; sacc += Pv[(i) + 1]; sacc += Pv[(i) + 2]; sacc += Pv[(i) + 3]; sacc += Pv[(i) + 4]; sacc += Pv[(i) + 5]; sacc += Pv[(i) + 6]; sacc += Pv[(i) + 7]; PINV(sacc); \
        PW[0] = PKW(Pv, i); PW[1] = PKW(Pv, (i) + 2); PW[2] = PKW(Pv, (i) + 4); PW[3] = PKW(Pv, (i) + 6); PINV(PW); SB2(); } while (0)
#define GAPB(MF, X, i) do { MF; X[i] = EX2(X[i]); X[(i) + 1] = EX2(X[(i) + 1]); X[(i) + 2] = EX2(X[(i) + 2]); X[(i) + 3] = EX2(X[(i) + 3]); PINV(X); SB2(); } while (0)
    for (int pass = 0; pass < NPASS; ++pass) {
        bf16x8 qa[4]; float sb0 = 0.f;
        { const bf16* Qw = PR + (size_t)(rowbase + tq) * NP + Qc;
          constexpr int ND0 = VAR == 2 ? 2 : 4; const int dbase = VAR == 2 ? 2 * pass : 0;
          float qf[8 * ND0];
#pragma unroll
          for (int d0 = 0; d0 < ND0; ++d0) { const bf16x8 raw = *(const bf16x8*)(Qw + (dbase + d0) * 16 + hi * 8);
#pragma unroll
              for (int j = 0; j < 8; ++j) qf[d0 * 8 + j] = bf2f((unsigned short)raw[j]); }
          constexpr float SC = (VAR == 2 ? 0.17677669529663687f : 0.125f) * LOG2E;
          if (VAR != 1) {
              float ss = 0.f;
#pragma unroll
              for (int i = 0; i < 8 * ND0; ++i) ss += qf[i] * qf[i];
              ss += xhalf(ss, hi); const float rstd = 1.0f / sqrtf(ss * (VAR == 2 ? 1.f / 32.f : 1.f / 64.f) + RMS_EPS);
              const float* g = P.qgain[VAR];
#pragma unroll
              for (int d0 = 0; d0 < ND0; ++d0)
#pragma unroll
                  for (int j = 0; j < 8; ++j) qf[d0 * 8 + j] *= rstd * g[16 * d0 + 8 * hi + j] * SC;
          } else {
#pragma unroll
              for (int i = 0; i < 8 * ND0; ++i) qf[i] *= SC;
          }
          if (VAR == 2 || VAR == 3) {
              float n0 = 0.f;
#pragma unroll
              for (int i = 0; i < 8 * ND0; ++i) n0 += qf[i] * qf[i];
              n0 += xhalf(n0, hi);
              float gk = fabsf(P.kgain[VAR][lane & (VAR == 2 ? 31 : 63)]);
              gk = fmaxf(gk, shx<1>(gk)); gk = fmaxf(gk, shx<2>(gk)); gk = fmaxf(gk, shx<4>(gk)); gk = fmaxf(gk, shx<8>(gk)); gk = fmaxf(gk, shx<16>(gk)); gk = half_max(gk);
              sb0 = 1.02f * sqrtf(n0) * (VAR == 2 ? 5.656854249f : 8.0f) * gk;
          }
#pragma unroll
          for (int d0 = 0; d0 < ND0; ++d0) { u32x4 w; w.x = cvtpk_s(qf[d0 * 8 + 0], qf[d0 * 8 + 1]); w.y = cvtpk_s(qf[d0 * 8 + 2], qf[d0 * 8 + 3]); w.z = cvtpk_s(qf[d0 * 8 + 4], qf[d0 * 8 + 5]); w.w = cvtpk_s(qf[d0 * 8 + 6], qf[d0 * 8 + 7]);
              qa[d0] = __builtin_bit_cast(bf16x8, w); }
          if (VAR == 2) { qa[2] = qa[0]; qa[3] = qa[1]; }
        }
        const float sbound = sb0;
        if (pass > 0) { DMA_K2(0, 0); DMA_K2(1, SLOTB); DMA_V2(0, 0); }
        float mhat = 0.f, l_reg = 0.f; bool hasref = false, resc = false; f32x16 o[2], negm;
#pragma unroll
        for (int r = 0; r < 16; ++r) { o[0][r] = 0.f; o[1][r] = 0.f; }
        f32x16 pA0, pA1, pB0, pB1; u32x4 pw0, pw1, pw2, pw3;
#pragma unroll
        for (int r = 0; r < 16; ++r) { pB0[r] = 0.f; pB1[r] = 0.f; }
        const auto setneg = [&](int t) __attribute__((always_inline)) { float v = -mhat; if (VAR == 0) v += cumt; else v += slope2 * (float)(t * 64 + 4 * hi - tq);
#pragma unroll
            for (int r = 0; r < 16; ++r) negm[r] = v;
            PINV(negm); };
        const auto mid = [&](f32x16& C0, f32x16& C1, const int it) __attribute__((always_inline)) {
            const int t = NT - 1 - it;
            if (VAR == 0) { const LAS float* cp = cumL + t * 64 + 4 * hi;
#pragma unroll
                for (int g = 0; g < 4; ++g) { const f32x4 c0 = *(const LAS f32x4*)(cp + 8 * g), c1 = *(const LAS f32x4*)(cp + 32 + 8 * g);
#pragma unroll
                    for (int i = 0; i < 4; ++i) { C0[4 * g + i] -= c0[i]; C1[4 * g + i] -= c1[i]; } } }
            else {
#pragma unroll
                for (int r = 0; r < 16; ++r) { const float kc = (float)((r & 3) + 8 * (r >> 2)); C0[r] += slope2 * kc; C1[r] += slope2 * (kc + 32.f); } }
            if (VAR != 3) { if (it < 4) { asm volatile("" ::: "memory");
                const int kb = 64 * (3 - it) + 4 * hi;
#pragma unroll
                for (int r = 0; r < 16; ++r) { const int kv = kb + (r & 3) + 8 * (r >> 2); if (kv > qrel) C0[r] = -INFINITY; if (kv + 32 > qrel) C1[r] = -INFINITY; } } }
            else { const u32x2 mw = *(const LAS u32x2*)(maskL + qrel * MROW + 2 * t); const unsigned w0 = mw.x >> (4 * hi), w1 = mw.y >> (4 * hi);
#pragma unroll
                for (int r = 0; r < 16; ++r) { const int c = (r & 3) + 8 * (r >> 2); if (!((w0 >> c) & 1u)) C0[r] = -INFINITY; if (!((w1 >> c) & 1u)) C1[r] = -INFINITY; } }
            const float rm = rowmax(C0, C1, hi);
            const bool need = hasref ? (rm > THR) : (rm > -INFINITY);
            resc = false;
            if (__any(need)) {
                const bool fin = rm > -INFINITY;
                const float dl = hasref ? fmaxf(rm, 0.f) : (fin ? rm : 0.f);
                const float f = hasref ? EX2(-dl) : 1.f;
                mhat += dl; l_reg *= f;
#pragma unroll
                for (int r = 0; r < 16; ++r) { C0[r] -= dl; C1[r] -= dl; }
                if (hi == 0) wsf[r32] = f;
                resc = true; hasref = hasref || fin;
            }
            if (VAR != 0) {
                const bool dead = hasref && (sbound - slope2 * (float)(tq - 64 * t + 1) - mhat < -150.f);
                const bool alld = __all(dead); if (lane == 0) ((LAS unsigned*)(sh + L_END))[(it & 1) * 8 + wid] = alld ? 1u : 0u;
            }
        };
#define KLD(dst0, dst1, d0) do { dst0 = *(const LAS bf16x8*)(kp_ + (d0) * 2048); dst1 = *(const LAS bf16x8*)(kp_ + (d0) * 2048 + 512); } while (0)
#define VLD(lo, hi_, i) do { lo = vtr(vp_ + (((i) >> 2) * 4096 + ((i) & 3) * 1024)); hi_ = vtr(vp_ + (((i) >> 2) * 4096 + ((i) & 3) * 1024 + 512)); } while (0)
#define VF(lo, hi_) (bf16x8){lo[0], lo[1], lo[2], lo[3], hi_[0], hi_[1], hi_[2], hi_[3]}
        const auto step = [&](f32x16& C0, f32x16& C1, f32x16& P0, f32x16& P1, const int it) __attribute__((always_inline)) -> bool {
            if (it + 1 < NT) ATT_BARN(2); else ATT_BARN(1);
            if (VAR != 0 && it >= 1) { const LAS unsigned* wz = (const LAS unsigned*)(sh + L_END) + ((it - 1) & 1) * 8;
                const u32x4 z0 = *(const LAS u32x4*)wz, z1 = *(const LAS u32x4*)(wz + 4);
                if (__builtin_amdgcn_readfirstlane((int)(z0.x & z0.y & z0.z & z0.w & z1.x & z1.y & z1.z & z1.w)) != 0) return true; }
            if (it + 2 < NT) DMA_K2(it + 2, slot3(it + 2));
            if (it + 1 < NT) DMA_V2(it + 1, slot3(it + 1));
            setneg(NT - 1 - it);
            int ko_ = slot3(it), vo_ = slot3(it + 2);
            asm volatile("" : "+s"(ko_), "+s"(vo_));
            const lds_cptr kp_ = kp0 + ko_; const lds_cptr vp_ = vp0 + vo_;
            bf16x8 ka0, ka1, kb0, kb1; s16x4 va0, va1, vb0, vb1;
            float sacc = 0.f;
            if (VAR == 2) {
                KLD(ka0, ka1, 2 * pass); KLD(kb0, kb1, 2 * pass + 1); SB2();
                GAPA8(C0 = MF32(ka0, qa[0], negm), P0, 0, pw0);
                GAPA8(C1 = MF32(ka1, qa[0], negm), P0, 8, pw1);
                GAPA8(C0 = MF32(kb0, qa[1], C0), P1, 0, pw2);
                GAPA8(C1 = MF32(kb1, qa[1], C1), P1, 8, pw3);
            } else {
                KLD(ka0, ka1, 0); KLD(kb0, kb1, 1); SB2();
                GAPA(C0 = MF32(ka0, qa[0], negm), P0, 0, pw0, 0);
                GAPA(C1 = MF32(ka1, qa[0], negm), P0, 4, pw0, 2);
                KLD(ka0, ka1, 2); SB2();
                GAPA(C0 = MF32(kb0, qa[1], C0), P0, 8, pw1, 0);
                GAPA(C1 = MF32(kb1, qa[1], C1), P0, 12, pw1, 2);
                KLD(kb0, kb1, 3); SB2();
                GAPA(C0 = MF32(ka0, qa[2], C0), P1, 0, pw2, 0);
                GAPA(C1 = MF32(ka1, qa[2], C1), P1, 4, pw2, 2);
                GAPA(C0 = MF32(kb0, qa[3], C0), P1, 8, pw3, 0);
                GAPA(C1 = MF32(kb1, qa[3], C1), P1, 12, pw3, 2);
            }
            l_reg += sacc;
            mid(C0, C1, it);
            SB2();
            if (it > 0) {
                VLD(va0, va1, 0); VLD(vb0, vb1, 4); SB2();
                GAPB(o[0] = MF32(PAF(0), VF(va0, va1), o[0]), C0, 0);  VLD(va0, va1, 1); SB2();
                GAPB(o[1] = MF32(PAF(0), VF(vb0, vb1), o[1]), C0, 4);  VLD(vb0, vb1, 5); SB2();
                GAPB(o[0] = MF32(PAF(1), VF(va0, va1), o[0]), C0, 8);  VLD(va0, va1, 2); SB2();
                GAPB(o[1] = MF32(PAF(1), VF(vb0, vb1), o[1]), C0, 12); VLD(vb0, vb1, 6); SB2();
                GAPB(o[0] = MF32(PAF(2), VF(va0, va1), o[0]), C1, 0);  VLD(va0, va1, 3); SB2();
                GAPB(o[1] = MF32(PAF(2), VF(vb0, vb1), o[1]), C1, 4);  VLD(vb0, vb1, 7); SB2();
                GAPB(o[0] = MF32(PAF(3), VF(va0, va1), o[0]), C1, 8);
                GAPB(o[1] = MF32(PAF(3), VF(vb0, vb1), o[1]), C1, 12);
                if (resc) {
#pragma unroll
                    for (int r = 0; r < 16; ++r) { const float fr = wsf[crow(r, hi)]; o[0][r] *= fr; o[1][r] *= fr; } }
            } else {
#pragma unroll
                for (int r = 0; r < 16; ++r) { C0[r] = EX2(C0[r]); C1[r] = EX2(C1[r]); }
            }
            return false;
        };
        bool ex = false, pendA = true; int it = 0;
        for (; it < NT; it += 2) {
            ex = step(pA0, pA1, pB0, pB1, it); if (ex) { pendA = false; break; }
            ex = step(pB0, pB1, pA0, pA1, it + 1); if (ex) { pendA = true; ++it; break; }
        }
        if (!ex) pendA = false;
        if (!ex) ATT_BARN(0);
        { int vo_ = slot3(it + 2); asm volatile("" : "+s"(vo_)); const lds_cptr vp_ = vp0 + vo_; s16x4 vlo[8], vhi[8];
#pragma unroll
          for (int i = 0; i < 8; ++i) VRD(i);
          float sacc = 0.f;
          if (pendA) {
#pragma unroll
              for (int r = 0; r < 16; ++r) sacc += pA0[r] + pA1[r];
              pw0 = (u32x4){PKW(pA0, 0), PKW(pA0, 2), PKW(pA0, 4), PKW(pA0, 6)}; pw1 = (u32x4){PKW(pA0, 8), PKW(pA0, 10), PKW(pA0, 12), PKW(pA0, 14)};
              pw2 = (u32x4){PKW(pA1, 0), PKW(pA1, 2), PKW(pA1, 4), PKW(pA1, 6)}; pw3 = (u32x4){PKW(pA1, 8), PKW(pA1, 10), PKW(pA1, 12), PKW(pA1, 14)};
          } else {
#pragma unroll
              for (int r = 0; r < 16; ++r) sacc += pB0[r] + pB1[r];
              pw0 = (u32x4){PKW(pB0, 0), PKW(pB0, 2), PKW(pB0, 4), PKW(pB0, 6)}; pw1 = (u32x4){PKW(pB0, 8), PKW(pB0, 10), PKW(pB0, 12), PKW(pB0, 14)};
              pw2 = (u32x4){PKW(pB1, 0), PKW(pB1, 2), PKW(pB1, 4), PKW(pB1, 6)}; pw3 = (u32x4){PKW(pB1, 8), PKW(pB1, 10), PKW(pB1, 12), PKW(pB1, 14)};
          }
          l_reg += sacc;
          o[0] = MF32(PAF(0), VFR(0), o[0]); o[1] = MF32(PAF(0), VFR(4), o[1]); o[0] = MF32(PAF(1), VFR(1), o[0]); o[1] = MF32(PAF(1), VFR(5), o[1]);
          o[0] = MF32(PAF(2), VFR(2), o[0]); o[1] = MF32(PAF(2), VFR(6), o[1]); o[0] = MF32(PAF(3), VFR(3), o[0]); o[1] = MF32(PAF(3), VFR(7), o[1]); }
        ATT_WAIT_BAR();
        if (pass == NPASS - 1 && tid == 0) nxt_u = __hip_atomic_fetch_add(qctr, 1u, RLX_AGENT);
        int lane_e = lane; asm volatile("" : "+v"(lane_e)); const int r32e = lane_e & 31, hie = lane_e >> 5;
        LAS float* wsfe = (LAS float*)(sh + L_WS) + wid * 64; LAS float* stge = (LAS float*)(sh + L_OST) + wid * 2048;
        float rli[16];
        l_reg += xhalf(l_reg, hie);
        if (hie == 0) wsfe[32 + r32e] = l_reg;
#pragma unroll
        for (int r = 0; r < 16; ++r) rli[r] = __builtin_amdgcn_rcpf(wsfe[32 + crow(r, hie)]);
#pragma unroll
        for (int r = 0; r < 16; ++r) { const int orow = crow(r, hie);
#pragma unroll
            for (int d0 = 0; d0 < 2; ++d0) { const float val = o[d0][r] * rli[r]; LAS float* sp = stge + orow * 64 + d0 * 32 + r32e;
                if (VAR == 2 && pass == 1) *sp = *sp - P.lam * val; else *sp = val; } }
    }
    LDS_WAIT();
    int lane_o = tid & 63; asm volatile("" : "+v"(lane_o));
    bf16* Ow = P.mix + (size_t)(rowbase + q0 + wid * 32) * DM + VAR * 256 + h * 64;
    { const int lane = lane_o; LAS float* stg = (LAS float*)(sh + L_OST) + wid * 2048;
#pragma unroll
    for (int i = 0; i < 4; ++i) { const int row = i * 8 + (lane >> 3), ch = lane & 7;
        const f32x4 a = *(const LAS f32x4*)(stg + row * 64 + ch * 8), c = *(const LAS f32x4*)(stg + row * 64 + ch * 8 + 4);
        float sc = 1.f;
        if (VAR == 2) { float ss = (a[0] * a[0] + a[1] * a[1]) + (a[2] * a[2] + a[3] * a[3]) + (c[0] * c[0] + c[1] * c[1]) + (c[2] * c[2] + c[3] * c[3]);
            ss += shx<1>(ss); ss += shx<2>(ss); ss += shx<4>(ss); sc = 1.0f / sqrtf(ss * (1.f / 64.f) + RMS_EPS); }
        u32x4 w; w.x = cvtpk_s(a[0] * sc, a[1] * sc); w.y = cvtpk_s(a[2] * sc, a[3] * sc); w.z = cvtpk_s(c[0] * sc, c[1] * sc); w.w = cvtpk_s(c[2] * sc, c[3] * sc);
        *(u32x4*)(Ow + (size_t)row * DM + ch * 8) = w; } }
    if (tid == 0) *qslot = nxt_u;
    asm volatile("s_waitcnt lgkmcnt(0)\n\ts_barrier" ::: "memory");
#undef DMA_K2
#undef DMA_V2
#undef TILE2
}
#undef SB2
#undef PINV
#undef MF32
#undef ATT_BARN
#undef PKW
#undef PAF
#undef VFR
#undef VRD
#undef EX2
#undef GAPA
#undef GAPA8
#undef GAPB
#undef KLD
#undef VLD
#undef VF
}

__device__ __forceinline__ void p4_attention(Frame& F, const Args& A, int l, int qsel) {
    att::AttnP P; P.proj = (const bf16*)(F.ws + WS_PROJ); P.mix = (bf16*)(F.ws + WS_MIX); P.cum = (const float*)(F.ws + WS_CUM); P.mask = (const unsigned*)(F.ws + WS_MASK);
    P.qgain[0] = inp<I_QNA>() + l * 64; P.qgain[1] = nullptr; P.qgain[2] = inp<I_QNC>() + l * 32; P.qgain[3] = inp<I_QND>() + l * 64; P.kgain[0] = nullptr; P.kgain[1] = nullptr; P.kgain[2] = inp<I_KNC>() + l * 32; P.kgain[3] = inp<I_KND>() + l * 64; P.lam = ((const float*)(F.ws + WS_MISC))[l];
    LAS char* sh = (LAS char*)F.lds;
    LAS float* rsl2 = (LAS float*)(F.lds + 126976);
    bool cv = BG_CONVERT && (qsel == 0);
    if (cv) { fill_rowscale(F, A, 0, rsl2); fill_rowscale(F, A, 1, rsl2 + DM); }
    if (F.tid == 0) F.MISC[0] = __hip_atomic_fetch_add(F.ctl + CW_AQ + 64 * qsel, 1u, RLX_AGENT);
    __syncthreads();
    for (;;) {
        const int u = (int)F.MISC[0];
        if (u >= 1024) break;
        const int qb = 7 - (u >> 7), r = u & 127, var = r >> 5, bh = r & 31, b = bh >> 2, h = bh & 3;
        const int tv = var == 0 ? 2 : var == 1 ? 1 : var == 2 ? 3 : 0;
        if (qsel >= 2 && PROBE_ATT_VAR >= 0 && tv != PROBE_ATT_VAR) { __syncthreads(); if (F.tid == 0) F.MISC[0] = __hip_atomic_fetch_add(F.ctl + CW_AQ + 64 * qsel, 1u, RLX_AGENT); __syncthreads(); continue; }
#ifdef ONLY_VAR2
        att::attn_unit2<ONLY_VAR2>(P, b, h, qb, sh, F.tid, F.ctl + CW_AQ + 64 * qsel, F.MISC);
#else
        if (tv == 2) att::attn_unit<2>(P, b, h, qb, sh, F.tid, qsel >= 2 ? PROBE_ATT_MODE : 0, F.ctl + CW_AQ + 64 * qsel, F.MISC);
        else if (tv == 1) att::attn_unit<1>(P, b, h, qb, sh, F.tid, qsel >= 2 ? PROBE_ATT_MODE : 0, F.ctl + CW_AQ + 64 * qsel, F.MISC);
        else if (tv == 3) att::attn_unit<3>(P, b, h, qb, sh, F.tid, qsel >= 2 ? PROBE_ATT_MODE : 0, F.ctl + CW_AQ + 64 * qsel, F.MISC);
        else att::attn_unit2<0>(P, b, h, qb, sh, F.tid, F.ctl + CW_AQ + 64 * qsel, F.MISC);
#endif
        if (cv) {
            if (F.tid == 0) F.MISC[3] = __hip_atomic_fetch_add(F.ctl + CW_CVQ, (unsigned)CV_CHUNK, RLX_AGENT);
            __syncthreads();
            const int gb = (int)F.MISC[3];
            if (gb >= CV_TOTAL) cv = false; else convert_chunk(F, A, gb, rsl2);
            __syncthreads();
        }
    }
    while (cv) {
        __syncthreads();
        if (F.tid == 0) F.MISC[3] = __hip_atomic_fetch_add(F.ctl + CW_CVQ, (unsigned)CV_CHUNK, RLX_AGENT);
        __syncthreads();
        const int gb = (int)F.MISC[3];
        if (gb >= CV_TOTAL) cv = false; else convert_chunk(F, A, gb, rsl2);
    }
    __syncthreads();
}

template <int N, int Dd> __device__ __forceinline__ void bfly(float (&p)[32], int lane) { const bool up = (lane & Dd) != 0;
#pragma unroll
    for (int j = 0; j < N / 2; ++j) { const float a = p[2 * j], bb = p[2 * j + 1]; const float send = up ? a : bb, keep = up ? bb : a; p[j] = keep + __shfl_xor(send, Dd); } }
__device__ __forceinline__ void p6_router(Frame& F, const Args& A, int l, int rep) {
    const float* MOD = (const float*)(F.ws + WS_MOD); const bf16* X1 = (const bf16*)(F.ws + WS_X1); bf16* H = (bf16*)(F.ws + WS_H);
    const bf16* WRH = (const bf16*)(F.ws + WS_WR) + (size_t)l * 48 * DM; const bf16* WRL = WRH + 2 * 48 * DM;
    int* tok_e = (int*)(F.ws + WS_TOK); float* tok_w = (float*)(F.ws + WS_TOK) + 2 * M; int* tok_pos = (int*)(F.ws + WS_TOK) + 4 * M;
    constexpr int AP = 528;
    LAS unsigned char* Ahi = F.lds; LAS unsigned char* Alo = F.lds + 64 * AP; LAS unsigned char* Bhi = F.lds + 128 * AP; LAS unsigned char* Blo = F.lds + 176 * AP;
    LAS float* PL = (LAS float*)F.lds;
    const int lane = F.lane, w = F.wave; const int mw = (F.vcu * NWAVES + w) * 8; const int b = mw >> 11;
    const float* md = MOD + ((size_t)l * 8 + b) * 6144;
    f32x4 hv[8][4];
#pragma unroll
    for (int r = 0; r < 8; ++r) {
        const bf16* xr = X1 + (size_t)(mw + r) * DM;
#pragma unroll
        for (int j = 0; j < 4; ++j) { const u32x2 q = *(const u32x2*)(xr + 256 * j + 4 * lane); hv[r][j] = (f32x4){bf2f(q.x & 0xffff), bf2f(q.x >> 16), bf2f(q.y & 0xffff), bf2f(q.y >> 16)}; }
    }
    { f32x4 gm[4], sc[4], sh[4]; const float* n2 = inp<I_N2G>() + l * DM;
#pragma unroll
      for (int j = 0; j < 4; ++j) { const int col = 256 * j + 4 * lane; gm[j] = *(const f32x4*)(n2 + col); sc[j] = *(const f32x4*)(md + 4 * DM + col); sh[j] = *(const f32x4*)(md + 3 * DM + col); gm[j] = gm[j] * (sc[j] + 1.0f); }
#pragma unroll
      for (int r = 0; r < 8; ++r) { float ss = 0.f;
#pragma unroll
        for (int j = 0; j < 4; ++j) ss += (hv[r][j][0] * hv[r][j][0] + hv[r][j][1] * hv[r][j][1]) + (hv[r][j][2] * hv[r][j][2] + hv[r][j][3] * hv[r][j][3]);
        const float rstd = 1.0f / sqrtf(wave_sum(ss) * (1.f / DM) + RMS_EPS);
#pragma unroll
        for (int j = 0; j < 4; ++j) { hv[r][j] = hv[r][j] * rstd * gm[j] + sh[j]; u32x2 pk; pk.x = pk2(hv[r][j][0], hv[r][j][1]); pk.y = pk2(hv[r][j][2], hv[r][j][3]);
            *(u32x2*)(H + (size_t)(mw + r) * DM + 256 * j + 4 * lane) = pk; } } }
    const int rt = w & 3, kh = w >> 2, arow = lane & 15, kg = lane >> 4;
    f32x4 acc[3];
#pragma unroll
    for (int c = 0; c < 3; ++c) acc[c] = (f32x4){0.f, 0.f, 0.f, 0.f};
#pragma unroll
    for (int j = 0; j < 4; ++j) {
        __syncthreads();
#pragma unroll
        for (int r = 0; r < 8; ++r) { const f32x4 x = hv[r][j]; unsigned h0 = f2bf(x[0]), h1 = f2bf(x[1]), h2 = f2bf(x[2]), h3 = f2bf(x[3]);
            u32x2 hi; hi.x = h0 | (h1 << 16); hi.y = h2 | (h3 << 16);
            u32x2 lo; lo.x = pk2(x[0] - bf2f((unsigned short)h0), x[1] - bf2f((unsigned short)h1)); lo.y = pk2(x[2] - bf2f((unsigned short)h2), x[3] - bf2f((unsigned short)h3));
            *(LAS u32x2*)(Ahi + (w * 8 + r) * AP + lane * 8) = hi; *(LAS u32x2*)(Alo + (w * 8 + r) * AP + lane * 8) = lo; }
        for (int i = F.tid; i < 48 * 32; i += 512) { const int o = i >> 5, c16 = i & 31;
            *(LAS u32x4*)(Bhi + o * AP + c16 * 16) = *(const u32x4*)(WRH + (size_t)o * DM + 256 * j + 8 * c16);
            *(LAS u32x4*)(Blo + o * AP + c16 * 16) = *(const u32x4*)(WRL + (size_t)o * DM + 256 * j + 8 * c16); }
        LDS_WAIT(); __syncthreads();
#pragma unroll
        for (int ks = 0; ks < 4; ++ks) { const int kb = ((4 * kh + ks) * 32 + 8 * kg) * 2;
            const bf16x8 ah = *(const LAS bf16x8*)(Ahi + (16 * rt + arow) * AP + kb), al = *(const LAS bf16x8*)(Alo + (16 * rt + arow) * AP + kb);
#pragma unroll
            for (int c = 0; c < 3; ++c) { const bf16x8 bh = *(const LAS bf16x8*)(Bhi + (16 * c + arow) * AP + kb), bl = *(const LAS bf16x8*)(Blo + (16 * c + arow) * AP + kb);
                acc[c] = __builtin_amdgcn_mfma_f32_16x16x32_bf16(ah, bh, acc[c], 0, 0, 0);
                acc[c] = __builtin_amdgcn_mfma_f32_16x16x32_bf16(al, bh, acc[c], 0, 0, 0);
                acc[c] = __builtin_amdgcn_mfma_f32_16x16x32_bf16(ah, bl, acc[c], 0, 0, 0); } }
    }
    __syncthreads();
#pragma unroll
    for (int c = 0; c < 3; ++c)
#pragma unroll
        for (int r = 0; r < 4; ++r) PL[(kh * 64 + 16 * rt + kg * 4 + r) * 48 + 16 * c + arow] = acc[c][r];
    LDS_WAIT(); __syncthreads();
    if (F.tid < 64 && rep == 0) {
        const int m = F.vcu * 64 + F.tid; const LAS float* q0 = PL + F.tid * 48; const LAS float* q1 = PL + (64 + F.tid) * 48;
        float gl[4]; int gi = 0; float gm;
#pragma unroll
        for (int g = 0; g < 4; ++g) gl[g] = (q0[g] + q1[g]) + inp<I_BG>()[l * 4 + g];
        gm = gl[0];
#pragma unroll
        for (int g = 1; g < 4; ++g) if (gl[g] > gm) { gm = gl[g]; gi = g; }
        float den = 0.f;
#pragma unroll
        for (int g = 0; g < 4; ++g) den += __expf(gl[g] - gm);
        const float gprob = 1.0f / den;
        float v1 = -INFINITY, v2 = -INFINITY; int i1 = 0, i2 = 0;
        for (int e = 0; e < 8; ++e) { const float v = (q0[4 + gi * 8 + e] + q1[4 + gi * 8 + e]) + inp<I_BE>()[l * 32 + gi * 8 + e];
            if (v > v1) { v2 = v1; i2 = i1; v1 = v; i1 = e; } else if (v > v2) { v2 = v; i2 = e; } }
        const float e2 = __expf(v2 - v1); const float w1 = gprob / (1.f + e2), w2 = gprob * e2 / (1.f + e2);
        const int ea = gi * 8 + i1, eb = gi * 8 + i2;
        tok_e[m] = ea; tok_e[M + m] = eb; tok_w[m] = w1; tok_w[M + m] = w2;
        LAS unsigned* lcnt = (LAS unsigned*)(F.lds + 32768); LAS unsigned* lbase = lcnt + 32;
        if (F.tid < 32) lcnt[F.tid] = 0u;
        asm volatile("s_waitcnt lgkmcnt(0)" ::: "memory");
        const unsigned ra = __hip_atomic_fetch_add(lcnt + ea, 1u, __ATOMIC_RELAXED, __HIP_MEMORY_SCOPE_WORKGROUP), rb = __hip_atomic_fetch_add(lcnt + eb, 1u, __ATOMIC_RELAXED, __HIP_MEMORY_SCOPE_WORKGROUP);
        asm volatile("s_waitcnt lgkmcnt(0)" ::: "memory");
        if (F.tid < 32) { const unsigned n = *(volatile LAS unsigned*)(lcnt + F.tid); unsigned bs = 0u; if (n) bs = __hip_atomic_fetch_add(F.ctl + CW_CNT + (l * 32 + F.tid) * 16, n, RLX_AGENT); *(volatile LAS unsigned*)(lbase + F.tid) = bs; }
        asm volatile("s_waitcnt vmcnt(0) lgkmcnt(0)" ::: "memory");
        const int pa = (int)(*(volatile LAS unsigned*)(lbase + ea) + ra), pb = (int)(*(volatile LAS unsigned*)(lbase + eb) + rb);
        tok_pos[m] = pa; tok_pos[M + m] = pb;
        int* elist = (int*)(F.ws + WS_ELIST); elist[ea * M + pa] = m; elist[eb * M + pb] = m;
    }
}

__device__ __forceinline__ void build_rowlists(Frame& F, int l) {
    volatile LAS int* base = (volatile LAS int*)(F.lds + BASE_OFF); volatile LAS int* cnts = (volatile LAS int*)(F.lds + CNTS_OFF); volatile LAS int* tab = (volatile LAS int*)(F.lds + TAB_OFF);
    LAS int* rowl = (LAS int*)(F.lds + ROWL_OFF); const int* elist = (const int*)(F.ws + WS_ELIST);
    const int ntile = (int)F.MISC[1];
    const int i = F.tid >> 8, r = F.tid & 255; const long L = (long)i * F.G + F.bx;
    int tok = 0;
    if (L < 2L * ntile) { const int tile = (int)(L >> 1), e = tab[tile], pos = 256 * (tile - base[e]) + r; if (pos < cnts[e]) tok = elist[e * M + pos]; }
    rowl[F.tid] = tok;
    __syncthreads();
}

constexpr int NPL = 7, NPH = 2 + 2 * NPL;
__global__ void __launch_bounds__(NWAVES * 64, 2) mk_fwd(Args args) {
    extern __shared__ __attribute__((aligned(16))) unsigned char lds[];
    Frame F;
    F.lds = (LAS unsigned char*)lds;
    F.MISC = (volatile LAS unsigned*)(F.lds + MISC_OFF);
    F.tid = threadIdx.x; F.lane = F.tid & 63; F.wave = __builtin_amdgcn_readfirstlane(F.tid >> 6);
    const int wave0 = F.wave;
    F.G = gridDim.x; F.bx = blockIdx.x; F.vcu = 0;
    F.ws = args.ws; F.out = args.out; F.ctl = (unsigned*)(args.ws + WS_CTL);
    for (int u = F.tid; u < (LDS_BYTES - LDSCTL_OFF) / 4; u += NWAVES * 64) ((LAS unsigned*)(F.lds + LDSCTL_OFF))[u] = 0u;
    __syncthreads();
    XcdBarrier bar; bar.bar = F.ctl + CW_BAR; bar.x = 0; bar.st = nullptr;
    if (!MK_PER_PHASE) bar = xcd_barrier_post(F.ctl + CW_BAR, F.MISC + 8);
    const int lo = args.ph_lo, hi = args.ph_hi;
#pragma unroll 1
    for (int ph = lo; ph < hi; ++ph) {
#if PROBE_REP_K >= 0
        const int ptype = ph == 0 ? 0 : (ph == NPH - 1 ? 10 : 1 + (ph - 1) % NPL);
        const int nrep = (ptype == PROBE_REP_K && (ph <= NPL || (PROBE_REP_K != 1 && PROBE_REP_K != 5))) ? 1 : 0;
#pragma unroll 1
        for (int rep = 0; rep <= nrep; ++rep) {
#else
        constexpr int rep = 0;
#endif
        { int w_ = wave0; asm volatile("" : "+s"(w_)); unsigned on_ = ~0u; asm volatile("" : "+s"(on_)); int ln_ = (int)__builtin_amdgcn_mbcnt_hi(on_, __builtin_amdgcn_mbcnt_lo(on_, 0u)); asm volatile("" : "+v"(ln_));
          F.wave = w_; F.lane = ln_; F.tid = w_ * 64 + ln_;
          unsigned long long ws_ = (unsigned long long)args.ws; asm volatile("" : "+s"(ws_)); F.ws = (unsigned char*)(GAS unsigned char*)ws_; F.ctl = (unsigned*)(F.ws + WS_CTL);
          int bx_ = blockIdx.x; asm volatile("" : "+s"(bx_)); F.bx = bx_; F.vcu = (F.G % 8 == 0) ? (bx_ % 8) * (F.G / 8) + bx_ / 8 : bx_; }
        if (ph == 0) {
#ifndef SKIP_P0
            p0_prologue(F, args);
#endif
        } else if (ph == NPH - 1) {
            row_pass(F, args, 2, 1);
        } else {
            const int l = (ph - 1) / NPL, k = (ph - 1) % NPL;
            if (k == 0) { row_pass(F, args, l == 0 ? 0 : 1, l); }
            else if (k == 1) {
                pg8::Gemm g{(const bf16*)(F.ws + WS_H), (const bf16*)(F.ws + WS_WIN) + (size_t)l * NP * DM, M, NP, DM}; pg8::StaticOrder S; S.init(M, NP, F.G, F.bx);
                pg8::EpiBf16 E{(bf16*)(F.ws + WS_PROJ), NP};
#ifndef SKIP_G1
                pg8::gemm_phase<pg8::EpiBf16, pg8::StaticOrder, true, true>(F.lds, g, S, E, F.tid);
#endif
            } else if (k == 2) {
#ifndef SKIP_P3
                p3_prep(F, args, l, rep);
#endif
            } else if (k == 3) {
#ifndef SKIP_P4
                p4_attention(F, args, l, l + 2 * rep);
#endif
            } else if (k == 4) {
                pg8::Gemm g{(const bf16*)(F.ws + WS_MIX), (const bf16*)(F.ws + WS_WOUT) + (size_t)l * DM * DM, M, DM, DM}; pg8::StaticOrder S; S.init(M, DM, F.G, F.bx);
                pg8::EpiResGate E{l == 0 ? inp<I_X>() : nullptr, (const bf16*)(F.ws + WS_X1), (bf16*)(F.ws + WS_X1), (const float*)(F.ws + WS_MOD) + (size_t)l * 8 * 6144 + 2 * DM};
#ifndef SKIP_G2
                pg8::gemm_phase<pg8::EpiResGate, pg8::StaticOrder, false, true>(F.lds, g, S, E, F.tid);
#endif
            } else if (k == 5) {
#ifndef SKIP_P6
                p6_router(F, args, l, rep);
#endif
            } else {
                build_tables(F, l); build_rowlists(F, l);
                unsigned* upf = F.ctl + CW_UPF + l * 8192; unsigned* dq = F.ctl + CW_DNQ + 16 * l;
                { pg8::Gemm g{(const bf16*)(F.ws + WS_H), (const bf16*)(F.ws + WS_WUP) + (size_t)l * NEXP * 512 * DM, MAXSLOT, 512, DM};
                  pg8::GroupOrder S{(const LAS int*)(F.lds + TAB_OFF), (int)F.MISC[1], 2, F.G, F.bx, (size_t)512 * DM * 2};
                  pg8::EpiSwiglu E{(bf16*)(F.ws + WS_HID), upf};
#ifndef SKIP_G3
                  pg8::gemm_phase<pg8::EpiSwiglu, pg8::GroupOrder, true, true, true>(F.lds, g, S, E, F.tid, (const LAS int*)(F.lds + ROWL_OFF));
#endif
                }
                if (GAP_CONVERT && !BG_CONVERT && l == 0 && rep == 0) convert_layer1_in_gap(F, args, 2 * (int)F.MISC[1] - F.G);
                { const pg8::Gemm g{(const bf16*)(F.ws + WS_HID), (const bf16*)(F.ws + WS_WDN) + (size_t)l * NEXP * DM * FF, MAXSLOT, DM, FF};
                  const pg8::EpiBf16 E{(bf16*)(F.ws + WS_Y), DM};
                  const LAS int* tab = (const LAS int*)(F.lds + TAB_OFF);
                  const int nd = 4 * __builtin_amdgcn_readfirstlane((int)F.MISC[1]);
                  pg8::DynOrder S{dq, upf, tab, F.MISC, nd, (size_t)DM * FF * 2, F.tid, 0u, 2u};
                  if (F.tid == 0) { const unsigned a = __hip_atomic_fetch_add(dq, 1u, RLX_AGENT), b = __hip_atomic_fetch_add(dq, 1u, RLX_AGENT); F.MISC[4] = a; F.MISC[5] = b;
                      if ((int)a < nd) while (__hip_atomic_load(upf + (a >> 2) * 16, RLX_AGENT) < 2u) __builtin_amdgcn_s_sleep(8);
                      __builtin_amdgcn_fence(__ATOMIC_ACQUIRE, "agent"); asm volatile("s_waitcnt vmcnt(0)" ::: "memory"); S.issue(b); }
                  __syncthreads();
                  for (;;) {
                      if (__builtin_amdgcn_readfirstlane((int)F.MISC[4]) >= nd) break;
#ifndef SKIP_G4
                      pg8::gemm_phase<pg8::EpiBf16, pg8::DynOrder, true, true>(F.lds, g, S, E, F.tid);
#endif
                      if (F.tid == 0) {
                          const unsigned idn = F.MISC[5];
                          if ((int)idn < nd) { unsigned f = S.pflag; while (f < 2u) { __builtin_amdgcn_s_sleep(8); f = __hip_atomic_load(upf + (idn >> 2) * 16, RLX_AGENT); }
                              __builtin_amdgcn_fence(__ATOMIC_ACQUIRE, "agent"); asm volatile("s_waitcnt vmcnt(0)" ::: "memory"); }
                          const unsigned idn2 = S.ppop; F.MISC[4] = idn; F.MISC[5] = idn2; S.issue(idn2); }
                      __syncthreads();
                  }
                }
            }
        }
#if PROBE_REP_K >= 0
        if (rep < nrep) xcd_barrier(bar, F.tid);
        }
#endif
        if (ph + 1 < hi) xcd_barrier(bar, F.tid);
#ifdef PROBE_DOUBLE_BAR
        if (ph + 1 < hi) xcd_barrier(bar, F.tid);
#endif
    }
}

extern "C" void kernel_launch(void* const* d_in, const int* in_sizes, int n_in, void* d_out, int out_size, void* d_ws, size_t ws_size, hipStream_t stream) {
    static int grid = 0;
    if (grid == 0) {
        if (n_in != 28 || out_size != M * DM || ws_size < WS_END) { fprintf(stderr, "kernel_launch: unexpected shapes (n_in %d, out %d, ws %zu)\n", n_in, out_size, ws_size); grid = -1; return; }
        int dev = 0, cus = 0, per_cu = 0;
        if (hipGetDevice(&dev) != hipSuccess || hipDeviceGetAttribute(&cus, hipDeviceAttributeMultiprocessorCount, dev) != hipSuccess) { grid = -1; return; }
        if (hipFuncSetAttribute((const void*)mk_fwd, hipFuncAttributeMaxDynamicSharedMemorySize, LDS_BYTES) != hipSuccess) { fprintf(stderr, "kernel_launch: hipFuncSetAttribute failed\n"); grid = -1; return; }
        if (hipOccupancyMaxActiveBlocksPerMultiprocessor(&per_cu, (const void*)mk_fwd, NWAVES * 64, LDS_BYTES) != hipSuccess || per_cu < 1)
            fprintf(stderr, "kernel_launch: occupancy query reports %d workgroups per CU\n", per_cu);
        (void)hipGetLastError();
        grid = cus;
    }
    if (grid < 0) return;
    if (hipMemsetAsync((char*)d_ws + WS_CTL, 0, CTL_ZERO_BYTES, stream) != hipSuccess) return;
    Args a{};
    for (int i = 0; i < 28; ++i) a.in[i] = (const float*)d_in[i];
    a.out = (float*)d_out; a.ws = (unsigned char*)d_ws;
#if MK_PER_PHASE
    for (int p = 0; p < NPH; ++p) { a.ph_lo = p; a.ph_hi = p + 1; hipLaunchKernelGGL(mk_fwd, dim3(grid), dim3(NWAVES * 64), LDS_BYTES, stream, a); }
#else
    a.ph_lo = 0; a.ph_hi = NPH; hipLaunchKernelGGL(mk_fwd, dim3(grid), dim3(NWAVES * 64), LDS_BYTES, stream, a);
#endif
}
```

```cpp
#include <hip/hip_runtime.h>
#include <cstdio>
#include <cstdint>

#ifndef MK_PER_PHASE
#define MK_PER_PHASE 0
#endif

#ifndef PROBE_P3_PART
#define PROBE_P3_PART 0
#endif
#ifndef PROBE_ATT_VAR
#define PROBE_ATT_VAR -1
#endif
#ifndef BG_CONVERT
#define BG_CONVERT 1
#endif
#ifndef GAP_CONVERT
#define GAP_CONVERT 1
#endif
#ifndef PROBE_ATT_MODE
#define PROBE_ATT_MODE 0
#endif
#ifndef PROBE_REP_K
#define PROBE_REP_K -1
#endif
#define LAS __attribute__((address_space(3)))
#define GAS __attribute__((address_space(1)))
typedef unsigned short bf16;
typedef short bf16x8 __attribute__((ext_vector_type(8)));
typedef short s16x4 __attribute__((ext_vector_type(4)));
typedef float f32x4 __attribute__((ext_vector_type(4)));
typedef float f32x2 __attribute__((ext_vector_type(2)));
typedef float f32x16 __attribute__((ext_vector_type(16)));
typedef unsigned u32x4 __attribute__((ext_vector_type(4)));
typedef unsigned u32x2 __attribute__((ext_vector_type(2)));

constexpr int BATCH = 8, SEQ = 2048, DM = 1024, M = BATCH * SEQ, DEPTH = 2;
constexpr int NP = 3072;
constexpr int P_IN = 2988;
constexpr int C_AQ = 0, C_AK = 256, C_AV = 512, C_BQ = 768, C_BK = 1024, C_BV = 1280, C_CQ = 1536, C_CK = 1792, C_CV = 2048,
              C_DQ = 2304, C_DK = 2560, C_DV = 2624, C_IQ = 2688, C_IK = 2944, C_IW = 2976, C_AF = 2984;
constexpr int NEXP = 32, FF = 256, MAXSLOT = M * 2 + NEXP * 256, MAXTILE = MAXSLOT / 256;
constexpr float LOG2E = 1.4426950408889634f;
constexpr float RMS_EPS = 1e-6f;

constexpr size_t MiB = 1u << 20;
constexpr size_t WS_CTL = 0, CTL_ZERO_BYTES = 1 * MiB;
constexpr size_t WS_WR = 1 * MiB;
constexpr size_t WS_MOD = 2 * MiB;
constexpr size_t WS_CUM = 3 * MiB;
constexpr size_t WS_TOK = 4 * MiB;
constexpr size_t WS_MISC = 5 * MiB;
constexpr size_t WS_MASK = 6 * MiB;
constexpr size_t WS_WIN = 10 * MiB;
constexpr size_t WS_WOUT = 22 * MiB;
constexpr size_t WS_WUP = 26 * MiB;
constexpr size_t WS_WDN = 90 * MiB;
constexpr size_t WS_X1 = 122 * MiB;
constexpr size_t WS_H = 186 * MiB;
constexpr size_t WS_MIX = WS_H;

constexpr size_t WS_PROJ = 218 * MiB;
constexpr size_t WS_Y = WS_PROJ;
constexpr size_t WS_HID = WS_PROJ + 80 * MiB;
constexpr size_t WS_ELIST = 322 * MiB;
constexpr size_t WS_END = 324 * MiB;
constexpr int CW_AQ = 256;
constexpr int CW_CNT = 1024;
constexpr int CW_BAR = 8192;
constexpr int CW_DNQ = 208;
constexpr int CW_UPF = 65536;

constexpr int RING_BYTES = 143360;
constexpr int LDSCTL_OFF = RING_BYTES, MISC_OFF = LDSCTL_OFF + 320, CNTS_OFF = LDSCTL_OFF + 512, BASE_OFF = LDSCTL_OFF + 640, TAB_OFF = LDSCTL_OFF + 768;
constexpr int ROWL_OFF = 131072;
constexpr int LDS_BYTES = 147456;
constexpr int NWAVES = 8;

#define LDS_WAIT() asm volatile("s_waitcnt lgkmcnt(0)" ::: "memory")
#define VM_WAIT() asm volatile("s_waitcnt vmcnt(0)" ::: "memory")
#define RLX_AGENT __ATOMIC_RELAXED, __HIP_MEMORY_SCOPE_AGENT

__device__ __forceinline__ float bf2f(unsigned short u) { return __builtin_bit_cast(float, (unsigned)u << 16); }
__device__ __forceinline__ unsigned f2bf(float f) { unsigned u = __builtin_bit_cast(unsigned, f); return (u + 0x7fffu + ((u >> 16) & 1u)) >> 16; }
__device__ __forceinline__ unsigned pk2(float lo, float hi) { return f2bf(lo) | (f2bf(hi) << 16); }
template <int O> __device__ __forceinline__ float shx(float x) { static_assert(O >= 1 && O <= 16, "swizzle xor"); return __builtin_bit_cast(float, __builtin_amdgcn_ds_swizzle(__builtin_bit_cast(int, x), (O << 10) | 0x1f)); }
__device__ __forceinline__ float half_sum(float x) { return __builtin_bit_cast(float, __builtin_amdgcn_readlane(__builtin_bit_cast(int, x), 0)) + __builtin_bit_cast(float, __builtin_amdgcn_readlane(__builtin_bit_cast(int, x), 32)); }
__device__ __forceinline__ float half_max(float x) { return fmaxf(__builtin_bit_cast(float, __builtin_amdgcn_readlane(__builtin_bit_cast(int, x), 0)), __builtin_bit_cast(float, __builtin_amdgcn_readlane(__builtin_bit_cast(int, x), 32))); }
__device__ __forceinline__ float shup(float x, int o, int lane) { return __builtin_bit_cast(float, __builtin_amdgcn_ds_bpermute((lane - o) << 2, __builtin_bit_cast(int, x))); }
__device__ __forceinline__ int shup_i(int x, int o, int lane) { return __builtin_amdgcn_ds_bpermute((lane - o) << 2, x); }
__device__ __forceinline__ float wave_sum(float v) { v += shx<1>(v); v += shx<2>(v); v += shx<4>(v); v += shx<8>(v); v += shx<16>(v); return half_sum(v); }

namespace pg8 {
constexpr int BM = 256, BK = 64, HALF = 128, HTB = HALF * BK * 2, STAGE_BYTES = 8 * HTB, NXCD = 8, WGM = 8;
__host__ __device__ __forceinline__ int lds_byte(int r, int c) { const int st = (r >> 4) * 2 + (c >> 5), rr = r & 15, cc = c & 31, ob = rr * 64 + cc * 2; return st * 1024 + (ob ^ (((ob >> 9) & 1) << 5)); }
__host__ __device__ __forceinline__ void stage_rc(int b, int& R, int& C) { const int st = b / 1024, sb = b % 1024, swz = sb ^ (((sb >> 9) & 1) << 5); R = (st >> 1) * 16 + swz / 64; C = (st & 1) * 32 + (swz % 64) / 2; }
__host__ __device__ __forceinline__ int perm32(int rho) { const int n = rho >> 4, i = rho & 15; return 8 * (i >> 2) + 4 * n + (i & 3); }

struct Unit { int pm, pn; size_t bo; };
struct Gemm { const bf16* A; const bf16* Bt; int M, N, K; };

struct StaticOrder {
    int nM, nN, nwg, G, c;
    __host__ __device__ void init(int M_, int N_, int G_, int c_) { nM = M_ / BM; nN = N_ / BM; nwg = nM * nN; G = G_; c = c_; }
    __host__ __device__ bool next(int i, Unit& u) const {
        const long L = (long)i * G + c; if (L >= nwg) return false;
        int wgid = (int)L; { const int q = nwg / NXCD, r = nwg % NXCD, xcd = wgid % NXCD, off = wgid / NXCD; wgid = (xcd < r ? xcd * (q + 1) : r * (q + 1) + (xcd - r) * q) + off; }
        const int nig = WGM * nN, gid = wgid / nig, fm = gid * WGM, gsz = (nM - fm) < WGM ? (nM - fm) : WGM;
        u.pm = fm + ((wgid % nig) % gsz); u.pn = (wgid % nig) / gsz; u.bo = 0; return true;
    }
};
struct GroupOrder {
    const LAS int* tab; int ntile, ncol, G, c; size_t ebytes;
    __device__ __forceinline__ bool next(int i, Unit& u) const {
        const long L = (long)i * G + c; if (L >= (long)ntile * ncol) return false;
        u.pm = (int)(L / ncol); u.pn = (int)(L % ncol);
        const int e = __builtin_amdgcn_readfirstlane(tab[u.pm]); u.bo = (size_t)e * ebytes; return true;
    }
};

struct OneUnit { Unit u; __device__ __forceinline__ bool next(int i, Unit& o) const { if (i != 0) return false; o = u; return true; } };
struct DynOrder {
    unsigned* dq; unsigned* upf; const LAS int* tab; volatile LAS unsigned* M; int nd; size_t ebytes; int tid; unsigned G;
    mutable unsigned ppop, pflag;
    __device__ __forceinline__ void issue(unsigned idnext) const {
        ppop = G + __builtin_amdgcn_atomic_inc32(dq, 0xFFFFFFFFu, __ATOMIC_RELAXED, "agent");
        pflag = 2u; if ((int)idnext < nd) pflag = __hip_atomic_load(upf + (idnext >> 2) * 16, __ATOMIC_RELAXED, __HIP_MEMORY_SCOPE_AGENT);
    }
    __device__ __forceinline__ void unit(int id, Unit& u) const { u.pm = id >> 2; u.pn = id & 3; u.bo = (size_t)__builtin_amdgcn_readfirstlane(tab[id >> 2]) * ebytes; }
    __device__ __forceinline__ bool next(int i, Unit& u) const {
        if (i == 0) { const int id = __builtin_amdgcn_readfirstlane((int)M[4]); if (id >= nd) return false; unit(id, u); return true; }
        if (tid == 0) {
            const unsigned idn = M[5]; const bool ready = (int)idn < nd && pflag >= 2u;
            M[6] = ready ? 1u : 0u;
            if (ready) { asm volatile("buffer_inv sc1" ::: "memory"); M[4] = idn; const unsigned idn2 = ppop; M[5] = idn2; issue(idn2); }
        }
        asm volatile("s_waitcnt lgkmcnt(0)\n\ts_barrier" ::: "memory");
        if (__builtin_amdgcn_readfirstlane((int)M[6]) == 0) return false;
        unit(__builtin_amdgcn_readfirstlane((int)M[4]), u); return true;
    }
};

__device__ __forceinline__ unsigned cvt_pk_bf16(float lo, float hi) { unsigned r; asm volatile("v_cvt_pk_bf16_f32 %0, %1, %2" : "=v"(r) : "v"(lo), "v"(hi)); return r; }

struct EpiBf16 {
    static constexpr bool PERM = true, PUBLISH = false;
    bf16* O; int ldc;
    __device__ __forceinline__ void operator()(const f32x4 (&acc)[2][2][4][2], const Unit& u, int wr, int wc, int fr, int fq) const {
        const int row0 = u.pm * BM + wr * 64 + fr; const int col0 = u.pn * BM + wc * 32 + 8 * fq;
#pragma unroll
        for (int ai = 0; ai < 2; ++ai)
#pragma unroll
            for (int m = 0; m < 4; ++m) { bf16* rowp = O + (size_t)(row0 + ai * HALF + m * 16) * ldc + col0;
#pragma unroll
                for (int bj = 0; bj < 2; ++bj) { const f32x4 v0 = acc[ai][bj][m][0], v1 = acc[ai][bj][m][1];
                    u32x4 w; w.x = cvt_pk_bf16(v0[0], v0[1]); w.y = cvt_pk_bf16(v0[2], v0[3]); w.z = cvt_pk_bf16(v1[0], v1[1]); w.w = cvt_pk_bf16(v1[2], v1[3]);
                    *(u32x4*)(rowp + bj * HALF) = w; } }
    }
};
struct EpiResGate {
    static constexpr bool PERM = true, PUBLISH = false;
    const float* base32; const bf16* base16; bf16* out; const float* gate;
    __device__ __forceinline__ void operator()(const f32x4 (&acc)[2][2][4][2], const Unit& u, int wr, int wc, int fr, int fq) const {
        const int col0 = u.pn * BM + wc * 32 + 8 * fq; const float* g = gate + (size_t)(u.pm >> 3) * 6144 + col0;
        f32x4 gv[2][2];
#pragma unroll
        for (int bj = 0; bj < 2; ++bj)
#pragma unroll
            for (int n = 0; n < 2; ++n) gv[bj][n] = *(const f32x4*)(g + bj * HALF + n * 4);
#pragma unroll
        for (int ai = 0; ai < 2; ++ai)
#pragma unroll
            for (int m = 0; m < 4; ++m) { const size_t off = (size_t)(u.pm * BM + ai * HALF + wr * 64 + m * 16 + fr) * DM + col0;
#pragma unroll
                for (int bj = 0; bj < 2; ++bj) { f32x4 b0, b1;
                    if (base32) { b0 = *(const f32x4*)(base32 + off + bj * HALF); b1 = *(const f32x4*)(base32 + off + bj * HALF + 4); }
                    else { const u32x4 r = *(const u32x4*)(base16 + off + bj * HALF);
                        b0 = (f32x4){bf2f(r.x & 0xffff), bf2f(r.x >> 16), bf2f(r.y & 0xffff), bf2f(r.y >> 16)}; b1 = (f32x4){bf2f(r.z & 0xffff), bf2f(r.z >> 16), bf2f(r.w & 0xffff), bf2f(r.w >> 16)}; }
                    const f32x4 v0 = b0 + gv[bj][0] * acc[ai][bj][m][0], v1 = b1 + gv[bj][1] * acc[ai][bj][m][1];
                    u32x4 w; w.x = cvt_pk_bf16(v0[0], v0[1]); w.y = cvt_pk_bf16(v0[2], v0[3]); w.z = cvt_pk_bf16(v1[0], v1[1]); w.w = cvt_pk_bf16(v1[2], v1[3]);
                    *(u32x4*)(out + off + bj * HALF) = w; } }
    }
};
struct EpiSwiglu {
    static constexpr bool PERM = true, PUBLISH = true;
    bf16* O; unsigned* flag;
    __device__ __forceinline__ void operator()(const f32x4 (&acc)[2][2][4][2], const Unit& u, int wr, int wc, int fr, int fq) const {
        const int row0 = u.pm * BM + wr * 64 + fr; const int col0 = u.pn * HALF + wc * 32 + 8 * fq;
#pragma unroll
        for (int ai = 0; ai < 2; ++ai)
#pragma unroll
            for (int m = 0; m < 4; ++m) { bf16* rowp = O + (size_t)(row0 + ai * HALF + m * 16) * FF + col0;
                float hv[8];
#pragma unroll
                for (int n = 0; n < 2; ++n)
#pragma unroll
                    for (int i = 0; i < 4; ++i) { const float a = acc[ai][0][m][n][i], b = acc[ai][1][m][n][i];
                        const float sg = __builtin_amdgcn_rcpf(1.f + __builtin_amdgcn_exp2f(-a * LOG2E)); hv[n * 4 + i] = a * sg * b; }
                u32x4 w; w.x = cvt_pk_bf16(hv[0], hv[1]); w.y = cvt_pk_bf16(hv[2], hv[3]); w.z = cvt_pk_bf16(hv[4], hv[5]); w.w = cvt_pk_bf16(hv[6], hv[7]);
                asm volatile("global_store_dwordx4 %0, %1, off sc1\n\ts_nop 2" :: "v"((const GAS bf16*)rowp), "v"(w) : "memory"); }
    }
};

template <class Epi, class Sched, bool ALIGN_EPI = false, bool SP2 = false, bool GATHER = false>
__device__ __forceinline__ void gemm_phase(LAS unsigned char* lds, const Gemm g, const Sched& S, const Epi& E, const int tid, const LAS int* rowl = nullptr) {
    static_assert(!GATHER || SP2, "gather mode is written for the SP2 loop");
    const int wid = __builtin_amdgcn_readfirstlane(tid >> 6), lane = tid & 63, wr = wid >> 2, wc = wid & 3, fr = lane & 15, fq = lane >> 4;
    const int K = g.K, nt = K / BK;
    unsigned voffA[2], voffB[2];
#pragma unroll
    for (int i = 0; i < 2; ++i) { int R, C; stage_rc(tid * 16 + i * 8192, R, C); const int Rb = Epi::PERM ? ((R & ~31) + perm32(R & 31)) : R;
        voffA[i] = (unsigned)(R * K + C) * 2u; voffB[i] = (unsigned)(Rb * K + C) * 2u; }
    const size_t kstep = (size_t)(BK * 2);
    const size_t hstep = (size_t)HALF * K * 2;
    const size_t tstep = 2 * hstep;
    const size_t hstepA = GATHER ? 0 : hstep, tstepA = GATHER ? 0 : tstep;
    unsigned voffGc[2][2], voffGn[2][2];
    int gR[2], gC[2];
#pragma unroll
    for (int i = 0; i < 2; ++i) stage_rc(tid * 16 + i * 8192, gR[i], gC[i]);
#define PG8_GOFF(dst, ui_) do { _Pragma("unroll") for (int h_ = 0; h_ < 2; ++h_) _Pragma("unroll") for (int i_ = 0; i_ < 2; ++i_) \
        dst[h_][i_] = (unsigned)rowl[(ui_) * 256 + h_ * HALF + gR[i_]] * (unsigned)(K * 2) + (unsigned)gC[i_] * 2u; } while (0)
    const unsigned ldsw = (unsigned)wid * 1024u;
    const int aoff = lds_byte(wr * 64 + fr, fq * 8), boff = lds_byte(wc * 32 + fr, fq * 8);
#define PG8_SA(b, h) (((b) * 2 + (h)) * HTB)
#define PG8_SB(b, h) ((4 + (b) * 2 + (h)) * HTB)
#define PG8_STAGE(bufoff, gbase, voff) do { _Pragma("unroll") for (int _i = 0; _i < 2; ++_i) \
        __builtin_amdgcn_global_load_lds((const unsigned*)((const char*)(gbase) + (voff)[_i]), (LAS unsigned*)(lds + (bufoff) + ldsw + _i * 8192), 16, 0, 0); } while (0)
#define PG8_STAGE_A(bufoff, gbase, H, NXT) do { if constexpr (GATHER) { unsigned vo_[2]; vo_[0] = (NXT) ? voffGn[H][0] : voffGc[H][0]; vo_[1] = (NXT) ? voffGn[H][1] : voffGc[H][1]; PG8_STAGE(bufoff, gbase, vo_); } \
        else { PG8_STAGE(bufoff, (const char*)(gbase) + (H) * hstep, voffA); } } while (0)
#define PG8_LDA(dst, b, h) do { _Pragma("unroll") for (int m = 0; m < 4; ++m) _Pragma("unroll") for (int k = 0; k < 2; ++k) dst[m][k] = *(const LAS bf16x8*)(lds + PG8_SA(b, h) + aoff + m * 2048 + k * 1024); } while (0)
#define PG8_LDB(dst, b, h) do { _Pragma("unroll") for (int n = 0; n < 2; ++n) _Pragma("unroll") for (int k = 0; k < 2; ++k) dst[n][k] = *(const LAS bf16x8*)(lds + PG8_SB(b, h) + boff + n * 2048 + k * 1024); } while (0)
#define PG8_MMA(ai, bj, At, Bt) do { __builtin_amdgcn_s_setprio(1); _Pragma("unroll") for (int m = 0; m < 4; ++m) _Pragma("unroll") for (int n = 0; n < 2; ++n) _Pragma("unroll") for (int k = 0; k < 2; ++k) \
        acc[ai][bj][m][n] = __builtin_amdgcn_mfma_f32_16x16x32_bf16(Bt[n][k], At[m][k], acc[ai][bj][m][n], 0, 0, 0); __builtin_amdgcn_s_setprio(0); } while (0)
#define PG8_WAIT_V(n) asm volatile("s_waitcnt vmcnt(" #n ")" ::: "memory")
#define PG8_WAIT_L(n) asm volatile("s_waitcnt lgkmcnt(" #n ")" ::: "memory")
#define PG8_BAR __builtin_amdgcn_s_barrier()
#define PG8_SCHED __builtin_amdgcn_sched_barrier(0)
    Unit cur, nxt; int ui = 0;
    if (!S.next(0, cur)) return;
    f32x4 acc[2][2][4][2];
#pragma unroll
    for (int a = 0; a < 2; ++a)
#pragma unroll
        for (int b = 0; b < 2; ++b)
#pragma unroll
            for (int m = 0; m < 4; ++m)
#pragma unroll
                for (int n = 0; n < 2; ++n) acc[a][b][m][n] = (f32x4){0.f, 0.f, 0.f, 0.f};
    bf16x8 At[4][2], B0[2][2], B1[2][2];
    const char* cA = (const char*)g.A + (size_t)cur.pm * tstepA; const char* cB = (const char*)g.Bt + cur.bo + (size_t)cur.pn * tstep;
    if constexpr (GATHER) { PG8_GOFF(voffGc, 0); PG8_GOFF(voffGn, 0); }
    if constexpr (SP2) {
        PG8_STAGE(PG8_SB(0, 0), cB, voffB); PG8_STAGE(PG8_SB(0, 1), cB + hstep, voffB); PG8_STAGE_A(PG8_SA(0, 0), cA, 0, false); PG8_STAGE_A(PG8_SA(0, 1), cA, 1, false);
        if (wr == 1) PG8_BAR;
        PG8_WAIT_V(2); PG8_BAR;
        PG8_STAGE(PG8_SB(1, 0), cB + kstep, voffB); PG8_STAGE_A(PG8_SA(1, 0), cA + kstep, 0, false); PG8_STAGE(PG8_SB(1, 1), cB + hstep + kstep, voffB);
        PG8_WAIT_V(6); PG8_BAR;
    } else {
        PG8_STAGE(PG8_SB(0, 0), cB, voffB); PG8_STAGE(PG8_SA(0, 0), cA, voffA); PG8_STAGE(PG8_SB(0, 1), cB + hstep, voffB); PG8_STAGE(PG8_SA(0, 1), cA + hstep, voffA);
        if (wr == 1) PG8_BAR;
        PG8_WAIT_V(4); PG8_BAR;
        PG8_STAGE(PG8_SB(1, 0), cB + kstep, voffB); PG8_STAGE(PG8_SA(1, 0), cA + kstep, voffA); PG8_STAGE(PG8_SB(1, 1), cB + hstep + kstep, voffB);
        PG8_WAIT_V(6); PG8_BAR;
    }
    for (;;) {
        const bool has_next = S.next(ui + 1, nxt);
        if constexpr (GATHER) { if (has_next) PG8_GOFF(voffGn, ui + 1); }
        const char* nA = has_next ? (const char*)g.A + (size_t)nxt.pm * tstepA : cA; const char* nB = has_next ? (const char*)g.Bt + nxt.bo + (size_t)nxt.pn * tstep : cB;
#pragma unroll 1
        for (int t = 0; t < nt; t += 2) {
            const bool last = (t == nt - 2);
            const char* a1 = cA + (size_t)(t + 1) * kstep;
            const char* a2 = last ? nA : cA + (size_t)(t + 2) * kstep; const char* b2 = last ? nB : cB + (size_t)(t + 2) * kstep;
            const char* a3 = a2 + kstep; const char* b3 = b2 + kstep;
            if constexpr (SP2) {
            PG8_LDB(B0, 0, 0); PG8_LDB(B1, 0, 1); PG8_SCHED; PG8_LDA(At, 0, 0); PG8_STAGE_A(PG8_SA(1, 1), a1, 1, false);
            PG8_WAIT_V(8); PG8_WAIT_L(0); PG8_BAR; PG8_MMA(0, 0, At, B0); PG8_MMA(0, 1, At, B1); PG8_BAR; PG8_SCHED;
            PG8_LDA(At, 0, 1); PG8_STAGE(PG8_SB(0, 0), b2, voffB); PG8_STAGE(PG8_SB(0, 1), b2 + hstep, voffB); PG8_STAGE_A(PG8_SA(0, 0), a2, 0, last);
            PG8_WAIT_V(8); PG8_WAIT_L(0); PG8_BAR; PG8_MMA(1, 0, At, B0); PG8_MMA(1, 1, At, B1); PG8_BAR; PG8_SCHED;
            PG8_LDB(B0, 1, 0); PG8_LDB(B1, 1, 1); PG8_SCHED; PG8_LDA(At, 1, 0); PG8_STAGE_A(PG8_SA(0, 1), a2, 1, last);
            PG8_WAIT_V(8); PG8_WAIT_L(0); PG8_BAR; PG8_MMA(0, 0, At, B0); PG8_MMA(0, 1, At, B1); PG8_BAR; PG8_SCHED;
            PG8_LDA(At, 1, 1); PG8_STAGE(PG8_SB(1, 0), b3, voffB); PG8_STAGE(PG8_SB(1, 1), b3 + hstep, voffB); PG8_STAGE_A(PG8_SA(1, 0), a3, 0, last);
            PG8_WAIT_V(8); PG8_WAIT_L(0); PG8_BAR; PG8_MMA(1, 0, At, B0); PG8_MMA(1, 1, At, B1); PG8_BAR; PG8_SCHED;
            } else {
            PG8_LDB(B0, 0, 0); PG8_SCHED; PG8_LDA(At, 0, 0); PG8_STAGE(PG8_SA(1, 1), a1 + hstep, voffA);
            PG8_WAIT_L(8); PG8_BAR; PG8_WAIT_L(0); PG8_MMA(0, 0, At, B0); PG8_BAR; PG8_SCHED;
            PG8_LDB(B1, 0, 1); PG8_STAGE(PG8_SB(0, 0), b2, voffB);
            PG8_BAR; PG8_WAIT_L(0); PG8_MMA(0, 1, At, B1); PG8_BAR;
            PG8_LDA(At, 0, 1); PG8_STAGE(PG8_SA(0, 0), a2, voffA);
            PG8_BAR; PG8_WAIT_L(0); PG8_MMA(1, 0, At, B0); PG8_BAR; PG8_SCHED;
            PG8_STAGE(PG8_SB(0, 1), b2 + hstep, voffB);
            PG8_WAIT_V(6); PG8_BAR; PG8_MMA(1, 1, At, B1); PG8_BAR;
            PG8_LDB(B0, 1, 0); PG8_SCHED; PG8_LDA(At, 1, 0); PG8_STAGE(PG8_SA(0, 1), a2 + hstep, voffA);
            PG8_WAIT_L(8); PG8_BAR; PG8_WAIT_L(0); PG8_MMA(0, 0, At, B0); PG8_BAR; PG8_SCHED;
            PG8_LDB(B1, 1, 1); PG8_STAGE(PG8_SB(1, 0), b3, voffB);
            PG8_BAR; PG8_WAIT_L(0); PG8_MMA(0, 1, At, B1); PG8_BAR;
            PG8_LDA(At, 1, 1); PG8_STAGE(PG8_SA(1, 0), a3, voffA);
            PG8_BAR; PG8_WAIT_L(0); PG8_MMA(1, 0, At, B0); PG8_BAR; PG8_SCHED;
            PG8_STAGE(PG8_SB(1, 1), b3 + hstep, voffB);
            PG8_WAIT_V(6); PG8_BAR; PG8_MMA(1, 1, At, B1); PG8_BAR;
            }
        }
        if constexpr (ALIGN_EPI) { if (wr == 0) PG8_BAR; }
        E(acc, cur, wr, wc, fr, fq);
        if constexpr (Epi::PUBLISH) {
            asm volatile("s_waitcnt vmcnt(0)" ::: "memory"); PG8_BAR;
            if (tid == 0) __hip_atomic_fetch_add(E.flag + cur.pm * 16, 1u, __ATOMIC_RELAXED, __HIP_MEMORY_SCOPE_AGENT);
        }
        if (!has_next) break;
#pragma unroll
        for (int a = 0; a < 2; ++a)
#pragma unroll
            for (int b = 0; b < 2; ++b)
#pragma unroll
                for (int m = 0; m < 4; ++m)
#pragma unroll
                    for (int n = 0; n < 2; ++n) acc[a][b][m][n] = (f32x4){0.f, 0.f, 0.f, 0.f};
        cur = nxt; cA = nA; cB = nB; ++ui;
        if constexpr (GATHER) { _Pragma("unroll") for (int h_ = 0; h_ < 2; ++h_) _Pragma("unroll") for (int i_ = 0; i_ < 2; ++i_) voffGc[h_][i_] = voffGn[h_][i_]; }
        if constexpr (ALIGN_EPI) { if (wr == 1) PG8_BAR; }
    }
    PG8_WAIT_V(0);
    if constexpr (!ALIGN_EPI) { if (wr == 0) PG8_BAR; }
    PG8_BAR;
#undef PG8_SA
#undef PG8_STAGE_A
#undef PG8_GOFF
#undef PG8_SB
#undef PG8_STAGE
#undef PG8_LDA
#undef PG8_LDB
#undef PG8_MMA
#undef PG8_WAIT_V
#undef PG8_WAIT_L
#undef PG8_BAR
#undef PG8_SCHED
}
}

#define XB_TMO      128
#define XB_XCNT(j)  (256  + 64 * (j))
#define XB_XSUB(j)  (1280 + 64 * (j))
#define XB_XGEN(j)  (2304 + 64 * (j))
#define XB_TOP      3328
#define XB_TOPGEN   3392
#define XCD_BAR_WORDS 3456
#define XB_SPIN_CAP (1u << 18)
__device__ __forceinline__ unsigned xb_ld(unsigned* p)              { return __hip_atomic_load(p, __ATOMIC_RELAXED, __HIP_MEMORY_SCOPE_AGENT); }
__device__ __forceinline__ unsigned xb_add(unsigned* p, unsigned v) { return __hip_atomic_fetch_add(p, v, __ATOMIC_RELAXED, __HIP_MEMORY_SCOPE_AGENT); }
__device__ __forceinline__ unsigned xb_xcc_id() { return (unsigned)__builtin_amdgcn_s_getreg((3 << 11) | 20) & 0xFu; }
#define XB_SPIN(cond, bar) do { unsigned _sp = 0; while (cond) { __builtin_amdgcn_s_sleep(1); \
    if ((++_sp & 255u) == 0u) { if (xb_ld(&(bar)[XB_TMO])) break; if (_sp > XB_SPIN_CAP) { atomicAdd(&(bar)[XB_TMO], 1u); break; } } } } while (0)
struct XcdBarrier { unsigned* bar; unsigned x; volatile LAS unsigned* st; };
__device__ __forceinline__ XcdBarrier xcd_barrier_post(unsigned* bar, volatile LAS unsigned* st) {
    XcdBarrier b; b.bar = bar; b.x = xb_xcc_id(); b.st = st;
    if (threadIdx.x == 0) (void)xb_add(&bar[XB_XCNT(b.x)], 1u);
    return b;
}
__device__ __forceinline__ void xcd_barrier_complete(unsigned* bar, unsigned x, unsigned& nloc, unsigned& nx) {
    const unsigned G = gridDim.x * gridDim.y * gridDim.z;
    unsigned sum, cnt, mine, sp = 0u;
    for (;;) {
        sum = 0u; cnt = 0u; mine = 0u;
#pragma unroll 1
        for (unsigned j = 0; j < 16; ++j) { const unsigned c = xb_ld(&bar[XB_XCNT(j)]); sum += c; cnt += (c > 0u) ? 1u : 0u; mine = (j == x) ? c : mine; }
        if (sum == G) break;
        __builtin_amdgcn_s_sleep(1);
        if ((++sp & 255u) == 0u) { if (xb_ld(&bar[XB_TMO])) break; if (sp > XB_SPIN_CAP) { atomicAdd(&bar[XB_TMO], 1u); break; } }
    }
    nloc = mine > 0u ? mine : 1u; nx = cnt > 0u ? cnt : 1u;
}
__device__ __forceinline__ void xcd_barrier(const XcdBarrier& b, const int tid) {
    asm volatile("s_waitcnt vmcnt(0)" ::: "memory");
    __syncthreads();
    if (tid == 0) {
        unsigned* bar = b.bar;
        __builtin_amdgcn_s_waitcnt(0);
        unsigned nloc = b.st[0], nx = b.st[1];
        if (nloc == 0u) { xcd_barrier_complete(bar, b.x, nloc, nx); b.st[0] = nloc; b.st[1] = nx; }
        const unsigned old = xb_add(&bar[XB_XSUB(b.x)], 1u);
        const unsigned gen = old / nloc;
        if (old + 1u == (gen + 1u) * nloc) {
            __builtin_amdgcn_fence(__ATOMIC_RELEASE, "agent");
            asm volatile("s_waitcnt vmcnt(0)" ::: "memory");
            const unsigned og = xb_add(&bar[XB_TOP], 1u);
            const unsigned tg = og / nx;
            if (og + 1u == (tg + 1u) * nx) xb_add(&bar[XB_TOPGEN], 1u);
            else XB_SPIN(xb_ld(&bar[XB_TOPGEN]) == tg, bar);
            __builtin_amdgcn_fence(__ATOMIC_ACQUIRE, "agent");
            xb_add(&bar[XB_XGEN(b.x)], 1u);
            asm volatile("s_waitcnt vmcnt(0)" ::: "memory");
        } else {
            XB_SPIN(xb_ld(&bar[XB_XGEN(b.x)]) == gen, bar);
            __builtin_amdgcn_fence(__ATOMIC_ACQUIRE, "agent");
            asm volatile("s_waitcnt vmcnt(0)" ::: "memory");
        }
    }
    __syncthreads();
}

struct Frame {
    LAS unsigned char* lds;
    volatile LAS unsigned* MISC;
    unsigned* ctl;
    int tid, lane, wave, vcu, G, bx;
    float* out; unsigned char* ws;
};
struct Args { const float* in[28]; float* out; unsigned char* ws; int ph_lo, ph_hi; };
enum { I_X = 0, I_C, I_ADAW, I_ADAB, I_N1G, I_N2G, I_WIN, I_BF, I_QNA, I_KNA, I_QNC, I_KNC, I_LQ1, I_LK1, I_LQ2, I_LK2, I_SUBLN, I_QND, I_KND, I_MIXB, I_WOUT,
       I_WG, I_BG, I_WE, I_BE, I_W1, I_W3, I_W2 };
template <int I> __device__ __forceinline__ const float* inp() {
    auto ka = __builtin_amdgcn_kernarg_segment_ptr(); unsigned long long raw;
    asm volatile("s_load_dwordx2 %0, %1, %2\n\ts_waitcnt lgkmcnt(0)" : "=s"(raw) : "s"(ka), "i"(I * 8));
    return (const float*)(const GAS float*)raw;
}


struct TItem { const float* W; bf16* WT; const float* rs; int ldw, K, dst_row0, src_n0, kb, mapin; };
__device__ __forceinline__ int colmap_in(int n) { return n < 768 ? n : (n < 2984 ? n + 4 : (n < 2988 ? n - 2984 + 768 : -1)); }
__device__ __forceinline__ void t_load(const TItem& T, f32x4 (&v)[8], int lane) {
    const int k0 = 64 * T.kb, r8 = lane >> 3, c4 = (lane & 7) * 4; const int sc = T.mapin ? colmap_in(T.src_n0 + c4) : T.src_n0 + c4;
#pragma unroll
    for (int i = 0; i < 8; ++i) { v[i] = (f32x4){0.f, 0.f, 0.f, 0.f}; if (sc >= 0) v[i] = *(const f32x4*)(T.W + (size_t)(k0 + 8 * r8 + i) * T.ldw + sc); }
}
__device__ __forceinline__ void t_store(const TItem& T, f32x4 (&v)[8], LAS float* scr, int lane) {
    (void)scr;
    const int k0 = 64 * T.kb, r8 = lane >> 3, c4 = (lane & 7) * 4;
    if (T.rs) {
#pragma unroll
        for (int i = 0; i < 8; ++i) v[i] = v[i] * T.rs[k0 + 8 * r8 + i]; }
#pragma unroll
    for (int c = 0; c < 4; ++c) { u32x4 o; o.x = pg8::cvt_pk_bf16(v[0][c], v[1][c]); o.y = pg8::cvt_pk_bf16(v[2][c], v[3][c]); o.z = pg8::cvt_pk_bf16(v[4][c], v[5][c]); o.w = pg8::cvt_pk_bf16(v[6][c], v[7][c]);
        *(GAS u32x4*)(T.WT + (size_t)(T.dst_row0 + c4 + c) * T.K + k0 + 8 * r8) = o; }
}
__device__ __forceinline__ float lambda_init(int l) { return l == 0 ? 0.2f : (0.8f - 0.6f * 0.7408182206817179f); }

constexpr int CI_IN = 16 * 96, CI_OUT = 16 * 32, CI_UP1 = 16 * 8, CI_DN = 4 * 32, CN_UP = 32 * 2 * CI_UP1, CN_DN = 32 * CI_DN, NITEMS_L = CI_IN + CI_OUT + CN_UP + CN_DN;
__device__ __forceinline__ void fill_rowscale(Frame& F, const Args& A, int l, LAS float* rsl) {
    for (int k = F.tid; k < DM; k += 512) { float v = inp<I_MIXB>()[l * DM + k];
        if (k >= 512 && k < 768) v *= inp<I_SUBLN>()[l * 64 + ((k - 512) & 63)] * (1.f - lambda_init(l)); rsl[k] = v; }
}
__device__ __forceinline__ void convert_items(Frame& F, const Args& A, int l, int first, int stride, int limit, LAS float* rsl) {
    LAS float* scr = (LAS float*)(F.lds + F.wave * 8704);
    bf16* WIN = (bf16*)(F.ws + WS_WIN); bf16* WOUT = (bf16*)(F.ws + WS_WOUT); bf16* WUP = (bf16*)(F.ws + WS_WUP); bf16* WDN = (bf16*)(F.ws + WS_WDN);
    auto decode = [&](int it, TItem& T) {
        int r = it; T.rs = nullptr; T.mapin = 0;
        if (r < CI_IN) { T.kb = r / 96; const int nb = r % 96;
            T.W = inp<I_WIN>() + (size_t)l * DM * P_IN; T.ldw = P_IN; T.K = DM; T.WT = WIN + (size_t)l * NP * DM; T.dst_row0 = 32 * nb; T.src_n0 = 32 * nb; T.mapin = 1; return; }
        r -= CI_IN;
        if (r < CI_OUT) { T.kb = r / 32; const int nb = r % 32;
            T.W = inp<I_WOUT>() + (size_t)l * DM * DM; T.ldw = DM; T.K = DM; T.WT = WOUT + (size_t)l * DM * DM; T.dst_row0 = 32 * nb; T.src_n0 = 32 * nb; T.rs = (const float*)rsl; return; }
        r -= CI_OUT;
        if (r < CN_UP) { const int le = l * 32 + r / (2 * CI_UP1), q = r % (2 * CI_UP1), which = q / CI_UP1, q2 = q % CI_UP1; T.kb = q2 / 8; const int nb = q2 % 8;
            T.W = (which == 0 ? inp<I_W1>() : inp<I_W3>()) + (size_t)le * DM * FF; T.ldw = FF; T.K = DM; T.WT = WUP + (size_t)le * 512 * DM;
            const int n0 = 32 * nb, pn = n0 >> 7, j = n0 & 127; T.dst_row0 = 256 * pn + 128 * which + j; T.src_n0 = n0; return; }
        r -= CN_UP;
        { const int le = l * 32 + r / CI_DN, q = r % CI_DN; T.kb = q / 32; const int nb = q % 32;
          T.W = inp<I_W2>() + (size_t)le * FF * DM; T.ldw = DM; T.K = FF; T.WT = WDN + (size_t)le * DM * FF; T.dst_row0 = 32 * nb; T.src_n0 = 32 * nb; }
    };
    TItem T0, T1, T2; f32x4 v0[8], v1[8], v2[8]; int it = first;
    if (it < limit) { decode(it, T0); t_load(T0, v0, F.lane); }
    if (it + stride < limit) { decode(it + stride, T1); t_load(T1, v1, F.lane); }
    while (it < limit) {
        if (it + 2 * stride < limit) { decode(it + 2 * stride, T2); t_load(T2, v2, F.lane); }
        t_store(T0, v0, scr, F.lane); it += stride; if (it >= limit) break;
        if (it + 2 * stride < limit) { decode(it + 2 * stride, T0); t_load(T0, v0, F.lane); }
        t_store(T1, v1, scr, F.lane); it += stride; if (it >= limit) break;
        if (it + 2 * stride < limit) { decode(it + 2 * stride, T1); t_load(T1, v1, F.lane); }
        t_store(T2, v2, scr, F.lane); it += stride;
    }
}
constexpr int CV_L0 = NITEMS_L - CI_IN, CV_TOTAL = CV_L0 + NITEMS_L, CV_CHUNK = 64, CW_CVQ = 192;
__device__ __forceinline__ void convert_chunk(Frame& F, const Args& A, int gbase, LAS float* rsl2  ) {
    const int g0 = gbase + F.wave * (CV_CHUNK / NWAVES);
#pragma unroll 1
    for (int l = 0; l < 2; ++l) {
        const int lo = g0 > (l ? CV_L0 : 0) ? g0 : (l ? CV_L0 : 0), hi0 = g0 + CV_CHUNK / NWAVES, hi = hi0 < (l ? CV_TOTAL : CV_L0) ? hi0 : (l ? CV_TOTAL : CV_L0);
        if (lo < hi) { const int off = l ? -CV_L0 : CI_IN; convert_items(F, A, l, lo + off, 1, hi + off, rsl2 + l * DM); }
    }
}
__device__ __forceinline__ void convert_layer1_in_gap(Frame& F, const Args& A, int n2  ) {
    LAS float* rsl = (LAS float*)(F.lds + 8 * 8704);
    if (n2 < 0) n2 = 0; if (n2 > F.G - 32) n2 = F.G - 32;
    if (F.bx < n2) return;
    fill_rowscale(F, A, 1, rsl);
    __syncthreads();
    const int nw = (F.G - n2) * NWAVES;
    convert_items(F, A, 1, (F.bx - n2) * NWAVES + F.wave, nw, NITEMS_L, rsl);
    __syncthreads();
}

__device__ __forceinline__ void p0_prologue(Frame& F, const Args& A) {
    LAS float* rsl = (LAS float*)(F.lds + 8 * 8704);
    fill_rowscale(F, A, 0, rsl);
    __syncthreads();
    const int gw = F.vcu * NWAVES + F.wave, NGW = F.G * NWAVES;
    convert_items(F, A, 0, gw, NGW, BG_CONVERT ? CI_IN : NITEMS_L, rsl);
    if (!GAP_CONVERT && !BG_CONVERT) { __syncthreads(); fill_rowscale(F, A, 1, rsl); __syncthreads(); convert_items(F, A, 1, gw, NGW, NITEMS_L, rsl); }
    { bf16* WRH = (bf16*)(F.ws + WS_WR); bf16* WRL = WRH + 2 * 48 * DM;
      for (int i = gw * 64 + F.lane; i < 2 * 48 * DM; i += NGW * 64) { const int l = i / (48 * DM), r = i % (48 * DM), o = r >> 10, k = r & 1023;
          float w = 0.f; if (o < 4) w = inp<I_WG>()[((size_t)l * DM + k) * 4 + o]; else if (o < 36) w = inp<I_WE>()[((size_t)l * DM + k) * 32 + (o - 4)];
          const unsigned hi = f2bf(w); WRH[i] = (bf16)hi; WRL[i] = (bf16)f2bf(w - bf2f((unsigned short)hi)); } }
    if (F.bx == 0 && F.wave == 0) {
        for (int l = 0; l < 2; ++l) { float a = 0.f, b = 0.f; if (F.lane < 32) { a = inp<I_LQ1>()[l * 32 + F.lane] * inp<I_LK1>()[l * 32 + F.lane]; b = inp<I_LQ2>()[l * 32 + F.lane] * inp<I_LK2>()[l * 32 + F.lane]; }
            a = wave_sum(a); b = wave_sum(b); if (F.lane == 0) ((float*)(F.ws + WS_MISC))[l] = __expf(a) - __expf(b) + lambda_init(l); }
    }
    __syncthreads();
    LAS float* cact = (LAS float*)F.lds;
    LAS float* red = (LAS float*)(F.lds + 32768);
    for (int i = F.tid; i < BATCH * DM; i += 512) { const float c = inp<I_C>()[i]; cact[i] = c / (1.f + __expf(-c)); }
    __syncthreads();
    for (int item = F.bx; item < 2 * 96; item += F.G) {
        const int l = item / 96, nb = item % 96, n = nb * 64 + F.lane; const float* aw = inp<I_ADAW>() + (size_t)l * DM * 6144 + n;
        float acc[8];
#pragma unroll
        for (int b = 0; b < 8; ++b) acc[b] = 0.f;
        const int k0 = F.wave * 128;
#pragma unroll 32
        for (int k = 0; k < 128; ++k) { const float w = aw[(size_t)(k0 + k) * 6144];
#pragma unroll
            for (int b = 0; b < 8; ++b) acc[b] += cact[b * DM + k0 + k] * w; }
#pragma unroll
        for (int b = 0; b < 8; ++b) red[(F.wave * 8 + b) * 64 + F.lane] = acc[b];
        __syncthreads();
        { const int b = F.wave; float s = inp<I_ADAB>()[l * 6144 + n];
#pragma unroll
          for (int w = 0; w < 8; ++w) s += red[(w * 8 + b) * 64 + F.lane];
          ((float*)(F.ws + WS_MOD))[((size_t)l * 8 + b) * 6144 + n] = s; }
        __syncthreads();
    }
}

__device__ __forceinline__ void build_tables(Frame& F, int l) {
    volatile LAS int* cnts = (volatile LAS int*)(F.lds + CNTS_OFF); volatile LAS int* base = (volatile LAS int*)(F.lds + BASE_OFF); volatile LAS int* tab = (volatile LAS int*)(F.lds + TAB_OFF);
    __syncthreads();
    if (F.tid < 64) {
        const int e = F.tid; int cnt = 0; if (e < 32) cnt = (int)__hip_atomic_load(F.ctl + CW_CNT + (l * 32 + e) * 16, RLX_AGENT);
        const int n = (cnt + 255) >> 8; int incl = n;
#pragma unroll
        for (int o = 1; o < 32; o <<= 1) { const int u = shup_i(incl, o, e); if (e >= o) incl += u; }
        const int t0 = incl - n;
        if (e < 32) { cnts[e] = cnt; base[e] = t0; for (int j = 0; j < n && t0 + j < MAXTILE; ++j) tab[t0 + j] = e; }
        if (e == 31) F.MISC[1] = (unsigned)(incl < MAXTILE ? incl : MAXTILE);
    }
    __syncthreads();
}
__device__ __forceinline__ void row_pass(Frame& F, const Args& A, int mode, int l) {
    const int gw = F.vcu * NWAVES + F.wave; const int lane = F.lane;
    const float* MOD = (const float*)(F.ws + WS_MOD);
    bf16* X1 = (bf16*)(F.ws + WS_X1); bf16* H = (bf16*)(F.ws + WS_H); const bf16* Y = (const bf16*)(F.ws + WS_Y);
    const int* tok_e = (const int*)(F.ws + WS_TOK); const int* tok_pos = (const int*)(F.ws + WS_TOK) + 4 * M; const float* tok_w = (const float*)(F.ws + WS_TOK) + 2 * M;
    volatile LAS int* basel = (volatile LAS int*)(F.lds + BASE_OFF);
    if (mode != 0) build_tables(F, mode == 1 ? 0 : 1);
    const int b = (gw * 8) >> 11; const int lp = (mode == 1) ? 0 : 1;
    f32x4 g2v[4], gm[4], shv[4];
#pragma unroll
    for (int j = 0; j < 4; ++j) { const int col = 256 * j + 4 * lane;
        g2v[j] = (f32x4){0.f, 0.f, 0.f, 0.f}; gm[j] = g2v[j]; shv[j] = g2v[j];
        if (mode != 0) g2v[j] = *(const f32x4*)(MOD + ((size_t)lp * 8 + b) * 6144 + 5 * DM + col);
        if (mode != 2) { const float* md = MOD + ((size_t)l * 8 + b) * 6144; gm[j] = *(const f32x4*)(inp<I_N1G>() + l * DM + col) * (*(const f32x4*)(md + DM + col) + 1.0f); shv[j] = *(const f32x4*)(md + col); } }
    for (int m0 = gw * 8; m0 < gw * 8 + 8; m0 += 4) {
        f32x4 v[4][4]; u32x2 ya[4][4], yb[4][4]; float wa[4], wb[4];
        if (mode != 0) {
            int sa[4], sb[4];
#pragma unroll
            for (int r = 0; r < 4; ++r) { const int m = m0 + r; sa[r] = 256 * basel[tok_e[m]] + tok_pos[m]; sb[r] = 256 * basel[tok_e[M + m]] + tok_pos[M + m]; wa[r] = tok_w[m]; wb[r] = tok_w[M + m]; }
#pragma unroll
            for (int r = 0; r < 4; ++r)
#pragma unroll
                for (int j = 0; j < 4; ++j) { const int col = 256 * j + 4 * lane; ya[r][j] = *(const u32x2*)(Y + (size_t)sa[r] * DM + col); yb[r][j] = *(const u32x2*)(Y + (size_t)sb[r] * DM + col); }
        }
#pragma unroll
        for (int r = 0; r < 4; ++r) { const int m = m0 + r;
            if (mode == 0) { const float* xr = inp<I_X>() + (size_t)m * DM;
#pragma unroll
                for (int j = 0; j < 4; ++j) v[r][j] = *(const f32x4*)(xr + 256 * j + 4 * lane); }
            else { const bf16* xr = X1 + (size_t)m * DM;
#pragma unroll
                for (int j = 0; j < 4; ++j) { const u32x2 q = *(const u32x2*)(xr + 256 * j + 4 * lane); v[r][j] = (f32x4){bf2f(q.x & 0xffff), bf2f(q.x >> 16), bf2f(q.y & 0xffff), bf2f(q.y >> 16)}; } } }
#pragma unroll
        for (int r = 0; r < 4; ++r) { const int m = m0 + r;
            if (mode != 0) {
#pragma unroll
                for (int j = 0; j < 4; ++j) { const u32x2 a = ya[r][j], c = yb[r][j];
                    f32x4 mo; mo[0] = wa[r] * bf2f(a.x & 0xffff) + wb[r] * bf2f(c.x & 0xffff); mo[1] = wa[r] * bf2f(a.x >> 16) + wb[r] * bf2f(c.x >> 16);
                    mo[2] = wa[r] * bf2f(a.y & 0xffff) + wb[r] * bf2f(c.y & 0xffff); mo[3] = wa[r] * bf2f(a.y >> 16) + wb[r] * bf2f(c.y >> 16);
                    v[r][j] = v[r][j] + g2v[j] * mo; }
                if (mode == 1) {
#pragma unroll
                    for (int j = 0; j < 4; ++j) { u32x2 q; q.x = pk2(v[r][j][0], v[r][j][1]); q.y = pk2(v[r][j][2], v[r][j][3]); *(u32x2*)(X1 + (size_t)m * DM + 256 * j + 4 * lane) = q; }
                } else { float* orow = F.out + (size_t)m * DM;
#pragma unroll
                    for (int j = 0; j < 4; ++j) *(f32x4*)(orow + 256 * j + 4 * lane) = v[r][j]; }
            }
            if (mode != 2) {
                float ss = 0.f;
#pragma unroll
                for (int j = 0; j < 4; ++j) ss += (v[r][j][0] * v[r][j][0] + v[r][j][1] * v[r][j][1]) + (v[r][j][2] * v[r][j][2] + v[r][j][3] * v[r][j][3]);
                const float rstd = 1.0f / sqrtf(wave_sum(ss) * (1.f / DM) + RMS_EPS);
#pragma unroll
                for (int j = 0; j < 4; ++j) { const f32x4 hv = v[r][j] * rstd * gm[j] + shv[j]; u32x2 w; w.x = pk2(hv[0], hv[1]); w.y = pk2(hv[2], hv[3]);
                    *(u32x2*)(H + (size_t)m * DM + 256 * j + 4 * lane) = w; }
            }
        }
    }
}

__device__ __forceinline__ void knorm_seg(bf16* p, int lane, int nlanes_active, int group_lanes, const float* gain, int gmask, float inv_n) {
    u32x2 raw = (u32x2){0u, 0u}; if (lane < nlanes_active) raw = *(const u32x2*)(p + 4 * lane);
    float x0 = bf2f(raw.x & 0xffff), x1 = bf2f(raw.x >> 16), x2 = bf2f(raw.y & 0xffff), x3 = bf2f(raw.y >> 16);
    float ss = (x0 * x0 + x1 * x1) + (x2 * x2 + x3 * x3);
    for (int o = 1; o < group_lanes; o <<= 1) ss += __shfl_xor(ss, o);
    const float rstd = 1.0f / sqrtf(ss * inv_n + RMS_EPS);
    const int c = (4 * lane) & gmask;
    x0 *= rstd * gain[c]; x1 *= rstd * gain[c + 1]; x2 *= rstd * gain[c + 2]; x3 *= rstd * gain[c + 3];
    if (lane < nlanes_active) { u32x2 w; w.x = pk2(x0, x1); w.y = pk2(x2, x3); *(u32x2*)(p + 4 * lane) = w; }
}
__device__ __forceinline__ unsigned sortable(float f) { const unsigned u = __builtin_bit_cast(unsigned, f); return (u & 0x80000000u) ? ~u : (u | 0x80000000u); }


__device__ __forceinline__ int wave_sum_i(int v) {
    v += __builtin_amdgcn_update_dpp(0, v, 0xB1, 0xF, 0xF, true);
    v += __builtin_amdgcn_update_dpp(0, v, 0x4E, 0xF, 0xF, true);
    v += __builtin_amdgcn_update_dpp(0, v, 0x141, 0xF, 0xF, true);
    v += __builtin_amdgcn_update_dpp(0, v, 0x140, 0xF, 0xF, true);
    return __builtin_amdgcn_readlane(v, 0) + __builtin_amdgcn_readlane(v, 16) + __builtin_amdgcn_readlane(v, 32) + __builtin_amdgcn_readlane(v, 48);
}
__device__ __forceinline__ void transpose32(unsigned (&a)[32]) {
#define TSTAGE(S, MSK) _Pragma("unroll") for (int i = 0; i < 32; ++i) if (!(i & S)) { const unsigned x = a[i], y = a[i + S]; a[i] = (x & MSK) | ((y << S) & ~MSK); a[i + S] = ((x >> S) & MSK) | (y & ~MSK); }
    TSTAGE(16, 0x0000FFFFu) TSTAGE(8, 0x00FF00FFu) TSTAGE(4, 0x0F0F0F0Fu) TSTAGE(2, 0x33333333u) TSTAGE(1, 0x55555555u)
#undef TSTAGE
}
__device__ __forceinline__ void sel_step(unsigned T, unsigned& cand, unsigned& above, int& na, int& nc, bool& done, bool& exact) {
    const unsigned ones = cand & T; const int s1 = wave_sum_i(__builtin_popcount(ones));
    if (na + s1 >= 256) { cand = ones; nc = s1; }
    else { above |= ones; na += s1; cand &= ~T; nc -= s1; }
    if (na + nc == 256) { done = true; exact = true; }
}
__device__ __forceinline__ unsigned sel_finish(unsigned cand, unsigned above, int na, bool exact, int lane) {
    if (exact) return above | cand;
    const int need = 256 - na; const int pc = __builtin_popcount(cand); int incl = pc;
#pragma unroll
    for (int o = 1; o < 64; o <<= 1) { const int t = shup_i(incl, o, lane); if (lane >= o) incl += t; }
    int take = need - (incl - pc); take = take < 0 ? 0 : (take > pc ? pc : take);
    unsigned w = cand, res = above;
    for (int k = 0; k < take; ++k) { const unsigned low = w & (0u - w); res |= low; w ^= low; }
    return res;
}

__device__ __forceinline__ void p3_prep(Frame& F, const Args& A, int l, int rep) {
    const int gw = F.vcu * NWAVES + F.wave, NGW = F.G * NWAVES;
    bf16* PROJ = (bf16*)(F.ws + WS_PROJ);
    if (!(rep > 0 && PROBE_P3_PART == 2)) { const float* ga = inp<I_KNA>() + l * 64; const float* gc = inp<I_KNC>() + l * 32; const float* gd = inp<I_KND>() + l * 64;
      const int la = F.lane; const int ca = (4 * la) & 63, cc = (4 * la) & 31;
      const f32x4 gva = *(const f32x4*)(ga + ca), gvc = *(const f32x4*)(gc + cc), gvd = *(const f32x4*)(gd + ca);
      for (int mb = gw * 8; mb < gw * 8 + 8; mb += 8) {
        u32x2 ra[8], rc[8], rd[8];
#pragma unroll
        for (int i = 0; i < 8; ++i) { bf16* row = PROJ + (size_t)(mb + i) * NP; ra[i] = *(const u32x2*)(row + C_AK + 4 * la); rc[i] = *(const u32x2*)(row + C_CK + 4 * la);
            rd[i] = (u32x2){0u, 0u}; if (la < 16) rd[i] = *(const u32x2*)(row + C_DK + 4 * la); }
#pragma unroll
        for (int i = 0; i < 8; ++i) { bf16* row = PROJ + (size_t)(mb + i) * NP;
            { float x0 = bf2f(ra[i].x & 0xffff), x1 = bf2f(ra[i].x >> 16), x2 = bf2f(ra[i].y & 0xffff), x3 = bf2f(ra[i].y >> 16); float ss = (x0 * x0 + x1 * x1) + (x2 * x2 + x3 * x3);
              ss += shx<1>(ss); ss += shx<2>(ss); ss += shx<4>(ss); ss += shx<8>(ss); const float rs = 1.0f / sqrtf(ss * (1.f / 64.f) + RMS_EPS);
              u32x2 w; w.x = pk2(x0 * rs * gva[0], x1 * rs * gva[1]); w.y = pk2(x2 * rs * gva[2], x3 * rs * gva[3]); *(u32x2*)(row + C_AK + 4 * la) = w; }
            { float x0 = bf2f(rc[i].x & 0xffff), x1 = bf2f(rc[i].x >> 16), x2 = bf2f(rc[i].y & 0xffff), x3 = bf2f(rc[i].y >> 16); float ss = (x0 * x0 + x1 * x1) + (x2 * x2 + x3 * x3);
              ss += shx<1>(ss); ss += shx<2>(ss); ss += shx<4>(ss); const float rs = 1.0f / sqrtf(ss * (1.f / 32.f) + RMS_EPS);
              u32x2 w; w.x = pk2(x0 * rs * gvc[0], x1 * rs * gvc[1]); w.y = pk2(x2 * rs * gvc[2], x3 * rs * gvc[3]); *(u32x2*)(row + C_CK + 4 * la) = w; }
            { float x0 = bf2f(rd[i].x & 0xffff), x1 = bf2f(rd[i].x >> 16), x2 = bf2f(rd[i].y & 0xffff), x3 = bf2f(rd[i].y >> 16); float ss = (x0 * x0 + x1 * x1) + (x2 * x2 + x3 * x3);
              ss += shx<1>(ss); ss += shx<2>(ss); ss += shx<4>(ss); ss += shx<8>(ss); const float rs = 1.0f / sqrtf(ss * (1.f / 64.f) + RMS_EPS);
              u32x2 w; w.x = pk2(x0 * rs * gvd[0], x1 * rs * gvd[1]); w.y = pk2(x2 * rs * gvd[2], x3 * rs * gvd[3]); if (la < 16) *(u32x2*)(row + C_DK + 4 * la) = w; }
        }
      }
    }
    if (!(rep > 0 && PROBE_P3_PART == 2)) {
        const int bh = gw >> 6, ck = gw & 63, b = bh >> 2, h = bh & 3; const float bfv = inp<I_BF>()[l * 4 + h];
        const int t = 32 * ck + (F.lane & 31);
        const float x = bf2f(PROJ[((size_t)b * SEQ + t) * NP + C_AF + h]) + bfv;
        float incl = fminf(x, 0.f) - log1pf(__expf(-fabsf(x)));
#pragma unroll
        for (int o = 1; o < 32; o <<= 1) { const float u = shup(incl, o, F.lane); if ((F.lane & 31) >= o) incl += u; }
        float* cum = (float*)(F.ws + WS_CUM);
        if (F.lane < 32) cum[(size_t)bh * SEQ + t] = incl;
        if (F.lane == 31) cum[32 * SEQ + bh * 64 + ck] = incl;
    }
    LAS float* sc = (LAS float*)F.lds;
    unsigned* MASK = (unsigned*)(F.ws + WS_MASK);
    constexpr int SCP = 2052;
    const int lane = F.lane, kq = lane >> 4, qi = lane & 15;
    __syncthreads();
    bf16x8 bq[8], wvr, akv[16];
    const auto unit_geom = [&](int i, int& b, int& t0, int& nkt) { const int u = F.bx + 256 * i; b = u >> 7; const int tqr = u & 127, tq = (i & 1) ? 127 - tqr : tqr; t0 = tq * 16; nkt = tq + 1; };
    const auto unit_load_q = [&](int i) { int b, t0, nkt; unit_geom(i, b, t0, nkt); const bf16* qrow = PROJ + (size_t)b * SEQ * NP + (size_t)(t0 + qi) * NP;
#pragma unroll
        for (int h = 0; h < 8; ++h) bq[h] = *(const bf16x8*)(qrow + C_IQ + h * 32 + 8 * kq);
        wvr = *(const bf16x8*)(qrow + C_IW); };
    const auto unit_load_k = [&](int i) { int b, t0, nkt; unit_geom(i, b, t0, nkt); const bf16* pb = PROJ + (size_t)b * SEQ * NP;
#pragma unroll
        for (int j = 0; j < 16; ++j) { const int kt = F.wave + 8 * j; akv[j] = (bf16x8){0, 0, 0, 0, 0, 0, 0, 0}; if (kt < nkt) akv[j] = *(const bf16x8*)(pb + (size_t)(kt * 16 + qi) * NP + C_IK + 8 * kq); } };
    const bool do_c = !(rep > 0 && PROBE_P3_PART == 1);
    if (do_c) unit_load_q(0);
    for (int i = 0; i < 4; ++i) {
        if (!do_c) break;
        int b, t0, nkt; unit_geom(i, b, t0, nkt);
        unit_load_k(i);
        float wq[8];
#pragma unroll
        for (int h = 0; h < 8; ++h) wq[h] = bf2f((unsigned short)wvr[h]) * (0.35355339059327373f * 0.17677669529663687f);
#pragma unroll
        for (int j = 0; j < 16; ++j) { const int kt = F.wave + 8 * j;
            if (kt < nkt) {
            f32x4 a4 = (f32x4){0.f, 0.f, 0.f, 0.f};
#pragma unroll
            for (int h = 0; h < 8; ++h) { const f32x4 s = __builtin_amdgcn_mfma_f32_16x16x32_bf16(akv[j], bq[h], (f32x4){0.f, 0.f, 0.f, 0.f}, 0, 0, 0);
#pragma unroll
                for (int r = 0; r < 4; ++r) a4[r] += wq[h] * fmaxf(s[r], 0.f); }
#pragma unroll
            for (int r = 0; r < 4; ++r) a4[r] += 0.f;
            { const int ci = kt * 4 + kq, L = ci >> 3, c = ci & 7;
              *(LAS f32x4*)(sc + qi * SCP + 4 * (L * 8 + (c ^ (L & 7)))) = a4; }
            } }
        if (i + 1 < 4) unit_load_q(i + 1);
        LDS_WAIT(); __syncthreads();
        if (rep > 0 && PROBE_P3_PART == 2) { }
        else if (t0 < 256) {
            for (int rr = 0; rr < 2; ++rr) { const int t = t0 + 2 * F.wave + rr; const int nb = t - 32 * lane + 1;
                MASK[((size_t)b * SEQ + t) * 64 + lane] = nb >= 32 ? 0xffffffffu : (nb <= 0 ? 0u : ((1u << nb) - 1u)); }
        } else {
            const int rA = 2 * F.wave, tA = t0 + rA, tB = tA + 1;
            unsigned ua[32], ub[32];
#pragma unroll
            for (int c = 0; c < 8; ++c) { const int off = 4 * (lane * 8 + (c ^ (lane & 7)));
                const f32x4 fa = *(const LAS f32x4*)(sc + rA * SCP + off), fb = *(const LAS f32x4*)(sc + (rA + 1) * SCP + off);
#pragma unroll
                for (int i = 0; i < 4; ++i) { ua[c * 4 + i] = sortable(fa[i]); ub[c * 4 + i] = sortable(fb[i]); } }
            transpose32(ua); transpose32(ub);
            unsigned candA, candB, abA = 0u, abB = 0u; int naA = 0, naB = 0, ncA = tA + 1, ncB = tB + 1; bool dA = false, dB = false, eA = false, eB = false;
            { const int nbA = tA - 32 * lane + 1, nbB = tB - 32 * lane + 1;
              candA = nbA >= 32 ? 0xffffffffu : (nbA <= 0 ? 0u : ((1u << nbA) - 1u)); candB = nbB >= 32 ? 0xffffffffu : (nbB <= 0 ? 0u : ((1u << nbB) - 1u)); }
#pragma unroll
            for (int bit = 31; bit >= 0; --bit) {
                if (!dA) sel_step(ua[bit], candA, abA, naA, ncA, dA, eA);
                if (!dB) sel_step(ub[bit], candB, abB, naB, ncB, dB, eB);
                if (dA && dB) break;
            }
            MASK[((size_t)b * SEQ + tA) * 64 + lane] = sel_finish(candA, abA, naA, eA, lane);
            MASK[((size_t)b * SEQ + tB) * 64 + lane] = sel_finish(candB, abB, naB, eB, lane);
        }
        __syncthreads();
    }
}

namespace att {
template <bool B> struct BoolC { static constexpr bool value = B; };
constexpr int SLOTB = 8192, L_K = 0, L_V = 3 * SLOTB, L_WS = 6 * SLOTB, L_OST = L_WS + 2048, L_CUM = L_OST + 8 * 8192, L_END = L_CUM + 8192;
constexpr int MROW = 66;
static_assert(L_OST + 256 * MROW * 4 <= L_END && L_END <= RING_BYTES, "attention LDS map");
constexpr float THR = 8.0f;
__device__ __forceinline__ int crow(int r, int hi) { return (r & 3) + 8 * (r >> 2) + 4 * hi; }
__device__ __forceinline__ void glds16(const void* gsrc, unsigned lds_dst) { unsigned keep;
    asm volatile("s_mov_b32 %0, m0\n\ts_mov_b32 m0, %2\n\ts_nop 0\n\tglobal_load_lds_dwordx4 %1, off\n\ts_mov_b32 m0, %0" : "=&s"(keep) : "v"(gsrc), "s"(lds_dst) : "memory"); }
#define ATT_WAIT_BAR() asm volatile("s_waitcnt vmcnt(0) lgkmcnt(0)\n\ts_barrier" ::: "memory")
__device__ __forceinline__ unsigned cvtpk_s(float lo, float hi) { typedef __bf16 bf16x2_t __attribute__((ext_vector_type(2))); f32x2 v = {lo, hi}; bf16x2_t b = __builtin_convertvector(v, bf16x2_t); return __builtin_bit_cast(unsigned, b); }
__device__ __forceinline__ float xhalf(float x, int hi) { auto rr = __builtin_amdgcn_permlane32_swap(__builtin_bit_cast(unsigned, x), __builtin_bit_cast(unsigned, x), false, false);
    return __builtin_bit_cast(float, hi ? rr[0] : rr[1]); }
template <int DA, int DB>
__device__ __forceinline__ void qkt(f32x16& p0, f32x16& p1, const LAS char* Kslot, const bf16x8* qr, const f32x16& cin, int r32, int hi) {
    const LAS char* kb = Kslot + hi * 1024 + r32 * 16;
#pragma unroll
    for (int d0 = DA; d0 < DB; ++d0) {
        const bf16x8 b0 = *(const LAS bf16x8*)(kb + d0 * 2048), b1 = *(const LAS bf16x8*)(kb + d0 * 2048 + 512);
        if (d0 == DA) { p0 = __builtin_amdgcn_mfma_f32_32x32x16_bf16(b0, qr[d0], cin, 0, 0, 0); p1 = __builtin_amdgcn_mfma_f32_32x32x16_bf16(b1, qr[d0], cin, 0, 0, 0); }
        else { p0 = __builtin_amdgcn_mfma_f32_32x32x16_bf16(b0, qr[d0], p0, 0, 0, 0); p1 = __builtin_amdgcn_mfma_f32_32x32x16_bf16(b1, qr[d0], p1, 0, 0, 0); } }
}
__device__ __forceinline__ void pv(f32x16* o, int vb, bf16x8 pa0, bf16x8 pa1, bf16x8 pa2, bf16x8 pa3) {
    s16x4 lo[2][4], hi[2][4];
#pragma unroll
    for (int d0 = 0; d0 < 2; ++d0)
#pragma unroll
        for (int ks = 0; ks < 4; ++ks) {
            asm volatile("ds_read_b64_tr_b16 %0,%1 offset:%c2" : "=&v"(lo[d0][ks]) : "v"(vb), "i"(d0 * 4096 + ks * 1024) : "memory");
            asm volatile("ds_read_b64_tr_b16 %0,%1 offset:%c2" : "=&v"(hi[d0][ks]) : "v"(vb), "i"(d0 * 4096 + ks * 1024 + 512) : "memory"); }
    asm volatile("s_waitcnt lgkmcnt(0)" ::: "memory"); __builtin_amdgcn_sched_barrier(0);
#define PK(d, k) (bf16x8){lo[d][k][0], lo[d][k][1], lo[d][k][2], lo[d][k][3], hi[d][k][0], hi[d][k][1], hi[d][k][2], hi[d][k][3]}
    o[0] = __builtin_amdgcn_mfma_f32_32x32x16_bf16(pa0, PK(0, 0), o[0], 0, 0, 0); o[1] = __builtin_amdgcn_mfma_f32_32x32x16_bf16(pa0, PK(1, 0), o[1], 0, 0, 0);
    o[0] = __builtin_amdgcn_mfma_f32_32x32x16_bf16(pa1, PK(0, 1), o[0], 0, 0, 0); o[1] = __builtin_amdgcn_mfma_f32_32x32x16_bf16(pa1, PK(1, 1), o[1], 0, 0, 0);
    o[0] = __builtin_amdgcn_mfma_f32_32x32x16_bf16(pa2, PK(0, 2), o[0], 0, 0, 0); o[1] = __builtin_amdgcn_mfma_f32_32x32x16_bf16(pa2, PK(1, 2), o[1], 0, 0, 0);
    o[0] = __builtin_amdgcn_mfma_f32_32x32x16_bf16(pa3, PK(0, 3), o[0], 0, 0, 0); o[1] = __builtin_amdgcn_mfma_f32_32x32x16_bf16(pa3, PK(1, 3), o[1], 0, 0, 0);
#undef PK
}
__device__ __forceinline__ float rowmax(const f32x16& p0, const f32x16& p1, int hi) {
    float a = fmaxf(fmaxf(p0[0], p0[1]), p1[0]), b = fmaxf(fmaxf(p0[2], p0[3]), p1[1]); a = fmaxf(fmaxf(a, p1[2]), p1[3]);
#pragma unroll
    for (int r = 4; r < 16; r += 4) { a = fmaxf(fmaxf(a, p0[r]), p0[r + 1]); b = fmaxf(fmaxf(b, p0[r + 2]), p0[r + 3]); a = fmaxf(fmaxf(a, p1[r]), p1[r + 1]); b = fmaxf(fmaxf(b, p1[r + 2]), p1[r + 3]); }
    const float m = fmaxf(a, b); return fmaxf(m, xhalf(m, hi));
}
struct AttnP { const bf16* proj; bf16* mix; const float* cum; const unsigned* mask; const float* qgain[4]; const float* kgain[4]; float lam; };

template <int VAR>
__device__ __forceinline__ void attn_unit(const AttnP& P, int b, int h, int qb, LAS char* sh, const int tid_in, const int pm, unsigned* qctr, volatile LAS unsigned* qslot) {
    int tid = tid_in; asm volatile("" : "+v"(tid));
    const int lane = tid & 63, r32 = lane & 31, hi = lane >> 5; const int wid = __builtin_amdgcn_readfirstlane(tid >> 6);
    const long rowbase = (long)b * SEQ; const int q0 = qb * 256, NT = 4 * (qb + 1);
    const int qrel = wid * 32 + r32, tq = q0 + qrel;
    constexpr bool REV = VAR != 0;
    constexpr int QCB = VAR == 0 ? C_AQ : VAR == 1 ? C_BQ : VAR == 2 ? C_CQ : C_DQ;
    constexpr int KCB = VAR == 0 ? C_AK : VAR == 1 ? C_BK : VAR == 2 ? C_CK : C_DK;
    constexpr int VCB = VAR == 0 ? C_AV : VAR == 1 ? C_BV : VAR == 2 ? C_CV : C_DV;
    const int Qc = QCB + 64 * h, Kc = VAR == 3 ? KCB : KCB + 64 * h, Vc = VAR == 3 ? VCB : VCB + 64 * h;
    const bf16* PR = P.proj;
    LAS float* wsf = (LAS float*)(sh + L_WS) + wid * 64;
    LAS float* stg = (LAS float*)(sh + L_OST) + wid * 2048;
    LAS float* cumL = (LAS float*)(sh + L_CUM);
    LAS unsigned* maskL = (LAS unsigned*)(sh + L_OST);
    const unsigned lds0 = (unsigned)(uintptr_t)sh;
    const bf16* ksrc = PR + (size_t)(rowbase + lane) * NP + Kc + wid * 8;
    const bf16* vsrc = PR + (size_t)(rowbase + 16 * (wid & 3) + (lane >> 2)) * NP + Vc + (wid >> 2) * 32 + (lane & 3) * 8;
    const unsigned kdst = lds0 + L_K + wid * 1024, vdst = lds0 + L_V + wid * 1024;
#define DMA_KV(t, slot) do { glds16(ksrc + (size_t)(t) * 64 * NP, (unsigned)__builtin_amdgcn_readfirstlane(kdst + (slot))); glds16(vsrc + (size_t)(t) * 64 * NP, (unsigned)__builtin_amdgcn_readfirstlane(vdst + (slot))); } while (0)
    DMA_KV(REV ? NT - 1 : 0, 0); DMA_KV(REV ? NT - 2 : 1, SLOTB);
    if (VAR == 0) {
        LAS float* pref = (LAS float*)(sh + L_WS);
        if (tid < 64) { const float ct = P.cum[32 * SEQ + (b * 4 + h) * 64 + tid]; float incl = ct;
#pragma unroll
            for (int o = 1; o < 64; o <<= 1) { const float u = shup(incl, o, tid); if (tid >= o) incl += u; }
            pref[tid] = incl - ct; }
        asm volatile("s_waitcnt lgkmcnt(0)\n\ts_barrier" ::: "memory");
        const float* cg = P.cum + (size_t)(b * 4 + h) * SEQ; for (int i = tid; i < q0 + 256; i += 512) cumL[i] = (cg[i] + pref[i >> 5]) * LOG2E;
        asm volatile("s_waitcnt lgkmcnt(0)\n\ts_barrier" ::: "memory");
    }
    if (VAR == 3) { const unsigned* mg = P.mask + (size_t)(rowbase + q0) * 64; const int nw = 2 * NT;
        for (int i = tid; i < 256 * 64; i += 512) { const int row = i >> 6, w = i & 63; if (w < nw) maskL[row * MROW + w] = mg[i]; } }
    asm volatile("s_waitcnt vmcnt(0) lgkmcnt(0)\n\ts_barrier" ::: "memory");
    const int vb0 = (int)(lds0 + L_V) + ((lane >> 4) & 1) * 32 + (lane & 3) * 8 + (4 * hi + ((lane & 15) >> 2)) * 64;
    float slope2 = 0.f;
    if (VAR == 2) slope2 = __builtin_amdgcn_exp2f(-(float)(2 * h + 1)) * LOG2E;
    if (VAR == 3) slope2 = __builtin_amdgcn_exp2f(-(float)(2 * h + 2)) * LOG2E;
    float cumt = 0.f; if (VAR == 0) cumt = cumL[tq];
    constexpr int NPASS = VAR == 2 ? 2 : 1;
    unsigned nxt_u = 0u;
    for (int pass = 0; pass < NPASS; ++pass) {
        bf16x8 qa[4]; float sb0 = 0.f;
        { const bf16* Qw = PR + (size_t)(rowbase + tq) * NP + Qc;
          constexpr int ND0 = VAR == 2 ? 2 : 4; const int dbase = VAR == 2 ? 2 * pass : 0;
          float qf[8 * ND0];
#pragma unroll
          for (int d0 = 0; d0 < ND0; ++d0) { const bf16x8 raw = *(const bf16x8*)(Qw + (dbase + d0) * 16 + hi * 8);
#pragma unroll
              for (int j = 0; j < 8; ++j) qf[d0 * 8 + j] = bf2f((unsigned short)raw[j]); }
          constexpr float SC = (VAR == 2 ? 0.17677669529663687f : 0.125f) * LOG2E;
          if (VAR != 1) {
              float ss = 0.f;
#pragma unroll
              for (int i = 0; i < 8 * ND0; ++i) ss += qf[i] * qf[i];
              ss += xhalf(ss, hi); const float rstd = 1.0f / sqrtf(ss * (VAR == 2 ? 1.f / 32.f : 1.f / 64.f) + RMS_EPS);
              const float* g = P.qgain[VAR];
#pragma unroll
              for (int d0 = 0; d0 < ND0; ++d0)
#pragma unroll
                  for (int j = 0; j < 8; ++j) qf[d0 * 8 + j] *= rstd * g[16 * d0 + 8 * hi + j] * SC;
          } else {
#pragma unroll
              for (int i = 0; i < 8 * ND0; ++i) qf[i] *= SC;
          }
          if (VAR == 2 || VAR == 3) {
              float n0 = 0.f;
#pragma unroll
              for (int i = 0; i < 8 * ND0; ++i) n0 += qf[i] * qf[i];
              n0 += xhalf(n0, hi);
              float gk = fabsf(P.kgain[VAR][lane & (VAR == 2 ? 31 : 63)]);
              gk = fmaxf(gk, shx<1>(gk)); gk = fmaxf(gk, shx<2>(gk)); gk = fmaxf(gk, shx<4>(gk)); gk = fmaxf(gk, shx<8>(gk)); gk = fmaxf(gk, shx<16>(gk)); gk = half_max(gk);
              sb0 = 1.02f * sqrtf(n0) * (VAR == 2 ? 5.656854249f : 8.0f) * gk;
          }
#pragma unroll
          for (int d0 = 0; d0 < ND0; ++d0) { u32x4 w; w.x = cvtpk_s(qf[d0 * 8 + 0], qf[d0 * 8 + 1]); w.y = cvtpk_s(qf[d0 * 8 + 2], qf[d0 * 8 + 3]); w.z = cvtpk_s(qf[d0 * 8 + 4], qf[d0 * 8 + 5]); w.w = cvtpk_s(qf[d0 * 8 + 6], qf[d0 * 8 + 7]);
              qa[d0] = __builtin_bit_cast(bf16x8, w); }
          if (VAR == 2) { qa[2] = qa[0]; qa[3] = qa[1]; }
        }
        float mhat = -1e30f, l_reg = 0.f, Rp = 1.f; f32x16 o[2]; const float sbound = sb0;
#pragma unroll
        for (int r = 0; r < 16; ++r) { o[0][r] = 0.f; o[1][r] = 0.f; }
        if (pass > 0) { DMA_KV(REV ? NT - 1 : 0, 0); DMA_KV(REV ? NT - 2 : 1, SLOTB); }
        int cur = 0, sl1 = SLOTB, sl2 = 2 * SLOTB;
        auto step = [&](auto band_c, const int it) -> bool {
            constexpr bool BAND = decltype(band_c)::value;
            const int t = REV ? NT - 1 - it : it;
            if (pm == 7) { }
            else if (it + 1 < NT) asm volatile("s_waitcnt vmcnt(2) lgkmcnt(0)\n\ts_barrier" ::: "memory");
            else ATT_WAIT_BAR();
            if (REV && it > 0) {
                const LAS unsigned* wz = (const LAS unsigned*)(sh + L_END) + ((it - 1) & 1) * 8;
                const u32x4 z0 = *(const LAS u32x4*)wz, z1 = *(const LAS u32x4*)(wz + 4);
                if (__builtin_amdgcn_readfirstlane((int)(z0.x & z0.y & z0.z & z0.w & z1.x & z1.y & z1.z & z1.w)) != 0) return true;
            }
            if (it + 2 < NT && pm != 7) DMA_KV(REV ? t - 2 : t + 2, sl2);
            const int jb = t - (NT - 4);
            float cinv = 0.f;
            if (VAR == 0) cinv = cumt;
            if (VAR == 2 || VAR == 3) cinv = slope2 * (float)(t * 64 + 4 * hi - tq);
            f32x16 cin;
#pragma unroll
            for (int r = 0; r < 16; ++r) cin[r] = cinv;
            f32x16 p0, p1;
            const LAS char* Ks = sh + L_K + cur;
            if (VAR == 2) { if (pass == 0) { const bf16x8 qq[4] = {qa[0], qa[1], qa[0], qa[1]}; qkt<0, 2>(p0, p1, Ks, qq, cin, r32, hi); }
                            else { const bf16x8 qq[4] = {qa[0], qa[1], qa[0], qa[1]}; qkt<2, 4>(p0, p1, Ks, qq, cin, r32, hi); } }
            else qkt<0, 4>(p0, p1, Ks, qa, cin, r32, hi);
            if (VAR != 1) {
                if (VAR == 0) { const LAS float* cp = cumL + t * 64 + 4 * hi;
#pragma unroll
                    for (int g = 0; g < 4; ++g) { const f32x4 c0 = *(const LAS f32x4*)(cp + 8 * g), c1 = *(const LAS f32x4*)(cp + 32 + 8 * g);
#pragma unroll
                        for (int i = 0; i < 4; ++i) { p0[4 * g + i] -= c0[i]; p1[4 * g + i] -= c1[i]; } } }
                if (VAR == 2 || VAR == 3) {
#pragma unroll
                    for (int r = 0; r < 16; ++r) { const float kc = (float)((r & 3) + 8 * (r >> 2)); p0[r] += slope2 * kc; p1[r] += slope2 * (kc + 32.f); } }
                if (VAR != 3) { if constexpr (BAND) { const int kb = 64 * jb + 4 * hi;
#pragma unroll
                    for (int r = 0; r < 16; ++r) { const int kv = kb + (r & 3) + 8 * (r >> 2); if (kv > qrel) p0[r] = -INFINITY; if (kv + 32 > qrel) p1[r] = -INFINITY; } } }
                else { const u32x2 mw = *(const LAS u32x2*)(maskL + qrel * MROW + 2 * t); const unsigned w0 = mw.x >> (4 * hi), w1 = mw.y >> (4 * hi);
#pragma unroll
                    for (int r = 0; r < 16; ++r) { const int c = (r & 3) + 8 * (r >> 2); if (!((w0 >> c) & 1u)) p0[r] = -INFINITY; if (!((w1 >> c) & 1u)) p1[r] = -INFINITY; } }
                const float rm = rowmax(p0, p1, hi);
                if (__any(rm - mhat > THR)) {
                    const float mn = fmaxf(mhat, rm); const float f = __builtin_amdgcn_exp2f(mhat - mn); mhat = mn; l_reg *= f;
                    if (hi == 0) wsf[r32] = f;
#pragma unroll
                    for (int r = 0; r < 16; ++r) { const float fr = wsf[crow(r, hi)]; o[0][r] *= fr; o[1][r] *= fr; }
                }
                float sa4[4] = {0.f, 0.f, 0.f, 0.f};
#pragma unroll
                for (int r = 0; r < 16; ++r) { p0[r] = __builtin_amdgcn_exp2f(p0[r] - mhat); p1[r] = __builtin_amdgcn_exp2f(p1[r] - mhat); sa4[r & 3] += p0[r] + p1[r]; }
                l_reg += (sa4[0] + sa4[1]) + (sa4[2] + sa4[3]);
                if (VAR == 2 || VAR == 3) {
                    const float ub = sbound - slope2 * (float)(tq - 64 * t + 1) - mhat;
                    const bool dead = __all(ub < -150.f); if (lane == 0) ((LAS unsigned*)(sh + L_END))[(it & 1) * 8 + wid] = dead ? 1u : 0u;
                }
            } else {
                f32x16 m0, m1;
#pragma unroll
                for (int r = 0; r < 16; ++r) {
                    { const float s = __builtin_amdgcn_fmed3f(p0[r], -64.f, 64.f); const float e = __builtin_amdgcn_exp2f(-s); const float bt = __builtin_amdgcn_rcpf(1.f + e); p0[r] = bt; m0[r] = e * bt; }
                    { const float s = __builtin_amdgcn_fmed3f(p1[r], -64.f, 64.f); const float e = __builtin_amdgcn_exp2f(-s); const float bt = __builtin_amdgcn_rcpf(1.f + e); p1[r] = bt; m1[r] = e * bt; } }
                if constexpr (BAND) { const int kb = 64 * jb + 4 * hi;
#pragma unroll
                    for (int r = 0; r < 16; ++r) { const int kv = kb + (r & 3) + 8 * (r >> 2);
                        if (kv >= qrel) { p0[r] = 0.f; m0[r] = 1.f; } if (kv + 32 >= qrel) { p1[r] = 0.f; m1[r] = 1.f; } } }
                float gp[8], gq[8], ex[8];
#pragma unroll
                for (int g = 0; g < 4; ++g) { gp[g] = (m0[4 * g] * m0[4 * g + 1]) * (m0[4 * g + 2] * m0[4 * g + 3]); gp[4 + g] = (m1[4 * g] * m1[4 * g + 1]) * (m1[4 * g + 2] * m1[4 * g + 3]); }
#pragma unroll
                for (int g = 0; g < 8; ++g) gq[g] = xhalf(gp[g], hi);
                float sp = Rp;
#pragma unroll
                for (int g = 7; g >= 0; --g) { ex[g] = hi ? sp : sp * gq[g]; sp *= gp[g] * gq[g]; }
                Rp = sp;
                { const bool allz = !__any(Rp != 0.f); if (lane == 0) ((LAS unsigned*)(sh + L_END))[(it & 1) * 8 + wid] = allz ? 1u : 0u; }
#pragma unroll
                for (int g = 0; g < 4; ++g) {
                    { float c = ex[g]; const float w3 = p0[4 * g + 3] * c; c *= m0[4 * g + 3]; const float w2 = p0[4 * g + 2] * c; c *= m0[4 * g + 2]; const float w1 = p0[4 * g + 1] * c; c *= m0[4 * g + 1]; const float w0 = p0[4 * g] * c;
                      p0[4 * g] = w0; p0[4 * g + 1] = w1; p0[4 * g + 2] = w2; p0[4 * g + 3] = w3; }
                    { float c = ex[4 + g]; const float w3 = p1[4 * g + 3] * c; c *= m1[4 * g + 3]; const float w2 = p1[4 * g + 2] * c; c *= m1[4 * g + 2]; const float w1 = p1[4 * g + 1] * c; c *= m1[4 * g + 1]; const float w0 = p1[4 * g] * c;
                      p1[4 * g] = w0; p1[4 * g + 1] = w1; p1[4 * g + 2] = w2; p1[4 * g + 3] = w3; } }
            }
            u32x4 pw0, pw1, pw2, pw3;
            pw0 = (u32x4){cvtpk_s(p0[0], p0[1]), cvtpk_s(p0[2], p0[3]), cvtpk_s(p0[4], p0[5]), cvtpk_s(p0[6], p0[7])};
            pw1 = (u32x4){cvtpk_s(p0[8], p0[9]), cvtpk_s(p0[10], p0[11]), cvtpk_s(p0[12], p0[13]), cvtpk_s(p0[14], p0[15])};
            pw2 = (u32x4){cvtpk_s(p1[0], p1[1]), cvtpk_s(p1[2], p1[3]), cvtpk_s(p1[4], p1[5]), cvtpk_s(p1[6], p1[7])};
            pw3 = (u32x4){cvtpk_s(p1[8], p1[9]), cvtpk_s(p1[10], p1[11]), cvtpk_s(p1[12], p1[13]), cvtpk_s(p1[14], p1[15])};
            pv(o, vb0 + cur, __builtin_bit_cast(bf16x8, pw0), __builtin_bit_cast(bf16x8, pw1), __builtin_bit_cast(bf16x8, pw2), __builtin_bit_cast(bf16x8, pw3));
            { const int tmp = cur; cur = sl1; sl1 = sl2; sl2 = tmp; }
            return false;
        };
        if (REV) { bool ex = false; int it = 0;
            for (; it < 4 && !ex; ++it) ex = step(BoolC<true>{}, it);
            for (; it < NT && !ex; ++it) ex = step(BoolC<false>{}, it); }
        else { int it = 0;
            for (; it < NT - 4; ++it) (void)step(BoolC<false>{}, it);
            for (; it < NT; ++it) (void)step(BoolC<true>{}, it); }
        ATT_WAIT_BAR();
        if (pass == NPASS - 1 && tid == 0) nxt_u = __hip_atomic_fetch_add(qctr, 1u, RLX_AGENT);
        float rli[16];
        if (VAR != 1) {
            l_reg += xhalf(l_reg, hi);
            if (hi == 0) wsf[32 + r32] = l_reg;
#pragma unroll
            for (int r = 0; r < 16; ++r) rli[r] = __builtin_amdgcn_rcpf(wsf[32 + crow(r, hi)]);
        } else {
#pragma unroll
            for (int r = 0; r < 16; ++r) rli[r] = 1.f;
        }
#pragma unroll
        for (int r = 0; r < 16; ++r) { const int orow = crow(r, hi);
#pragma unroll
            for (int d0 = 0; d0 < 2; ++d0) { const float val = o[d0][r] * rli[r]; LAS float* sp = stg + orow * 64 + d0 * 32 + r32;
                if (VAR == 2 && pass == 1) *sp = *sp - P.lam * val; else *sp = val; } }
    }
    LDS_WAIT();
    bf16* Ow = P.mix + (size_t)(rowbase + q0 + wid * 32) * DM + VAR * 256 + h * 64;
#pragma unroll
    for (int i = 0; i < 4; ++i) { const int row = i * 8 + (lane >> 3), ch = lane & 7;
        const f32x4 a = *(const LAS f32x4*)(stg + row * 64 + ch * 8), c = *(const LAS f32x4*)(stg + row * 64 + ch * 8 + 4);
        float sc = 1.f;
        if (VAR == 2) { float ss = (a[0] * a[0] + a[1] * a[1]) + (a[2] * a[2] + a[3] * a[3]) + (c[0] * c[0] + c[1] * c[1]) + (c[2] * c[2] + c[3] * c[3]);
            ss += shx<1>(ss); ss += shx<2>(ss); ss += shx<4>(ss); sc = 1.0f / sqrtf(ss * (1.f / 64.f) + RMS_EPS); }
        u32x4 w; w.x = cvtpk_s(a[0] * sc, a[1] * sc); w.y = cvtpk_s(a[2] * sc, a[3] * sc); w.z = cvtpk_s(c[0] * sc, c[1] * sc); w.w = cvtpk_s(c[2] * sc, c[3] * sc);
        if (pm == 0 || (w.x == 0x12345678u && w.y == 0x9abcdef0u)) *(u32x4*)(Ow + (size_t)row * DM + ch * 8) = w; }
    if (tid == 0) *qslot = nxt_u;
    asm volatile("s_waitcnt lgkmcnt(0)\n\ts_barrier" ::: "memory");
#undef DMA_KV
}
typedef __attribute__((address_space(3))) const char* lds_cptr;
typedef short v4i16_t __attribute__((ext_vector_type(4)));
__device__ __forceinline__ s16x4 vtr(lds_cptr p) { return __builtin_bit_cast(s16x4, __builtin_amdgcn_ds_read_tr16_b64_v4i16((__attribute__((address_space(3))) v4i16_t*)p)); }
template <int VAR>
__device__ __forceinline__ void attn_unit2(const AttnP& P, int b, int h, int qb, LAS char* sh, const int tid_in, unsigned* qctr, volatile LAS unsigned* qslot) {
    static_assert(VAR == 0 || VAR == 2 || VAR == 3, "softmax mixers only");
    int tid = tid_in; asm volatile("" : "+v"(tid));
    const int lane = tid & 63, r32 = lane & 31, hi = lane >> 5; const int wid = __builtin_amdgcn_readfirstlane(tid >> 6);
    const long rowbase = (long)b * SEQ; const int q0 = qb * 256, NT = 4 * (qb + 1);
    const int qrel = wid * 32 + r32, tq = q0 + qrel;
    constexpr int QCB = VAR == 0 ? C_AQ : VAR == 1 ? C_BQ : VAR == 2 ? C_CQ : C_DQ;
    constexpr int KCB = VAR == 0 ? C_AK : VAR == 1 ? C_BK : VAR == 2 ? C_CK : C_DK;
    constexpr int VCB = VAR == 0 ? C_AV : VAR == 1 ? C_BV : VAR == 2 ? C_CV : C_DV;
    const int Qc = QCB + 64 * h, Kc = VAR == 3 ? KCB : KCB + 64 * h, Vc = VAR == 3 ? VCB : VCB + 64 * h;
    const bf16* PR = P.proj;
    LAS float* wsf = (LAS float*)(sh + L_WS) + wid * 64;
    LAS float* stg = (LAS float*)(sh + L_OST) + wid * 2048;
    LAS float* cumL = (LAS float*)(sh + L_CUM);
    LAS unsigned* maskL = (LAS unsigned*)(sh + L_OST);
    const unsigned lds0 = (unsigned)(uintptr_t)sh;
    const bf16* ksrc = PR + (size_t)(rowbase + lane) * NP + Kc + wid * 8;
    const bf16* vsrc = PR + (size_t)(rowbase + 16 * (wid & 3) + (lane >> 2)) * NP + Vc + (wid >> 2) * 32 + (lane & 3) * 8;
    const unsigned kdst = lds0 + L_K + wid * 1024, vdst = lds0 + L_V + wid * 1024;
#define TILE2(j) (NT - 1 - (j))
#define DMA_K2(j, slot) glds16(ksrc + (size_t)TILE2(j) * 64 * NP, (unsigned)__builtin_amdgcn_readfirstlane(kdst + (slot)))
#define DMA_V2(j, slot) glds16(vsrc + (size_t)TILE2(j) * 64 * NP, (unsigned)__builtin_amdgcn_readfirstlane(vdst + (slot)))
    DMA_K2(0, 0); DMA_K2(1, SLOTB); DMA_V2(0, 0);
    if (VAR == 0) {
        LAS float* pref = (LAS float*)(sh + L_WS);
        if (tid < 64) { const float ct = P.cum[32 * SEQ + (b * 4 + h) * 64 + tid]; float incl = ct;
#pragma unroll
            for (int o = 1; o < 64; o <<= 1) { const float u = shup(incl, o, tid); if (tid >= o) incl += u; }
            pref[tid] = incl - ct; }
        asm volatile("s_waitcnt lgkmcnt(0)\n\ts_barrier" ::: "memory");
        const float* cg = P.cum + (size_t)(b * 4 + h) * SEQ; for (int i = tid; i < q0 + 256; i += 512) cumL[i] = (cg[i] + pref[i >> 5]) * LOG2E;
        asm volatile("s_waitcnt lgkmcnt(0)\n\ts_barrier" ::: "memory");
    }
    if (VAR == 3) { const unsigned* mg = P.mask + (size_t)(rowbase + q0) * 64; const int nw = 2 * NT;
        for (int i = tid; i < 256 * 64; i += 512) { const int row = i >> 6, w = i & 63; if (w < nw) maskL[row * MROW + w] = mg[i]; } }
    asm volatile("s_waitcnt vmcnt(0) lgkmcnt(0)\n\ts_barrier" ::: "memory");
    const lds_cptr shc = (lds_cptr)sh;
    const lds_cptr kp0 = shc + L_K + hi * 1024 + r32 * 16;
    const lds_cptr vp0 = shc + L_V + ((lane >> 4) & 1) * 32 + (lane & 3) * 8 + (4 * hi + ((lane & 15) >> 2)) * 64;
    float slope2 = 0.f;
    if (VAR == 2) slope2 = __builtin_amdgcn_exp2f(-(float)(2 * h + 1)) * LOG2E;
    if (VAR == 3) slope2 = __builtin_amdgcn_exp2f(-(float)(2 * h + 2)) * LOG2E;
    float cumt = 0.f; if (VAR == 0) cumt = cumL[tq];
    constexpr int NPASS = VAR == 2 ? 2 : 1;
    unsigned nxt_u = 0u;
    const auto slot3 = [](int j) { return (j % 3) * SLOTB; };
#define SB2() __builtin_amdgcn_sched_barrier(0)
#define PINV(x) asm volatile("" : "+v"(x))
#define MF32(a, b, c) __builtin_amdgcn_mfma_f32_32x32x16_bf16(a, b, c, 0, 0, 0)
#define ATT_BARN(N) do { asm volatile("s_waitcnt vmcnt(" #N ") lgkmcnt(0)\n\ts_barrier" ::: "memory"); SB2(); } while (0)
#define PKW(Pv, i) cvtpk_s(Pv[i], Pv[(i) + 1])
#define PAF(k) __builtin_bit_cast(bf16x8, pw##k)
#define VFR(i) (bf16x8){vlo[i][0], vlo[i][1], vlo[i][2], vlo[i][3], vhi[i][0], vhi[i][1], vhi[i][2], vhi[i][3]}
#define VRD(i) do { vlo[i] = vtr(vp_ + (((i) >> 2) * 4096 + ((i) & 3) * 1024)); vhi[i] = vtr(vp_ + (((i) >> 2) * 4096 + ((i) & 3) * 1024 + 512)); } while (0)
#define EX2(v) __builtin_amdgcn_exp2f(v)
#define GAPA(MF, Pv, i, PW, w) do { MF; sacc += Pv[i]; sacc += Pv[(i) + 1]; sacc += Pv[(i) + 2]; sacc += Pv[(i) + 3]; PINV(sacc); PW[w] = PKW(Pv, i); PW[(w) + 1] = PKW(Pv, (i) + 2); PINV(PW); SB2(); } while (0)
#define GAPA8(MF, Pv, i, PW) do { MF; sacc += Pv[i]; sacc += Pv[(i) + 1]; sacc += Pv[(i) + 2]; sacc += Pv[(i) + 3]; sacc += Pv[(i) + 4]; sacc += Pv[(i) + 5]; sacc += Pv[(i) + 6]; sacc += Pv[(i) + 7]; PINV(sacc); \
        PW[0] = PKW(Pv, i); PW[1] = PKW(Pv, (i) + 2); PW[2] = PKW(Pv, (i) + 4); PW[3] = PKW(Pv, (i) + 6); PINV(PW); SB2(); } while (0)
#define GAPB(MF, X, i) do { MF; X[i] = EX2(X[i]); X[(i) + 1] = EX2(X[(i) + 1]); X[(i) + 2] = EX2(X[(i) + 2]); X[(i) + 3] = EX2(X[(i) + 3]); PINV(X); SB2(); } while (0)
    for (int pass = 0; pass < NPASS; ++pass) {
        bf16x8 qa[4]; float sb0 = 0.f;
        { const bf16* Qw = PR + (size_t)(rowbase + tq) * NP + Qc;
          constexpr int ND0 = VAR == 2 ? 2 : 4; const int dbase = VAR == 2 ? 2 * pass : 0;
          float qf[8 * ND0];
#pragma unroll
          for (int d0 = 0; d0 < ND0; ++d0) { const bf16x8 raw = *(const bf16x8*)(Qw + (dbase + d0) * 16 + hi * 8);
#pragma unroll
              for (int j = 0; j < 8; ++j) qf[d0 * 8 + j] = bf2f((unsigned short)raw[j]); }
          constexpr float SC = (VAR == 2 ? 0.17677669529663687f : 0.125f) * LOG2E;
          if (VAR != 1) {
              float ss = 0.f;
#pragma unroll
              for (int i = 0; i < 8 * ND0; ++i) ss += qf[i] * qf[i];
              ss += xhalf(ss, hi); const float rstd = 1.0f / sqrtf(ss * (VAR == 2 ? 1.f / 32.f : 1.f / 64.f) + RMS_EPS);
              const float* g = P.qgain[VAR];
#pragma unroll
              for (int d0 = 0; d0 < ND0; ++d0)
#pragma unroll
                  for (int j = 0; j < 8; ++j) qf[d0 * 8 + j] *= rstd * g[16 * d0 + 8 * hi + j] * SC;
          } else {
#pragma unroll
              for (int i = 0; i < 8 * ND0; ++i) qf[i] *= SC;
          }
          if (VAR == 2 || VAR == 3) {
              float n0 = 0.f;
#pragma unroll
              for (int i = 0; i < 8 * ND0; ++i) n0 += qf[i] * qf[i];
              n0 += xhalf(n0, hi);
              float gk = fabsf(P.kgain[VAR][lane & (VAR == 2 ? 31 : 63)]);
              gk = fmaxf(gk, shx<1>(gk)); gk = fmaxf(gk, shx<2>(gk)); gk = fmaxf(gk, shx<4>(gk)); gk = fmaxf(gk, shx<8>(gk)); gk = fmaxf(gk, shx<16>(gk)); gk = half_max(gk);
              sb0 = 1.02f * sqrtf(n0) * (VAR == 2 ? 5.656854249f : 8.0f) * gk;
          }
#pragma unroll
          for (int d0 = 0; d0 < ND0; ++d0) { u32x4 w; w.x = cvtpk_s(qf[d0 * 8 + 0], qf[d0 * 8 + 1]); w.y = cvtpk_s(qf[d0 * 8 + 2], qf[d0 * 8 + 3]); w.z = cvtpk_s(qf[d0 * 8 + 4], qf[d0 * 8 + 5]); w.w = cvtpk_s(qf[d0 * 8 + 6], qf[d0 * 8 + 7]);
              qa[d0] = __builtin_bit_cast(bf16x8, w); }
          if (VAR == 2) { qa[2] = qa[0]; qa[3] = qa[1]; }
        }
        const float sbound = sb0;
        if (pass > 0) { DMA_K2(0, 0); DMA_K2(1, SLOTB); DMA_V2(0, 0); }
        float mhat = 0.f, l_reg = 0.f; bool hasref = false, resc = false; f32x16 o[2], negm;
#pragma unroll
        for (int r = 0; r < 16; ++r) { o[0][r] = 0.f; o[1][r] = 0.f; }
        f32x16 pA0, pA1, pB0, pB1; u32x4 pw0, pw1, pw2, pw3;
#pragma unroll
        for (int r = 0; r < 16; ++r) { pB0[r] = 0.f; pB1[r] = 0.f; }
        const auto setneg = [&](int t) __attribute__((always_inline)) { float v = -mhat; if (VAR == 0) v += cumt; else v += slope2 * (float)(t * 64 + 4 * hi - tq);
#pragma unroll
            for (int r = 0; r < 16; ++r) negm[r] = v;
            PINV(negm); };
        const auto mid = [&](f32x16& C0, f32x16& C1, const int it) __attribute__((always_inline)) {
            const int t = NT - 1 - it;
            if (VAR == 0) { const LAS float* cp = cumL + t * 64 + 4 * hi;
#pragma unroll
                for (int g = 0; g < 4; ++g) { const f32x4 c0 = *(const LAS f32x4*)(cp + 8 * g), c1 = *(const LAS f32x4*)(cp + 32 + 8 * g);
#pragma unroll
                    for (int i = 0; i < 4; ++i) { C0[4 * g + i] -= c0[i]; C1[4 * g + i] -= c1[i]; } } }
            else {
#pragma unroll
                for (int r = 0; r < 16; ++r) { const float kc = (float)((r & 3) + 8 * (r >> 2)); C0[r] += slope2 * kc; C1[r] += slope2 * (kc + 32.f); } }
            if (VAR != 3) { if (it < 4) { asm volatile("" ::: "memory");
                const int kb = 64 * (3 - it) + 4 * hi;
#pragma unroll
                for (int r = 0; r < 16; ++r) { const int kv = kb + (r & 3) + 8 * (r >> 2); if (kv > qrel) C0[r] = -INFINITY; if (kv + 32 > qrel) C1[r] = -INFINITY; } } }
            else { const u32x2 mw = *(const LAS u32x2*)(maskL + qrel * MROW + 2 * t); const unsigned w0 = mw.x >> (4 * hi), w1 = mw.y >> (4 * hi);
#pragma unroll
                for (int r = 0; r < 16; ++r) { const int c = (r & 3) + 8 * (r >> 2); if (!((w0 >> c) & 1u)) C0[r] = -INFINITY; if (!((w1 >> c) & 1u)) C1[r] = -INFINITY; } }
            const float rm = rowmax(C0, C1, hi);
            const bool need = hasref ? (rm > THR) : (rm > -INFINITY);
            resc = false;
            if (__any(need)) {
                const bool fin = rm > -INFINITY;
                const float dl = hasref ? fmaxf(rm, 0.f) : (fin ? rm : 0.f);
                const float f = hasref ? EX2(-dl) : 1.f;
                mhat += dl; l_reg *= f;
#pragma unroll
                for (int r = 0; r < 16; ++r) { C0[r] -= dl; C1[r] -= dl; }
                if (hi == 0) wsf[r32] = f;
                resc = true; hasref = hasref || fin;
            }
            if (VAR != 0) {
                const bool dead = hasref && (sbound - slope2 * (float)(tq - 64 * t + 1) - mhat < -150.f);
                const bool alld = __all(dead); if (lane == 0) ((LAS unsigned*)(sh + L_END))[(it & 1) * 8 + wid] = alld ? 1u : 0u;
            }
        };
#define KLD(dst0, dst1, d0) do { dst0 = *(const LAS bf16x8*)(kp_ + (d0) * 2048); dst1 = *(const LAS bf16x8*)(kp_ + (d0) * 2048 + 512); } while (0)
#define VLD(lo, hi_, i) do { lo = vtr(vp_ + (((i) >> 2) * 4096 + ((i) & 3) * 1024)); hi_ = vtr(vp_ + (((i) >> 2) * 4096 + ((i) & 3) * 1024 + 512)); } while (0)
#define VF(lo, hi_) (bf16x8){lo[0], lo[1], lo[2], lo[3], hi_[0], hi_[1], hi_[2], hi_[3]}
        const auto step = [&](f32x16& C0, f32x16& C1, f32x16& P0, f32x16& P1, const int it) __attribute__((always_inline)) -> bool {
            if (it + 1 < NT) ATT_BARN(2); else ATT_BARN(1);
            if (VAR != 0 && it >= 1) { const LAS unsigned* wz = (const LAS unsigned*)(sh + L_END) + ((it - 1) & 1) * 8;
                const u32x4 z0 = *(const LAS u32x4*)wz, z1 = *(const LAS u32x4*)(wz + 4);
                if (__builtin_amdgcn_readfirstlane((int)(z0.x & z0.y & z0.z & z0.w & z1.x & z1.y & z1.z & z1.w)) != 0) return true; }
            if (it + 2 < NT) DMA_K2(it + 2, slot3(it + 2));
            if (it + 1 < NT) DMA_V2(it + 1, slot3(it + 1));
            setneg(NT - 1 - it);
            int ko_ = slot3(it), vo_ = slot3(it + 2);
            asm volatile("" : "+s"(ko_), "+s"(vo_));
            const lds_cptr kp_ = kp0 + ko_; const lds_cptr vp_ = vp0 + vo_;
            bf16x8 ka0, ka1, kb0, kb1; s16x4 va0, va1, vb0, vb1;
            float sacc = 0.f;
            if (VAR == 2) {
                KLD(ka0, ka1, 2 * pass); KLD(kb0, kb1, 2 * pass + 1); SB2();
                GAPA8(C0 = MF32(ka0, qa[0], negm), P0, 0, pw0);
                GAPA8(C1 = MF32(ka1, qa[0], negm), P0, 8, pw1);
                GAPA8(C0 = MF32(kb0, qa[1], C0), P1, 0, pw2);
                GAPA8(C1 = MF32(kb1, qa[1], C1), P1, 8, pw3);
            } else {
                KLD(ka0, ka1, 0); KLD(kb0, kb1, 1); SB2();
                GAPA(C0 = MF32(ka0, qa[0], negm), P0, 0, pw0, 0);
                GAPA(C1 = MF32(ka1, qa[0], negm), P0, 4, pw0, 2);
                KLD(ka0, ka1, 2); SB2();
                GAPA(C0 = MF32(kb0, qa[1], C0), P0, 8, pw1, 0);
                GAPA(C1 = MF32(kb1, qa[1], C1), P0, 12, pw1, 2);
                KLD(kb0, kb1, 3); SB2();
                GAPA(C0 = MF32(ka0, qa[2], C0), P1, 0, pw2, 0);
                GAPA(C1 = MF32(ka1, qa[2], C1), P1, 4, pw2, 2);
                GAPA(C0 = MF32(kb0, qa[3], C0), P1, 8, pw3, 0);
                GAPA(C1 = MF32(kb1, qa[3], C1), P1, 12, pw3, 2);
            }
            l_reg += sacc;
            mid(C0, C1, it);
            SB2();
            if (it > 0) {
                VLD(va0, va1, 0); VLD(vb0, vb1, 4); SB2();
                GAPB(o[0] = MF32(PAF(0), VF(va0, va1), o[0]), C0, 0);  VLD(va0, va1, 1); SB2();
                GAPB(o[1] = MF32(PAF(0), VF(vb0, vb1), o[1]), C0, 4);  VLD(vb0, vb1, 5); SB2();
                GAPB(o[0] = MF32(PAF(1), VF(va0, va1), o[0]), C0, 8);  VLD(va0, va1, 2); SB2();
                GAPB(o[1] = MF32(PAF(1), VF(vb0, vb1), o[1]), C0, 12); VLD(vb0, vb1, 6); SB2();
                GAPB(o[0] = MF32(PAF(2), VF(va0, va1), o[0]), C1, 0);  VLD(va0, va1, 3); SB2();
                GAPB(o[1] = MF32(PAF(2), VF(vb0, vb1), o[1]), C1, 4);  VLD(vb0, vb1, 7); SB2();
                GAPB(o[0] = MF32(PAF(3), VF(va0, va1), o[0]), C1, 8);
                GAPB(o[1] = MF32(PAF(3), VF(vb0, vb1), o[1]), C1, 12);
                if (resc) {
#pragma unroll
                    for (int r = 0; r < 16; ++r) { const float fr = wsf[crow(r, hi)]; o[0][r] *= fr; o[1][r] *= fr; } }
            } else {
#pragma unroll
                for (int r = 0; r < 16; ++r) { C0[r] = EX2(C0[r]); C1[r] = EX2(C1[r]); }
            }
            return false;
        };
        bool ex = false, pendA = true; int it = 0;
        for (; it < NT; it += 2) {
            ex = step(pA0, pA1, pB0, pB1, it); if (ex) { pendA = false; break; }
            ex = step(pB0, pB1, pA0, pA1, it + 1); if (ex) { pendA = true; ++it; break; }
        }
        if (!ex) pendA = false;
        if (!ex) ATT_BARN(0);
        { int vo_ = slot3(it + 2); asm volatile("" : "+s"(vo_)); const lds_cptr vp_ = vp0 + vo_; s16x4 vlo[8], vhi[8];
#pragma unroll
          for (int i = 0; i < 8; ++i) VRD(i);
          float sacc = 0.f;
          if (pendA) {
#pragma unroll
              for (int r = 0; r < 16; ++r) sacc += pA0[r] + pA1[r];
              pw0 = (u32x4){PKW(pA0, 0), PKW(pA0, 2), PKW(pA0, 4), PKW(pA0, 6)}; pw1 = (u32x4){PKW(pA0, 8), PKW(pA0, 10), PKW(pA0, 12), PKW(pA0, 14)};
              pw2 = (u32x4){PKW(pA1, 0), PKW(pA1, 2), PKW(pA1, 4), PKW(pA1, 6)}; pw3 = (u32x4){PKW(pA1, 8), PKW(pA1, 10), PKW(pA1, 12), PKW(pA1, 14)};
          } else {
#pragma unroll
              for (int r = 0; r < 16; ++r) sacc += pB0[r] + pB1[r];
              pw0 = (u32x4){PKW(pB0, 0), PKW(pB0, 2), PKW(pB0, 4), PKW(pB0, 6)}; pw1 = (u32x4){PKW(pB0, 8), PKW(pB0, 10), PKW(pB0, 12), PKW(pB0, 14)};
              pw2 = (u32x4){PKW(pB1, 0), PKW(pB1, 2), PKW(pB1, 4), PKW(pB1, 6)}; pw3 = (u32x4){PKW(pB1, 8), PKW(pB1, 10), PKW(pB1, 12), PKW(pB1, 14)};
          }
          l_reg += sacc;
          o[0] = MF32(PAF(0), VFR(0), o[0]); o[1] = MF32(PAF(0), VFR(4), o[1]); o[0] = MF32(PAF(1), VFR(1), o[0]); o[1] = MF32(PAF(1), VFR(5), o[1]);
          o[0] = MF32(PAF(2), VFR(2), o[0]); o[1] = MF32(PAF(2), VFR(6), o[1]); o[0] = MF32(PAF(3), VFR(3), o[0]); o[1] = MF32(PAF(3), VFR(7), o[1]); }
        ATT_WAIT_BAR();
        if (pass == NPASS - 1 && tid == 0) nxt_u = __hip_atomic_fetch_add(qctr, 1u, RLX_AGENT);
        int lane_e = lane; asm volatile("" : "+v"(lane_e)); const int r32e = lane_e & 31, hie = lane_e >> 5;
        LAS float* wsfe = (LAS float*)(sh + L_WS) + wid * 64; LAS float* stge = (LAS float*)(sh + L_OST) + wid * 2048;
        float rli[16];
        l_reg += xhalf(l_reg, hie);
        if (hie == 0) wsfe[32 + r32e] = l_reg;
#pragma unroll
        for (int r = 0; r < 16; ++r) rli[r] = __builtin_amdgcn_rcpf(wsfe[32 + crow(r, hie)]);
#pragma unroll
        for (int r = 0; r < 16; ++r) { const int orow = crow(r, hie);
#pragma unroll
            for (int d0 = 0; d0 < 2; ++d0) { const float val = o[d0][r] * rli[r]; LAS float* sp = stge + orow * 64 + d0 * 32 + r32e;
                if (VAR == 2 && pass == 1) *sp = *sp - P.lam * val; else *sp = val; } }
    }
    LDS_WAIT();
    int lane_o = tid & 63; asm volatile("" : "+v"(lane_o));
    bf16* Ow = P.mix + (size_t)(rowbase + q0 + wid * 32) * DM + VAR * 256 + h * 64;
    { const int lane = lane_o; LAS float* stg = (LAS float*)(sh + L_OST) + wid * 2048;
#pragma unroll
    for (int i = 0; i < 4; ++i) { const int row = i * 8 + (lane >> 3), ch = lane & 7;
        const f32x4 a = *(const LAS f32x4*)(stg + row * 64 + ch * 8), c = *(const LAS f32x4*)(stg + row * 64 + ch * 8 + 4);
        float sc = 1.f;
        if (VAR == 2) { float ss = (a[0] * a[0] + a[1] * a[1]) + (a[2] * a[2] + a[3] * a[3]) + (c[0] * c[0] + c[1] * c[1]) + (c[2] * c[2] + c[3] * c[3]);
            ss += shx<1>(ss); ss += shx<2>(ss); ss += shx<4>(ss); sc = 1.0f / sqrtf(ss * (1.f / 64.f) + RMS_EPS); }
        u32x4 w; w.x = cvtpk_s(a[0] * sc, a[1] * sc); w.y = cvtpk_s(a[2] * sc, a[3] * sc); w.z = cvtpk_s(c[0] * sc, c[1] * sc); w.w = cvtpk_s(c[2] * sc, c[3] * sc);
        *(u32x4*)(Ow + (size_t)row * DM + ch * 8) = w; } }
    if (tid == 0) *qslot = nxt_u;
    asm volatile("s_waitcnt lgkmcnt(0)\n\ts_barrier" ::: "memory");
#undef DMA_K2
#undef DMA_V2
#undef TILE2
}
#undef SB2
#undef PINV
#undef MF32
#undef ATT_BARN
#undef PKW
#undef PAF
#undef VFR
#undef VRD
#undef EX2
#undef GAPA
#undef GAPA8
#undef GAPB
#undef KLD
#undef VLD
#undef VF
}

__device__ __forceinline__ void p4_attention(Frame& F, const Args& A, int l, int qsel) {
    att::AttnP P; P.proj = (const bf16*)(F.ws + WS_PROJ); P.mix = (bf16*)(F.ws + WS_MIX); P.cum = (const float*)(F.ws + WS_CUM); P.mask = (const unsigned*)(F.ws + WS_MASK);
    P.qgain[0] = inp<I_QNA>() + l * 64; P.qgain[1] = nullptr; P.qgain[2] = inp<I_QNC>() + l * 32; P.qgain[3] = inp<I_QND>() + l * 64; P.kgain[0] = nullptr; P.kgain[1] = nullptr; P.kgain[2] = inp<I_KNC>() + l * 32; P.kgain[3] = inp<I_KND>() + l * 64; P.lam = ((const float*)(F.ws + WS_MISC))[l];
    LAS char* sh = (LAS char*)F.lds;
    LAS float* rsl2 = (LAS float*)(F.lds + 126976);
    bool cv = BG_CONVERT && (qsel == 0);
    if (cv) { fill_rowscale(F, A, 0, rsl2); fill_rowscale(F, A, 1, rsl2 + DM); }
    if (F.tid == 0) F.MISC[0] = (unsigned)(F.bx - F.G);
    __syncthreads();
    for (;;) {
        const int u = (int)F.MISC[0] + F.G;
        if (u >= 1024) break;
        const int qb = 7 - (u >> 7), r = u & 127, var = r >> 5, bh = r & 31, b = bh >> 2, h = bh & 3;
        const int tv = var == 0 ? 2 : var == 1 ? 1 : var == 2 ? 3 : 0;
        if (qsel >= 2 && PROBE_ATT_VAR >= 0 && tv != PROBE_ATT_VAR) { __syncthreads(); if (F.tid == 0) F.MISC[0] = __hip_atomic_fetch_add(F.ctl + CW_AQ + 64 * qsel, 1u, RLX_AGENT); __syncthreads(); continue; }
#ifdef ONLY_VAR2
        att::attn_unit2<ONLY_VAR2>(P, b, h, qb, sh, F.tid, F.ctl + CW_AQ + 64 * qsel, F.MISC);
#else
        if (tv == 2) att::attn_unit<2>(P, b, h, qb, sh, F.tid, qsel >= 2 ? PROBE_ATT_MODE : 0, F.ctl + CW_AQ + 64 * qsel, F.MISC);
        else if (tv == 1) att::attn_unit<1>(P, b, h, qb, sh, F.tid, qsel >= 2 ? PROBE_ATT_MODE : 0, F.ctl + CW_AQ + 64 * qsel, F.MISC);
        else if (tv == 3) att::attn_unit<3>(P, b, h, qb, sh, F.tid, qsel >= 2 ? PROBE_ATT_MODE : 0, F.ctl + CW_AQ + 64 * qsel, F.MISC);
        else att::attn_unit2<0>(P, b, h, qb, sh, F.tid, F.ctl + CW_AQ + 64 * qsel, F.MISC);
#endif
        if (cv) {
            if (F.tid == 0) F.MISC[3] = __hip_atomic_fetch_add(F.ctl + CW_CVQ, (unsigned)CV_CHUNK, RLX_AGENT);
            __syncthreads();
            const int gb = (int)F.MISC[3];
            if (gb >= CV_TOTAL) cv = false; else convert_chunk(F, A, gb, rsl2);
            __syncthreads();
        }
    }
    while (cv) {
        __syncthreads();
        if (F.tid == 0) F.MISC[3] = __hip_atomic_fetch_add(F.ctl + CW_CVQ, (unsigned)CV_CHUNK, RLX_AGENT);
        __syncthreads();
        const int gb = (int)F.MISC[3];
        if (gb >= CV_TOTAL) cv = false; else convert_chunk(F, A, gb, rsl2);
    }
    __syncthreads();
}

template <int N, int Dd> __device__ __forceinline__ void bfly(float (&p)[32], int lane) { const bool up = (lane & Dd) != 0;
#pragma unroll
    for (int j = 0; j < N / 2; ++j) { const float a = p[2 * j], bb = p[2 * j + 1]; const float send = up ? a : bb, keep = up ? bb : a; p[j] = keep + __shfl_xor(send, Dd); } }
__device__ __forceinline__ void p6_router(Frame& F, const Args& A, int l, int rep) {
    const float* MOD = (const float*)(F.ws + WS_MOD); const bf16* X1 = (const bf16*)(F.ws + WS_X1); bf16* H = (bf16*)(F.ws + WS_H);
    const bf16* WRH = (const bf16*)(F.ws + WS_WR) + (size_t)l * 48 * DM; const bf16* WRL = WRH + 2 * 48 * DM;
    int* tok_e = (int*)(F.ws + WS_TOK); float* tok_w = (float*)(F.ws + WS_TOK) + 2 * M; int* tok_pos = (int*)(F.ws + WS_TOK) + 4 * M;
    constexpr int AP = 528;
    LAS unsigned char* Ahi = F.lds; LAS unsigned char* Alo = F.lds + 64 * AP; LAS unsigned char* Bhi = F.lds + 128 * AP; LAS unsigned char* Blo = F.lds + 176 * AP;
    LAS float* PL = (LAS float*)F.lds;
    const int lane = F.lane, w = F.wave; const int mw = (F.vcu * NWAVES + w) * 8; const int b = mw >> 11;
    const float* md = MOD + ((size_t)l * 8 + b) * 6144;
    f32x4 hv[8][4];
#pragma unroll
    for (int r = 0; r < 8; ++r) {
        const bf16* xr = X1 + (size_t)(mw + r) * DM;
#pragma unroll
        for (int j = 0; j < 4; ++j) { const u32x2 q = *(const u32x2*)(xr + 256 * j + 4 * lane); hv[r][j] = (f32x4){bf2f(q.x & 0xffff), bf2f(q.x >> 16), bf2f(q.y & 0xffff), bf2f(q.y >> 16)}; }
    }
    { f32x4 gm[4], sc[4], sh[4]; const float* n2 = inp<I_N2G>() + l * DM;
#pragma unroll
      for (int j = 0; j < 4; ++j) { const int col = 256 * j + 4 * lane; gm[j] = *(const f32x4*)(n2 + col); sc[j] = *(const f32x4*)(md + 4 * DM + col); sh[j] = *(const f32x4*)(md + 3 * DM + col); gm[j] = gm[j] * (sc[j] + 1.0f); }
#pragma unroll
      for (int r = 0; r < 8; ++r) { float ss = 0.f;
#pragma unroll
        for (int j = 0; j < 4; ++j) ss += (hv[r][j][0] * hv[r][j][0] + hv[r][j][1] * hv[r][j][1]) + (hv[r][j][2] * hv[r][j][2] + hv[r][j][3] * hv[r][j][3]);
        const float rstd = 1.0f / sqrtf(wave_sum(ss) * (1.f / DM) + RMS_EPS);
#pragma unroll
        for (int j = 0; j < 4; ++j) { hv[r][j] = hv[r][j] * rstd * gm[j] + sh[j]; u32x2 pk; pk.x = pk2(hv[r][j][0], hv[r][j][1]); pk.y = pk2(hv[r][j][2], hv[r][j][3]);
            *(u32x2*)(H + (size_t)(mw + r) * DM + 256 * j + 4 * lane) = pk; } } }
    const int rt = w & 3, kh = w >> 2, arow = lane & 15, kg = lane >> 4;
    f32x4 acc[3];
#pragma unroll
    for (int c = 0; c < 3; ++c) acc[c] = (f32x4){0.f, 0.f, 0.f, 0.f};
#pragma unroll
    for (int j = 0; j < 4; ++j) {
        __syncthreads();
#pragma unroll
        for (int r = 0; r < 8; ++r) { const f32x4 x = hv[r][j]; unsigned h0 = f2bf(x[0]), h1 = f2bf(x[1]), h2 = f2bf(x[2]), h3 = f2bf(x[3]);
            u32x2 hi; hi.x = h0 | (h1 << 16); hi.y = h2 | (h3 << 16);
            u32x2 lo; lo.x = pk2(x[0] - bf2f((unsigned short)h0), x[1] - bf2f((unsigned short)h1)); lo.y = pk2(x[2] - bf2f((unsigned short)h2), x[3] - bf2f((unsigned short)h3));
            *(LAS u32x2*)(Ahi + (w * 8 + r) * AP + lane * 8) = hi; *(LAS u32x2*)(Alo + (w * 8 + r) * AP + lane * 8) = lo; }
        for (int i = F.tid; i < 48 * 32; i += 512) { const int o = i >> 5, c16 = i & 31;
            *(LAS u32x4*)(Bhi + o * AP + c16 * 16) = *(const u32x4*)(WRH + (size_t)o * DM + 256 * j + 8 * c16);
            *(LAS u32x4*)(Blo + o * AP + c16 * 16) = *(const u32x4*)(WRL + (size_t)o * DM + 256 * j + 8 * c16); }
        LDS_WAIT(); __syncthreads();
#pragma unroll
        for (int ks = 0; ks < 4; ++ks) { const int kb = ((4 * kh + ks) * 32 + 8 * kg) * 2;
            const bf16x8 ah = *(const LAS bf16x8*)(Ahi + (16 * rt + arow) * AP + kb), al = *(const LAS bf16x8*)(Alo + (16 * rt + arow) * AP + kb);
#pragma unroll
            for (int c = 0; c < 3; ++c) { const bf16x8 bh = *(const LAS bf16x8*)(Bhi + (16 * c + arow) * AP + kb), bl = *(const LAS bf16x8*)(Blo + (16 * c + arow) * AP + kb);
                acc[c] = __builtin_amdgcn_mfma_f32_16x16x32_bf16(ah, bh, acc[c], 0, 0, 0);
                acc[c] = __builtin_amdgcn_mfma_f32_16x16x32_bf16(al, bh, acc[c], 0, 0, 0);
                acc[c] = __builtin_amdgcn_mfma_f32_16x16x32_bf16(ah, bl, acc[c], 0, 0, 0); } }
    }
    __syncthreads();
#pragma unroll
    for (int c = 0; c < 3; ++c)
#pragma unroll
        for (int r = 0; r < 4; ++r) PL[(kh * 64 + 16 * rt + kg * 4 + r) * 48 + 16 * c + arow] = acc[c][r];
    LDS_WAIT(); __syncthreads();
    if (F.tid < 64 && rep == 0) {
        const int m = F.vcu * 64 + F.tid; const LAS float* q0 = PL + F.tid * 48; const LAS float* q1 = PL + (64 + F.tid) * 48;
        float gl[4]; int gi = 0; float gm;
#pragma unroll
        for (int g = 0; g < 4; ++g) gl[g] = (q0[g] + q1[g]) + inp<I_BG>()[l * 4 + g];
        gm = gl[0];
#pragma unroll
        for (int g = 1; g < 4; ++g) if (gl[g] > gm) { gm = gl[g]; gi = g; }
        float den = 0.f;
#pragma unroll
        for (int g = 0; g < 4; ++g) den += __expf(gl[g] - gm);
        const float gprob = 1.0f / den;
        float v1 = -INFINITY, v2 = -INFINITY; int i1 = 0, i2 = 0;
        for (int e = 0; e < 8; ++e) { const float v = (q0[4 + gi * 8 + e] + q1[4 + gi * 8 + e]) + inp<I_BE>()[l * 32 + gi * 8 + e];
            if (v > v1) { v2 = v1; i2 = i1; v1 = v; i1 = e; } else if (v > v2) { v2 = v; i2 = e; } }
        const float e2 = __expf(v2 - v1); const float w1 = gprob / (1.f + e2), w2 = gprob * e2 / (1.f + e2);
        const int ea = gi * 8 + i1, eb = gi * 8 + i2;
        tok_e[m] = ea; tok_e[M + m] = eb; tok_w[m] = w1; tok_w[M + m] = w2;
        LAS unsigned* lcnt = (LAS unsigned*)(F.lds + 32768); LAS unsigned* lbase = lcnt + 32;
        if (F.tid < 32) lcnt[F.tid] = 0u;
        asm volatile("s_waitcnt lgkmcnt(0)" ::: "memory");
        const unsigned ra = __hip_atomic_fetch_add(lcnt + ea, 1u, __ATOMIC_RELAXED, __HIP_MEMORY_SCOPE_WORKGROUP), rb = __hip_atomic_fetch_add(lcnt + eb, 1u, __ATOMIC_RELAXED, __HIP_MEMORY_SCOPE_WORKGROUP);
        asm volatile("s_waitcnt lgkmcnt(0)" ::: "memory");
        if (F.tid < 32) { const unsigned n = *(volatile LAS unsigned*)(lcnt + F.tid); unsigned bs = 0u; if (n) bs = __hip_atomic_fetch_add(F.ctl + CW_CNT + (l * 32 + F.tid) * 16, n, RLX_AGENT); *(volatile LAS unsigned*)(lbase + F.tid) = bs; }
        asm volatile("s_waitcnt vmcnt(0) lgkmcnt(0)" ::: "memory");
        const int pa = (int)(*(volatile LAS unsigned*)(lbase + ea) + ra), pb = (int)(*(volatile LAS unsigned*)(lbase + eb) + rb);
        tok_pos[m] = pa; tok_pos[M + m] = pb;
        int* elist = (int*)(F.ws + WS_ELIST); elist[ea * M + pa] = m; elist[eb * M + pb] = m;
    }
}

__device__ __forceinline__ void build_rowlists(Frame& F, int l) {
    volatile LAS int* base = (volatile LAS int*)(F.lds + BASE_OFF); volatile LAS int* cnts = (volatile LAS int*)(F.lds + CNTS_OFF); volatile LAS int* tab = (volatile LAS int*)(F.lds + TAB_OFF);
    LAS int* rowl = (LAS int*)(F.lds + ROWL_OFF); const int* elist = (const int*)(F.ws + WS_ELIST);
    const int ntile = (int)F.MISC[1];
    const int i = F.tid >> 8, r = F.tid & 255; const long L = (long)i * F.G + F.bx;
    int tok = 0;
    if (L < 2L * ntile) { const int tile = (int)(L >> 1), e = tab[tile], pos = 256 * (tile - base[e]) + r; if (pos < cnts[e]) tok = elist[e * M + pos]; }
    rowl[F.tid] = tok;
    __syncthreads();
}

constexpr int NPL = 7, NPH = 2 + 2 * NPL;
__global__ void __launch_bounds__(NWAVES * 64, 2) mk_fwd(Args args) {
    extern __shared__ __attribute__((aligned(16))) unsigned char lds[];
    Frame F;
    F.lds = (LAS unsigned char*)lds;
    F.MISC = (volatile LAS unsigned*)(F.lds + MISC_OFF);
    F.tid = threadIdx.x; F.lane = F.tid & 63; F.wave = __builtin_amdgcn_readfirstlane(F.tid >> 6);
    const int wave0 = F.wave;
    F.G = gridDim.x; F.bx = blockIdx.x; F.vcu = 0;
    F.ws = args.ws; F.out = args.out; F.ctl = (unsigned*)(args.ws + WS_CTL);
    for (int u = F.tid; u < (LDS_BYTES - LDSCTL_OFF) / 4; u += NWAVES * 64) ((LAS unsigned*)(F.lds + LDSCTL_OFF))[u] = 0u;
    __syncthreads();
    XcdBarrier bar; bar.bar = F.ctl + CW_BAR; bar.x = 0; bar.st = nullptr;
    if (!MK_PER_PHASE) bar = xcd_barrier_post(F.ctl + CW_BAR, F.MISC + 8);
    const int lo = args.ph_lo, hi = args.ph_hi;
#pragma unroll 1
    for (int ph = lo; ph < hi; ++ph) {
#if PROBE_REP_K >= 0
        const int ptype = ph == 0 ? 0 : (ph == NPH - 1 ? 10 : 1 + (ph - 1) % NPL);
        const int nrep = (ptype == PROBE_REP_K && (ph <= NPL || (PROBE_REP_K != 1 && PROBE_REP_K != 5))) ? 1 : 0;
#pragma unroll 1
        for (int rep = 0; rep <= nrep; ++rep) {
#else
        constexpr int rep = 0;
#endif
        { int w_ = wave0; asm volatile("" : "+s"(w_)); unsigned on_ = ~0u; asm volatile("" : "+s"(on_)); int ln_ = (int)__builtin_amdgcn_mbcnt_hi(on_, __builtin_amdgcn_mbcnt_lo(on_, 0u)); asm volatile("" : "+v"(ln_));
          F.wave = w_; F.lane = ln_; F.tid = w_ * 64 + ln_;
          unsigned long long ws_ = (unsigned long long)args.ws; asm volatile("" : "+s"(ws_)); F.ws = (unsigned char*)(GAS unsigned char*)ws_; F.ctl = (unsigned*)(F.ws + WS_CTL);
          int bx_ = blockIdx.x; asm volatile("" : "+s"(bx_)); F.bx = bx_; F.vcu = (F.G % 8 == 0) ? (bx_ % 8) * (F.G / 8) + bx_ / 8 : bx_; }
        if (ph == 0) {
#ifndef SKIP_P0
            p0_prologue(F, args);
#endif
        } else if (ph == NPH - 1) {
            row_pass(F, args, 2, 1);
        } else {
            const int l = (ph - 1) / NPL, k = (ph - 1) % NPL;
            if (k == 0) { row_pass(F, args, l == 0 ? 0 : 1, l); }
            else if (k == 1) {
                pg8::Gemm g{(const bf16*)(F.ws + WS_H), (const bf16*)(F.ws + WS_WIN) + (size_t)l * NP * DM, M, NP, DM}; pg8::StaticOrder S; S.init(M, NP, F.G, F.bx);
                pg8::EpiBf16 E{(bf16*)(F.ws + WS_PROJ), NP};
#ifndef SKIP_G1
                pg8::gemm_phase<pg8::EpiBf16, pg8::StaticOrder, true, true>(F.lds, g, S, E, F.tid);
#endif
            } else if (k == 2) {
#ifndef SKIP_P3
                p3_prep(F, args, l, rep);
#endif
            } else if (k == 3) {
#ifndef SKIP_P4
                p4_attention(F, args, l, l + 2 * rep);
#endif
            } else if (k == 4) {
                pg8::Gemm g{(const bf16*)(F.ws + WS_MIX), (const bf16*)(F.ws + WS_WOUT) + (size_t)l * DM * DM, M, DM, DM}; pg8::StaticOrder S; S.init(M, DM, F.G, F.bx);
                pg8::EpiResGate E{l == 0 ? inp<I_X>() : nullptr, (const bf16*)(F.ws + WS_X1), (bf16*)(F.ws + WS_X1), (const float*)(F.ws + WS_MOD) + (size_t)l * 8 * 6144 + 2 * DM};
#ifndef SKIP_G2
                pg8::gemm_phase<pg8::EpiResGate, pg8::StaticOrder, false, true>(F.lds, g, S, E, F.tid);
#endif
            } else if (k == 5) {
#ifndef SKIP_P6
                p6_router(F, args, l, rep);
#endif
            } else {
                build_tables(F, l); build_rowlists(F, l);
                unsigned* upf = F.ctl + CW_UPF + l * 8192; unsigned* dq = F.ctl + CW_DNQ + 16 * l;
                { pg8::Gemm g{(const bf16*)(F.ws + WS_H), (const bf16*)(F.ws + WS_WUP) + (size_t)l * NEXP * 512 * DM, MAXSLOT, 512, DM};
                  pg8::GroupOrder S{(const LAS int*)(F.lds + TAB_OFF), (int)F.MISC[1], 2, F.G, F.bx, (size_t)512 * DM * 2};
                  pg8::EpiSwiglu E{(bf16*)(F.ws + WS_HID), upf};
#ifndef SKIP_G3
                  pg8::gemm_phase<pg8::EpiSwiglu, pg8::GroupOrder, true, true, true>(F.lds, g, S, E, F.tid, (const LAS int*)(F.lds + ROWL_OFF));
#endif
                }
                if (GAP_CONVERT && !BG_CONVERT && l == 0 && rep == 0) convert_layer1_in_gap(F, args, 2 * (int)F.MISC[1] - F.G);
                { const pg8::Gemm g{(const bf16*)(F.ws + WS_HID), (const bf16*)(F.ws + WS_WDN) + (size_t)l * NEXP * DM * FF, MAXSLOT, DM, FF};
                  const pg8::EpiBf16 E{(bf16*)(F.ws + WS_Y), DM};
                  const LAS int* tab = (const LAS int*)(F.lds + TAB_OFF);
                  const int nd = 4 * __builtin_amdgcn_readfirstlane((int)F.MISC[1]);
                  pg8::DynOrder S{dq, upf, tab, F.MISC, nd, (size_t)DM * FF * 2, F.tid, (unsigned)F.G, 0u, 2u};
                  if (F.tid == 0) { const unsigned a = (unsigned)F.bx, b = (unsigned)F.G + __hip_atomic_fetch_add(dq, 1u, RLX_AGENT); F.MISC[4] = a; F.MISC[5] = b;
                      if ((int)a < nd) while (__hip_atomic_load(upf + (a >> 2) * 16, RLX_AGENT) < 2u) __builtin_amdgcn_s_sleep(8);
                      __builtin_amdgcn_fence(__ATOMIC_ACQUIRE, "agent"); asm volatile("s_waitcnt vmcnt(0)" ::: "memory"); S.issue(b); }
                  __syncthreads();
                  for (;;) {
                      if (__builtin_amdgcn_readfirstlane((int)F.MISC[4]) >= nd) break;
#ifndef SKIP_G4
                      pg8::gemm_phase<pg8::EpiBf16, pg8::DynOrder, true, true>(F.lds, g, S, E, F.tid);
#endif
                      if (F.tid == 0) {
                          const unsigned idn = F.MISC[5];
                          if ((int)idn < nd) { unsigned f = S.pflag; while (f < 2u) { __builtin_amdgcn_s_sleep(8); f = __hip_atomic_load(upf + (idn >> 2) * 16, RLX_AGENT); }
                              __builtin_amdgcn_fence(__ATOMIC_ACQUIRE, "agent"); asm volatile("s_waitcnt vmcnt(0)" ::: "memory"); }
                          const unsigned idn2 = S.ppop; F.MISC[4] = idn; F.MISC[5] = idn2; S.issue(idn2); }
                      __syncthreads();
                  }
                }
            }
        }
#if PROBE_REP_K >= 0
        if (rep < nrep) xcd_barrier(bar, F.tid);
        }
#endif
        if (ph + 1 < hi) xcd_barrier(bar, F.tid);
#ifdef PROBE_DOUBLE_BAR
        if (ph + 1 < hi) xcd_barrier(bar, F.tid);
#endif
    }
}

extern "C" void kernel_launch(void* const* d_in, const int* in_sizes, int n_in, void* d_out, int out_size, void* d_ws, size_t ws_size, hipStream_t stream) {
    static int grid = 0;
    if (grid == 0) {
        if (n_in != 28 || out_size != M * DM || ws_size < WS_END) { fprintf(stderr, "kernel_launch: unexpected shapes (n_in %d, out %d, ws %zu)\n", n_in, out_size, ws_size); grid = -1; return; }
        int dev = 0, cus = 0, per_cu = 0;
        if (hipGetDevice(&dev) != hipSuccess || hipDeviceGetAttribute(&cus, hipDeviceAttributeMultiprocessorCount, dev) != hipSuccess) { grid = -1; return; }
        if (hipFuncSetAttribute((const void*)mk_fwd, hipFuncAttributeMaxDynamicSharedMemorySize, LDS_BYTES) != hipSuccess) { fprintf(stderr, "kernel_launch: hipFuncSetAttribute failed\n"); grid = -1; return; }
        if (hipOccupancyMaxActiveBlocksPerMultiprocessor(&per_cu, (const void*)mk_fwd, NWAVES * 64, LDS_BYTES) != hipSuccess || per_cu < 1)
            fprintf(stderr, "kernel_launch: occupancy query reports %d workgroups per CU\n", per_cu);
        (void)hipGetLastError();
        grid = cus;
    }
    if (grid < 0) return;
    if (hipMemsetAsync((char*)d_ws + WS_CTL, 0, CTL_ZERO_BYTES, stream) != hipSuccess) return;
    Args a{};
    for (int i = 0; i < 28; ++i) a.in[i] = (const float*)d_in[i];
    a.out = (float*)d_out; a.ws = (unsigned char*)d_ws;
#if MK_PER_PHASE
    for (int p = 0; p < NPH; ++p) { a.ph_lo = p; a.ph_hi = p + 1; hipLaunchKernelGGL(mk_fwd, dim3(grid), dim3(NWAVES * 64), LDS_BYTES, stream, a); }
#else
    a.ph_lo = 0; a.ph_hi = NPH; hipLaunchKernelGGL(mk_fwd, dim3(grid), dim3(NWAVES * 64), LDS_BYTES, stream, a);
#endif
}
```

```cpp
#include <hip/hip_runtime.h>
#include <cstdio>
#include <cstdint>

#ifndef MK_PER_PHASE
#define MK_PER_PHASE 0
#endif

#ifndef PROBE_P3_PART
#define PROBE_P3_PART 0
#endif
#ifndef PROBE_ATT_VAR
#define PROBE_ATT_VAR -1
#endif
#ifndef BG_CONVERT
#define BG_CONVERT 1
#endif
#ifndef GAP_CONVERT
#define GAP_CONVERT 1
#endif
#ifndef PROBE_ATT_MODE
#define PROBE_ATT_MODE 0
#endif
#ifndef PROBE_REP_K
#define PROBE_REP_K -1
#endif
#define LAS __attribute__((address_space(3)))
#define GAS __attribute__((address_space(1)))
typedef unsigned short bf16;
typedef short bf16x8 __attribute__((ext_vector_type(8)));
typedef short s16x4 __attribute__((ext_vector_type(4)));
typedef float f32x4 __attribute__((ext_vector_type(4)));
typedef float f32x2 __attribute__((ext_vector_type(2)));
typedef float f32x16 __attribute__((ext_vector_type(16)));
typedef unsigned u32x4 __attribute__((ext_vector_type(4)));
typedef unsigned u32x2 __attribute__((ext_vector_type(2)));

constexpr int BATCH = 8, SEQ = 2048, DM = 1024, M = BATCH * SEQ, DEPTH = 2;
constexpr int NP = 3072;
constexpr int P_IN = 2988;
constexpr int C_AQ = 0, C_AK = 256, C_AV = 512, C_BQ = 768, C_BK = 1024, C_BV = 1280, C_CQ = 1536, C_CK = 1792, C_CV = 2048,
              C_DQ = 2304, C_DK = 2560, C_DV = 2624, C_IQ = 2688, C_IK = 2944, C_IW = 2976, C_AF = 2984;
constexpr int NEXP = 32, FF = 256, MAXSLOT = M * 2 + NEXP * 256, MAXTILE = MAXSLOT / 256;
constexpr float LOG2E = 1.4426950408889634f;
constexpr float RMS_EPS = 1e-6f;

constexpr size_t MiB = 1u << 20;
constexpr size_t WS_CTL = 0, CTL_ZERO_BYTES = 1 * MiB;
constexpr size_t WS_WR = 1 * MiB;
constexpr size_t WS_MOD = 2 * MiB;
constexpr size_t WS_CUM = 3 * MiB;
constexpr size_t WS_TOK = 4 * MiB;
constexpr size_t WS_MISC = 5 * MiB;
constexpr size_t WS_MASK = 6 * MiB;
constexpr size_t WS_WIN = 10 * MiB;
constexpr size_t WS_WOUT = 22 * MiB;
constexpr size_t WS_WUP = 26 * MiB;
constexpr size_t WS_WDN = 90 * MiB;
constexpr size_t WS_X1 = 122 * MiB;
constexpr size_t WS_H = 186 * MiB;
constexpr size_t WS_MIX = WS_H;

constexpr size_t WS_PROJ = 218 * MiB;
constexpr size_t WS_Y = WS_PROJ;
constexpr size_t WS_HID = WS_PROJ + 80 * MiB;
constexpr size_t WS_ELIST = 322 * MiB;
constexpr size_t WS_END = 324 * MiB;
constexpr int CW_AQ = 256;
constexpr int CW_CNT = 1024;
constexpr int CW_BAR = 8192;
constexpr int CW_DNQ = 208;
constexpr int CW_UPF = 65536;

constexpr int RING_BYTES = 143360;
constexpr int LDSCTL_OFF = RING_BYTES, MISC_OFF = LDSCTL_OFF + 320, CNTS_OFF = LDSCTL_OFF + 512, BASE_OFF = LDSCTL_OFF + 640, TAB_OFF = LDSCTL_OFF + 768;
constexpr int ROWL_OFF = 131072;
constexpr int LDS_BYTES = 147456;
constexpr int NWAVES = 8;

#define LDS_WAIT() asm volatile("s_waitcnt lgkmcnt(0)" ::: "memory")
#define VM_WAIT() asm volatile("s_waitcnt vmcnt(0)" ::: "memory")
#define RLX_AGENT __ATOMIC_RELAXED, __HIP_MEMORY_SCOPE_AGENT

__device__ __forceinline__ float bf2f(unsigned short u) { return __builtin_bit_cast(float, (unsigned)u << 16); }
__device__ __forceinline__ unsigned f2bf(float f) { unsigned u = __builtin_bit_cast(unsigned, f); return (u + 0x7fffu + ((u >> 16) & 1u)) >> 16; }
__device__ __forceinline__ unsigned pk2(float lo, float hi) { return f2bf(lo) | (f2bf(hi) << 16); }
template <int O> __device__ __forceinline__ float shx(float x) { static_assert(O >= 1 && O <= 16, "swizzle xor"); return __builtin_bit_cast(float, __builtin_amdgcn_ds_swizzle(__builtin_bit_cast(int, x), (O << 10) | 0x1f)); }
__device__ __forceinline__ float half_sum(float x) { return __builtin_bit_cast(float, __builtin_amdgcn_readlane(__builtin_bit_cast(int, x), 0)) + __builtin_bit_cast(float, __builtin_amdgcn_readlane(__builtin_bit_cast(int, x), 32)); }
__device__ __forceinline__ float half_max(float x) { return fmaxf(__builtin_bit_cast(float, __builtin_amdgcn_readlane(__builtin_bit_cast(int, x), 0)), __builtin_bit_cast(float, __builtin_amdgcn_readlane(__builtin_bit_cast(int, x), 32))); }
__device__ __forceinline__ float shup(float x, int o, int lane) { return __builtin_bit_cast(float, __builtin_amdgcn_ds_bpermute((lane - o) << 2, __builtin_bit_cast(int, x))); }
__device__ __forceinline__ int shup_i(int x, int o, int lane) { return __builtin_amdgcn_ds_bpermute((lane - o) << 2, x); }
__device__ __forceinline__ float wave_sum(float v) { v += shx<1>(v); v += shx<2>(v); v += shx<4>(v); v += shx<8>(v); v += shx<16>(v); return half_sum(v); }

namespace pg8 {
constexpr int BM = 256, BK = 64, HALF = 128, HTB = HALF * BK * 2, STAGE_BYTES = 8 * HTB, NXCD = 8, WGM = 8;
__host__ __device__ __forceinline__ int lds_byte(int r, int c) { const int st = (r >> 4) * 2 + (c >> 5), rr = r & 15, cc = c & 31, ob = rr * 64 + cc * 2; return st * 1024 + (ob ^ (((ob >> 9) & 1) << 5)); }
__host__ __device__ __forceinline__ void stage_rc(int b, int& R, int& C) { const int st = b / 1024, sb = b % 1024, swz = sb ^ (((sb >> 9) & 1) << 5); R = (st >> 1) * 16 + swz / 64; C = (st & 1) * 32 + (swz % 64) / 2; }
__host__ __device__ __forceinline__ int perm32(int rho) { const int n = rho >> 4, i = rho & 15; return 8 * (i >> 2) + 4 * n + (i & 3); }

struct Unit { int pm, pn; size_t bo; };
struct Gemm { const bf16* A; const bf16* Bt; int M, N, K; };

struct StaticOrder {
    int nM, nN, nwg, G, c;
    __host__ __device__ void init(int M_, int N_, int G_, int c_) { nM = M_ / BM; nN = N_ / BM; nwg = nM * nN; G = G_; c = c_; }
    __host__ __device__ bool next(int i, Unit& u) const {
        const long L = (long)i * G + c; if (L >= nwg) return false;
        int wgid = (int)L; { const int q = nwg / NXCD, r = nwg % NXCD, xcd = wgid % NXCD, off = wgid / NXCD; wgid = (xcd < r ? xcd * (q + 1) : r * (q + 1) + (xcd - r) * q) + off; }
        const int nig = WGM * nN, gid = wgid / nig, fm = gid * WGM, gsz = (nM - fm) < WGM ? (nM - fm) : WGM;
        u.pm = fm + ((wgid % nig) % gsz); u.pn = (wgid % nig) / gsz; u.bo = 0; return true;
    }
};
struct GroupOrder {
    const LAS int* tab; int ntile, ncol, G, c; size_t ebytes;
    __device__ __forceinline__ bool next(int i, Unit& u) const {
        const long L = (long)i * G + c; if (L >= (long)ntile * ncol) return false;
        u.pm = (int)(L / ncol); u.pn = (int)(L % ncol);
        const int e = __builtin_amdgcn_readfirstlane(tab[u.pm]); u.bo = (size_t)e * ebytes; return true;
    }
};

struct OneUnit { Unit u; __device__ __forceinline__ bool next(int i, Unit& o) const { if (i != 0) return false; o = u; return true; } };
struct DynOrder {
    unsigned* dq; unsigned* upf; const LAS int* tab; volatile LAS unsigned* M; int nd; size_t ebytes; int tid; unsigned G;
    mutable unsigned ppop, pflag;
    __device__ __forceinline__ void issue(unsigned idnext) const {
        ppop = G + __builtin_amdgcn_atomic_inc32(dq, 0xFFFFFFFFu, __ATOMIC_RELAXED, "agent");
        pflag = 2u; if ((int)idnext < nd) pflag = __hip_atomic_load(upf + (idnext >> 2) * 16, __ATOMIC_RELAXED, __HIP_MEMORY_SCOPE_AGENT);
    }
    __device__ __forceinline__ void unit(int id, Unit& u) const { u.pm = id >> 2; u.pn = id & 3; u.bo = (size_t)__builtin_amdgcn_readfirstlane(tab[id >> 2]) * ebytes; }
    __device__ __forceinline__ bool next(int i, Unit& u) const {
        if (i == 0) { const int id = __builtin_amdgcn_readfirstlane((int)M[4]); if (id >= nd) return false; unit(id, u); return true; }
        if (tid == 0) {
            const unsigned idn = M[5]; const bool ready = (int)idn < nd && pflag >= 2u;
            M[6] = ready ? 1u : 0u;
            if (ready) { asm volatile("buffer_inv sc1" ::: "memory"); M[4] = idn; const unsigned idn2 = ppop; M[5] = idn2; issue(idn2); }
        }
        asm volatile("s_waitcnt lgkmcnt(0)\n\ts_barrier" ::: "memory");
        if (__builtin_amdgcn_readfirstlane((int)M[6]) == 0) return false;
        unit(__builtin_amdgcn_readfirstlane((int)M[4]), u); return true;
    }
};

__device__ __forceinline__ unsigned cvt_pk_bf16(float lo, float hi) { unsigned r; asm volatile("v_cvt_pk_bf16_f32 %0, %1, %2" : "=v"(r) : "v"(lo), "v"(hi)); return r; }

struct EpiBf16 {
    static constexpr bool PERM = true, PUBLISH = false;
    bf16* O; int ldc;
    __device__ __forceinline__ void operator()(const f32x4 (&acc)[2][2][4][2], const Unit& u, int wr, int wc, int fr, int fq) const {
        const int row0 = u.pm * BM + wr * 64 + fr; const int col0 = u.pn * BM + wc * 32 + 8 * fq;
#pragma unroll
        for (int ai = 0; ai < 2; ++ai)
#pragma unroll
            for (int m = 0; m < 4; ++m) { bf16* rowp = O + (size_t)(row0 + ai * HALF + m * 16) * ldc + col0;
#pragma unroll
                for (int bj = 0; bj < 2; ++bj) { const f32x4 v0 = acc[ai][bj][m][0], v1 = acc[ai][bj][m][1];
                    u32x4 w; w.x = cvt_pk_bf16(v0[0], v0[1]); w.y = cvt_pk_bf16(v0[2], v0[3]); w.z = cvt_pk_bf16(v1[0], v1[1]); w.w = cvt_pk_bf16(v1[2], v1[3]);
                    *(u32x4*)(rowp + bj * HALF) = w; } }
    }
};
struct EpiResGate {
    static constexpr bool PERM = true, PUBLISH = false;
    const float* base32; const bf16* base16; bf16* out; const float* gate;
    __device__ __forceinline__ void operator()(const f32x4 (&acc)[2][2][4][2], const Unit& u, int wr, int wc, int fr, int fq) const {
        const int col0 = u.pn * BM + wc * 32 + 8 * fq; const float* g = gate + (size_t)(u.pm >> 3) * 6144 + col0;
        f32x4 gv[2][2];
#pragma unroll
        for (int bj = 0; bj < 2; ++bj)
#pragma unroll
            for (int n = 0; n < 2; ++n) gv[bj][n] = *(const f32x4*)(g + bj * HALF + n * 4);
#pragma unroll
        for (int ai = 0; ai < 2; ++ai)
#pragma unroll
            for (int m = 0; m < 4; ++m) { const size_t off = (size_t)(u.pm * BM + ai * HALF + wr * 64 + m * 16 + fr) * DM + col0;
#pragma unroll
                for (int bj = 0; bj < 2; ++bj) { f32x4 b0, b1;
                    if (base32) { b0 = *(const f32x4*)(base32 + off + bj * HALF); b1 = *(const f32x4*)(base32 + off + bj * HALF + 4); }
                    else { const u32x4 r = *(const u32x4*)(base16 + off + bj * HALF);
                        b0 = (f32x4){bf2f(r.x & 0xffff), bf2f(r.x >> 16), bf2f(r.y & 0xffff), bf2f(r.y >> 16)}; b1 = (f32x4){bf2f(r.z & 0xffff), bf2f(r.z >> 16), bf2f(r.w & 0xffff), bf2f(r.w >> 16)}; }
                    const f32x4 v0 = b0 + gv[bj][0] * acc[ai][bj][m][0], v1 = b1 + gv[bj][1] * acc[ai][bj][m][1];
                    u32x4 w; w.x = cvt_pk_bf16(v0[0], v0[1]); w.y = cvt_pk_bf16(v0[2], v0[3]); w.z = cvt_pk_bf16(v1[0], v1[1]); w.w = cvt_pk_bf16(v1[2], v1[3]);
                    *(u32x4*)(out + off + bj * HALF) = w; } }
    }
};
struct EpiSwiglu {
    static constexpr bool PERM = true, PUBLISH = true;
    bf16* O; unsigned* flag;
    __device__ __forceinline__ void operator()(const f32x4 (&acc)[2][2][4][2], const Unit& u, int wr, int wc, int fr, int fq) const {
        const int row0 = u.pm * BM + wr * 64 + fr; const int col0 = u.pn * HALF + wc * 32 + 8 * fq;
#pragma unroll
        for (int ai = 0; ai < 2; ++ai)
#pragma unroll
            for (int m = 0; m < 4; ++m) { bf16* rowp = O + (size_t)(row0 + ai * HALF + m * 16) * FF + col0;
                float hv[8];
#pragma unroll
                for (int n = 0; n < 2; ++n)
#pragma unroll
                    for (int i = 0; i < 4; ++i) { const float a = acc[ai][0][m][n][i], b = acc[ai][1][m][n][i];
                        const float sg = __builtin_amdgcn_rcpf(1.f + __builtin_amdgcn_exp2f(-a * LOG2E)); hv[n * 4 + i] = a * sg * b; }
                u32x4 w; w.x = cvt_pk_bf16(hv[0], hv[1]); w.y = cvt_pk_bf16(hv[2], hv[3]); w.z = cvt_pk_bf16(hv[4], hv[5]); w.w = cvt_pk_bf16(hv[6], hv[7]);
                asm volatile("global_store_dwordx4 %0, %1, off sc1\n\ts_nop 2" :: "v"((const GAS bf16*)rowp), "v"(w) : "memory"); }
    }
};

template <class Epi, class Sched, bool ALIGN_EPI = false, bool SP2 = false, bool GATHER = false>
__device__ __forceinline__ void gemm_phase(LAS unsigned char* lds, const Gemm g, const Sched& S, const Epi& E, const int tid, const LAS int* rowl = nullptr) {
    static_assert(!GATHER || SP2, "gather mode is written for the SP2 loop");
    const int wid = __builtin_amdgcn_readfirstlane(tid >> 6), lane = tid & 63, wr = wid >> 2, wc = wid & 3, fr = lane & 15, fq = lane >> 4;
    const int K = g.K, nt = K / BK;
    unsigned voffA[2], voffB[2];
#pragma unroll
    for (int i = 0; i < 2; ++i) { int R, C; stage_rc(tid * 16 + i * 8192, R, C); const int Rb = Epi::PERM ? ((R & ~31) + perm32(R & 31)) : R;
        voffA[i] = (unsigned)(R * K + C) * 2u; voffB[i] = (unsigned)(Rb * K + C) * 2u; }
    const size_t kstep = (size_t)(BK * 2);
    const size_t hstep = (size_t)HALF * K * 2;
    const size_t tstep = 2 * hstep;
    const size_t hstepA = GATHER ? 0 : hstep, tstepA = GATHER ? 0 : tstep;
    unsigned voffGc[2][2], voffGn[2][2];
    int gR[2], gC[2];
#pragma unroll
    for (int i = 0; i < 2; ++i) stage_rc(tid * 16 + i * 8192, gR[i], gC[i]);
#define PG8_GOFF(dst, ui_) do { _Pragma("unroll") for (int h_ = 0; h_ < 2; ++h_) _Pragma("unroll") for (int i_ = 0; i_ < 2; ++i_) \
        dst[h_][i_] = (unsigned)rowl[(ui_) * 256 + h_ * HALF + gR[i_]] * (unsigned)(K * 2) + (unsigned)gC[i_] * 2u; } while (0)
    const unsigned ldsw = (unsigned)wid * 1024u;
    const int aoff = lds_byte(wr * 64 + fr, fq * 8), boff = lds_byte(wc * 32 + fr, fq * 8);
#define PG8_SA(b, h) (((b) * 2 + (h)) * HTB)
#define PG8_SB(b, h) ((4 + (b) * 2 + (h)) * HTB)
#define PG8_STAGE(bufoff, gbase, voff) do { _Pragma("unroll") for (int _i = 0; _i < 2; ++_i) \
        __builtin_amdgcn_global_load_lds((const unsigned*)((const char*)(gbase) + (voff)[_i]), (LAS unsigned*)(lds + (bufoff) + ldsw + _i * 8192), 16, 0, 0); } while (0)
#define PG8_STAGE_A(bufoff, gbase, H, NXT) do { if constexpr (GATHER) { unsigned vo_[2]; vo_[0] = (NXT) ? voffGn[H][0] : voffGc[H][0]; vo_[1] = (NXT) ? voffGn[H][1] : voffGc[H][1]; PG8_STAGE(bufoff, gbase, vo_); } \
        else { PG8_STAGE(bufoff, (const char*)(gbase) + (H) * hstep, voffA); } } while (0)
#define PG8_LDA(dst, b, h) do { _Pragma("unroll") for (int m = 0; m < 4; ++m) _Pragma("unroll") for (int k = 0; k < 2; ++k) dst[m][k] = *(const LAS bf16x8*)(lds + PG8_SA(b, h) + aoff + m * 2048 + k * 1024); } while (0)
#define PG8_LDB(dst, b, h) do { _Pragma("unroll") for (int n = 0; n < 2; ++n) _Pragma("unroll") for (int k = 0; k < 2; ++k) dst[n][k] = *(const LAS bf16x8*)(lds + PG8_SB(b, h) + boff + n * 2048 + k * 1024); } while (0)
#define PG8_MMA(ai, bj, At, Bt) do { __builtin_amdgcn_s_setprio(1); _Pragma("unroll") for (int m = 0; m < 4; ++m) _Pragma("unroll") for (int n = 0; n < 2; ++n) _Pragma("unroll") for (int k = 0; k < 2; ++k) \
        acc[ai][bj][m][n] = __builtin_amdgcn_mfma_f32_16x16x32_bf16(Bt[n][k], At[m][k], acc[ai][bj][m][n], 0, 0, 0); __builtin_amdgcn_s_setprio(0); } while (0)
#define PG8_WAIT_V(n) asm volatile("s_waitcnt vmcnt(" #n ")" ::: "memory")
#define PG8_WAIT_L(n) asm volatile("s_waitcnt lgkmcnt(" #n ")" ::: "memory")
#define PG8_BAR __builtin_amdgcn_s_barrier()
#define PG8_SCHED __builtin_amdgcn_sched_barrier(0)
    Unit cur, nxt; int ui = 0;
    if (!S.next(0, cur)) return;
    f32x4 acc[2][2][4][2];
#pragma unroll
    for (int a = 0; a < 2; ++a)
#pragma unroll
        for (int b = 0; b < 2; ++b)
#pragma unroll
            for (int m = 0; m < 4; ++m)
#pragma unroll
                for (int n = 0; n < 2; ++n) acc[a][b][m][n] = (f32x4){0.f, 0.f, 0.f, 0.f};
    bf16x8 At[4][2], B0[2][2], B1[2][2];
    const char* cA = (const char*)g.A + (size_t)cur.pm * tstepA; const char* cB = (const char*)g.Bt + cur.bo + (size_t)cur.pn * tstep;
    if constexpr (GATHER) { PG8_GOFF(voffGc, 0); PG8_GOFF(voffGn, 0); }
    if constexpr (SP2) {
        PG8_STAGE(PG8_SB(0, 0), cB, voffB); PG8_STAGE(PG8_SB(0, 1), cB + hstep, voffB); PG8_STAGE_A(PG8_SA(0, 0), cA, 0, false); PG8_STAGE_A(PG8_SA(0, 1), cA, 1, false);
        if (wr == 1) PG8_BAR;
        PG8_WAIT_V(2); PG8_BAR;
        PG8_STAGE(PG8_SB(1, 0), cB + kstep, voffB); PG8_STAGE_A(PG8_SA(1, 0), cA + kstep, 0, false); PG8_STAGE(PG8_SB(1, 1), cB + hstep + kstep, voffB);
        PG8_WAIT_V(6); PG8_BAR;
    } else {
        PG8_STAGE(PG8_SB(0, 0), cB, voffB); PG8_STAGE(PG8_SA(0, 0), cA, voffA); PG8_STAGE(PG8_SB(0, 1), cB + hstep, voffB); PG8_STAGE(PG8_SA(0, 1), cA + hstep, voffA);
        if (wr == 1) PG8_BAR;
        PG8_WAIT_V(4); PG8_BAR;
        PG8_STAGE(PG8_SB(1, 0), cB + kstep, voffB); PG8_STAGE(PG8_SA(1, 0), cA + kstep, voffA); PG8_STAGE(PG8_SB(1, 1), cB + hstep + kstep, voffB);
        PG8_WAIT_V(6); PG8_BAR;
    }
    for (;;) {
        const bool has_next = S.next(ui + 1, nxt);
        if constexpr (GATHER) { if (has_next) PG8_GOFF(voffGn, ui + 1); }
        const char* nA = has_next ? (const char*)g.A + (size_t)nxt.pm * tstepA : cA; const char* nB = has_next ? (const char*)g.Bt + nxt.bo + (size_t)nxt.pn * tstep : cB;
#pragma unroll 1
        for (int t = 0; t < nt; t += 2) {
            const bool last = (t == nt - 2);
            const char* a1 = cA + (size_t)(t + 1) * kstep;
            const char* a2 = last ? nA : cA + (size_t)(t + 2) * kstep; const char* b2 = last ? nB : cB + (size_t)(t + 2) * kstep;
            const char* a3 = a2 + kstep; const char* b3 = b2 + kstep;
            if constexpr (SP2) {
            PG8_LDB(B0, 0, 0); PG8_LDB(B1, 0, 1); PG8_SCHED; PG8_LDA(At, 0, 0); PG8_STAGE_A(PG8_SA(1, 1), a1, 1, false);
            PG8_WAIT_V(8); PG8_WAIT_L(0); PG8_BAR; PG8_MMA(0, 0, At, B0); PG8_MMA(0, 1, At, B1); PG8_BAR; PG8_SCHED;
            PG8_LDA(At, 0, 1); PG8_STAGE(PG8_SB(0, 0), b2, voffB); PG8_STAGE(PG8_SB(0, 1), b2 + hstep, voffB); PG8_STAGE_A(PG8_SA(0, 0), a2, 0, last);
            PG8_WAIT_V(8); PG8_WAIT_L(0); PG8_BAR; PG8_MMA(1, 0, At, B0); PG8_MMA(1, 1, At, B1); PG8_BAR; PG8_SCHED;
            PG8_LDB(B0, 1, 0); PG8_LDB(B1, 1, 1); PG8_SCHED; PG8_LDA(At, 1, 0); PG8_STAGE_A(PG8_SA(0, 1), a2, 1, last);
            PG8_WAIT_V(8); PG8_WAIT_L(0); PG8_BAR; PG8_MMA(0, 0, At, B0); PG8_MMA(0, 1, At, B1); PG8_BAR; PG8_SCHED;
            PG8_LDA(At, 1, 1); PG8_STAGE(PG8_SB(1, 0), b3, voffB); PG8_STAGE(PG8_SB(1, 1), b3 + hstep, voffB); PG8_STAGE_A(PG8_SA(1, 0), a3, 0, last);
            PG8_WAIT_V(8); PG8_WAIT_L(0); PG8_BAR; PG8_MMA(1, 0, At, B0); PG8_MMA(1, 1, At, B1); PG8_BAR; PG8_SCHED;
            } else {
            PG8_LDB(B0, 0, 0); PG8_SCHED; PG8_LDA(At, 0, 0); PG8_STAGE(PG8_SA(1, 1), a1 + hstep, voffA);
            PG8_WAIT_L(8); PG8_BAR; PG8_WAIT_L(0); PG8_MMA(0, 0, At, B0); PG8_BAR; PG8_SCHED;
            PG8_LDB(B1, 0, 1); PG8_STAGE(PG8_SB(0, 0), b2, voffB);
            PG8_BAR; PG8_WAIT_L(0); PG8_MMA(0, 1, At, B1); PG8_BAR;
            PG8_LDA(At, 0, 1); PG8_STAGE(PG8_SA(0, 0), a2, voffA);
            PG8_BAR; PG8_WAIT_L(0); PG8_MMA(1, 0, At, B0); PG8_BAR; PG8_SCHED;
            PG8_STAGE(PG8_SB(0, 1), b2 + hstep, voffB);
            PG8_WAIT_V(6); PG8_BAR; PG8_MMA(1, 1, At, B1); PG8_BAR;
            PG8_LDB(B0, 1, 0); PG8_SCHED; PG8_LDA(At, 1, 0); PG8_STAGE(PG8_SA(0, 1), a2 + hstep, voffA);
            PG8_WAIT_L(8); PG8_BAR; PG8_WAIT_L(0); PG8_MMA(0, 0, At, B0); PG8_BAR; PG8_SCHED;
            PG8_LDB(B1, 1, 1); PG8_STAGE(PG8_SB(1, 0), b3, voffB);
            PG8_BAR; PG8_WAIT_L(0); PG8_MMA(0, 1, At, B1); PG8_BAR;
            PG8_LDA(At, 1, 1); PG8_STAGE(PG8_SA(1, 0), a3, voffA);
            PG8_BAR; PG8_WAIT_L(0); PG8_MMA(1, 0, At, B0); PG8_BAR; PG8_SCHED;
            PG8_STAGE(PG8_SB(1, 1), b3 + hstep, voffB);
            PG8_WAIT_V(6); PG8_BAR; PG8_MMA(1, 1, At, B1); PG8_BAR;
            }
        }
        if constexpr (ALIGN_EPI) { if (wr == 0) PG8_BAR; }
        E(acc, cur, wr, wc, fr, fq);
        if constexpr (Epi::PUBLISH) {
            asm volatile("s_waitcnt vmcnt(0)" ::: "memory"); PG8_BAR;
            if (tid == 0) __hip_atomic_fetch_add(E.flag + cur.pm * 16, 1u, __ATOMIC_RELAXED, __HIP_MEMORY_SCOPE_AGENT);
        }
        if (!has_next) break;
#pragma unroll
        for (int a = 0; a < 2; ++a)
#pragma unroll
            for (int b = 0; b < 2; ++b)
#pragma unroll
                for (int m = 0; m < 4; ++m)
#pragma unroll
                    for (int n = 0; n < 2; ++n) acc[a][b][m][n] = (f32x4){0.f, 0.f, 0.f, 0.f};
        cur = nxt; cA = nA; cB = nB; ++ui;
        if constexpr (GATHER) { _Pragma("unroll") for (int h_ = 0; h_ < 2; ++h_) _Pragma("unroll") for (int i_ = 0; i_ < 2; ++i_) voffGc[h_][i_] = voffGn[h_][i_]; }
        if constexpr (ALIGN_EPI) { if (wr == 1) PG8_BAR; }
    }
    PG8_WAIT_V(0);
    if constexpr (!ALIGN_EPI) { if (wr == 0) PG8_BAR; }
    PG8_BAR;
#undef PG8_SA
#undef PG8_STAGE_A
#undef PG8_GOFF
#undef PG8_SB
#undef PG8_STAGE
#undef PG8_LDA
#undef PG8_LDB
#undef PG8_MMA
#undef PG8_WAIT_V
#undef PG8_WAIT_L
#undef PG8_BAR
#undef PG8_SCHED
}
}

#define XB_TMO      128
#define XB_XCNT(j)  (256  + 64 * (j))
#define XB_XSUB(j)  (1280 + 64 * (j))
#define XB_XGEN(j)  (2304 + 64 * (j))
#define XB_TOP      3328
#define XB_TOPGEN   3392
#define XCD_BAR_WORDS 3456
#define XB_SPIN_CAP (1u << 18)
__device__ __forceinline__ unsigned xb_ld(unsigned* p)              { return __hip_atomic_load(p, __ATOMIC_RELAXED, __HIP_MEMORY_SCOPE_AGENT); }
__device__ __forceinline__ unsigned xb_add(unsigned* p, unsigned v) { return __hip_atomic_fetch_add(p, v, __ATOMIC_RELAXED, __HIP_MEMORY_SCOPE_AGENT); }
__device__ __forceinline__ unsigned xb_xcc_id() { return (unsigned)__builtin_amdgcn_s_getreg((3 << 11) | 20) & 0xFu; }
#define XB_SPIN(cond, bar) do { unsigned _sp = 0; while (cond) { __builtin_amdgcn_s_sleep(1); \
    if ((++_sp & 255u) == 0u) { if (xb_ld(&(bar)[XB_TMO])) break; if (_sp > XB_SPIN_CAP) { atomicAdd(&(bar)[XB_TMO], 1u); break; } } } } while (0)
struct XcdBarrier { unsigned* bar; unsigned x; volatile LAS unsigned* st; };
__device__ __forceinline__ XcdBarrier xcd_barrier_post(unsigned* bar, volatile LAS unsigned* st) {
    XcdBarrier b; b.bar = bar; b.x = xb_xcc_id(); b.st = st;
    if (threadIdx.x == 0) (void)xb_add(&bar[XB_XCNT(b.x)], 1u);
    return b;
}
__device__ __forceinline__ void xcd_barrier_complete(unsigned* bar, unsigned x, unsigned& nloc, unsigned& nx) {
    const unsigned G = gridDim.x * gridDim.y * gridDim.z;
    unsigned sum, cnt, mine, sp = 0u;
    for (;;) {
        sum = 0u; cnt = 0u; mine = 0u;
#pragma unroll 1
        for (unsigned j = 0; j < 16; ++j) { const unsigned c = xb_ld(&bar[XB_XCNT(j)]); sum += c; cnt += (c > 0u) ? 1u : 0u; mine = (j == x) ? c : mine; }
        if (sum == G) break;
        __builtin_amdgcn_s_sleep(1);
        if ((++sp & 255u) == 0u) { if (xb_ld(&bar[XB_TMO])) break; if (sp > XB_SPIN_CAP) { atomicAdd(&bar[XB_TMO], 1u); break; } }
    }
    nloc = mine > 0u ? mine : 1u; nx = cnt > 0u ? cnt : 1u;
}
__device__ __forceinline__ void xcd_barrier(const XcdBarrier& b, const int tid) {
    asm volatile("s_waitcnt vmcnt(0)" ::: "memory");
    __syncthreads();
    if (tid == 0) {
        unsigned* bar = b.bar;
        __builtin_amdgcn_s_waitcnt(0);
        unsigned nloc = b.st[0], nx = b.st[1];
        if (nloc == 0u) { xcd_barrier_complete(bar, b.x, nloc, nx); b.st[0] = nloc; b.st[1] = nx; }
        const unsigned old = xb_add(&bar[XB_XSUB(b.x)], 1u);
        const unsigned gen = old / nloc;
        if (old + 1u == (gen + 1u) * nloc) {
            __builtin_amdgcn_fence(__ATOMIC_RELEASE, "agent");
            asm volatile("s_waitcnt vmcnt(0)" ::: "memory");
            const unsigned og = xb_add(&bar[XB_TOP], 1u);
            const unsigned tg = og / nx;
            if (og + 1u == (tg + 1u) * nx) xb_add(&bar[XB_TOPGEN], 1u);
            else XB_SPIN(xb_ld(&bar[XB_TOPGEN]) == tg, bar);
            __builtin_amdgcn_fence(__ATOMIC_ACQUIRE, "agent");
            xb_add(&bar[XB_XGEN(b.x)], 1u);
            asm volatile("s_waitcnt vmcnt(0)" ::: "memory");
        } else {
            XB_SPIN(xb_ld(&bar[XB_XGEN(b.x)]) == gen, bar);
            __builtin_amdgcn_fence(__ATOMIC_ACQUIRE, "agent");
            asm volatile("s_waitcnt vmcnt(0)" ::: "memory");
        }
    }
    __syncthreads();
}

struct Frame {
    LAS unsigned char* lds;
    volatile LAS unsigned* MISC;
    unsigned* ctl;
    int tid, lane, wave, vcu, G, bx;
    float* out; unsigned char* ws;
};
struct Args { const float* in[28]; float* out; unsigned char* ws; int ph_lo, ph_hi; };
enum { I_X = 0, I_C, I_ADAW, I_ADAB, I_N1G, I_N2G, I_WIN, I_BF, I_QNA, I_KNA, I_QNC, I_KNC, I_LQ1, I_LK1, I_LQ2, I_LK2, I_SUBLN, I_QND, I_KND, I_MIXB, I_WOUT,
       I_WG, I_BG, I_WE, I_BE, I_W1, I_W3, I_W2 };
template <int I> __device__ __forceinline__ const float* inp() {
    auto ka = __builtin_amdgcn_kernarg_segment_ptr(); unsigned long long raw;
    asm volatile("s_load_dwordx2 %0, %1, %2\n\ts_waitcnt lgkmcnt(0)" : "=s"(raw) : "s"(ka), "i"(I * 8));
    return (const float*)(const GAS float*)raw;
}


struct TItem { const float* W; bf16* WT; const float* rs; int ldw, K, dst_row0, src_n0, kb, mapin; };
__device__ __forceinline__ int colmap_in(int n) { return n < 768 ? n : (n < 2984 ? n + 4 : (n < 2988 ? n - 2984 + 768 : -1)); }
__device__ __forceinline__ void t_load(const TItem& T, f32x4 (&v)[8], int lane) {
    const int k0 = 64 * T.kb, r8 = lane >> 3, c4 = (lane & 7) * 4; const int sc = T.mapin ? colmap_in(T.src_n0 + c4) : T.src_n0 + c4;
#pragma unroll
    for (int i = 0; i < 8; ++i) { v[i] = (f32x4){0.f, 0.f, 0.f, 0.f}; if (sc >= 0) v[i] = *(const f32x4*)(T.W + (size_t)(k0 + 8 * r8 + i) * T.ldw + sc); }
}
__device__ __forceinline__ void t_store(const TItem& T, f32x4 (&v)[8], LAS float* scr, int lane) {
    (void)scr;
    const int k0 = 64 * T.kb, r8 = lane >> 3, c4 = (lane & 7) * 4;
    if (T.rs) {
#pragma unroll
        for (int i = 0; i < 8; ++i) v[i] = v[i] * T.rs[k0 + 8 * r8 + i]; }
#pragma unroll
    for (int c = 0; c < 4; ++c) { u32x4 o; o.x = pg8::cvt_pk_bf16(v[0][c], v[1][c]); o.y = pg8::cvt_pk_bf16(v[2][c], v[3][c]); o.z = pg8::cvt_pk_bf16(v[4][c], v[5][c]); o.w = pg8::cvt_pk_bf16(v[6][c], v[7][c]);
        *(GAS u32x4*)(T.WT + (size_t)(T.dst_row0 + c4 + c) * T.K + k0 + 8 * r8) = o; }
}
__device__ __forceinline__ float lambda_init(int l) { return l == 0 ? 0.2f : (0.8f - 0.6f * 0.7408182206817179f); }

constexpr int CI_IN = 16 * 96, CI_OUT = 16 * 32, CI_UP1 = 16 * 8, CI_DN = 4 * 32, CN_UP = 32 * 2 * CI_UP1, CN_DN = 32 * CI_DN, NITEMS_L = CI_IN + CI_OUT + CN_UP + CN_DN;
__device__ __forceinline__ void fill_rowscale(Frame& F, const Args& A, int l, LAS float* rsl) {
    for (int k = F.tid; k < DM; k += 512) { float v = inp<I_MIXB>()[l * DM + k];
        if (k >= 512 && k < 768) v *= inp<I_SUBLN>()[l * 64 + ((k - 512) & 63)] * (1.f - lambda_init(l)); rsl[k] = v; }
}
__device__ __forceinline__ void convert_items(Frame& F, const Args& A, int l, int first, int stride, int limit, LAS float* rsl) {
    LAS float* scr = (LAS float*)(F.lds + F.wave * 8704);
    bf16* WIN = (bf16*)(F.ws + WS_WIN); bf16* WOUT = (bf16*)(F.ws + WS_WOUT); bf16* WUP = (bf16*)(F.ws + WS_WUP); bf16* WDN = (bf16*)(F.ws + WS_WDN);
    auto decode = [&](int it, TItem& T) {
        int r = it; T.rs = nullptr; T.mapin = 0;
        if (r < CI_IN) { T.kb = r / 96; const int nb = r % 96;
            T.W = inp<I_WIN>() + (size_t)l * DM * P_IN; T.ldw = P_IN; T.K = DM; T.WT = WIN + (size_t)l * NP * DM; T.dst_row0 = 32 * nb; T.src_n0 = 32 * nb; T.mapin = 1; return; }
        r -= CI_IN;
        if (r < CI_OUT) { T.kb = r / 32; const int nb = r % 32;
            T.W = inp<I_WOUT>() + (size_t)l * DM * DM; T.ldw = DM; T.K = DM; T.WT = WOUT + (size_t)l * DM * DM; T.dst_row0 = 32 * nb; T.src_n0 = 32 * nb; T.rs = (const float*)rsl; return; }
        r -= CI_OUT;
        if (r < CN_UP) { const int le = l * 32 + r / (2 * CI_UP1), q = r % (2 * CI_UP1), which = q / CI_UP1, q2 = q % CI_UP1; T.kb = q2 / 8; const int nb = q2 % 8;
            T.W = (which == 0 ? inp<I_W1>() : inp<I_W3>()) + (size_t)le * DM * FF; T.ldw = FF; T.K = DM; T.WT = WUP + (size_t)le * 512 * DM;
            const int n0 = 32 * nb, pn = n0 >> 7, j = n0 & 127; T.dst_row0 = 256 * pn + 128 * which + j; T.src_n0 = n0; return; }
        r -= CN_UP;
        { const int le = l * 32 + r / CI_DN, q = r % CI_DN; T.kb = q / 32; const int nb = q % 32;
          T.W = inp<I_W2>() + (size_t)le * FF * DM; T.ldw = DM; T.K = FF; T.WT = WDN + (size_t)le * DM * FF; T.dst_row0 = 32 * nb; T.src_n0 = 32 * nb; }
    };
    TItem T0, T1, T2; f32x4 v0[8], v1[8], v2[8]; int it = first;
    if (it < limit) { decode(it, T0); t_load(T0, v0, F.lane); }
    if (it + stride < limit) { decode(it + stride, T1); t_load(T1, v1, F.lane); }
    while (it < limit) {
        if (it + 2 * stride < limit) { decode(it + 2 * stride, T2); t_load(T2, v2, F.lane); }
        t_store(T0, v0, scr, F.lane); it += stride; if (it >= limit) break;
        if (it + 2 * stride < limit) { decode(it + 2 * stride, T0); t_load(T0, v0, F.lane); }
        t_store(T1, v1, scr, F.lane); it += stride; if (it >= limit) break;
        if (it + 2 * stride < limit) { decode(it + 2 * stride, T1); t_load(T1, v1, F.lane); }
        t_store(T2, v2, scr, F.lane); it += stride;
    }
}
constexpr int CV_L0 = NITEMS_L - CI_IN, CV_TOTAL = CV_L0 + NITEMS_L, CV_CHUNK = 64, CW_CVQ = 192;
__device__ __forceinline__ void convert_chunk(Frame& F, const Args& A, int gbase, LAS float* rsl2  ) {
    const int g0 = gbase + F.wave * (CV_CHUNK / NWAVES);
#pragma unroll 1
    for (int l = 0; l < 2; ++l) {
        const int lo = g0 > (l ? CV_L0 : 0) ? g0 : (l ? CV_L0 : 0), hi0 = g0 + CV_CHUNK / NWAVES, hi = hi0 < (l ? CV_TOTAL : CV_L0) ? hi0 : (l ? CV_TOTAL : CV_L0);
        if (lo < hi) { const int off = l ? -CV_L0 : CI_IN; convert_items(F, A, l, lo + off, 1, hi + off, rsl2 + l * DM); }
    }
}
__device__ __forceinline__ void convert_layer1_in_gap(Frame& F, const Args& A, int n2  ) {
    LAS float* rsl = (LAS float*)(F.lds + 8 * 8704);
    if (n2 < 0) n2 = 0; if (n2 > F.G - 32) n2 = F.G - 32;
    if (F.bx < n2) return;
    fill_rowscale(F, A, 1, rsl);
    __syncthreads();
    const int nw = (F.G - n2) * NWAVES;
    convert_items(F, A, 1, (F.bx - n2) * NWAVES + F.wave, nw, NITEMS_L, rsl);
    __syncthreads();
}

__device__ __forceinline__ void p0_prologue(Frame& F, const Args& A) {
    LAS float* rsl = (LAS float*)(F.lds + 8 * 8704);
    fill_rowscale(F, A, 0, rsl);
    __syncthreads();
    const int gw = F.vcu * NWAVES + F.wave, NGW = F.G * NWAVES;
    convert_items(F, A, 0, gw, NGW, BG_CONVERT ? CI_IN : NITEMS_L, rsl);
    if (!GAP_CONVERT && !BG_CONVERT) { __syncthreads(); fill_rowscale(F, A, 1, rsl); __syncthreads(); convert_items(F, A, 1, gw, NGW, NITEMS_L, rsl); }
    { bf16* WRH = (bf16*)(F.ws + WS_WR); bf16* WRL = WRH + 2 * 48 * DM;
      for (int i = gw * 64 + F.lane; i < 2 * 48 * DM; i += NGW * 64) { const int l = i / (48 * DM), r = i % (48 * DM), o = r >> 10, k = r & 1023;
          float w = 0.f; if (o < 4) w = inp<I_WG>()[((size_t)l * DM + k) * 4 + o]; else if (o < 36) w = inp<I_WE>()[((size_t)l * DM + k) * 32 + (o - 4)];
          const unsigned hi = f2bf(w); WRH[i] = (bf16)hi; WRL[i] = (bf16)f2bf(w - bf2f((unsigned short)hi)); } }
    if (F.bx == 0 && F.wave == 0) {
        for (int l = 0; l < 2; ++l) { float a = 0.f, b = 0.f; if (F.lane < 32) { a = inp<I_LQ1>()[l * 32 + F.lane] * inp<I_LK1>()[l * 32 + F.lane]; b = inp<I_LQ2>()[l * 32 + F.lane] * inp<I_LK2>()[l * 32 + F.lane]; }
            a = wave_sum(a); b = wave_sum(b); if (F.lane == 0) ((float*)(F.ws + WS_MISC))[l] = __expf(a) - __expf(b) + lambda_init(l); }
    }
    __syncthreads();
    LAS float* cact = (LAS float*)F.lds;
    LAS float* red = (LAS float*)(F.lds + 32768);
    for (int i = F.tid; i < BATCH * DM; i += 512) { const float c = inp<I_C>()[i]; cact[i] = c / (1.f + __expf(-c)); }
    __syncthreads();
    for (int item = F.bx; item < 2 * 96; item += F.G) {
        const int l = item / 96, nb = item % 96, n = nb * 64 + F.lane; const float* aw = inp<I_ADAW>() + (size_t)l * DM * 6144 + n;
        float acc[8];
#pragma unroll
        for (int b = 0; b < 8; ++b) acc[b] = 0.f;
        const int k0 = F.wave * 128;
#pragma unroll 32
        for (int k = 0; k < 128; ++k) { const float w = aw[(size_t)(k0 + k) * 6144];
#pragma unroll
            for (int b = 0; b < 8; ++b) acc[b] += cact[b * DM + k0 + k] * w; }
#pragma unroll
        for (int b = 0; b < 8; ++b) red[(F.wave * 8 + b) * 64 + F.lane] = acc[b];
        __syncthreads();
        { const int b = F.wave; float s = inp<I_ADAB>()[l * 6144 + n];
#pragma unroll
          for (int w = 0; w < 8; ++w) s += red[(w * 8 + b) * 64 + F.lane];
          ((float*)(F.ws + WS_MOD))[((size_t)l * 8 + b) * 6144 + n] = s; }
        __syncthreads();
    }
}

__device__ __forceinline__ void build_tables(Frame& F, int l) {
    volatile LAS int* cnts = (volatile LAS int*)(F.lds + CNTS_OFF); volatile LAS int* base = (volatile LAS int*)(F.lds + BASE_OFF); volatile LAS int* tab = (volatile LAS int*)(F.lds + TAB_OFF);
    __syncthreads();
    if (F.tid < 64) {
        const int e = F.tid; int cnt = 0; if (e < 32) cnt = (int)__hip_atomic_load(F.ctl + CW_CNT + (l * 32 + e) * 16, RLX_AGENT);
        const int n = (cnt + 255) >> 8; int incl = n;
#pragma unroll
        for (int o = 1; o < 32; o <<= 1) { const int u = shup_i(incl, o, e); if (e >= o) incl += u; }
        const int t0 = incl - n;
        if (e < 32) { cnts[e] = cnt; base[e] = t0; for (int j = 0; j < n && t0 + j < MAXTILE; ++j) tab[t0 + j] = e; }
        if (e == 31) F.MISC[1] = (unsigned)(incl < MAXTILE ? incl : MAXTILE);
    }
    __syncthreads();
}
__device__ __forceinline__ void row_pass(Frame& F, const Args& A, int mode, int l) {
    const int gw = F.vcu * NWAVES + F.wave; const int lane = F.lane;
    const float* MOD = (const float*)(F.ws + WS_MOD);
    bf16* X1 = (bf16*)(F.ws + WS_X1); bf16* H = (bf16*)(F.ws + WS_H); const bf16* Y = (const bf16*)(F.ws + WS_Y);
    const int* tok_e = (const int*)(F.ws + WS_TOK); const int* tok_pos = (const int*)(F.ws + WS_TOK) + 4 * M; const float* tok_w = (const float*)(F.ws + WS_TOK) + 2 * M;
    volatile LAS int* basel = (volatile LAS int*)(F.lds + BASE_OFF);
    if (mode != 0) build_tables(F, mode == 1 ? 0 : 1);
    const int b = (gw * 8) >> 11; const int lp = (mode == 1) ? 0 : 1;
    f32x4 g2v[4], gm[4], shv[4];
#pragma unroll
    for (int j = 0; j < 4; ++j) { const int col = 256 * j + 4 * lane;
        g2v[j] = (f32x4){0.f, 0.f, 0.f, 0.f}; gm[j] = g2v[j]; shv[j] = g2v[j];
        if (mode != 0) g2v[j] = *(const f32x4*)(MOD + ((size_t)lp * 8 + b) * 6144 + 5 * DM + col);
        if (mode != 2) { const float* md = MOD + ((size_t)l * 8 + b) * 6144; gm[j] = *(const f32x4*)(inp<I_N1G>() + l * DM + col) * (*(const f32x4*)(md + DM + col) + 1.0f); shv[j] = *(const f32x4*)(md + col); } }
    for (int m0 = gw * 8; m0 < gw * 8 + 8; m0 += 4) {
        f32x4 v[4][4]; u32x2 ya[4][4], yb[4][4]; float wa[4], wb[4];
        if (mode != 0) {
            int sa[4], sb[4];
#pragma unroll
            for (int r = 0; r < 4; ++r) { const int m = m0 + r; sa[r] = 256 * basel[tok_e[m]] + tok_pos[m]; sb[r] = 256 * basel[tok_e[M + m]] + tok_pos[M + m]; wa[r] = tok_w[m]; wb[r] = tok_w[M + m]; }
#pragma unroll
            for (int r = 0; r < 4; ++r)
#pragma unroll
                for (int j = 0; j < 4; ++j) { const int col = 256 * j + 4 * lane; ya[r][j] = *(const u32x2*)(Y + (size_t)sa[r] * DM + col); yb[r][j] = *(const u32x2*)(Y + (size_t)sb[r] * DM + col); }
        }
#pragma unroll
        for (int r = 0; r < 4; ++r) { const int m = m0 + r;
            if (mode == 0) { const float* xr = inp<I_X>() + (size_t)m * DM;
#pragma unroll
                for (int j = 0; j < 4; ++j) v[r][j] = *(const f32x4*)(xr + 256 * j + 4 * lane); }
            else { const bf16* xr = X1 + (size_t)m * DM;
#pragma unroll
                for (int j = 0; j < 4; ++j) { const u32x2 q = *(const u32x2*)(xr + 256 * j + 4 * lane); v[r][j] = (f32x4){bf2f(q.x & 0xffff), bf2f(q.x >> 16), bf2f(q.y & 0xffff), bf2f(q.y >> 16)}; } } }
#pragma unroll
        for (int r = 0; r < 4; ++r) { const int m = m0 + r;
            if (mode != 0) {
#pragma unroll
                for (int j = 0; j < 4; ++j) { const u32x2 a = ya[r][j], c = yb[r][j];
                    f32x4 mo; mo[0] = wa[r] * bf2f(a.x & 0xffff) + wb[r] * bf2f(c.x & 0xffff); mo[1] = wa[r] * bf2f(a.x >> 16) + wb[r] * bf2f(c.x >> 16);
                    mo[2] = wa[r] * bf2f(a.y & 0xffff) + wb[r] * bf2f(c.y & 0xffff); mo[3] = wa[r] * bf2f(a.y >> 16) + wb[r] * bf2f(c.y >> 16);
                    v[r][j] = v[r][j] + g2v[j] * mo; }
                if (mode == 1) {
#pragma unroll
                    for (int j = 0; j < 4; ++j) { u32x2 q; q.x = pk2(v[r][j][0], v[r][j][1]); q.y = pk2(v[r][j][2], v[r][j][3]); *(u32x2*)(X1 + (size_t)m * DM + 256 * j + 4 * lane) = q; }
                } else { float* orow = F.out + (size_t)m * DM;
#pragma unroll
                    for (int j = 0; j < 4; ++j) *(f32x4*)(orow + 256 * j + 4 * lane) = v[r][j]; }
            }
            if (mode != 2) {
                float ss = 0.f;
#pragma unroll
                for (int j = 0; j < 4; ++j) ss += (v[r][j][0] * v[r][j][0] + v[r][j][1] * v[r][j][1]) + (v[r][j][2] * v[r][j][2] + v[r][j][3] * v[r][j][3]);
                const float rstd = 1.0f / sqrtf(wave_sum(ss) * (1.f / DM) + RMS_EPS);
#pragma unroll
                for (int j = 0; j < 4; ++j) { const f32x4 hv = v[r][j] * rstd * gm[j] + shv[j]; u32x2 w; w.x = pk2(hv[0], hv[1]); w.y = pk2(hv[2], hv[3]);
                    *(u32x2*)(H + (size_t)m * DM + 256 * j + 4 * lane) = w; }
            }
        }
    }
}

__device__ __forceinline__ void knorm_seg(bf16* p, int lane, int nlanes_active, int group_lanes, const float* gain, int gmask, float inv_n) {
    u32x2 raw = (u32x2){0u, 0u}; if (lane < nlanes_active) raw = *(const u32x2*)(p + 4 * lane);
    float x0 = bf2f(raw.x & 0xffff), x1 = bf2f(raw.x >> 16), x2 = bf2f(raw.y & 0xffff), x3 = bf2f(raw.y >> 16);
    float ss = (x0 * x0 + x1 * x1) + (x2 * x2 + x3 * x3);
    for (int o = 1; o < group_lanes; o <<= 1) ss += __shfl_xor(ss, o);
    const float rstd = 1.0f / sqrtf(ss * inv_n + RMS_EPS);
    const int c = (4 * lane) & gmask;
    x0 *= rstd * gain[c]; x1 *= rstd * gain[c + 1]; x2 *= rstd * gain[c + 2]; x3 *= rstd * gain[c + 3];
    if (lane < nlanes_active) { u32x2 w; w.x = pk2(x0, x1); w.y = pk2(x2, x3); *(u32x2*)(p + 4 * lane) = w; }
}
__device__ __forceinline__ unsigned sortable(float f) { const unsigned u = __builtin_bit_cast(unsigned, f); return (u & 0x80000000u) ? ~u : (u | 0x80000000u); }


__device__ __forceinline__ int wave_sum_i(int v) {
    v += __builtin_amdgcn_update_dpp(0, v, 0xB1, 0xF, 0xF, true);
    v += __builtin_amdgcn_update_dpp(0, v, 0x4E, 0xF, 0xF, true);
    v += __builtin_amdgcn_update_dpp(0, v, 0x141, 0xF, 0xF, true);
    v += __builtin_amdgcn_update_dpp(0, v, 0x140, 0xF, 0xF, true);
    return __builtin_amdgcn_readlane(v, 0) + __builtin_amdgcn_readlane(v, 16) + __builtin_amdgcn_readlane(v, 32) + __builtin_amdgcn_readlane(v, 48);
}
__device__ __forceinline__ void transpose32(unsigned (&a)[32]) {
#define TSTAGE(S, MSK) _Pragma("unroll") for (int i = 0; i < 32; ++i) if (!(i & S)) { const unsigned x = a[i], y = a[i + S]; a[i] = (x & MSK) | ((y << S) & ~MSK); a[i + S] = ((x >> S) & MSK) | (y & ~MSK); }
    TSTAGE(16, 0x0000FFFFu) TSTAGE(8, 0x00FF00FFu) TSTAGE(4, 0x0F0F0F0Fu) TSTAGE(2, 0x33333333u) TSTAGE(1, 0x55555555u)
#undef TSTAGE
}
__device__ __forceinline__ void sel_step(unsigned T, unsigned& cand, unsigned& above, int& na, int& nc, bool& done, bool& exact) {
    const unsigned ones = cand & T; const int s1 = wave_sum_i(__builtin_popcount(ones));
    if (na + s1 >= 256) { cand = ones; nc = s1; }
    else { above |= ones; na += s1; cand &= ~T; nc -= s1; }
    if (na + nc == 256) { done = true; exact = true; }
}
__device__ __forceinline__ unsigned sel_finish(unsigned cand, unsigned above, int na, bool exact, int lane) {
    if (exact) return above | cand;
    const int need = 256 - na; const int pc = __builtin_popcount(cand); int incl = pc;
#pragma unroll
    for (int o = 1; o < 64; o <<= 1) { const int t = shup_i(incl, o, lane); if (lane >= o) incl += t; }
    int take = need - (incl - pc); take = take < 0 ? 0 : (take > pc ? pc : take);
    unsigned w = cand, res = above;
    for (int k = 0; k < take; ++k) { const unsigned low = w & (0u - w); res |= low; w ^= low; }
    return res;
}

__device__ __forceinline__ void p3_prep(Frame& F, const Args& A, int l, int rep) {
    const int gw = F.vcu * NWAVES + F.wave, NGW = F.G * NWAVES;
    bf16* PROJ = (bf16*)(F.ws + WS_PROJ);
    if (!(rep > 0 && PROBE_P3_PART == 2)) { const float* ga = inp<I_KNA>() + l * 64; const float* gc = inp<I_KNC>() + l * 32; const float* gd = inp<I_KND>() + l * 64;
      const int la = F.lane; const int ca = (4 * la) & 63, cc = (4 * la) & 31;
      const f32x4 gva = *(const f32x4*)(ga + ca), gvc = *(const f32x4*)(gc + cc), gvd = *(const f32x4*)(gd + ca);
      for (int mb = gw * 8; mb < gw * 8 + 8; mb += 8) {
        u32x2 ra[8], rc[8], rd[8];
#pragma unroll
        for (int i = 0; i < 8; ++i) { bf16* row = PROJ + (size_t)(mb + i) * NP; ra[i] = *(const u32x2*)(row + C_AK + 4 * la); rc[i] = *(const u32x2*)(row + C_CK + 4 * la);
            rd[i] = (u32x2){0u, 0u}; if (la < 16) rd[i] = *(const u32x2*)(row + C_DK + 4 * la); }
#pragma unroll
        for (int i = 0; i < 8; ++i) { bf16* row = PROJ + (size_t)(mb + i) * NP;
            { float x0 = bf2f(ra[i].x & 0xffff), x1 = bf2f(ra[i].x >> 16), x2 = bf2f(ra[i].y & 0xffff), x3 = bf2f(ra[i].y >> 16); float ss = (x0 * x0 + x1 * x1) + (x2 * x2 + x3 * x3);
              ss += shx<1>(ss); ss += shx<2>(ss); ss += shx<4>(ss); ss += shx<8>(ss); const float rs = 1.0f / sqrtf(ss * (1.f / 64.f) + RMS_EPS);
              u32x2 w; w.x = pk2(x0 * rs * gva[0], x1 * rs * gva[1]); w.y = pk2(x2 * rs * gva[2], x3 * rs * gva[3]); *(u32x2*)(row + C_AK + 4 * la) = w; }
            { float x0 = bf2f(rc[i].x & 0xffff), x1 = bf2f(rc[i].x >> 16), x2 = bf2f(rc[i].y & 0xffff), x3 = bf2f(rc[i].y >> 16); float ss = (x0 * x0 + x1 * x1) + (x2 * x2 + x3 * x3);
              ss += shx<1>(ss); ss += shx<2>(ss); ss += shx<4>(ss); const float rs = 1.0f / sqrtf(ss * (1.f / 32.f) + RMS_EPS);
              u32x2 w; w.x = pk2(x0 * rs * gvc[0], x1 * rs * gvc[1]); w.y = pk2(x2 * rs * gvc[2], x3 * rs * gvc[3]); *(u32x2*)(row + C_CK + 4 * la) = w; }
            { float x0 = bf2f(rd[i].x & 0xffff), x1 = bf2f(rd[i].x >> 16), x2 = bf2f(rd[i].y & 0xffff), x3 = bf2f(rd[i].y >> 16); float ss = (x0 * x0 + x1 * x1) + (x2 * x2 + x3 * x3);
              ss += shx<1>(ss); ss += shx<2>(ss); ss += shx<4>(ss); ss += shx<8>(ss); const float rs = 1.0f / sqrtf(ss * (1.f / 64.f) + RMS_EPS);
              u32x2 w; w.x = pk2(x0 * rs * gvd[0], x1 * rs * gvd[1]); w.y = pk2(x2 * rs * gvd[2], x3 * rs * gvd[3]); if (la < 16) *(u32x2*)(row + C_DK + 4 * la) = w; }
        }
      }
    }
    if (!(rep > 0 && PROBE_P3_PART == 2)) {
        const int bh = gw >> 6, ck = gw & 63, b = bh >> 2, h = bh & 3; const float bfv = inp<I_BF>()[l * 4 + h];
        const int t = 32 * ck + (F.lane & 31);
        const float x = bf2f(PROJ[((size_t)b * SEQ + t) * NP + C_AF + h]) + bfv;
        float incl = fminf(x, 0.f) - log1pf(__expf(-fabsf(x)));
#pragma unroll
        for (int o = 1; o < 32; o <<= 1) { const float u = shup(incl, o, F.lane); if ((F.lane & 31) >= o) incl += u; }
        float* cum = (float*)(F.ws + WS_CUM);
        if (F.lane < 32) cum[(size_t)bh * SEQ + t] = incl;
        if (F.lane == 31) cum[32 * SEQ + bh * 64 + ck] = incl;
    }
    LAS float* sc = (LAS float*)F.lds;
    unsigned* MASK = (unsigned*)(F.ws + WS_MASK);
    constexpr int SCP = 2052;
    const int lane = F.lane, kq = lane >> 4, qi = lane & 15;
    __syncthreads();
    bf16x8 bq[8], wvr, akv[16];
    const auto unit_geom = [&](int i, int& b, int& t0, int& nkt) { const int u = F.bx + 256 * i; b = u >> 7; const int tqr = u & 127, tq = (i & 1) ? 127 - tqr : tqr; t0 = tq * 16; nkt = tq + 1; };
    const auto unit_load_q = [&](int i) { int b, t0, nkt; unit_geom(i, b, t0, nkt); const bf16* qrow = PROJ + (size_t)b * SEQ * NP + (size_t)(t0 + qi) * NP;
#pragma unroll
        for (int h = 0; h < 8; ++h) bq[h] = *(const bf16x8*)(qrow + C_IQ + h * 32 + 8 * kq);
        wvr = *(const bf16x8*)(qrow + C_IW); };
    const auto unit_load_k = [&](int i) { int b, t0, nkt; unit_geom(i, b, t0, nkt); const bf16* pb = PROJ + (size_t)b * SEQ * NP;
#pragma unroll
        for (int j = 0; j < 16; ++j) { const int kt = F.wave + 8 * j; akv[j] = (bf16x8){0, 0, 0, 0, 0, 0, 0, 0}; if (kt < nkt) akv[j] = *(const bf16x8*)(pb + (size_t)(kt * 16 + qi) * NP + C_IK + 8 * kq); } };
    const bool do_c = !(rep > 0 && PROBE_P3_PART == 1);
    if (do_c) unit_load_q(0);
    for (int i = 0; i < 4; ++i) {
        if (!do_c) break;
        int b, t0, nkt; unit_geom(i, b, t0, nkt);
        unit_load_k(i);
        float wq[8];
#pragma unroll
        for (int h = 0; h < 8; ++h) wq[h] = bf2f((unsigned short)wvr[h]) * (0.35355339059327373f * 0.17677669529663687f);
#pragma unroll
        for (int j = 0; j < 16; ++j) { const int kt = F.wave + 8 * j;
            if (kt < nkt) {
            f32x4 a4 = (f32x4){0.f, 0.f, 0.f, 0.f};
#pragma unroll
            for (int h = 0; h < 8; ++h) { const f32x4 s = __builtin_amdgcn_mfma_f32_16x16x32_bf16(akv[j], bq[h], (f32x4){0.f, 0.f, 0.f, 0.f}, 0, 0, 0);
#pragma unroll
                for (int r = 0; r < 4; ++r) a4[r] += wq[h] * fmaxf(s[r], 0.f); }
#pragma unroll
            for (int r = 0; r < 4; ++r) a4[r] += 0.f;
            { const int ci = kt * 4 + kq, L = ci >> 3, c = ci & 7;
              *(LAS f32x4*)(sc + qi * SCP + 4 * (L * 8 + (c ^ (L & 7)))) = a4; }
            } }
        if (i + 1 < 4) unit_load_q(i + 1);
        LDS_WAIT(); __syncthreads();
        if (rep > 0 && PROBE_P3_PART == 2) { }
        else if (t0 < 256) {
            for (int rr = 0; rr < 2; ++rr) { const int t = t0 + 2 * F.wave + rr; const int nb = t - 32 * lane + 1;
                MASK[((size_t)b * SEQ + t) * 64 + lane] = nb >= 32 ? 0xffffffffu : (nb <= 0 ? 0u : ((1u << nb) - 1u)); }
        } else {
            const int rA = 2 * F.wave, tA = t0 + rA, tB = tA + 1;
            unsigned ua[32], ub[32];
#pragma unroll
            for (int c = 0; c < 8; ++c) { const int off = 4 * (lane * 8 + (c ^ (lane & 7)));
                const f32x4 fa = *(const LAS f32x4*)(sc + rA * SCP + off), fb = *(const LAS f32x4*)(sc + (rA + 1) * SCP + off);
#pragma unroll
                for (int i = 0; i < 4; ++i) { ua[c * 4 + i] = sortable(fa[i]); ub[c * 4 + i] = sortable(fb[i]); } }
            transpose32(ua); transpose32(ub);
            unsigned candA, candB, abA = 0u, abB = 0u; int naA = 0, naB = 0, ncA = tA + 1, ncB = tB + 1; bool dA = false, dB = false, eA = false, eB = false;
            { const int nbA = tA - 32 * lane + 1, nbB = tB - 32 * lane + 1;
              candA = nbA >= 32 ? 0xffffffffu : (nbA <= 0 ? 0u : ((1u << nbA) - 1u)); candB = nbB >= 32 ? 0xffffffffu : (nbB <= 0 ? 0u : ((1u << nbB) - 1u)); }
#pragma unroll
            for (int bit = 31; bit >= 0; --bit) {
                if (!dA) sel_step(ua[bit], candA, abA, naA, ncA, dA, eA);
                if (!dB) sel_step(ub[bit], candB, abB, naB, ncB, dB, eB);
                if (dA && dB) break;
            }
            MASK[((size_t)b * SEQ + tA) * 64 + lane] = sel_finish(candA, abA, naA, eA, lane);
            MASK[((size_t)b * SEQ + tB) * 64 + lane] = sel_finish(candB, abB, naB, eB, lane);
        }
        __syncthreads();
    }
}

namespace att {
template <bool B> struct BoolC { static constexpr bool value = B; };
constexpr int SLOTB = 8192, L_K = 0, L_V = 3 * SLOTB, L_WS = 6 * SLOTB, L_OST = L_WS + 2048, L_CUM = L_OST + 8 * 8192, L_END = L_CUM + 8192;
constexpr int MROW = 66;
static_assert(L_OST + 256 * MROW * 4 <= L_END && L_END <= RING_BYTES, "attention LDS map");
constexpr float THR = 8.0f;
__device__ __forceinline__ int crow(int r, int hi) { return (r & 3) + 8 * (r >> 2) + 4 * hi; }
__device__ __forceinline__ void glds16(const void* gsrc, unsigned lds_dst) { unsigned keep;
    asm volatile("s_mov_b32 %0, m0\n\ts_mov_b32 m0, %2\n\ts_nop 0\n\tglobal_load_lds_dwordx4 %1, off\n\ts_mov_b32 m0, %0" : "=&s"(keep) : "v"(gsrc), "s"(lds_dst) : "memory"); }
#define ATT_WAIT_BAR() asm volatile("s_waitcnt vmcnt(0) lgkmcnt(0)\n\ts_barrier" ::: "memory")
__device__ __forceinline__ unsigned cvtpk_s(float lo, float hi) { typedef __bf16 bf16x2_t __attribute__((ext_vector_type(2))); f32x2 v = {lo, hi}; bf16x2_t b = __builtin_convertvector(v, bf16x2_t); return __builtin_bit_cast(unsigned, b); }
__device__ __forceinline__ float xhalf(float x, int hi) { auto rr = __builtin_amdgcn_permlane32_swap(__builtin_bit_cast(unsigned, x), __builtin_bit_cast(unsigned, x), false, false);
    return __builtin_bit_cast(float, hi ? rr[0] : rr[1]); }
template <int DA, int DB>
__device__ __forceinline__ void qkt(f32x16& p0, f32x16& p1, const LAS char* Kslot, const bf16x8* qr, const f32x16& cin, int r32, int hi) {
    const LAS char* kb = Kslot + hi * 1024 + r32 * 16;
#pragma unroll
    for (int d0 = DA; d0 < DB; ++d0) {
        const bf16x8 b0 = *(const LAS bf16x8*)(kb + d0 * 2048), b1 = *(const LAS bf16x8*)(kb + d0 * 2048 + 512);
        if (d0 == DA) { p0 = __builtin_amdgcn_mfma_f32_32x32x16_bf16(b0, qr[d0], cin, 0, 0, 0); p1 = __builtin_amdgcn_mfma_f32_32x32x16_bf16(b1, qr[d0], cin, 0, 0, 0); }
        else { p0 = __builtin_amdgcn_mfma_f32_32x32x16_bf16(b0, qr[d0], p0, 0, 0, 0); p1 = __builtin_amdgcn_mfma_f32_32x32x16_bf16(b1, qr[d0], p1, 0, 0, 0); } }
}
__device__ __forceinline__ void pv(f32x16* o, int vb, bf16x8 pa0, bf16x8 pa1, bf16x8 pa2, bf16x8 pa3) {
    s16x4 lo[2][4], hi[2][4];
#pragma unroll
    for (int d0 = 0; d0 < 2; ++d0)
#pragma unroll
        for (int ks = 0; ks < 4; ++ks) {
            asm volatile("ds_read_b64_tr_b16 %0,%1 offset:%c2" : "=&v"(lo[d0][ks]) : "v"(vb), "i"(d0 * 4096 + ks * 1024) : "memory");
            asm volatile("ds_read_b64_tr_b16 %0,%1 offset:%c2" : "=&v"(hi[d0][ks]) : "v"(vb), "i"(d0 * 4096 + ks * 1024 + 512) : "memory"); }
    asm volatile("s_waitcnt lgkmcnt(0)" ::: "memory"); __builtin_amdgcn_sched_barrier(0);
#define PK(d, k) (bf16x8){lo[d][k][0], lo[d][k][1], lo[d][k][2], lo[d][k][3], hi[d][k][0], hi[d][k][1], hi[d][k][2], hi[d][k][3]}
    o[0] = __builtin_amdgcn_mfma_f32_32x32x16_bf16(pa0, PK(0, 0), o[0], 0, 0, 0); o[1] = __builtin_amdgcn_mfma_f32_32x32x16_bf16(pa0, PK(1, 0), o[1], 0, 0, 0);
    o[0] = __builtin_amdgcn_mfma_f32_32x32x16_bf16(pa1, PK(0, 1), o[0], 0, 0, 0); o[1] = __builtin_amdgcn_mfma_f32_32x32x16_bf16(pa1, PK(1, 1), o[1], 0, 0, 0);
    o[0] = __builtin_amdgcn_mfma_f32_32x32x16_bf16(pa2, PK(0, 2), o[0], 0, 0, 0); o[1] = __builtin_amdgcn_mfma_f32_32x32x16_bf16(pa2, PK(1, 2), o[1], 0, 0, 0);
    o[0] = __builtin_amdgcn_mfma_f32_32x32x16_bf16(pa3, PK(0, 3), o[0], 0, 0, 0); o[1] = __builtin_amdgcn_mfma_f32_32x32x16_bf16(pa3, PK(1, 3), o[1], 0, 0, 0);
#undef PK
}
__device__ __forceinline__ float rowmax(const f32x16& p0, const f32x16& p1, int hi) {
    float a = fmaxf(fmaxf(p0[0], p0[1]), p1[0]), b = fmaxf(fmaxf(p0[2], p0[3]), p1[1]); a = fmaxf(fmaxf(a, p1[2]), p1[3]);
#pragma unroll
    for (int r = 4; r < 16; r += 4) { a = fmaxf(fmaxf(a, p0[r]), p0[r + 1]); b = fmaxf(fmaxf(b, p0[r + 2]), p0[r + 3]); a = fmaxf(fmaxf(a, p1[r]), p1[r + 1]); b = fmaxf(fmaxf(b, p1[r + 2]), p1[r + 3]); }
    const float m = fmaxf(a, b); return fmaxf(m, xhalf(m, hi));
}
struct AttnP { const bf16* proj; bf16* mix; const float* cum; const unsigned* mask; const float* qgain[4]; const float* kgain[4]; float lam; };

template <int VAR>
__device__ __forceinline__ void attn_unit(const AttnP& P, int b, int h, int qb, LAS char* sh, const int tid_in, const int pm, unsigned* qctr, volatile LAS unsigned* qslot) {
    int tid = tid_in; asm volatile("" : "+v"(tid));
    const int lane = tid & 63, r32 = lane & 31, hi = lane >> 5; const int wid = __builtin_amdgcn_readfirstlane(tid >> 6);
    const long rowbase = (long)b * SEQ; const int q0 = qb * 256, NT = 4 * (qb + 1);
    const int qrel = wid * 32 + r32, tq = q0 + qrel;
    constexpr bool REV = VAR != 0;
    constexpr int QCB = VAR == 0 ? C_AQ : VAR == 1 ? C_BQ : VAR == 2 ? C_CQ : C_DQ;
    constexpr int KCB = VAR == 0 ? C_AK : VAR == 1 ? C_BK : VAR == 2 ? C_CK : C_DK;
    constexpr int VCB = VAR == 0 ? C_AV : VAR == 1 ? C_BV : VAR == 2 ? C_CV : C_DV;
    const int Qc = QCB + 64 * h, Kc = VAR == 3 ? KCB : KCB + 64 * h, Vc = VAR == 3 ? VCB : VCB + 64 * h;
    const bf16* PR = P.proj;
    LAS float* wsf = (LAS float*)(sh + L_WS) + wid * 64;
    LAS float* stg = (LAS float*)(sh + L_OST) + wid * 2048;
    LAS float* cumL = (LAS float*)(sh + L_CUM);
    LAS unsigned* maskL = (LAS unsigned*)(sh + L_OST);
    const unsigned lds0 = (unsigned)(uintptr_t)sh;
    const bf16* ksrc = PR + (size_t)(rowbase + lane) * NP + Kc + wid * 8;
    const bf16* vsrc = PR + (size_t)(rowbase + 16 * (wid & 3) + (lane >> 2)) * NP + Vc + (wid >> 2) * 32 + (lane & 3) * 8;
    const unsigned kdst = lds0 + L_K + wid * 1024, vdst = lds0 + L_V + wid * 1024;
#define DMA_KV(t, slot) do { glds16(ksrc + (size_t)(t) * 64 * NP, (unsigned)__builtin_amdgcn_readfirstlane(kdst + (slot))); glds16(vsrc + (size_t)(t) * 64 * NP, (unsigned)__builtin_amdgcn_readfirstlane(vdst + (slot))); } while (0)
    DMA_KV(REV ? NT - 1 : 0, 0); DMA_KV(REV ? NT - 2 : 1, SLOTB);
    if (VAR == 0) {
        LAS float* pref = (LAS float*)(sh + L_WS);
        if (tid < 64) { const float ct = P.cum[32 * SEQ + (b * 4 + h) * 64 + tid]; float incl = ct;
#pragma unroll
            for (int o = 1; o < 64; o <<= 1) { const float u = shup(incl, o, tid); if (tid >= o) incl += u; }
            pref[tid] = incl - ct; }
        asm volatile("s_waitcnt lgkmcnt(0)\n\ts_barrier" ::: "memory");
        const float* cg = P.cum + (size_t)(b * 4 + h) * SEQ; for (int i = tid; i < q0 + 256; i += 512) cumL[i] = (cg[i] + pref[i >> 5]) * LOG2E;
        asm volatile("s_waitcnt lgkmcnt(0)\n\ts_barrier" ::: "memory");
    }
    if (VAR == 3) { const unsigned* mg = P.mask + (size_t)(rowbase + q0) * 64; const int nw = 2 * NT;
#pragma unroll 8
        for (int i = tid; i < 256 * 32; i += 512) { const int row = i >> 5, w = 2 * (i & 31); if (w < nw) *(LAS u32x2*)(maskL + row * MROW + w) = *(const u32x2*)(mg + row * 64 + w); } }
    asm volatile("s_waitcnt vmcnt(0) lgkmcnt(0)\n\ts_barrier" ::: "memory");
    const int vb0 = (int)(lds0 + L_V) + ((lane >> 4) & 1) * 32 + (lane & 3) * 8 + (4 * hi + ((lane & 15) >> 2)) * 64;
    float slope2 = 0.f;
    if (VAR == 2) slope2 = __builtin_amdgcn_exp2f(-(float)(2 * h + 1)) * LOG2E;
    if (VAR == 3) slope2 = __builtin_amdgcn_exp2f(-(float)(2 * h + 2)) * LOG2E;
    float cumt = 0.f; if (VAR == 0) cumt = cumL[tq];
    constexpr int NPASS = VAR == 2 ? 2 : 1;
    unsigned nxt_u = 0u;
    for (int pass = 0; pass < NPASS; ++pass) {
        bf16x8 qa[4]; float sb0 = 0.f;
        { const bf16* Qw = PR + (size_t)(rowbase + tq) * NP + Qc;
          constexpr int ND0 = VAR == 2 ? 2 : 4; const int dbase = VAR == 2 ? 2 * pass : 0;
          float qf[8 * ND0];
#pragma unroll
          for (int d0 = 0; d0 < ND0; ++d0) { const bf16x8 raw = *(const bf16x8*)(Qw + (dbase + d0) * 16 + hi * 8);
#pragma unroll
              for (int j = 0; j < 8; ++j) qf[d0 * 8 + j] = bf2f((unsigned short)raw[j]); }
          constexpr float SC = (VAR == 2 ? 0.17677669529663687f : 0.125f) * LOG2E;
          if (VAR != 1) {
              float ss = 0.f;
#pragma unroll
              for (int i = 0; i < 8 * ND0; ++i) ss += qf[i] * qf[i];
              ss += xhalf(ss, hi); const float rstd = 1.0f / sqrtf(ss * (VAR == 2 ? 1.f / 32.f : 1.f / 64.f) + RMS_EPS);
              const float* g = P.qgain[VAR];
#pragma unroll
              for (int d0 = 0; d0 < ND0; ++d0)
#pragma unroll
                  for (int j = 0; j < 8; ++j) qf[d0 * 8 + j] *= rstd * g[16 * d0 + 8 * hi + j] * SC;
          } else {
#pragma unroll
              for (int i = 0; i < 8 * ND0; ++i) qf[i] *= SC;
          }
          if (VAR == 2 || VAR == 3) {
              float n0 = 0.f;
#pragma unroll
              for (int i = 0; i < 8 * ND0; ++i) n0 += qf[i] * qf[i];
              n0 += xhalf(n0, hi);
              float gk = fabsf(P.kgain[VAR][lane & (VAR == 2 ? 31 : 63)]);
              gk = fmaxf(gk, shx<1>(gk)); gk = fmaxf(gk, shx<2>(gk)); gk = fmaxf(gk, shx<4>(gk)); gk = fmaxf(gk, shx<8>(gk)); gk = fmaxf(gk, shx<16>(gk)); gk = half_max(gk);
              sb0 = 1.02f * sqrtf(n0) * (VAR == 2 ? 5.656854249f : 8.0f) * gk;
          }
#pragma unroll
          for (int d0 = 0; d0 < ND0; ++d0) { u32x4 w; w.x = cvtpk_s(qf[d0 * 8 + 0], qf[d0 * 8 + 1]); w.y = cvtpk_s(qf[d0 * 8 + 2], qf[d0 * 8 + 3]); w.z = cvtpk_s(qf[d0 * 8 + 4], qf[d0 * 8 + 5]); w.w = cvtpk_s(qf[d0 * 8 + 6], qf[d0 * 8 + 7]);
              qa[d0] = __builtin_bit_cast(bf16x8, w); }
          if (VAR == 2) { qa[2] = qa[0]; qa[3] = qa[1]; }
        }
        float mhat = -1e30f, l_reg = 0.f, Rp = 1.f; f32x16 o[2]; const float sbound = sb0;
#pragma unroll
        for (int r = 0; r < 16; ++r) { o[0][r] = 0.f; o[1][r] = 0.f; }
        if (pass > 0) { DMA_KV(REV ? NT - 1 : 0, 0); DMA_KV(REV ? NT - 2 : 1, SLOTB); }
        int cur = 0, sl1 = SLOTB, sl2 = 2 * SLOTB;
        auto step = [&](auto band_c, const int it) -> bool {
            constexpr bool BAND = decltype(band_c)::value;
            const int t = REV ? NT - 1 - it : it;
            if (pm == 7) { }
            else if (it + 1 < NT) asm volatile("s_waitcnt vmcnt(2) lgkmcnt(0)\n\ts_barrier" ::: "memory");
            else ATT_WAIT_BAR();
            if (REV && it > 0) {
                const LAS unsigned* wz = (const LAS unsigned*)(sh + L_END) + ((it - 1) & 1) * 8;
                const u32x4 z0 = *(const LAS u32x4*)wz, z1 = *(const LAS u32x4*)(wz + 4);
                if (__builtin_amdgcn_readfirstlane((int)(z0.x & z0.y & z0.z & z0.w & z1.x & z1.y & z1.z & z1.w)) != 0) return true;
            }
            if (it + 2 < NT && pm != 7) DMA_KV(REV ? t - 2 : t + 2, sl2);
            const int jb = t - (NT - 4);
            float cinv = 0.f;
            if (VAR == 0) cinv = cumt;
            if (VAR == 2 || VAR == 3) cinv = slope2 * (float)(t * 64 + 4 * hi - tq);
            f32x16 cin;
#pragma unroll
            for (int r = 0; r < 16; ++r) cin[r] = cinv;
            f32x16 p0, p1;
            const LAS char* Ks = sh + L_K + cur;
            if (VAR == 2) { if (pass == 0) { const bf16x8 qq[4] = {qa[0], qa[1], qa[0], qa[1]}; qkt<0, 2>(p0, p1, Ks, qq, cin, r32, hi); }
                            else { const bf16x8 qq[4] = {qa[0], qa[1], qa[0], qa[1]}; qkt<2, 4>(p0, p1, Ks, qq, cin, r32, hi); } }
            else qkt<0, 4>(p0, p1, Ks, qa, cin, r32, hi);
            if (VAR != 1) {
                if (VAR == 0) { const LAS float* cp = cumL + t * 64 + 4 * hi;
#pragma unroll
                    for (int g = 0; g < 4; ++g) { const f32x4 c0 = *(const LAS f32x4*)(cp + 8 * g), c1 = *(const LAS f32x4*)(cp + 32 + 8 * g);
#pragma unroll
                        for (int i = 0; i < 4; ++i) { p0[4 * g + i] -= c0[i]; p1[4 * g + i] -= c1[i]; } } }
                if (VAR == 2 || VAR == 3) {
#pragma unroll
                    for (int r = 0; r < 16; ++r) { const float kc = (float)((r & 3) + 8 * (r >> 2)); p0[r] += slope2 * kc; p1[r] += slope2 * (kc + 32.f); } }
                if (VAR != 3) { if constexpr (BAND) { const int kb = 64 * jb + 4 * hi;
#pragma unroll
                    for (int r = 0; r < 16; ++r) { const int kv = kb + (r & 3) + 8 * (r >> 2); if (kv > qrel) p0[r] = -INFINITY; if (kv + 32 > qrel) p1[r] = -INFINITY; } } }
                else { const u32x2 mw = *(const LAS u32x2*)(maskL + qrel * MROW + 2 * t); const unsigned w0 = mw.x >> (4 * hi), w1 = mw.y >> (4 * hi);
#pragma unroll
                    for (int r = 0; r < 16; ++r) { const int c = (r & 3) + 8 * (r >> 2); if (!((w0 >> c) & 1u)) p0[r] = -INFINITY; if (!((w1 >> c) & 1u)) p1[r] = -INFINITY; } }
                const float rm = rowmax(p0, p1, hi);
                if (__any(rm - mhat > THR)) {
                    const float mn = fmaxf(mhat, rm); const float f = __builtin_amdgcn_exp2f(mhat - mn); mhat = mn; l_reg *= f;
                    if (hi == 0) wsf[r32] = f;
#pragma unroll
                    for (int r = 0; r < 16; ++r) { const float fr = wsf[crow(r, hi)]; o[0][r] *= fr; o[1][r] *= fr; }
                }
                float sa4[4] = {0.f, 0.f, 0.f, 0.f};
#pragma unroll
                for (int r = 0; r < 16; ++r) { p0[r] = __builtin_amdgcn_exp2f(p0[r] - mhat); p1[r] = __builtin_amdgcn_exp2f(p1[r] - mhat); sa4[r & 3] += p0[r] + p1[r]; }
                l_reg += (sa4[0] + sa4[1]) + (sa4[2] + sa4[3]);
                if (VAR == 2 || VAR == 3) {
                    const float ub = sbound - slope2 * (float)(tq - 64 * t + 1) - mhat;
                    const bool dead = __all(ub < -150.f); if (lane == 0) ((LAS unsigned*)(sh + L_END))[(it & 1) * 8 + wid] = dead ? 1u : 0u;
                }
            } else {
                f32x16 m0, m1;
#pragma unroll
                for (int r = 0; r < 16; ++r) {
                    { const float s = __builtin_amdgcn_fmed3f(p0[r], -64.f, 64.f); const float e = __builtin_amdgcn_exp2f(-s); const float bt = __builtin_amdgcn_rcpf(1.f + e); p0[r] = bt; m0[r] = e * bt; }
                    { const float s = __builtin_amdgcn_fmed3f(p1[r], -64.f, 64.f); const float e = __builtin_amdgcn_exp2f(-s); const float bt = __builtin_amdgcn_rcpf(1.f + e); p1[r] = bt; m1[r] = e * bt; } }
                if constexpr (BAND) { const int kb = 64 * jb + 4 * hi;
#pragma unroll
                    for (int r = 0; r < 16; ++r) { const int kv = kb + (r & 3) + 8 * (r >> 2);
                        if (kv >= qrel) { p0[r] = 0.f; m0[r] = 1.f; } if (kv + 32 >= qrel) { p1[r] = 0.f; m1[r] = 1.f; } } }
                float gp[8], gq[8], ex[8];
#pragma unroll
                for (int g = 0; g < 4; ++g) { gp[g] = (m0[4 * g] * m0[4 * g + 1]) * (m0[4 * g + 2] * m0[4 * g + 3]); gp[4 + g] = (m1[4 * g] * m1[4 * g + 1]) * (m1[4 * g + 2] * m1[4 * g + 3]); }
#pragma unroll
                for (int g = 0; g < 8; ++g) gq[g] = xhalf(gp[g], hi);
                float sp = Rp;
#pragma unroll
                for (int g = 7; g >= 0; --g) { ex[g] = hi ? sp : sp * gq[g]; sp *= gp[g] * gq[g]; }
                Rp = sp;
                { const bool allz = !__any(Rp != 0.f); if (lane == 0) ((LAS unsigned*)(sh + L_END))[(it & 1) * 8 + wid] = allz ? 1u : 0u; }
#pragma unroll
                for (int g = 0; g < 4; ++g) {
                    { float c = ex[g]; const float w3 = p0[4 * g + 3] * c; c *= m0[4 * g + 3]; const float w2 = p0[4 * g + 2] * c; c *= m0[4 * g + 2]; const float w1 = p0[4 * g + 1] * c; c *= m0[4 * g + 1]; const float w0 = p0[4 * g] * c;
                      p0[4 * g] = w0; p0[4 * g + 1] = w1; p0[4 * g + 2] = w2; p0[4 * g + 3] = w3; }
                    { float c = ex[4 + g]; const float w3 = p1[4 * g + 3] * c; c *= m1[4 * g + 3]; const float w2 = p1[4 * g + 2] * c; c *= m1[4 * g + 2]; const float w1 = p1[4 * g + 1] * c; c *= m1[4 * g + 1]; const float w0 = p1[4 * g] * c;
                      p1[4 * g] = w0; p1[4 * g + 1] = w1; p1[4 * g + 2] = w2; p1[4 * g + 3] = w3; } }
            }
            u32x4 pw0, pw1, pw2, pw3;
            pw0 = (u32x4){cvtpk_s(p0[0], p0[1]), cvtpk_s(p0[2], p0[3]), cvtpk_s(p0[4], p0[5]), cvtpk_s(p0[6], p0[7])};
            pw1 = (u32x4){cvtpk_s(p0[8], p0[9]), cvtpk_s(p0[10], p0[11]), cvtpk_s(p0[12], p0[13]), cvtpk_s(p0[14], p0[15])};
            pw2 = (u32x4){cvtpk_s(p1[0], p1[1]), cvtpk_s(p1[2], p1[3]), cvtpk_s(p1[4], p1[5]), cvtpk_s(p1[6], p1[7])};
            pw3 = (u32x4){cvtpk_s(p1[8], p1[9]), cvtpk_s(p1[10], p1[11]), cvtpk_s(p1[12], p1[13]), cvtpk_s(p1[14], p1[15])};
            pv(o, vb0 + cur, __builtin_bit_cast(bf16x8, pw0), __builtin_bit_cast(bf16x8, pw1), __builtin_bit_cast(bf16x8, pw2), __builtin_bit_cast(bf16x8, pw3));
            { const int tmp = cur; cur = sl1; sl1 = sl2; sl2 = tmp; }
            return false;
        };
        if (REV) { bool ex = false; int it = 0;
            for (; it < 4 && !ex; ++it) ex = step(BoolC<true>{}, it);
            for (; it < NT && !ex; ++it) ex = step(BoolC<false>{}, it); }
        else { int it = 0;
            for (; it < NT - 4; ++it) (void)step(BoolC<false>{}, it);
            for (; it < NT; ++it) (void)step(BoolC<true>{}, it); }
        ATT_WAIT_BAR();
        if (pass == NPASS - 1 && tid == 0) nxt_u = __hip_atomic_fetch_add(qctr, 1u, RLX_AGENT);
        float rli[16];
        if (VAR != 1) {
            l_reg += xhalf(l_reg, hi);
            if (hi == 0) wsf[32 + r32] = l_reg;
#pragma unroll
            for (int r = 0; r < 16; ++r) rli[r] = __builtin_amdgcn_rcpf(wsf[32 + crow(r, hi)]);
        } else {
#pragma unroll
            for (int r = 0; r < 16; ++r) rli[r] = 1.f;
        }
#pragma unroll
        for (int r = 0; r < 16; ++r) { const int orow = crow(r, hi);
#pragma unroll
            for (int d0 = 0; d0 < 2; ++d0) { const float val = o[d0][r] * rli[r]; LAS float* sp = stg + orow * 64 + d0 * 32 + r32;
                if (VAR == 2 && pass == 1) *sp = *sp - P.lam * val; else *sp = val; } }
    }
    LDS_WAIT();
    bf16* Ow = P.mix + (size_t)(rowbase + q0 + wid * 32) * DM + VAR * 256 + h * 64;
#pragma unroll
    for (int i = 0; i < 4; ++i) { const int row = i * 8 + (lane >> 3), ch = lane & 7;
        const f32x4 a = *(const LAS f32x4*)(stg + row * 64 + ch * 8), c = *(const LAS f32x4*)(stg + row * 64 + ch * 8 + 4);
        float sc = 1.f;
        if (VAR == 2) { float ss = (a[0] * a[0] + a[1] * a[1]) + (a[2] * a[2] + a[3] * a[3]) + (c[0] * c[0] + c[1] * c[1]) + (c[2] * c[2] + c[3] * c[3]);
            ss += shx<1>(ss); ss += shx<2>(ss); ss += shx<4>(ss); sc = 1.0f / sqrtf(ss * (1.f / 64.f) + RMS_EPS); }
        u32x4 w; w.x = cvtpk_s(a[0] * sc, a[1] * sc); w.y = cvtpk_s(a[2] * sc, a[3] * sc); w.z = cvtpk_s(c[0] * sc, c[1] * sc); w.w = cvtpk_s(c[2] * sc, c[3] * sc);
        if (pm == 0 || (w.x == 0x12345678u && w.y == 0x9abcdef0u)) *(u32x4*)(Ow + (size_t)row * DM + ch * 8) = w; }
    if (tid == 0) *qslot = nxt_u;
    asm volatile("s_waitcnt lgkmcnt(0)\n\ts_barrier" ::: "memory");
#undef DMA_KV
}
typedef __attribute__((address_space(3))) const char* lds_cptr;
typedef short v4i16_t __attribute__((ext_vector_type(4)));
__device__ __forceinline__ s16x4 vtr(lds_cptr p) { return __builtin_bit_cast(s16x4, __builtin_amdgcn_ds_read_tr16_b64_v4i16((__attribute__((address_space(3))) v4i16_t*)p)); }
template <int VAR>
__device__ __forceinline__ void attn_unit2(const AttnP& P, int b, int h, int qb, LAS char* sh, const int tid_in, unsigned* qctr, volatile LAS unsigned* qslot) {
    static_assert(VAR == 0 || VAR == 2 || VAR == 3, "softmax mixers only");
    int tid = tid_in; asm volatile("" : "+v"(tid));
    const int lane = tid & 63, r32 = lane & 31, hi = lane >> 5; const int wid = __builtin_amdgcn_readfirstlane(tid >> 6);
    const long rowbase = (long)b * SEQ; const int q0 = qb * 256, NT = 4 * (qb + 1);
    const int qrel = wid * 32 + r32, tq = q0 + qrel;
    constexpr int QCB = VAR == 0 ? C_AQ : VAR == 1 ? C_BQ : VAR == 2 ? C_CQ : C_DQ;
    constexpr int KCB = VAR == 0 ? C_AK : VAR == 1 ? C_BK : VAR == 2 ? C_CK : C_DK;
    constexpr int VCB = VAR == 0 ? C_AV : VAR == 1 ? C_BV : VAR == 2 ? C_CV : C_DV;
    const int Qc = QCB + 64 * h, Kc = VAR == 3 ? KCB : KCB + 64 * h, Vc = VAR == 3 ? VCB : VCB + 64 * h;
    const bf16* PR = P.proj;
    LAS float* wsf = (LAS float*)(sh + L_WS) + wid * 64;
    LAS float* stg = (LAS float*)(sh + L_OST) + wid * 2048;
    LAS float* cumL = (LAS float*)(sh + L_CUM);
    LAS unsigned* maskL = (LAS unsigned*)(sh + L_OST);
    const unsigned lds0 = (unsigned)(uintptr_t)sh;
    const bf16* ksrc = PR + (size_t)(rowbase + lane) * NP + Kc + wid * 8;
    const bf16* vsrc = PR + (size_t)(rowbase + 16 * (wid & 3) + (lane >> 2)) * NP + Vc + (wid >> 2) * 32 + (lane & 3) * 8;
    const unsigned kdst = lds0 + L_K + wid * 1024, vdst = lds0 + L_V + wid * 1024;
#define TILE2(j) (NT - 1 - (j))
#define DMA_K2(j, slot) glds16(ksrc + (size_t)TILE2(j) * 64 * NP, (unsigned)__builtin_amdgcn_readfirstlane(kdst + (slot)))
#define DMA_V2(j, slot) glds16(vsrc + (size_t)TILE2(j) * 64 * NP, (unsigned)__builtin_amdgcn_readfirstlane(vdst + (slot)))
    DMA_K2(0, 0); DMA_K2(1, SLOTB); DMA_V2(0, 0);
    if (VAR == 0) {
        LAS float* pref = (LAS float*)(sh + L_WS);
        if (tid < 64) { const float ct = P.cum[32 * SEQ + (b * 4 + h) * 64 + tid]; float incl = ct;
#pragma unroll
            for (int o = 1; o < 64; o <<= 1) { const float u = shup(incl, o, tid); if (tid >= o) incl += u; }
            pref[tid] = incl - ct; }
        asm volatile("s_waitcnt lgkmcnt(0)\n\ts_barrier" ::: "memory");
        const float* cg = P.cum + (size_t)(b * 4 + h) * SEQ; for (int i = tid; i < q0 + 256; i += 512) cumL[i] = (cg[i] + pref[i >> 5]) * LOG2E;
        asm volatile("s_waitcnt lgkmcnt(0)\n\ts_barrier" ::: "memory");
    }
    if (VAR == 3) { const unsigned* mg = P.mask + (size_t)(rowbase + q0) * 64; const int nw = 2 * NT;
#pragma unroll 8
        for (int i = tid; i < 256 * 32; i += 512) { const int row = i >> 5, w = 2 * (i & 31); if (w < nw) *(LAS u32x2*)(maskL + row * MROW + w) = *(const u32x2*)(mg + row * 64 + w); } }
    asm volatile("s_waitcnt vmcnt(0) lgkmcnt(0)\n\ts_barrier" ::: "memory");
    const lds_cptr shc = (lds_cptr)sh;
    const lds_cptr kp0 = shc + L_K + hi * 1024 + r32 * 16;
    const lds_cptr vp0 = shc + L_V + ((lane >> 4) & 1) * 32 + (lane & 3) * 8 + (4 * hi + ((lane & 15) >> 2)) * 64;
    float slope2 = 0.f;
    if (VAR == 2) slope2 = __builtin_amdgcn_exp2f(-(float)(2 * h + 1)) * LOG2E;
    if (VAR == 3) slope2 = __builtin_amdgcn_exp2f(-(float)(2 * h + 2)) * LOG2E;
    float cumt = 0.f; if (VAR == 0) cumt = cumL[tq];
    constexpr int NPASS = VAR == 2 ? 2 : 1;
    unsigned nxt_u = 0u;
    const auto slot3 = [](int j) { return (j % 3) * SLOTB; };
#define SB2() __builtin_amdgcn_sched_barrier(0)
#define PINV(x) asm volatile("" : "+v"(x))
#define MF32(a, b, c) __builtin_amdgcn_mfma_f32_32x32x16_bf16(a, b, c, 0, 0, 0)
#define ATT_BARN(N) do { asm volatile("s_waitcnt vmcnt(" #N ") lgkmcnt(0)\n\ts_barrier" ::: "memory"); SB2(); } while (0)
#define PKW(Pv, i) cvtpk_s(Pv[i], Pv[(i) + 1])
#define PAF(k) __builtin_bit_cast(bf16x8, pw##k)
#define VFR(i) (bf16x8){vlo[i][0], vlo[i][1], vlo[i][2], vlo[i][3], vhi[i][0], vhi[i][1], vhi[i][2], vhi[i][3]}
#define VRD(i) do { vlo[i] = vtr(vp_ + (((i) >> 2) * 4096 + ((i) & 3) * 1024)); vhi[i] = vtr(vp_ + (((i) >> 2) * 4096 + ((i) & 3) * 1024 + 512)); } while (0)
#define EX2(v) __builtin_amdgcn_exp2f(v)
#define GAPA(MF, Pv, i, PW, w) do { MF; sacc += Pv[i]; sacc += Pv[(i) + 1]; sacc += Pv[(i) + 2]; sacc += Pv[(i) + 3]; PINV(sacc); PW[w] = PKW(Pv, i); PW[(w) + 1] = PKW(Pv, (i) + 2); PINV(PW); SB2(); } while (0)
#define GAPA8(MF, Pv, i, PW) do { MF; sacc += Pv[i]; sacc += Pv[(i) + 1]; sacc += Pv[(i) + 2]; sacc += Pv[(i) + 3]; sacc += Pv[(i) + 4]; sacc += Pv[(i) + 5]; sacc += Pv[(i) + 6]; sacc += Pv[(i) + 7]; PINV(sacc); \
        PW[0] = PKW(Pv, i); PW[1] = PKW(Pv, (i) + 2); PW[2] = PKW(Pv, (i) + 4); PW[3] = PKW(Pv, (i) + 6); PINV(PW); SB2(); } while (0)
#define GAPB(MF, X, i) do { MF; X[i] = EX2(X[i]); X[(i) + 1] = EX2(X[(i) + 1]); X[(i) + 2] = EX2(X[(i) + 2]); X[(i) + 3] = EX2(X[(i) + 3]); PINV(X); SB2(); } while (0)
    for (int pass = 0; pass < NPASS; ++pass) {
        bf16x8 qa[4]; float sb0 = 0.f;
        { const bf16* Qw = PR + (size_t)(rowbase + tq) * NP + Qc;
          constexpr int ND0 = VAR == 2 ? 2 : 4; const int dbase = VAR == 2 ? 2 * pass : 0;
          float qf[8 * ND0];
#pragma unroll
          for (int d0 = 0; d0 < ND0; ++d0) { const bf16x8 raw = *(const bf16x8*)(Qw + (dbase + d0) * 16 + hi * 8);
#pragma unroll
              for (int j = 0; j < 8; ++j) qf[d0 * 8 + j] = bf2f((unsigned short)raw[j]); }
          constexpr float SC = (VAR == 2 ? 0.17677669529663687f : 0.125f) * LOG2E;
          if (VAR != 1) {
              float ss = 0.f;
#pragma unroll
              for (int i = 0; i < 8 * ND0; ++i) ss += qf[i] * qf[i];
              ss += xhalf(ss, hi); const float rstd = 1.0f / sqrtf(ss * (VAR == 2 ? 1.f / 32.f : 1.f / 64.f) + RMS_EPS);
              const float* g = P.qgain[VAR];
#pragma unroll
              for (int d0 = 0; d0 < ND0; ++d0)
#pragma unroll
                  for (int j = 0; j < 8; ++j) qf[d0 * 8 + j] *= rstd * g[16 * d0 + 8 * hi + j] * SC;
          } else {
#pragma unroll
              for (int i = 0; i < 8 * ND0; ++i) qf[i] *= SC;
          }
          if (VAR == 2 || VAR == 3) {
              float n0 = 0.f;
#pragma unroll
              for (int i = 0; i < 8 * ND0; ++i) n0 += qf[i] * qf[i];
              n0 += xhalf(n0, hi);
              float gk = fabsf(P.kgain[VAR][lane & (VAR == 2 ? 31 : 63)]);
              gk = fmaxf(gk, shx<1>(gk)); gk = fmaxf(gk, shx<2>(gk)); gk = fmaxf(gk, shx<4>(gk)); gk = fmaxf(gk, shx<8>(gk)); gk = fmaxf(gk, shx<16>(gk)); gk = half_max(gk);
              sb0 = 1.02f * sqrtf(n0) * (VAR == 2 ? 5.656854249f : 8.0f) * gk;
          }
#pragma unroll
          for (int d0 = 0; d0 < ND0; ++d0) { u32x4 w; w.x = cvtpk_s(qf[d0 * 8 + 0], qf[d0 * 8 + 1]); w.y = cvtpk_s(qf[d0 * 8 + 2], qf[d0 * 8 + 3]); w.z = cvtpk_s(qf[d0 * 8 + 4], qf[d0 * 8 + 5]); w.w = cvtpk_s(qf[d0 * 8 + 6], qf[d0 * 8 + 7]);
              qa[d0] = __builtin_bit_cast(bf16x8, w); }
          if (VAR == 2) { qa[2] = qa[0]; qa[3] = qa[1]; }
        }
        const float sbound = sb0;
        if (pass > 0) { DMA_K2(0, 0); DMA_K2(1, SLOTB); DMA_V2(0, 0); }
        float mhat = 0.f, l_reg = 0.f; bool hasref = false, resc = false; f32x16 o[2], negm;
#pragma unroll
        for (int r = 0; r < 16; ++r) { o[0][r] = 0.f; o[1][r] = 0.f; }
        f32x16 pA0, pA1, pB0, pB1; u32x4 pw0, pw1, pw2, pw3;
#pragma unroll
        for (int r = 0; r < 16; ++r) { pB0[r] = 0.f; pB1[r] = 0.f; }
        const auto setneg = [&](int t) __attribute__((always_inline)) { float v = -mhat; if (VAR == 0) v += cumt; else v += slope2 * (float)(t * 64 + 4 * hi - tq);
#pragma unroll
            for (int r = 0; r < 16; ++r) negm[r] = v;
            PINV(negm); };
        const auto mid = [&](f32x16& C0, f32x16& C1, const int it) __attribute__((always_inline)) {
            const int t = NT - 1 - it;
            if (VAR == 0) { const LAS float* cp = cumL + t * 64 + 4 * hi;
#pragma unroll
                for (int g = 0; g < 4; ++g) { const f32x4 c0 = *(const LAS f32x4*)(cp + 8 * g), c1 = *(const LAS f32x4*)(cp + 32 + 8 * g);
#pragma unroll
                    for (int i = 0; i < 4; ++i) { C0[4 * g + i] -= c0[i]; C1[4 * g + i] -= c1[i]; } } }
            else {
#pragma unroll
                for (int r = 0; r < 16; ++r) { const float kc = (float)((r & 3) + 8 * (r >> 2)); C0[r] += slope2 * kc; C1[r] += slope2 * (kc + 32.f); } }
            if (VAR != 3) { if (it < 4) { asm volatile("" ::: "memory");
                const int kb = 64 * (3 - it) + 4 * hi;
#pragma unroll
                for (int r = 0; r < 16; ++r) { const int kv = kb + (r & 3) + 8 * (r >> 2); if (kv > qrel) C0[r] = -INFINITY; if (kv + 32 > qrel) C1[r] = -INFINITY; } } }
            else { const u32x2 mw = *(const LAS u32x2*)(maskL + qrel * MROW + 2 * t); const unsigned w0 = mw.x >> (4 * hi), w1 = mw.y >> (4 * hi);
#pragma unroll
                for (int r = 0; r < 16; ++r) { const int c = (r & 3) + 8 * (r >> 2); if (!((w0 >> c) & 1u)) C0[r] = -INFINITY; if (!((w1 >> c) & 1u)) C1[r] = -INFINITY; } }
            const float rm = rowmax(C0, C1, hi);
            const bool need = hasref ? (rm > THR) : (rm > -INFINITY);
            resc = false;
            if (__any(need)) {
                const bool fin = rm > -INFINITY;
                const float dl = hasref ? fmaxf(rm, 0.f) : (fin ? rm : 0.f);
                const float f = hasref ? EX2(-dl) : 1.f;
                mhat += dl; l_reg *= f;
#pragma unroll
                for (int r = 0; r < 16; ++r) { C0[r] -= dl; C1[r] -= dl; }
                if (hi == 0) wsf[r32] = f;
                resc = true; hasref = hasref || fin;
            }
            if (VAR != 0) {
                const bool dead = hasref && (sbound - slope2 * (float)(tq - 64 * t + 1) - mhat < -150.f);
                const bool alld = __all(dead); if (lane == 0) ((LAS unsigned*)(sh + L_END))[(it & 1) * 8 + wid] = alld ? 1u : 0u;
            }
        };
#define KLD(dst0, dst1, d0) do { dst0 = *(const LAS bf16x8*)(kp_ + (d0) * 2048); dst1 = *(const LAS bf16x8*)(kp_ + (d0) * 2048 + 512); } while (0)
#define VLD(lo, hi_, i) do { lo = vtr(vp_ + (((i) >> 2) * 4096 + ((i) & 3) * 1024)); hi_ = vtr(vp_ + (((i) >> 2) * 4096 + ((i) & 3) * 1024 + 512)); } while (0)
#define VF(lo, hi_) (bf16x8){lo[0], lo[1], lo[2], lo[3], hi_[0], hi_[1], hi_[2], hi_[3]}
        const auto step = [&](f32x16& C0, f32x16& C1, f32x16& P0, f32x16& P1, const int it) __attribute__((always_inline)) -> bool {
            if (it + 1 < NT) ATT_BARN(2); else ATT_BARN(1);
            if (VAR != 0 && it >= 1) { const LAS unsigned* wz = (const LAS unsigned*)(sh + L_END) + ((it - 1) & 1) * 8;
                const u32x4 z0 = *(const LAS u32x4*)wz, z1 = *(const LAS u32x4*)(wz + 4);
                if (__builtin_amdgcn_readfirstlane((int)(z0.x & z0.y & z0.z & z0.w & z1.x & z1.y & z1.z & z1.w)) != 0) return true; }
            if (it + 2 < NT) DMA_K2(it + 2, slot3(it + 2));
            if (it + 1 < NT) DMA_V2(it + 1, slot3(it + 1));
            setneg(NT - 1 - it);
            int ko_ = slot3(it), vo_ = slot3(it + 2);
            asm volatile("" : "+s"(ko_), "+s"(vo_));
            const lds_cptr kp_ = kp0 + ko_; const lds_cptr vp_ = vp0 + vo_;
            bf16x8 ka0, ka1, kb0, kb1; s16x4 va0, va1, vb0, vb1;
            float sacc = 0.f;
            if (VAR == 2) {
                KLD(ka0, ka1, 2 * pass); KLD(kb0, kb1, 2 * pass + 1); SB2();
                GAPA8(C0 = MF32(ka0, qa[0], negm), P0, 0, pw0);
                GAPA8(C1 = MF32(ka1, qa[0], negm), P0, 8, pw1);
                GAPA8(C0 = MF32(kb0, qa[1], C0), P1, 0, pw2);
                GAPA8(C1 = MF32(kb1, qa[1], C1), P1, 8, pw3);
            } else {
                KLD(ka0, ka1, 0); KLD(kb0, kb1, 1); SB2();
                GAPA(C0 = MF32(ka0, qa[0], negm), P0, 0, pw0, 0);
                GAPA(C1 = MF32(ka1, qa[0], negm), P0, 4, pw0, 2);
                KLD(ka0, ka1, 2); SB2();
                GAPA(C0 = MF32(kb0, qa[1], C0), P0, 8, pw1, 0);
                GAPA(C1 = MF32(kb1, qa[1], C1), P0, 12, pw1, 2);
                KLD(kb0, kb1, 3); SB2();
                GAPA(C0 = MF32(ka0, qa[2], C0), P1, 0, pw2, 0);
                GAPA(C1 = MF32(ka1, qa[2], C1), P1, 4, pw2, 2);
                GAPA(C0 = MF32(kb0, qa[3], C0), P1, 8, pw3, 0);
                GAPA(C1 = MF32(kb1, qa[3], C1), P1, 12, pw3, 2);
            }
            l_reg += sacc;
            mid(C0, C1, it);
            SB2();
            if (it > 0) {
                VLD(va0, va1, 0); VLD(vb0, vb1, 4); SB2();
                GAPB(o[0] = MF32(PAF(0), VF(va0, va1), o[0]), C0, 0);  VLD(va0, va1, 1); SB2();
                GAPB(o[1] = MF32(PAF(0), VF(vb0, vb1), o[1]), C0, 4);  VLD(vb0, vb1, 5); SB2();
                GAPB(o[0] = MF32(PAF(1), VF(va0, va1), o[0]), C0, 8);  VLD(va0, va1, 2); SB2();
                GAPB(o[1] = MF32(PAF(1), VF(vb0, vb1), o[1]), C0, 12); VLD(vb0, vb1, 6); SB2();
                GAPB(o[0] = MF32(PAF(2), VF(va0, va1), o[0]), C1, 0);  VLD(va0, va1, 3); SB2();
                GAPB(o[1] = MF32(PAF(2), VF(vb0, vb1), o[1]), C1, 4);  VLD(vb0, vb1, 7); SB2();
                GAPB(o[0] = MF32(PAF(3), VF(va0, va1), o[0]), C1, 8);
                GAPB(o[1] = MF32(PAF(3), VF(vb0, vb1), o[1]), C1, 12);
                if (resc) {
#pragma unroll
                    for (int r = 0; r < 16; ++r) { const float fr = wsf[crow(r, hi)]; o[0][r] *= fr; o[1][r] *= fr; } }
            } else {
#pragma unroll
                for (int r = 0; r < 16; ++r) { C0[r] = EX2(C0[r]); C1[r] = EX2(C1[r]); }
            }
            return false;
        };
        bool ex = false, pendA = true; int it = 0;
        for (; it < NT; it += 2) {
            ex = step(pA0, pA1, pB0, pB1, it); if (ex) { pendA = false; break; }
            ex = step(pB0, pB1, pA0, pA1, it + 1); if (ex) { pendA = true; ++it; break; }
        }
        if (!ex) pendA = false;
        if (!ex) ATT_BARN(0);
        { int vo_ = slot3(it + 2); asm volatile("" : "+s"(vo_)); const lds_cptr vp_ = vp0 + vo_; s16x4 vlo[8], vhi[8];
#pragma unroll
          for (int i = 0; i < 8; ++i) VRD(i);
          float sacc = 0.f;
          if (pendA) {
#pragma unroll
              for (int r = 0; r < 16; ++r) sacc += pA0[r] + pA1[r];
              pw0 = (u32x4){PKW(pA0, 0), PKW(pA0, 2), PKW(pA0, 4), PKW(pA0, 6)}; pw1 = (u32x4){PKW(pA0, 8), PKW(pA0, 10), PKW(pA0, 12), PKW(pA0, 14)};
              pw2 = (u32x4){PKW(pA1, 0), PKW(pA1, 2), PKW(pA1, 4), PKW(pA1, 6)}; pw3 = (u32x4){PKW(pA1, 8), PKW(pA1, 10), PKW(pA1, 12), PKW(pA1, 14)};
          } else {
#pragma unroll
              for (int r = 0; r < 16; ++r) sacc += pB0[r] + pB1[r];
              pw0 = (u32x4){PKW(pB0, 0), PKW(pB0, 2), PKW(pB0, 4), PKW(pB0, 6)}; pw1 = (u32x4){PKW(pB0, 8), PKW(pB0, 10), PKW(pB0, 12), PKW(pB0, 14)};
              pw2 = (u32x4){PKW(pB1, 0), PKW(pB1, 2), PKW(pB1, 4), PKW(pB1, 6)}; pw3 = (u32x4){PKW(pB1, 8), PKW(pB1, 10), PKW(pB1, 12), PKW(pB1, 14)};
          }
          l_reg += sacc;
          o[0] = MF32(PAF(0), VFR(0), o[0]); o[1] = MF32(PAF(0), VFR(4), o[1]); o[0] = MF32(PAF(1), VFR(1), o[0]); o[1] = MF32(PAF(1), VFR(5), o[1]);
          o[0] = MF32(PAF(2), VFR(2), o[0]); o[1] = MF32(PAF(2), VFR(6), o[1]); o[0] = MF32(PAF(3), VFR(3), o[0]); o[1] = MF32(PAF(3), VFR(7), o[1]); }
        ATT_WAIT_BAR();
        if (pass == NPASS - 1 && tid == 0) nxt_u = __hip_atomic_fetch_add(qctr, 1u, RLX_AGENT);
        int lane_e = lane; asm volatile("" : "+v"(lane_e)); const int r32e = lane_e & 31, hie = lane_e >> 5;
        LAS float* wsfe = (LAS float*)(sh + L_WS) + wid * 64; LAS float* stge = (LAS float*)(sh + L_OST) + wid * 2048;
        float rli[16];
        l_reg += xhalf(l_reg, hie);
        if (hie == 0) wsfe[32 + r32e] = l_reg;
#pragma unroll
        for (int r = 0; r < 16; ++r) rli[r] = __builtin_amdgcn_rcpf(wsfe[32 + crow(r, hie)]);
#pragma unroll
        for (int r = 0; r < 16; ++r) { const int orow = crow(r, hie);
#pragma unroll
            for (int d0 = 0; d0 < 2; ++d0) { const float val = o[d0][r] * rli[r]; LAS float* sp = stge + orow * 64 + d0 * 32 + r32e;
                if (VAR == 2 && pass == 1) *sp = *sp - P.lam * val; else *sp = val; } }
    }
    LDS_WAIT();
    int lane_o = tid & 63; asm volatile("" : "+v"(lane_o));
    bf16* Ow = P.mix + (size_t)(rowbase + q0 + wid * 32) * DM + VAR * 256 + h * 64;
    { const int lane = lane_o; LAS float* stg = (LAS float*)(sh + L_OST) + wid * 2048;
#pragma unroll
    for (int i = 0; i < 4; ++i) { const int row = i * 8 + (lane >> 3), ch = lane & 7;
        const f32x4 a = *(const LAS f32x4*)(stg + row * 64 + ch * 8), c = *(const LAS f32x4*)(stg + row * 64 + ch * 8 + 4);
        float sc = 1.f;
        if (VAR == 2) { float ss = (a[0] * a[0] + a[1] * a[1]) + (a[2] * a[2] + a[3] * a[3]) + (c[0] * c[0] + c[1] * c[1]) + (c[2] * c[2] + c[3] * c[3]);
            ss += shx<1>(ss); ss += shx<2>(ss); ss += shx<4>(ss); sc = 1.0f / sqrtf(ss * (1.f / 64.f) + RMS_EPS); }
        u32x4 w; w.x = cvtpk_s(a[0] * sc, a[1] * sc); w.y = cvtpk_s(a[2] * sc, a[3] * sc); w.z = cvtpk_s(c[0] * sc, c[1] * sc); w.w = cvtpk_s(c[2] * sc, c[3] * sc);
        *(u32x4*)(Ow + (size_t)row * DM + ch * 8) = w; } }
    if (tid == 0) *qslot = nxt_u;
    asm volatile("s_waitcnt lgkmcnt(0)\n\ts_barrier" ::: "memory");
#undef DMA_K2
#undef DMA_V2
#undef TILE2
}
#undef SB2
#undef PINV
#undef MF32
#undef ATT_BARN
#undef PKW
#undef PAF
#undef VFR
#undef VRD
#undef EX2
#undef GAPA
#undef GAPA8
#undef GAPB
#undef KLD
#undef VLD
#undef VF
}

__device__ __forceinline__ void p4_attention(Frame& F, const Args& A, int l, int qsel) {
    att::AttnP P; P.proj = (const bf16*)(F.ws + WS_PROJ); P.mix = (bf16*)(F.ws + WS_MIX); P.cum = (const float*)(F.ws + WS_CUM); P.mask = (const unsigned*)(F.ws + WS_MASK);
    P.qgain[0] = inp<I_QNA>() + l * 64; P.qgain[1] = nullptr; P.qgain[2] = inp<I_QNC>() + l * 32; P.qgain[3] = inp<I_QND>() + l * 64; P.kgain[0] = nullptr; P.kgain[1] = nullptr; P.kgain[2] = inp<I_KNC>() + l * 32; P.kgain[3] = inp<I_KND>() + l * 64; P.lam = ((const float*)(F.ws + WS_MISC))[l];
    LAS char* sh = (LAS char*)F.lds;
    LAS float* rsl2 = (LAS float*)(F.lds + 126976);
    bool cv = BG_CONVERT && (qsel == 0);
    if (cv) { fill_rowscale(F, A, 0, rsl2); fill_rowscale(F, A, 1, rsl2 + DM); }
    if (F.tid == 0) F.MISC[0] = (unsigned)(F.bx - F.G);
    __syncthreads();
    for (;;) {
        const int u = (int)F.MISC[0] + F.G;
        if (u >= 1024) break;
        const int qb = 7 - (u >> 7), r = u & 127, var = r >> 5, bh = r & 31, b = bh >> 2, h = bh & 3;
        const int tv = var == 0 ? 2 : var == 1 ? 1 : var == 2 ? 3 : 0;
        if (qsel >= 2 && PROBE_ATT_VAR >= 0 && tv != PROBE_ATT_VAR) { __syncthreads(); if (F.tid == 0) F.MISC[0] = __hip_atomic_fetch_add(F.ctl + CW_AQ + 64 * qsel, 1u, RLX_AGENT); __syncthreads(); continue; }
#ifdef ONLY_VAR2
        att::attn_unit2<ONLY_VAR2>(P, b, h, qb, sh, F.tid, F.ctl + CW_AQ + 64 * qsel, F.MISC);
#else
        if (tv == 2) att::attn_unit<2>(P, b, h, qb, sh, F.tid, qsel >= 2 ? PROBE_ATT_MODE : 0, F.ctl + CW_AQ + 64 * qsel, F.MISC);
        else if (tv == 1) att::attn_unit<1>(P, b, h, qb, sh, F.tid, qsel >= 2 ? PROBE_ATT_MODE : 0, F.ctl + CW_AQ + 64 * qsel, F.MISC);
        else if (tv == 3) att::attn_unit<3>(P, b, h, qb, sh, F.tid, qsel >= 2 ? PROBE_ATT_MODE : 0, F.ctl + CW_AQ + 64 * qsel, F.MISC);
        else att::attn_unit2<0>(P, b, h, qb, sh, F.tid, F.ctl + CW_AQ + 64 * qsel, F.MISC);
#endif
        if (cv) {
            if (F.tid == 0) F.MISC[3] = __hip_atomic_fetch_add(F.ctl + CW_CVQ, (unsigned)CV_CHUNK, RLX_AGENT);
            __syncthreads();
            const int gb = (int)F.MISC[3];
            if (gb >= CV_TOTAL) cv = false; else convert_chunk(F, A, gb, rsl2);
            __syncthreads();
        }
    }
    while (cv) {
        __syncthreads();
        if (F.tid == 0) F.MISC[3] = __hip_atomic_fetch_add(F.ctl + CW_CVQ, (unsigned)CV_CHUNK, RLX_AGENT);
        __syncthreads();
        const int gb = (int)F.MISC[3];
        if (gb >= CV_TOTAL) cv = false; else convert_chunk(F, A, gb, rsl2);
    }
    __syncthreads();
}

template <int N, int Dd> __device__ __forceinline__ void bfly(float (&p)[32], int lane) { const bool up = (lane & Dd) != 0;
#pragma unroll
    for (int j = 0; j < N / 2; ++j) { const float a = p[2 * j], bb = p[2 * j + 1]; const float send = up ? a : bb, keep = up ? bb : a; p[j] = keep + __shfl_xor(send, Dd); } }
__device__ __forceinline__ void p6_router(Frame& F, const Args& A, int l, int rep) {
    const float* MOD = (const float*)(F.ws + WS_MOD); const bf16* X1 = (const bf16*)(F.ws + WS_X1); bf16* H = (bf16*)(F.ws + WS_H);
    const bf16* WRH = (const bf16*)(F.ws + WS_WR) + (size_t)l * 48 * DM; const bf16* WRL = WRH + 2 * 48 * DM;
    int* tok_e = (int*)(F.ws + WS_TOK); float* tok_w = (float*)(F.ws + WS_TOK) + 2 * M; int* tok_pos = (int*)(F.ws + WS_TOK) + 4 * M;
    constexpr int AP = 528;
    LAS unsigned char* Ahi = F.lds; LAS unsigned char* Alo = F.lds + 64 * AP; LAS unsigned char* Bhi = F.lds + 128 * AP; LAS unsigned char* Blo = F.lds + 176 * AP;
    LAS float* PL = (LAS float*)F.lds;
    const int lane = F.lane, w = F.wave; const int mw = (F.vcu * NWAVES + w) * 8; const int b = mw >> 11;
    const float* md = MOD + ((size_t)l * 8 + b) * 6144;
    f32x4 hv[8][4];
#pragma unroll
    for (int r = 0; r < 8; ++r) {
        const bf16* xr = X1 + (size_t)(mw + r) * DM;
#pragma unroll
        for (int j = 0; j < 4; ++j) { const u32x2 q = *(const u32x2*)(xr + 256 * j + 4 * lane); hv[r][j] = (f32x4){bf2f(q.x & 0xffff), bf2f(q.x >> 16), bf2f(q.y & 0xffff), bf2f(q.y >> 16)}; }
    }
    { f32x4 gm[4], sc[4], sh[4]; const float* n2 = inp<I_N2G>() + l * DM;
#pragma unroll
      for (int j = 0; j < 4; ++j) { const int col = 256 * j + 4 * lane; gm[j] = *(const f32x4*)(n2 + col); sc[j] = *(const f32x4*)(md + 4 * DM + col); sh[j] = *(const f32x4*)(md + 3 * DM + col); gm[j] = gm[j] * (sc[j] + 1.0f); }
#pragma unroll
      for (int r = 0; r < 8; ++r) { float ss = 0.f;
#pragma unroll
        for (int j = 0; j < 4; ++j) ss += (hv[r][j][0] * hv[r][j][0] + hv[r][j][1] * hv[r][j][1]) + (hv[r][j][2] * hv[r][j][2] + hv[r][j][3] * hv[r][j][3]);
        const float rstd = 1.0f / sqrtf(wave_sum(ss) * (1.f / DM) + RMS_EPS);
#pragma unroll
        for (int j = 0; j < 4; ++j) { hv[r][j] = hv[r][j] * rstd * gm[j] + sh[j]; u32x2 pk; pk.x = pk2(hv[r][j][0], hv[r][j][1]); pk.y = pk2(hv[r][j][2], hv[r][j][3]);
            *(u32x2*)(H + (size_t)(mw + r) * DM + 256 * j + 4 * lane) = pk; } } }
    const int rt = w & 3, kh = w >> 2, arow = lane & 15, kg = lane >> 4;
    f32x4 acc[3];
#pragma unroll
    for (int c = 0; c < 3; ++c) acc[c] = (f32x4){0.f, 0.f, 0.f, 0.f};
#pragma unroll
    for (int j = 0; j < 4; ++j) {
        __syncthreads();
#pragma unroll
        for (int r = 0; r < 8; ++r) { const f32x4 x = hv[r][j]; unsigned h0 = f2bf(x[0]), h1 = f2bf(x[1]), h2 = f2bf(x[2]), h3 = f2bf(x[3]);
            u32x2 hi; hi.x = h0 | (h1 << 16); hi.y = h2 | (h3 << 16);
            u32x2 lo; lo.x = pk2(x[0] - bf2f((unsigned short)h0), x[1] - bf2f((unsigned short)h1)); lo.y = pk2(x[2] - bf2f((unsigned short)h2), x[3] - bf2f((unsigned short)h3));
            *(LAS u32x2*)(Ahi + (w * 8 + r) * AP + lane * 8) = hi; *(LAS u32x2*)(Alo + (w * 8 + r) * AP + lane * 8) = lo; }
        for (int i = F.tid; i < 48 * 32; i += 512) { const int o = i >> 5, c16 = i & 31;
            *(LAS u32x4*)(Bhi + o * AP + c16 * 16) = *(const u32x4*)(WRH + (size_t)o * DM + 256 * j + 8 * c16);
            *(LAS u32x4*)(Blo + o * AP + c16 * 16) = *(const u32x4*)(WRL + (size_t)o * DM + 256 * j + 8 * c16); }
        LDS_WAIT(); __syncthreads();
#pragma unroll
        for (int ks = 0; ks < 4; ++ks) { const int kb = ((4 * kh + ks) * 32 + 8 * kg) * 2;
            const bf16x8 ah = *(const LAS bf16x8*)(Ahi + (16 * rt + arow) * AP + kb), al = *(const LAS bf16x8*)(Alo + (16 * rt + arow) * AP + kb);
#pragma unroll
            for (int c = 0; c < 3; ++c) { const bf16x8 bh = *(const LAS bf16x8*)(Bhi + (16 * c + arow) * AP + kb), bl = *(const LAS bf16x8*)(Blo + (16 * c + arow) * AP + kb);
                acc[c] = __builtin_amdgcn_mfma_f32_16x16x32_bf16(ah, bh, acc[c], 0, 0, 0);
                acc[c] = __builtin_amdgcn_mfma_f32_16x16x32_bf16(al, bh, acc[c], 0, 0, 0);
                acc[c] = __builtin_amdgcn_mfma_f32_16x16x32_bf16(ah, bl, acc[c], 0, 0, 0); } }
    }
    __syncthreads();
#pragma unroll
    for (int c = 0; c < 3; ++c)
#pragma unroll
        for (int r = 0; r < 4; ++r) PL[(kh * 64 + 16 * rt + kg * 4 + r) * 48 + 16 * c + arow] = acc[c][r];
    LDS_WAIT(); __syncthreads();
    if (F.tid < 64 && rep == 0) {
        const int m = F.vcu * 64 + F.tid; const LAS float* q0 = PL + F.tid * 48; const LAS float* q1 = PL + (64 + F.tid) * 48;
        float gl[4]; int gi = 0; float gm;
#pragma unroll
        for (int g = 0; g < 4; ++g) gl[g] = (q0[g] + q1[g]) + inp<I_BG>()[l * 4 + g];
        gm = gl[0];
#pragma unroll
        for (int g = 1; g < 4; ++g) if (gl[g] > gm) { gm = gl[g]; gi = g; }
        float den = 0.f;
#pragma unroll
        for (int g = 0; g < 4; ++g) den += __expf(gl[g] - gm);
        const float gprob = 1.0f / den;
        float v1 = -INFINITY, v2 = -INFINITY; int i1 = 0, i2 = 0;
        for (int e = 0; e < 8; ++e) { const float v = (q0[4 + gi * 8 + e] + q1[4 + gi * 8 + e]) + inp<I_BE>()[l * 32 + gi * 8 + e];
            if (v > v1) { v2 = v1; i2 = i1; v1 = v; i1 = e; } else if (v > v2) { v2 = v; i2 = e; } }
        const float e2 = __expf(v2 - v1); const float w1 = gprob / (1.f + e2), w2 = gprob * e2 / (1.f + e2);
        const int ea = gi * 8 + i1, eb = gi * 8 + i2;
        tok_e[m] = ea; tok_e[M + m] = eb; tok_w[m] = w1; tok_w[M + m] = w2;
        LAS unsigned* lcnt = (LAS unsigned*)(F.lds + 32768); LAS unsigned* lbase = lcnt + 32;
        if (F.tid < 32) lcnt[F.tid] = 0u;
        asm volatile("s_waitcnt lgkmcnt(0)" ::: "memory");
        const unsigned ra = __hip_atomic_fetch_add(lcnt + ea, 1u, __ATOMIC_RELAXED, __HIP_MEMORY_SCOPE_WORKGROUP), rb = __hip_atomic_fetch_add(lcnt + eb, 1u, __ATOMIC_RELAXED, __HIP_MEMORY_SCOPE_WORKGROUP);
        asm volatile("s_waitcnt lgkmcnt(0)" ::: "memory");
        if (F.tid < 32) { const unsigned n = *(volatile LAS unsigned*)(lcnt + F.tid); unsigned bs = 0u; if (n) bs = __hip_atomic_fetch_add(F.ctl + CW_CNT + (l * 32 + F.tid) * 16, n, RLX_AGENT); *(volatile LAS unsigned*)(lbase + F.tid) = bs; }
        asm volatile("s_waitcnt vmcnt(0) lgkmcnt(0)" ::: "memory");
        const int pa = (int)(*(volatile LAS unsigned*)(lbase + ea) + ra), pb = (int)(*(volatile LAS unsigned*)(lbase + eb) + rb);
        tok_pos[m] = pa; tok_pos[M + m] = pb;
        int* elist = (int*)(F.ws + WS_ELIST); elist[ea * M + pa] = m; elist[eb * M + pb] = m;
    }
}

__device__ __forceinline__ void build_rowlists(Frame& F, int l) {
    volatile LAS int* base = (volatile LAS int*)(F.lds + BASE_OFF); volatile LAS int* cnts = (volatile LAS int*)(F.lds + CNTS_OFF); volatile LAS int* tab = (volatile LAS int*)(F.lds + TAB_OFF);
    LAS int* rowl = (LAS int*)(F.lds + ROWL_OFF); const int* elist = (const int*)(F.ws + WS_ELIST);
    const int ntile = (int)F.MISC[1];
    const int i = F.tid >> 8, r = F.tid & 255; const long L = (long)i * F.G + F.bx;
    int tok = 0;
    if (L < 2L * ntile) { const int tile = (int)(L >> 1), e = tab[tile], pos = 256 * (tile - base[e]) + r; if (pos < cnts[e]) tok = elist[e * M + pos]; }
    rowl[F.tid] = tok;
    __syncthreads();
}

constexpr int NPL = 7, NPH = 2 + 2 * NPL;
__global__ void __launch_bounds__(NWAVES * 64, 2) mk_fwd(Args args) {
    extern __shared__ __attribute__((aligned(16))) unsigned char lds[];
    Frame F;
    F.lds = (LAS unsigned char*)lds;
    F.MISC = (volatile LAS unsigned*)(F.lds + MISC_OFF);
    F.tid = threadIdx.x; F.lane = F.tid & 63; F.wave = __builtin_amdgcn_readfirstlane(F.tid >> 6);
    const int wave0 = F.wave;
    F.G = gridDim.x; F.bx = blockIdx.x; F.vcu = 0;
    F.ws = args.ws; F.out = args.out; F.ctl = (unsigned*)(args.ws + WS_CTL);
    for (int u = F.tid; u < (LDS_BYTES - LDSCTL_OFF) / 4; u += NWAVES * 64) ((LAS unsigned*)(F.lds + LDSCTL_OFF))[u] = 0u;
    __syncthreads();
    XcdBarrier bar; bar.bar = F.ctl + CW_BAR; bar.x = 0; bar.st = nullptr;
    if (!MK_PER_PHASE) bar = xcd_barrier_post(F.ctl + CW_BAR, F.MISC + 8);
    const int lo = args.ph_lo, hi = args.ph_hi;
#pragma unroll 1
    for (int ph = lo; ph < hi; ++ph) {
#if PROBE_REP_K >= 0
        const int ptype = ph == 0 ? 0 : (ph == NPH - 1 ? 10 : 1 + (ph - 1) % NPL);
        const int nrep = (ptype == PROBE_REP_K && (ph <= NPL || (PROBE_REP_K != 1 && PROBE_REP_K != 5))) ? 1 : 0;
#pragma unroll 1
        for (int rep = 0; rep <= nrep; ++rep) {
#else
        constexpr int rep = 0;
#endif
        { int w_ = wave0; asm volatile("" : "+s"(w_)); unsigned on_ = ~0u; asm volatile("" : "+s"(on_)); int ln_ = (int)__builtin_amdgcn_mbcnt_hi(on_, __builtin_amdgcn_mbcnt_lo(on_, 0u)); asm volatile("" : "+v"(ln_));
          F.wave = w_; F.lane = ln_; F.tid = w_ * 64 + ln_;
          unsigned long long ws_ = (unsigned long long)args.ws; asm volatile("" : "+s"(ws_)); F.ws = (unsigned char*)(GAS unsigned char*)ws_; F.ctl = (unsigned*)(F.ws + WS_CTL);
          int bx_ = blockIdx.x; asm volatile("" : "+s"(bx_)); F.bx = bx_; F.vcu = (F.G % 8 == 0) ? (bx_ % 8) * (F.G / 8) + bx_ / 8 : bx_; }
        if (ph == 0) {
#ifndef SKIP_P0
            p0_prologue(F, args);
#endif
        } else if (ph == NPH - 1) {
            row_pass(F, args, 2, 1);
        } else {
            const int l = (ph - 1) / NPL, k = (ph - 1) % NPL;
            if (k == 0) { row_pass(F, args, l == 0 ? 0 : 1, l); }
            else if (k == 1) {
                pg8::Gemm g{(const bf16*)(F.ws + WS_H), (const bf16*)(F.ws + WS_WIN) + (size_t)l * NP * DM, M, NP, DM}; pg8::StaticOrder S; S.init(M, NP, F.G, F.bx);
                pg8::EpiBf16 E{(bf16*)(F.ws + WS_PROJ), NP};
#ifndef SKIP_G1
                pg8::gemm_phase<pg8::EpiBf16, pg8::StaticOrder, true, true>(F.lds, g, S, E, F.tid);
#endif
            } else if (k == 2) {
#ifndef SKIP_P3
                p3_prep(F, args, l, rep);
#endif
            } else if (k == 3) {
#ifndef SKIP_P4
                p4_attention(F, args, l, l + 2 * rep);
#endif
            } else if (k == 4) {
                pg8::Gemm g{(const bf16*)(F.ws + WS_MIX), (const bf16*)(F.ws + WS_WOUT) + (size_t)l * DM * DM, M, DM, DM}; pg8::StaticOrder S; S.init(M, DM, F.G, F.bx);
                pg8::EpiResGate E{l == 0 ? inp<I_X>() : nullptr, (const bf16*)(F.ws + WS_X1), (bf16*)(F.ws + WS_X1), (const float*)(F.ws + WS_MOD) + (size_t)l * 8 * 6144 + 2 * DM};
#ifndef SKIP_G2
                pg8::gemm_phase<pg8::EpiResGate, pg8::StaticOrder, false, true>(F.lds, g, S, E, F.tid);
#endif
            } else if (k == 5) {
#ifndef SKIP_P6
                p6_router(F, args, l, rep);
#endif
            } else {
                build_tables(F, l); build_rowlists(F, l);
                unsigned* upf = F.ctl + CW_UPF + l * 8192; unsigned* dq = F.ctl + CW_DNQ + 16 * l;
                { pg8::Gemm g{(const bf16*)(F.ws + WS_H), (const bf16*)(F.ws + WS_WUP) + (size_t)l * NEXP * 512 * DM, MAXSLOT, 512, DM};
                  pg8::GroupOrder S{(const LAS int*)(F.lds + TAB_OFF), (int)F.MISC[1], 2, F.G, F.bx, (size_t)512 * DM * 2};
                  pg8::EpiSwiglu E{(bf16*)(F.ws + WS_HID), upf};
#ifndef SKIP_G3
                  pg8::gemm_phase<pg8::EpiSwiglu, pg8::GroupOrder, true, true, true>(F.lds, g, S, E, F.tid, (const LAS int*)(F.lds + ROWL_OFF));
#endif
                }
                if (GAP_CONVERT && !BG_CONVERT && l == 0 && rep == 0) convert_layer1_in_gap(F, args, 2 * (int)F.MISC[1] - F.G);
                { const pg8::Gemm g{(const bf16*)(F.ws + WS_HID), (const bf16*)(F.ws + WS_WDN) + (size_t)l * NEXP * DM * FF, MAXSLOT, DM, FF};
                  const pg8::EpiBf16 E{(bf16*)(F.ws + WS_Y), DM};
                  const LAS int* tab = (const LAS int*)(F.lds + TAB_OFF);
                  const int nd = 4 * __builtin_amdgcn_readfirstlane((int)F.MISC[1]);
                  pg8::DynOrder S{dq, upf, tab, F.MISC, nd, (size_t)DM * FF * 2, F.tid, (unsigned)F.G, 0u, 2u};
                  if (F.tid == 0) { const unsigned a = (unsigned)F.bx, b = (unsigned)F.G + __hip_atomic_fetch_add(dq, 1u, RLX_AGENT); F.MISC[4] = a; F.MISC[5] = b;
                      if ((int)a < nd) while (__hip_atomic_load(upf + (a >> 2) * 16, RLX_AGENT) < 2u) __builtin_amdgcn_s_sleep(8);
                      __builtin_amdgcn_fence(__ATOMIC_ACQUIRE, "agent"); asm volatile("s_waitcnt vmcnt(0)" ::: "memory"); S.issue(b); }
                  __syncthreads();
                  for (;;) {
                      if (__builtin_amdgcn_readfirstlane((int)F.MISC[4]) >= nd) break;
#ifndef SKIP_G4
                      pg8::gemm_phase<pg8::EpiBf16, pg8::DynOrder, true, true>(F.lds, g, S, E, F.tid);
#endif
                      if (F.tid == 0) {
                          const unsigned idn = F.MISC[5];
                          if ((int)idn < nd) { unsigned f = S.pflag; while (f < 2u) { __builtin_amdgcn_s_sleep(8); f = __hip_atomic_load(upf + (idn >> 2) * 16, RLX_AGENT); }
                              __builtin_amdgcn_fence(__ATOMIC_ACQUIRE, "agent"); asm volatile("s_waitcnt vmcnt(0)" ::: "memory"); }
                          const unsigned idn2 = S.ppop; F.MISC[4] = idn; F.MISC[5] = idn2; S.issue(idn2); }
                      __syncthreads();
                  }
                }
            }
        }
#if PROBE_REP_K >= 0
        if (rep < nrep) xcd_barrier(bar, F.tid);
        }
#endif
        if (ph + 1 < hi) xcd_barrier(bar, F.tid);
#ifdef PROBE_DOUBLE_BAR
        if (ph + 1 < hi) xcd_barrier(bar, F.tid);
#endif
    }
}

extern "C" void kernel_launch(void* const* d_in, const int* in_sizes, int n_in, void* d_out, int out_size, void* d_ws, size_t ws_size, hipStream_t stream) {
    static int grid = 0;
    if (grid == 0) {
        if (n_in != 28 || out_size != M * DM || ws_size < WS_END) { fprintf(stderr, "kernel_launch: unexpected shapes (n_in %d, out %d, ws %zu)\n", n_in, out_size, ws_size); grid = -1; return; }
        int dev = 0, cus = 0, per_cu = 0;
        if (hipGetDevice(&dev) != hipSuccess || hipDeviceGetAttribute(&cus, hipDeviceAttributeMultiprocessorCount, dev) != hipSuccess) { grid = -1; return; }
        if (hipFuncSetAttribute((const void*)mk_fwd, hipFuncAttributeMaxDynamicSharedMemorySize, LDS_BYTES) != hipSuccess) { fprintf(stderr, "kernel_launch: hipFuncSetAttribute failed\n"); grid = -1; return; }
        if (hipOccupancyMaxActiveBlocksPerMultiprocessor(&per_cu, (const void*)mk_fwd, NWAVES * 64, LDS_BYTES) != hipSuccess || per_cu < 1)
            fprintf(stderr, "kernel_launch: occupancy query reports %d workgroups per CU\n", per_cu);
        (void)hipGetLastError();
        grid = cus;
    }
    if (grid < 0) return;
    if (hipMemsetAsync((char*)d_ws + WS_CTL, 0, CTL_ZERO_BYTES, stream) != hipSuccess) return;
    Args a{};
    for (int i = 0; i < 28; ++i) a.in[i] = (const float*)d_in[i];
    a.out = (float*)d_out; a.ws = (unsigned char*)d_ws;
#if MK_PER_PHASE
    for (int p = 0; p < NPH; ++p) { a.ph_lo = p; a.ph_hi = p + 1; hipLaunchKernelGGL(mk_fwd, dim3(grid), dim3(NWAVES * 64), LDS_BYTES, stream, a); }
#else
    a.ph_lo = 0; a.ph_hi = NPH; hipLaunchKernelGGL(mk_fwd, dim3(grid), dim3(NWAVES * 64), LDS_BYTES, stream, a);
#endif
}
```

```cpp
#include <hip/hip_runtime.h>
#include <cstdio>
#include <cstdint>

#ifndef MK_PER_PHASE
#define MK_PER_PHASE 0
#endif

#ifndef PROBE_P3_PART
#define PROBE_P3_PART 0
#endif
#ifndef PROBE_ATT_VAR
#define PROBE_ATT_VAR -1
#endif
#ifndef BG_CONVERT
#define BG_CONVERT 1
#endif
#ifndef GAP_CONVERT
#define GAP_CONVERT 1
#endif
#ifndef PROBE_ATT_MODE
#define PROBE_ATT_MODE 0
#endif
#ifndef PROBE_REP_K
#define PROBE_REP_K -1
#endif
#define LAS __attribute__((address_space(3)))
#define GAS __attribute__((address_space(1)))
typedef unsigned short bf16;
typedef short bf16x8 __attribute__((ext_vector_type(8)));
typedef short s16x4 __attribute__((ext_vector_type(4)));
typedef float f32x4 __attribute__((ext_vector_type(4)));
typedef float f32x2 __attribute__((ext_vector_type(2)));
typedef float f32x16 __attribute__((ext_vector_type(16)));
typedef unsigned u32x4 __attribute__((ext_vector_type(4)));
typedef unsigned u32x2 __attribute__((ext_vector_type(2)));

constexpr int BATCH = 8, SEQ = 2048, DM = 1024, M = BATCH * SEQ, DEPTH = 2;
constexpr int NP = 3072;
constexpr int P_IN = 2988;
constexpr int C_AQ = 0, C_AK = 256, C_AV = 512, C_BQ = 768, C_BK = 1024, C_BV = 1280, C_CQ = 1536, C_CK = 1792, C_CV = 2048,
              C_DQ = 2304, C_DK = 2560, C_DV = 2624, C_IQ = 2688, C_IK = 2944, C_IW = 2976, C_AF = 2984;
constexpr int NEXP = 32, FF = 256, MAXSLOT = M * 2 + NEXP * 256, MAXTILE = MAXSLOT / 256;
constexpr float LOG2E = 1.4426950408889634f;
constexpr float RMS_EPS = 1e-6f;

constexpr size_t MiB = 1u << 20;
constexpr size_t WS_CTL = 0, CTL_ZERO_BYTES = 1 * MiB;
constexpr size_t WS_WR = 1 * MiB;
constexpr size_t WS_MOD = 2 * MiB;
constexpr size_t WS_CUM = 3 * MiB;
constexpr size_t WS_TOK = 4 * MiB;
constexpr size_t WS_MISC = 5 * MiB;
constexpr size_t WS_MASK = 6 * MiB;
constexpr size_t WS_WIN = 10 * MiB;
constexpr size_t WS_WOUT = 22 * MiB;
constexpr size_t WS_WUP = 26 * MiB;
constexpr size_t WS_WDN = 90 * MiB;
constexpr size_t WS_X1 = 122 * MiB;
constexpr size_t WS_H = 186 * MiB;
constexpr size_t WS_MIX = WS_H;

constexpr size_t WS_PROJ = 218 * MiB;
constexpr size_t WS_Y = WS_PROJ;
constexpr size_t WS_HID = WS_PROJ + 80 * MiB;
constexpr size_t WS_ELIST = 322 * MiB;
constexpr size_t WS_END = 324 * MiB;
constexpr int CW_AQ = 256;
constexpr int CW_CNT = 1024;
constexpr int CW_BAR = 8192;
constexpr int CW_DNQ = 208;
constexpr int CW_UPF = 65536;

constexpr int RING_BYTES = 143360;
constexpr int LDSCTL_OFF = RING_BYTES, MISC_OFF = LDSCTL_OFF + 320, CNTS_OFF = LDSCTL_OFF + 512, BASE_OFF = LDSCTL_OFF + 640, TAB_OFF = LDSCTL_OFF + 768;
constexpr int ROWL_OFF = 131072;
constexpr int LDS_BYTES = 147456;
constexpr int NWAVES = 8;

#define LDS_WAIT() asm volatile("s_waitcnt lgkmcnt(0)" ::: "memory")
#define VM_WAIT() asm volatile("s_waitcnt vmcnt(0)" ::: "memory")
#define RLX_AGENT __ATOMIC_RELAXED, __HIP_MEMORY_SCOPE_AGENT

__device__ __forceinline__ float bf2f(unsigned short u) { return __builtin_bit_cast(float, (unsigned)u << 16); }
__device__ __forceinline__ unsigned f2bf(float f) { unsigned u = __builtin_bit_cast(unsigned, f); return (u + 0x7fffu + ((u >> 16) & 1u)) >> 16; }
__device__ __forceinline__ unsigned pk2(float lo, float hi) { return f2bf(lo) | (f2bf(hi) << 16); }
template <int O> __device__ __forceinline__ float shx(float x) { static_assert(O >= 1 && O <= 16, "swizzle xor"); return __builtin_bit_cast(float, __builtin_amdgcn_ds_swizzle(__builtin_bit_cast(int, x), (O << 10) | 0x1f)); }
__device__ __forceinline__ float half_sum(float x) { return __builtin_bit_cast(float, __builtin_amdgcn_readlane(__builtin_bit_cast(int, x), 0)) + __builtin_bit_cast(float, __builtin_amdgcn_readlane(__builtin_bit_cast(int, x), 32)); }
__device__ __forceinline__ float half_max(float x) { return fmaxf(__builtin_bit_cast(float, __builtin_amdgcn_readlane(__builtin_bit_cast(int, x), 0)), __builtin_bit_cast(float, __builtin_amdgcn_readlane(__builtin_bit_cast(int, x), 32))); }
__device__ __forceinline__ float shup(float x, int o, int lane) { return __builtin_bit_cast(float, __builtin_amdgcn_ds_bpermute((lane - o) << 2, __builtin_bit_cast(int, x))); }
__device__ __forceinline__ int shup_i(int x, int o, int lane) { return __builtin_amdgcn_ds_bpermute((lane - o) << 2, x); }
__device__ __forceinline__ float wave_sum(float v) { v += shx<1>(v); v += shx<2>(v); v += shx<4>(v); v += shx<8>(v); v += shx<16>(v); return half_sum(v); }

namespace pg8 {
constexpr int BM = 256, BK = 64, HALF = 128, HTB = HALF * BK * 2, STAGE_BYTES = 8 * HTB, NXCD = 8, WGM = 8;
__host__ __device__ __forceinline__ int lds_byte(int r, int c) { const int st = (r >> 4) * 2 + (c >> 5), rr = r & 15, cc = c & 31, ob = rr * 64 + cc * 2; return st * 1024 + (ob ^ (((ob >> 9) & 1) << 5)); }
__host__ __device__ __forceinline__ void stage_rc(int b, int& R, int& C) { const int st = b / 1024, sb = b % 1024, swz = sb ^ (((sb >> 9) & 1) << 5); R = (st >> 1) * 16 + swz / 64; C = (st & 1) * 32 + (swz % 64) / 2; }
__host__ __device__ __forceinline__ int perm32(int rho) { const int n = rho >> 4, i = rho & 15; return 8 * (i >> 2) + 4 * n + (i & 3); }

struct Unit { int pm, pn; size_t bo; };
struct Gemm { const bf16* A; const bf16* Bt; int M, N, K; };

struct StaticOrder {
    int nM, nN, nwg, G, c;
    __host__ __device__ void init(int M_, int N_, int G_, int c_) { nM = M_ / BM; nN = N_ / BM; nwg = nM * nN; G = G_; c = c_; }
    __host__ __device__ bool next(int i, Unit& u) const {
        const long L = (long)i * G + c; if (L >= nwg) return false;
        int wgid = (int)L; { const int q = nwg / NXCD, r = nwg % NXCD, xcd = wgid % NXCD, off = wgid / NXCD; wgid = (xcd < r ? xcd * (q + 1) : r * (q + 1) + (xcd - r) * q) + off; }
        const int nig = WGM * nN, gid = wgid / nig, fm = gid * WGM, gsz = (nM - fm) < WGM ? (nM - fm) : WGM;
        u.pm = fm + ((wgid % nig) % gsz); u.pn = (wgid % nig) / gsz; u.bo = 0; return true;
    }
};
struct GroupOrder {
    const LAS int* tab; int ntile, ncol, G, c; size_t ebytes;
    __device__ __forceinline__ bool next(int i, Unit& u) const {
        const long L = (long)i * G + c; if (L >= (long)ntile * ncol) return false;
        u.pm = (int)(L / ncol); u.pn = (int)(L % ncol);
        const int e = __builtin_amdgcn_readfirstlane(tab[u.pm]); u.bo = (size_t)e * ebytes; return true;
    }
};

struct OneUnit { Unit u; __device__ __forceinline__ bool next(int i, Unit& o) const { if (i != 0) return false; o = u; return true; } };
struct DynOrder {
    unsigned* dq; unsigned* upf; const LAS int* tab; volatile LAS unsigned* M; int nd; size_t ebytes; int tid; unsigned G;
    mutable unsigned ppop, pflag;
    __device__ __forceinline__ void issue(unsigned idnext) const {
        ppop = G + __builtin_amdgcn_atomic_inc32(dq, 0xFFFFFFFFu, __ATOMIC_RELAXED, "agent");
        pflag = 2u; if ((int)idnext < nd) pflag = __hip_atomic_load(upf + (idnext >> 2) * 16, __ATOMIC_RELAXED, __HIP_MEMORY_SCOPE_AGENT);
    }
    __device__ __forceinline__ void unit(int id, Unit& u) const { u.pm = id >> 2; u.pn = id & 3; u.bo = (size_t)__builtin_amdgcn_readfirstlane(tab[id >> 2]) * ebytes; }
    __device__ __forceinline__ bool next(int i, Unit& u) const {
        if (i == 0) { const int id = __builtin_amdgcn_readfirstlane((int)M[4]); if (id >= nd) return false; unit(id, u); return true; }
        if (tid == 0) {
            const unsigned idn = M[5]; const bool ready = (int)idn < nd && pflag >= 2u;
            M[6] = ready ? 1u : 0u;
            if (ready) { asm volatile("buffer_inv sc1" ::: "memory"); M[4] = idn; const unsigned idn2 = ppop; M[5] = idn2; issue(idn2); }
        }
        asm volatile("s_waitcnt lgkmcnt(0)\n\ts_barrier" ::: "memory");
        if (__builtin_amdgcn_readfirstlane((int)M[6]) == 0) return false;
        unit(__builtin_amdgcn_readfirstlane((int)M[4]), u); return true;
    }
};

__device__ __forceinline__ unsigned cvt_pk_bf16(float lo, float hi) { unsigned r; asm volatile("v_cvt_pk_bf16_f32 %0, %1, %2" : "=v"(r) : "v"(lo), "v"(hi)); return r; }

struct EpiBf16 {
    static constexpr bool PERM = true, PUBLISH = false;
    bf16* O; int ldc;
    __device__ __forceinline__ void operator()(const f32x4 (&acc)[2][2][4][2], const Unit& u, int wr, int wc, int fr, int fq) const {
        const int row0 = u.pm * BM + wr * 64 + fr; const int col0 = u.pn * BM + wc * 32 + 8 * fq;
#pragma unroll
        for (int ai = 0; ai < 2; ++ai)
#pragma unroll
            for (int m = 0; m < 4; ++m) { bf16* rowp = O + (size_t)(row0 + ai * HALF + m * 16) * ldc + col0;
#pragma unroll
                for (int bj = 0; bj < 2; ++bj) { const f32x4 v0 = acc[ai][bj][m][0], v1 = acc[ai][bj][m][1];
                    u32x4 w; w.x = cvt_pk_bf16(v0[0], v0[1]); w.y = cvt_pk_bf16(v0[2], v0[3]); w.z = cvt_pk_bf16(v1[0], v1[1]); w.w = cvt_pk_bf16(v1[2], v1[3]);
                    *(u32x4*)(rowp + bj * HALF) = w; } }
    }
};
struct EpiResGate {
    static constexpr bool PERM = true, PUBLISH = false;
    const float* base32; const bf16* base16; bf16* out; const float* gate;
    __device__ __forceinline__ void operator()(const f32x4 (&acc)[2][2][4][2], const Unit& u, int wr, int wc, int fr, int fq) const {
        const int col0 = u.pn * BM + wc * 32 + 8 * fq; const float* g = gate + (size_t)(u.pm >> 3) * 6144 + col0;
        f32x4 gv[2][2];
#pragma unroll
        for (int bj = 0; bj < 2; ++bj)
#pragma unroll
            for (int n = 0; n < 2; ++n) gv[bj][n] = *(const f32x4*)(g + bj * HALF + n * 4);
#pragma unroll
        for (int ai = 0; ai < 2; ++ai)
#pragma unroll
            for (int m = 0; m < 4; ++m) { const size_t off = (size_t)(u.pm * BM + ai * HALF + wr * 64 + m * 16 + fr) * DM + col0;
#pragma unroll
                for (int bj = 0; bj < 2; ++bj) { f32x4 b0, b1;
                    if (base32) { b0 = *(const f32x4*)(base32 + off + bj * HALF); b1 = *(const f32x4*)(base32 + off + bj * HALF + 4); }
                    else { const u32x4 r = *(const u32x4*)(base16 + off + bj * HALF);
                        b0 = (f32x4){bf2f(r.x & 0xffff), bf2f(r.x >> 16), bf2f(r.y & 0xffff), bf2f(r.y >> 16)}; b1 = (f32x4){bf2f(r.z & 0xffff), bf2f(r.z >> 16), bf2f(r.w & 0xffff), bf2f(r.w >> 16)}; }
                    const f32x4 v0 = b0 + gv[bj][0] * acc[ai][bj][m][0], v1 = b1 + gv[bj][1] * acc[ai][bj][m][1];
                    u32x4 w; w.x = cvt_pk_bf16(v0[0], v0[1]); w.y = cvt_pk_bf16(v0[2], v0[3]); w.z = cvt_pk_bf16(v1[0], v1[1]); w.w = cvt_pk_bf16(v1[2], v1[3]);
                    *(u32x4*)(out + off + bj * HALF) = w; } }
    }
};
struct EpiSwiglu {
    static constexpr bool PERM = true, PUBLISH = true;
    bf16* O; unsigned* flag;
    __device__ __forceinline__ void operator()(const f32x4 (&acc)[2][2][4][2], const Unit& u, int wr, int wc, int fr, int fq) const {
        const int row0 = u.pm * BM + wr * 64 + fr; const int col0 = u.pn * HALF + wc * 32 + 8 * fq;
#pragma unroll
        for (int ai = 0; ai < 2; ++ai)
#pragma unroll
            for (int m = 0; m < 4; ++m) { bf16* rowp = O + (size_t)(row0 + ai * HALF + m * 16) * FF + col0;
                float hv[8];
#pragma unroll
                for (int n = 0; n < 2; ++n)
#pragma unroll
                    for (int i = 0; i < 4; ++i) { const float a = acc[ai][0][m][n][i], b = acc[ai][1][m][n][i];
                        const float sg = __builtin_amdgcn_rcpf(1.f + __builtin_amdgcn_exp2f(-a * LOG2E)); hv[n * 4 + i] = a * sg * b; }
                u32x4 w; w.x = cvt_pk_bf16(hv[0], hv[1]); w.y = cvt_pk_bf16(hv[2], hv[3]); w.z = cvt_pk_bf16(hv[4], hv[5]); w.w = cvt_pk_bf16(hv[6], hv[7]);
                asm volatile("global_store_dwordx4 %0, %1, off sc1\n\ts_nop 2" :: "v"((const GAS bf16*)rowp), "v"(w) : "memory"); }
    }
};

template <class Epi, class Sched, bool ALIGN_EPI = false, bool SP2 = false, bool GATHER = false>
__device__ __forceinline__ void gemm_phase(LAS unsigned char* lds, const Gemm g, const Sched& S, const Epi& E, const int tid, const LAS int* rowl = nullptr) {
    static_assert(!GATHER || SP2, "gather mode is written for the SP2 loop");
    const int wid = __builtin_amdgcn_readfirstlane(tid >> 6), lane = tid & 63, wr = wid >> 2, wc = wid & 3, fr = lane & 15, fq = lane >> 4;
    const int K = g.K, nt = K / BK;
    unsigned voffA[2], voffB[2];
#pragma unroll
    for (int i = 0; i < 2; ++i) { int R, C; stage_rc(tid * 16 + i * 8192, R, C); const int Rb = Epi::PERM ? ((R & ~31) + perm32(R & 31)) : R;
        voffA[i] = (unsigned)(R * K + C) * 2u; voffB[i] = (unsigned)(Rb * K + C) * 2u; }
    const size_t kstep = (size_t)(BK * 2);
    const size_t hstep = (size_t)HALF * K * 2;
    const size_t tstep = 2 * hstep;
    const size_t hstepA = GATHER ? 0 : hstep, tstepA = GATHER ? 0 : tstep;
    unsigned voffGc[2][2], voffGn[2][2];
    int gR[2], gC[2];
#pragma unroll
    for (int i = 0; i < 2; ++i) stage_rc(tid * 16 + i * 8192, gR[i], gC[i]);
#define PG8_GOFF(dst, ui_) do { _Pragma("unroll") for (int h_ = 0; h_ < 2; ++h_) _Pragma("unroll") for (int i_ = 0; i_ < 2; ++i_) \
        dst[h_][i_] = (unsigned)rowl[(ui_) * 256 + h_ * HALF + gR[i_]] * (unsigned)(K * 2) + (unsigned)gC[i_] * 2u; } while (0)
    const unsigned ldsw = (unsigned)wid * 1024u;
    const int aoff = lds_byte(wr * 64 + fr, fq * 8), boff = lds_byte(wc * 32 + fr, fq * 8);
#define PG8_SA(b, h) (((b) * 2 + (h)) * HTB)
#define PG8_SB(b, h) ((4 + (b) * 2 + (h)) * HTB)
#define PG8_STAGE(bufoff, gbase, voff) do { _Pragma("unroll") for (int _i = 0; _i < 2; ++_i) \
        __builtin_amdgcn_global_load_lds((const unsigned*)((const char*)(gbase) + (voff)[_i]), (LAS unsigned*)(lds + (bufoff) + ldsw + _i * 8192), 16, 0, 0); } while (0)
#define PG8_STAGE_A(bufoff, gbase, H, NXT) do { if constexpr (GATHER) { unsigned vo_[2]; vo_[0] = (NXT) ? voffGn[H][0] : voffGc[H][0]; vo_[1] = (NXT) ? voffGn[H][1] : voffGc[H][1]; PG8_STAGE(bufoff, gbase, vo_); } \
        else { PG8_STAGE(bufoff, (const char*)(gbase) + (H) * hstep, voffA); } } while (0)
#define PG8_LDA(dst, b, h) do { _Pragma("unroll") for (int m = 0; m < 4; ++m) _Pragma("unroll") for (int k = 0; k < 2; ++k) dst[m][k] = *(const LAS bf16x8*)(lds + PG8_SA(b, h) + aoff + m * 2048 + k * 1024); } while (0)
#define PG8_LDB(dst, b, h) do { _Pragma("unroll") for (int n = 0; n < 2; ++n) _Pragma("unroll") for (int k = 0; k < 2; ++k) dst[n][k] = *(const LAS bf16x8*)(lds + PG8_SB(b, h) + boff + n * 2048 + k * 1024); } while (0)
#define PG8_MMA(ai, bj, At, Bt) do { __builtin_amdgcn_s_setprio(1); _Pragma("unroll") for (int m = 0; m < 4; ++m) _Pragma("unroll") for (int n = 0; n < 2; ++n) _Pragma("unroll") for (int k = 0; k < 2; ++k) \
        acc[ai][bj][m][n] = __builtin_amdgcn_mfma_f32_16x16x32_bf16(Bt[n][k], At[m][k], acc[ai][bj][m][n], 0, 0, 0); __builtin_amdgcn_s_setprio(0); } while (0)
#define PG8_WAIT_V(n) asm volatile("s_waitcnt vmcnt(" #n ")" ::: "memory")
#define PG8_WAIT_L(n) asm volatile("s_waitcnt lgkmcnt(" #n ")" ::: "memory")
#define PG8_BAR __builtin_amdgcn_s_barrier()
#define PG8_SCHED __builtin_amdgcn_sched_barrier(0)
    Unit cur, nxt; int ui = 0;
    if (!S.next(0, cur)) return;
    f32x4 acc[2][2][4][2];
#pragma unroll
    for (int a = 0; a < 2; ++a)
#pragma unroll
        for (int b = 0; b < 2; ++b)
#pragma unroll
            for (int m = 0; m < 4; ++m)
#pragma unroll
                for (int n = 0; n < 2; ++n) acc[a][b][m][n] = (f32x4){0.f, 0.f, 0.f, 0.f};
    bf16x8 At[4][2], B0[2][2], B1[2][2];
    const char* cA = (const char*)g.A + (size_t)cur.pm * tstepA; const char* cB = (const char*)g.Bt + cur.bo + (size_t)cur.pn * tstep;
    if constexpr (GATHER) { PG8_GOFF(voffGc, 0); PG8_GOFF(voffGn, 0); }
    if constexpr (SP2) {
        PG8_STAGE(PG8_SB(0, 0), cB, voffB); PG8_STAGE(PG8_SB(0, 1), cB + hstep, voffB); PG8_STAGE_A(PG8_SA(0, 0), cA, 0, false); PG8_STAGE_A(PG8_SA(0, 1), cA, 1, false);
        if (wr == 1) PG8_BAR;
        PG8_WAIT_V(2); PG8_BAR;
        PG8_STAGE(PG8_SB(1, 0), cB + kstep, voffB); PG8_STAGE_A(PG8_SA(1, 0), cA + kstep, 0, false); PG8_STAGE(PG8_SB(1, 1), cB + hstep + kstep, voffB);
        PG8_WAIT_V(6); PG8_BAR;
    } else {
        PG8_STAGE(PG8_SB(0, 0), cB, voffB); PG8_STAGE(PG8_SA(0, 0), cA, voffA); PG8_STAGE(PG8_SB(0, 1), cB + hstep, voffB); PG8_STAGE(PG8_SA(0, 1), cA + hstep, voffA);
        if (wr == 1) PG8_BAR;
        PG8_WAIT_V(4); PG8_BAR;
        PG8_STAGE(PG8_SB(1, 0), cB + kstep, voffB); PG8_STAGE(PG8_SA(1, 0), cA + kstep, voffA); PG8_STAGE(PG8_SB(1, 1), cB + hstep + kstep, voffB);
        PG8_WAIT_V(6); PG8_BAR;
    }
    for (;;) {
        const bool has_next = S.next(ui + 1, nxt);
        if constexpr (GATHER) { if (has_next) PG8_GOFF(voffGn, ui + 1); }
        const char* nA = has_next ? (const char*)g.A + (size_t)nxt.pm * tstepA : cA; const char* nB = has_next ? (const char*)g.Bt + nxt.bo + (size_t)nxt.pn * tstep : cB;
#pragma unroll 1
        for (int t = 0; t < nt; t += 2) {
            const bool last = (t == nt - 2);
            const char* a1 = cA + (size_t)(t + 1) * kstep;
            const char* a2 = last ? nA : cA + (size_t)(t + 2) * kstep; const char* b2 = last ? nB : cB + (size_t)(t + 2) * kstep;
            const char* a3 = a2 + kstep; const char* b3 = b2 + kstep;
            if constexpr (SP2) {
            PG8_LDB(B0, 0, 0); PG8_LDB(B1, 0, 1); PG8_SCHED; PG8_LDA(At, 0, 0); PG8_STAGE_A(PG8_SA(1, 1), a1, 1, false);
            PG8_WAIT_V(8); PG8_WAIT_L(0); PG8_BAR; PG8_MMA(0, 0, At, B0); PG8_MMA(0, 1, At, B1); PG8_BAR; PG8_SCHED;
            PG8_LDA(At, 0, 1); PG8_STAGE(PG8_SB(0, 0), b2, voffB); PG8_STAGE(PG8_SB(0, 1), b2 + hstep, voffB); PG8_STAGE_A(PG8_SA(0, 0), a2, 0, last);
            PG8_WAIT_V(8); PG8_WAIT_L(0); PG8_BAR; PG8_MMA(1, 0, At, B0); PG8_MMA(1, 1, At, B1); PG8_BAR; PG8_SCHED;
            PG8_LDB(B0, 1, 0); PG8_LDB(B1, 1, 1); PG8_SCHED; PG8_LDA(At, 1, 0); PG8_STAGE_A(PG8_SA(0, 1), a2, 1, last);
            PG8_WAIT_V(8); PG8_WAIT_L(0); PG8_BAR; PG8_MMA(0, 0, At, B0); PG8_MMA(0, 1, At, B1); PG8_BAR; PG8_SCHED;
            PG8_LDA(At, 1, 1); PG8_STAGE(PG8_SB(1, 0), b3, voffB); PG8_STAGE(PG8_SB(1, 1), b3 + hstep, voffB); PG8_STAGE_A(PG8_SA(1, 0), a3, 0, last);
            PG8_WAIT_V(8); PG8_WAIT_L(0); PG8_BAR; PG8_MMA(1, 0, At, B0); PG8_MMA(1, 1, At, B1); PG8_BAR; PG8_SCHED;
            } else {
            PG8_LDB(B0, 0, 0); PG8_SCHED; PG8_LDA(At, 0, 0); PG8_STAGE(PG8_SA(1, 1), a1 + hstep, voffA);
            PG8_WAIT_L(8); PG8_BAR; PG8_WAIT_L(0); PG8_MMA(0, 0, At, B0); PG8_BAR; PG8_SCHED;
            PG8_LDB(B1, 0, 1); PG8_STAGE(PG8_SB(0, 0), b2, voffB);
            PG8_BAR; PG8_WAIT_L(0); PG8_MMA(0, 1, At, B1); PG8_BAR;
            PG8_LDA(At, 0, 1); PG8_STAGE(PG8_SA(0, 0), a2, voffA);
            PG8_BAR; PG8_WAIT_L(0); PG8_MMA(1, 0, At, B0); PG8_BAR; PG8_SCHED;
            PG8_STAGE(PG8_SB(0, 1), b2 + hstep, voffB);
            PG8_WAIT_V(6); PG8_BAR; PG8_MMA(1, 1, At, B1); PG8_BAR;
            PG8_LDB(B0, 1, 0); PG8_SCHED; PG8_LDA(At, 1, 0); PG8_STAGE(PG8_SA(0, 1), a2 + hstep, voffA);
            PG8_WAIT_L(8); PG8_BAR; PG8_WAIT_L(0); PG8_MMA(0, 0, At, B0); PG8_BAR; PG8_SCHED;
            PG8_LDB(B1, 1, 1); PG8_STAGE(PG8_SB(1, 0), b3, voffB);
            PG8_BAR; PG8_WAIT_L(0); PG8_MMA(0, 1, At, B1); PG8_BAR;
            PG8_LDA(At, 1, 1); PG8_STAGE(PG8_SA(1, 0), a3, voffA);
            PG8_BAR; PG8_WAIT_L(0); PG8_MMA(1, 0, At, B0); PG8_BAR; PG8_SCHED;
            PG8_STAGE(PG8_SB(1, 1), b3 + hstep, voffB);
            PG8_WAIT_V(6); PG8_BAR; PG8_MMA(1, 1, At, B1); PG8_BAR;
            }
        }
        if constexpr (ALIGN_EPI) { if (wr == 0) PG8_BAR; }
        E(acc, cur, wr, wc, fr, fq);
        if constexpr (Epi::PUBLISH) {
            asm volatile("s_waitcnt vmcnt(0)" ::: "memory"); PG8_BAR;
            if (tid == 0) __hip_atomic_fetch_add(E.flag + cur.pm * 16, 1u, __ATOMIC_RELAXED, __HIP_MEMORY_SCOPE_AGENT);
        }
        if (!has_next) break;
#pragma unroll
        for (int a = 0; a < 2; ++a)
#pragma unroll
            for (int b = 0; b < 2; ++b)
#pragma unroll
                for (int m = 0; m < 4; ++m)
#pragma unroll
                    for (int n = 0; n < 2; ++n) acc[a][b][m][n] = (f32x4){0.f, 0.f, 0.f, 0.f};
        cur = nxt; cA = nA; cB = nB; ++ui;
        if constexpr (GATHER) { _Pragma("unroll") for (int h_ = 0; h_ < 2; ++h_) _Pragma("unroll") for (int i_ = 0; i_ < 2; ++i_) voffGc[h_][i_] = voffGn[h_][i_]; }
        if constexpr (ALIGN_EPI) { if (wr == 1) PG8_BAR; }
    }
    PG8_WAIT_V(0);
    if constexpr (!ALIGN_EPI) { if (wr == 0) PG8_BAR; }
    PG8_BAR;
#undef PG8_SA
#undef PG8_STAGE_A
#undef PG8_GOFF
#undef PG8_SB
#undef PG8_STAGE
#undef PG8_LDA
#undef PG8_LDB
#undef PG8_MMA
#undef PG8_WAIT_V
#undef PG8_WAIT_L
#undef PG8_BAR
#undef PG8_SCHED
}
}

#define XB_TMO      128
#define XB_XCNT(j)  (256  + 64 * (j))
#define XB_XSUB(j)  (1280 + 64 * (j))
#define XB_XGEN(j)  (2304 + 64 * (j))
#define XB_TOP      3328
#define XB_TOPGEN   3392
#define XCD_BAR_WORDS 3456
#define XB_SPIN_CAP (1u << 18)
__device__ __forceinline__ unsigned xb_ld(unsigned* p)              { return __hip_atomic_load(p, __ATOMIC_RELAXED, __HIP_MEMORY_SCOPE_AGENT); }
__device__ __forceinline__ unsigned xb_add(unsigned* p, unsigned v) { return __hip_atomic_fetch_add(p, v, __ATOMIC_RELAXED, __HIP_MEMORY_SCOPE_AGENT); }
__device__ __forceinline__ unsigned xb_xcc_id() { return (unsigned)__builtin_amdgcn_s_getreg((3 << 11) | 20) & 0xFu; }
#define XB_SPIN(cond, bar) do { unsigned _sp = 0; while (cond) { __builtin_amdgcn_s_sleep(1); \
    if ((++_sp & 255u) == 0u) { if (xb_ld(&(bar)[XB_TMO])) break; if (_sp > XB_SPIN_CAP) { atomicAdd(&(bar)[XB_TMO], 1u); break; } } } } while (0)
struct XcdBarrier { unsigned* bar; unsigned x; volatile LAS unsigned* st; };
__device__ __forceinline__ XcdBarrier xcd_barrier_post(unsigned* bar, volatile LAS unsigned* st) {
    XcdBarrier b; b.bar = bar; b.x = xb_xcc_id(); b.st = st;
    if (threadIdx.x == 0) (void)xb_add(&bar[XB_XCNT(b.x)], 1u);
    return b;
}
__device__ __forceinline__ void xcd_barrier_complete(unsigned* bar, unsigned x, unsigned& nloc, unsigned& nx) {
    const unsigned G = gridDim.x * gridDim.y * gridDim.z;
    unsigned sum, cnt, mine, sp = 0u;
    for (;;) {
        sum = 0u; cnt = 0u; mine = 0u;
#pragma unroll 1
        for (unsigned j = 0; j < 16; ++j) { const unsigned c = xb_ld(&bar[XB_XCNT(j)]); sum += c; cnt += (c > 0u) ? 1u : 0u; mine = (j == x) ? c : mine; }
        if (sum == G) break;
        __builtin_amdgcn_s_sleep(1);
        if ((++sp & 255u) == 0u) { if (xb_ld(&bar[XB_TMO])) break; if (sp > XB_SPIN_CAP) { atomicAdd(&bar[XB_TMO], 1u); break; } }
    }
    nloc = mine > 0u ? mine : 1u; nx = cnt > 0u ? cnt : 1u;
}
__device__ __forceinline__ void xcd_barrier(const XcdBarrier& b, const int tid) {
    asm volatile("s_waitcnt vmcnt(0)" ::: "memory");
    __syncthreads();
    if (tid == 0) {
        unsigned* bar = b.bar;
        __builtin_amdgcn_s_waitcnt(0);
        unsigned nloc = b.st[0], nx = b.st[1];
        if (nloc == 0u) { xcd_barrier_complete(bar, b.x, nloc, nx); b.st[0] = nloc; b.st[1] = nx; }
        const unsigned old = xb_add(&bar[XB_XSUB(b.x)], 1u);
        const unsigned gen = old / nloc;
        if (old + 1u == (gen + 1u) * nloc) {
            __builtin_amdgcn_fence(__ATOMIC_RELEASE, "agent");
            asm volatile("s_waitcnt vmcnt(0)" ::: "memory");
            const unsigned og = xb_add(&bar[XB_TOP], 1u);
            const unsigned tg = og / nx;
            if (og + 1u == (tg + 1u) * nx) xb_add(&bar[XB_TOPGEN], 1u);
            else XB_SPIN(xb_ld(&bar[XB_TOPGEN]) == tg, bar);
            __builtin_amdgcn_fence(__ATOMIC_ACQUIRE, "agent");
            xb_add(&bar[XB_XGEN(b.x)], 1u);
            asm volatile("s_waitcnt vmcnt(0)" ::: "memory");
        } else {
            XB_SPIN(xb_ld(&bar[XB_XGEN(b.x)]) == gen, bar);
            __builtin_amdgcn_fence(__ATOMIC_ACQUIRE, "agent");
            asm volatile("s_waitcnt vmcnt(0)" ::: "memory");
        }
    }
    __syncthreads();
}

struct Frame {
    LAS unsigned char* lds;
    volatile LAS unsigned* MISC;
    unsigned* ctl;
    int tid, lane, wave, vcu, G, bx;
    float* out; unsigned char* ws;
};
struct Args { const float* in[28]; float* out; unsigned char* ws; int ph_lo, ph_hi; };
enum { I_X = 0, I_C, I_ADAW, I_ADAB, I_N1G, I_N2G, I_WIN, I_BF, I_QNA, I_KNA, I_QNC, I_KNC, I_LQ1, I_LK1, I_LQ2, I_LK2, I_SUBLN, I_QND, I_KND, I_MIXB, I_WOUT,
       I_WG, I_BG, I_WE, I_BE, I_W1, I_W3, I_W2 };
template <int I> __device__ __forceinline__ const float* inp() {
    auto ka = __builtin_amdgcn_kernarg_segment_ptr(); unsigned long long raw;
    asm volatile("s_load_dwordx2 %0, %1, %2\n\ts_waitcnt lgkmcnt(0)" : "=s"(raw) : "s"(ka), "i"(I * 8));
    return (const float*)(const GAS float*)raw;
}


struct TItem { const float* W; bf16* WT; const float* rs; int ldw, K, dst_row0, src_n0, kb, mapin; };
__device__ __forceinline__ int colmap_in(int n) { return n < 768 ? n : (n < 2984 ? n + 4 : (n < 2988 ? n - 2984 + 768 : -1)); }
__device__ __forceinline__ void t_load(const TItem& T, f32x4 (&v)[8], int lane) {
    const int k0 = 64 * T.kb, r8 = lane >> 3, c4 = (lane & 7) * 4; const int sc = T.mapin ? colmap_in(T.src_n0 + c4) : T.src_n0 + c4;
#pragma unroll
    for (int i = 0; i < 8; ++i) { v[i] = (f32x4){0.f, 0.f, 0.f, 0.f}; if (sc >= 0) v[i] = *(const f32x4*)(T.W + (size_t)(k0 + 8 * r8 + i) * T.ldw + sc); }
}
__device__ __forceinline__ void t_store(const TItem& T, f32x4 (&v)[8], LAS float* scr, int lane) {
    (void)scr;
    const int k0 = 64 * T.kb, r8 = lane >> 3, c4 = (lane & 7) * 4;
    if (T.rs) {
#pragma unroll
        for (int i = 0; i < 8; ++i) v[i] = v[i] * T.rs[k0 + 8 * r8 + i]; }
#pragma unroll
    for (int c = 0; c < 4; ++c) { u32x4 o; o.x = pg8::cvt_pk_bf16(v[0][c], v[1][c]); o.y = pg8::cvt_pk_bf16(v[2][c], v[3][c]); o.z = pg8::cvt_pk_bf16(v[4][c], v[5][c]); o.w = pg8::cvt_pk_bf16(v[6][c], v[7][c]);
        *(GAS u32x4*)(T.WT + (size_t)(T.dst_row0 + c4 + c) * T.K + k0 + 8 * r8) = o; }
}
__device__ __forceinline__ float lambda_init(int l) { return l == 0 ? 0.2f : (0.8f - 0.6f * 0.7408182206817179f); }

constexpr int CI_IN = 16 * 96, CI_OUT = 16 * 32, CI_UP1 = 16 * 8, CI_DN = 4 * 32, CN_UP = 32 * 2 * CI_UP1, CN_DN = 32 * CI_DN, NITEMS_L = CI_IN + CI_OUT + CN_UP + CN_DN;
__device__ __forceinline__ void fill_rowscale(Frame& F, const Args& A, int l, LAS float* rsl) {
    for (int k = F.tid; k < DM; k += 512) { float v = inp<I_MIXB>()[l * DM + k];
        if (k >= 512 && k < 768) v *= inp<I_SUBLN>()[l * 64 + ((k - 512) & 63)] * (1.f - lambda_init(l)); rsl[k] = v; }
}
__device__ __forceinline__ void convert_items(Frame& F, const Args& A, int l, int first, int stride, int limit, LAS float* rsl) {
    LAS float* scr = (LAS float*)(F.lds + F.wave * 8704);
    bf16* WIN = (bf16*)(F.ws + WS_WIN); bf16* WOUT = (bf16*)(F.ws + WS_WOUT); bf16* WUP = (bf16*)(F.ws + WS_WUP); bf16* WDN = (bf16*)(F.ws + WS_WDN);
    auto decode = [&](int it, TItem& T) {
        int r = it; T.rs = nullptr; T.mapin = 0;
        if (r < CI_IN) { T.kb = r / 96; const int nb = r % 96;
            T.W = inp<I_WIN>() + (size_t)l * DM * P_IN; T.ldw = P_IN; T.K = DM; T.WT = WIN + (size_t)l * NP * DM; T.dst_row0 = 32 * nb; T.src_n0 = 32 * nb; T.mapin = 1; return; }
        r -= CI_IN;
        if (r < CI_OUT) { T.kb = r / 32; const int nb = r % 32;
            T.W = inp<I_WOUT>() + (size_t)l * DM * DM; T.ldw = DM; T.K = DM; T.WT = WOUT + (size_t)l * DM * DM; T.dst_row0 = 32 * nb; T.src_n0 = 32 * nb; T.rs = (const float*)rsl; return; }
        r -= CI_OUT;
        if (r < CN_UP) { const int le = l * 32 + r / (2 * CI_UP1), q = r % (2 * CI_UP1), which = q / CI_UP1, q2 = q % CI_UP1; T.kb = q2 / 8; const int nb = q2 % 8;
            T.W = (which == 0 ? inp<I_W1>() : inp<I_W3>()) + (size_t)le * DM * FF; T.ldw = FF; T.K = DM; T.WT = WUP + (size_t)le * 512 * DM;
            const int n0 = 32 * nb, pn = n0 >> 7, j = n0 & 127; T.dst_row0 = 256 * pn + 128 * which + j; T.src_n0 = n0; return; }
        r -= CN_UP;
        { const int le = l * 32 + r / CI_DN, q = r % CI_DN; T.kb = q / 32; const int nb = q % 32;
          T.W = inp<I_W2>() + (size_t)le * FF * DM; T.ldw = DM; T.K = FF; T.WT = WDN + (size_t)le * DM * FF; T.dst_row0 = 32 * nb; T.src_n0 = 32 * nb; }
    };
    TItem T0, T1, T2; f32x4 v0[8], v1[8], v2[8]; int it = first;
    if (it < limit) { decode(it, T0); t_load(T0, v0, F.lane); }
    if (it + stride < limit) { decode(it + stride, T1); t_load(T1, v1, F.lane); }
    while (it < limit) {
        if (it + 2 * stride < limit) { decode(it + 2 * stride, T2); t_load(T2, v2, F.lane); }
        t_store(T0, v0, scr, F.lane); it += stride; if (it >= limit) break;
        if (it + 2 * stride < limit) { decode(it + 2 * stride, T0); t_load(T0, v0, F.lane); }
        t_store(T1, v1, scr, F.lane); it += stride; if (it >= limit) break;
        if (it + 2 * stride < limit) { decode(it + 2 * stride, T1); t_load(T1, v1, F.lane); }
        t_store(T2, v2, scr, F.lane); it += stride;
    }
}
constexpr int CV_L0 = NITEMS_L - CI_IN, CV_TOTAL = CV_L0 + NITEMS_L, CV_CHUNK = 64, CW_CVQ = 192;
__device__ __forceinline__ void convert_chunk(Frame& F, const Args& A, int gbase, LAS float* rsl2  ) {
    const int g0 = gbase + F.wave * (CV_CHUNK / NWAVES);
#pragma unroll 1
    for (int l = 0; l < 2; ++l) {
        const int lo = g0 > (l ? CV_L0 : 0) ? g0 : (l ? CV_L0 : 0), hi0 = g0 + CV_CHUNK / NWAVES, hi = hi0 < (l ? CV_TOTAL : CV_L0) ? hi0 : (l ? CV_TOTAL : CV_L0);
        if (lo < hi) { const int off = l ? -CV_L0 : CI_IN; convert_items(F, A, l, lo + off, 1, hi + off, rsl2 + l * DM); }
    }
}
__device__ __forceinline__ void convert_layer1_in_gap(Frame& F, const Args& A, int n2  ) {
    LAS float* rsl = (LAS float*)(F.lds + 8 * 8704);
    if (n2 < 0) n2 = 0; if (n2 > F.G - 32) n2 = F.G - 32;
    if (F.bx < n2) return;
    fill_rowscale(F, A, 1, rsl);
    __syncthreads();
    const int nw = (F.G - n2) * NWAVES;
    convert_items(F, A, 1, (F.bx - n2) * NWAVES + F.wave, nw, NITEMS_L, rsl);
    __syncthreads();
}

__device__ __forceinline__ void p0_prologue(Frame& F, const Args& A) {
    LAS float* rsl = (LAS float*)(F.lds + 8 * 8704);
    fill_rowscale(F, A, 0, rsl);
    __syncthreads();
    const int gw = F.vcu * NWAVES + F.wave, NGW = F.G * NWAVES;
    convert_items(F, A, 0, gw, NGW, BG_CONVERT ? CI_IN : NITEMS_L, rsl);
    if (!GAP_CONVERT && !BG_CONVERT) { __syncthreads(); fill_rowscale(F, A, 1, rsl); __syncthreads(); convert_items(F, A, 1, gw, NGW, NITEMS_L, rsl); }
    { bf16* WRH = (bf16*)(F.ws + WS_WR); bf16* WRL = WRH + 2 * 48 * DM;
      for (int i = gw * 64 + F.lane; i < 2 * 48 * DM; i += NGW * 64) { const int l = i / (48 * DM), r = i % (48 * DM), o = r >> 10, k = r & 1023;
          float w = 0.f; if (o < 4) w = inp<I_WG>()[((size_t)l * DM + k) * 4 + o]; else if (o < 36) w = inp<I_WE>()[((size_t)l * DM + k) * 32 + (o - 4)];
          const unsigned hi = f2bf(w); WRH[i] = (bf16)hi; WRL[i] = (bf16)f2bf(w - bf2f((unsigned short)hi)); } }
    if (F.bx == 0 && F.wave == 0) {
        for (int l = 0; l < 2; ++l) { float a = 0.f, b = 0.f; if (F.lane < 32) { a = inp<I_LQ1>()[l * 32 + F.lane] * inp<I_LK1>()[l * 32 + F.lane]; b = inp<I_LQ2>()[l * 32 + F.lane] * inp<I_LK2>()[l * 32 + F.lane]; }
            a = wave_sum(a); b = wave_sum(b); if (F.lane == 0) ((float*)(F.ws + WS_MISC))[l] = __expf(a) - __expf(b) + lambda_init(l); }
    }
    __syncthreads();
    LAS float* cact = (LAS float*)F.lds;
    LAS float* red = (LAS float*)(F.lds + 32768);
    for (int i = F.tid; i < BATCH * DM; i += 512) { const float c = inp<I_C>()[i]; cact[i] = c / (1.f + __expf(-c)); }
    __syncthreads();
    for (int item = F.bx; item < 2 * 96; item += F.G) {
        const int l = item / 96, nb = item % 96, n = nb * 64 + F.lane; const float* aw = inp<I_ADAW>() + (size_t)l * DM * 6144 + n;
        float acc[8];
#pragma unroll
        for (int b = 0; b < 8; ++b) acc[b] = 0.f;
        const int k0 = F.wave * 128;
#pragma unroll 32
        for (int k = 0; k < 128; ++k) { const float w = aw[(size_t)(k0 + k) * 6144];
#pragma unroll
            for (int b = 0; b < 8; ++b) acc[b] += cact[b * DM + k0 + k] * w; }
#pragma unroll
        for (int b = 0; b < 8; ++b) red[(F.wave * 8 + b) * 64 + F.lane] = acc[b];
        __syncthreads();
        { const int b = F.wave; float s = inp<I_ADAB>()[l * 6144 + n];
#pragma unroll
          for (int w = 0; w < 8; ++w) s += red[(w * 8 + b) * 64 + F.lane];
          ((float*)(F.ws + WS_MOD))[((size_t)l * 8 + b) * 6144 + n] = s; }
        __syncthreads();
    }
}

__device__ __forceinline__ void build_tables(Frame& F, int l) {
    volatile LAS int* cnts = (volatile LAS int*)(F.lds + CNTS_OFF); volatile LAS int* base = (volatile LAS int*)(F.lds + BASE_OFF); volatile LAS int* tab = (volatile LAS int*)(F.lds + TAB_OFF);
    __syncthreads();
    if (F.tid < 64) {
        const int e = F.tid; int cnt = 0; if (e < 32) cnt = (int)__hip_atomic_load(F.ctl + CW_CNT + (l * 32 + e) * 16, RLX_AGENT);
        const int n = (cnt + 255) >> 8; int incl = n;
#pragma unroll
        for (int o = 1; o < 32; o <<= 1) { const int u = shup_i(incl, o, e); if (e >= o) incl += u; }
        const int t0 = incl - n;
        if (e < 32) { cnts[e] = cnt; base[e] = t0; for (int j = 0; j < n && t0 + j < MAXTILE; ++j) tab[t0 + j] = e; }
        if (e == 31) F.MISC[1] = (unsigned)(incl < MAXTILE ? incl : MAXTILE);
    }
    __syncthreads();
}
__device__ __forceinline__ void row_pass(Frame& F, const Args& A, int mode, int l) {
    const int gw = F.vcu * NWAVES + F.wave; const int lane = F.lane;
    const float* MOD = (const float*)(F.ws + WS_MOD);
    bf16* X1 = (bf16*)(F.ws + WS_X1); bf16* H = (bf16*)(F.ws + WS_H); const bf16* Y = (const bf16*)(F.ws + WS_Y);
    const int* tok_e = (const int*)(F.ws + WS_TOK); const int* tok_pos = (const int*)(F.ws + WS_TOK) + 4 * M; const float* tok_w = (const float*)(F.ws + WS_TOK) + 2 * M;
    volatile LAS int* basel = (volatile LAS int*)(F.lds + BASE_OFF);
    if (mode != 0) build_tables(F, mode == 1 ? 0 : 1);
    const int b = (gw * 8) >> 11; const int lp = (mode == 1) ? 0 : 1;
    f32x4 g2v[4], gm[4], shv[4];
#pragma unroll
    for (int j = 0; j < 4; ++j) { const int col = 256 * j + 4 * lane;
        g2v[j] = (f32x4){0.f, 0.f, 0.f, 0.f}; gm[j] = g2v[j]; shv[j] = g2v[j];
        if (mode != 0) g2v[j] = *(const f32x4*)(MOD + ((size_t)lp * 8 + b) * 6144 + 5 * DM + col);
        if (mode != 2) { const float* md = MOD + ((size_t)l * 8 + b) * 6144; gm[j] = *(const f32x4*)(inp<I_N1G>() + l * DM + col) * (*(const f32x4*)(md + DM + col) + 1.0f); shv[j] = *(const f32x4*)(md + col); } }
    for (int m0 = gw * 8; m0 < gw * 8 + 8; m0 += 4) {
        f32x4 v[4][4]; u32x2 ya[4][4], yb[4][4]; float wa[4], wb[4];
        if (mode != 0) {
            int sa[4], sb[4];
#pragma unroll
            for (int r = 0; r < 4; ++r) { const int m = m0 + r; sa[r] = 256 * basel[tok_e[m]] + tok_pos[m]; sb[r] = 256 * basel[tok_e[M + m]] + tok_pos[M + m]; wa[r] = tok_w[m]; wb[r] = tok_w[M + m]; }
#pragma unroll
            for (int r = 0; r < 4; ++r)
#pragma unroll
                for (int j = 0; j < 4; ++j) { const int col = 256 * j + 4 * lane; ya[r][j] = *(const u32x2*)(Y + (size_t)sa[r] * DM + col); yb[r][j] = *(const u32x2*)(Y + (size_t)sb[r] * DM + col); }
        }
#pragma unroll
        for (int r = 0; r < 4; ++r) { const int m = m0 + r;
            if (mode == 0) { const float* xr = inp<I_X>() + (size_t)m * DM;
#pragma unroll
                for (int j = 0; j < 4; ++j) v[r][j] = *(const f32x4*)(xr + 256 * j + 4 * lane); }
            else { const bf16* xr = X1 + (size_t)m * DM;
#pragma unroll
                for (int j = 0; j < 4; ++j) { const u32x2 q = *(const u32x2*)(xr + 256 * j + 4 * lane); v[r][j] = (f32x4){bf2f(q.x & 0xffff), bf2f(q.x >> 16), bf2f(q.y & 0xffff), bf2f(q.y >> 16)}; } } }
#pragma unroll
        for (int r = 0; r < 4; ++r) { const int m = m0 + r;
            if (mode != 0) {
#pragma unroll
                for (int j = 0; j < 4; ++j) { const u32x2 a = ya[r][j], c = yb[r][j];
                    f32x4 mo; mo[0] = wa[r] * bf2f(a.x & 0xffff) + wb[r] * bf2f(c.x & 0xffff); mo[1] = wa[r] * bf2f(a.x >> 16) + wb[r] * bf2f(c.x >> 16);
                    mo[2] = wa[r] * bf2f(a.y & 0xffff) + wb[r] * bf2f(c.y & 0xffff); mo[3] = wa[r] * bf2f(a.y >> 16) + wb[r] * bf2f(c.y >> 16);
                    v[r][j] = v[r][j] + g2v[j] * mo; }
                if (mode == 1) {
#pragma unroll
                    for (int j = 0; j < 4; ++j) { u32x2 q; q.x = pk2(v[r][j][0], v[r][j][1]); q.y = pk2(v[r][j][2], v[r][j][3]); *(u32x2*)(X1 + (size_t)m * DM + 256 * j + 4 * lane) = q; }
                } else { float* orow = F.out + (size_t)m * DM;
#pragma unroll
                    for (int j = 0; j < 4; ++j) *(f32x4*)(orow + 256 * j + 4 * lane) = v[r][j]; }
            }
            if (mode != 2) {
                float ss = 0.f;
#pragma unroll
                for (int j = 0; j < 4; ++j) ss += (v[r][j][0] * v[r][j][0] + v[r][j][1] * v[r][j][1]) + (v[r][j][2] * v[r][j][2] + v[r][j][3] * v[r][j][3]);
                const float rstd = 1.0f / sqrtf(wave_sum(ss) * (1.f / DM) + RMS_EPS);
#pragma unroll
                for (int j = 0; j < 4; ++j) { const f32x4 hv = v[r][j] * rstd * gm[j] + shv[j]; u32x2 w; w.x = pk2(hv[0], hv[1]); w.y = pk2(hv[2], hv[3]);
                    *(u32x2*)(H + (size_t)m * DM + 256 * j + 4 * lane) = w; }
            }
        }
    }
}

__device__ __forceinline__ void knorm_seg(bf16* p, int lane, int nlanes_active, int group_lanes, const float* gain, int gmask, float inv_n) {
    u32x2 raw = (u32x2){0u, 0u}; if (lane < nlanes_active) raw = *(const u32x2*)(p + 4 * lane);
    float x0 = bf2f(raw.x & 0xffff), x1 = bf2f(raw.x >> 16), x2 = bf2f(raw.y & 0xffff), x3 = bf2f(raw.y >> 16);
    float ss = (x0 * x0 + x1 * x1) + (x2 * x2 + x3 * x3);
    for (int o = 1; o < group_lanes; o <<= 1) ss += __shfl_xor(ss, o);
    const float rstd = 1.0f / sqrtf(ss * inv_n + RMS_EPS);
    const int c = (4 * lane) & gmask;
    x0 *= rstd * gain[c]; x1 *= rstd * gain[c + 1]; x2 *= rstd * gain[c + 2]; x3 *= rstd * gain[c + 3];
    if (lane < nlanes_active) { u32x2 w; w.x = pk2(x0, x1); w.y = pk2(x2, x3); *(u32x2*)(p + 4 * lane) = w; }
}
__device__ __forceinline__ unsigned sortable(float f) { const unsigned u = __builtin_bit_cast(unsigned, f); return (u & 0x80000000u) ? ~u : (u | 0x80000000u); }


__device__ __forceinline__ int wave_sum_i(int v) {
    v += __builtin_amdgcn_update_dpp(0, v, 0xB1, 0xF, 0xF, true);
    v += __builtin_amdgcn_update_dpp(0, v, 0x4E, 0xF, 0xF, true);
    v += __builtin_amdgcn_update_dpp(0, v, 0x141, 0xF, 0xF, true);
    v += __builtin_amdgcn_update_dpp(0, v, 0x140, 0xF, 0xF, true);
    return __builtin_amdgcn_readlane(v, 0) + __builtin_amdgcn_readlane(v, 16) + __builtin_amdgcn_readlane(v, 32) + __builtin_amdgcn_readlane(v, 48);
}
__device__ __forceinline__ void transpose32(unsigned (&a)[32]) {
#define TSTAGE(S, MSK) _Pragma("unroll") for (int i = 0; i < 32; ++i) if (!(i & S)) { const unsigned x = a[i], y = a[i + S]; a[i] = (x & MSK) | ((y << S) & ~MSK); a[i + S] = ((x >> S) & MSK) | (y & ~MSK); }
    TSTAGE(16, 0x0000FFFFu) TSTAGE(8, 0x00FF00FFu) TSTAGE(4, 0x0F0F0F0Fu) TSTAGE(2, 0x33333333u) TSTAGE(1, 0x55555555u)
#undef TSTAGE
}
__device__ __forceinline__ void sel_step(unsigned T, unsigned& cand, unsigned& above, int& na, int& nc, bool& done, bool& exact) {
    const unsigned ones = cand & T; const int s1 = wave_sum_i(__builtin_popcount(ones));
    if (na + s1 >= 256) { cand = ones; nc = s1; }
    else { above |= ones; na += s1; cand &= ~T; nc -= s1; }
    if (na + nc == 256) { done = true; exact = true; }
}
__device__ __forceinline__ unsigned sel_finish(unsigned cand, unsigned above, int na, bool exact, int lane) {
    if (exact) return above | cand;
    const int need = 256 - na; const int pc = __builtin_popcount(cand); int incl = pc;
#pragma unroll
    for (int o = 1; o < 64; o <<= 1) { const int t = shup_i(incl, o, lane); if (lane >= o) incl += t; }
    int take = need - (incl - pc); take = take < 0 ? 0 : (take > pc ? pc : take);
    unsigned w = cand, res = above;
    for (int k = 0; k < take; ++k) { const unsigned low = w & (0u - w); res |= low; w ^= low; }
    return res;
}

__device__ __forceinline__ void p3_prep(Frame& F, const Args& A, int l, int rep) {
    const int gw = F.vcu * NWAVES + F.wave, NGW = F.G * NWAVES;
    bf16* PROJ = (bf16*)(F.ws + WS_PROJ);
    if (!(rep > 0 && PROBE_P3_PART == 2)) { const float* ga = inp<I_KNA>() + l * 64; const float* gc = inp<I_KNC>() + l * 32; const float* gd = inp<I_KND>() + l * 64;
      const int la = F.lane; const int ca = (4 * la) & 63, cc = (4 * la) & 31;
      const f32x4 gva = *(const f32x4*)(ga + ca), gvc = *(const f32x4*)(gc + cc), gvd = *(const f32x4*)(gd + ca);
      for (int mb = gw * 8; mb < gw * 8 + 8; mb += 8) {
        u32x2 ra[8], rc[8], rd[8];
#pragma unroll
        for (int i = 0; i < 8; ++i) { bf16* row = PROJ + (size_t)(mb + i) * NP; ra[i] = *(const u32x2*)(row + C_AK + 4 * la); rc[i] = *(const u32x2*)(row + C_CK + 4 * la);
            rd[i] = (u32x2){0u, 0u}; if (la < 16) rd[i] = *(const u32x2*)(row + C_DK + 4 * la); }
#pragma unroll
        for (int i = 0; i < 8; ++i) { bf16* row = PROJ + (size_t)(mb + i) * NP;
            { float x0 = bf2f(ra[i].x & 0xffff), x1 = bf2f(ra[i].x >> 16), x2 = bf2f(ra[i].y & 0xffff), x3 = bf2f(ra[i].y >> 16); float ss = (x0 * x0 + x1 * x1) + (x2 * x2 + x3 * x3);
              ss += shx<1>(ss); ss += shx<2>(ss); ss += shx<4>(ss); ss += shx<8>(ss); const float rs = 1.0f / sqrtf(ss * (1.f / 64.f) + RMS_EPS);
              u32x2 w; w.x = pk2(x0 * rs * gva[0], x1 * rs * gva[1]); w.y = pk2(x2 * rs * gva[2], x3 * rs * gva[3]); *(u32x2*)(row + C_AK + 4 * la) = w; }
            { float x0 = bf2f(rc[i].x & 0xffff), x1 = bf2f(rc[i].x >> 16), x2 = bf2f(rc[i].y & 0xffff), x3 = bf2f(rc[i].y >> 16); float ss = (x0 * x0 + x1 * x1) + (x2 * x2 + x3 * x3);
              ss += shx<1>(ss); ss += shx<2>(ss); ss += shx<4>(ss); const float rs = 1.0f / sqrtf(ss * (1.f / 32.f) + RMS_EPS);
              u32x2 w; w.x = pk2(x0 * rs * gvc[0], x1 * rs * gvc[1]); w.y = pk2(x2 * rs * gvc[2], x3 * rs * gvc[3]); *(u32x2*)(row + C_CK + 4 * la) = w; }
            { float x0 = bf2f(rd[i].x & 0xffff), x1 = bf2f(rd[i].x >> 16), x2 = bf2f(rd[i].y & 0xffff), x3 = bf2f(rd[i].y >> 16); float ss = (x0 * x0 + x1 * x1) + (x2 * x2 + x3 * x3);
              ss += shx<1>(ss); ss += shx<2>(ss); ss += shx<4>(ss); ss += shx<8>(ss); const float rs = 1.0f / sqrtf(ss * (1.f / 64.f) + RMS_EPS);
              u32x2 w; w.x = pk2(x0 * rs * gvd[0], x1 * rs * gvd[1]); w.y = pk2(x2 * rs * gvd[2], x3 * rs * gvd[3]); if (la < 16) *(u32x2*)(row + C_DK + 4 * la) = w; }
        }
      }
    }
    if (!(rep > 0 && PROBE_P3_PART == 2)) {
        const int bh = gw >> 6, ck = gw & 63, b = bh >> 2, h = bh & 3; const float bfv = inp<I_BF>()[l * 4 + h];
        const int t = 32 * ck + (F.lane & 31);
        const float x = bf2f(PROJ[((size_t)b * SEQ + t) * NP + C_AF + h]) + bfv;
        float incl = fminf(x, 0.f) - log1pf(__expf(-fabsf(x)));
#pragma unroll
        for (int o = 1; o < 32; o <<= 1) { const float u = shup(incl, o, F.lane); if ((F.lane & 31) >= o) incl += u; }
        float* cum = (float*)(F.ws + WS_CUM);
        if (F.lane < 32) cum[(size_t)bh * SEQ + t] = incl;
        if (F.lane == 31) cum[32 * SEQ + bh * 64 + ck] = incl;
    }
    LAS float* sc = (LAS float*)F.lds;
    unsigned* MASK = (unsigned*)(F.ws + WS_MASK);
    constexpr int SCP = 2052;
    const int lane = F.lane, kq = lane >> 4, qi = lane & 15;
    __syncthreads();
    bf16x8 bq[8], wvr, akv[16];
    const auto unit_geom = [&](int i, int& b, int& t0, int& nkt) { const int u = F.bx + 256 * i; b = u >> 7; const int tqr = u & 127, tq = (i & 1) ? 127 - tqr : tqr; t0 = tq * 16; nkt = tq + 1; };
    const auto unit_load_q = [&](int i) { int b, t0, nkt; unit_geom(i, b, t0, nkt); const bf16* qrow = PROJ + (size_t)b * SEQ * NP + (size_t)(t0 + qi) * NP;
#pragma unroll
        for (int h = 0; h < 8; ++h) bq[h] = *(const bf16x8*)(qrow + C_IQ + h * 32 + 8 * kq);
        wvr = *(const bf16x8*)(qrow + C_IW); };
    const auto unit_load_k = [&](int i) { int b, t0, nkt; unit_geom(i, b, t0, nkt); const bf16* pb = PROJ + (size_t)b * SEQ * NP;
#pragma unroll
        for (int j = 0; j < 16; ++j) { const int kt = F.wave + 8 * j; akv[j] = (bf16x8){0, 0, 0, 0, 0, 0, 0, 0}; if (kt < nkt) akv[j] = *(const bf16x8*)(pb + (size_t)(kt * 16 + qi) * NP + C_IK + 8 * kq); } };
    const bool do_c = !(rep > 0 && PROBE_P3_PART == 1);
    if (do_c) unit_load_q(0);
    for (int i = 0; i < 4; ++i) {
        if (!do_c) break;
        int b, t0, nkt; unit_geom(i, b, t0, nkt);
        unit_load_k(i);
        float wq[8];
#pragma unroll
        for (int h = 0; h < 8; ++h) wq[h] = bf2f((unsigned short)wvr[h]) * (0.35355339059327373f * 0.17677669529663687f);
#pragma unroll
        for (int j = 0; j < 16; ++j) { const int kt = F.wave + 8 * j;
            if (kt < nkt) {
            f32x4 a4 = (f32x4){0.f, 0.f, 0.f, 0.f};
#pragma unroll
            for (int h = 0; h < 8; ++h) { const f32x4 s = __builtin_amdgcn_mfma_f32_16x16x32_bf16(akv[j], bq[h], (f32x4){0.f, 0.f, 0.f, 0.f}, 0, 0, 0);
#pragma unroll
                for (int r = 0; r < 4; ++r) a4[r] += wq[h] * fmaxf(s[r], 0.f); }
#pragma unroll
            for (int r = 0; r < 4; ++r) a4[r] += 0.f;
            { const int ci = kt * 4 + kq, L = ci >> 3, c = ci & 7;
              *(LAS f32x4*)(sc + qi * SCP + 4 * (L * 8 + (c ^ (L & 7)))) = a4; }
            } }
        if (i + 1 < 4) unit_load_q(i + 1);
        LDS_WAIT(); __syncthreads();
        if (rep > 0 && PROBE_P3_PART == 2) { }
        else if (t0 < 256) {
            for (int rr = 0; rr < 2; ++rr) { const int t = t0 + 2 * F.wave + rr; const int nb = t - 32 * lane + 1;
                MASK[((size_t)b * SEQ + t) * 64 + lane] = nb >= 32 ? 0xffffffffu : (nb <= 0 ? 0u : ((1u << nb) - 1u)); }
        } else {
            const int rA = 2 * F.wave, tA = t0 + rA, tB = tA + 1;
            unsigned ua[32], ub[32];
#pragma unroll
            for (int c = 0; c < 8; ++c) { const int off = 4 * (lane * 8 + (c ^ (lane & 7)));
                const f32x4 fa = *(const LAS f32x4*)(sc + rA * SCP + off), fb = *(const LAS f32x4*)(sc + (rA + 1) * SCP + off);
#pragma unroll
                for (int i = 0; i < 4; ++i) { ua[c * 4 + i] = sortable(fa[i]); ub[c * 4 + i] = sortable(fb[i]); } }
            transpose32(ua); transpose32(ub);
            unsigned candA, candB, abA = 0u, abB = 0u; int naA = 0, naB = 0, ncA = tA + 1, ncB = tB + 1; bool dA = false, dB = false, eA = false, eB = false;
            { const int nbA = tA - 32 * lane + 1, nbB = tB - 32 * lane + 1;
              candA = nbA >= 32 ? 0xffffffffu : (nbA <= 0 ? 0u : ((1u << nbA) - 1u)); candB = nbB >= 32 ? 0xffffffffu : (nbB <= 0 ? 0u : ((1u << nbB) - 1u)); }
#pragma unroll
            for (int bit = 31; bit >= 0; --bit) {
                if (!dA) sel_step(ua[bit], candA, abA, naA, ncA, dA, eA);
                if (!dB) sel_step(ub[bit], candB, abB, naB, ncB, dB, eB);
                if (dA && dB) break;
            }
            MASK[((size_t)b * SEQ + tA) * 64 + lane] = sel_finish(candA, abA, naA, eA, lane);
            MASK[((size_t)b * SEQ + tB) * 64 + lane] = sel_finish(candB, abB, naB, eB, lane);
        }
        __syncthreads();
    }
}

namespace att {
template <bool B> struct BoolC { static constexpr bool value = B; };
constexpr int SLOTB = 8192, L_K = 0, L_V = 3 * SLOTB, L_WS = 6 * SLOTB, L_OST = L_WS + 2048, L_CUM = L_OST + 8 * 8192, L_END = L_CUM + 8192;
constexpr int MROW = 66;
static_assert(L_OST + 256 * MROW * 4 <= L_END && L_END <= RING_BYTES, "attention LDS map");
constexpr float THR = 8.0f;
__device__ __forceinline__ int crow(int r, int hi) { return (r & 3) + 8 * (r >> 2) + 4 * hi; }
__device__ __forceinline__ void glds16(const void* gsrc, unsigned lds_dst) { unsigned keep;
    asm volatile("s_mov_b32 %0, m0\n\ts_mov_b32 m0, %2\n\ts_nop 0\n\tglobal_load_lds_dwordx4 %1, off\n\ts_mov_b32 m0, %0" : "=&s"(keep) : "v"(gsrc), "s"(lds_dst) : "memory"); }
#define ATT_WAIT_BAR() asm volatile("s_waitcnt vmcnt(0) lgkmcnt(0)\n\ts_barrier" ::: "memory")
__device__ __forceinline__ unsigned cvtpk_s(float lo, float hi) { typedef __bf16 bf16x2_t __attribute__((ext_vector_type(2))); f32x2 v = {lo, hi}; bf16x2_t b = __builtin_convertvector(v, bf16x2_t); return __builtin_bit_cast(unsigned, b); }
__device__ __forceinline__ float xhalf(float x, int hi) { auto rr = __builtin_amdgcn_permlane32_swap(__builtin_bit_cast(unsigned, x), __builtin_bit_cast(unsigned, x), false, false);
    return __builtin_bit_cast(float, hi ? rr[0] : rr[1]); }
template <int DA, int DB>
__device__ __forceinline__ void qkt(f32x16& p0, f32x16& p1, const LAS char* Kslot, const bf16x8* qr, const f32x16& cin, int r32, int hi) {
    const LAS char* kb = Kslot + hi * 1024 + r32 * 16;
#pragma unroll
    for (int d0 = DA; d0 < DB; ++d0) {
        const bf16x8 b0 = *(const LAS bf16x8*)(kb + d0 * 2048), b1 = *(const LAS bf16x8*)(kb + d0 * 2048 + 512);
        if (d0 == DA) { p0 = __builtin_amdgcn_mfma_f32_32x32x16_bf16(b0, qr[d0], cin, 0, 0, 0); p1 = __builtin_amdgcn_mfma_f32_32x32x16_bf16(b1, qr[d0], cin, 0, 0, 0); }
        else { p0 = __builtin_amdgcn_mfma_f32_32x32x16_bf16(b0, qr[d0], p0, 0, 0, 0); p1 = __builtin_amdgcn_mfma_f32_32x32x16_bf16(b1, qr[d0], p1, 0, 0, 0); } }
}
__device__ __forceinline__ void pv(f32x16* o, int vb, bf16x8 pa0, bf16x8 pa1, bf16x8 pa2, bf16x8 pa3) {
    s16x4 lo[2][4], hi[2][4];
#pragma unroll
    for (int d0 = 0; d0 < 2; ++d0)
#pragma unroll
        for (int ks = 0; ks < 4; ++ks) {
            asm volatile("ds_read_b64_tr_b16 %0,%1 offset:%c2" : "=&v"(lo[d0][ks]) : "v"(vb), "i"(d0 * 4096 + ks * 1024) : "memory");
            asm volatile("ds_read_b64_tr_b16 %0,%1 offset:%c2" : "=&v"(hi[d0][ks]) : "v"(vb), "i"(d0 * 4096 + ks * 1024 + 512) : "memory"); }
    asm volatile("s_waitcnt lgkmcnt(0)" ::: "memory"); __builtin_amdgcn_sched_barrier(0);
#define PK(d, k) (bf16x8){lo[d][k][0], lo[d][k][1], lo[d][k][2], lo[d][k][3], hi[d][k][0], hi[d][k][1], hi[d][k][2], hi[d][k][3]}
    o[0] = __builtin_amdgcn_mfma_f32_32x32x16_bf16(pa0, PK(0, 0), o[0], 0, 0, 0); o[1] = __builtin_amdgcn_mfma_f32_32x32x16_bf16(pa0, PK(1, 0), o[1], 0, 0, 0);
    o[0] = __builtin_amdgcn_mfma_f32_32x32x16_bf16(pa1, PK(0, 1), o[0], 0, 0, 0); o[1] = __builtin_amdgcn_mfma_f32_32x32x16_bf16(pa1, PK(1, 1), o[1], 0, 0, 0);
    o[0] = __builtin_amdgcn_mfma_f32_32x32x16_bf16(pa2, PK(0, 2), o[0], 0, 0, 0); o[1] = __builtin_amdgcn_mfma_f32_32x32x16_bf16(pa2, PK(1, 2), o[1], 0, 0, 0);
    o[0] = __builtin_amdgcn_mfma_f32_32x32x16_bf16(pa3, PK(0, 3), o[0], 0, 0, 0); o[1] = __builtin_amdgcn_mfma_f32_32x32x16_bf16(pa3, PK(1, 3), o[1], 0, 0, 0);
#undef PK
}
__device__ __forceinline__ float rowmax(const f32x16& p0, const f32x16& p1, int hi) {
    float a = fmaxf(fmaxf(p0[0], p0[1]), p1[0]), b = fmaxf(fmaxf(p0[2], p0[3]), p1[1]); a = fmaxf(fmaxf(a, p1[2]), p1[3]);
#pragma unroll
    for (int r = 4; r < 16; r += 4) { a = fmaxf(fmaxf(a, p0[r]), p0[r + 1]); b = fmaxf(fmaxf(b, p0[r + 2]), p0[r + 3]); a = fmaxf(fmaxf(a, p1[r]), p1[r + 1]); b = fmaxf(fmaxf(b, p1[r + 2]), p1[r + 3]); }
    const float m = fmaxf(a, b); return fmaxf(m, xhalf(m, hi));
}
struct AttnP { const bf16* proj; bf16* mix; const float* cum; const unsigned* mask; const float* qgain[4]; const float* kgain[4]; float lam; };

template <int VAR>
__device__ __forceinline__ void attn_unit(const AttnP& P, int b, int h, int qb, LAS char* sh, const int tid_in, const int pm, unsigned* qctr, volatile LAS unsigned* qslot) {
    int tid = tid_in; asm volatile("" : "+v"(tid));
    const int lane = tid & 63, r32 = lane & 31, hi = lane >> 5; const int wid = __builtin_amdgcn_readfirstlane(tid >> 6);
    const long rowbase = (long)b * SEQ; const int q0 = qb * 256, NT = 4 * (qb + 1);
    const int qrel = wid * 32 + r32, tq = q0 + qrel;
    constexpr bool REV = VAR != 0;
    constexpr int QCB = VAR == 0 ? C_AQ : VAR == 1 ? C_BQ : VAR == 2 ? C_CQ : C_DQ;
    constexpr int KCB = VAR == 0 ? C_AK : VAR == 1 ? C_BK : VAR == 2 ? C_CK : C_DK;
    constexpr int VCB = VAR == 0 ? C_AV : VAR == 1 ? C_BV : VAR == 2 ? C_CV : C_DV;
    const int Qc = QCB + 64 * h, Kc = VAR == 3 ? KCB : KCB + 64 * h, Vc = VAR == 3 ? VCB : VCB + 64 * h;
    const bf16* PR = P.proj;
    LAS float* wsf = (LAS float*)(sh + L_WS) + wid * 64;
    LAS float* stg = (LAS float*)(sh + L_OST) + wid * 2048;
    LAS float* cumL = (LAS float*)(sh + L_CUM);
    LAS unsigned* maskL = (LAS unsigned*)(sh + L_OST);
    const unsigned lds0 = (unsigned)(uintptr_t)sh;
    const bf16* ksrc = PR + (size_t)(rowbase + lane) * NP + Kc + wid * 8;
    const bf16* vsrc = PR + (size_t)(rowbase + 16 * (wid & 3) + (lane >> 2)) * NP + Vc + (wid >> 2) * 32 + (lane & 3) * 8;
    const unsigned kdst = lds0 + L_K + wid * 1024, vdst = lds0 + L_V + wid * 1024;
#define DMA_KV(t, slot) do { glds16(ksrc + (size_t)(t) * 64 * NP, (unsigned)__builtin_amdgcn_readfirstlane(kdst + (slot))); glds16(vsrc + (size_t)(t) * 64 * NP, (unsigned)__builtin_amdgcn_readfirstlane(vdst + (slot))); } while (0)
    DMA_KV(REV ? NT - 1 : 0, 0); DMA_KV(REV ? NT - 2 : 1, SLOTB);
    constexpr int NDQ = VAR == 2 ? 2 : 4; bf16x8 qpre[NDQ];
    { const bf16* Qw0 = PR + (size_t)(rowbase + tq) * NP + Qc;
#pragma unroll
      for (int d0 = 0; d0 < NDQ; ++d0) qpre[d0] = *(const bf16x8*)(Qw0 + d0 * 16 + hi * 8); }
    if (VAR == 0) {
        LAS float* pref = (LAS float*)(sh + L_WS);
        const float* cg = P.cum + (size_t)(b * 4 + h) * SEQ; float cgv[4];
#pragma unroll
        for (int k = 0; k < 4; ++k) { const int i = tid + 512 * k; cgv[k] = i < q0 + 256 ? cg[i] : 0.f; }
        if (tid < 64) { const float ct = P.cum[32 * SEQ + (b * 4 + h) * 64 + tid]; float incl = ct;
#pragma unroll
            for (int o = 1; o < 64; o <<= 1) { const float u = shup(incl, o, tid); if (tid >= o) incl += u; }
            pref[tid] = incl - ct; }
        asm volatile("s_waitcnt lgkmcnt(0)\n\ts_barrier" ::: "memory");
#pragma unroll
        for (int k = 0; k < 4; ++k) { const int i = tid + 512 * k; if (i < q0 + 256) cumL[i] = (cgv[k] + pref[i >> 5]) * LOG2E; }
        asm volatile("s_waitcnt lgkmcnt(0)\n\ts_barrier" ::: "memory");
    }
    if (VAR == 3) { const unsigned* mg = P.mask + (size_t)(rowbase + q0) * 64; const int nw = 2 * NT;
#pragma unroll 16
        for (int i = tid; i < 256 * 32; i += 512) { const int row = i >> 5, w = 2 * (i & 31); if (w < nw) *(LAS u32x2*)(maskL + row * MROW + w) = *(const u32x2*)(mg + row * 64 + w); } }
    asm volatile("s_waitcnt vmcnt(0) lgkmcnt(0)\n\ts_barrier" ::: "memory");
    const int vb0 = (int)(lds0 + L_V) + ((lane >> 4) & 1) * 32 + (lane & 3) * 8 + (4 * hi + ((lane & 15) >> 2)) * 64;
    float slope2 = 0.f;
    if (VAR == 2) slope2 = __builtin_amdgcn_exp2f(-(float)(2 * h + 1)) * LOG2E;
    if (VAR == 3) slope2 = __builtin_amdgcn_exp2f(-(float)(2 * h + 2)) * LOG2E;
    float cumt = 0.f; if (VAR == 0) cumt = cumL[tq];
    constexpr int NPASS = VAR == 2 ? 2 : 1;
    unsigned nxt_u = 0u;
    for (int pass = 0; pass < NPASS; ++pass) {
        bf16x8 qa[4]; float sb0 = 0.f;
        { const bf16* Qw = PR + (size_t)(rowbase + tq) * NP + Qc;
          constexpr int ND0 = VAR == 2 ? 2 : 4; const int dbase = VAR == 2 ? 2 * pass : 0;
          float qf[8 * ND0];
#pragma unroll
          for (int d0 = 0; d0 < ND0; ++d0) { bf16x8 raw = qpre[d0]; if (pass > 0) raw = *(const bf16x8*)(Qw + (dbase + d0) * 16 + hi * 8);
#pragma unroll
              for (int j = 0; j < 8; ++j) qf[d0 * 8 + j] = bf2f((unsigned short)raw[j]); }
          constexpr float SC = (VAR == 2 ? 0.17677669529663687f : 0.125f) * LOG2E;
          if (VAR != 1) {
              float ss = 0.f;
#pragma unroll
              for (int i = 0; i < 8 * ND0; ++i) ss += qf[i] * qf[i];
              ss += xhalf(ss, hi); const float rstd = 1.0f / sqrtf(ss * (VAR == 2 ? 1.f / 32.f : 1.f / 64.f) + RMS_EPS);
              const float* g = P.qgain[VAR];
#pragma unroll
              for (int d0 = 0; d0 < ND0; ++d0)
#pragma unroll
                  for (int j = 0; j < 8; ++j) qf[d0 * 8 + j] *= rstd * g[16 * d0 + 8 * hi + j] * SC;
          } else {
#pragma unroll
              for (int i = 0; i < 8 * ND0; ++i) qf[i] *= SC;
          }
          if (VAR == 2 || VAR == 3) {
              float n0 = 0.f;
#pragma unroll
              for (int i = 0; i < 8 * ND0; ++i) n0 += qf[i] * qf[i];
              n0 += xhalf(n0, hi);
              float gk = fabsf(P.kgain[VAR][lane & (VAR == 2 ? 31 : 63)]);
              gk = fmaxf(gk, shx<1>(gk)); gk = fmaxf(gk, shx<2>(gk)); gk = fmaxf(gk, shx<4>(gk)); gk = fmaxf(gk, shx<8>(gk)); gk = fmaxf(gk, shx<16>(gk)); gk = half_max(gk);
              sb0 = 1.02f * sqrtf(n0) * (VAR == 2 ? 5.656854249f : 8.0f) * gk;
          }
#pragma unroll
          for (int d0 = 0; d0 < ND0; ++d0) { u32x4 w; w.x = cvtpk_s(qf[d0 * 8 + 0], qf[d0 * 8 + 1]); w.y = cvtpk_s(qf[d0 * 8 + 2], qf[d0 * 8 + 3]); w.z = cvtpk_s(qf[d0 * 8 + 4], qf[d0 * 8 + 5]); w.w = cvtpk_s(qf[d0 * 8 + 6], qf[d0 * 8 + 7]);
              qa[d0] = __builtin_bit_cast(bf16x8, w); }
          if (VAR == 2) { qa[2] = qa[0]; qa[3] = qa[1]; }
        }
        float mhat = -1e30f, l_reg = 0.f, Rp = 1.f; f32x16 o[2]; const float sbound = sb0;
#pragma unroll
        for (int r = 0; r < 16; ++r) { o[0][r] = 0.f; o[1][r] = 0.f; }
        if (pass > 0) { DMA_KV(REV ? NT - 1 : 0, 0); DMA_KV(REV ? NT - 2 : 1, SLOTB); }
        int cur = 0, sl1 = SLOTB, sl2 = 2 * SLOTB;
        auto step = [&](auto band_c, const int it) -> bool {
            constexpr bool BAND = decltype(band_c)::value;
            const int t = REV ? NT - 1 - it : it;
            if (pm == 7) { }
            else if (it + 1 < NT) asm volatile("s_waitcnt vmcnt(2) lgkmcnt(0)\n\ts_barrier" ::: "memory");
            else ATT_WAIT_BAR();
            if (REV && it > 0) {
                const LAS unsigned* wz = (const LAS unsigned*)(sh + L_END) + ((it - 1) & 1) * 8;
                const u32x4 z0 = *(const LAS u32x4*)wz, z1 = *(const LAS u32x4*)(wz + 4);
                if (__builtin_amdgcn_readfirstlane((int)(z0.x & z0.y & z0.z & z0.w & z1.x & z1.y & z1.z & z1.w)) != 0) return true;
            }
            if (it + 2 < NT && pm != 7) DMA_KV(REV ? t - 2 : t + 2, sl2);
            const int jb = t - (NT - 4);
            float cinv = 0.f;
            if (VAR == 0) cinv = cumt;
            if (VAR == 2 || VAR == 3) cinv = slope2 * (float)(t * 64 + 4 * hi - tq);
            f32x16 cin;
#pragma unroll
            for (int r = 0; r < 16; ++r) cin[r] = cinv;
            f32x16 p0, p1;
            const LAS char* Ks = sh + L_K + cur;
            if (VAR == 2) { if (pass == 0) { const bf16x8 qq[4] = {qa[0], qa[1], qa[0], qa[1]}; qkt<0, 2>(p0, p1, Ks, qq, cin, r32, hi); }
                            else { const bf16x8 qq[4] = {qa[0], qa[1], qa[0], qa[1]}; qkt<2, 4>(p0, p1, Ks, qq, cin, r32, hi); } }
            else qkt<0, 4>(p0, p1, Ks, qa, cin, r32, hi);
            if (VAR != 1) {
                if (VAR == 0) { const LAS float* cp = cumL + t * 64 + 4 * hi;
#pragma unroll
                    for (int g = 0; g < 4; ++g) { const f32x4 c0 = *(const LAS f32x4*)(cp + 8 * g), c1 = *(const LAS f32x4*)(cp + 32 + 8 * g);
#pragma unroll
                        for (int i = 0; i < 4; ++i) { p0[4 * g + i] -= c0[i]; p1[4 * g + i] -= c1[i]; } } }
                if (VAR == 2 || VAR == 3) {
#pragma unroll
                    for (int r = 0; r < 16; ++r) { const float kc = (float)((r & 3) + 8 * (r >> 2)); p0[r] += slope2 * kc; p1[r] += slope2 * (kc + 32.f); } }
                if (VAR != 3) { if constexpr (BAND) { const int kb = 64 * jb + 4 * hi;
#pragma unroll
                    for (int r = 0; r < 16; ++r) { const int kv = kb + (r & 3) + 8 * (r >> 2); if (kv > qrel) p0[r] = -INFINITY; if (kv + 32 > qrel) p1[r] = -INFINITY; } } }
                else { const u32x2 mw = *(const LAS u32x2*)(maskL + qrel * MROW + 2 * t); const unsigned w0 = mw.x >> (4 * hi), w1 = mw.y >> (4 * hi);
#pragma unroll
                    for (int r = 0; r < 16; ++r) { const int c = (r & 3) + 8 * (r >> 2); if (!((w0 >> c) & 1u)) p0[r] = -INFINITY; if (!((w1 >> c) & 1u)) p1[r] = -INFINITY; } }
                const float rm = rowmax(p0, p1, hi);
                if (__any(rm - mhat > THR)) {
                    const float mn = fmaxf(mhat, rm); const float f = __builtin_amdgcn_exp2f(mhat - mn); mhat = mn; l_reg *= f;
                    if (hi == 0) wsf[r32] = f;
#pragma unroll
                    for (int r = 0; r < 16; ++r) { const float fr = wsf[crow(r, hi)]; o[0][r] *= fr; o[1][r] *= fr; }
                }
                float sa4[4] = {0.f, 0.f, 0.f, 0.f};
#pragma unroll
                for (int r = 0; r < 16; ++r) { p0[r] = __builtin_amdgcn_exp2f(p0[r] - mhat); p1[r] = __builtin_amdgcn_exp2f(p1[r] - mhat); sa4[r & 3] += p0[r] + p1[r]; }
                l_reg += (sa4[0] + sa4[1]) + (sa4[2] + sa4[3]);
                if (VAR == 2 || VAR == 3) {
                    const float ub = sbound - slope2 * (float)(tq - 64 * t + 1) - mhat;
                    const bool dead = __all(ub < -150.f); if (lane == 0) ((LAS unsigned*)(sh + L_END))[(it & 1) * 8 + wid] = dead ? 1u : 0u;
                }
            } else {
                f32x16 m0, m1;
#pragma unroll
                for (int r = 0; r < 16; ++r) {
                    { const float s = __builtin_amdgcn_fmed3f(p0[r], -64.f, 64.f); const float e = __builtin_amdgcn_exp2f(-s); const float bt = __builtin_amdgcn_rcpf(1.f + e); p0[r] = bt; m0[r] = e * bt; }
                    { const float s = __builtin_amdgcn_fmed3f(p1[r], -64.f, 64.f); const float e = __builtin_amdgcn_exp2f(-s); const float bt = __builtin_amdgcn_rcpf(1.f + e); p1[r] = bt; m1[r] = e * bt; } }
                if constexpr (BAND) { const int kb = 64 * jb + 4 * hi;
#pragma unroll
                    for (int r = 0; r < 16; ++r) { const int kv = kb + (r & 3) + 8 * (r >> 2);
                        if (kv >= qrel) { p0[r] = 0.f; m0[r] = 1.f; } if (kv + 32 >= qrel) { p1[r] = 0.f; m1[r] = 1.f; } } }
                float gp[8], gq[8], ex[8];
#pragma unroll
                for (int g = 0; g < 4; ++g) { gp[g] = (m0[4 * g] * m0[4 * g + 1]) * (m0[4 * g + 2] * m0[4 * g + 3]); gp[4 + g] = (m1[4 * g] * m1[4 * g + 1]) * (m1[4 * g + 2] * m1[4 * g + 3]); }
#pragma unroll
                for (int g = 0; g < 8; ++g) gq[g] = xhalf(gp[g], hi);
                float sp = Rp;
#pragma unroll
                for (int g = 7; g >= 0; --g) { ex[g] = hi ? sp : sp * gq[g]; sp *= gp[g] * gq[g]; }
                Rp = sp;
                { const bool allz = !__any(Rp != 0.f); if (lane == 0) ((LAS unsigned*)(sh + L_END))[(it & 1) * 8 + wid] = allz ? 1u : 0u; }
#pragma unroll
                for (int g = 0; g < 4; ++g) {
                    { float c = ex[g]; const float w3 = p0[4 * g + 3] * c; c *= m0[4 * g + 3]; const float w2 = p0[4 * g + 2] * c; c *= m0[4 * g + 2]; const float w1 = p0[4 * g + 1] * c; c *= m0[4 * g + 1]; const float w0 = p0[4 * g] * c;
                      p0[4 * g] = w0; p0[4 * g + 1] = w1; p0[4 * g + 2] = w2; p0[4 * g + 3] = w3; }
                    { float c = ex[4 + g]; const float w3 = p1[4 * g + 3] * c; c *= m1[4 * g + 3]; const float w2 = p1[4 * g + 2] * c; c *= m1[4 * g + 2]; const float w1 = p1[4 * g + 1] * c; c *= m1[4 * g + 1]; const float w0 = p1[4 * g] * c;
                      p1[4 * g] = w0; p1[4 * g + 1] = w1; p1[4 * g + 2] = w2; p1[4 * g + 3] = w3; } }
            }
            u32x4 pw0, pw1, pw2, pw3;
            pw0 = (u32x4){cvtpk_s(p0[0], p0[1]), cvtpk_s(p0[2], p0[3]), cvtpk_s(p0[4], p0[5]), cvtpk_s(p0[6], p0[7])};
            pw1 = (u32x4){cvtpk_s(p0[8], p0[9]), cvtpk_s(p0[10], p0[11]), cvtpk_s(p0[12], p0[13]), cvtpk_s(p0[14], p0[15])};
            pw2 = (u32x4){cvtpk_s(p1[0], p1[1]), cvtpk_s(p1[2], p1[3]), cvtpk_s(p1[4], p1[5]), cvtpk_s(p1[6], p1[7])};
            pw3 = (u32x4){cvtpk_s(p1[8], p1[9]), cvtpk_s(p1[10], p1[11]), cvtpk_s(p1[12], p1[13]), cvtpk_s(p1[14], p1[15])};
            pv(o, vb0 + cur, __builtin_bit_cast(bf16x8, pw0), __builtin_bit_cast(bf16x8, pw1), __builtin_bit_cast(bf16x8, pw2), __builtin_bit_cast(bf16x8, pw3));
            { const int tmp = cur; cur = sl1; sl1 = sl2; sl2 = tmp; }
            return false;
        };
        if (REV) { bool ex = false; int it = 0;
            for (; it < 4 && !ex; ++it) ex = step(BoolC<true>{}, it);
            for (; it < NT && !ex; ++it) ex = step(BoolC<false>{}, it); }
        else { int it = 0;
            for (; it < NT - 4; ++it) (void)step(BoolC<false>{}, it);
            for (; it < NT; ++it) (void)step(BoolC<true>{}, it); }
        ATT_WAIT_BAR();
        if (pass == NPASS - 1 && tid == 0) nxt_u = __hip_atomic_fetch_add(qctr, 1u, RLX_AGENT);
        float rli[16];
        if (VAR != 1) {
            l_reg += xhalf(l_reg, hi);
            if (hi == 0) wsf[32 + r32] = l_reg;
#pragma unroll
            for (int r = 0; r < 16; ++r) rli[r] = __builtin_amdgcn_rcpf(wsf[32 + crow(r, hi)]);
        } else {
#pragma unroll
            for (int r = 0; r < 16; ++r) rli[r] = 1.f;
        }
#pragma unroll
        for (int r = 0; r < 16; ++r) { const int orow = crow(r, hi);
#pragma unroll
            for (int d0 = 0; d0 < 2; ++d0) { const float val = o[d0][r] * rli[r]; LAS float* sp = stg + orow * 64 + d0 * 32 + r32;
                if (VAR == 2 && pass == 1) *sp = *sp - P.lam * val; else *sp = val; } }
    }
    LDS_WAIT();
    bf16* Ow = P.mix + (size_t)(rowbase + q0 + wid * 32) * DM + VAR * 256 + h * 64;
#pragma unroll
    for (int i = 0; i < 4; ++i) { const int row = i * 8 + (lane >> 3), ch = lane & 7;
        const f32x4 a = *(const LAS f32x4*)(stg + row * 64 + ch * 8), c = *(const LAS f32x4*)(stg + row * 64 + ch * 8 + 4);
        float sc = 1.f;
        if (VAR == 2) { float ss = (a[0] * a[0] + a[1] * a[1]) + (a[2] * a[2] + a[3] * a[3]) + (c[0] * c[0] + c[1] * c[1]) + (c[2] * c[2] + c[3] * c[3]);
            ss += shx<1>(ss); ss += shx<2>(ss); ss += shx<4>(ss); sc = 1.0f / sqrtf(ss * (1.f / 64.f) + RMS_EPS); }
        u32x4 w; w.x = cvtpk_s(a[0] * sc, a[1] * sc); w.y = cvtpk_s(a[2] * sc, a[3] * sc); w.z = cvtpk_s(c[0] * sc, c[1] * sc); w.w = cvtpk_s(c[2] * sc, c[3] * sc);
        if (pm == 0 || (w.x == 0x12345678u && w.y == 0x9abcdef0u)) *(u32x4*)(Ow + (size_t)row * DM + ch * 8) = w; }
    if (tid == 0) *qslot = nxt_u;
    asm volatile("s_waitcnt lgkmcnt(0)\n\ts_barrier" ::: "memory");
#undef DMA_KV
}
typedef __attribute__((address_space(3))) const char* lds_cptr;
typedef short v4i16_t __attribute__((ext_vector_type(4)));
__device__ __forceinline__ s16x4 vtr(lds_cptr p) { return __builtin_bit_cast(s16x4, __builtin_amdgcn_ds_read_tr16_b64_v4i16((__attribute__((address_space(3))) v4i16_t*)p)); }
template <int VAR>
__device__ __forceinline__ void attn_unit2(const AttnP& P, int b, int h, int qb, LAS char* sh, const int tid_in, unsigned* qctr, volatile LAS unsigned* qslot) {
    static_assert(VAR == 0 || VAR == 2 || VAR == 3, "softmax mixers only");
    int tid = tid_in; asm volatile("" : "+v"(tid));
    const int lane = tid & 63, r32 = lane & 31, hi = lane >> 5; const int wid = __builtin_amdgcn_readfirstlane(tid >> 6);
    const long rowbase = (long)b * SEQ; const int q0 = qb * 256, NT = 4 * (qb + 1);
    const int qrel = wid * 32 + r32, tq = q0 + qrel;
    constexpr int QCB = VAR == 0 ? C_AQ : VAR == 1 ? C_BQ : VAR == 2 ? C_CQ : C_DQ;
    constexpr int KCB = VAR == 0 ? C_AK : VAR == 1 ? C_BK : VAR == 2 ? C_CK : C_DK;
    constexpr int VCB = VAR == 0 ? C_AV : VAR == 1 ? C_BV : VAR == 2 ? C_CV : C_DV;
    const int Qc = QCB + 64 * h, Kc = VAR == 3 ? KCB : KCB + 64 * h, Vc = VAR == 3 ? VCB : VCB + 64 * h;
    const bf16* PR = P.proj;
    LAS float* wsf = (LAS float*)(sh + L_WS) + wid * 64;
    LAS float* stg = (LAS float*)(sh + L_OST) + wid * 2048;
    LAS float* cumL = (LAS float*)(sh + L_CUM);
    LAS unsigned* maskL = (LAS unsigned*)(sh + L_OST);
    const unsigned lds0 = (unsigned)(uintptr_t)sh;
    const bf16* ksrc = PR + (size_t)(rowbase + lane) * NP + Kc + wid * 8;
    const bf16* vsrc = PR + (size_t)(rowbase + 16 * (wid & 3) + (lane >> 2)) * NP + Vc + (wid >> 2) * 32 + (lane & 3) * 8;
    const unsigned kdst = lds0 + L_K + wid * 1024, vdst = lds0 + L_V + wid * 1024;
#define TILE2(j) (NT - 1 - (j))
#define DMA_K2(j, slot) glds16(ksrc + (size_t)TILE2(j) * 64 * NP, (unsigned)__builtin_amdgcn_readfirstlane(kdst + (slot)))
#define DMA_V2(j, slot) glds16(vsrc + (size_t)TILE2(j) * 64 * NP, (unsigned)__builtin_amdgcn_readfirstlane(vdst + (slot)))
    DMA_K2(0, 0); DMA_K2(1, SLOTB); DMA_V2(0, 0);
    constexpr int NDQ = VAR == 2 ? 2 : 4; bf16x8 qpre[NDQ];
    { const bf16* Qw0 = PR + (size_t)(rowbase + tq) * NP + Qc;
#pragma unroll
      for (int d0 = 0; d0 < NDQ; ++d0) qpre[d0] = *(const bf16x8*)(Qw0 + d0 * 16 + hi * 8); }
    if (VAR == 0) {
        LAS float* pref = (LAS float*)(sh + L_WS);
        const float* cg = P.cum + (size_t)(b * 4 + h) * SEQ; float cgv[4];
#pragma unroll
        for (int k = 0; k < 4; ++k) { const int i = tid + 512 * k; cgv[k] = i < q0 + 256 ? cg[i] : 0.f; }
        if (tid < 64) { const float ct = P.cum[32 * SEQ + (b * 4 + h) * 64 + tid]; float incl = ct;
#pragma unroll
            for (int o = 1; o < 64; o <<= 1) { const float u = shup(incl, o, tid); if (tid >= o) incl += u; }
            pref[tid] = incl - ct; }
        asm volatile("s_waitcnt lgkmcnt(0)\n\ts_barrier" ::: "memory");
#pragma unroll
        for (int k = 0; k < 4; ++k) { const int i = tid + 512 * k; if (i < q0 + 256) cumL[i] = (cgv[k] + pref[i >> 5]) * LOG2E; }
        asm volatile("s_waitcnt lgkmcnt(0)\n\ts_barrier" ::: "memory");
    }
    if (VAR == 3) { const unsigned* mg = P.mask + (size_t)(rowbase + q0) * 64; const int nw = 2 * NT;
#pragma unroll 16
        for (int i = tid; i < 256 * 32; i += 512) { const int row = i >> 5, w = 2 * (i & 31); if (w < nw) *(LAS u32x2*)(maskL + row * MROW + w) = *(const u32x2*)(mg + row * 64 + w); } }
    asm volatile("s_waitcnt vmcnt(0) lgkmcnt(0)\n\ts_barrier" ::: "memory");
    const lds_cptr shc = (lds_cptr)sh;
    const lds_cptr kp0 = shc + L_K + hi * 1024 + r32 * 16;
    const lds_cptr vp0 = shc + L_V + ((lane >> 4) & 1) * 32 + (lane & 3) * 8 + (4 * hi + ((lane & 15) >> 2)) * 64;
    float slope2 = 0.f;
    if (VAR == 2) slope2 = __builtin_amdgcn_exp2f(-(float)(2 * h + 1)) * LOG2E;
    if (VAR == 3) slope2 = __builtin_amdgcn_exp2f(-(float)(2 * h + 2)) * LOG2E;
    float cumt = 0.f; if (VAR == 0) cumt = cumL[tq];
    constexpr int NPASS = VAR == 2 ? 2 : 1;
    unsigned nxt_u = 0u;
    const auto slot3 = [](int j) { return (j % 3) * SLOTB; };
#define SB2() __builtin_amdgcn_sched_barrier(0)
#define PINV(x) asm volatile("" : "+v"(x))
#define MF32(a, b, c) __builtin_amdgcn_mfma_f32_32x32x16_bf16(a, b, c, 0, 0, 0)
#define ATT_BARN(N) do { asm volatile("s_waitcnt vmcnt(" #N ") lgkmcnt(0)\n\ts_barrier" ::: "memory"); SB2(); } while (0)
#define PKW(Pv, i) cvtpk_s(Pv[i], Pv[(i) + 1])
#define PAF(k) __builtin_bit_cast(bf16x8, pw##k)
#define VFR(i) (bf16x8){vlo[i][0], vlo[i][1], vlo[i][2], vlo[i][3], vhi[i][0], vhi[i][1], vhi[i][2], vhi[i][3]}
#define VRD(i) do { vlo[i] = vtr(vp_ + (((i) >> 2) * 4096 + ((i) & 3) * 1024)); vhi[i] = vtr(vp_ + (((i) >> 2) * 4096 + ((i) & 3) * 1024 + 512)); } while (0)
#define EX2(v) __builtin_amdgcn_exp2f(v)
#define GAPA(MF, Pv, i, PW, w) do { MF; sacc += Pv[i]; sacc += Pv[(i) + 1]; sacc += Pv[(i) + 2]; sacc += Pv[(i) + 3]; PINV(sacc); PW[w] = PKW(Pv, i); PW[(w) + 1] = PKW(Pv, (i) + 2); PINV(PW); SB2(); } while (0)
#define GAPA8(MF, Pv, i, PW) do { MF; sacc += Pv[i]; sacc += Pv[(i) + 1]; sacc += Pv[(i) + 2]; sacc += Pv[(i) + 3]; sacc += Pv[(i) + 4]; sacc += Pv[(i) + 5]; sacc += Pv[(i) + 6]; sacc += Pv[(i) + 7]; PINV(sacc); \
        PW[0] = PKW(Pv, i); PW[1] = PKW(Pv, (i) + 2); PW[2] = PKW(Pv, (i) + 4); PW[3] = PKW(Pv, (i) + 6); PINV(PW); SB2(); } while (0)
#define GAPB(MF, X, i) do { MF; X[i] = EX2(X[i]); X[(i) + 1] = EX2(X[(i) + 1]); X[(i) + 2] = EX2(X[(i) + 2]); X[(i) + 3] = EX2(X[(i) + 3]); PINV(X); SB2(); } while (0)
    for (int pass = 0; pass < NPASS; ++pass) {
        bf16x8 qa[4]; float sb0 = 0.f;
        { const bf16* Qw = PR + (size_t)(rowbase + tq) * NP + Qc;
          constexpr int ND0 = VAR == 2 ? 2 : 4; const int dbase = VAR == 2 ? 2 * pass : 0;
          float qf[8 * ND0];
#pragma unroll
          for (int d0 = 0; d0 < ND0; ++d0) { bf16x8 raw = qpre[d0]; if (pass > 0) raw = *(const bf16x8*)(Qw + (dbase + d0) * 16 + hi * 8);
#pragma unroll
              for (int j = 0; j < 8; ++j) qf[d0 * 8 + j] = bf2f((unsigned short)raw[j]); }
          constexpr float SC = (VAR == 2 ? 0.17677669529663687f : 0.125f) * LOG2E;
          if (VAR != 1) {
              float ss = 0.f;
#pragma unroll
              for (int i = 0; i < 8 * ND0; ++i) ss += qf[i] * qf[i];
              ss += xhalf(ss, hi); const float rstd = 1.0f / sqrtf(ss * (VAR == 2 ? 1.f / 32.f : 1.f / 64.f) + RMS_EPS);
              const float* g = P.qgain[VAR];
#pragma unroll
              for (int d0 = 0; d0 < ND0; ++d0)
#pragma unroll
                  for (int j = 0; j < 8; ++j) qf[d0 * 8 + j] *= rstd * g[16 * d0 + 8 * hi + j] * SC;
          } else {
#pragma unroll
              for (int i = 0; i < 8 * ND0; ++i) qf[i] *= SC;
          }
          if (VAR == 2 || VAR == 3) {
              float n0 = 0.f;
#pragma unroll
              for (int i = 0; i < 8 * ND0; ++i) n0 += qf[i] * qf[i];
              n0 += xhalf(n0, hi);
              float gk = fabsf(P.kgain[VAR][lane & (VAR == 2 ? 31 : 63)]);
              gk = fmaxf(gk, shx<1>(gk)); gk = fmaxf(gk, shx<2>(gk)); gk = fmaxf(gk, shx<4>(gk)); gk = fmaxf(gk, shx<8>(gk)); gk = fmaxf(gk, shx<16>(gk)); gk = half_max(gk);
              sb0 = 1.02f * sqrtf(n0) * (VAR == 2 ? 5.656854249f : 8.0f) * gk;
          }
#pragma unroll
          for (int d0 = 0; d0 < ND0; ++d0) { u32x4 w; w.x = cvtpk_s(qf[d0 * 8 + 0], qf[d0 * 8 + 1]); w.y = cvtpk_s(qf[d0 * 8 + 2], qf[d0 * 8 + 3]); w.z = cvtpk_s(qf[d0 * 8 + 4], qf[d0 * 8 + 5]); w.w = cvtpk_s(qf[d0 * 8 + 6], qf[d0 * 8 + 7]);
              qa[d0] = __builtin_bit_cast(bf16x8, w); }
          if (VAR == 2) { qa[2] = qa[0]; qa[3] = qa[1]; }
        }
        const float sbound = sb0;
        if (pass > 0) { DMA_K2(0, 0); DMA_K2(1, SLOTB); DMA_V2(0, 0); }
        float mhat = 0.f, l_reg = 0.f; bool hasref = false, resc = false; f32x16 o[2], negm;
#pragma unroll
        for (int r = 0; r < 16; ++r) { o[0][r] = 0.f; o[1][r] = 0.f; }
        f32x16 pA0, pA1, pB0, pB1; u32x4 pw0, pw1, pw2, pw3;
#pragma unroll
        for (int r = 0; r < 16; ++r) { pB0[r] = 0.f; pB1[r] = 0.f; }
        const auto setneg = [&](int t) __attribute__((always_inline)) { float v = -mhat; if (VAR == 0) v += cumt; else v += slope2 * (float)(t * 64 + 4 * hi - tq);
#pragma unroll
            for (int r = 0; r < 16; ++r) negm[r] = v;
            PINV(negm); };
        const auto mid = [&](f32x16& C0, f32x16& C1, const int it) __attribute__((always_inline)) {
            const int t = NT - 1 - it;
            if (VAR == 0) { const LAS float* cp = cumL + t * 64 + 4 * hi;
#pragma unroll
                for (int g = 0; g < 4; ++g) { const f32x4 c0 = *(const LAS f32x4*)(cp + 8 * g), c1 = *(const LAS f32x4*)(cp + 32 + 8 * g);
#pragma unroll
                    for (int i = 0; i < 4; ++i) { C0[4 * g + i] -= c0[i]; C1[4 * g + i] -= c1[i]; } } }
            else {
#pragma unroll
                for (int r = 0; r < 16; ++r) { const float kc = (float)((r & 3) + 8 * (r >> 2)); C0[r] += slope2 * kc; C1[r] += slope2 * (kc + 32.f); } }
            if (VAR != 3) { if (it < 4) { asm volatile("" ::: "memory");
                const int kb = 64 * (3 - it) + 4 * hi;
#pragma unroll
                for (int r = 0; r < 16; ++r) { const int kv = kb + (r & 3) + 8 * (r >> 2); if (kv > qrel) C0[r] = -INFINITY; if (kv + 32 > qrel) C1[r] = -INFINITY; } } }
            else { const u32x2 mw = *(const LAS u32x2*)(maskL + qrel * MROW + 2 * t); const unsigned w0 = mw.x >> (4 * hi), w1 = mw.y >> (4 * hi);
#pragma unroll
                for (int r = 0; r < 16; ++r) { const int c = (r & 3) + 8 * (r >> 2); if (!((w0 >> c) & 1u)) C0[r] = -INFINITY; if (!((w1 >> c) & 1u)) C1[r] = -INFINITY; } }
            const float rm = rowmax(C0, C1, hi);
            const bool need = hasref ? (rm > THR) : (rm > -INFINITY);
            resc = false;
            if (__any(need)) {
                const bool fin = rm > -INFINITY;
                const float dl = hasref ? fmaxf(rm, 0.f) : (fin ? rm : 0.f);
                const float f = hasref ? EX2(-dl) : 1.f;
                mhat += dl; l_reg *= f;
#pragma unroll
                for (int r = 0; r < 16; ++r) { C0[r] -= dl; C1[r] -= dl; }
                if (hi == 0) wsf[r32] = f;
                resc = true; hasref = hasref || fin;
            }
            if (VAR != 0) {
                const bool dead = hasref && (sbound - slope2 * (float)(tq - 64 * t + 1) - mhat < -150.f);
                const bool alld = __all(dead); if (lane == 0) ((LAS unsigned*)(sh + L_END))[(it & 1) * 8 + wid] = alld ? 1u : 0u;
            }
        };
#define KLD(dst0, dst1, d0) do { dst0 = *(const LAS bf16x8*)(kp_ + (d0) * 2048); dst1 = *(const LAS bf16x8*)(kp_ + (d0) * 2048 + 512); } while (0)
#define VLD(lo, hi_, i) do { lo = vtr(vp_ + (((i) >> 2) * 4096 + ((i) & 3) * 1024)); hi_ = vtr(vp_ + (((i) >> 2) * 4096 + ((i) & 3) * 1024 + 512)); } while (0)
#define VF(lo, hi_) (bf16x8){lo[0], lo[1], lo[2], lo[3], hi_[0], hi_[1], hi_[2], hi_[3]}
        const auto step = [&](f32x16& C0, f32x16& C1, f32x16& P0, f32x16& P1, const int it) __attribute__((always_inline)) -> bool {
            if (it + 1 < NT) ATT_BARN(2); else ATT_BARN(1);
            if (VAR != 0 && it >= 1) { const LAS unsigned* wz = (const LAS unsigned*)(sh + L_END) + ((it - 1) & 1) * 8;
                const u32x4 z0 = *(const LAS u32x4*)wz, z1 = *(const LAS u32x4*)(wz + 4);
                if (__builtin_amdgcn_readfirstlane((int)(z0.x & z0.y & z0.z & z0.w & z1.x & z1.y & z1.z & z1.w)) != 0) return true; }
            if (it + 2 < NT) DMA_K2(it + 2, slot3(it + 2));
            if (it + 1 < NT) DMA_V2(it + 1, slot3(it + 1));
            setneg(NT - 1 - it);
            int ko_ = slot3(it), vo_ = slot3(it + 2);
            asm volatile("" : "+s"(ko_), "+s"(vo_));
            const lds_cptr kp_ = kp0 + ko_; const lds_cptr vp_ = vp0 + vo_;
            bf16x8 ka0, ka1, kb0, kb1; s16x4 va0, va1, vb0, vb1;
            float sacc = 0.f;
            if (VAR == 2) {
                KLD(ka0, ka1, 2 * pass); KLD(kb0, kb1, 2 * pass + 1); SB2();
                GAPA8(C0 = MF32(ka0, qa[0], negm), P0, 0, pw0);
                GAPA8(C1 = MF32(ka1, qa[0], negm), P0, 8, pw1);
                GAPA8(C0 = MF32(kb0, qa[1], C0), P1, 0, pw2);
                GAPA8(C1 = MF32(kb1, qa[1], C1), P1, 8, pw3);
            } else {
                KLD(ka0, ka1, 0); KLD(kb0, kb1, 1); SB2();
                GAPA(C0 = MF32(ka0, qa[0], negm), P0, 0, pw0, 0);
                GAPA(C1 = MF32(ka1, qa[0], negm), P0, 4, pw0, 2);
                KLD(ka0, ka1, 2); SB2();
                GAPA(C0 = MF32(kb0, qa[1], C0), P0, 8, pw1, 0);
                GAPA(C1 = MF32(kb1, qa[1], C1), P0, 12, pw1, 2);
                KLD(kb0, kb1, 3); SB2();
                GAPA(C0 = MF32(ka0, qa[2], C0), P1, 0, pw2, 0);
                GAPA(C1 = MF32(ka1, qa[2], C1), P1, 4, pw2, 2);
                GAPA(C0 = MF32(kb0, qa[3], C0), P1, 8, pw3, 0);
                GAPA(C1 = MF32(kb1, qa[3], C1), P1, 12, pw3, 2);
            }
            l_reg += sacc;
            mid(C0, C1, it);
            SB2();
            if (it > 0) {
                VLD(va0, va1, 0); VLD(vb0, vb1, 4); SB2();
                GAPB(o[0] = MF32(PAF(0), VF(va0, va1), o[0]), C0, 0);  VLD(va0, va1, 1); SB2();
                GAPB(o[1] = MF32(PAF(0), VF(vb0, vb1), o[1]), C0, 4);  VLD(vb0, vb1, 5); SB2();
                GAPB(o[0] = MF32(PAF(1), VF(va0, va1), o[0]), C0, 8);  VLD(va0, va1, 2); SB2();
                GAPB(o[1] = MF32(PAF(1), VF(vb0, vb1), o[1]), C0, 12); VLD(vb0, vb1, 6); SB2();
                GAPB(o[0] = MF32(PAF(2), VF(va0, va1), o[0]), C1, 0);  VLD(va0, va1, 3); SB2();
                GAPB(o[1] = MF32(PAF(2), VF(vb0, vb1), o[1]), C1, 4);  VLD(vb0, vb1, 7); SB2();
                GAPB(o[0] = MF32(PAF(3), VF(va0, va1), o[0]), C1, 8);
                GAPB(o[1] = MF32(PAF(3), VF(vb0, vb1), o[1]), C1, 12);
                if (resc) {
#pragma unroll
                    for (int r = 0; r < 16; ++r) { const float fr = wsf[crow(r, hi)]; o[0][r] *= fr; o[1][r] *= fr; } }
            } else {
#pragma unroll
                for (int r = 0; r < 16; ++r) { C0[r] = EX2(C0[r]); C1[r] = EX2(C1[r]); }
            }
            return false;
        };
        bool ex = false, pendA = true; int it = 0;
        for (; it < NT; it += 2) {
            ex = step(pA0, pA1, pB0, pB1, it); if (ex) { pendA = false; break; }
            ex = step(pB0, pB1, pA0, pA1, it + 1); if (ex) { pendA = true; ++it; break; }
        }
        if (!ex) pendA = false;
        if (!ex) ATT_BARN(0);
        { int vo_ = slot3(it + 2); asm volatile("" : "+s"(vo_)); const lds_cptr vp_ = vp0 + vo_; s16x4 vlo[8], vhi[8];
#pragma unroll
          for (int i = 0; i < 8; ++i) VRD(i);
          float sacc = 0.f;
          if (pendA) {
#pragma unroll
              for (int r = 0; r < 16; ++r) sacc += pA0[r] + pA1[r];
              pw0 = (u32x4){PKW(pA0, 0), PKW(pA0, 2), PKW(pA0, 4), PKW(pA0, 6)}; pw1 = (u32x4){PKW(pA0, 8), PKW(pA0, 10), PKW(pA0, 12), PKW(pA0, 14)};
              pw2 = (u32x4){PKW(pA1, 0), PKW(pA1, 2), PKW(pA1, 4), PKW(pA1, 6)}; pw3 = (u32x4){PKW(pA1, 8), PKW(pA1, 10), PKW(pA1, 12), PKW(pA1, 14)};
          } else {
#pragma unroll
              for (int r = 0; r < 16; ++r) sacc += pB0[r] + pB1[r];
              pw0 = (u32x4){PKW(pB0, 0), PKW(pB0, 2), PKW(pB0, 4), PKW(pB0, 6)}; pw1 = (u32x4){PKW(pB0, 8), PKW(pB0, 10), PKW(pB0, 12), PKW(pB0, 14)};
              pw2 = (u32x4){PKW(pB1, 0), PKW(pB1, 2), PKW(pB1, 4), PKW(pB1, 6)}; pw3 = (u32x4){PKW(pB1, 8), PKW(pB1, 10), PKW(pB1, 12), PKW(pB1, 14)};
          }
          l_reg += sacc;
          o[0] = MF32(PAF(0), VFR(0), o[0]); o[1] = MF32(PAF(0), VFR(4), o[1]); o[0] = MF32(PAF(1), VFR(1), o[0]); o[1] = MF32(PAF(1), VFR(5), o[1]);
          o[0] = MF32(PAF(2), VFR(2), o[0]); o[1] = MF32(PAF(2), VFR(6), o[1]); o[0] = MF32(PAF(3), VFR(3), o[0]); o[1] = MF32(PAF(3), VFR(7), o[1]); }
        ATT_WAIT_BAR();
        if (pass == NPASS - 1 && tid == 0) nxt_u = __hip_atomic_fetch_add(qctr, 1u, RLX_AGENT);
        int lane_e = lane; asm volatile("" : "+v"(lane_e)); const int r32e = lane_e & 31, hie = lane_e >> 5;
        LAS float* wsfe = (LAS float*)(sh + L_WS) + wid * 64; LAS float* stge = (LAS float*)(sh + L_OST) + wid * 2048;
        float rli[16];
        l_reg += xhalf(l_reg, hie);
        if (hie == 0) wsfe[32 + r32e] = l_reg;
#pragma unroll
        for (int r = 0; r < 16; ++r) rli[r] = __builtin_amdgcn_rcpf(wsfe[32 + crow(r, hie)]);
#pragma unroll
        for (int r = 0; r < 16; ++r) { const int orow = crow(r, hie);
#pragma unroll
            for (int d0 = 0; d0 < 2; ++d0) { const float val = o[d0][r] * rli[r]; LAS float* sp = stge + orow * 64 + d0 * 32 + r32e;
                if (VAR == 2 && pass == 1) *sp = *sp - P.lam * val; else *sp = val; } }
    }
    LDS_WAIT();
    int lane_o = tid & 63; asm volatile("" : "+v"(lane_o));
    bf16* Ow = P.mix + (size_t)(rowbase + q0 + wid * 32) * DM + VAR * 256 + h * 64;
    { const int lane = lane_o; LAS float* stg = (LAS float*)(sh + L_OST) + wid * 2048;
#pragma unroll
    for (int i = 0; i < 4; ++i) { const int row = i * 8 + (lane >> 3), ch = lane & 7;
        const f32x4 a = *(const LAS f32x4*)(stg + row * 64 + ch * 8), c = *(const LAS f32x4*)(stg + row * 64 + ch * 8 + 4);
        float sc = 1.f;
        if (VAR == 2) { float ss = (a[0] * a[0] + a[1] * a[1]) + (a[2] * a[2] + a[3] * a[3]) + (c[0] * c[0] + c[1] * c[1]) + (c[2] * c[2] + c[3] * c[3]);
            ss += shx<1>(ss); ss += shx<2>(ss); ss += shx<4>(ss); sc = 1.0f / sqrtf(ss * (1.f / 64.f) + RMS_EPS); }
        u32x4 w; w.x = cvtpk_s(a[0] * sc, a[1] * sc); w.y = cvtpk_s(a[2] * sc, a[3] * sc); w.z = cvtpk_s(c[0] * sc, c[1] * sc); w.w = cvtpk_s(c[2] * sc, c[3] * sc);
        *(u32x4*)(Ow + (size_t)row * DM + ch * 8) = w; } }
    if (tid == 0) *qslot = nxt_u;
    asm volatile("s_waitcnt lgkmcnt(0)\n\ts_barrier" ::: "memory");
#undef DMA_K2
#undef DMA_V2
#undef TILE2
}
#undef SB2
#undef PINV
#undef MF32
#undef ATT_BARN
#undef PKW
#undef PAF
#undef VFR
#undef VRD
#undef EX2
#undef GAPA
#undef GAPA8
#undef GAPB
#undef KLD
#undef VLD
#undef VF
}

__device__ __forceinline__ void p4_attention(Frame& F, const Args& A, int l, int qsel) {
    att::AttnP P; P.proj = (const bf16*)(F.ws + WS_PROJ); P.mix = (bf16*)(F.ws + WS_MIX); P.cum = (const float*)(F.ws + WS_CUM); P.mask = (const unsigned*)(F.ws + WS_MASK);
    P.qgain[0] = inp<I_QNA>() + l * 64; P.qgain[1] = nullptr; P.qgain[2] = inp<I_QNC>() + l * 32; P.qgain[3] = inp<I_QND>() + l * 64; P.kgain[0] = nullptr; P.kgain[1] = nullptr; P.kgain[2] = inp<I_KNC>() + l * 32; P.kgain[3] = inp<I_KND>() + l * 64; P.lam = ((const float*)(F.ws + WS_MISC))[l];
    LAS char* sh = (LAS char*)F.lds;
    LAS float* rsl2 = (LAS float*)(F.lds + 126976);
    bool cv = BG_CONVERT && (qsel == 0);
    if (cv) { fill_rowscale(F, A, 0, rsl2); fill_rowscale(F, A, 1, rsl2 + DM); }
    if (F.tid == 0) F.MISC[0] = (unsigned)(F.bx - F.G);
    __syncthreads();
    for (;;) {
        const int u = (int)F.MISC[0] + F.G;
        if (u >= 1024) break;
        const int qb = 7 - (u >> 7), r = u & 127, var = r >> 5, bh = r & 31, b = bh >> 2, h = bh & 3;
        const int tv = var == 0 ? 2 : var == 1 ? 1 : var == 2 ? 3 : 0;
        if (qsel >= 2 && PROBE_ATT_VAR >= 0 && tv != PROBE_ATT_VAR) { __syncthreads(); if (F.tid == 0) F.MISC[0] = __hip_atomic_fetch_add(F.ctl + CW_AQ + 64 * qsel, 1u, RLX_AGENT); __syncthreads(); continue; }
#ifdef ONLY_VAR2
        att::attn_unit2<ONLY_VAR2>(P, b, h, qb, sh, F.tid, F.ctl + CW_AQ + 64 * qsel, F.MISC);
#else
        if (tv == 2) att::attn_unit<2>(P, b, h, qb, sh, F.tid, qsel >= 2 ? PROBE_ATT_MODE : 0, F.ctl + CW_AQ + 64 * qsel, F.MISC);
        else if (tv == 1) att::attn_unit<1>(P, b, h, qb, sh, F.tid, qsel >= 2 ? PROBE_ATT_MODE : 0, F.ctl + CW_AQ + 64 * qsel, F.MISC);
        else if (tv == 3) att::attn_unit<3>(P, b, h, qb, sh, F.tid, qsel >= 2 ? PROBE_ATT_MODE : 0, F.ctl + CW_AQ + 64 * qsel, F.MISC);
        else att::attn_unit2<0>(P, b, h, qb, sh, F.tid, F.ctl + CW_AQ + 64 * qsel, F.MISC);
#endif
        if (cv) {
            if (F.tid == 0) F.MISC[3] = __hip_atomic_fetch_add(F.ctl + CW_CVQ, (unsigned)CV_CHUNK, RLX_AGENT);
            __syncthreads();
            const int gb = (int)F.MISC[3];
            if (gb >= CV_TOTAL) cv = false; else convert_chunk(F, A, gb, rsl2);
            __syncthreads();
        }
    }
    while (cv) {
        __syncthreads();
        if (F.tid == 0) F.MISC[3] = __hip_atomic_fetch_add(F.ctl + CW_CVQ, (unsigned)CV_CHUNK, RLX_AGENT);
        __syncthreads();
        const int gb = (int)F.MISC[3];
        if (gb >= CV_TOTAL) cv = false; else convert_chunk(F, A, gb, rsl2);
    }
    __syncthreads();
}

template <int N, int Dd> __device__ __forceinline__ void bfly(float (&p)[32], int lane) { const bool up = (lane & Dd) != 0;
#pragma unroll
    for (int j = 0; j < N / 2; ++j) { const float a = p[2 * j], bb = p[2 * j + 1]; const float send = up ? a : bb, keep = up ? bb : a; p[j] = keep + __shfl_xor(send, Dd); } }
__device__ __forceinline__ void p6_router(Frame& F, const Args& A, int l, int rep) {
    const float* MOD = (const float*)(F.ws + WS_MOD); const bf16* X1 = (const bf16*)(F.ws + WS_X1); bf16* H = (bf16*)(F.ws + WS_H);
    const bf16* WRH = (const bf16*)(F.ws + WS_WR) + (size_t)l * 48 * DM; const bf16* WRL = WRH + 2 * 48 * DM;
    int* tok_e = (int*)(F.ws + WS_TOK); float* tok_w = (float*)(F.ws + WS_TOK) + 2 * M; int* tok_pos = (int*)(F.ws + WS_TOK) + 4 * M;
    constexpr int AP = 528;
    LAS unsigned char* Ahi = F.lds; LAS unsigned char* Alo = F.lds + 64 * AP; LAS unsigned char* Bhi = F.lds + 128 * AP; LAS unsigned char* Blo = F.lds + 176 * AP;
    LAS float* PL = (LAS float*)F.lds;
    const int lane = F.lane, w = F.wave; const int mw = (F.vcu * NWAVES + w) * 8; const int b = mw >> 11;
    const float* md = MOD + ((size_t)l * 8 + b) * 6144;
    f32x4 hv[8][4];
#pragma unroll
    for (int r = 0; r < 8; ++r) {
        const bf16* xr = X1 + (size_t)(mw + r) * DM;
#pragma unroll
        for (int j = 0; j < 4; ++j) { const u32x2 q = *(const u32x2*)(xr + 256 * j + 4 * lane); hv[r][j] = (f32x4){bf2f(q.x & 0xffff), bf2f(q.x >> 16), bf2f(q.y & 0xffff), bf2f(q.y >> 16)}; }
    }
    { f32x4 gm[4], sc[4], sh[4]; const float* n2 = inp<I_N2G>() + l * DM;
#pragma unroll
      for (int j = 0; j < 4; ++j) { const int col = 256 * j + 4 * lane; gm[j] = *(const f32x4*)(n2 + col); sc[j] = *(const f32x4*)(md + 4 * DM + col); sh[j] = *(const f32x4*)(md + 3 * DM + col); gm[j] = gm[j] * (sc[j] + 1.0f); }
#pragma unroll
      for (int r = 0; r < 8; ++r) { float ss = 0.f;
#pragma unroll
        for (int j = 0; j < 4; ++j) ss += (hv[r][j][0] * hv[r][j][0] + hv[r][j][1] * hv[r][j][1]) + (hv[r][j][2] * hv[r][j][2] + hv[r][j][3] * hv[r][j][3]);
        const float rstd = 1.0f / sqrtf(wave_sum(ss) * (1.f / DM) + RMS_EPS);
#pragma unroll
        for (int j = 0; j < 4; ++j) { hv[r][j] = hv[r][j] * rstd * gm[j] + sh[j]; u32x2 pk; pk.x = pk2(hv[r][j][0], hv[r][j][1]); pk.y = pk2(hv[r][j][2], hv[r][j][3]);
            *(u32x2*)(H + (size_t)(mw + r) * DM + 256 * j + 4 * lane) = pk; } } }
    const int rt = w & 3, kh = w >> 2, arow = lane & 15, kg = lane >> 4;
    f32x4 acc[3];
#pragma unroll
    for (int c = 0; c < 3; ++c) acc[c] = (f32x4){0.f, 0.f, 0.f, 0.f};
#pragma unroll
    for (int j = 0; j < 4; ++j) {
        __syncthreads();
#pragma unroll
        for (int r = 0; r < 8; ++r) { const f32x4 x = hv[r][j]; unsigned h0 = f2bf(x[0]), h1 = f2bf(x[1]), h2 = f2bf(x[2]), h3 = f2bf(x[3]);
            u32x2 hi; hi.x = h0 | (h1 << 16); hi.y = h2 | (h3 << 16);
            u32x2 lo; lo.x = pk2(x[0] - bf2f((unsigned short)h0), x[1] - bf2f((unsigned short)h1)); lo.y = pk2(x[2] - bf2f((unsigned short)h2), x[3] - bf2f((unsigned short)h3));
            *(LAS u32x2*)(Ahi + (w * 8 + r) * AP + lane * 8) = hi; *(LAS u32x2*)(Alo + (w * 8 + r) * AP + lane * 8) = lo; }
        for (int i = F.tid; i < 48 * 32; i += 512) { const int o = i >> 5, c16 = i & 31;
            *(LAS u32x4*)(Bhi + o * AP + c16 * 16) = *(const u32x4*)(WRH + (size_t)o * DM + 256 * j + 8 * c16);
            *(LAS u32x4*)(Blo + o * AP + c16 * 16) = *(const u32x4*)(WRL + (size_t)o * DM + 256 * j + 8 * c16); }
        LDS_WAIT(); __syncthreads();
#pragma unroll
        for (int ks = 0; ks < 4; ++ks) { const int kb = ((4 * kh + ks) * 32 + 8 * kg) * 2;
            const bf16x8 ah = *(const LAS bf16x8*)(Ahi + (16 * rt + arow) * AP + kb), al = *(const LAS bf16x8*)(Alo + (16 * rt + arow) * AP + kb);
#pragma unroll
            for (int c = 0; c < 3; ++c) { const bf16x8 bh = *(const LAS bf16x8*)(Bhi + (16 * c + arow) * AP + kb), bl = *(const LAS bf16x8*)(Blo + (16 * c + arow) * AP + kb);
                acc[c] = __builtin_amdgcn_mfma_f32_16x16x32_bf16(ah, bh, acc[c], 0, 0, 0);
                acc[c] = __builtin_amdgcn_mfma_f32_16x16x32_bf16(al, bh, acc[c], 0, 0, 0);
                acc[c] = __builtin_amdgcn_mfma_f32_16x16x32_bf16(ah, bl, acc[c], 0, 0, 0); } }
    }
    __syncthreads();
#pragma unroll
    for (int c = 0; c < 3; ++c)
#pragma unroll
        for (int r = 0; r < 4; ++r) PL[(kh * 64 + 16 * rt + kg * 4 + r) * 48 + 16 * c + arow] = acc[c][r];
    LDS_WAIT(); __syncthreads();
    if (F.tid < 64 && rep == 0) {
        const int m = F.vcu * 64 + F.tid; const LAS float* q0 = PL + F.tid * 48; const LAS float* q1 = PL + (64 + F.tid) * 48;
        float gl[4]; int gi = 0; float gm;
#pragma unroll
        for (int g = 0; g < 4; ++g) gl[g] = (q0[g] + q1[g]) + inp<I_BG>()[l * 4 + g];
        gm = gl[0];
#pragma unroll
        for (int g = 1; g < 4; ++g) if (gl[g] > gm) { gm = gl[g]; gi = g; }
        float den = 0.f;
#pragma unroll
        for (int g = 0; g < 4; ++g) den += __expf(gl[g] - gm);
        const float gprob = 1.0f / den;
        float v1 = -INFINITY, v2 = -INFINITY; int i1 = 0, i2 = 0;
        for (int e = 0; e < 8; ++e) { const float v = (q0[4 + gi * 8 + e] + q1[4 + gi * 8 + e]) + inp<I_BE>()[l * 32 + gi * 8 + e];
            if (v > v1) { v2 = v1; i2 = i1; v1 = v; i1 = e; } else if (v > v2) { v2 = v; i2 = e; } }
        const float e2 = __expf(v2 - v1); const float w1 = gprob / (1.f + e2), w2 = gprob * e2 / (1.f + e2);
        const int ea = gi * 8 + i1, eb = gi * 8 + i2;
        tok_e[m] = ea; tok_e[M + m] = eb; tok_w[m] = w1; tok_w[M + m] = w2;
        LAS unsigned* lcnt = (LAS unsigned*)(F.lds + 32768); LAS unsigned* lbase = lcnt + 32;
        if (F.tid < 32) lcnt[F.tid] = 0u;
        asm volatile("s_waitcnt lgkmcnt(0)" ::: "memory");
        const unsigned ra = __hip_atomic_fetch_add(lcnt + ea, 1u, __ATOMIC_RELAXED, __HIP_MEMORY_SCOPE_WORKGROUP), rb = __hip_atomic_fetch_add(lcnt + eb, 1u, __ATOMIC_RELAXED, __HIP_MEMORY_SCOPE_WORKGROUP);
        asm volatile("s_waitcnt lgkmcnt(0)" ::: "memory");
        if (F.tid < 32) { const unsigned n = *(volatile LAS unsigned*)(lcnt + F.tid); unsigned bs = 0u; if (n) bs = __hip_atomic_fetch_add(F.ctl + CW_CNT + (l * 32 + F.tid) * 16, n, RLX_AGENT); *(volatile LAS unsigned*)(lbase + F.tid) = bs; }
        asm volatile("s_waitcnt vmcnt(0) lgkmcnt(0)" ::: "memory");
        const int pa = (int)(*(volatile LAS unsigned*)(lbase + ea) + ra), pb = (int)(*(volatile LAS unsigned*)(lbase + eb) + rb);
        tok_pos[m] = pa; tok_pos[M + m] = pb;
        int* elist = (int*)(F.ws + WS_ELIST); elist[ea * M + pa] = m; elist[eb * M + pb] = m;
    }
}

__device__ __forceinline__ void build_rowlists(Frame& F, int l) {
    volatile LAS int* base = (volatile LAS int*)(F.lds + BASE_OFF); volatile LAS int* cnts = (volatile LAS int*)(F.lds + CNTS_OFF); volatile LAS int* tab = (volatile LAS int*)(F.lds + TAB_OFF);
    LAS int* rowl = (LAS int*)(F.lds + ROWL_OFF); const int* elist = (const int*)(F.ws + WS_ELIST);
    const int ntile = (int)F.MISC[1];
    const int i = F.tid >> 8, r = F.tid & 255; const long L = (long)i * F.G + F.bx;
    int tok = 0;
    if (L < 2L * ntile) { const int tile = (int)(L >> 1), e = tab[tile], pos = 256 * (tile - base[e]) + r; if (pos < cnts[e]) tok = elist[e * M + pos]; }
    rowl[F.tid] = tok;
    __syncthreads();
}

constexpr int NPL = 7, NPH = 2 + 2 * NPL;
__global__ void __launch_bounds__(NWAVES * 64, 2) mk_fwd(Args args) {
    extern __shared__ __attribute__((aligned(16))) unsigned char lds[];
    Frame F;
    F.lds = (LAS unsigned char*)lds;
    F.MISC = (volatile LAS unsigned*)(F.lds + MISC_OFF);
    F.tid = threadIdx.x; F.lane = F.tid & 63; F.wave = __builtin_amdgcn_readfirstlane(F.tid >> 6);
    const int wave0 = F.wave;
    F.G = gridDim.x; F.bx = blockIdx.x; F.vcu = 0;
    F.ws = args.ws; F.out = args.out; F.ctl = (unsigned*)(args.ws + WS_CTL);
    for (int u = F.tid; u < (LDS_BYTES - LDSCTL_OFF) / 4; u += NWAVES * 64) ((LAS unsigned*)(F.lds + LDSCTL_OFF))[u] = 0u;
    __syncthreads();
    XcdBarrier bar; bar.bar = F.ctl + CW_BAR; bar.x = 0; bar.st = nullptr;
    if (!MK_PER_PHASE) bar = xcd_barrier_post(F.ctl + CW_BAR, F.MISC + 8);
    const int lo = args.ph_lo, hi = args.ph_hi;
#pragma unroll 1
    for (int ph = lo; ph < hi; ++ph) {
#if PROBE_REP_K >= 0
        const int ptype = ph == 0 ? 0 : (ph == NPH - 1 ? 10 : 1 + (ph - 1) % NPL);
        const int nrep = (ptype == PROBE_REP_K && (ph <= NPL || (PROBE_REP_K != 1 && PROBE_REP_K != 5))) ? 1 : 0;
#pragma unroll 1
        for (int rep = 0; rep <= nrep; ++rep) {
#else
        constexpr int rep = 0;
#endif
        { int w_ = wave0; asm volatile("" : "+s"(w_)); unsigned on_ = ~0u; asm volatile("" : "+s"(on_)); int ln_ = (int)__builtin_amdgcn_mbcnt_hi(on_, __builtin_amdgcn_mbcnt_lo(on_, 0u)); asm volatile("" : "+v"(ln_));
          F.wave = w_; F.lane = ln_; F.tid = w_ * 64 + ln_;
          unsigned long long ws_ = (unsigned long long)args.ws; asm volatile("" : "+s"(ws_)); F.ws = (unsigned char*)(GAS unsigned char*)ws_; F.ctl = (unsigned*)(F.ws + WS_CTL);
          int bx_ = blockIdx.x; asm volatile("" : "+s"(bx_)); F.bx = bx_; F.vcu = (F.G % 8 == 0) ? (bx_ % 8) * (F.G / 8) + bx_ / 8 : bx_; }
        if (ph == 0) {
#ifndef SKIP_P0
            p0_prologue(F, args);
#endif
        } else if (ph == NPH - 1) {
            row_pass(F, args, 2, 1);
        } else {
            const int l = (ph - 1) / NPL, k = (ph - 1) % NPL;
            if (k == 0) { row_pass(F, args, l == 0 ? 0 : 1, l); }
            else if (k == 1) {
                pg8::Gemm g{(const bf16*)(F.ws + WS_H), (const bf16*)(F.ws + WS_WIN) + (size_t)l * NP * DM, M, NP, DM}; pg8::StaticOrder S; S.init(M, NP, F.G, F.bx);
                pg8::EpiBf16 E{(bf16*)(F.ws + WS_PROJ), NP};
#ifndef SKIP_G1
                pg8::gemm_phase<pg8::EpiBf16, pg8::StaticOrder, true, true>(F.lds, g, S, E, F.tid);
#endif
            } else if (k == 2) {
#ifndef SKIP_P3
                p3_prep(F, args, l, rep);
#endif
            } else if (k == 3) {
#ifndef SKIP_P4
                p4_attention(F, args, l, l + 2 * rep);
#endif
            } else if (k == 4) {
                pg8::Gemm g{(const bf16*)(F.ws + WS_MIX), (const bf16*)(F.ws + WS_WOUT) + (size_t)l * DM * DM, M, DM, DM}; pg8::StaticOrder S; S.init(M, DM, F.G, F.bx);
                pg8::EpiResGate E{l == 0 ? inp<I_X>() : nullptr, (const bf16*)(F.ws + WS_X1), (bf16*)(F.ws + WS_X1), (const float*)(F.ws + WS_MOD) + (size_t)l * 8 * 6144 + 2 * DM};
#ifndef SKIP_G2
                pg8::gemm_phase<pg8::EpiResGate, pg8::StaticOrder, false, true>(F.lds, g, S, E, F.tid);
#endif
            } else if (k == 5) {
#ifndef SKIP_P6
                p6_router(F, args, l, rep);
#endif
            } else {
                build_tables(F, l); build_rowlists(F, l);
                unsigned* upf = F.ctl + CW_UPF + l * 8192; unsigned* dq = F.ctl + CW_DNQ + 16 * l;
                { pg8::Gemm g{(const bf16*)(F.ws + WS_H), (const bf16*)(F.ws + WS_WUP) + (size_t)l * NEXP * 512 * DM, MAXSLOT, 512, DM};
                  pg8::GroupOrder S{(const LAS int*)(F.lds + TAB_OFF), (int)F.MISC[1], 2, F.G, F.bx, (size_t)512 * DM * 2};
                  pg8::EpiSwiglu E{(bf16*)(F.ws + WS_HID), upf};
#ifndef SKIP_G3
                  pg8::gemm_phase<pg8::EpiSwiglu, pg8::GroupOrder, true, true, true>(F.lds, g, S, E, F.tid, (const LAS int*)(F.lds + ROWL_OFF));
#endif
                }
                if (GAP_CONVERT && !BG_CONVERT && l == 0 && rep == 0) convert_layer1_in_gap(F, args, 2 * (int)F.MISC[1] - F.G);
                { const pg8::Gemm g{(const bf16*)(F.ws + WS_HID), (const bf16*)(F.ws + WS_WDN) + (size_t)l * NEXP * DM * FF, MAXSLOT, DM, FF};
                  const pg8::EpiBf16 E{(bf16*)(F.ws + WS_Y), DM};
                  const LAS int* tab = (const LAS int*)(F.lds + TAB_OFF);
                  const int nd = 4 * __builtin_amdgcn_readfirstlane((int)F.MISC[1]);
                  pg8::DynOrder S{dq, upf, tab, F.MISC, nd, (size_t)DM * FF * 2, F.tid, (unsigned)F.G, 0u, 2u};
                  if (F.tid == 0) { const unsigned a = (unsigned)F.bx, b = (unsigned)F.G + __hip_atomic_fetch_add(dq, 1u, RLX_AGENT); F.MISC[4] = a; F.MISC[5] = b;
                      if ((int)a < nd) while (__hip_atomic_load(upf + (a >> 2) * 16, RLX_AGENT) < 2u) __builtin_amdgcn_s_sleep(8);
                      __builtin_amdgcn_fence(__ATOMIC_ACQUIRE, "agent"); asm volatile("s_waitcnt vmcnt(0)" ::: "memory"); S.issue(b); }
                  __syncthreads();
                  for (;;) {
                      if (__builtin_amdgcn_readfirstlane((int)F.MISC[4]) >= nd) break;
#ifndef SKIP_G4
                      pg8::gemm_phase<pg8::EpiBf16, pg8::DynOrder, true, true>(F.lds, g, S, E, F.tid);
#endif
                      if (F.tid == 0) {
                          const unsigned idn = F.MISC[5];
                          if ((int)idn < nd) { unsigned f = S.pflag; while (f < 2u) { __builtin_amdgcn_s_sleep(8); f = __hip_atomic_load(upf + (idn >> 2) * 16, RLX_AGENT); }
                              __builtin_amdgcn_fence(__ATOMIC_ACQUIRE, "agent"); asm volatile("s_waitcnt vmcnt(0)" ::: "memory"); }
                          const unsigned idn2 = S.ppop; F.MISC[4] = idn; F.MISC[5] = idn2; S.issue(idn2); }
                      __syncthreads();
                  }
                }
            }
        }
#if PROBE_REP_K >= 0
        if (rep < nrep) xcd_barrier(bar, F.tid);
        }
#endif
        if (ph + 1 < hi) xcd_barrier(bar, F.tid);
#ifdef PROBE_DOUBLE_BAR
        if (ph + 1 < hi) xcd_barrier(bar, F.tid);
#endif
    }
}

extern "C" void kernel_launch(void* const* d_in, const int* in_sizes, int n_in, void* d_out, int out_size, void* d_ws, size_t ws_size, hipStream_t stream) {
    static int grid = 0;
    if (grid == 0) {
        if (n_in != 28 || out_size != M * DM || ws_size < WS_END) { fprintf(stderr, "kernel_launch: unexpected shapes (n_in %d, out %d, ws %zu)\n", n_in, out_size, ws_size); grid = -1; return; }
        int dev = 0, cus = 0, per_cu = 0;
        if (hipGetDevice(&dev) != hipSuccess || hipDeviceGetAttribute(&cus, hipDeviceAttributeMultiprocessorCount, dev) != hipSuccess) { grid = -1; return; }
        if (hipFuncSetAttribute((const void*)mk_fwd, hipFuncAttributeMaxDynamicSharedMemorySize, LDS_BYTES) != hipSuccess) { fprintf(stderr, "kernel_launch: hipFuncSetAttribute failed\n"); grid = -1; return; }
        if (hipOccupancyMaxActiveBlocksPerMultiprocessor(&per_cu, (const void*)mk_fwd, NWAVES * 64, LDS_BYTES) != hipSuccess || per_cu < 1)
            fprintf(stderr, "kernel_launch: occupancy query reports %d workgroups per CU\n", per_cu);
        (void)hipGetLastError();
        grid = cus;
    }
    if (grid < 0) return;
    if (hipMemsetAsync((char*)d_ws + WS_CTL, 0, CTL_ZERO_BYTES, stream) != hipSuccess) return;
    Args a{};
    for (int i = 0; i < 28; ++i) a.in[i] = (const float*)d_in[i];
    a.out = (float*)d_out; a.ws = (unsigned char*)d_ws;
#if MK_PER_PHASE
    for (int p = 0; p < NPH; ++p) { a.ph_lo = p; a.ph_hi = p + 1; hipLaunchKernelGGL(mk_fwd, dim3(grid), dim3(NWAVES * 64), LDS_BYTES, stream, a); }
#else
    a.ph_lo = 0; a.ph_hi = NPH; hipLaunchKernelGGL(mk_fwd, dim3(grid), dim3(NWAVES * 64), LDS_BYTES, stream, a);
#endif
}
```

```cpp
#include <hip/hip_runtime.h>
#include <cstdio>
#include <cstdint>

#ifndef MK_PER_PHASE
#define MK_PER_PHASE 0
#endif

#ifndef PROBE_P3_PART
#define PROBE_P3_PART 0
#endif
#ifndef PROBE_ATT_VAR
#define PROBE_ATT_VAR -1
#endif
#ifndef BG_CONVERT
#define BG_CONVERT 1
#endif
#ifndef GAP_CONVERT
#define GAP_CONVERT 1
#endif
#ifndef PROBE_ATT_MODE
#define PROBE_ATT_MODE 0
#endif
#ifndef PROBE_REP_K
#define PROBE_REP_K -1
#endif
#define LAS __attribute__((address_space(3)))
#define GAS __attribute__((address_space(1)))
typedef unsigned short bf16;
typedef short bf16x8 __attribute__((ext_vector_type(8)));
typedef short s16x4 __attribute__((ext_vector_type(4)));
typedef float f32x4 __attribute__((ext_vector_type(4)));
typedef float f32x2 __attribute__((ext_vector_type(2)));
typedef float f32x16 __attribute__((ext_vector_type(16)));
typedef unsigned u32x4 __attribute__((ext_vector_type(4)));
typedef unsigned u32x2 __attribute__((ext_vector_type(2)));

constexpr int BATCH = 8, SEQ = 2048, DM = 1024, M = BATCH * SEQ, DEPTH = 2;
constexpr int NP = 3072;
constexpr int P_IN = 2988;
constexpr int C_AQ = 0, C_AK = 256, C_AV = 512, C_BQ = 768, C_BK = 1024, C_BV = 1280, C_CQ = 1536, C_CK = 1792, C_CV = 2048,
              C_DQ = 2304, C_DK = 2560, C_DV = 2624, C_IQ = 2688, C_IK = 2944, C_IW = 2976, C_AF = 2984;
constexpr int NEXP = 32, FF = 256, MAXSLOT = M * 2 + NEXP * 256, MAXTILE = MAXSLOT / 256;
constexpr float LOG2E = 1.4426950408889634f;
constexpr float RMS_EPS = 1e-6f;

constexpr size_t MiB = 1u << 20;
constexpr size_t WS_CTL = 0, CTL_ZERO_BYTES = 1 * MiB;
constexpr size_t WS_WR = 1 * MiB;
constexpr size_t WS_MOD = 2 * MiB;
constexpr size_t WS_CUM = 3 * MiB;
constexpr size_t WS_TOK = 4 * MiB;
constexpr size_t WS_MISC = 5 * MiB;
constexpr size_t WS_MASK = 6 * MiB;
constexpr size_t WS_WIN = 10 * MiB;
constexpr size_t WS_WOUT = 22 * MiB;
constexpr size_t WS_WUP = 26 * MiB;
constexpr size_t WS_WDN = 90 * MiB;
constexpr size_t WS_X1 = 122 * MiB;
constexpr size_t WS_H = 186 * MiB;
constexpr size_t WS_MIX = WS_H;

constexpr size_t WS_PROJ = 218 * MiB;
constexpr size_t WS_Y = WS_PROJ;
constexpr size_t WS_HID = WS_PROJ + 80 * MiB;
constexpr size_t WS_ELIST = 322 * MiB;
constexpr size_t WS_END = 324 * MiB;
constexpr int CW_AQ = 256;
constexpr int CW_CNT = 1024;
constexpr int CW_BAR = 8192;
constexpr int CW_DNQ = 208;
constexpr int CW_UPF = 65536;

constexpr int RING_BYTES = 143360;
constexpr int LDSCTL_OFF = RING_BYTES, MISC_OFF = LDSCTL_OFF + 320, CNTS_OFF = LDSCTL_OFF + 512, BASE_OFF = LDSCTL_OFF + 640, TAB_OFF = LDSCTL_OFF + 768;
constexpr int ROWL_OFF = 131072;
constexpr int LDS_BYTES = 147456;
constexpr int NWAVES = 8;

#define LDS_WAIT() asm volatile("s_waitcnt lgkmcnt(0)" ::: "memory")
#define VM_WAIT() asm volatile("s_waitcnt vmcnt(0)" ::: "memory")
#define RLX_AGENT __ATOMIC_RELAXED, __HIP_MEMORY_SCOPE_AGENT

__device__ __forceinline__ float bf2f(unsigned short u) { return __builtin_bit_cast(float, (unsigned)u << 16); }
__device__ __forceinline__ unsigned f2bf(float f) { unsigned u = __builtin_bit_cast(unsigned, f); return (u + 0x7fffu + ((u >> 16) & 1u)) >> 16; }
__device__ __forceinline__ unsigned pk2(float lo, float hi) { return f2bf(lo) | (f2bf(hi) << 16); }
template <int O> __device__ __forceinline__ float shx(float x) { static_assert(O >= 1 && O <= 16, "swizzle xor"); return __builtin_bit_cast(float, __builtin_amdgcn_ds_swizzle(__builtin_bit_cast(int, x), (O << 10) | 0x1f)); }
__device__ __forceinline__ float half_sum(float x) { return __builtin_bit_cast(float, __builtin_amdgcn_readlane(__builtin_bit_cast(int, x), 0)) + __builtin_bit_cast(float, __builtin_amdgcn_readlane(__builtin_bit_cast(int, x), 32)); }
__device__ __forceinline__ float half_max(float x) { return fmaxf(__builtin_bit_cast(float, __builtin_amdgcn_readlane(__builtin_bit_cast(int, x), 0)), __builtin_bit_cast(float, __builtin_amdgcn_readlane(__builtin_bit_cast(int, x), 32))); }
__device__ __forceinline__ float shup(float x, int o, int lane) { return __builtin_bit_cast(float, __builtin_amdgcn_ds_bpermute((lane - o) << 2, __builtin_bit_cast(int, x))); }
__device__ __forceinline__ int shup_i(int x, int o, int lane) { return __builtin_amdgcn_ds_bpermute((lane - o) << 2, x); }
__device__ __forceinline__ float wave_sum(float v) { v += shx<1>(v); v += shx<2>(v); v += shx<4>(v); v += shx<8>(v); v += shx<16>(v); return half_sum(v); }

namespace pg8 {
constexpr int BM = 256, BK = 64, HALF = 128, HTB = HALF * BK * 2, STAGE_BYTES = 8 * HTB, NXCD = 8, WGM = 8;
__host__ __device__ __forceinline__ int lds_byte(int r, int c) { const int st = (r >> 4) * 2 + (c >> 5), rr = r & 15, cc = c & 31, ob = rr * 64 + cc * 2; return st * 1024 + (ob ^ (((ob >> 9) & 1) << 5)); }
__host__ __device__ __forceinline__ void stage_rc(int b, int& R, int& C) { const int st = b / 1024, sb = b % 1024, swz = sb ^ (((sb >> 9) & 1) << 5); R = (st >> 1) * 16 + swz / 64; C = (st & 1) * 32 + (swz % 64) / 2; }
__host__ __device__ __forceinline__ int perm32(int rho) { const int n = rho >> 4, i = rho & 15; return 8 * (i >> 2) + 4 * n + (i & 3); }

struct Unit { int pm, pn; size_t bo; };
struct Gemm { const bf16* A; const bf16* Bt; int M, N, K; };

struct StaticOrder {
    int nM, nN, nwg, G, c;
    __host__ __device__ void init(int M_, int N_, int G_, int c_) { nM = M_ / BM; nN = N_ / BM; nwg = nM * nN; G = G_; c = c_; }
    __host__ __device__ bool next(int i, Unit& u) const {
        const long L = (long)i * G + c; if (L >= nwg) return false;
        int wgid = (int)L; { const int q = nwg / NXCD, r = nwg % NXCD, xcd = wgid % NXCD, off = wgid / NXCD; wgid = (xcd < r ? xcd * (q + 1) : r * (q + 1) + (xcd - r) * q) + off; }
        const int nig = WGM * nN, gid = wgid / nig, fm = gid * WGM, gsz = (nM - fm) < WGM ? (nM - fm) : WGM;
        u.pm = fm + ((wgid % nig) % gsz); u.pn = (wgid % nig) / gsz; u.bo = 0; return true;
    }
};
struct GroupOrder {
    const LAS int* tab; int ntile, ncol, G, c; size_t ebytes;
    __device__ __forceinline__ bool next(int i, Unit& u) const {
        const long L = (long)i * G + c; if (L >= (long)ntile * ncol) return false;
        u.pm = (int)(L / ncol); u.pn = (int)(L % ncol);
        const int e = __builtin_amdgcn_readfirstlane(tab[u.pm]); u.bo = (size_t)e * ebytes; return true;
    }
};

struct OneUnit { Unit u; __device__ __forceinline__ bool next(int i, Unit& o) const { if (i != 0) return false; o = u; return true; } };
struct DynOrder {
    unsigned* dq; unsigned* upf; const LAS int* tab; volatile LAS unsigned* M; int nd; size_t ebytes; int tid; unsigned G;
    mutable unsigned ppop, pflag;
    __device__ __forceinline__ void issue(unsigned idnext) const {
        ppop = G + __builtin_amdgcn_atomic_inc32(dq, 0xFFFFFFFFu, __ATOMIC_RELAXED, "agent");
        pflag = 2u; if ((int)idnext < nd) pflag = __hip_atomic_load(upf + (idnext >> 2) * 16, __ATOMIC_RELAXED, __HIP_MEMORY_SCOPE_AGENT);
    }
    __device__ __forceinline__ void unit(int id, Unit& u) const { u.pm = id >> 2; u.pn = id & 3; u.bo = (size_t)__builtin_amdgcn_readfirstlane(tab[id >> 2]) * ebytes; }
    __device__ __forceinline__ bool next(int i, Unit& u) const {
        if (i == 0) { const int id = __builtin_amdgcn_readfirstlane((int)M[4]); if (id >= nd) return false; unit(id, u); return true; }
        if (tid == 0) {
            const unsigned idn = M[5]; const bool ready = (int)idn < nd && pflag >= 2u;
            M[6] = ready ? 1u : 0u;
            if (ready) { asm volatile("buffer_inv sc1" ::: "memory"); M[4] = idn; const unsigned idn2 = ppop; M[5] = idn2; issue(idn2); }
        }
        asm volatile("s_waitcnt lgkmcnt(0)\n\ts_barrier" ::: "memory");
        if (__builtin_amdgcn_readfirstlane((int)M[6]) == 0) return false;
        unit(__builtin_amdgcn_readfirstlane((int)M[4]), u); return true;
    }
};

__device__ __forceinline__ unsigned cvt_pk_bf16(float lo, float hi) { unsigned r; asm volatile("v_cvt_pk_bf16_f32 %0, %1, %2" : "=v"(r) : "v"(lo), "v"(hi)); return r; }

struct EpiBf16 {
    static constexpr bool PERM = true, PUBLISH = false;
    bf16* O; int ldc;
    __device__ __forceinline__ void operator()(const f32x4 (&acc)[2][2][4][2], const Unit& u, int wr, int wc, int fr, int fq) const {
        const int row0 = u.pm * BM + wr * 64 + fr; const int col0 = u.pn * BM + wc * 32 + 8 * fq;
#pragma unroll
        for (int ai = 0; ai < 2; ++ai)
#pragma unroll
            for (int m = 0; m < 4; ++m) { bf16* rowp = O + (size_t)(row0 + ai * HALF + m * 16) * ldc + col0;
#pragma unroll
                for (int bj = 0; bj < 2; ++bj) { const f32x4 v0 = acc[ai][bj][m][0], v1 = acc[ai][bj][m][1];
                    u32x4 w; w.x = cvt_pk_bf16(v0[0], v0[1]); w.y = cvt_pk_bf16(v0[2], v0[3]); w.z = cvt_pk_bf16(v1[0], v1[1]); w.w = cvt_pk_bf16(v1[2], v1[3]);
                    *(u32x4*)(rowp + bj * HALF) = w; } }
    }
};
struct EpiResGate {
    static constexpr bool PERM = true, PUBLISH = false;
    const float* base32; const bf16* base16; bf16* out; const float* gate;
    __device__ __forceinline__ void operator()(const f32x4 (&acc)[2][2][4][2], const Unit& u, int wr, int wc, int fr, int fq) const {
        const int col0 = u.pn * BM + wc * 32 + 8 * fq; const float* g = gate + (size_t)(u.pm >> 3) * 6144 + col0;
        f32x4 gv[2][2];
#pragma unroll
        for (int bj = 0; bj < 2; ++bj)
#pragma unroll
            for (int n = 0; n < 2; ++n) gv[bj][n] = *(const f32x4*)(g + bj * HALF + n * 4);
#pragma unroll
        for (int ai = 0; ai < 2; ++ai)
#pragma unroll
            for (int m = 0; m < 4; ++m) { const size_t off = (size_t)(u.pm * BM + ai * HALF + wr * 64 + m * 16 + fr) * DM + col0;
#pragma unroll
                for (int bj = 0; bj < 2; ++bj) { f32x4 b0, b1;
                    if (base32) { b0 = *(const f32x4*)(base32 + off + bj * HALF); b1 = *(const f32x4*)(base32 + off + bj * HALF + 4); }
                    else { const u32x4 r = *(const u32x4*)(base16 + off + bj * HALF);
                        b0 = (f32x4){bf2f(r.x & 0xffff), bf2f(r.x >> 16), bf2f(r.y & 0xffff), bf2f(r.y >> 16)}; b1 = (f32x4){bf2f(r.z & 0xffff), bf2f(r.z >> 16), bf2f(r.w & 0xffff), bf2f(r.w >> 16)}; }
                    const f32x4 v0 = b0 + gv[bj][0] * acc[ai][bj][m][0], v1 = b1 + gv[bj][1] * acc[ai][bj][m][1];
                    u32x4 w; w.x = cvt_pk_bf16(v0[0], v0[1]); w.y = cvt_pk_bf16(v0[2], v0[3]); w.z = cvt_pk_bf16(v1[0], v1[1]); w.w = cvt_pk_bf16(v1[2], v1[3]);
                    *(u32x4*)(out + off + bj * HALF) = w; } }
    }
};
struct EpiSwiglu {
    static constexpr bool PERM = true, PUBLISH = true;
    bf16* O; unsigned* flag;
    __device__ __forceinline__ void operator()(const f32x4 (&acc)[2][2][4][2], const Unit& u, int wr, int wc, int fr, int fq) const {
        const int row0 = u.pm * BM + wr * 64 + fr; const int col0 = u.pn * HALF + wc * 32 + 8 * fq;
#pragma unroll
        for (int ai = 0; ai < 2; ++ai)
#pragma unroll
            for (int m = 0; m < 4; ++m) { bf16* rowp = O + (size_t)(row0 + ai * HALF + m * 16) * FF + col0;
                float hv[8];
#pragma unroll
                for (int n = 0; n < 2; ++n)
#pragma unroll
                    for (int i = 0; i < 4; ++i) { const float a = acc[ai][0][m][n][i], b = acc[ai][1][m][n][i];
                        const float sg = __builtin_amdgcn_rcpf(1.f + __builtin_amdgcn_exp2f(-a * LOG2E)); hv[n * 4 + i] = a * sg * b; }
                u32x4 w; w.x = cvt_pk_bf16(hv[0], hv[1]); w.y = cvt_pk_bf16(hv[2], hv[3]); w.z = cvt_pk_bf16(hv[4], hv[5]); w.w = cvt_pk_bf16(hv[6], hv[7]);
                asm volatile("global_store_dwordx4 %0, %1, off sc1\n\ts_nop 2" :: "v"((const GAS bf16*)rowp), "v"(w) : "memory"); }
    }
};

template <class Epi, class Sched, bool ALIGN_EPI = false, bool SP2 = false, bool GATHER = false>
__device__ __forceinline__ void gemm_phase(LAS unsigned char* lds, const Gemm g, const Sched& S, const Epi& E, const int tid, const LAS int* rowl = nullptr) {
    static_assert(!GATHER || SP2, "gather mode is written for the SP2 loop");
    const int wid = __builtin_amdgcn_readfirstlane(tid >> 6), lane = tid & 63, wr = wid >> 2, wc = wid & 3, fr = lane & 15, fq = lane >> 4;
    const int K = g.K, nt = K / BK;
    unsigned voffA[2], voffB[2];
#pragma unroll
    for (int i = 0; i < 2; ++i) { int R, C; stage_rc(tid * 16 + i * 8192, R, C); const int Rb = Epi::PERM ? ((R & ~31) + perm32(R & 31)) : R;
        voffA[i] = (unsigned)(R * K + C) * 2u; voffB[i] = (unsigned)(Rb * K + C) * 2u; }
    const size_t kstep = (size_t)(BK * 2);
    const size_t hstep = (size_t)HALF * K * 2;
    const size_t tstep = 2 * hstep;
    const size_t hstepA = GATHER ? 0 : hstep, tstepA = GATHER ? 0 : tstep;
    unsigned voffGc[2][2], voffGn[2][2];
    int gR[2], gC[2];
#pragma unroll
    for (int i = 0; i < 2; ++i) stage_rc(tid * 16 + i * 8192, gR[i], gC[i]);
#define PG8_GOFF(dst, ui_) do { _Pragma("unroll") for (int h_ = 0; h_ < 2; ++h_) _Pragma("unroll") for (int i_ = 0; i_ < 2; ++i_) \
        dst[h_][i_] = (unsigned)rowl[(ui_) * 256 + h_ * HALF + gR[i_]] * (unsigned)(K * 2) + (unsigned)gC[i_] * 2u; } while (0)
    const unsigned ldsw = (unsigned)wid * 1024u;
    const int aoff = lds_byte(wr * 64 + fr, fq * 8), boff = lds_byte(wc * 32 + fr, fq * 8);
#define PG8_SA(b, h) (((b) * 2 + (h)) * HTB)
#define PG8_SB(b, h) ((4 + (b) * 2 + (h)) * HTB)
#define PG8_STAGE(bufoff, gbase, voff) do { _Pragma("unroll") for (int _i = 0; _i < 2; ++_i) \
        __builtin_amdgcn_global_load_lds((const unsigned*)((const char*)(gbase) + (voff)[_i]), (LAS unsigned*)(lds + (bufoff) + ldsw + _i * 8192), 16, 0, 0); } while (0)
#define PG8_STAGE_A(bufoff, gbase, H, NXT) do { if constexpr (GATHER) { unsigned vo_[2]; vo_[0] = (NXT) ? voffGn[H][0] : voffGc[H][0]; vo_[1] = (NXT) ? voffGn[H][1] : voffGc[H][1]; PG8_STAGE(bufoff, gbase, vo_); } \
        else { PG8_STAGE(bufoff, (const char*)(gbase) + (H) * hstep, voffA); } } while (0)
#define PG8_LDA(dst, b, h) do { _Pragma("unroll") for (int m = 0; m < 4; ++m) _Pragma("unroll") for (int k = 0; k < 2; ++k) dst[m][k] = *(const LAS bf16x8*)(lds + PG8_SA(b, h) + aoff + m * 2048 + k * 1024); } while (0)
#define PG8_LDB(dst, b, h) do { _Pragma("unroll") for (int n = 0; n < 2; ++n) _Pragma("unroll") for (int k = 0; k < 2; ++k) dst[n][k] = *(const LAS bf16x8*)(lds + PG8_SB(b, h) + boff + n * 2048 + k * 1024); } while (0)
#define PG8_MMA(ai, bj, At, Bt) do { __builtin_amdgcn_s_setprio(1); _Pragma("unroll") for (int m = 0; m < 4; ++m) _Pragma("unroll") for (int n = 0; n < 2; ++n) _Pragma("unroll") for (int k = 0; k < 2; ++k) \
        acc[ai][bj][m][n] = __builtin_amdgcn_mfma_f32_16x16x32_bf16(Bt[n][k], At[m][k], acc[ai][bj][m][n], 0, 0, 0); __builtin_amdgcn_s_setprio(0); } while (0)
#define PG8_WAIT_V(n) asm volatile("s_waitcnt vmcnt(" #n ")" ::: "memory")
#define PG8_WAIT_L(n) asm volatile("s_waitcnt lgkmcnt(" #n ")" ::: "memory")
#define PG8_BAR __builtin_amdgcn_s_barrier()
#define PG8_SCHED __builtin_amdgcn_sched_barrier(0)
    Unit cur, nxt; int ui = 0;
    if (!S.next(0, cur)) return;
    f32x4 acc[2][2][4][2];
#pragma unroll
    for (int a = 0; a < 2; ++a)
#pragma unroll
        for (int b = 0; b < 2; ++b)
#pragma unroll
            for (int m = 0; m < 4; ++m)
#pragma unroll
                for (int n = 0; n < 2; ++n) acc[a][b][m][n] = (f32x4){0.f, 0.f, 0.f, 0.f};
    bf16x8 At[4][2], B0[2][2], B1[2][2];
    const char* cA = (const char*)g.A + (size_t)cur.pm * tstepA; const char* cB = (const char*)g.Bt + cur.bo + (size_t)cur.pn * tstep;
    if constexpr (GATHER) { PG8_GOFF(voffGc, 0); PG8_GOFF(voffGn, 0); }
    if constexpr (SP2) {
        PG8_STAGE(PG8_SB(0, 0), cB, voffB); PG8_STAGE(PG8_SB(0, 1), cB + hstep, voffB); PG8_STAGE_A(PG8_SA(0, 0), cA, 0, false); PG8_STAGE_A(PG8_SA(0, 1), cA, 1, false);
        if (wr == 1) PG8_BAR;
        PG8_WAIT_V(2); PG8_BAR;
        PG8_STAGE(PG8_SB(1, 0), cB + kstep, voffB); PG8_STAGE_A(PG8_SA(1, 0), cA + kstep, 0, false); PG8_STAGE(PG8_SB(1, 1), cB + hstep + kstep, voffB);
        PG8_WAIT_V(6); PG8_BAR;
    } else {
        PG8_STAGE(PG8_SB(0, 0), cB, voffB); PG8_STAGE(PG8_SA(0, 0), cA, voffA); PG8_STAGE(PG8_SB(0, 1), cB + hstep, voffB); PG8_STAGE(PG8_SA(0, 1), cA + hstep, voffA);
        if (wr == 1) PG8_BAR;
        PG8_WAIT_V(4); PG8_BAR;
        PG8_STAGE(PG8_SB(1, 0), cB + kstep, voffB); PG8_STAGE(PG8_SA(1, 0), cA + kstep, voffA); PG8_STAGE(PG8_SB(1, 1), cB + hstep + kstep, voffB);
        PG8_WAIT_V(6); PG8_BAR;
    }
    for (;;) {
        const bool has_next = S.next(ui + 1, nxt);
        if constexpr (GATHER) { if (has_next) PG8_GOFF(voffGn, ui + 1); }
        const char* nA = has_next ? (const char*)g.A + (size_t)nxt.pm * tstepA : cA; const char* nB = has_next ? (const char*)g.Bt + nxt.bo + (size_t)nxt.pn * tstep : cB;
#pragma unroll 1
        for (int t = 0; t < nt; t += 2) {
            const bool last = (t == nt - 2);
            const char* a1 = cA + (size_t)(t + 1) * kstep;
            const char* a2 = last ? nA : cA + (size_t)(t + 2) * kstep; const char* b2 = last ? nB : cB + (size_t)(t + 2) * kstep;
            const char* a3 = a2 + kstep; const char* b3 = b2 + kstep;
            if constexpr (SP2) {
            PG8_LDB(B0, 0, 0); PG8_LDB(B1, 0, 1); PG8_SCHED; PG8_LDA(At, 0, 0); PG8_STAGE_A(PG8_SA(1, 1), a1, 1, false);
            PG8_WAIT_V(8); PG8_WAIT_L(0); PG8_BAR; PG8_MMA(0, 0, At, B0); PG8_MMA(0, 1, At, B1); PG8_BAR; PG8_SCHED;
            PG8_LDA(At, 0, 1); PG8_STAGE(PG8_SB(0, 0), b2, voffB); PG8_STAGE(PG8_SB(0, 1), b2 + hstep, voffB); PG8_STAGE_A(PG8_SA(0, 0), a2, 0, last);
            PG8_WAIT_V(8); PG8_WAIT_L(0); PG8_BAR; PG8_MMA(1, 0, At, B0); PG8_MMA(1, 1, At, B1); PG8_BAR; PG8_SCHED;
            PG8_LDB(B0, 1, 0); PG8_LDB(B1, 1, 1); PG8_SCHED; PG8_LDA(At, 1, 0); PG8_STAGE_A(PG8_SA(0, 1), a2, 1, last);
            PG8_WAIT_V(8); PG8_WAIT_L(0); PG8_BAR; PG8_MMA(0, 0, At, B0); PG8_MMA(0, 1, At, B1); PG8_BAR; PG8_SCHED;
            PG8_LDA(At, 1, 1); PG8_STAGE(PG8_SB(1, 0), b3, voffB); PG8_STAGE(PG8_SB(1, 1), b3 + hstep, voffB); PG8_STAGE_A(PG8_SA(1, 0), a3, 0, last);
            PG8_WAIT_V(8); PG8_WAIT_L(0); PG8_BAR; PG8_MMA(1, 0, At, B0); PG8_MMA(1, 1, At, B1); PG8_BAR; PG8_SCHED;
            } else {
            PG8_LDB(B0, 0, 0); PG8_SCHED; PG8_LDA(At, 0, 0); PG8_STAGE(PG8_SA(1, 1), a1 + hstep, voffA);
            PG8_WAIT_L(8); PG8_BAR; PG8_WAIT_L(0); PG8_MMA(0, 0, At, B0); PG8_BAR; PG8_SCHED;
            PG8_LDB(B1, 0, 1); PG8_STAGE(PG8_SB(0, 0), b2, voffB);
            PG8_BAR; PG8_WAIT_L(0); PG8_MMA(0, 1, At, B1); PG8_BAR;
            PG8_LDA(At, 0, 1); PG8_STAGE(PG8_SA(0, 0), a2, voffA);
            PG8_BAR; PG8_WAIT_L(0); PG8_MMA(1, 0, At, B0); PG8_BAR; PG8_SCHED;
            PG8_STAGE(PG8_SB(0, 1), b2 + hstep, voffB);
            PG8_WAIT_V(6); PG8_BAR; PG8_MMA(1, 1, At, B1); PG8_BAR;
            PG8_LDB(B0, 1, 0); PG8_SCHED; PG8_LDA(At, 1, 0); PG8_STAGE(PG8_SA(0, 1), a2 + hstep, voffA);
            PG8_WAIT_L(8); PG8_BAR; PG8_WAIT_L(0); PG8_MMA(0, 0, At, B0); PG8_BAR; PG8_SCHED;
            PG8_LDB(B1, 1, 1); PG8_STAGE(PG8_SB(1, 0), b3, voffB);
            PG8_BAR; PG8_WAIT_L(0); PG8_MMA(0, 1, At, B1); PG8_BAR;
            PG8_LDA(At, 1, 1); PG8_STAGE(PG8_SA(1, 0), a3, voffA);
            PG8_BAR; PG8_WAIT_L(0); PG8_MMA(1, 0, At, B0); PG8_BAR; PG8_SCHED;
            PG8_STAGE(PG8_SB(1, 1), b3 + hstep, voffB);
            PG8_WAIT_V(6); PG8_BAR; PG8_MMA(1, 1, At, B1); PG8_BAR;
            }
        }
        if constexpr (ALIGN_EPI) { if (wr == 0) PG8_BAR; }
        E(acc, cur, wr, wc, fr, fq);
        if constexpr (Epi::PUBLISH) {
            asm volatile("s_waitcnt vmcnt(0)" ::: "memory"); PG8_BAR;
            if (tid == 0) __hip_atomic_fetch_add(E.flag + cur.pm * 16, 1u, __ATOMIC_RELAXED, __HIP_MEMORY_SCOPE_AGENT);
        }
        if (!has_next) break;
#pragma unroll
        for (int a = 0; a < 2; ++a)
#pragma unroll
            for (int b = 0; b < 2; ++b)
#pragma unroll
                for (int m = 0; m < 4; ++m)
#pragma unroll
                    for (int n = 0; n < 2; ++n) acc[a][b][m][n] = (f32x4){0.f, 0.f, 0.f, 0.f};
        cur = nxt; cA = nA; cB = nB; ++ui;
        if constexpr (GATHER) { _Pragma("unroll") for (int h_ = 0; h_ < 2; ++h_) _Pragma("unroll") for (int i_ = 0; i_ < 2; ++i_) voffGc[h_][i_] = voffGn[h_][i_]; }
        if constexpr (ALIGN_EPI) { if (wr == 1) PG8_BAR; }
    }
    PG8_WAIT_V(0);
    if constexpr (!ALIGN_EPI) { if (wr == 0) PG8_BAR; }
    PG8_BAR;
#undef PG8_SA
#undef PG8_STAGE_A
#undef PG8_GOFF
#undef PG8_SB
#undef PG8_STAGE
#undef PG8_LDA
#undef PG8_LDB
#undef PG8_MMA
#undef PG8_WAIT_V
#undef PG8_WAIT_L
#undef PG8_BAR
#undef PG8_SCHED
}
}

#define XB_TMO      128
#define XB_XCNT(j)  (256  + 64 * (j))
#define XB_XSUB(j)  (1280 + 64 * (j))
#define XB_XGEN(j)  (2304 + 64 * (j))
#define XB_TOP      3328
#define XB_TOPGEN   3392
#define XCD_BAR_WORDS 3456
#define XB_SPIN_CAP (1u << 18)
__device__ __forceinline__ unsigned xb_ld(unsigned* p)              { return __hip_atomic_load(p, __ATOMIC_RELAXED, __HIP_MEMORY_SCOPE_AGENT); }
__device__ __forceinline__ unsigned xb_add(unsigned* p, unsigned v) { return __hip_atomic_fetch_add(p, v, __ATOMIC_RELAXED, __HIP_MEMORY_SCOPE_AGENT); }
__device__ __forceinline__ unsigned xb_xcc_id() { return (unsigned)__builtin_amdgcn_s_getreg((3 << 11) | 20) & 0xFu; }
#define XB_SPIN(cond, bar) do { unsigned _sp = 0; while (cond) { __builtin_amdgcn_s_sleep(1); \
    if ((++_sp & 255u) == 0u) { if (xb_ld(&(bar)[XB_TMO])) break; if (_sp > XB_SPIN_CAP) { atomicAdd(&(bar)[XB_TMO], 1u); break; } } } } while (0)
struct XcdBarrier { unsigned* bar; unsigned x; volatile LAS unsigned* st; };
__device__ __forceinline__ XcdBarrier xcd_barrier_post(unsigned* bar, volatile LAS unsigned* st) {
    XcdBarrier b; b.bar = bar; b.x = xb_xcc_id(); b.st = st;
    if (threadIdx.x == 0) (void)xb_add(&bar[XB_XCNT(b.x)], 1u);
    return b;
}
__device__ __forceinline__ void xcd_barrier_complete(unsigned* bar, unsigned x, unsigned& nloc, unsigned& nx) {
    const unsigned G = gridDim.x * gridDim.y * gridDim.z;
    unsigned sum, cnt, mine, sp = 0u;
    for (;;) {
        sum = 0u; cnt = 0u; mine = 0u;
#pragma unroll 1
        for (unsigned j = 0; j < 16; ++j) { const unsigned c = xb_ld(&bar[XB_XCNT(j)]); sum += c; cnt += (c > 0u) ? 1u : 0u; mine = (j == x) ? c : mine; }
        if (sum == G) break;
        __builtin_amdgcn_s_sleep(1);
        if ((++sp & 255u) == 0u) { if (xb_ld(&bar[XB_TMO])) break; if (sp > XB_SPIN_CAP) { atomicAdd(&bar[XB_TMO], 1u); break; } }
    }
    nloc = mine > 0u ? mine : 1u; nx = cnt > 0u ? cnt : 1u;
}
__device__ __forceinline__ void xcd_barrier(const XcdBarrier& b, const int tid) {
    asm volatile("s_waitcnt vmcnt(0)" ::: "memory");
    __syncthreads();
    if (tid == 0) {
        unsigned* bar = b.bar;
        __builtin_amdgcn_s_waitcnt(0);
        unsigned nloc = b.st[0], nx = b.st[1];
        if (nloc == 0u) { xcd_barrier_complete(bar, b.x, nloc, nx); b.st[0] = nloc; b.st[1] = nx; }
        const unsigned old = xb_add(&bar[XB_XSUB(b.x)], 1u);
        const unsigned gen = old / nloc;
        if (old + 1u == (gen + 1u) * nloc) {
            __builtin_amdgcn_fence(__ATOMIC_RELEASE, "agent");
            asm volatile("s_waitcnt vmcnt(0)" ::: "memory");
            const unsigned og = xb_add(&bar[XB_TOP], 1u);
            const unsigned tg = og / nx;
            if (og + 1u == (tg + 1u) * nx) xb_add(&bar[XB_TOPGEN], 1u);
            else XB_SPIN(xb_ld(&bar[XB_TOPGEN]) == tg, bar);
            __builtin_amdgcn_fence(__ATOMIC_ACQUIRE, "agent");
            xb_add(&bar[XB_XGEN(b.x)], 1u);
            asm volatile("s_waitcnt vmcnt(0)" ::: "memory");
        } else {
            XB_SPIN(xb_ld(&bar[XB_XGEN(b.x)]) == gen, bar);
            __builtin_amdgcn_fence(__ATOMIC_ACQUIRE, "agent");
            asm volatile("s_waitcnt vmcnt(0)" ::: "memory");
        }
    }
    __syncthreads();
}

struct Frame {
    LAS unsigned char* lds;
    volatile LAS unsigned* MISC;
    unsigned* ctl;
    int tid, lane, wave, vcu, G, bx;
    float* out; unsigned char* ws;
};
struct Args { const float* in[28]; float* out; unsigned char* ws; int ph_lo, ph_hi; };
enum { I_X = 0, I_C, I_ADAW, I_ADAB, I_N1G, I_N2G, I_WIN, I_BF, I_QNA, I_KNA, I_QNC, I_KNC, I_LQ1, I_LK1, I_LQ2, I_LK2, I_SUBLN, I_QND, I_KND, I_MIXB, I_WOUT,
       I_WG, I_BG, I_WE, I_BE, I_W1, I_W3, I_W2 };
template <int I> __device__ __forceinline__ const float* inp() {
    auto ka = __builtin_amdgcn_kernarg_segment_ptr(); unsigned long long raw;
    asm volatile("s_load_dwordx2 %0, %1, %2\n\ts_waitcnt lgkmcnt(0)" : "=s"(raw) : "s"(ka), "i"(I * 8));
    return (const float*)(const GAS float*)raw;
}


struct TItem { const float* W; bf16* WT; const float* rs; int ldw, K, dst_row0, src_n0, kb, mapin; };
__device__ __forceinline__ int colmap_in(int n) { return n < 768 ? n : (n < 2984 ? n + 4 : (n < 2988 ? n - 2984 + 768 : -1)); }
__device__ __forceinline__ void t_load(const TItem& T, f32x4 (&v)[8], int lane) {
    const int k0 = 64 * T.kb, r8 = lane >> 3, c4 = (lane & 7) * 4; const int sc = T.mapin ? colmap_in(T.src_n0 + c4) : T.src_n0 + c4;
#pragma unroll
    for (int i = 0; i < 8; ++i) { v[i] = (f32x4){0.f, 0.f, 0.f, 0.f}; if (sc >= 0) v[i] = *(const f32x4*)(T.W + (size_t)(k0 + 8 * r8 + i) * T.ldw + sc); }
}
__device__ __forceinline__ void t_store(const TItem& T, f32x4 (&v)[8], LAS float* scr, int lane) {
    (void)scr;
    const int k0 = 64 * T.kb, r8 = lane >> 3, c4 = (lane & 7) * 4;
    if (T.rs) {
#pragma unroll
        for (int i = 0; i < 8; ++i) v[i] = v[i] * T.rs[k0 + 8 * r8 + i]; }
#pragma unroll
    for (int c = 0; c < 4; ++c) { u32x4 o; o.x = pg8::cvt_pk_bf16(v[0][c], v[1][c]); o.y = pg8::cvt_pk_bf16(v[2][c], v[3][c]); o.z = pg8::cvt_pk_bf16(v[4][c], v[5][c]); o.w = pg8::cvt_pk_bf16(v[6][c], v[7][c]);
        *(GAS u32x4*)(T.WT + (size_t)(T.dst_row0 + c4 + c) * T.K + k0 + 8 * r8) = o; }
}
__device__ __forceinline__ float lambda_init(int l) { return l == 0 ? 0.2f : (0.8f - 0.6f * 0.7408182206817179f); }

constexpr int CI_IN = 16 * 96, CI_OUT = 16 * 32, CI_UP1 = 16 * 8, CI_DN = 4 * 32, CN_UP = 32 * 2 * CI_UP1, CN_DN = 32 * CI_DN, NITEMS_L = CI_IN + CI_OUT + CN_UP + CN_DN;
__device__ __forceinline__ void fill_rowscale(Frame& F, const Args& A, int l, LAS float* rsl) {
    for (int k = F.tid; k < DM; k += 512) { float v = inp<I_MIXB>()[l * DM + k];
        if (k >= 512 && k < 768) v *= inp<I_SUBLN>()[l * 64 + ((k - 512) & 63)] * (1.f - lambda_init(l)); rsl[k] = v; }
}
__device__ __forceinline__ void convert_items(Frame& F, const Args& A, int l, int first, int stride, int limit, LAS float* rsl) {
    LAS float* scr = (LAS float*)(F.lds + F.wave * 8704);
    bf16* WIN = (bf16*)(F.ws + WS_WIN); bf16* WOUT = (bf16*)(F.ws + WS_WOUT); bf16* WUP = (bf16*)(F.ws + WS_WUP); bf16* WDN = (bf16*)(F.ws + WS_WDN);
    auto decode = [&](int it, TItem& T) {
        int r = it; T.rs = nullptr; T.mapin = 0;
        if (r < CI_IN) { T.kb = r / 96; const int nb = r % 96;
            T.W = inp<I_WIN>() + (size_t)l * DM * P_IN; T.ldw = P_IN; T.K = DM; T.WT = WIN + (size_t)l * NP * DM; T.dst_row0 = 32 * nb; T.src_n0 = 32 * nb; T.mapin = 1; return; }
        r -= CI_IN;
        if (r < CI_OUT) { T.kb = r / 32; const int nb = r % 32;
            T.W = inp<I_WOUT>() + (size_t)l * DM * DM; T.ldw = DM; T.K = DM; T.WT = WOUT + (size_t)l * DM * DM; T.dst_row0 = 32 * nb; T.src_n0 = 32 * nb; T.rs = (const float*)rsl; return; }
        r -= CI_OUT;
        if (r < CN_UP) { const int le = l * 32 + r / (2 * CI_UP1), q = r % (2 * CI_UP1), which = q / CI_UP1, q2 = q % CI_UP1; T.kb = q2 / 8; const int nb = q2 % 8;
            T.W = (which == 0 ? inp<I_W1>() : inp<I_W3>()) + (size_t)le * DM * FF; T.ldw = FF; T.K = DM; T.WT = WUP + (size_t)le * 512 * DM;
            const int n0 = 32 * nb, pn = n0 >> 7, j = n0 & 127; T.dst_row0 = 256 * pn + 128 * which + j; T.src_n0 = n0; return; }
        r -= CN_UP;
        { const int le = l * 32 + r / CI_DN, q = r % CI_DN; T.kb = q / 32; const int nb = q % 32;
          T.W = inp<I_W2>() + (size_t)le * FF * DM; T.ldw = DM; T.K = FF; T.WT = WDN + (size_t)le * DM * FF; T.dst_row0 = 32 * nb; T.src_n0 = 32 * nb; }
    };
    TItem T0, T1, T2; f32x4 v0[8], v1[8], v2[8]; int it = first;
    if (it < limit) { decode(it, T0); t_load(T0, v0, F.lane); }
    if (it + stride < limit) { decode(it + stride, T1); t_load(T1, v1, F.lane); }
    while (it < limit) {
        if (it + 2 * stride < limit) { decode(it + 2 * stride, T2); t_load(T2, v2, F.lane); }
        t_store(T0, v0, scr, F.lane); it += stride; if (it >= limit) break;
        if (it + 2 * stride < limit) { decode(it + 2 * stride, T0); t_load(T0, v0, F.lane); }
        t_store(T1, v1, scr, F.lane); it += stride; if (it >= limit) break;
        if (it + 2 * stride < limit) { decode(it + 2 * stride, T1); t_load(T1, v1, F.lane); }
        t_store(T2, v2, scr, F.lane); it += stride;
    }
}
constexpr int CV_L0 = NITEMS_L - CI_IN, CV_TOTAL = CV_L0 + NITEMS_L, CV_CHUNK = 64, CW_CVQ = 192;
__device__ __forceinline__ void convert_chunk(Frame& F, const Args& A, int gbase, LAS float* rsl2  ) {
    const int g0 = gbase + F.wave * (CV_CHUNK / NWAVES);
#pragma unroll 1
    for (int l = 0; l < 2; ++l) {
        const int lo = g0 > (l ? CV_L0 : 0) ? g0 : (l ? CV_L0 : 0), hi0 = g0 + CV_CHUNK / NWAVES, hi = hi0 < (l ? CV_TOTAL : CV_L0) ? hi0 : (l ? CV_TOTAL : CV_L0);
        if (lo < hi) { const int off = l ? -CV_L0 : CI_IN; convert_items(F, A, l, lo + off, 1, hi + off, rsl2 + l * DM); }
    }
}
__device__ __forceinline__ void convert_layer1_in_gap(Frame& F, const Args& A, int n2  ) {
    LAS float* rsl = (LAS float*)(F.lds + 8 * 8704);
    if (n2 < 0) n2 = 0; if (n2 > F.G - 32) n2 = F.G - 32;
    if (F.bx < n2) return;
    fill_rowscale(F, A, 1, rsl);
    __syncthreads();
    const int nw = (F.G - n2) * NWAVES;
    convert_items(F, A, 1, (F.bx - n2) * NWAVES + F.wave, nw, NITEMS_L, rsl);
    __syncthreads();
}

__device__ __forceinline__ void p0_prologue(Frame& F, const Args& A) {
    LAS float* rsl = (LAS float*)(F.lds + 8 * 8704);
    fill_rowscale(F, A, 0, rsl);
    __syncthreads();
    const int gw = F.vcu * NWAVES + F.wave, NGW = F.G * NWAVES;
    convert_items(F, A, 0, gw, NGW, BG_CONVERT ? CI_IN : NITEMS_L, rsl);
    if (!GAP_CONVERT && !BG_CONVERT) { __syncthreads(); fill_rowscale(F, A, 1, rsl); __syncthreads(); convert_items(F, A, 1, gw, NGW, NITEMS_L, rsl); }
    { bf16* WRH = (bf16*)(F.ws + WS_WR); bf16* WRL = WRH + 2 * 48 * DM;
      for (int i = gw * 64 + F.lane; i < 2 * 48 * DM; i += NGW * 64) { const int l = i / (48 * DM), r = i % (48 * DM), o = r >> 10, k = r & 1023;
          float w = 0.f; if (o < 4) w = inp<I_WG>()[((size_t)l * DM + k) * 4 + o]; else if (o < 36) w = inp<I_WE>()[((size_t)l * DM + k) * 32 + (o - 4)];
          const unsigned hi = f2bf(w); WRH[i] = (bf16)hi; WRL[i] = (bf16)f2bf(w - bf2f((unsigned short)hi)); } }
    if (F.bx == 0 && F.wave == 0) {
        for (int l = 0; l < 2; ++l) { float a = 0.f, b = 0.f; if (F.lane < 32) { a = inp<I_LQ1>()[l * 32 + F.lane] * inp<I_LK1>()[l * 32 + F.lane]; b = inp<I_LQ2>()[l * 32 + F.lane] * inp<I_LK2>()[l * 32 + F.lane]; }
            a = wave_sum(a); b = wave_sum(b); if (F.lane == 0) ((float*)(F.ws + WS_MISC))[l] = __expf(a) - __expf(b) + lambda_init(l); }
    }
    __syncthreads();
    LAS float* cact = (LAS float*)F.lds;
    LAS float* red = (LAS float*)(F.lds + 32768);
    for (int i = F.tid; i < BATCH * DM; i += 512) { const float c = inp<I_C>()[i]; cact[i] = c / (1.f + __expf(-c)); }
    __syncthreads();
    for (int item = F.bx; item < 2 * 96; item += F.G) {
        const int l = item / 96, nb = item % 96, n = nb * 64 + F.lane; const float* aw = inp<I_ADAW>() + (size_t)l * DM * 6144 + n;
        float acc[8];
#pragma unroll
        for (int b = 0; b < 8; ++b) acc[b] = 0.f;
        const int k0 = F.wave * 128;
#pragma unroll 64
        for (int k = 0; k < 128; ++k) { const float w = aw[(size_t)(k0 + k) * 6144];
#pragma unroll
            for (int b = 0; b < 8; ++b) acc[b] += cact[b * DM + k0 + k] * w; }
#pragma unroll
        for (int b = 0; b < 8; ++b) red[(F.wave * 8 + b) * 64 + F.lane] = acc[b];
        __syncthreads();
        { const int b = F.wave; float s = inp<I_ADAB>()[l * 6144 + n];
#pragma unroll
          for (int w = 0; w < 8; ++w) s += red[(w * 8 + b) * 64 + F.lane];
          ((float*)(F.ws + WS_MOD))[((size_t)l * 8 + b) * 6144 + n] = s; }
        __syncthreads();
    }
}

__device__ __forceinline__ void build_tables(Frame& F, int l) {
    volatile LAS int* cnts = (volatile LAS int*)(F.lds + CNTS_OFF); volatile LAS int* base = (volatile LAS int*)(F.lds + BASE_OFF); volatile LAS int* tab = (volatile LAS int*)(F.lds + TAB_OFF);
    __syncthreads();
    if (F.tid < 64) {
        const int e = F.tid; int cnt = 0; if (e < 32) cnt = (int)__hip_atomic_load(F.ctl + CW_CNT + (l * 32 + e) * 16, RLX_AGENT);
        const int n = (cnt + 255) >> 8; int incl = n;
#pragma unroll
        for (int o = 1; o < 32; o <<= 1) { const int u = shup_i(incl, o, e); if (e >= o) incl += u; }
        const int t0 = incl - n;
        if (e < 32) { cnts[e] = cnt; base[e] = t0; for (int j = 0; j < n && t0 + j < MAXTILE; ++j) tab[t0 + j] = e; }
        if (e == 31) F.MISC[1] = (unsigned)(incl < MAXTILE ? incl : MAXTILE);
    }
    __syncthreads();
}
__device__ __forceinline__ void row_pass(Frame& F, const Args& A, int mode, int l) {
    const int gw = F.vcu * NWAVES + F.wave; const int lane = F.lane;
    const float* MOD = (const float*)(F.ws + WS_MOD);
    bf16* X1 = (bf16*)(F.ws + WS_X1); bf16* H = (bf16*)(F.ws + WS_H); const bf16* Y = (const bf16*)(F.ws + WS_Y);
    const int* tok_e = (const int*)(F.ws + WS_TOK); const int* tok_pos = (const int*)(F.ws + WS_TOK) + 4 * M; const float* tok_w = (const float*)(F.ws + WS_TOK) + 2 * M;
    volatile LAS int* basel = (volatile LAS int*)(F.lds + BASE_OFF);
    if (mode != 0) build_tables(F, mode == 1 ? 0 : 1);
    const int b = (gw * 8) >> 11; const int lp = (mode == 1) ? 0 : 1;
    f32x4 g2v[4], gm[4], shv[4];
#pragma unroll
    for (int j = 0; j < 4; ++j) { const int col = 256 * j + 4 * lane;
        g2v[j] = (f32x4){0.f, 0.f, 0.f, 0.f}; gm[j] = g2v[j]; shv[j] = g2v[j];
        if (mode != 0) g2v[j] = *(const f32x4*)(MOD + ((size_t)lp * 8 + b) * 6144 + 5 * DM + col);
        if (mode != 2) { const float* md = MOD + ((size_t)l * 8 + b) * 6144; gm[j] = *(const f32x4*)(inp<I_N1G>() + l * DM + col) * (*(const f32x4*)(md + DM + col) + 1.0f); shv[j] = *(const f32x4*)(md + col); } }
    for (int m0 = gw * 8; m0 < gw * 8 + 8; m0 += 4) {
        f32x4 v[4][4]; u32x2 ya[4][4], yb[4][4]; float wa[4], wb[4];
        if (mode != 0) {
            int sa[4], sb[4];
#pragma unroll
            for (int r = 0; r < 4; ++r) { const int m = m0 + r; sa[r] = 256 * basel[tok_e[m]] + tok_pos[m]; sb[r] = 256 * basel[tok_e[M + m]] + tok_pos[M + m]; wa[r] = tok_w[m]; wb[r] = tok_w[M + m]; }
#pragma unroll
            for (int r = 0; r < 4; ++r)
#pragma unroll
                for (int j = 0; j < 4; ++j) { const int col = 256 * j + 4 * lane; ya[r][j] = *(const u32x2*)(Y + (size_t)sa[r] * DM + col); yb[r][j] = *(const u32x2*)(Y + (size_t)sb[r] * DM + col); }
        }
#pragma unroll
        for (int r = 0; r < 4; ++r) { const int m = m0 + r;
            if (mode == 0) { const float* xr = inp<I_X>() + (size_t)m * DM;
#pragma unroll
                for (int j = 0; j < 4; ++j) v[r][j] = *(const f32x4*)(xr + 256 * j + 4 * lane); }
            else { const bf16* xr = X1 + (size_t)m * DM;
#pragma unroll
                for (int j = 0; j < 4; ++j) { const u32x2 q = *(const u32x2*)(xr + 256 * j + 4 * lane); v[r][j] = (f32x4){bf2f(q.x & 0xffff), bf2f(q.x >> 16), bf2f(q.y & 0xffff), bf2f(q.y >> 16)}; } } }
#pragma unroll
        for (int r = 0; r < 4; ++r) { const int m = m0 + r;
            if (mode != 0) {
#pragma unroll
                for (int j = 0; j < 4; ++j) { const u32x2 a = ya[r][j], c = yb[r][j];
                    f32x4 mo; mo[0] = wa[r] * bf2f(a.x & 0xffff) + wb[r] * bf2f(c.x & 0xffff); mo[1] = wa[r] * bf2f(a.x >> 16) + wb[r] * bf2f(c.x >> 16);
                    mo[2] = wa[r] * bf2f(a.y & 0xffff) + wb[r] * bf2f(c.y & 0xffff); mo[3] = wa[r] * bf2f(a.y >> 16) + wb[r] * bf2f(c.y >> 16);
                    v[r][j] = v[r][j] + g2v[j] * mo; }
                if (mode == 1) {
#pragma unroll
                    for (int j = 0; j < 4; ++j) { u32x2 q; q.x = pk2(v[r][j][0], v[r][j][1]); q.y = pk2(v[r][j][2], v[r][j][3]); *(u32x2*)(X1 + (size_t)m * DM + 256 * j + 4 * lane) = q; }
                } else { float* orow = F.out + (size_t)m * DM;
#pragma unroll
                    for (int j = 0; j < 4; ++j) *(f32x4*)(orow + 256 * j + 4 * lane) = v[r][j]; }
            }
            if (mode != 2) {
                float ss = 0.f;
#pragma unroll
                for (int j = 0; j < 4; ++j) ss += (v[r][j][0] * v[r][j][0] + v[r][j][1] * v[r][j][1]) + (v[r][j][2] * v[r][j][2] + v[r][j][3] * v[r][j][3]);
                const float rstd = 1.0f / sqrtf(wave_sum(ss) * (1.f / DM) + RMS_EPS);
#pragma unroll
                for (int j = 0; j < 4; ++j) { const f32x4 hv = v[r][j] * rstd * gm[j] + shv[j]; u32x2 w; w.x = pk2(hv[0], hv[1]); w.y = pk2(hv[2], hv[3]);
                    *(u32x2*)(H + (size_t)m * DM + 256 * j + 4 * lane) = w; }
            }
        }
    }
}

__device__ __forceinline__ void knorm_seg(bf16* p, int lane, int nlanes_active, int group_lanes, const float* gain, int gmask, float inv_n) {
    u32x2 raw = (u32x2){0u, 0u}; if (lane < nlanes_active) raw = *(const u32x2*)(p + 4 * lane);
    float x0 = bf2f(raw.x & 0xffff), x1 = bf2f(raw.x >> 16), x2 = bf2f(raw.y & 0xffff), x3 = bf2f(raw.y >> 16);
    float ss = (x0 * x0 + x1 * x1) + (x2 * x2 + x3 * x3);
    for (int o = 1; o < group_lanes; o <<= 1) ss += __shfl_xor(ss, o);
    const float rstd = 1.0f / sqrtf(ss * inv_n + RMS_EPS);
    const int c = (4 * lane) & gmask;
    x0 *= rstd * gain[c]; x1 *= rstd * gain[c + 1]; x2 *= rstd * gain[c + 2]; x3 *= rstd * gain[c + 3];
    if (lane < nlanes_active) { u32x2 w; w.x = pk2(x0, x1); w.y = pk2(x2, x3); *(u32x2*)(p + 4 * lane) = w; }
}
__device__ __forceinline__ unsigned sortable(float f) { const unsigned u = __builtin_bit_cast(unsigned, f); return (u & 0x80000000u) ? ~u : (u | 0x80000000u); }


__device__ __forceinline__ int wave_sum_i(int v) {
    v += __builtin_amdgcn_update_dpp(0, v, 0xB1, 0xF, 0xF, true);
    v += __builtin_amdgcn_update_dpp(0, v, 0x4E, 0xF, 0xF, true);
    v += __builtin_amdgcn_update_dpp(0, v, 0x141, 0xF, 0xF, true);
    v += __builtin_amdgcn_update_dpp(0, v, 0x140, 0xF, 0xF, true);
    return __builtin_amdgcn_readlane(v, 0) + __builtin_amdgcn_readlane(v, 16) + __builtin_amdgcn_readlane(v, 32) + __builtin_amdgcn_readlane(v, 48);
}
__device__ __forceinline__ void transpose32(unsigned (&a)[32]) {
#define TSTAGE(S, MSK) _Pragma("unroll") for (int i = 0; i < 32; ++i) if (!(i & S)) { const unsigned x = a[i], y = a[i + S]; a[i] = (x & MSK) | ((y << S) & ~MSK); a[i + S] = ((x >> S) & MSK) | (y & ~MSK); }
    TSTAGE(16, 0x0000FFFFu) TSTAGE(8, 0x00FF00FFu) TSTAGE(4, 0x0F0F0F0Fu) TSTAGE(2, 0x33333333u) TSTAGE(1, 0x55555555u)
#undef TSTAGE
}
__device__ __forceinline__ void sel_step(unsigned T, unsigned& cand, unsigned& above, int& na, int& nc, bool& done, bool& exact) {
    const unsigned ones = cand & T; const int s1 = wave_sum_i(__builtin_popcount(ones));
    if (na + s1 >= 256) { cand = ones; nc = s1; }
    else { above |= ones; na += s1; cand &= ~T; nc -= s1; }
    if (na + nc == 256) { done = true; exact = true; }
}
__device__ __forceinline__ unsigned sel_finish(unsigned cand, unsigned above, int na, bool exact, int lane) {
    if (exact) return above | cand;
    const int need = 256 - na; const int pc = __builtin_popcount(cand); int incl = pc;
#pragma unroll
    for (int o = 1; o < 64; o <<= 1) { const int t = shup_i(incl, o, lane); if (lane >= o) incl += t; }
    int take = need - (incl - pc); take = take < 0 ? 0 : (take > pc ? pc : take);
    unsigned w = cand, res = above;
    for (int k = 0; k < take; ++k) { const unsigned low = w & (0u - w); res |= low; w ^= low; }
    return res;
}

__device__ __forceinline__ void p3_prep(Frame& F, const Args& A, int l, int rep) {
    const int gw = F.vcu * NWAVES + F.wave, NGW = F.G * NWAVES;
    bf16* PROJ = (bf16*)(F.ws + WS_PROJ);
    if (!(rep > 0 && PROBE_P3_PART == 2)) { const float* ga = inp<I_KNA>() + l * 64; const float* gc = inp<I_KNC>() + l * 32; const float* gd = inp<I_KND>() + l * 64;
      const int la = F.lane; const int ca = (4 * la) & 63, cc = (4 * la) & 31;
      const f32x4 gva = *(const f32x4*)(ga + ca), gvc = *(const f32x4*)(gc + cc), gvd = *(const f32x4*)(gd + ca);
      for (int mb = gw * 8; mb < gw * 8 + 8; mb += 8) {
        u32x2 ra[8], rc[8], rd[8];
#pragma unroll
        for (int i = 0; i < 8; ++i) { bf16* row = PROJ + (size_t)(mb + i) * NP; ra[i] = *(const u32x2*)(row + C_AK + 4 * la); rc[i] = *(const u32x2*)(row + C_CK + 4 * la);
            rd[i] = (u32x2){0u, 0u}; if (la < 16) rd[i] = *(const u32x2*)(row + C_DK + 4 * la); }
#pragma unroll
        for (int i = 0; i < 8; ++i) { bf16* row = PROJ + (size_t)(mb + i) * NP;
            { float x0 = bf2f(ra[i].x & 0xffff), x1 = bf2f(ra[i].x >> 16), x2 = bf2f(ra[i].y & 0xffff), x3 = bf2f(ra[i].y >> 16); float ss = (x0 * x0 + x1 * x1) + (x2 * x2 + x3 * x3);
              ss += shx<1>(ss); ss += shx<2>(ss); ss += shx<4>(ss); ss += shx<8>(ss); const float rs = 1.0f / sqrtf(ss * (1.f / 64.f) + RMS_EPS);
              u32x2 w; w.x = pk2(x0 * rs * gva[0], x1 * rs * gva[1]); w.y = pk2(x2 * rs * gva[2], x3 * rs * gva[3]); *(u32x2*)(row + C_AK + 4 * la) = w; }
            { float x0 = bf2f(rc[i].x & 0xffff), x1 = bf2f(rc[i].x >> 16), x2 = bf2f(rc[i].y & 0xffff), x3 = bf2f(rc[i].y >> 16); float ss = (x0 * x0 + x1 * x1) + (x2 * x2 + x3 * x3);
              ss += shx<1>(ss); ss += shx<2>(ss); ss += shx<4>(ss); const float rs = 1.0f / sqrtf(ss * (1.f / 32.f) + RMS_EPS);
              u32x2 w; w.x = pk2(x0 * rs * gvc[0], x1 * rs * gvc[1]); w.y = pk2(x2 * rs * gvc[2], x3 * rs * gvc[3]); *(u32x2*)(row + C_CK + 4 * la) = w; }
            { float x0 = bf2f(rd[i].x & 0xffff), x1 = bf2f(rd[i].x >> 16), x2 = bf2f(rd[i].y & 0xffff), x3 = bf2f(rd[i].y >> 16); float ss = (x0 * x0 + x1 * x1) + (x2 * x2 + x3 * x3);
              ss += shx<1>(ss); ss += shx<2>(ss); ss += shx<4>(ss); ss += shx<8>(ss); const float rs = 1.0f / sqrtf(ss * (1.f / 64.f) + RMS_EPS);
              u32x2 w; w.x = pk2(x0 * rs * gvd[0], x1 * rs * gvd[1]); w.y = pk2(x2 * rs * gvd[2], x3 * rs * gvd[3]); if (la < 16) *(u32x2*)(row + C_DK + 4 * la) = w; }
        }
      }
    }
    if (!(rep > 0 && PROBE_P3_PART == 2)) {
        const int bh = gw >> 6, ck = gw & 63, b = bh >> 2, h = bh & 3; const float bfv = inp<I_BF>()[l * 4 + h];
        const int t = 32 * ck + (F.lane & 31);
        const float x = bf2f(PROJ[((size_t)b * SEQ + t) * NP + C_AF + h]) + bfv;
        float incl = fminf(x, 0.f) - log1pf(__expf(-fabsf(x)));
#pragma unroll
        for (int o = 1; o < 32; o <<= 1) { const float u = shup(incl, o, F.lane); if ((F.lane & 31) >= o) incl += u; }
        float* cum = (float*)(F.ws + WS_CUM);
        if (F.lane < 32) cum[(size_t)bh * SEQ + t] = incl;
        if (F.lane == 31) cum[32 * SEQ + bh * 64 + ck] = incl;
    }
    LAS float* sc = (LAS float*)F.lds;
    unsigned* MASK = (unsigned*)(F.ws + WS_MASK);
    constexpr int SCP = 2052;
    const int lane = F.lane, kq = lane >> 4, qi = lane & 15;
    __syncthreads();
    bf16x8 bq[8], wvr, akv[16];
    const auto unit_geom = [&](int i, int& b, int& t0, int& nkt) { const int u = F.bx + 256 * i; b = u >> 7; const int tqr = u & 127, tq = (i & 1) ? 127 - tqr : tqr; t0 = tq * 16; nkt = tq + 1; };
    const auto unit_load_q = [&](int i) { int b, t0, nkt; unit_geom(i, b, t0, nkt); const bf16* qrow = PROJ + (size_t)b * SEQ * NP + (size_t)(t0 + qi) * NP;
#pragma unroll
        for (int h = 0; h < 8; ++h) bq[h] = *(const bf16x8*)(qrow + C_IQ + h * 32 + 8 * kq);
        wvr = *(const bf16x8*)(qrow + C_IW); };
    const auto unit_load_k = [&](int i) { int b, t0, nkt; unit_geom(i, b, t0, nkt); const bf16* pb = PROJ + (size_t)b * SEQ * NP;
#pragma unroll
        for (int j = 0; j < 16; ++j) { const int kt = F.wave + 8 * j; akv[j] = (bf16x8){0, 0, 0, 0, 0, 0, 0, 0}; if (kt < nkt) akv[j] = *(const bf16x8*)(pb + (size_t)(kt * 16 + qi) * NP + C_IK + 8 * kq); } };
    const bool do_c = !(rep > 0 && PROBE_P3_PART == 1);
    if (do_c) unit_load_q(0);
    for (int i = 0; i < 4; ++i) {
        if (!do_c) break;
        int b, t0, nkt; unit_geom(i, b, t0, nkt);
        unit_load_k(i);
        float wq[8];
#pragma unroll
        for (int h = 0; h < 8; ++h) wq[h] = bf2f((unsigned short)wvr[h]) * (0.35355339059327373f * 0.17677669529663687f);
#pragma unroll
        for (int j = 0; j < 16; ++j) { const int kt = F.wave + 8 * j;
            if (kt < nkt) {
            f32x4 a4 = (f32x4){0.f, 0.f, 0.f, 0.f};
#pragma unroll
            for (int h = 0; h < 8; ++h) { const f32x4 s = __builtin_amdgcn_mfma_f32_16x16x32_bf16(akv[j], bq[h], (f32x4){0.f, 0.f, 0.f, 0.f}, 0, 0, 0);
#pragma unroll
                for (int r = 0; r < 4; ++r) a4[r] += wq[h] * fmaxf(s[r], 0.f); }
#pragma unroll
            for (int r = 0; r < 4; ++r) a4[r] += 0.f;
            { const int ci = kt * 4 + kq, L = ci >> 3, c = ci & 7;
              *(LAS f32x4*)(sc + qi * SCP + 4 * (L * 8 + (c ^ (L & 7)))) = a4; }
            } }
        if (i + 1 < 4) unit_load_q(i + 1);
        LDS_WAIT(); __syncthreads();
        if (rep > 0 && PROBE_P3_PART == 2) { }
        else if (t0 < 256) {
            for (int rr = 0; rr < 2; ++rr) { const int t = t0 + 2 * F.wave + rr; const int nb = t - 32 * lane + 1;
                MASK[((size_t)b * SEQ + t) * 64 + lane] = nb >= 32 ? 0xffffffffu : (nb <= 0 ? 0u : ((1u << nb) - 1u)); }
        } else {
            const int rA = 2 * F.wave, tA = t0 + rA, tB = tA + 1;
            unsigned ua[32], ub[32];
#pragma unroll
            for (int c = 0; c < 8; ++c) { const int off = 4 * (lane * 8 + (c ^ (lane & 7)));
                const f32x4 fa = *(const LAS f32x4*)(sc + rA * SCP + off), fb = *(const LAS f32x4*)(sc + (rA + 1) * SCP + off);
#pragma unroll
                for (int i = 0; i < 4; ++i) { ua[c * 4 + i] = sortable(fa[i]); ub[c * 4 + i] = sortable(fb[i]); } }
            transpose32(ua); transpose32(ub);
            unsigned candA, candB, abA = 0u, abB = 0u; int naA = 0, naB = 0, ncA = tA + 1, ncB = tB + 1; bool dA = false, dB = false, eA = false, eB = false;
            { const int nbA = tA - 32 * lane + 1, nbB = tB - 32 * lane + 1;
              candA = nbA >= 32 ? 0xffffffffu : (nbA <= 0 ? 0u : ((1u << nbA) - 1u)); candB = nbB >= 32 ? 0xffffffffu : (nbB <= 0 ? 0u : ((1u << nbB) - 1u)); }
#pragma unroll
            for (int bit = 31; bit >= 0; --bit) {
                if (!dA) sel_step(ua[bit], candA, abA, naA, ncA, dA, eA);
                if (!dB) sel_step(ub[bit], candB, abB, naB, ncB, dB, eB);
                if (dA && dB) break;
            }
            MASK[((size_t)b * SEQ + tA) * 64 + lane] = sel_finish(candA, abA, naA, eA, lane);
            MASK[((size_t)b * SEQ + tB) * 64 + lane] = sel_finish(candB, abB, naB, eB, lane);
        }
        __syncthreads();
    }
}

namespace att {
template <bool B> struct BoolC { static constexpr bool value = B; };
constexpr int SLOTB = 8192, L_K = 0, L_V = 3 * SLOTB, L_WS = 6 * SLOTB, L_OST = L_WS + 2048, L_CUM = L_OST + 8 * 8192, L_END = L_CUM + 8192;
constexpr int MROW = 66;
static_assert(L_OST + 256 * MROW * 4 <= L_END && L_END <= RING_BYTES, "attention LDS map");
constexpr float THR = 8.0f;
__device__ __forceinline__ int crow(int r, int hi) { return (r & 3) + 8 * (r >> 2) + 4 * hi; }
__device__ __forceinline__ void glds16(const void* gsrc, unsigned lds_dst) { unsigned keep;
    asm volatile("s_mov_b32 %0, m0\n\ts_mov_b32 m0, %2\n\ts_nop 0\n\tglobal_load_lds_dwordx4 %1, off\n\ts_mov_b32 m0, %0" : "=&s"(keep) : "v"(gsrc), "s"(lds_dst) : "memory"); }
#define ATT_WAIT_BAR() asm volatile("s_waitcnt vmcnt(0) lgkmcnt(0)\n\ts_barrier" ::: "memory")
__device__ __forceinline__ unsigned cvtpk_s(float lo, float hi) { typedef __bf16 bf16x2_t __attribute__((ext_vector_type(2))); f32x2 v = {lo, hi}; bf16x2_t b = __builtin_convertvector(v, bf16x2_t); return __builtin_bit_cast(unsigned, b); }
__device__ __forceinline__ float xhalf(float x, int hi) { auto rr = __builtin_amdgcn_permlane32_swap(__builtin_bit_cast(unsigned, x), __builtin_bit_cast(unsigned, x), false, false);
    return __builtin_bit_cast(float, hi ? rr[0] : rr[1]); }
template <int DA, int DB>
__device__ __forceinline__ void qkt(f32x16& p0, f32x16& p1, const LAS char* Kslot, const bf16x8* qr, const f32x16& cin, int r32, int hi) {
    const LAS char* kb = Kslot + hi * 1024 + r32 * 16;
#pragma unroll
    for (int d0 = DA; d0 < DB; ++d0) {
        const bf16x8 b0 = *(const LAS bf16x8*)(kb + d0 * 2048), b1 = *(const LAS bf16x8*)(kb + d0 * 2048 + 512);
        if (d0 == DA) { p0 = __builtin_amdgcn_mfma_f32_32x32x16_bf16(b0, qr[d0], cin, 0, 0, 0); p1 = __builtin_amdgcn_mfma_f32_32x32x16_bf16(b1, qr[d0], cin, 0, 0, 0); }
        else { p0 = __builtin_amdgcn_mfma_f32_32x32x16_bf16(b0, qr[d0], p0, 0, 0, 0); p1 = __builtin_amdgcn_mfma_f32_32x32x16_bf16(b1, qr[d0], p1, 0, 0, 0); } }
}
__device__ __forceinline__ void pv(f32x16* o, int vb, bf16x8 pa0, bf16x8 pa1, bf16x8 pa2, bf16x8 pa3) {
    s16x4 lo[2][4], hi[2][4];
#pragma unroll
    for (int d0 = 0; d0 < 2; ++d0)
#pragma unroll
        for (int ks = 0; ks < 4; ++ks) {
            asm volatile("ds_read_b64_tr_b16 %0,%1 offset:%c2" : "=&v"(lo[d0][ks]) : "v"(vb), "i"(d0 * 4096 + ks * 1024) : "memory");
            asm volatile("ds_read_b64_tr_b16 %0,%1 offset:%c2" : "=&v"(hi[d0][ks]) : "v"(vb), "i"(d0 * 4096 + ks * 1024 + 512) : "memory"); }
    asm volatile("s_waitcnt lgkmcnt(0)" ::: "memory"); __builtin_amdgcn_sched_barrier(0);
#define PK(d, k) (bf16x8){lo[d][k][0], lo[d][k][1], lo[d][k][2], lo[d][k][3], hi[d][k][0], hi[d][k][1], hi[d][k][2], hi[d][k][3]}
    o[0] = __builtin_amdgcn_mfma_f32_32x32x16_bf16(pa0, PK(0, 0), o[0], 0, 0, 0); o[1] = __builtin_amdgcn_mfma_f32_32x32x16_bf16(pa0, PK(1, 0), o[1], 0, 0, 0);
    o[0] = __builtin_amdgcn_mfma_f32_32x32x16_bf16(pa1, PK(0, 1), o[0], 0, 0, 0); o[1] = __builtin_amdgcn_mfma_f32_32x32x16_bf16(pa1, PK(1, 1), o[1], 0, 0, 0);
    o[0] = __builtin_amdgcn_mfma_f32_32x32x16_bf16(pa2, PK(0, 2), o[0], 0, 0, 0); o[1] = __builtin_amdgcn_mfma_f32_32x32x16_bf16(pa2, PK(1, 2), o[1], 0, 0, 0);
    o[0] = __builtin_amdgcn_mfma_f32_32x32x16_bf16(pa3, PK(0, 3), o[0], 0, 0, 0); o[1] = __builtin_amdgcn_mfma_f32_32x32x16_bf16(pa3, PK(1, 3), o[1], 0, 0, 0);
#undef PK
}
__device__ __forceinline__ float rowmax(const f32x16& p0, const f32x16& p1, int hi) {
    float a = fmaxf(fmaxf(p0[0], p0[1]), p1[0]), b = fmaxf(fmaxf(p0[2], p0[3]), p1[1]); a = fmaxf(fmaxf(a, p1[2]), p1[3]);
#pragma unroll
    for (int r = 4; r < 16; r += 4) { a = fmaxf(fmaxf(a, p0[r]), p0[r + 1]); b = fmaxf(fmaxf(b, p0[r + 2]), p0[r + 3]); a = fmaxf(fmaxf(a, p1[r]), p1[r + 1]); b = fmaxf(fmaxf(b, p1[r + 2]), p1[r + 3]); }
    const float m = fmaxf(a, b); return fmaxf(m, xhalf(m, hi));
}
struct AttnP { const bf16* proj; bf16* mix; const float* cum; const unsigned* mask; const float* qgain[4]; const float* kgain[4]; float lam; };

template <int VAR>
__device__ __forceinline__ void attn_unit(const AttnP& P, int b, int h, int qb, LAS char* sh, const int tid_in, const int pm, unsigned* qctr, volatile LAS unsigned* qslot) {
    int tid = tid_in; asm volatile("" : "+v"(tid));
    const int lane = tid & 63, r32 = lane & 31, hi = lane >> 5; const int wid = __builtin_amdgcn_readfirstlane(tid >> 6);
    const long rowbase = (long)b * SEQ; const int q0 = qb * 256, NT = 4 * (qb + 1);
    const int qrel = wid * 32 + r32, tq = q0 + qrel;
    constexpr bool REV = VAR != 0;
    constexpr int QCB = VAR == 0 ? C_AQ : VAR == 1 ? C_BQ : VAR == 2 ? C_CQ : C_DQ;
    constexpr int KCB = VAR == 0 ? C_AK : VAR == 1 ? C_BK : VAR == 2 ? C_CK : C_DK;
    constexpr int VCB = VAR == 0 ? C_AV : VAR == 1 ? C_BV : VAR == 2 ? C_CV : C_DV;
    const int Qc = QCB + 64 * h, Kc = VAR == 3 ? KCB : KCB + 64 * h, Vc = VAR == 3 ? VCB : VCB + 64 * h;
    const bf16* PR = P.proj;
    LAS float* wsf = (LAS float*)(sh + L_WS) + wid * 64;
    LAS float* stg = (LAS float*)(sh + L_OST) + wid * 2048;
    LAS float* cumL = (LAS float*)(sh + L_CUM);
    LAS unsigned* maskL = (LAS unsigned*)(sh + L_OST);
    const unsigned lds0 = (unsigned)(uintptr_t)sh;
    const bf16* ksrc = PR + (size_t)(rowbase + lane) * NP + Kc + wid * 8;
    const bf16* vsrc = PR + (size_t)(rowbase + 16 * (wid & 3) + (lane >> 2)) * NP + Vc + (wid >> 2) * 32 + (lane & 3) * 8;
    const unsigned kdst = lds0 + L_K + wid * 1024, vdst = lds0 + L_V + wid * 1024;
#define DMA_KV(t, slot) do { glds16(ksrc + (size_t)(t) * 64 * NP, (unsigned)__builtin_amdgcn_readfirstlane(kdst + (slot))); glds16(vsrc + (size_t)(t) * 64 * NP, (unsigned)__builtin_amdgcn_readfirstlane(vdst + (slot))); } while (0)
    DMA_KV(REV ? NT - 1 : 0, 0); DMA_KV(REV ? NT - 2 : 1, SLOTB);
    constexpr int NDQ = VAR == 2 ? 2 : 4; bf16x8 qpre[NDQ];
    { const bf16* Qw0 = PR + (size_t)(rowbase + tq) * NP + Qc;
#pragma unroll
      for (int d0 = 0; d0 < NDQ; ++d0) qpre[d0] = *(const bf16x8*)(Qw0 + d0 * 16 + hi * 8); }
    if (VAR == 0) {
        LAS float* pref = (LAS float*)(sh + L_WS);
        const float* cg = P.cum + (size_t)(b * 4 + h) * SEQ; float cgv[4];
#pragma unroll
        for (int k = 0; k < 4; ++k) { const int i = tid + 512 * k; cgv[k] = i < q0 + 256 ? cg[i] : 0.f; }
        if (tid < 64) { const float ct = P.cum[32 * SEQ + (b * 4 + h) * 64 + tid]; float incl = ct;
#pragma unroll
            for (int o = 1; o < 64; o <<= 1) { const float u = shup(incl, o, tid); if (tid >= o) incl += u; }
            pref[tid] = incl - ct; }
        asm volatile("s_waitcnt lgkmcnt(0)\n\ts_barrier" ::: "memory");
#pragma unroll
        for (int k = 0; k < 4; ++k) { const int i = tid + 512 * k; if (i < q0 + 256) cumL[i] = (cgv[k] + pref[i >> 5]) * LOG2E; }
        asm volatile("s_waitcnt lgkmcnt(0)\n\ts_barrier" ::: "memory");
    }
    if (VAR == 3) { const unsigned* mg = P.mask + (size_t)(rowbase + q0) * 64; const int nw = 2 * NT;
#pragma unroll 16
        for (int i = tid; i < 256 * 32; i += 512) { const int row = i >> 5, w = 2 * (i & 31); if (w < nw) *(LAS u32x2*)(maskL + row * MROW + w) = *(const u32x2*)(mg + row * 64 + w); } }
    asm volatile("s_waitcnt vmcnt(0) lgkmcnt(0)\n\ts_barrier" ::: "memory");
    const int vb0 = (int)(lds0 + L_V) + ((lane >> 4) & 1) * 32 + (lane & 3) * 8 + (4 * hi + ((lane & 15) >> 2)) * 64;
    float slope2 = 0.f;
    if (VAR == 2) slope2 = __builtin_amdgcn_exp2f(-(float)(2 * h + 1)) * LOG2E;
    if (VAR == 3) slope2 = __builtin_amdgcn_exp2f(-(float)(2 * h + 2)) * LOG2E;
    float cumt = 0.f; if (VAR == 0) cumt = cumL[tq];
    constexpr int NPASS = VAR == 2 ? 2 : 1;
    unsigned nxt_u = 0u;
    for (int pass = 0; pass < NPASS; ++pass) {
        bf16x8 qa[4]; float sb0 = 0.f;
        { const bf16* Qw = PR + (size_t)(rowbase + tq) * NP + Qc;
          constexpr int ND0 = VAR == 2 ? 2 : 4; const int dbase = VAR == 2 ? 2 * pass : 0;
          float qf[8 * ND0];
#pragma unroll
          for (int d0 = 0; d0 < ND0; ++d0) { bf16x8 raw = qpre[d0]; if (pass > 0) raw = *(const bf16x8*)(Qw + (dbase + d0) * 16 + hi * 8);
#pragma unroll
              for (int j = 0; j < 8; ++j) qf[d0 * 8 + j] = bf2f((unsigned short)raw[j]); }
          constexpr float SC = (VAR == 2 ? 0.17677669529663687f : 0.125f) * LOG2E;
          if (VAR != 1) {
              float ss = 0.f;
#pragma unroll
              for (int i = 0; i < 8 * ND0; ++i) ss += qf[i] * qf[i];
              ss += xhalf(ss, hi); const float rstd = 1.0f / sqrtf(ss * (VAR == 2 ? 1.f / 32.f : 1.f / 64.f) + RMS_EPS);
              const float* g = P.qgain[VAR];
#pragma unroll
              for (int d0 = 0; d0 < ND0; ++d0)
#pragma unroll
                  for (int j = 0; j < 8; ++j) qf[d0 * 8 + j] *= rstd * g[16 * d0 + 8 * hi + j] * SC;
          } else {
#pragma unroll
              for (int i = 0; i < 8 * ND0; ++i) qf[i] *= SC;
          }
          if (VAR == 2 || VAR == 3) {
              float n0 = 0.f;
#pragma unroll
              for (int i = 0; i < 8 * ND0; ++i) n0 += qf[i] * qf[i];
              n0 += xhalf(n0, hi);
              float gk = fabsf(P.kgain[VAR][lane & (VAR == 2 ? 31 : 63)]);
              gk = fmaxf(gk, shx<1>(gk)); gk = fmaxf(gk, shx<2>(gk)); gk = fmaxf(gk, shx<4>(gk)); gk = fmaxf(gk, shx<8>(gk)); gk = fmaxf(gk, shx<16>(gk)); gk = half_max(gk);
              sb0 = 1.02f * sqrtf(n0) * (VAR == 2 ? 5.656854249f : 8.0f) * gk;
          }
#pragma unroll
          for (int d0 = 0; d0 < ND0; ++d0) { u32x4 w; w.x = cvtpk_s(qf[d0 * 8 + 0], qf[d0 * 8 + 1]); w.y = cvtpk_s(qf[d0 * 8 + 2], qf[d0 * 8 + 3]); w.z = cvtpk_s(qf[d0 * 8 + 4], qf[d0 * 8 + 5]); w.w = cvtpk_s(qf[d0 * 8 + 6], qf[d0 * 8 + 7]);
              qa[d0] = __builtin_bit_cast(bf16x8, w); }
          if (VAR == 2) { qa[2] = qa[0]; qa[3] = qa[1]; }
        }
        float mhat = -1e30f, l_reg = 0.f, Rp = 1.f; f32x16 o[2]; const float sbound = sb0;
#pragma unroll
        for (int r = 0; r < 16; ++r) { o[0][r] = 0.f; o[1][r] = 0.f; }
        if (pass > 0) { DMA_KV(REV ? NT - 1 : 0, 0); DMA_KV(REV ? NT - 2 : 1, SLOTB); }
        int cur = 0, sl1 = SLOTB, sl2 = 2 * SLOTB;
        auto step = [&](auto band_c, const int it) -> bool {
            constexpr bool BAND = decltype(band_c)::value;
            const int t = REV ? NT - 1 - it : it;
            if (pm == 7) { }
            else if (it + 1 < NT) asm volatile("s_waitcnt vmcnt(2) lgkmcnt(0)\n\ts_barrier" ::: "memory");
            else ATT_WAIT_BAR();
            if (REV && it > 0) {
                const LAS unsigned* wz = (const LAS unsigned*)(sh + L_END) + ((it - 1) & 1) * 8;
                const u32x4 z0 = *(const LAS u32x4*)wz, z1 = *(const LAS u32x4*)(wz + 4);
                if (__builtin_amdgcn_readfirstlane((int)(z0.x & z0.y & z0.z & z0.w & z1.x & z1.y & z1.z & z1.w)) != 0) return true;
            }
            if (it + 2 < NT && pm != 7) DMA_KV(REV ? t - 2 : t + 2, sl2);
            const int jb = t - (NT - 4);
            float cinv = 0.f;
            if (VAR == 0) cinv = cumt;
            if (VAR == 2 || VAR == 3) cinv = slope2 * (float)(t * 64 + 4 * hi - tq);
            f32x16 cin;
#pragma unroll
            for (int r = 0; r < 16; ++r) cin[r] = cinv;
            f32x16 p0, p1;
            const LAS char* Ks = sh + L_K + cur;
            if (VAR == 2) { if (pass == 0) { const bf16x8 qq[4] = {qa[0], qa[1], qa[0], qa[1]}; qkt<0, 2>(p0, p1, Ks, qq, cin, r32, hi); }
                            else { const bf16x8 qq[4] = {qa[0], qa[1], qa[0], qa[1]}; qkt<2, 4>(p0, p1, Ks, qq, cin, r32, hi); } }
            else qkt<0, 4>(p0, p1, Ks, qa, cin, r32, hi);
            if (VAR != 1) {
                if (VAR == 0) { const LAS float* cp = cumL + t * 64 + 4 * hi;
#pragma unroll
                    for (int g = 0; g < 4; ++g) { const f32x4 c0 = *(const LAS f32x4*)(cp + 8 * g), c1 = *(const LAS f32x4*)(cp + 32 + 8 * g);
#pragma unroll
                        for (int i = 0; i < 4; ++i) { p0[4 * g + i] -= c0[i]; p1[4 * g + i] -= c1[i]; } } }
                if (VAR == 2 || VAR == 3) {
#pragma unroll
                    for (int r = 0; r < 16; ++r) { const float kc = (float)((r & 3) + 8 * (r >> 2)); p0[r] += slope2 * kc; p1[r] += slope2 * (kc + 32.f); } }
                if (VAR != 3) { if constexpr (BAND) { const int kb = 64 * jb + 4 * hi;
#pragma unroll
                    for (int r = 0; r < 16; ++r) { const int kv = kb + (r & 3) + 8 * (r >> 2); if (kv > qrel) p0[r] = -INFINITY; if (kv + 32 > qrel) p1[r] = -INFINITY; } } }
                else { const u32x2 mw = *(const LAS u32x2*)(maskL + qrel * MROW + 2 * t); const unsigned w0 = mw.x >> (4 * hi), w1 = mw.y >> (4 * hi);
#pragma unroll
                    for (int r = 0; r < 16; ++r) { const int c = (r & 3) + 8 * (r >> 2); if (!((w0 >> c) & 1u)) p0[r] = -INFINITY; if (!((w1 >> c) & 1u)) p1[r] = -INFINITY; } }
                const float rm = rowmax(p0, p1, hi);
                if (__any(rm - mhat > THR)) {
                    const float mn = fmaxf(mhat, rm); const float f = __builtin_amdgcn_exp2f(mhat - mn); mhat = mn; l_reg *= f;
                    if (hi == 0) wsf[r32] = f;
#pragma unroll
                    for (int r = 0; r < 16; ++r) { const float fr = wsf[crow(r, hi)]; o[0][r] *= fr; o[1][r] *= fr; }
                }
                float sa4[4] = {0.f, 0.f, 0.f, 0.f};
#pragma unroll
                for (int r = 0; r < 16; ++r) { p0[r] = __builtin_amdgcn_exp2f(p0[r] - mhat); p1[r] = __builtin_amdgcn_exp2f(p1[r] - mhat); sa4[r & 3] += p0[r] + p1[r]; }
                l_reg += (sa4[0] + sa4[1]) + (sa4[2] + sa4[3]);
                if (VAR == 2 || VAR == 3) {
                    const float ub = sbound - slope2 * (float)(tq - 64 * t + 1) - mhat;
                    const bool dead = __all(ub < -150.f); if (lane == 0) ((LAS unsigned*)(sh + L_END))[(it & 1) * 8 + wid] = dead ? 1u : 0u;
                }
            } else {
                f32x16 m0, m1;
#pragma unroll
                for (int r = 0; r < 16; ++r) {
                    { const float s = __builtin_amdgcn_fmed3f(p0[r], -64.f, 64.f); const float e = __builtin_amdgcn_exp2f(-s); const float bt = __builtin_amdgcn_rcpf(1.f + e); p0[r] = bt; m0[r] = e * bt; }
                    { const float s = __builtin_amdgcn_fmed3f(p1[r], -64.f, 64.f); const float e = __builtin_amdgcn_exp2f(-s); const float bt = __builtin_amdgcn_rcpf(1.f + e); p1[r] = bt; m1[r] = e * bt; } }
                if constexpr (BAND) { const int kb = 64 * jb + 4 * hi;
#pragma unroll
                    for (int r = 0; r < 16; ++r) { const int kv = kb + (r & 3) + 8 * (r >> 2);
                        if (kv >= qrel) { p0[r] = 0.f; m0[r] = 1.f; } if (kv + 32 >= qrel) { p1[r] = 0.f; m1[r] = 1.f; } } }
                float gp[8], gq[8], ex[8];
#pragma unroll
                for (int g = 0; g < 4; ++g) { gp[g] = (m0[4 * g] * m0[4 * g + 1]) * (m0[4 * g + 2] * m0[4 * g + 3]); gp[4 + g] = (m1[4 * g] * m1[4 * g + 1]) * (m1[4 * g + 2] * m1[4 * g + 3]); }
#pragma unroll
                for (int g = 0; g < 8; ++g) gq[g] = xhalf(gp[g], hi);
                float sp = Rp;
#pragma unroll
                for (int g = 7; g >= 0; --g) { ex[g] = hi ? sp : sp * gq[g]; sp *= gp[g] * gq[g]; }
                Rp = sp;
                { const bool allz = !__any(Rp != 0.f); if (lane == 0) ((LAS unsigned*)(sh + L_END))[(it & 1) * 8 + wid] = allz ? 1u : 0u; }
#pragma unroll
                for (int g = 0; g < 4; ++g) {
                    { float c = ex[g]; const float w3 = p0[4 * g + 3] * c; c *= m0[4 * g + 3]; const float w2 = p0[4 * g + 2] * c; c *= m0[4 * g + 2]; const float w1 = p0[4 * g + 1] * c; c *= m0[4 * g + 1]; const float w0 = p0[4 * g] * c;
                      p0[4 * g] = w0; p0[4 * g + 1] = w1; p0[4 * g + 2] = w2; p0[4 * g + 3] = w3; }
                    { float c = ex[4 + g]; const float w3 = p1[4 * g + 3] * c; c *= m1[4 * g + 3]; const float w2 = p1[4 * g + 2] * c; c *= m1[4 * g + 2]; const float w1 = p1[4 * g + 1] * c; c *= m1[4 * g + 1]; const float w0 = p1[4 * g] * c;
                      p1[4 * g] = w0; p1[4 * g + 1] = w1; p1[4 * g + 2] = w2; p1[4 * g + 3] = w3; } }
            }
            u32x4 pw0, pw1, pw2, pw3;
            pw0 = (u32x4){cvtpk_s(p0[0], p0[1]), cvtpk_s(p0[2], p0[3]), cvtpk_s(p0[4], p0[5]), cvtpk_s(p0[6], p0[7])};
            pw1 = (u32x4){cvtpk_s(p0[8], p0[9]), cvtpk_s(p0[10], p0[11]), cvtpk_s(p0[12], p0[13]), cvtpk_s(p0[14], p0[15])};
            pw2 = (u32x4){cvtpk_s(p1[0], p1[1]), cvtpk_s(p1[2], p1[3]), cvtpk_s(p1[4], p1[5]), cvtpk_s(p1[6], p1[7])};
            pw3 = (u32x4){cvtpk_s(p1[8], p1[9]), cvtpk_s(p1[10], p1[11]), cvtpk_s(p1[12], p1[13]), cvtpk_s(p1[14], p1[15])};
            pv(o, vb0 + cur, __builtin_bit_cast(bf16x8, pw0), __builtin_bit_cast(bf16x8, pw1), __builtin_bit_cast(bf16x8, pw2), __builtin_bit_cast(bf16x8, pw3));
            { const int tmp = cur; cur = sl1; sl1 = sl2; sl2 = tmp; }
            return false;
        };
        if (REV) { bool ex = false; int it = 0;
            for (; it < 4 && !ex; ++it) ex = step(BoolC<true>{}, it);
            for (; it < NT && !ex; ++it) ex = step(BoolC<false>{}, it); }
        else { int it = 0;
            for (; it < NT - 4; ++it) (void)step(BoolC<false>{}, it);
            for (; it < NT; ++it) (void)step(BoolC<true>{}, it); }
        ATT_WAIT_BAR();
        if (pass == NPASS - 1 && tid == 0) nxt_u = __builtin_amdgcn_atomic_inc32(qctr, 0xFFFFFFFFu, __ATOMIC_RELAXED, "agent");
        float rli[16];
        if (VAR != 1) {
            l_reg += xhalf(l_reg, hi);
            if (hi == 0) wsf[32 + r32] = l_reg;
#pragma unroll
            for (int r = 0; r < 16; ++r) rli[r] = __builtin_amdgcn_rcpf(wsf[32 + crow(r, hi)]);
        } else {
#pragma unroll
            for (int r = 0; r < 16; ++r) rli[r] = 1.f;
        }
#pragma unroll
        for (int r = 0; r < 16; ++r) { const int orow = crow(r, hi);
#pragma unroll
            for (int d0 = 0; d0 < 2; ++d0) { const float val = o[d0][r] * rli[r]; LAS float* sp = stg + orow * 64 + d0 * 32 + r32;
                if (VAR == 2 && pass == 1) *sp = *sp - P.lam * val; else *sp = val; } }
    }
    LDS_WAIT();
    bf16* Ow = P.mix + (size_t)(rowbase + q0 + wid * 32) * DM + VAR * 256 + h * 64;
#pragma unroll
    for (int i = 0; i < 4; ++i) { const int row = i * 8 + (lane >> 3), ch = lane & 7;
        const f32x4 a = *(const LAS f32x4*)(stg + row * 64 + ch * 8), c = *(const LAS f32x4*)(stg + row * 64 + ch * 8 + 4);
        float sc = 1.f;
        if (VAR == 2) { float ss = (a[0] * a[0] + a[1] * a[1]) + (a[2] * a[2] + a[3] * a[3]) + (c[0] * c[0] + c[1] * c[1]) + (c[2] * c[2] + c[3] * c[3]);
            ss += shx<1>(ss); ss += shx<2>(ss); ss += shx<4>(ss); sc = 1.0f / sqrtf(ss * (1.f / 64.f) + RMS_EPS); }
        u32x4 w; w.x = cvtpk_s(a[0] * sc, a[1] * sc); w.y = cvtpk_s(a[2] * sc, a[3] * sc); w.z = cvtpk_s(c[0] * sc, c[1] * sc); w.w = cvtpk_s(c[2] * sc, c[3] * sc);
        if (pm == 0 || (w.x == 0x12345678u && w.y == 0x9abcdef0u)) *(u32x4*)(Ow + (size_t)row * DM + ch * 8) = w; }
    if (tid == 0) *qslot = nxt_u;
    asm volatile("s_waitcnt lgkmcnt(0)\n\ts_barrier" ::: "memory");
#undef DMA_KV
}
typedef __attribute__((address_space(3))) const char* lds_cptr;
typedef short v4i16_t __attribute__((ext_vector_type(4)));
__device__ __forceinline__ s16x4 vtr(lds_cptr p) { return __builtin_bit_cast(s16x4, __builtin_amdgcn_ds_read_tr16_b64_v4i16((__attribute__((address_space(3))) v4i16_t*)p)); }
template <int VAR>
__device__ __forceinline__ void attn_unit2(const AttnP& P, int b, int h, int qb, LAS char* sh, const int tid_in, unsigned* qctr, volatile LAS unsigned* qslot) {
    static_assert(VAR == 0 || VAR == 2 || VAR == 3, "softmax mixers only");
    int tid = tid_in; asm volatile("" : "+v"(tid));
    const int lane = tid & 63, r32 = lane & 31, hi = lane >> 5; const int wid = __builtin_amdgcn_readfirstlane(tid >> 6);
    const long rowbase = (long)b * SEQ; const int q0 = qb * 256, NT = 4 * (qb + 1);
    const int qrel = wid * 32 + r32, tq = q0 + qrel;
    constexpr int QCB = VAR == 0 ? C_AQ : VAR == 1 ? C_BQ : VAR == 2 ? C_CQ : C_DQ;
    constexpr int KCB = VAR == 0 ? C_AK : VAR == 1 ? C_BK : VAR == 2 ? C_CK : C_DK;
    constexpr int VCB = VAR == 0 ? C_AV : VAR == 1 ? C_BV : VAR == 2 ? C_CV : C_DV;
    const int Qc = QCB + 64 * h, Kc = VAR == 3 ? KCB : KCB + 64 * h, Vc = VAR == 3 ? VCB : VCB + 64 * h;
    const bf16* PR = P.proj;
    LAS float* wsf = (LAS float*)(sh + L_WS) + wid * 64;
    LAS float* stg = (LAS float*)(sh + L_OST) + wid * 2048;
    LAS float* cumL = (LAS float*)(sh + L_CUM);
    LAS unsigned* maskL = (LAS unsigned*)(sh + L_OST);
    const unsigned lds0 = (unsigned)(uintptr_t)sh;
    const bf16* ksrc = PR + (size_t)(rowbase + lane) * NP + Kc + wid * 8;
    const bf16* vsrc = PR + (size_t)(rowbase + 16 * (wid & 3) + (lane >> 2)) * NP + Vc + (wid >> 2) * 32 + (lane & 3) * 8;
    const unsigned kdst = lds0 + L_K + wid * 1024, vdst = lds0 + L_V + wid * 1024;
#define TILE2(j) (NT - 1 - (j))
#define DMA_K2(j, slot) glds16(ksrc + (size_t)TILE2(j) * 64 * NP, (unsigned)__builtin_amdgcn_readfirstlane(kdst + (slot)))
#define DMA_V2(j, slot) glds16(vsrc + (size_t)TILE2(j) * 64 * NP, (unsigned)__builtin_amdgcn_readfirstlane(vdst + (slot)))
    DMA_K2(0, 0); DMA_K2(1, SLOTB); DMA_V2(0, 0);
    constexpr int NDQ = VAR == 2 ? 2 : 4; bf16x8 qpre[NDQ];
    { const bf16* Qw0 = PR + (size_t)(rowbase + tq) * NP + Qc;
#pragma unroll
      for (int d0 = 0; d0 < NDQ; ++d0) qpre[d0] = *(const bf16x8*)(Qw0 + d0 * 16 + hi * 8); }
    if (VAR == 0) {
        LAS float* pref = (LAS float*)(sh + L_WS);
        const float* cg = P.cum + (size_t)(b * 4 + h) * SEQ; float cgv[4];
#pragma unroll
        for (int k = 0; k < 4; ++k) { const int i = tid + 512 * k; cgv[k] = i < q0 + 256 ? cg[i] : 0.f; }
        if (tid < 64) { const float ct = P.cum[32 * SEQ + (b * 4 + h) * 64 + tid]; float incl = ct;
#pragma unroll
            for (int o = 1; o < 64; o <<= 1) { const float u = shup(incl, o, tid); if (tid >= o) incl += u; }
            pref[tid] = incl - ct; }
        asm volatile("s_waitcnt lgkmcnt(0)\n\ts_barrier" ::: "memory");
#pragma unroll
        for (int k = 0; k < 4; ++k) { const int i = tid + 512 * k; if (i < q0 + 256) cumL[i] = (cgv[k] + pref[i >> 5]) * LOG2E; }
        asm volatile("s_waitcnt lgkmcnt(0)\n\ts_barrier" ::: "memory");
    }
    if (VAR == 3) { const unsigned* mg = P.mask + (size_t)(rowbase + q0) * 64; const int nw = 2 * NT;
#pragma unroll 16
        for (int i = tid; i < 256 * 32; i += 512) { const int row = i >> 5, w = 2 * (i & 31); if (w < nw) *(LAS u32x2*)(maskL + row * MROW + w) = *(const u32x2*)(mg + row * 64 + w); } }
    asm volatile("s_waitcnt vmcnt(0) lgkmcnt(0)\n\ts_barrier" ::: "memory");
    const lds_cptr shc = (lds_cptr)sh;
    const lds_cptr kp0 = shc + L_K + hi * 1024 + r32 * 16;
    const lds_cptr vp0 = shc + L_V + ((lane >> 4) & 1) * 32 + (lane & 3) * 8 + (4 * hi + ((lane & 15) >> 2)) * 64;
    float slope2 = 0.f;
    if (VAR == 2) slope2 = __builtin_amdgcn_exp2f(-(float)(2 * h + 1)) * LOG2E;
    if (VAR == 3) slope2 = __builtin_amdgcn_exp2f(-(float)(2 * h + 2)) * LOG2E;
    float cumt = 0.f; if (VAR == 0) cumt = cumL[tq];
    constexpr int NPASS = VAR == 2 ? 2 : 1;
    unsigned nxt_u = 0u;
    const auto slot3 = [](int j) { return (j % 3) * SLOTB; };
#define SB2() __builtin_amdgcn_sched_barrier(0)
#define PINV(x) asm volatile("" : "+v"(x))
#define MF32(a, b, c) __builtin_amdgcn_mfma_f32_32x32x16_bf16(a, b, c, 0, 0, 0)
#define ATT_BARN(N) do { asm volatile("s_waitcnt vmcnt(" #N ") lgkmcnt(0)\n\ts_barrier" ::: "memory"); SB2(); } while (0)
#define PKW(Pv, i) cvtpk_s(Pv[i], Pv[(i) + 1])
#define PAF(k) __builtin_bit_cast(bf16x8, pw##k)
#define VFR(i) (bf16x8){vlo[i][0], vlo[i][1], vlo[i][2], vlo[i][3], vhi[i][0], vhi[i][1], vhi[i][2], vhi[i][3]}
#define VRD(i) do { vlo[i] = vtr(vp_ + (((i) >> 2) * 4096 + ((i) & 3) * 1024)); vhi[i] = vtr(vp_ + (((i) >> 2) * 4096 + ((i) & 3) * 1024 + 512)); } while (0)
#define EX2(v) __builtin_amdgcn_exp2f(v)
#define GAPA(MF, Pv, i, PW, w) do { MF; sacc += Pv[i]; sacc += Pv[(i) + 1]; sacc += Pv[(i) + 2]; sacc += Pv[(i) + 3]; PINV(sacc); PW[w] = PKW(Pv, i); PW[(w) + 1] = PKW(Pv, (i) + 2); PINV(PW); SB2(); } while (0)
#define GAPA8(MF, Pv, i, PW) do { MF; sacc += Pv[i]; sacc += Pv[(i) + 1]; sacc += Pv[(i) + 2]; sacc += Pv[(i) + 3]; sacc += Pv[(i) + 4]; sacc += Pv[(i) + 5]; sacc += Pv[(i) + 6]; sacc += Pv[(i) + 7]; PINV(sacc); \
        PW[0] = PKW(Pv, i); PW[1] = PKW(Pv, (i) + 2); PW[2] = PKW(Pv, (i) + 4); PW[3] = PKW(Pv, (i) + 6); PINV(PW); SB2(); } while (0)
#define GAPB(MF, X, i) do { MF; X[i] = EX2(X[i]); X[(i) + 1] = EX2(X[(i) + 1]); X[(i) + 2] = EX2(X[(i) + 2]); X[(i) + 3] = EX2(X[(i) + 3]); PINV(X); SB2(); } while (0)
    for (int pass = 0; pass < NPASS; ++pass) {
        bf16x8 qa[4]; float sb0 = 0.f;
        { const bf16* Qw = PR + (size_t)(rowbase + tq) * NP + Qc;
          constexpr int ND0 = VAR == 2 ? 2 : 4; const int dbase = VAR == 2 ? 2 * pass : 0;
          float qf[8 * ND0];
#pragma unroll
          for (int d0 = 0; d0 < ND0; ++d0) { bf16x8 raw = qpre[d0]; if (pass > 0) raw = *(const bf16x8*)(Qw + (dbase + d0) * 16 + hi * 8);
#pragma unroll
              for (int j = 0; j < 8; ++j) qf[d0 * 8 + j] = bf2f((unsigned short)raw[j]); }
          constexpr float SC = (VAR == 2 ? 0.17677669529663687f : 0.125f) * LOG2E;
          if (VAR != 1) {
              float ss = 0.f;
#pragma unroll
              for (int i = 0; i < 8 * ND0; ++i) ss += qf[i] * qf[i];
              ss += xhalf(ss, hi); const float rstd = 1.0f / sqrtf(ss * (VAR == 2 ? 1.f / 32.f : 1.f / 64.f) + RMS_EPS);
              const float* g = P.qgain[VAR];
#pragma unroll
              for (int d0 = 0; d0 < ND0; ++d0)
#pragma unroll
                  for (int j = 0; j < 8; ++j) qf[d0 * 8 + j] *= rstd * g[16 * d0 + 8 * hi + j] * SC;
          } else {
#pragma unroll
              for (int i = 0; i < 8 * ND0; ++i) qf[i] *= SC;
          }
          if (VAR == 2 || VAR == 3) {
              float n0 = 0.f;
#pragma unroll
              for (int i = 0; i < 8 * ND0; ++i) n0 += qf[i] * qf[i];
              n0 += xhalf(n0, hi);
              float gk = fabsf(P.kgain[VAR][lane & (VAR == 2 ? 31 : 63)]);
              gk = fmaxf(gk, shx<1>(gk)); gk = fmaxf(gk, shx<2>(gk)); gk = fmaxf(gk, shx<4>(gk)); gk = fmaxf(gk, shx<8>(gk)); gk = fmaxf(gk, shx<16>(gk)); gk = half_max(gk);
              sb0 = 1.02f * sqrtf(n0) * (VAR == 2 ? 5.656854249f : 8.0f) * gk;
          }
#pragma unroll
          for (int d0 = 0; d0 < ND0; ++d0) { u32x4 w; w.x = cvtpk_s(qf[d0 * 8 + 0], qf[d0 * 8 + 1]); w.y = cvtpk_s(qf[d0 * 8 + 2], qf[d0 * 8 + 3]); w.z = cvtpk_s(qf[d0 * 8 + 4], qf[d0 * 8 + 5]); w.w = cvtpk_s(qf[d0 * 8 + 6], qf[d0 * 8 + 7]);
              qa[d0] = __builtin_bit_cast(bf16x8, w); }
          if (VAR == 2) { qa[2] = qa[0]; qa[3] = qa[1]; }
        }
        const float sbound = sb0;
        if (pass > 0) { DMA_K2(0, 0); DMA_K2(1, SLOTB); DMA_V2(0, 0); }
        float mhat = 0.f, l_reg = 0.f; bool hasref = false, resc = false; f32x16 o[2], negm;
#pragma unroll
        for (int r = 0; r < 16; ++r) { o[0][r] = 0.f; o[1][r] = 0.f; }
        f32x16 pA0, pA1, pB0, pB1; u32x4 pw0, pw1, pw2, pw3;
#pragma unroll
        for (int r = 0; r < 16; ++r) { pB0[r] = 0.f; pB1[r] = 0.f; }
        const auto setneg = [&](int t) __attribute__((always_inline)) { float v = -mhat; if (VAR == 0) v += cumt; else v += slope2 * (float)(t * 64 + 4 * hi - tq);
#pragma unroll
            for (int r = 0; r < 16; ++r) negm[r] = v;
            PINV(negm); };
        const auto mid = [&](f32x16& C0, f32x16& C1, const int it) __attribute__((always_inline)) {
            const int t = NT - 1 - it;
            if (VAR == 0) { const LAS float* cp = cumL + t * 64 + 4 * hi;
#pragma unroll
                for (int g = 0; g < 4; ++g) { const f32x4 c0 = *(const LAS f32x4*)(cp + 8 * g), c1 = *(const LAS f32x4*)(cp + 32 + 8 * g);
#pragma unroll
                    for (int i = 0; i < 4; ++i) { C0[4 * g + i] -= c0[i]; C1[4 * g + i] -= c1[i]; } } }
            else {
#pragma unroll
                for (int r = 0; r < 16; ++r) { const float kc = (float)((r & 3) + 8 * (r >> 2)); C0[r] += slope2 * kc; C1[r] += slope2 * (kc + 32.f); } }
            if (VAR != 3) { if (it < 4) { asm volatile("" ::: "memory");
                const int kb = 64 * (3 - it) + 4 * hi;
#pragma unroll
                for (int r = 0; r < 16; ++r) { const int kv = kb + (r & 3) + 8 * (r >> 2); if (kv > qrel) C0[r] = -INFINITY; if (kv + 32 > qrel) C1[r] = -INFINITY; } } }
            else { const u32x2 mw = *(const LAS u32x2*)(maskL + qrel * MROW + 2 * t); const unsigned w0 = mw.x >> (4 * hi), w1 = mw.y >> (4 * hi);
#pragma unroll
                for (int r = 0; r < 16; ++r) { const int c = (r & 3) + 8 * (r >> 2); if (!((w0 >> c) & 1u)) C0[r] = -INFINITY; if (!((w1 >> c) & 1u)) C1[r] = -INFINITY; } }
            const float rm = rowmax(C0, C1, hi);
            const bool need = hasref ? (rm > THR) : (rm > -INFINITY);
            resc = false;
            if (__any(need)) {
                const bool fin = rm > -INFINITY;
                const float dl = hasref ? fmaxf(rm, 0.f) : (fin ? rm : 0.f);
                const float f = hasref ? EX2(-dl) : 1.f;
                mhat += dl; l_reg *= f;
#pragma unroll
                for (int r = 0; r < 16; ++r) { C0[r] -= dl; C1[r] -= dl; }
                if (hi == 0) wsf[r32] = f;
                resc = true; hasref = hasref || fin;
            }
            if (VAR != 0) {
                const bool dead = hasref && (sbound - slope2 * (float)(tq - 64 * t + 1) - mhat < -150.f);
                const bool alld = __all(dead); if (lane == 0) ((LAS unsigned*)(sh + L_END))[(it & 1) * 8 + wid] = alld ? 1u : 0u;
            }
        };
#define KLD(dst0, dst1, d0) do { dst0 = *(const LAS bf16x8*)(kp_ + (d0) * 2048); dst1 = *(const LAS bf16x8*)(kp_ + (d0) * 2048 + 512); } while (0)
#define VLD(lo, hi_, i) do { lo = vtr(vp_ + (((i) >> 2) * 4096 + ((i) & 3) * 1024)); hi_ = vtr(vp_ + (((i) >> 2) * 4096 + ((i) & 3) * 1024 + 512)); } while (0)
#define VF(lo, hi_) (bf16x8){lo[0], lo[1], lo[2], lo[3], hi_[0], hi_[1], hi_[2], hi_[3]}
        const auto step = [&](f32x16& C0, f32x16& C1, f32x16& P0, f32x16& P1, const int it) __attribute__((always_inline)) -> bool {
            if (it + 1 < NT) ATT_BARN(2); else ATT_BARN(1);
            if (VAR != 0 && it >= 1) { const LAS unsigned* wz = (const LAS unsigned*)(sh + L_END) + ((it - 1) & 1) * 8;
                const u32x4 z0 = *(const LAS u32x4*)wz, z1 = *(const LAS u32x4*)(wz + 4);
                if (__builtin_amdgcn_readfirstlane((int)(z0.x & z0.y & z0.z & z0.w & z1.x & z1.y & z1.z & z1.w)) != 0) return true; }
            if (it + 2 < NT) DMA_K2(it + 2, slot3(it + 2));
            if (it + 1 < NT) DMA_V2(it + 1, slot3(it + 1));
            setneg(NT - 1 - it);
            int ko_ = slot3(it), vo_ = slot3(it + 2);
            asm volatile("" : "+s"(ko_), "+s"(vo_));
            const lds_cptr kp_ = kp0 + ko_; const lds_cptr vp_ = vp0 + vo_;
            bf16x8 ka0, ka1, kb0, kb1; s16x4 va0, va1, vb0, vb1;
            float sacc = 0.f;
            if (VAR == 2) {
                KLD(ka0, ka1, 2 * pass); KLD(kb0, kb1, 2 * pass + 1); SB2();
                GAPA8(C0 = MF32(ka0, qa[0], negm), P0, 0, pw0);
                GAPA8(C1 = MF32(ka1, qa[0], negm), P0, 8, pw1);
                GAPA8(C0 = MF32(kb0, qa[1], C0), P1, 0, pw2);
                GAPA8(C1 = MF32(kb1, qa[1], C1), P1, 8, pw3);
            } else {
                KLD(ka0, ka1, 0); KLD(kb0, kb1, 1); SB2();
                GAPA(C0 = MF32(ka0, qa[0], negm), P0, 0, pw0, 0);
                GAPA(C1 = MF32(ka1, qa[0], negm), P0, 4, pw0, 2);
                KLD(ka0, ka1, 2); SB2();
                GAPA(C0 = MF32(kb0, qa[1], C0), P0, 8, pw1, 0);
                GAPA(C1 = MF32(kb1, qa[1], C1), P0, 12, pw1, 2);
                KLD(kb0, kb1, 3); SB2();
                GAPA(C0 = MF32(ka0, qa[2], C0), P1, 0, pw2, 0);
                GAPA(C1 = MF32(ka1, qa[2], C1), P1, 4, pw2, 2);
                GAPA(C0 = MF32(kb0, qa[3], C0), P1, 8, pw3, 0);
                GAPA(C1 = MF32(kb1, qa[3], C1), P1, 12, pw3, 2);
            }
            l_reg += sacc;
            mid(C0, C1, it);
            SB2();
            if (it > 0) {
                VLD(va0, va1, 0); VLD(vb0, vb1, 4); SB2();
                GAPB(o[0] = MF32(PAF(0), VF(va0, va1), o[0]), C0, 0);  VLD(va0, va1, 1); SB2();
                GAPB(o[1] = MF32(PAF(0), VF(vb0, vb1), o[1]), C0, 4);  VLD(vb0, vb1, 5); SB2();
                GAPB(o[0] = MF32(PAF(1), VF(va0, va1), o[0]), C0, 8);  VLD(va0, va1, 2); SB2();
                GAPB(o[1] = MF32(PAF(1), VF(vb0, vb1), o[1]), C0, 12); VLD(vb0, vb1, 6); SB2();
                GAPB(o[0] = MF32(PAF(2), VF(va0, va1), o[0]), C1, 0);  VLD(va0, va1, 3); SB2();
                GAPB(o[1] = MF32(PAF(2), VF(vb0, vb1), o[1]), C1, 4);  VLD(vb0, vb1, 7); SB2();
                GAPB(o[0] = MF32(PAF(3), VF(va0, va1), o[0]), C1, 8);
                GAPB(o[1] = MF32(PAF(3), VF(vb0, vb1), o[1]), C1, 12);
                if (resc) {
#pragma unroll
                    for (int r = 0; r < 16; ++r) { const float fr = wsf[crow(r, hi)]; o[0][r] *= fr; o[1][r] *= fr; } }
            } else {
#pragma unroll
                for (int r = 0; r < 16; ++r) { C0[r] = EX2(C0[r]); C1[r] = EX2(C1[r]); }
            }
            return false;
        };
        bool ex = false, pendA = true; int it = 0;
        for (; it < NT; it += 2) {
            ex = step(pA0, pA1, pB0, pB1, it); if (ex) { pendA = false; break; }
            ex = step(pB0, pB1, pA0, pA1, it + 1); if (ex) { pendA = true; ++it; break; }
        }
        if (!ex) pendA = false;
        if (!ex) ATT_BARN(0);
        { int vo_ = slot3(it + 2); asm volatile("" : "+s"(vo_)); const lds_cptr vp_ = vp0 + vo_; s16x4 vlo[8], vhi[8];
#pragma unroll
          for (int i = 0; i < 8; ++i) VRD(i);
          float sacc = 0.f;
          if (pendA) {
#pragma unroll
              for (int r = 0; r < 16; ++r) sacc += pA0[r] + pA1[r];
              pw0 = (u32x4){PKW(pA0, 0), PKW(pA0, 2), PKW(pA0, 4), PKW(pA0, 6)}; pw1 = (u32x4){PKW(pA0, 8), PKW(pA0, 10), PKW(pA0, 12), PKW(pA0, 14)};
              pw2 = (u32x4){PKW(pA1, 0), PKW(pA1, 2), PKW(pA1, 4), PKW(pA1, 6)}; pw3 = (u32x4){PKW(pA1, 8), PKW(pA1, 10), PKW(pA1, 12), PKW(pA1, 14)};
          } else {
#pragma unroll
              for (int r = 0; r < 16; ++r) sacc += pB0[r] + pB1[r];
              pw0 = (u32x4){PKW(pB0, 0), PKW(pB0, 2), PKW(pB0, 4), PKW(pB0, 6)}; pw1 = (u32x4){PKW(pB0, 8), PKW(pB0, 10), PKW(pB0, 12), PKW(pB0, 14)};
              pw2 = (u32x4){PKW(pB1, 0), PKW(pB1, 2), PKW(pB1, 4), PKW(pB1, 6)}; pw3 = (u32x4){PKW(pB1, 8), PKW(pB1, 10), PKW(pB1, 12), PKW(pB1, 14)};
          }
          l_reg += sacc;
          o[0] = MF32(PAF(0), VFR(0), o[0]); o[1] = MF32(PAF(0), VFR(4), o[1]); o[0] = MF32(PAF(1), VFR(1), o[0]); o[1] = MF32(PAF(1), VFR(5), o[1]);
          o[0] = MF32(PAF(2), VFR(2), o[0]); o[1] = MF32(PAF(2), VFR(6), o[1]); o[0] = MF32(PAF(3), VFR(3), o[0]); o[1] = MF32(PAF(3), VFR(7), o[1]); }
        ATT_WAIT_BAR();
        if (pass == NPASS - 1 && tid == 0) nxt_u = __builtin_amdgcn_atomic_inc32(qctr, 0xFFFFFFFFu, __ATOMIC_RELAXED, "agent");
        int lane_e = lane; asm volatile("" : "+v"(lane_e)); const int r32e = lane_e & 31, hie = lane_e >> 5;
        LAS float* wsfe = (LAS float*)(sh + L_WS) + wid * 64; LAS float* stge = (LAS float*)(sh + L_OST) + wid * 2048;
        float rli[16];
        l_reg += xhalf(l_reg, hie);
        if (hie == 0) wsfe[32 + r32e] = l_reg;
#pragma unroll
        for (int r = 0; r < 16; ++r) rli[r] = __builtin_amdgcn_rcpf(wsfe[32 + crow(r, hie)]);
#pragma unroll
        for (int r = 0; r < 16; ++r) { const int orow = crow(r, hie);
#pragma unroll
            for (int d0 = 0; d0 < 2; ++d0) { const float val = o[d0][r] * rli[r]; LAS float* sp = stge + orow * 64 + d0 * 32 + r32e;
                if (VAR == 2 && pass == 1) *sp = *sp - P.lam * val; else *sp = val; } }
    }
    LDS_WAIT();
    int lane_o = tid & 63; asm volatile("" : "+v"(lane_o));
    bf16* Ow = P.mix + (size_t)(rowbase + q0 + wid * 32) * DM + VAR * 256 + h * 64;
    { const int lane = lane_o; LAS float* stg = (LAS float*)(sh + L_OST) + wid * 2048;
#pragma unroll
    for (int i = 0; i < 4; ++i) { const int row = i * 8 + (lane >> 3), ch = lane & 7;
        const f32x4 a = *(const LAS f32x4*)(stg + row * 64 + ch * 8), c = *(const LAS f32x4*)(stg + row * 64 + ch * 8 + 4);
        float sc = 1.f;
        if (VAR == 2) { float ss = (a[0] * a[0] + a[1] * a[1]) + (a[2] * a[2] + a[3] * a[3]) + (c[0] * c[0] + c[1] * c[1]) + (c[2] * c[2] + c[3] * c[3]);
            ss += shx<1>(ss); ss += shx<2>(ss); ss += shx<4>(ss); sc = 1.0f / sqrtf(ss * (1.f / 64.f) + RMS_EPS); }
        u32x4 w; w.x = cvtpk_s(a[0] * sc, a[1] * sc); w.y = cvtpk_s(a[2] * sc, a[3] * sc); w.z = cvtpk_s(c[0] * sc, c[1] * sc); w.w = cvtpk_s(c[2] * sc, c[3] * sc);
        *(u32x4*)(Ow + (size_t)row * DM + ch * 8) = w; } }
    if (tid == 0) *qslot = nxt_u;
    asm volatile("s_waitcnt lgkmcnt(0)\n\ts_barrier" ::: "memory");
#undef DMA_K2
#undef DMA_V2
#undef TILE2
}
#undef SB2
#undef PINV
#undef MF32
#undef ATT_BARN
#undef PKW
#undef PAF
#undef VFR
#undef VRD
#undef EX2
#undef GAPA
#undef GAPA8
#undef GAPB
#undef KLD
#undef VLD
#undef VF
}

__device__ __forceinline__ void p4_attention(Frame& F, const Args& A, int l, int qsel) {
    att::AttnP P; P.proj = (const bf16*)(F.ws + WS_PROJ); P.mix = (bf16*)(F.ws + WS_MIX); P.cum = (const float*)(F.ws + WS_CUM); P.mask = (const unsigned*)(F.ws + WS_MASK);
    P.qgain[0] = inp<I_QNA>() + l * 64; P.qgain[1] = nullptr; P.qgain[2] = inp<I_QNC>() + l * 32; P.qgain[3] = inp<I_QND>() + l * 64; P.kgain[0] = nullptr; P.kgain[1] = nullptr; P.kgain[2] = inp<I_KNC>() + l * 32; P.kgain[3] = inp<I_KND>() + l * 64; P.lam = ((const float*)(F.ws + WS_MISC))[l];
    LAS char* sh = (LAS char*)F.lds;
    LAS float* rsl2 = (LAS float*)(F.lds + 126976);
    bool cv = BG_CONVERT && (qsel == 0);
    if (cv) { fill_rowscale(F, A, 0, rsl2); fill_rowscale(F, A, 1, rsl2 + DM); }
    if (F.tid == 0) F.MISC[0] = (unsigned)(F.bx - F.G);
    __syncthreads();
    for (;;) {
        const int u = (int)F.MISC[0] + F.G;
        if (u >= 1024) break;
        const int qb = 7 - (u >> 7), r = u & 127, var = r >> 5, bh = r & 31, b = bh >> 2, h = bh & 3;
        const int tv = var == 0 ? 2 : var == 1 ? 1 : var == 2 ? 3 : 0;
        if (qsel >= 2 && PROBE_ATT_VAR >= 0 && tv != PROBE_ATT_VAR) { __syncthreads(); if (F.tid == 0) F.MISC[0] = __hip_atomic_fetch_add(F.ctl + CW_AQ + 64 * qsel, 1u, RLX_AGENT); __syncthreads(); continue; }
#ifdef ONLY_VAR2
        att::attn_unit2<ONLY_VAR2>(P, b, h, qb, sh, F.tid, F.ctl + CW_AQ + 64 * qsel, F.MISC);
#else
        if (tv == 2) att::attn_unit<2>(P, b, h, qb, sh, F.tid, qsel >= 2 ? PROBE_ATT_MODE : 0, F.ctl + CW_AQ + 64 * qsel, F.MISC);
        else if (tv == 1) att::attn_unit<1>(P, b, h, qb, sh, F.tid, qsel >= 2 ? PROBE_ATT_MODE : 0, F.ctl + CW_AQ + 64 * qsel, F.MISC);
        else if (tv == 3) att::attn_unit<3>(P, b, h, qb, sh, F.tid, qsel >= 2 ? PROBE_ATT_MODE : 0, F.ctl + CW_AQ + 64 * qsel, F.MISC);
        else att::attn_unit2<0>(P, b, h, qb, sh, F.tid, F.ctl + CW_AQ + 64 * qsel, F.MISC);
#endif
        if (cv) {
            if (F.tid == 0) F.MISC[3] = __hip_atomic_fetch_add(F.ctl + CW_CVQ, (unsigned)CV_CHUNK, RLX_AGENT);
            __syncthreads();
            const int gb = (int)F.MISC[3];
            if (gb >= CV_TOTAL) cv = false; else convert_chunk(F, A, gb, rsl2);
            __syncthreads();
        }
    }
    while (cv) {
        __syncthreads();
        if (F.tid == 0) F.MISC[3] = __hip_atomic_fetch_add(F.ctl + CW_CVQ, (unsigned)CV_CHUNK, RLX_AGENT);
        __syncthreads();
        const int gb = (int)F.MISC[3];
        if (gb >= CV_TOTAL) cv = false; else convert_chunk(F, A, gb, rsl2);
    }
    __syncthreads();
}

template <int N, int Dd> __device__ __forceinline__ void bfly(float (&p)[32], int lane) { const bool up = (lane & Dd) != 0;
#pragma unroll
    for (int j = 0; j < N / 2; ++j) { const float a = p[2 * j], bb = p[2 * j + 1]; const float send = up ? a : bb, keep = up ? bb : a; p[j] = keep + __shfl_xor(send, Dd); } }
__device__ __forceinline__ void p6_router(Frame& F, const Args& A, int l, int rep) {
    const float* MOD = (const float*)(F.ws + WS_MOD); const bf16* X1 = (const bf16*)(F.ws + WS_X1); bf16* H = (bf16*)(F.ws + WS_H);
    const bf16* WRH = (const bf16*)(F.ws + WS_WR) + (size_t)l * 48 * DM; const bf16* WRL = WRH + 2 * 48 * DM;
    int* tok_e = (int*)(F.ws + WS_TOK); float* tok_w = (float*)(F.ws + WS_TOK) + 2 * M; int* tok_pos = (int*)(F.ws + WS_TOK) + 4 * M;
    constexpr int AP = 528;
    LAS unsigned char* Ahi = F.lds; LAS unsigned char* Alo = F.lds + 64 * AP; LAS unsigned char* Bhi = F.lds + 128 * AP; LAS unsigned char* Blo = F.lds + 176 * AP;
    LAS float* PL = (LAS float*)F.lds;
    const int lane = F.lane, w = F.wave; const int mw = (F.vcu * NWAVES + w) * 8; const int b = mw >> 11;
    const float* md = MOD + ((size_t)l * 8 + b) * 6144;
    f32x4 hv[8][4];
#pragma unroll
    for (int r = 0; r < 8; ++r) {
        const bf16* xr = X1 + (size_t)(mw + r) * DM;
#pragma unroll
        for (int j = 0; j < 4; ++j) { const u32x2 q = *(const u32x2*)(xr + 256 * j + 4 * lane); hv[r][j] = (f32x4){bf2f(q.x & 0xffff), bf2f(q.x >> 16), bf2f(q.y & 0xffff), bf2f(q.y >> 16)}; }
    }
    { f32x4 gm[4], sc[4], sh[4]; const float* n2 = inp<I_N2G>() + l * DM;
#pragma unroll
      for (int j = 0; j < 4; ++j) { const int col = 256 * j + 4 * lane; gm[j] = *(const f32x4*)(n2 + col); sc[j] = *(const f32x4*)(md + 4 * DM + col); sh[j] = *(const f32x4*)(md + 3 * DM + col); gm[j] = gm[j] * (sc[j] + 1.0f); }
#pragma unroll
      for (int r = 0; r < 8; ++r) { float ss = 0.f;
#pragma unroll
        for (int j = 0; j < 4; ++j) ss += (hv[r][j][0] * hv[r][j][0] + hv[r][j][1] * hv[r][j][1]) + (hv[r][j][2] * hv[r][j][2] + hv[r][j][3] * hv[r][j][3]);
        const float rstd = 1.0f / sqrtf(wave_sum(ss) * (1.f / DM) + RMS_EPS);
#pragma unroll
        for (int j = 0; j < 4; ++j) { hv[r][j] = hv[r][j] * rstd * gm[j] + sh[j]; u32x2 pk; pk.x = pk2(hv[r][j][0], hv[r][j][1]); pk.y = pk2(hv[r][j][2], hv[r][j][3]);
            *(u32x2*)(H + (size_t)(mw + r) * DM + 256 * j + 4 * lane) = pk; } } }
    const int rt = w & 3, kh = w >> 2, arow = lane & 15, kg = lane >> 4;
    f32x4 acc[3];
#pragma unroll
    for (int c = 0; c < 3; ++c) acc[c] = (f32x4){0.f, 0.f, 0.f, 0.f};
    u32x4 bpre[2][3];
    const auto loadB = [&](int j) {
#pragma unroll
        for (int k = 0; k < 3; ++k) { const int i = F.tid + 512 * k, o = i >> 5, c16 = i & 31;
            bpre[0][k] = *(const u32x4*)(WRH + (size_t)o * DM + 256 * j + 8 * c16); bpre[1][k] = *(const u32x4*)(WRL + (size_t)o * DM + 256 * j + 8 * c16); } };
    loadB(0);
#pragma unroll
    for (int j = 0; j < 4; ++j) {
        __syncthreads();
#pragma unroll
        for (int r = 0; r < 8; ++r) { const f32x4 x = hv[r][j]; unsigned h0 = f2bf(x[0]), h1 = f2bf(x[1]), h2 = f2bf(x[2]), h3 = f2bf(x[3]);
            u32x2 hi; hi.x = h0 | (h1 << 16); hi.y = h2 | (h3 << 16);
            u32x2 lo; lo.x = pk2(x[0] - bf2f((unsigned short)h0), x[1] - bf2f((unsigned short)h1)); lo.y = pk2(x[2] - bf2f((unsigned short)h2), x[3] - bf2f((unsigned short)h3));
            *(LAS u32x2*)(Ahi + (w * 8 + r) * AP + lane * 8) = hi; *(LAS u32x2*)(Alo + (w * 8 + r) * AP + lane * 8) = lo; }
#pragma unroll
        for (int k = 0; k < 3; ++k) { const int i = F.tid + 512 * k, o = i >> 5, c16 = i & 31; *(LAS u32x4*)(Bhi + o * AP + c16 * 16) = bpre[0][k]; *(LAS u32x4*)(Blo + o * AP + c16 * 16) = bpre[1][k]; }
        if (j + 1 < 4) loadB(j + 1);
        LDS_WAIT(); __syncthreads();
#pragma unroll
        for (int ks = 0; ks < 4; ++ks) { const int kb = ((4 * kh + ks) * 32 + 8 * kg) * 2;
            const bf16x8 ah = *(const LAS bf16x8*)(Ahi + (16 * rt + arow) * AP + kb), al = *(const LAS bf16x8*)(Alo + (16 * rt + arow) * AP + kb);
#pragma unroll
            for (int c = 0; c < 3; ++c) { const bf16x8 bh = *(const LAS bf16x8*)(Bhi + (16 * c + arow) * AP + kb), bl = *(const LAS bf16x8*)(Blo + (16 * c + arow) * AP + kb);
                acc[c] = __builtin_amdgcn_mfma_f32_16x16x32_bf16(ah, bh, acc[c], 0, 0, 0);
                acc[c] = __builtin_amdgcn_mfma_f32_16x16x32_bf16(al, bh, acc[c], 0, 0, 0);
                acc[c] = __builtin_amdgcn_mfma_f32_16x16x32_bf16(ah, bl, acc[c], 0, 0, 0); } }
    }
    __syncthreads();
#pragma unroll
    for (int c = 0; c < 3; ++c)
#pragma unroll
        for (int r = 0; r < 4; ++r) PL[(kh * 64 + 16 * rt + kg * 4 + r) * 48 + 16 * c + arow] = acc[c][r];
    LDS_WAIT(); __syncthreads();
    if (F.tid < 64 && rep == 0) {
        const int m = F.vcu * 64 + F.tid; const LAS float* q0 = PL + F.tid * 48; const LAS float* q1 = PL + (64 + F.tid) * 48;
        float gl[4]; int gi = 0; float gm;
#pragma unroll
        for (int g = 0; g < 4; ++g) gl[g] = (q0[g] + q1[g]) + inp<I_BG>()[l * 4 + g];
        gm = gl[0];
#pragma unroll
        for (int g = 1; g < 4; ++g) if (gl[g] > gm) { gm = gl[g]; gi = g; }
        float den = 0.f;
#pragma unroll
        for (int g = 0; g < 4; ++g) den += __expf(gl[g] - gm);
        const float gprob = 1.0f / den;
        float v1 = -INFINITY, v2 = -INFINITY; int i1 = 0, i2 = 0;
        for (int e = 0; e < 8; ++e) { const float v = (q0[4 + gi * 8 + e] + q1[4 + gi * 8 + e]) + inp<I_BE>()[l * 32 + gi * 8 + e];
            if (v > v1) { v2 = v1; i2 = i1; v1 = v; i1 = e; } else if (v > v2) { v2 = v; i2 = e; } }
        const float e2 = __expf(v2 - v1); const float w1 = gprob / (1.f + e2), w2 = gprob * e2 / (1.f + e2);
        const int ea = gi * 8 + i1, eb = gi * 8 + i2;
        tok_e[m] = ea; tok_e[M + m] = eb; tok_w[m] = w1; tok_w[M + m] = w2;
        LAS unsigned* lcnt = (LAS unsigned*)(F.lds + 32768); LAS unsigned* lbase = lcnt + 32;
        if (F.tid < 32) lcnt[F.tid] = 0u;
        asm volatile("s_waitcnt lgkmcnt(0)" ::: "memory");
        const unsigned ra = __hip_atomic_fetch_add(lcnt + ea, 1u, __ATOMIC_RELAXED, __HIP_MEMORY_SCOPE_WORKGROUP), rb = __hip_atomic_fetch_add(lcnt + eb, 1u, __ATOMIC_RELAXED, __HIP_MEMORY_SCOPE_WORKGROUP);
        asm volatile("s_waitcnt lgkmcnt(0)" ::: "memory");
        if (F.tid < 32) { const unsigned n = *(volatile LAS unsigned*)(lcnt + F.tid); unsigned bs = 0u; if (n) bs = __hip_atomic_fetch_add(F.ctl + CW_CNT + (l * 32 + F.tid) * 16, n, RLX_AGENT); *(volatile LAS unsigned*)(lbase + F.tid) = bs; }
        asm volatile("s_waitcnt vmcnt(0) lgkmcnt(0)" ::: "memory");
        const int pa = (int)(*(volatile LAS unsigned*)(lbase + ea) + ra), pb = (int)(*(volatile LAS unsigned*)(lbase + eb) + rb);
        tok_pos[m] = pa; tok_pos[M + m] = pb;
        int* elist = (int*)(F.ws + WS_ELIST); elist[ea * M + pa] = m; elist[eb * M + pb] = m;
    }
}

__device__ __forceinline__ void build_rowlists(Frame& F, int l) {
    volatile LAS int* base = (volatile LAS int*)(F.lds + BASE_OFF); volatile LAS int* cnts = (volatile LAS int*)(F.lds + CNTS_OFF); volatile LAS int* tab = (volatile LAS int*)(F.lds + TAB_OFF);
    LAS int* rowl = (LAS int*)(F.lds + ROWL_OFF); const int* elist = (const int*)(F.ws + WS_ELIST);
    const int ntile = (int)F.MISC[1];
    const int i = F.tid >> 8, r = F.tid & 255; const long L = (long)i * F.G + F.bx;
    int tok = 0;
    if (L < 2L * ntile) { const int tile = (int)(L >> 1), e = tab[tile], pos = 256 * (tile - base[e]) + r; if (pos < cnts[e]) tok = elist[e * M + pos]; }
    rowl[F.tid] = tok;
    __syncthreads();
}

constexpr int NPL = 7, NPH = 2 + 2 * NPL;
__global__ void __launch_bounds__(NWAVES * 64, 2) mk_fwd(Args args) {
    extern __shared__ __attribute__((aligned(16))) unsigned char lds[];
    Frame F;
    F.lds = (LAS unsigned char*)lds;
    F.MISC = (volatile LAS unsigned*)(F.lds + MISC_OFF);
    F.tid = threadIdx.x; F.lane = F.tid & 63; F.wave = __builtin_amdgcn_readfirstlane(F.tid >> 6);
    const int wave0 = F.wave;
    F.G = gridDim.x; F.bx = blockIdx.x; F.vcu = 0;
    F.ws = args.ws; F.out = args.out; F.ctl = (unsigned*)(args.ws + WS_CTL);
    for (int u = F.tid; u < (LDS_BYTES - LDSCTL_OFF) / 4; u += NWAVES * 64) ((LAS unsigned*)(F.lds + LDSCTL_OFF))[u] = 0u;
    __syncthreads();
    XcdBarrier bar; bar.bar = F.ctl + CW_BAR; bar.x = 0; bar.st = nullptr;
    if (!MK_PER_PHASE) bar = xcd_barrier_post(F.ctl + CW_BAR, F.MISC + 8);
    const int lo = args.ph_lo, hi = args.ph_hi;
#pragma unroll 1
    for (int ph = lo; ph < hi; ++ph) {
#if PROBE_REP_K >= 0
        const int ptype = ph == 0 ? 0 : (ph == NPH - 1 ? 10 : 1 + (ph - 1) % NPL);
        const int nrep = (ptype == PROBE_REP_K && (ph <= NPL || (PROBE_REP_K != 1 && PROBE_REP_K != 5))) ? 1 : 0;
#pragma unroll 1
        for (int rep = 0; rep <= nrep; ++rep) {
#else
        constexpr int rep = 0;
#endif
        { int w_ = wave0; asm volatile("" : "+s"(w_)); unsigned on_ = ~0u; asm volatile("" : "+s"(on_)); int ln_ = (int)__builtin_amdgcn_mbcnt_hi(on_, __builtin_amdgcn_mbcnt_lo(on_, 0u)); asm volatile("" : "+v"(ln_));
          F.wave = w_; F.lane = ln_; F.tid = w_ * 64 + ln_;
          unsigned long long ws_ = (unsigned long long)args.ws; asm volatile("" : "+s"(ws_)); F.ws = (unsigned char*)(GAS unsigned char*)ws_; F.ctl = (unsigned*)(F.ws + WS_CTL);
          int bx_ = blockIdx.x; asm volatile("" : "+s"(bx_)); F.bx = bx_; F.vcu = (F.G % 8 == 0) ? (bx_ % 8) * (F.G / 8) + bx_ / 8 : bx_; }
        if (ph == 0) {
#ifndef SKIP_P0
            p0_prologue(F, args);
#endif
        } else if (ph == NPH - 1) {
            row_pass(F, args, 2, 1);
        } else {
            const int l = (ph - 1) / NPL, k = (ph - 1) % NPL;
            if (k == 0) { row_pass(F, args, l == 0 ? 0 : 1, l); }
            else if (k == 1) {
                pg8::Gemm g{(const bf16*)(F.ws + WS_H), (const bf16*)(F.ws + WS_WIN) + (size_t)l * NP * DM, M, NP, DM}; pg8::StaticOrder S; S.init(M, NP, F.G, F.bx);
                pg8::EpiBf16 E{(bf16*)(F.ws + WS_PROJ), NP};
#ifndef SKIP_G1
                pg8::gemm_phase<pg8::EpiBf16, pg8::StaticOrder, true, true>(F.lds, g, S, E, F.tid);
#endif
            } else if (k == 2) {
#ifndef SKIP_P3
                p3_prep(F, args, l, rep);
#endif
            } else if (k == 3) {
#ifndef SKIP_P4
                p4_attention(F, args, l, l + 2 * rep);
#endif
            } else if (k == 4) {
                pg8::Gemm g{(const bf16*)(F.ws + WS_MIX), (const bf16*)(F.ws + WS_WOUT) + (size_t)l * DM * DM, M, DM, DM}; pg8::StaticOrder S; S.init(M, DM, F.G, F.bx);
                pg8::EpiResGate E{l == 0 ? inp<I_X>() : nullptr, (const bf16*)(F.ws + WS_X1), (bf16*)(F.ws + WS_X1), (const float*)(F.ws + WS_MOD) + (size_t)l * 8 * 6144 + 2 * DM};
#ifndef SKIP_G2
                pg8::gemm_phase<pg8::EpiResGate, pg8::StaticOrder, false, true>(F.lds, g, S, E, F.tid);
#endif
            } else if (k == 5) {
#ifndef SKIP_P6
                p6_router(F, args, l, rep);
#endif
            } else {
                build_tables(F, l); build_rowlists(F, l);
                unsigned* upf = F.ctl + CW_UPF + l * 8192; unsigned* dq = F.ctl + CW_DNQ + 16 * l;
                { pg8::Gemm g{(const bf16*)(F.ws + WS_H), (const bf16*)(F.ws + WS_WUP) + (size_t)l * NEXP * 512 * DM, MAXSLOT, 512, DM};
                  pg8::GroupOrder S{(const LAS int*)(F.lds + TAB_OFF), (int)F.MISC[1], 2, F.G, F.bx, (size_t)512 * DM * 2};
                  pg8::EpiSwiglu E{(bf16*)(F.ws + WS_HID), upf};
#ifndef SKIP_G3
                  pg8::gemm_phase<pg8::EpiSwiglu, pg8::GroupOrder, true, true, true>(F.lds, g, S, E, F.tid, (const LAS int*)(F.lds + ROWL_OFF));
#endif
                }
                if (GAP_CONVERT && !BG_CONVERT && l == 0 && rep == 0) convert_layer1_in_gap(F, args, 2 * (int)F.MISC[1] - F.G);
                { const pg8::Gemm g{(const bf16*)(F.ws + WS_HID), (const bf16*)(F.ws + WS_WDN) + (size_t)l * NEXP * DM * FF, MAXSLOT, DM, FF};
                  const pg8::EpiBf16 E{(bf16*)(F.ws + WS_Y), DM};
                  const LAS int* tab = (const LAS int*)(F.lds + TAB_OFF);
                  const int nd = 4 * __builtin_amdgcn_readfirstlane((int)F.MISC[1]);
                  pg8::DynOrder S{dq, upf, tab, F.MISC, nd, (size_t)DM * FF * 2, F.tid, (unsigned)F.G, 0u, 2u};
                  if (F.tid == 0) { const unsigned a = (unsigned)F.bx, b = (unsigned)F.G + __hip_atomic_fetch_add(dq, 1u, RLX_AGENT); F.MISC[4] = a; F.MISC[5] = b;
                      if ((int)a < nd) while (__hip_atomic_load(upf + (a >> 2) * 16, RLX_AGENT) < 2u) __builtin_amdgcn_s_sleep(8);
                      __builtin_amdgcn_fence(__ATOMIC_ACQUIRE, "agent"); asm volatile("s_waitcnt vmcnt(0)" ::: "memory"); S.issue(b); }
                  __syncthreads();
                  for (;;) {
                      if (__builtin_amdgcn_readfirstlane((int)F.MISC[4]) >= nd) break;
#ifndef SKIP_G4
                      pg8::gemm_phase<pg8::EpiBf16, pg8::DynOrder, true, true>(F.lds, g, S, E, F.tid);
#endif
                      if (F.tid == 0) {
                          const unsigned idn = F.MISC[5];
                          if ((int)idn < nd) { unsigned f = S.pflag; while (f < 2u) { __builtin_amdgcn_s_sleep(8); f = __hip_atomic_load(upf + (idn >> 2) * 16, RLX_AGENT); }
                              __builtin_amdgcn_fence(__ATOMIC_ACQUIRE, "agent"); asm volatile("s_waitcnt vmcnt(0)" ::: "memory"); }
                          const unsigned idn2 = S.ppop; F.MISC[4] = idn; F.MISC[5] = idn2; S.issue(idn2); }
                      __syncthreads();
                  }
                }
            }
        }
#if PROBE_REP_K >= 0
        if (rep < nrep) xcd_barrier(bar, F.tid);
        }
#endif
        if (ph + 1 < hi) xcd_barrier(bar, F.tid);
#ifdef PROBE_DOUBLE_BAR
        if (ph + 1 < hi) xcd_barrier(bar, F.tid);
#endif
    }
}

extern "C" void kernel_launch(void* const* d_in, const int* in_sizes, int n_in, void* d_out, int out_size, void* d_ws, size_t ws_size, hipStream_t stream) {
    static int grid = 0;
    if (grid == 0) {
        if (n_in != 28 || out_size != M * DM || ws_size < WS_END) { fprintf(stderr, "kernel_launch: unexpected shapes (n_in %d, out %d, ws %zu)\n", n_in, out_size, ws_size); grid = -1; return; }
        int dev = 0, cus = 0, per_cu = 0;
        if (hipGetDevice(&dev) != hipSuccess || hipDeviceGetAttribute(&cus, hipDeviceAttributeMultiprocessorCount, dev) != hipSuccess) { grid = -1; return; }
        if (hipFuncSetAttribute((const void*)mk_fwd, hipFuncAttributeMaxDynamicSharedMemorySize, LDS_BYTES) != hipSuccess) { fprintf(stderr, "kernel_launch: hipFuncSetAttribute failed\n"); grid = -1; return; }
        if (hipOccupancyMaxActiveBlocksPerMultiprocessor(&per_cu, (const void*)mk_fwd, NWAVES * 64, LDS_BYTES) != hipSuccess || per_cu < 1)
            fprintf(stderr, "kernel_launch: occupancy query reports %d workgroups per CU\n", per_cu);
        (void)hipGetLastError();
        grid = cus;
    }
    if (grid < 0) return;
    if (hipMemsetAsync((char*)d_ws + WS_CTL, 0, CTL_ZERO_BYTES, stream) != hipSuccess) return;
    Args a{};
    for (int i = 0; i < 28; ++i) a.in[i] = (const float*)d_in[i];
    a.out = (float*)d_out; a.ws = (unsigned char*)d_ws;
#if MK_PER_PHASE
    for (int p = 0; p < NPH; ++p) { a.ph_lo = p; a.ph_hi = p + 1; hipLaunchKernelGGL(mk_fwd, dim3(grid), dim3(NWAVES * 64), LDS_BYTES, stream, a); }
#else
    a.ph_lo = 0; a.ph_hi = NPH; hipLaunchKernelGGL(mk_fwd, dim3(grid), dim3(NWAVES * 64), LDS_BYTES, stream, a);
#endif
}
```

```cpp
#include <hip/hip_runtime.h>
#include <cstdio>
#include <cstdint>

#ifndef MK_PER_PHASE
#define MK_PER_PHASE 0
#endif

#ifndef PROBE_P3_PART
#define PROBE_P3_PART 0
#endif
#ifndef PROBE_ATT_VAR
#define PROBE_ATT_VAR -1
#endif
#ifndef BG_CONVERT
#define BG_CONVERT 1
#endif
#ifndef GAP_CONVERT
#define GAP_CONVERT 1
#endif
#ifndef PROBE_ATT_MODE
#define PROBE_ATT_MODE 0
#endif
#ifndef PROBE_REP_K
#define PROBE_REP_K -1
#endif
#define LAS __attribute__((address_space(3)))
#define GAS __attribute__((address_space(1)))
typedef unsigned short bf16;
typedef short bf16x8 __attribute__((ext_vector_type(8)));
typedef short s16x4 __attribute__((ext_vector_type(4)));
typedef float f32x4 __attribute__((ext_vector_type(4)));
typedef float f32x2 __attribute__((ext_vector_type(2)));
typedef float f32x16 __attribute__((ext_vector_type(16)));
typedef unsigned u32x4 __attribute__((ext_vector_type(4)));
typedef unsigned u32x2 __attribute__((ext_vector_type(2)));

constexpr int BATCH = 8, SEQ = 2048, DM = 1024, M = BATCH * SEQ, DEPTH = 2;
constexpr int NP = 3072;
constexpr int P_IN = 2988;
constexpr int C_AQ = 0, C_AK = 256, C_AV = 512, C_BQ = 768, C_BK = 1024, C_BV = 1280, C_CQ = 1536, C_CK = 1792, C_CV = 2048,
              C_DQ = 2304, C_DK = 2560, C_DV = 2624, C_IQ = 2688, C_IK = 2944, C_IW = 2976, C_AF = 2984;
constexpr int NEXP = 32, FF = 256, MAXSLOT = M * 2 + NEXP * 256, MAXTILE = MAXSLOT / 256;
constexpr float LOG2E = 1.4426950408889634f;
constexpr float RMS_EPS = 1e-6f;

constexpr size_t MiB = 1u << 20;
constexpr size_t WS_CTL = 0, CTL_ZERO_BYTES = 1 * MiB;
constexpr size_t WS_WR = 1 * MiB;
constexpr size_t WS_MOD = 2 * MiB;
constexpr size_t WS_CUM = 3 * MiB;
constexpr size_t WS_TOK = 4 * MiB;
constexpr size_t WS_MISC = 5 * MiB;
constexpr size_t WS_MASK = 6 * MiB;
constexpr size_t WS_WIN = 10 * MiB;
constexpr size_t WS_WOUT = 22 * MiB;
constexpr size_t WS_WUP = 26 * MiB;
constexpr size_t WS_WDN = 90 * MiB;
constexpr size_t WS_X1 = 122 * MiB;
constexpr size_t WS_H = 186 * MiB;
constexpr size_t WS_MIX = WS_H;

constexpr size_t WS_PROJ = 218 * MiB;
constexpr size_t WS_Y = WS_PROJ;
constexpr size_t WS_HID = WS_PROJ + 80 * MiB;
constexpr size_t WS_ELIST = 322 * MiB;
constexpr size_t WS_END = 324 * MiB;
constexpr int CW_AQ = 256;
constexpr int CW_CNT = 1024;
constexpr int CW_BAR = 8192;
constexpr int CW_DNQ = 208;
constexpr int CW_UPF = 65536;

constexpr int RING_BYTES = 143360;
constexpr int LDSCTL_OFF = RING_BYTES, MISC_OFF = LDSCTL_OFF + 320, CNTS_OFF = LDSCTL_OFF + 512, BASE_OFF = LDSCTL_OFF + 640, TAB_OFF = LDSCTL_OFF + 768;
constexpr int ROWL_OFF = 131072;
constexpr int LDS_BYTES = 147456;
constexpr int NWAVES = 8;

#define LDS_WAIT() asm volatile("s_waitcnt lgkmcnt(0)" ::: "memory")
#define VM_WAIT() asm volatile("s_waitcnt vmcnt(0)" ::: "memory")
#define RLX_AGENT __ATOMIC_RELAXED, __HIP_MEMORY_SCOPE_AGENT

__device__ __forceinline__ float bf2f(unsigned short u) { return __builtin_bit_cast(float, (unsigned)u << 16); }
__device__ __forceinline__ unsigned f2bf(float f) { unsigned u = __builtin_bit_cast(unsigned, f); return (u + 0x7fffu + ((u >> 16) & 1u)) >> 16; }
__device__ __forceinline__ unsigned pk2(float lo, float hi) { return f2bf(lo) | (f2bf(hi) << 16); }
template <int O> __device__ __forceinline__ float shx(float x) { static_assert(O >= 1 && O <= 16, "swizzle xor"); return __builtin_bit_cast(float, __builtin_amdgcn_ds_swizzle(__builtin_bit_cast(int, x), (O << 10) | 0x1f)); }
__device__ __forceinline__ float half_sum(float x) { return __builtin_bit_cast(float, __builtin_amdgcn_readlane(__builtin_bit_cast(int, x), 0)) + __builtin_bit_cast(float, __builtin_amdgcn_readlane(__builtin_bit_cast(int, x), 32)); }
__device__ __forceinline__ float half_max(float x) { return fmaxf(__builtin_bit_cast(float, __builtin_amdgcn_readlane(__builtin_bit_cast(int, x), 0)), __builtin_bit_cast(float, __builtin_amdgcn_readlane(__builtin_bit_cast(int, x), 32))); }
__device__ __forceinline__ float shup(float x, int o, int lane) { return __builtin_bit_cast(float, __builtin_amdgcn_ds_bpermute((lane - o) << 2, __builtin_bit_cast(int, x))); }
__device__ __forceinline__ int shup_i(int x, int o, int lane) { return __builtin_amdgcn_ds_bpermute((lane - o) << 2, x); }
__device__ __forceinline__ float wave_sum(float v) { v += shx<1>(v); v += shx<2>(v); v += shx<4>(v); v += shx<8>(v); v += shx<16>(v); return half_sum(v); }

namespace pg8 {
constexpr int BM = 256, BK = 64, HALF = 128, HTB = HALF * BK * 2, STAGE_BYTES = 8 * HTB, NXCD = 8, WGM = 8;
__host__ __device__ __forceinline__ int lds_byte(int r, int c) { const int st = (r >> 4) * 2 + (c >> 5), rr = r & 15, cc = c & 31, ob = rr * 64 + cc * 2; return st * 1024 + (ob ^ (((ob >> 9) & 1) << 5)); }
__host__ __device__ __forceinline__ void stage_rc(int b, int& R, int& C) { const int st = b / 1024, sb = b % 1024, swz = sb ^ (((sb >> 9) & 1) << 5); R = (st >> 1) * 16 + swz / 64; C = (st & 1) * 32 + (swz % 64) / 2; }
__host__ __device__ __forceinline__ int perm32(int rho) { const int n = rho >> 4, i = rho & 15; return 8 * (i >> 2) + 4 * n + (i & 3); }

struct Unit { int pm, pn; size_t bo; };
struct Gemm { const bf16* A; const bf16* Bt; int M, N, K; };

struct StaticOrder {
    int nM, nN, nwg, G, c;
    __host__ __device__ void init(int M_, int N_, int G_, int c_) { nM = M_ / BM; nN = N_ / BM; nwg = nM * nN; G = G_; c = c_; }
    __host__ __device__ bool next(int i, Unit& u) const {
        const long L = (long)i * G + c; if (L >= nwg) return false;
        int wgid = (int)L; { const int q = nwg / NXCD, r = nwg % NXCD, xcd = wgid % NXCD, off = wgid / NXCD; wgid = (xcd < r ? xcd * (q + 1) : r * (q + 1) + (xcd - r) * q) + off; }
        const int nig = WGM * nN, gid = wgid / nig, fm = gid * WGM, gsz = (nM - fm) < WGM ? (nM - fm) : WGM;
        u.pm = fm + ((wgid % nig) % gsz); u.pn = (wgid % nig) / gsz; u.bo = 0; return true;
    }
};
struct GroupOrder {
    const LAS int* tab; int ntile, ncol, G, c; size_t ebytes;
    __device__ __forceinline__ bool next(int i, Unit& u) const {
        const long L = (long)i * G + c; if (L >= (long)ntile * ncol) return false;
        u.pm = (int)(L / ncol); u.pn = (int)(L % ncol);
        const int e = __builtin_amdgcn_readfirstlane(tab[u.pm]); u.bo = (size_t)e * ebytes; return true;
    }
};

struct OneUnit { Unit u; __device__ __forceinline__ bool next(int i, Unit& o) const { if (i != 0) return false; o = u; return true; } };
struct DynOrder {
    unsigned* dq; unsigned* upf; const LAS int* tab; volatile LAS unsigned* M; int nd; size_t ebytes; int tid; unsigned G;
    mutable unsigned ppop, pflag;
    __device__ __forceinline__ void issue(unsigned idnext) const {
        ppop = G + __builtin_amdgcn_atomic_inc32(dq, 0xFFFFFFFFu, __ATOMIC_RELAXED, "agent");
        pflag = 2u; if ((int)idnext < nd) pflag = __hip_atomic_load(upf + (idnext >> 2) * 16, __ATOMIC_RELAXED, __HIP_MEMORY_SCOPE_AGENT);
    }
    __device__ __forceinline__ void unit(int id, Unit& u) const { u.pm = id >> 2; u.pn = id & 3; u.bo = (size_t)__builtin_amdgcn_readfirstlane(tab[id >> 2]) * ebytes; }
    __device__ __forceinline__ bool next(int i, Unit& u) const {
        if (i == 0) { const int id = __builtin_amdgcn_readfirstlane((int)M[4]); if (id >= nd) return false; unit(id, u); return true; }
        if (tid == 0) {
            const unsigned idn = M[5]; const bool ready = (int)idn < nd && pflag >= 2u;
            M[6] = ready ? 1u : 0u;
            if (ready) { asm volatile("buffer_inv sc1" ::: "memory"); M[4] = idn; const unsigned idn2 = ppop; M[5] = idn2; issue(idn2); }
        }
        asm volatile("s_waitcnt lgkmcnt(0)\n\ts_barrier" ::: "memory");
        if (__builtin_amdgcn_readfirstlane((int)M[6]) == 0) return false;
        unit(__builtin_amdgcn_readfirstlane((int)M[4]), u); return true;
    }
};

__device__ __forceinline__ unsigned cvt_pk_bf16(float lo, float hi) { unsigned r; asm volatile("v_cvt_pk_bf16_f32 %0, %1, %2" : "=v"(r) : "v"(lo), "v"(hi)); return r; }

struct EpiBf16 {
    static constexpr bool PERM = true, PUBLISH = false;
    bf16* O; int ldc;
    __device__ __forceinline__ void operator()(const f32x4 (&acc)[2][2][4][2], const Unit& u, int wr, int wc, int fr, int fq) const {
        const int row0 = u.pm * BM + wr * 64 + fr; const int col0 = u.pn * BM + wc * 32 + 8 * fq;
#pragma unroll
        for (int ai = 0; ai < 2; ++ai)
#pragma unroll
            for (int m = 0; m < 4; ++m) { bf16* rowp = O + (size_t)(row0 + ai * HALF + m * 16) * ldc + col0;
#pragma unroll
                for (int bj = 0; bj < 2; ++bj) { const f32x4 v0 = acc[ai][bj][m][0], v1 = acc[ai][bj][m][1];
                    u32x4 w; w.x = cvt_pk_bf16(v0[0], v0[1]); w.y = cvt_pk_bf16(v0[2], v0[3]); w.z = cvt_pk_bf16(v1[0], v1[1]); w.w = cvt_pk_bf16(v1[2], v1[3]);
                    *(u32x4*)(rowp + bj * HALF) = w; } }
    }
};
struct EpiResGate {
    static constexpr bool PERM = true, PUBLISH = false;
    const float* base32; const bf16* base16; bf16* out; const float* gate;
    __device__ __forceinline__ void operator()(const f32x4 (&acc)[2][2][4][2], const Unit& u, int wr, int wc, int fr, int fq) const {
        const int col0 = u.pn * BM + wc * 32 + 8 * fq; const float* g = gate + (size_t)(u.pm >> 3) * 6144 + col0;
        f32x4 gv[2][2];
#pragma unroll
        for (int bj = 0; bj < 2; ++bj)
#pragma unroll
            for (int n = 0; n < 2; ++n) gv[bj][n] = *(const f32x4*)(g + bj * HALF + n * 4);
#pragma unroll
        for (int ai = 0; ai < 2; ++ai)
#pragma unroll
            for (int m = 0; m < 4; ++m) { const size_t off = (size_t)(u.pm * BM + ai * HALF + wr * 64 + m * 16 + fr) * DM + col0;
#pragma unroll
                for (int bj = 0; bj < 2; ++bj) { f32x4 b0, b1;
                    if (base32) { b0 = *(const f32x4*)(base32 + off + bj * HALF); b1 = *(const f32x4*)(base32 + off + bj * HALF + 4); }
                    else { const u32x4 r = *(const u32x4*)(base16 + off + bj * HALF);
                        b0 = (f32x4){bf2f(r.x & 0xffff), bf2f(r.x >> 16), bf2f(r.y & 0xffff), bf2f(r.y >> 16)}; b1 = (f32x4){bf2f(r.z & 0xffff), bf2f(r.z >> 16), bf2f(r.w & 0xffff), bf2f(r.w >> 16)}; }
                    const f32x4 v0 = b0 + gv[bj][0] * acc[ai][bj][m][0], v1 = b1 + gv[bj][1] * acc[ai][bj][m][1];
                    u32x4 w; w.x = cvt_pk_bf16(v0[0], v0[1]); w.y = cvt_pk_bf16(v0[2], v0[3]); w.z = cvt_pk_bf16(v1[0], v1[1]); w.w = cvt_pk_bf16(v1[2], v1[3]);
                    *(u32x4*)(out + off + bj * HALF) = w; } }
    }
};
struct EpiSwiglu {
    static constexpr bool PERM = true, PUBLISH = true;
    bf16* O; unsigned* flag;
    __device__ __forceinline__ void operator()(const f32x4 (&acc)[2][2][4][2], const Unit& u, int wr, int wc, int fr, int fq) const {
        const int row0 = u.pm * BM + wr * 64 + fr; const int col0 = u.pn * HALF + wc * 32 + 8 * fq;
#pragma unroll
        for (int ai = 0; ai < 2; ++ai)
#pragma unroll
            for (int m = 0; m < 4; ++m) { bf16* rowp = O + (size_t)(row0 + ai * HALF + m * 16) * FF + col0;
                float hv[8];
#pragma unroll
                for (int n = 0; n < 2; ++n)
#pragma unroll
                    for (int i = 0; i < 4; ++i) { const float a = acc[ai][0][m][n][i], b = acc[ai][1][m][n][i];
                        const float sg = __builtin_amdgcn_rcpf(1.f + __builtin_amdgcn_exp2f(-a * LOG2E)); hv[n * 4 + i] = a * sg * b; }
                u32x4 w; w.x = cvt_pk_bf16(hv[0], hv[1]); w.y = cvt_pk_bf16(hv[2], hv[3]); w.z = cvt_pk_bf16(hv[4], hv[5]); w.w = cvt_pk_bf16(hv[6], hv[7]);
                asm volatile("global_store_dwordx4 %0, %1, off sc1\n\ts_nop 2" :: "v"((const GAS bf16*)rowp), "v"(w) : "memory"); }
    }
};

template <class Epi, class Sched, bool ALIGN_EPI = false, bool SP2 = false, bool GATHER = false>
__device__ __forceinline__ void gemm_phase(LAS unsigned char* lds, const Gemm g, const Sched& S, const Epi& E, const int tid, const LAS int* rowl = nullptr) {
    static_assert(!GATHER || SP2, "gather mode is written for the SP2 loop");
    const int wid = __builtin_amdgcn_readfirstlane(tid >> 6), lane = tid & 63, wr = wid >> 2, wc = wid & 3, fr = lane & 15, fq = lane >> 4;
    const int K = g.K, nt = K / BK;
    unsigned voffA[2], voffB[2];
#pragma unroll
    for (int i = 0; i < 2; ++i) { int R, C; stage_rc(tid * 16 + i * 8192, R, C); const int Rb = Epi::PERM ? ((R & ~31) + perm32(R & 31)) : R;
        voffA[i] = (unsigned)(R * K + C) * 2u; voffB[i] = (unsigned)(Rb * K + C) * 2u; }
    const size_t kstep = (size_t)(BK * 2);
    const size_t hstep = (size_t)HALF * K * 2;
    const size_t tstep = 2 * hstep;
    const size_t hstepA = GATHER ? 0 : hstep, tstepA = GATHER ? 0 : tstep;
    unsigned voffGc[2][2], voffGn[2][2];
    int gR[2], gC[2];
#pragma unroll
    for (int i = 0; i < 2; ++i) stage_rc(tid * 16 + i * 8192, gR[i], gC[i]);
#define PG8_GOFF(dst, ui_) do { _Pragma("unroll") for (int h_ = 0; h_ < 2; ++h_) _Pragma("unroll") for (int i_ = 0; i_ < 2; ++i_) \
        dst[h_][i_] = (unsigned)rowl[(ui_) * 256 + h_ * HALF + gR[i_]] * (unsigned)(K * 2) + (unsigned)gC[i_] * 2u; } while (0)
    const unsigned ldsw = (unsigned)wid * 1024u;
    const int aoff = lds_byte(wr * 64 + fr, fq * 8), boff = lds_byte(wc * 32 + fr, fq * 8);
#define PG8_SA(b, h) (((b) * 2 + (h)) * HTB)
#define PG8_SB(b, h) ((4 + (b) * 2 + (h)) * HTB)
#define PG8_STAGE(bufoff, gbase, voff) do { _Pragma("unroll") for (int _i = 0; _i < 2; ++_i) \
        __builtin_amdgcn_global_load_lds((const unsigned*)((const char*)(gbase) + (voff)[_i]), (LAS unsigned*)(lds + (bufoff) + ldsw + _i * 8192), 16, 0, 0); } while (0)
#define PG8_STAGE_A(bufoff, gbase, H, NXT) do { if constexpr (GATHER) { unsigned vo_[2]; vo_[0] = (NXT) ? voffGn[H][0] : voffGc[H][0]; vo_[1] = (NXT) ? voffGn[H][1] : voffGc[H][1]; PG8_STAGE(bufoff, gbase, vo_); } \
        else { PG8_STAGE(bufoff, (const char*)(gbase) + (H) * hstep, voffA); } } while (0)
#define PG8_LDA(dst, b, h) do { _Pragma("unroll") for (int m = 0; m < 4; ++m) _Pragma("unroll") for (int k = 0; k < 2; ++k) dst[m][k] = *(const LAS bf16x8*)(lds + PG8_SA(b, h) + aoff + m * 2048 + k * 1024); } while (0)
#define PG8_LDB(dst, b, h) do { _Pragma("unroll") for (int n = 0; n < 2; ++n) _Pragma("unroll") for (int k = 0; k < 2; ++k) dst[n][k] = *(const LAS bf16x8*)(lds + PG8_SB(b, h) + boff + n * 2048 + k * 1024); } while (0)
#define PG8_MMA(ai, bj, At, Bt) do { __builtin_amdgcn_s_setprio(1); _Pragma("unroll") for (int m = 0; m < 4; ++m) _Pragma("unroll") for (int n = 0; n < 2; ++n) _Pragma("unroll") for (int k = 0; k < 2; ++k) \
        acc[ai][bj][m][n] = __builtin_amdgcn_mfma_f32_16x16x32_bf16(Bt[n][k], At[m][k], acc[ai][bj][m][n], 0, 0, 0); __builtin_amdgcn_s_setprio(0); } while (0)
#define PG8_WAIT_V(n) asm volatile("s_waitcnt vmcnt(" #n ")" ::: "memory")
#define PG8_WAIT_L(n) asm volatile("s_waitcnt lgkmcnt(" #n ")" ::: "memory")
#define PG8_BAR __builtin_amdgcn_s_barrier()
#define PG8_SCHED __builtin_amdgcn_sched_barrier(0)
    Unit cur, nxt; int ui = 0;
    if (!S.next(0, cur)) return;
    f32x4 acc[2][2][4][2];
#pragma unroll
    for (int a = 0; a < 2; ++a)
#pragma unroll
        for (int b = 0; b < 2; ++b)
#pragma unroll
            for (int m = 0; m < 4; ++m)
#pragma unroll
                for (int n = 0; n < 2; ++n) acc[a][b][m][n] = (f32x4){0.f, 0.f, 0.f, 0.f};
    bf16x8 At[4][2], B0[2][2], B1[2][2];
    const char* cA = (const char*)g.A + (size_t)cur.pm * tstepA; const char* cB = (const char*)g.Bt + cur.bo + (size_t)cur.pn * tstep;
    if constexpr (GATHER) { PG8_GOFF(voffGc, 0); PG8_GOFF(voffGn, 0); }
    if constexpr (SP2) {
        PG8_STAGE(PG8_SB(0, 0), cB, voffB); PG8_STAGE(PG8_SB(0, 1), cB + hstep, voffB); PG8_STAGE_A(PG8_SA(0, 0), cA, 0, false); PG8_STAGE_A(PG8_SA(0, 1), cA, 1, false);
        if (wr == 1) PG8_BAR;
        PG8_WAIT_V(2); PG8_BAR;
        PG8_STAGE(PG8_SB(1, 0), cB + kstep, voffB); PG8_STAGE_A(PG8_SA(1, 0), cA + kstep, 0, false); PG8_STAGE(PG8_SB(1, 1), cB + hstep + kstep, voffB);
        PG8_WAIT_V(6); PG8_BAR;
    } else {
        PG8_STAGE(PG8_SB(0, 0), cB, voffB); PG8_STAGE(PG8_SA(0, 0), cA, voffA); PG8_STAGE(PG8_SB(0, 1), cB + hstep, voffB); PG8_STAGE(PG8_SA(0, 1), cA + hstep, voffA);
        if (wr == 1) PG8_BAR;
        PG8_WAIT_V(4); PG8_BAR;
        PG8_STAGE(PG8_SB(1, 0), cB + kstep, voffB); PG8_STAGE(PG8_SA(1, 0), cA + kstep, voffA); PG8_STAGE(PG8_SB(1, 1), cB + hstep + kstep, voffB);
        PG8_WAIT_V(6); PG8_BAR;
    }
    for (;;) {
        const bool has_next = S.next(ui + 1, nxt);
        if constexpr (GATHER) { if (has_next) PG8_GOFF(voffGn, ui + 1); }
        const char* nA = has_next ? (const char*)g.A + (size_t)nxt.pm * tstepA : cA; const char* nB = has_next ? (const char*)g.Bt + nxt.bo + (size_t)nxt.pn * tstep : cB;
#pragma unroll 1
        for (int t = 0; t < nt; t += 2) {
            const bool last = (t == nt - 2);
            const char* a1 = cA + (size_t)(t + 1) * kstep;
            const char* a2 = last ? nA : cA + (size_t)(t + 2) * kstep; const char* b2 = last ? nB : cB + (size_t)(t + 2) * kstep;
            const char* a3 = a2 + kstep; const char* b3 = b2 + kstep;
            if constexpr (SP2) {
            PG8_LDB(B0, 0, 0); PG8_LDB(B1, 0, 1); PG8_SCHED; PG8_LDA(At, 0, 0); PG8_STAGE_A(PG8_SA(1, 1), a1, 1, false);
            PG8_WAIT_V(8); PG8_WAIT_L(0); PG8_BAR; PG8_MMA(0, 0, At, B0); PG8_MMA(0, 1, At, B1); PG8_BAR; PG8_SCHED;
            PG8_LDA(At, 0, 1); PG8_STAGE(PG8_SB(0, 0), b2, voffB); PG8_STAGE(PG8_SB(0, 1), b2 + hstep, voffB); PG8_STAGE_A(PG8_SA(0, 0), a2, 0, last);
            PG8_WAIT_V(8); PG8_WAIT_L(0); PG8_BAR; PG8_MMA(1, 0, At, B0); PG8_MMA(1, 1, At, B1); PG8_BAR; PG8_SCHED;
            PG8_LDB(B0, 1, 0); PG8_LDB(B1, 1, 1); PG8_SCHED; PG8_LDA(At, 1, 0); PG8_STAGE_A(PG8_SA(0, 1), a2, 1, last);
            PG8_WAIT_V(8); PG8_WAIT_L(0); PG8_BAR; PG8_MMA(0, 0, At, B0); PG8_MMA(0, 1, At, B1); PG8_BAR; PG8_SCHED;
            PG8_LDA(At, 1, 1); PG8_STAGE(PG8_SB(1, 0), b3, voffB); PG8_STAGE(PG8_SB(1, 1), b3 + hstep, voffB); PG8_STAGE_A(PG8_SA(1, 0), a3, 0, last);
            PG8_WAIT_V(8); PG8_WAIT_L(0); PG8_BAR; PG8_MMA(1, 0, At, B0); PG8_MMA(1, 1, At, B1); PG8_BAR; PG8_SCHED;
            } else {
            PG8_LDB(B0, 0, 0); PG8_SCHED; PG8_LDA(At, 0, 0); PG8_STAGE(PG8_SA(1, 1), a1 + hstep, voffA);
            PG8_WAIT_L(8); PG8_BAR; PG8_WAIT_L(0); PG8_MMA(0, 0, At, B0); PG8_BAR; PG8_SCHED;
            PG8_LDB(B1, 0, 1); PG8_STAGE(PG8_SB(0, 0), b2, voffB);
            PG8_BAR; PG8_WAIT_L(0); PG8_MMA(0, 1, At, B1); PG8_BAR;
            PG8_LDA(At, 0, 1); PG8_STAGE(PG8_SA(0, 0), a2, voffA);
            PG8_BAR; PG8_WAIT_L(0); PG8_MMA(1, 0, At, B0); PG8_BAR; PG8_SCHED;
            PG8_STAGE(PG8_SB(0, 1), b2 + hstep, voffB);
            PG8_WAIT_V(6); PG8_BAR; PG8_MMA(1, 1, At, B1); PG8_BAR;
            PG8_LDB(B0, 1, 0); PG8_SCHED; PG8_LDA(At, 1, 0); PG8_STAGE(PG8_SA(0, 1), a2 + hstep, voffA);
            PG8_WAIT_L(8); PG8_BAR; PG8_WAIT_L(0); PG8_MMA(0, 0, At, B0); PG8_BAR; PG8_SCHED;
            PG8_LDB(B1, 1, 1); PG8_STAGE(PG8_SB(1, 0), b3, voffB);
            PG8_BAR; PG8_WAIT_L(0); PG8_MMA(0, 1, At, B1); PG8_BAR;
            PG8_LDA(At, 1, 1); PG8_STAGE(PG8_SA(1, 0), a3, voffA);
            PG8_BAR; PG8_WAIT_L(0); PG8_MMA(1, 0, At, B0); PG8_BAR; PG8_SCHED;
            PG8_STAGE(PG8_SB(1, 1), b3 + hstep, voffB);
            PG8_WAIT_V(6); PG8_BAR; PG8_MMA(1, 1, At, B1); PG8_BAR;
            }
        }
        if constexpr (ALIGN_EPI) { if (wr == 0) PG8_BAR; }
        E(acc, cur, wr, wc, fr, fq);
        if constexpr (Epi::PUBLISH) {
            asm volatile("s_waitcnt vmcnt(0)" ::: "memory"); PG8_BAR;
            if (tid == 0) __hip_atomic_fetch_add(E.flag + cur.pm * 16, 1u, __ATOMIC_RELAXED, __HIP_MEMORY_SCOPE_AGENT);
        }
        if (!has_next) break;
#pragma unroll
        for (int a = 0; a < 2; ++a)
#pragma unroll
            for (int b = 0; b < 2; ++b)
#pragma unroll
                for (int m = 0; m < 4; ++m)
#pragma unroll
                    for (int n = 0; n < 2; ++n) acc[a][b][m][n] = (f32x4){0.f, 0.f, 0.f, 0.f};
        cur = nxt; cA = nA; cB = nB; ++ui;
        if constexpr (GATHER) { _Pragma("unroll") for (int h_ = 0; h_ < 2; ++h_) _Pragma("unroll") for (int i_ = 0; i_ < 2; ++i_) voffGc[h_][i_] = voffGn[h_][i_]; }
        if constexpr (ALIGN_EPI) { if (wr == 1) PG8_BAR; }
    }
    PG8_WAIT_V(0);
    if constexpr (!ALIGN_EPI) { if (wr == 0) PG8_BAR; }
    PG8_BAR;
#undef PG8_SA
#undef PG8_STAGE_A
#undef PG8_GOFF
#undef PG8_SB
#undef PG8_STAGE
#undef PG8_LDA
#undef PG8_LDB
#undef PG8_MMA
#undef PG8_WAIT_V
#undef PG8_WAIT_L
#undef PG8_BAR
#undef PG8_SCHED
}
}

#define XB_TMO      128
#define XB_XCNT(j)  (256  + 64 * (j))
#define XB_XSUB(j)  (1280 + 64 * (j))
#define XB_XGEN(j)  (2304 + 64 * (j))
#define XB_TOP      3328
#define XB_TOPGEN   3392
#define XCD_BAR_WORDS 3456
#define XB_SPIN_CAP (1u << 18)
__device__ __forceinline__ unsigned xb_ld(unsigned* p)              { return __hip_atomic_load(p, __ATOMIC_RELAXED, __HIP_MEMORY_SCOPE_AGENT); }
__device__ __forceinline__ unsigned xb_add(unsigned* p, unsigned v) { return __hip_atomic_fetch_add(p, v, __ATOMIC_RELAXED, __HIP_MEMORY_SCOPE_AGENT); }
__device__ __forceinline__ unsigned xb_xcc_id() { return (unsigned)__builtin_amdgcn_s_getreg((3 << 11) | 20) & 0xFu; }
#define XB_SPIN(cond, bar) do { unsigned _sp = 0; while (cond) { __builtin_amdgcn_s_sleep(1); \
    if ((++_sp & 255u) == 0u) { if (xb_ld(&(bar)[XB_TMO])) break; if (_sp > XB_SPIN_CAP) { atomicAdd(&(bar)[XB_TMO], 1u); break; } } } } while (0)
struct XcdBarrier { unsigned* bar; unsigned x; volatile LAS unsigned* st; };
__device__ __forceinline__ XcdBarrier xcd_barrier_post(unsigned* bar, volatile LAS unsigned* st) {
    XcdBarrier b; b.bar = bar; b.x = xb_xcc_id(); b.st = st;
    if (threadIdx.x == 0) (void)xb_add(&bar[XB_XCNT(b.x)], 1u);
    return b;
}
__device__ __forceinline__ void xcd_barrier_complete(unsigned* bar, unsigned x, unsigned& nloc, unsigned& nx) {
    const unsigned G = gridDim.x * gridDim.y * gridDim.z;
    unsigned sum, cnt, mine, sp = 0u;
    for (;;) {
        sum = 0u; cnt = 0u; mine = 0u;
#pragma unroll 1
        for (unsigned j = 0; j < 16; ++j) { const unsigned c = xb_ld(&bar[XB_XCNT(j)]); sum += c; cnt += (c > 0u) ? 1u : 0u; mine = (j == x) ? c : mine; }
        if (sum == G) break;
        __builtin_amdgcn_s_sleep(1);
        if ((++sp & 255u) == 0u) { if (xb_ld(&bar[XB_TMO])) break; if (sp > XB_SPIN_CAP) { atomicAdd(&bar[XB_TMO], 1u); break; } }
    }
    nloc = mine > 0u ? mine : 1u; nx = cnt > 0u ? cnt : 1u;
}
__device__ __forceinline__ void xcd_barrier(const XcdBarrier& b, const int tid) {
    asm volatile("s_waitcnt vmcnt(0)" ::: "memory");
    __syncthreads();
    if (tid == 0) {
        unsigned* bar = b.bar;
        __builtin_amdgcn_s_waitcnt(0);
        unsigned nloc = b.st[0], nx = b.st[1];
        if (nloc == 0u) { xcd_barrier_complete(bar, b.x, nloc, nx); b.st[0] = nloc; b.st[1] = nx; }
        const unsigned old = xb_add(&bar[XB_XSUB(b.x)], 1u);
        const unsigned gen = old / nloc;
        if (old + 1u == (gen + 1u) * nloc) {
            __builtin_amdgcn_fence(__ATOMIC_RELEASE, "agent");
            asm volatile("s_waitcnt vmcnt(0)" ::: "memory");
            const unsigned og = xb_add(&bar[XB_TOP], 1u);
            const unsigned tg = og / nx;
            if (og + 1u == (tg + 1u) * nx) xb_add(&bar[XB_TOPGEN], 1u);
            else XB_SPIN(xb_ld(&bar[XB_TOPGEN]) == tg, bar);
            __builtin_amdgcn_fence(__ATOMIC_ACQUIRE, "agent");
            xb_add(&bar[XB_XGEN(b.x)], 1u);
            asm volatile("s_waitcnt vmcnt(0)" ::: "memory");
        } else {
            XB_SPIN(xb_ld(&bar[XB_XGEN(b.x)]) == gen, bar);
            __builtin_amdgcn_fence(__ATOMIC_ACQUIRE, "agent");
            asm volatile("s_waitcnt vmcnt(0)" ::: "memory");
        }
    }
    __syncthreads();
}

struct Frame {
    LAS unsigned char* lds;
    volatile LAS unsigned* MISC;
    unsigned* ctl;
    int tid, lane, wave, vcu, G, bx;
    float* out; unsigned char* ws;
};
struct Args { const float* in[28]; float* out; unsigned char* ws; int ph_lo, ph_hi; };
enum { I_X = 0, I_C, I_ADAW, I_ADAB, I_N1G, I_N2G, I_WIN, I_BF, I_QNA, I_KNA, I_QNC, I_KNC, I_LQ1, I_LK1, I_LQ2, I_LK2, I_SUBLN, I_QND, I_KND, I_MIXB, I_WOUT,
       I_WG, I_BG, I_WE, I_BE, I_W1, I_W3, I_W2 };
template <int I> __device__ __forceinline__ const float* inp() {
    auto ka = __builtin_amdgcn_kernarg_segment_ptr(); unsigned long long raw;
    asm volatile("s_load_dwordx2 %0, %1, %2\n\ts_waitcnt lgkmcnt(0)" : "=s"(raw) : "s"(ka), "i"(I * 8));
    return (const float*)(const GAS float*)raw;
}


struct TItem { const float* W; bf16* WT; const float* rs; int ldw, K, dst_row0, src_n0, kb, mapin; };
__device__ __forceinline__ int colmap_in(int n) { return n < 768 ? n : (n < 2984 ? n + 4 : (n < 2988 ? n - 2984 + 768 : -1)); }
__device__ __forceinline__ void t_load(const TItem& T, f32x4 (&v)[8], int lane) {
    const int k0 = 64 * T.kb, r8 = lane >> 3, c4 = (lane & 7) * 4; const int sc = T.mapin ? colmap_in(T.src_n0 + c4) : T.src_n0 + c4;
#pragma unroll
    for (int i = 0; i < 8; ++i) { v[i] = (f32x4){0.f, 0.f, 0.f, 0.f}; if (sc >= 0) v[i] = *(const f32x4*)(T.W + (size_t)(k0 + 8 * r8 + i) * T.ldw + sc); }
}
__device__ __forceinline__ void t_store(const TItem& T, f32x4 (&v)[8], LAS float* scr, int lane) {
    (void)scr;
    const int k0 = 64 * T.kb, r8 = lane >> 3, c4 = (lane & 7) * 4;
    if (T.rs) {
#pragma unroll
        for (int i = 0; i < 8; ++i) v[i] = v[i] * T.rs[k0 + 8 * r8 + i]; }
#pragma unroll
    for (int c = 0; c < 4; ++c) { u32x4 o; o.x = pg8::cvt_pk_bf16(v[0][c], v[1][c]); o.y = pg8::cvt_pk_bf16(v[2][c], v[3][c]); o.z = pg8::cvt_pk_bf16(v[4][c], v[5][c]); o.w = pg8::cvt_pk_bf16(v[6][c], v[7][c]);
        *(GAS u32x4*)(T.WT + (size_t)(T.dst_row0 + c4 + c) * T.K + k0 + 8 * r8) = o; }
}
__device__ __forceinline__ float lambda_init(int l) { return l == 0 ? 0.2f : (0.8f - 0.6f * 0.7408182206817179f); }

constexpr int CI_IN = 16 * 96, CI_OUT = 16 * 32, CI_UP1 = 16 * 8, CI_DN = 4 * 32, CN_UP = 32 * 2 * CI_UP1, CN_DN = 32 * CI_DN, NITEMS_L = CI_IN + CI_OUT + CN_UP + CN_DN;
__device__ __forceinline__ void fill_rowscale(Frame& F, const Args& A, int l, LAS float* rsl) {
    for (int k = F.tid; k < DM; k += 512) { float v = inp<I_MIXB>()[l * DM + k];
        if (k >= 512 && k < 768) v *= inp<I_SUBLN>()[l * 64 + ((k - 512) & 63)] * (1.f - lambda_init(l)); rsl[k] = v; }
}
__device__ __forceinline__ void convert_items(Frame& F, const Args& A, int l, int first, int stride, int limit, LAS float* rsl) {
    LAS float* scr = (LAS float*)(F.lds + F.wave * 8704);
    bf16* WIN = (bf16*)(F.ws + WS_WIN); bf16* WOUT = (bf16*)(F.ws + WS_WOUT); bf16* WUP = (bf16*)(F.ws + WS_WUP); bf16* WDN = (bf16*)(F.ws + WS_WDN);
    auto decode = [&](int it, TItem& T) {
        int r = it; T.rs = nullptr; T.mapin = 0;
        if (r < CI_IN) { T.kb = r / 96; const int nb = r % 96;
            T.W = inp<I_WIN>() + (size_t)l * DM * P_IN; T.ldw = P_IN; T.K = DM; T.WT = WIN + (size_t)l * NP * DM; T.dst_row0 = 32 * nb; T.src_n0 = 32 * nb; T.mapin = 1; return; }
        r -= CI_IN;
        if (r < CI_OUT) { T.kb = r / 32; const int nb = r % 32;
            T.W = inp<I_WOUT>() + (size_t)l * DM * DM; T.ldw = DM; T.K = DM; T.WT = WOUT + (size_t)l * DM * DM; T.dst_row0 = 32 * nb; T.src_n0 = 32 * nb; T.rs = (const float*)rsl; return; }
        r -= CI_OUT;
        if (r < CN_UP) { const int le = l * 32 + r / (2 * CI_UP1), q = r % (2 * CI_UP1), which = q / CI_UP1, q2 = q % CI_UP1; T.kb = q2 / 8; const int nb = q2 % 8;
            T.W = (which == 0 ? inp<I_W1>() : inp<I_W3>()) + (size_t)le * DM * FF; T.ldw = FF; T.K = DM; T.WT = WUP + (size_t)le * 512 * DM;
            const int n0 = 32 * nb, pn = n0 >> 7, j = n0 & 127; T.dst_row0 = 256 * pn + 128 * which + j; T.src_n0 = n0; return; }
        r -= CN_UP;
        { const int le = l * 32 + r / CI_DN, q = r % CI_DN; T.kb = q / 32; const int nb = q % 32;
          T.W = inp<I_W2>() + (size_t)le * FF * DM; T.ldw = DM; T.K = FF; T.WT = WDN + (size_t)le * DM * FF; T.dst_row0 = 32 * nb; T.src_n0 = 32 * nb; }
    };
    TItem T0, T1, T2; f32x4 v0[8], v1[8], v2[8]; int it = first;
    if (it < limit) { decode(it, T0); t_load(T0, v0, F.lane); }
    if (it + stride < limit) { decode(it + stride, T1); t_load(T1, v1, F.lane); }
    while (it < limit) {
        if (it + 2 * stride < limit) { decode(it + 2 * stride, T2); t_load(T2, v2, F.lane); }
        t_store(T0, v0, scr, F.lane); it += stride; if (it >= limit) break;
        if (it + 2 * stride < limit) { decode(it + 2 * stride, T0); t_load(T0, v0, F.lane); }
        t_store(T1, v1, scr, F.lane); it += stride; if (it >= limit) break;
        if (it + 2 * stride < limit) { decode(it + 2 * stride, T1); t_load(T1, v1, F.lane); }
        t_store(T2, v2, scr, F.lane); it += stride;
    }
}
constexpr int CV_L0 = NITEMS_L - CI_IN, CV_TOTAL = CV_L0 + NITEMS_L, CV_CHUNK = 64, CW_CVQ = 192;
__device__ __forceinline__ void convert_chunk(Frame& F, const Args& A, int gbase, LAS float* rsl2  ) {
    const int g0 = gbase + F.wave * (CV_CHUNK / NWAVES);
#pragma unroll 1
    for (int l = 0; l < 2; ++l) {
        const int lo = g0 > (l ? CV_L0 : 0) ? g0 : (l ? CV_L0 : 0), hi0 = g0 + CV_CHUNK / NWAVES, hi = hi0 < (l ? CV_TOTAL : CV_L0) ? hi0 : (l ? CV_TOTAL : CV_L0);
        if (lo < hi) { const int off = l ? -CV_L0 : CI_IN; convert_items(F, A, l, lo + off, 1, hi + off, rsl2 + l * DM); }
    }
}
__device__ __forceinline__ void convert_layer1_in_gap(Frame& F, const Args& A, int n2  ) {
    LAS float* rsl = (LAS float*)(F.lds + 8 * 8704);
    if (n2 < 0) n2 = 0; if (n2 > F.G - 32) n2 = F.G - 32;
    if (F.bx < n2) return;
    fill_rowscale(F, A, 1, rsl);
    __syncthreads();
    const int nw = (F.G - n2) * NWAVES;
    convert_items(F, A, 1, (F.bx - n2) * NWAVES + F.wave, nw, NITEMS_L, rsl);
    __syncthreads();
}

__device__ __forceinline__ void p0_prologue(Frame& F, const Args& A) {
    LAS float* rsl = (LAS float*)(F.lds + 8 * 8704);
    fill_rowscale(F, A, 0, rsl);
    __syncthreads();
    const int gw = F.vcu * NWAVES + F.wave, NGW = F.G * NWAVES;
    convert_items(F, A, 0, gw, NGW, BG_CONVERT ? CI_IN : NITEMS_L, rsl);
    if (!GAP_CONVERT && !BG_CONVERT) { __syncthreads(); fill_rowscale(F, A, 1, rsl); __syncthreads(); convert_items(F, A, 1, gw, NGW, NITEMS_L, rsl); }
    { bf16* WRH = (bf16*)(F.ws + WS_WR); bf16* WRL = WRH + 2 * 48 * DM;
      for (int i = gw * 64 + F.lane; i < 2 * 48 * DM; i += NGW * 64) { const int l = i / (48 * DM), r = i % (48 * DM), o = r >> 10, k = r & 1023;
          float w = 0.f; if (o < 4) w = inp<I_WG>()[((size_t)l * DM + k) * 4 + o]; else if (o < 36) w = inp<I_WE>()[((size_t)l * DM + k) * 32 + (o - 4)];
          const unsigned hi = f2bf(w); WRH[i] = (bf16)hi; WRL[i] = (bf16)f2bf(w - bf2f((unsigned short)hi)); } }
    if (F.bx == 0 && F.wave == 0) {
        for (int l = 0; l < 2; ++l) { float a = 0.f, b = 0.f; if (F.lane < 32) { a = inp<I_LQ1>()[l * 32 + F.lane] * inp<I_LK1>()[l * 32 + F.lane]; b = inp<I_LQ2>()[l * 32 + F.lane] * inp<I_LK2>()[l * 32 + F.lane]; }
            a = wave_sum(a); b = wave_sum(b); if (F.lane == 0) ((float*)(F.ws + WS_MISC))[l] = __expf(a) - __expf(b) + lambda_init(l); }
    }
    __syncthreads();
    LAS float* cact = (LAS float*)F.lds;
    LAS float* red = (LAS float*)(F.lds + 32768);
    for (int i = F.tid; i < BATCH * DM; i += 512) { const float c = inp<I_C>()[i]; cact[i] = c / (1.f + __expf(-c)); }
    __syncthreads();
    for (int item = F.bx; item < 2 * 96; item += F.G) {
        const int l = item / 96, nb = item % 96, n = nb * 64 + F.lane; const float* aw = inp<I_ADAW>() + (size_t)l * DM * 6144 + n;
        float acc[8];
#pragma unroll
        for (int b = 0; b < 8; ++b) acc[b] = 0.f;
        const int k0 = F.wave * 128;
#pragma unroll 64
        for (int k = 0; k < 128; ++k) { const float w = aw[(size_t)(k0 + k) * 6144];
#pragma unroll
            for (int b = 0; b < 8; ++b) acc[b] += cact[b * DM + k0 + k] * w; }
#pragma unroll
        for (int b = 0; b < 8; ++b) red[(F.wave * 8 + b) * 64 + F.lane] = acc[b];
        __syncthreads();
        { const int b = F.wave; float s = inp<I_ADAB>()[l * 6144 + n];
#pragma unroll
          for (int w = 0; w < 8; ++w) s += red[(w * 8 + b) * 64 + F.lane];
          ((float*)(F.ws + WS_MOD))[((size_t)l * 8 + b) * 6144 + n] = s; }
        __syncthreads();
    }
}

__device__ __forceinline__ void build_tables(Frame& F, int l) {
    volatile LAS int* cnts = (volatile LAS int*)(F.lds + CNTS_OFF); volatile LAS int* base = (volatile LAS int*)(F.lds + BASE_OFF); volatile LAS int* tab = (volatile LAS int*)(F.lds + TAB_OFF);
    __syncthreads();
    if (F.tid < 64) {
        const int e = F.tid; int cnt = 0; if (e < 32) cnt = (int)__hip_atomic_load(F.ctl + CW_CNT + (l * 32 + e) * 16, RLX_AGENT);
        const int n = (cnt + 255) >> 8; int incl = n;
#pragma unroll
        for (int o = 1; o < 32; o <<= 1) { const int u = shup_i(incl, o, e); if (e >= o) incl += u; }
        const int t0 = incl - n;
        if (e < 32) { cnts[e] = cnt; base[e] = t0; for (int j = 0; j < n && t0 + j < MAXTILE; ++j) tab[t0 + j] = e; }
        if (e == 31) F.MISC[1] = (unsigned)(incl < MAXTILE ? incl : MAXTILE);
    }
    __syncthreads();
}
__device__ __forceinline__ void row_pass(Frame& F, const Args& A, int mode, int l) {
    const int gw = F.vcu * NWAVES + F.wave; const int lane = F.lane;
    const float* MOD = (const float*)(F.ws + WS_MOD);
    bf16* X1 = (bf16*)(F.ws + WS_X1); bf16* H = (bf16*)(F.ws + WS_H); const bf16* Y = (const bf16*)(F.ws + WS_Y);
    const int* tok_e = (const int*)(F.ws + WS_TOK); const int* tok_pos = (const int*)(F.ws + WS_TOK) + 4 * M; const float* tok_w = (const float*)(F.ws + WS_TOK) + 2 * M;
    volatile LAS int* basel = (volatile LAS int*)(F.lds + BASE_OFF);
    int pe_a[4], pe_b[4], pp_a[4], pp_b[4]; float pw_a[4], pw_b[4];
    const auto ldtok = [&](int m0) {
#pragma unroll
        for (int r = 0; r < 4; ++r) { const int m = m0 + r; pe_a[r] = tok_e[m]; pe_b[r] = tok_e[M + m]; pp_a[r] = tok_pos[m]; pp_b[r] = tok_pos[M + m]; pw_a[r] = tok_w[m]; pw_b[r] = tok_w[M + m]; } };
    if (mode != 0) { ldtok(gw * 8); build_tables(F, mode == 1 ? 0 : 1); }
    const int b = (gw * 8) >> 11; const int lp = (mode == 1) ? 0 : 1;
    f32x4 g2v[4], gm[4], shv[4];
#pragma unroll
    for (int j = 0; j < 4; ++j) { const int col = 256 * j + 4 * lane;
        g2v[j] = (f32x4){0.f, 0.f, 0.f, 0.f}; gm[j] = g2v[j]; shv[j] = g2v[j];
        if (mode != 0) g2v[j] = *(const f32x4*)(MOD + ((size_t)lp * 8 + b) * 6144 + 5 * DM + col);
        if (mode != 2) { const float* md = MOD + ((size_t)l * 8 + b) * 6144; gm[j] = *(const f32x4*)(inp<I_N1G>() + l * DM + col) * (*(const f32x4*)(md + DM + col) + 1.0f); shv[j] = *(const f32x4*)(md + col); } }
    for (int m0 = gw * 8; m0 < gw * 8 + 8; m0 += 4) {
        f32x4 v[4][4]; u32x2 ya[4][4], yb[4][4]; float wa[4], wb[4];
        if (mode != 0) {
            int sa[4], sb[4];
#pragma unroll
            for (int r = 0; r < 4; ++r) { sa[r] = 256 * basel[pe_a[r]] + pp_a[r]; sb[r] = 256 * basel[pe_b[r]] + pp_b[r]; wa[r] = pw_a[r]; wb[r] = pw_b[r]; }
#pragma unroll
            for (int r = 0; r < 4; ++r)
#pragma unroll
                for (int j = 0; j < 4; ++j) { const int col = 256 * j + 4 * lane; ya[r][j] = *(const u32x2*)(Y + (size_t)sa[r] * DM + col); yb[r][j] = *(const u32x2*)(Y + (size_t)sb[r] * DM + col); }
            if (m0 == gw * 8) ldtok(m0 + 4);
        }
#pragma unroll
        for (int r = 0; r < 4; ++r) { const int m = m0 + r;
            if (mode == 0) { const float* xr = inp<I_X>() + (size_t)m * DM;
#pragma unroll
                for (int j = 0; j < 4; ++j) v[r][j] = *(const f32x4*)(xr + 256 * j + 4 * lane); }
            else { const bf16* xr = X1 + (size_t)m * DM;
#pragma unroll
                for (int j = 0; j < 4; ++j) { const u32x2 q = *(const u32x2*)(xr + 256 * j + 4 * lane); v[r][j] = (f32x4){bf2f(q.x & 0xffff), bf2f(q.x >> 16), bf2f(q.y & 0xffff), bf2f(q.y >> 16)}; } } }
#pragma unroll
        for (int r = 0; r < 4; ++r) { const int m = m0 + r;
            if (mode != 0) {
#pragma unroll
                for (int j = 0; j < 4; ++j) { const u32x2 a = ya[r][j], c = yb[r][j];
                    f32x4 mo; mo[0] = wa[r] * bf2f(a.x & 0xffff) + wb[r] * bf2f(c.x & 0xffff); mo[1] = wa[r] * bf2f(a.x >> 16) + wb[r] * bf2f(c.x >> 16);
                    mo[2] = wa[r] * bf2f(a.y & 0xffff) + wb[r] * bf2f(c.y & 0xffff); mo[3] = wa[r] * bf2f(a.y >> 16) + wb[r] * bf2f(c.y >> 16);
                    v[r][j] = v[r][j] + g2v[j] * mo; }
                if (mode == 1) {
#pragma unroll
                    for (int j = 0; j < 4; ++j) { u32x2 q; q.x = pk2(v[r][j][0], v[r][j][1]); q.y = pk2(v[r][j][2], v[r][j][3]); *(u32x2*)(X1 + (size_t)m * DM + 256 * j + 4 * lane) = q; }
                } else { float* orow = F.out + (size_t)m * DM;
#pragma unroll
                    for (int j = 0; j < 4; ++j) *(f32x4*)(orow + 256 * j + 4 * lane) = v[r][j]; }
            }
            if (mode != 2) {
                float ss = 0.f;
#pragma unroll
                for (int j = 0; j < 4; ++j) ss += (v[r][j][0] * v[r][j][0] + v[r][j][1] * v[r][j][1]) + (v[r][j][2] * v[r][j][2] + v[r][j][3] * v[r][j][3]);
                const float rstd = 1.0f / sqrtf(wave_sum(ss) * (1.f / DM) + RMS_EPS);
#pragma unroll
                for (int j = 0; j < 4; ++j) { const f32x4 hv = v[r][j] * rstd * gm[j] + shv[j]; u32x2 w; w.x = pk2(hv[0], hv[1]); w.y = pk2(hv[2], hv[3]);
                    *(u32x2*)(H + (size_t)m * DM + 256 * j + 4 * lane) = w; }
            }
        }
    }
}

__device__ __forceinline__ void knorm_seg(bf16* p, int lane, int nlanes_active, int group_lanes, const float* gain, int gmask, float inv_n) {
    u32x2 raw = (u32x2){0u, 0u}; if (lane < nlanes_active) raw = *(const u32x2*)(p + 4 * lane);
    float x0 = bf2f(raw.x & 0xffff), x1 = bf2f(raw.x >> 16), x2 = bf2f(raw.y & 0xffff), x3 = bf2f(raw.y >> 16);
    float ss = (x0 * x0 + x1 * x1) + (x2 * x2 + x3 * x3);
    for (int o = 1; o < group_lanes; o <<= 1) ss += __shfl_xor(ss, o);
    const float rstd = 1.0f / sqrtf(ss * inv_n + RMS_EPS);
    const int c = (4 * lane) & gmask;
    x0 *= rstd * gain[c]; x1 *= rstd * gain[c + 1]; x2 *= rstd * gain[c + 2]; x3 *= rstd * gain[c + 3];
    if (lane < nlanes_active) { u32x2 w; w.x = pk2(x0, x1); w.y = pk2(x2, x3); *(u32x2*)(p + 4 * lane) = w; }
}
__device__ __forceinline__ unsigned sortable(float f) { const unsigned u = __builtin_bit_cast(unsigned, f); return (u & 0x80000000u) ? ~u : (u | 0x80000000u); }


__device__ __forceinline__ int wave_sum_i(int v) {
    v += __builtin_amdgcn_update_dpp(0, v, 0xB1, 0xF, 0xF, true);
    v += __builtin_amdgcn_update_dpp(0, v, 0x4E, 0xF, 0xF, true);
    v += __builtin_amdgcn_update_dpp(0, v, 0x141, 0xF, 0xF, true);
    v += __builtin_amdgcn_update_dpp(0, v, 0x140, 0xF, 0xF, true);
    return __builtin_amdgcn_readlane(v, 0) + __builtin_amdgcn_readlane(v, 16) + __builtin_amdgcn_readlane(v, 32) + __builtin_amdgcn_readlane(v, 48);
}
__device__ __forceinline__ void transpose32(unsigned (&a)[32]) {
#define TSTAGE(S, MSK) _Pragma("unroll") for (int i = 0; i < 32; ++i) if (!(i & S)) { const unsigned x = a[i], y = a[i + S]; a[i] = (x & MSK) | ((y << S) & ~MSK); a[i + S] = ((x >> S) & MSK) | (y & ~MSK); }
    TSTAGE(16, 0x0000FFFFu) TSTAGE(8, 0x00FF00FFu) TSTAGE(4, 0x0F0F0F0Fu) TSTAGE(2, 0x33333333u) TSTAGE(1, 0x55555555u)
#undef TSTAGE
}
__device__ __forceinline__ void sel_step(unsigned T, unsigned& cand, unsigned& above, int& na, int& nc, bool& done, bool& exact) {
    const unsigned ones = cand & T; const int s1 = wave_sum_i(__builtin_popcount(ones));
    if (na + s1 >= 256) { cand = ones; nc = s1; }
    else { above |= ones; na += s1; cand &= ~T; nc -= s1; }
    if (na + nc == 256) { done = true; exact = true; }
}
__device__ __forceinline__ unsigned sel_finish(unsigned cand, unsigned above, int na, bool exact, int lane) {
    if (exact) return above | cand;
    const int need = 256 - na; const int pc = __builtin_popcount(cand); int incl = pc;
#pragma unroll
    for (int o = 1; o < 64; o <<= 1) { const int t = shup_i(incl, o, lane); if (lane >= o) incl += t; }
    int take = need - (incl - pc); take = take < 0 ? 0 : (take > pc ? pc : take);
    unsigned w = cand, res = above;
    for (int k = 0; k < take; ++k) { const unsigned low = w & (0u - w); res |= low; w ^= low; }
    return res;
}

__device__ __forceinline__ void p3_prep(Frame& F, const Args& A, int l, int rep) {
    const int gw = F.vcu * NWAVES + F.wave, NGW = F.G * NWAVES;
    bf16* PROJ = (bf16*)(F.ws + WS_PROJ);
    if (!(rep > 0 && PROBE_P3_PART == 2)) { const float* ga = inp<I_KNA>() + l * 64; const float* gc = inp<I_KNC>() + l * 32; const float* gd = inp<I_KND>() + l * 64;
      const int la = F.lane; const int ca = (4 * la) & 63, cc = (4 * la) & 31;
      const f32x4 gva = *(const f32x4*)(ga + ca), gvc = *(const f32x4*)(gc + cc), gvd = *(const f32x4*)(gd + ca);
      for (int mb = gw * 8; mb < gw * 8 + 8; mb += 8) {
        u32x2 ra[8], rc[8], rd[8];
#pragma unroll
        for (int i = 0; i < 8; ++i) { bf16* row = PROJ + (size_t)(mb + i) * NP; ra[i] = *(const u32x2*)(row + C_AK + 4 * la); rc[i] = *(const u32x2*)(row + C_CK + 4 * la);
            rd[i] = (u32x2){0u, 0u}; if (la < 16) rd[i] = *(const u32x2*)(row + C_DK + 4 * la); }
#pragma unroll
        for (int i = 0; i < 8; ++i) { bf16* row = PROJ + (size_t)(mb + i) * NP;
            { float x0 = bf2f(ra[i].x & 0xffff), x1 = bf2f(ra[i].x >> 16), x2 = bf2f(ra[i].y & 0xffff), x3 = bf2f(ra[i].y >> 16); float ss = (x0 * x0 + x1 * x1) + (x2 * x2 + x3 * x3);
              ss += shx<1>(ss); ss += shx<2>(ss); ss += shx<4>(ss); ss += shx<8>(ss); const float rs = 1.0f / sqrtf(ss * (1.f / 64.f) + RMS_EPS);
              u32x2 w; w.x = pk2(x0 * rs * gva[0], x1 * rs * gva[1]); w.y = pk2(x2 * rs * gva[2], x3 * rs * gva[3]); *(u32x2*)(row + C_AK + 4 * la) = w; }
            { float x0 = bf2f(rc[i].x & 0xffff), x1 = bf2f(rc[i].x >> 16), x2 = bf2f(rc[i].y & 0xffff), x3 = bf2f(rc[i].y >> 16); float ss = (x0 * x0 + x1 * x1) + (x2 * x2 + x3 * x3);
              ss += shx<1>(ss); ss += shx<2>(ss); ss += shx<4>(ss); const float rs = 1.0f / sqrtf(ss * (1.f / 32.f) + RMS_EPS);
              u32x2 w; w.x = pk2(x0 * rs * gvc[0], x1 * rs * gvc[1]); w.y = pk2(x2 * rs * gvc[2], x3 * rs * gvc[3]); *(u32x2*)(row + C_CK + 4 * la) = w; }
            { float x0 = bf2f(rd[i].x & 0xffff), x1 = bf2f(rd[i].x >> 16), x2 = bf2f(rd[i].y & 0xffff), x3 = bf2f(rd[i].y >> 16); float ss = (x0 * x0 + x1 * x1) + (x2 * x2 + x3 * x3);
              ss += shx<1>(ss); ss += shx<2>(ss); ss += shx<4>(ss); ss += shx<8>(ss); const float rs = 1.0f / sqrtf(ss * (1.f / 64.f) + RMS_EPS);
              u32x2 w; w.x = pk2(x0 * rs * gvd[0], x1 * rs * gvd[1]); w.y = pk2(x2 * rs * gvd[2], x3 * rs * gvd[3]); if (la < 16) *(u32x2*)(row + C_DK + 4 * la) = w; }
        }
      }
    }
    if (!(rep > 0 && PROBE_P3_PART == 2)) {
        const int bh = gw >> 6, ck = gw & 63, b = bh >> 2, h = bh & 3; const float bfv = inp<I_BF>()[l * 4 + h];
        const int t = 32 * ck + (F.lane & 31);
        const float x = bf2f(PROJ[((size_t)b * SEQ + t) * NP + C_AF + h]) + bfv;
        float incl = fminf(x, 0.f) - log1pf(__expf(-fabsf(x)));
#pragma unroll
        for (int o = 1; o < 32; o <<= 1) { const float u = shup(incl, o, F.lane); if ((F.lane & 31) >= o) incl += u; }
        float* cum = (float*)(F.ws + WS_CUM);
        if (F.lane < 32) cum[(size_t)bh * SEQ + t] = incl;
        if (F.lane == 31) cum[32 * SEQ + bh * 64 + ck] = incl;
    }
    LAS float* sc = (LAS float*)F.lds;
    unsigned* MASK = (unsigned*)(F.ws + WS_MASK);
    constexpr int SCP = 2052;
    const int lane = F.lane, kq = lane >> 4, qi = lane & 15;
    __syncthreads();
    bf16x8 bq[8], wvr, akv[16];
    const auto unit_geom = [&](int i, int& b, int& t0, int& nkt) { const int u = F.bx + 256 * i; b = u >> 7; const int tqr = u & 127, tq = (i & 1) ? 127 - tqr : tqr; t0 = tq * 16; nkt = tq + 1; };
    const auto unit_load_q = [&](int i) { int b, t0, nkt; unit_geom(i, b, t0, nkt); const bf16* qrow = PROJ + (size_t)b * SEQ * NP + (size_t)(t0 + qi) * NP;
#pragma unroll
        for (int h = 0; h < 8; ++h) bq[h] = *(const bf16x8*)(qrow + C_IQ + h * 32 + 8 * kq);
        wvr = *(const bf16x8*)(qrow + C_IW); };
    const auto unit_load_k = [&](int i) { int b, t0, nkt; unit_geom(i, b, t0, nkt); const bf16* pb = PROJ + (size_t)b * SEQ * NP;
#pragma unroll
        for (int j = 0; j < 16; ++j) { const int kt = F.wave + 8 * j; akv[j] = (bf16x8){0, 0, 0, 0, 0, 0, 0, 0}; if (kt < nkt) akv[j] = *(const bf16x8*)(pb + (size_t)(kt * 16 + qi) * NP + C_IK + 8 * kq); } };
    const bool do_c = !(rep > 0 && PROBE_P3_PART == 1);
    if (do_c) unit_load_q(0);
    for (int i = 0; i < 4; ++i) {
        if (!do_c) break;
        int b, t0, nkt; unit_geom(i, b, t0, nkt);
        unit_load_k(i);
        float wq[8];
#pragma unroll
        for (int h = 0; h < 8; ++h) wq[h] = bf2f((unsigned short)wvr[h]) * (0.35355339059327373f * 0.17677669529663687f);
#pragma unroll
        for (int j = 0; j < 16; ++j) { const int kt = F.wave + 8 * j;
            if (kt < nkt) {
            f32x4 a4 = (f32x4){0.f, 0.f, 0.f, 0.f};
#pragma unroll
            for (int h = 0; h < 8; ++h) { const f32x4 s = __builtin_amdgcn_mfma_f32_16x16x32_bf16(akv[j], bq[h], (f32x4){0.f, 0.f, 0.f, 0.f}, 0, 0, 0);
#pragma unroll
                for (int r = 0; r < 4; ++r) a4[r] += wq[h] * fmaxf(s[r], 0.f); }
#pragma unroll
            for (int r = 0; r < 4; ++r) a4[r] += 0.f;
            { const int ci = kt * 4 + kq, L = ci >> 3, c = ci & 7;
              *(LAS f32x4*)(sc + qi * SCP + 4 * (L * 8 + (c ^ (L & 7)))) = a4; }
            } }
        if (i + 1 < 4) unit_load_q(i + 1);
        LDS_WAIT(); __syncthreads();
        if (rep > 0 && PROBE_P3_PART == 2) { }
        else if (t0 < 256) {
            for (int rr = 0; rr < 2; ++rr) { const int t = t0 + 2 * F.wave + rr; const int nb = t - 32 * lane + 1;
                MASK[((size_t)b * SEQ + t) * 64 + lane] = nb >= 32 ? 0xffffffffu : (nb <= 0 ? 0u : ((1u << nb) - 1u)); }
        } else {
            const int rA = 2 * F.wave, tA = t0 + rA, tB = tA + 1;
            unsigned ua[32], ub[32];
#pragma unroll
            for (int c = 0; c < 8; ++c) { const int off = 4 * (lane * 8 + (c ^ (lane & 7)));
                const f32x4 fa = *(const LAS f32x4*)(sc + rA * SCP + off), fb = *(const LAS f32x4*)(sc + (rA + 1) * SCP + off);
#pragma unroll
                for (int i = 0; i < 4; ++i) { ua[c * 4 + i] = sortable(fa[i]); ub[c * 4 + i] = sortable(fb[i]); } }
            transpose32(ua); transpose32(ub);
            unsigned candA, candB, abA = 0u, abB = 0u; int naA = 0, naB = 0, ncA = tA + 1, ncB = tB + 1; bool dA = false, dB = false, eA = false, eB = false;
            { const int nbA = tA - 32 * lane + 1, nbB = tB - 32 * lane + 1;
              candA = nbA >= 32 ? 0xffffffffu : (nbA <= 0 ? 0u : ((1u << nbA) - 1u)); candB = nbB >= 32 ? 0xffffffffu : (nbB <= 0 ? 0u : ((1u << nbB) - 1u)); }
#pragma unroll
            for (int bit = 31; bit >= 0; --bit) {
                if (!dA) sel_step(ua[bit], candA, abA, naA, ncA, dA, eA);
                if (!dB) sel_step(ub[bit], candB, abB, naB, ncB, dB, eB);
                if (dA && dB) break;
            }
            MASK[((size_t)b * SEQ + tA) * 64 + lane] = sel_finish(candA, abA, naA, eA, lane);
            MASK[((size_t)b * SEQ + tB) * 64 + lane] = sel_finish(candB, abB, naB, eB, lane);
        }
        __syncthreads();
    }
}

namespace att {
template <bool B> struct BoolC { static constexpr bool value = B; };
constexpr int SLOTB = 8192, L_K = 0, L_V = 3 * SLOTB, L_WS = 6 * SLOTB, L_OST = L_WS + 2048, L_CUM = L_OST + 8 * 8192, L_END = L_CUM + 8192;
constexpr int MROW = 66;
static_assert(L_OST + 256 * MROW * 4 <= L_END && L_END <= RING_BYTES, "attention LDS map");
constexpr float THR = 8.0f;
__device__ __forceinline__ int crow(int r, int hi) { return (r & 3) + 8 * (r >> 2) + 4 * hi; }
__device__ __forceinline__ void glds16(const void* gsrc, unsigned lds_dst) { unsigned keep;
    asm volatile("s_mov_b32 %0, m0\n\ts_mov_b32 m0, %2\n\ts_nop 0\n\tglobal_load_lds_dwordx4 %1, off\n\ts_mov_b32 m0, %0" : "=&s"(keep) : "v"(gsrc), "s"(lds_dst) : "memory"); }
#define ATT_WAIT_BAR() asm volatile("s_waitcnt vmcnt(0) lgkmcnt(0)\n\ts_barrier" ::: "memory")
__device__ __forceinline__ unsigned cvtpk_s(float lo, float hi) { typedef __bf16 bf16x2_t __attribute__((ext_vector_type(2))); f32x2 v = {lo, hi}; bf16x2_t b = __builtin_convertvector(v, bf16x2_t); return __builtin_bit_cast(unsigned, b); }
__device__ __forceinline__ float xhalf(float x, int hi) { auto rr = __builtin_amdgcn_permlane32_swap(__builtin_bit_cast(unsigned, x), __builtin_bit_cast(unsigned, x), false, false);
    return __builtin_bit_cast(float, hi ? rr[0] : rr[1]); }
template <int DA, int DB>
__device__ __forceinline__ void qkt(f32x16& p0, f32x16& p1, const LAS char* Kslot, const bf16x8* qr, const f32x16& cin, int r32, int hi) {
    const LAS char* kb = Kslot + hi * 1024 + r32 * 16;
#pragma unroll
    for (int d0 = DA; d0 < DB; ++d0) {
        const bf16x8 b0 = *(const LAS bf16x8*)(kb + d0 * 2048), b1 = *(const LAS bf16x8*)(kb + d0 * 2048 + 512);
        if (d0 == DA) { p0 = __builtin_amdgcn_mfma_f32_32x32x16_bf16(b0, qr[d0], cin, 0, 0, 0); p1 = __builtin_amdgcn_mfma_f32_32x32x16_bf16(b1, qr[d0], cin, 0, 0, 0); }
        else { p0 = __builtin_amdgcn_mfma_f32_32x32x16_bf16(b0, qr[d0], p0, 0, 0, 0); p1 = __builtin_amdgcn_mfma_f32_32x32x16_bf16(b1, qr[d0], p1, 0, 0, 0); } }
}
__device__ __forceinline__ void pv(f32x16* o, int vb, bf16x8 pa0, bf16x8 pa1, bf16x8 pa2, bf16x8 pa3) {
    s16x4 lo[2][4], hi[2][4];
#pragma unroll
    for (int d0 = 0; d0 < 2; ++d0)
#pragma unroll
        for (int ks = 0; ks < 4; ++ks) {
            asm volatile("ds_read_b64_tr_b16 %0,%1 offset:%c2" : "=&v"(lo[d0][ks]) : "v"(vb), "i"(d0 * 4096 + ks * 1024) : "memory");
            asm volatile("ds_read_b64_tr_b16 %0,%1 offset:%c2" : "=&v"(hi[d0][ks]) : "v"(vb), "i"(d0 * 4096 + ks * 1024 + 512) : "memory"); }
    asm volatile("s_waitcnt lgkmcnt(0)" ::: "memory"); __builtin_amdgcn_sched_barrier(0);
#define PK(d, k) (bf16x8){lo[d][k][0], lo[d][k][1], lo[d][k][2], lo[d][k][3], hi[d][k][0], hi[d][k][1], hi[d][k][2], hi[d][k][3]}
    o[0] = __builtin_amdgcn_mfma_f32_32x32x16_bf16(pa0, PK(0, 0), o[0], 0, 0, 0); o[1] = __builtin_amdgcn_mfma_f32_32x32x16_bf16(pa0, PK(1, 0), o[1], 0, 0, 0);
    o[0] = __builtin_amdgcn_mfma_f32_32x32x16_bf16(pa1, PK(0, 1), o[0], 0, 0, 0); o[1] = __builtin_amdgcn_mfma_f32_32x32x16_bf16(pa1, PK(1, 1), o[1], 0, 0, 0);
    o[0] = __builtin_amdgcn_mfma_f32_32x32x16_bf16(pa2, PK(0, 2), o[0], 0, 0, 0); o[1] = __builtin_amdgcn_mfma_f32_32x32x16_bf16(pa2, PK(1, 2), o[1], 0, 0, 0);
    o[0] = __builtin_amdgcn_mfma_f32_32x32x16_bf16(pa3, PK(0, 3), o[0], 0, 0, 0); o[1] = __builtin_amdgcn_mfma_f32_32x32x16_bf16(pa3, PK(1, 3), o[1], 0, 0, 0);
#undef PK
}
__device__ __forceinline__ float rowmax(const f32x16& p0, const f32x16& p1, int hi) {
    float a = fmaxf(fmaxf(p0[0], p0[1]), p1[0]), b = fmaxf(fmaxf(p0[2], p0[3]), p1[1]); a = fmaxf(fmaxf(a, p1[2]), p1[3]);
#pragma unroll
    for (int r = 4; r < 16; r += 4) { a = fmaxf(fmaxf(a, p0[r]), p0[r + 1]); b = fmaxf(fmaxf(b, p0[r + 2]), p0[r + 3]); a = fmaxf(fmaxf(a, p1[r]), p1[r + 1]); b = fmaxf(fmaxf(b, p1[r + 2]), p1[r + 3]); }
    const float m = fmaxf(a, b); return fmaxf(m, xhalf(m, hi));
}
struct AttnP { const bf16* proj; bf16* mix; const float* cum; const unsigned* mask; const float* qgain[4]; const float* kgain[4]; float lam; unsigned* cvq; };

template <int VAR>
__device__ __forceinline__ void attn_unit(const AttnP& P, int b, int h, int qb, LAS char* sh, const int tid_in, const int pm, unsigned* qctr, volatile LAS unsigned* qslot) {
    int tid = tid_in; asm volatile("" : "+v"(tid));
    const int lane = tid & 63, r32 = lane & 31, hi = lane >> 5; const int wid = __builtin_amdgcn_readfirstlane(tid >> 6);
    const long rowbase = (long)b * SEQ; const int q0 = qb * 256, NT = 4 * (qb + 1);
    const int qrel = wid * 32 + r32, tq = q0 + qrel;
    constexpr bool REV = VAR != 0;
    constexpr int QCB = VAR == 0 ? C_AQ : VAR == 1 ? C_BQ : VAR == 2 ? C_CQ : C_DQ;
    constexpr int KCB = VAR == 0 ? C_AK : VAR == 1 ? C_BK : VAR == 2 ? C_CK : C_DK;
    constexpr int VCB = VAR == 0 ? C_AV : VAR == 1 ? C_BV : VAR == 2 ? C_CV : C_DV;
    const int Qc = QCB + 64 * h, Kc = VAR == 3 ? KCB : KCB + 64 * h, Vc = VAR == 3 ? VCB : VCB + 64 * h;
    const bf16* PR = P.proj;
    LAS float* wsf = (LAS float*)(sh + L_WS) + wid * 64;
    LAS float* stg = (LAS float*)(sh + L_OST) + wid * 2048;
    LAS float* cumL = (LAS float*)(sh + L_CUM);
    LAS unsigned* maskL = (LAS unsigned*)(sh + L_OST);
    const unsigned lds0 = (unsigned)(uintptr_t)sh;
    const bf16* ksrc = PR + (size_t)(rowbase + lane) * NP + Kc + wid * 8;
    const bf16* vsrc = PR + (size_t)(rowbase + 16 * (wid & 3) + (lane >> 2)) * NP + Vc + (wid >> 2) * 32 + (lane & 3) * 8;
    const unsigned kdst = lds0 + L_K + wid * 1024, vdst = lds0 + L_V + wid * 1024;
#define DMA_KV(t, slot) do { glds16(ksrc + (size_t)(t) * 64 * NP, (unsigned)__builtin_amdgcn_readfirstlane(kdst + (slot))); glds16(vsrc + (size_t)(t) * 64 * NP, (unsigned)__builtin_amdgcn_readfirstlane(vdst + (slot))); } while (0)
    DMA_KV(REV ? NT - 1 : 0, 0); DMA_KV(REV ? NT - 2 : 1, SLOTB);
    constexpr int NDQ = VAR == 2 ? 2 : 4; bf16x8 qpre[NDQ];
    { const bf16* Qw0 = PR + (size_t)(rowbase + tq) * NP + Qc;
#pragma unroll
      for (int d0 = 0; d0 < NDQ; ++d0) qpre[d0] = *(const bf16x8*)(Qw0 + d0 * 16 + hi * 8); }
    if (VAR == 0) {
        LAS float* pref = (LAS float*)(sh + L_WS);
        const float* cg = P.cum + (size_t)(b * 4 + h) * SEQ; float cgv[4];
#pragma unroll
        for (int k = 0; k < 4; ++k) { const int i = tid + 512 * k; cgv[k] = i < q0 + 256 ? cg[i] : 0.f; }
        if (tid < 64) { const float ct = P.cum[32 * SEQ + (b * 4 + h) * 64 + tid]; float incl = ct;
#pragma unroll
            for (int o = 1; o < 64; o <<= 1) { const float u = shup(incl, o, tid); if (tid >= o) incl += u; }
            pref[tid] = incl - ct; }
        asm volatile("s_waitcnt lgkmcnt(0)\n\ts_barrier" ::: "memory");
#pragma unroll
        for (int k = 0; k < 4; ++k) { const int i = tid + 512 * k; if (i < q0 + 256) cumL[i] = (cgv[k] + pref[i >> 5]) * LOG2E; }
        asm volatile("s_waitcnt lgkmcnt(0)\n\ts_barrier" ::: "memory");
    }
    if (VAR == 3) { const unsigned* mg = P.mask + (size_t)(rowbase + q0) * 64; const int nw = 2 * NT;
#pragma unroll 16
        for (int i = tid; i < 256 * 32; i += 512) { const int row = i >> 5, w = 2 * (i & 31); if (w < nw) *(LAS u32x2*)(maskL + row * MROW + w) = *(const u32x2*)(mg + row * 64 + w); } }
    asm volatile("s_waitcnt vmcnt(0) lgkmcnt(0)\n\ts_barrier" ::: "memory");
    const int vb0 = (int)(lds0 + L_V) + ((lane >> 4) & 1) * 32 + (lane & 3) * 8 + (4 * hi + ((lane & 15) >> 2)) * 64;
    float slope2 = 0.f;
    if (VAR == 2) slope2 = __builtin_amdgcn_exp2f(-(float)(2 * h + 1)) * LOG2E;
    if (VAR == 3) slope2 = __builtin_amdgcn_exp2f(-(float)(2 * h + 2)) * LOG2E;
    float cumt = 0.f; if (VAR == 0) cumt = cumL[tq];
    constexpr int NPASS = VAR == 2 ? 2 : 1;
    unsigned nxt_u = 0u, nxt_c = 0u;
    for (int pass = 0; pass < NPASS; ++pass) {
        bf16x8 qa[4]; float sb0 = 0.f;
        { const bf16* Qw = PR + (size_t)(rowbase + tq) * NP + Qc;
          constexpr int ND0 = VAR == 2 ? 2 : 4; const int dbase = VAR == 2 ? 2 * pass : 0;
          float qf[8 * ND0];
#pragma unroll
          for (int d0 = 0; d0 < ND0; ++d0) { bf16x8 raw = qpre[d0]; if (pass > 0) raw = *(const bf16x8*)(Qw + (dbase + d0) * 16 + hi * 8);
#pragma unroll
              for (int j = 0; j < 8; ++j) qf[d0 * 8 + j] = bf2f((unsigned short)raw[j]); }
          constexpr float SC = (VAR == 2 ? 0.17677669529663687f : 0.125f) * LOG2E;
          if (VAR != 1) {
              float ss = 0.f;
#pragma unroll
              for (int i = 0; i < 8 * ND0; ++i) ss += qf[i] * qf[i];
              ss += xhalf(ss, hi); const float rstd = 1.0f / sqrtf(ss * (VAR == 2 ? 1.f / 32.f : 1.f / 64.f) + RMS_EPS);
              const float* g = P.qgain[VAR];
#pragma unroll
              for (int d0 = 0; d0 < ND0; ++d0)
#pragma unroll
                  for (int j = 0; j < 8; ++j) qf[d0 * 8 + j] *= rstd * g[16 * d0 + 8 * hi + j] * SC;
          } else {
#pragma unroll
              for (int i = 0; i < 8 * ND0; ++i) qf[i] *= SC;
          }
          if (VAR == 2 || VAR == 3) {
              float n0 = 0.f;
#pragma unroll
              for (int i = 0; i < 8 * ND0; ++i) n0 += qf[i] * qf[i];
              n0 += xhalf(n0, hi);
              float gk = fabsf(P.kgain[VAR][lane & (VAR == 2 ? 31 : 63)]);
              gk = fmaxf(gk, shx<1>(gk)); gk = fmaxf(gk, shx<2>(gk)); gk = fmaxf(gk, shx<4>(gk)); gk = fmaxf(gk, shx<8>(gk)); gk = fmaxf(gk, shx<16>(gk)); gk = half_max(gk);
              sb0 = 1.02f * sqrtf(n0) * (VAR == 2 ? 5.656854249f : 8.0f) * gk;
          }
#pragma unroll
          for (int d0 = 0; d0 < ND0; ++d0) { u32x4 w; w.x = cvtpk_s(qf[d0 * 8 + 0], qf[d0 * 8 + 1]); w.y = cvtpk_s(qf[d0 * 8 + 2], qf[d0 * 8 + 3]); w.z = cvtpk_s(qf[d0 * 8 + 4], qf[d0 * 8 + 5]); w.w = cvtpk_s(qf[d0 * 8 + 6], qf[d0 * 8 + 7]);
              qa[d0] = __builtin_bit_cast(bf16x8, w); }
          if (VAR == 2) { qa[2] = qa[0]; qa[3] = qa[1]; }
        }
        float mhat = -1e30f, l_reg = 0.f, Rp = 1.f; f32x16 o[2]; const float sbound = sb0;
#pragma unroll
        for (int r = 0; r < 16; ++r) { o[0][r] = 0.f; o[1][r] = 0.f; }
        if (pass > 0) { DMA_KV(REV ? NT - 1 : 0, 0); DMA_KV(REV ? NT - 2 : 1, SLOTB); }
        int cur = 0, sl1 = SLOTB, sl2 = 2 * SLOTB;
        auto step = [&](auto band_c, const int it) -> bool {
            constexpr bool BAND = decltype(band_c)::value;
            const int t = REV ? NT - 1 - it : it;
            if (pm == 7) { }
            else if (it + 1 < NT) asm volatile("s_waitcnt vmcnt(2) lgkmcnt(0)\n\ts_barrier" ::: "memory");
            else ATT_WAIT_BAR();
            if (REV && it > 0) {
                const LAS unsigned* wz = (const LAS unsigned*)(sh + L_END) + ((it - 1) & 1) * 8;
                const u32x4 z0 = *(const LAS u32x4*)wz, z1 = *(const LAS u32x4*)(wz + 4);
                if (__builtin_amdgcn_readfirstlane((int)(z0.x & z0.y & z0.z & z0.w & z1.x & z1.y & z1.z & z1.w)) != 0) return true;
            }
            if (it + 2 < NT && pm != 7) DMA_KV(REV ? t - 2 : t + 2, sl2);
            const int jb = t - (NT - 4);
            float cinv = 0.f;
            if (VAR == 0) cinv = cumt;
            if (VAR == 2 || VAR == 3) cinv = slope2 * (float)(t * 64 + 4 * hi - tq);
            f32x16 cin;
#pragma unroll
            for (int r = 0; r < 16; ++r) cin[r] = cinv;
            f32x16 p0, p1;
            const LAS char* Ks = sh + L_K + cur;
            if (VAR == 2) { if (pass == 0) { const bf16x8 qq[4] = {qa[0], qa[1], qa[0], qa[1]}; qkt<0, 2>(p0, p1, Ks, qq, cin, r32, hi); }
                            else { const bf16x8 qq[4] = {qa[0], qa[1], qa[0], qa[1]}; qkt<2, 4>(p0, p1, Ks, qq, cin, r32, hi); } }
            else qkt<0, 4>(p0, p1, Ks, qa, cin, r32, hi);
            if (VAR != 1) {
                if (VAR == 0) { const LAS float* cp = cumL + t * 64 + 4 * hi;
#pragma unroll
                    for (int g = 0; g < 4; ++g) { const f32x4 c0 = *(const LAS f32x4*)(cp + 8 * g), c1 = *(const LAS f32x4*)(cp + 32 + 8 * g);
#pragma unroll
                        for (int i = 0; i < 4; ++i) { p0[4 * g + i] -= c0[i]; p1[4 * g + i] -= c1[i]; } } }
                if (VAR == 2 || VAR == 3) {
#pragma unroll
                    for (int r = 0; r < 16; ++r) { const float kc = (float)((r & 3) + 8 * (r >> 2)); p0[r] += slope2 * kc; p1[r] += slope2 * (kc + 32.f); } }
                if (VAR != 3) { if constexpr (BAND) { const int kb = 64 * jb + 4 * hi;
#pragma unroll
                    for (int r = 0; r < 16; ++r) { const int kv = kb + (r & 3) + 8 * (r >> 2); if (kv > qrel) p0[r] = -INFINITY; if (kv + 32 > qrel) p1[r] = -INFINITY; } } }
                else { const u32x2 mw = *(const LAS u32x2*)(maskL + qrel * MROW + 2 * t); const unsigned w0 = mw.x >> (4 * hi), w1 = mw.y >> (4 * hi);
#pragma unroll
                    for (int r = 0; r < 16; ++r) { const int c = (r & 3) + 8 * (r >> 2); if (!((w0 >> c) & 1u)) p0[r] = -INFINITY; if (!((w1 >> c) & 1u)) p1[r] = -INFINITY; } }
                const float rm = rowmax(p0, p1, hi);
                if (__any(rm - mhat > THR)) {
                    const float mn = fmaxf(mhat, rm); const float f = __builtin_amdgcn_exp2f(mhat - mn); mhat = mn; l_reg *= f;
                    if (hi == 0) wsf[r32] = f;
#pragma unroll
                    for (int r = 0; r < 16; ++r) { const float fr = wsf[crow(r, hi)]; o[0][r] *= fr; o[1][r] *= fr; }
                }
                float sa4[4] = {0.f, 0.f, 0.f, 0.f};
#pragma unroll
                for (int r = 0; r < 16; ++r) { p0[r] = __builtin_amdgcn_exp2f(p0[r] - mhat); p1[r] = __builtin_amdgcn_exp2f(p1[r] - mhat); sa4[r & 3] += p0[r] + p1[r]; }
                l_reg += (sa4[0] + sa4[1]) + (sa4[2] + sa4[3]);
                if (VAR == 2 || VAR == 3) {
                    const float ub = sbound - slope2 * (float)(tq - 64 * t + 1) - mhat;
                    const bool dead = __all(ub < -150.f); if (lane == 0) ((LAS unsigned*)(sh + L_END))[(it & 1) * 8 + wid] = dead ? 1u : 0u;
                }
            } else {
                f32x16 m0, m1;
#pragma unroll
                for (int r = 0; r < 16; ++r) {
                    { const float s = __builtin_amdgcn_fmed3f(p0[r], -64.f, 64.f); const float e = __builtin_amdgcn_exp2f(-s); const float bt = __builtin_amdgcn_rcpf(1.f + e); p0[r] = bt; m0[r] = e * bt; }
                    { const float s = __builtin_amdgcn_fmed3f(p1[r], -64.f, 64.f); const float e = __builtin_amdgcn_exp2f(-s); const float bt = __builtin_amdgcn_rcpf(1.f + e); p1[r] = bt; m1[r] = e * bt; } }
                if constexpr (BAND) { const int kb = 64 * jb + 4 * hi;
#pragma unroll
                    for (int r = 0; r < 16; ++r) { const int kv = kb + (r & 3) + 8 * (r >> 2);
                        if (kv >= qrel) { p0[r] = 0.f; m0[r] = 1.f; } if (kv + 32 >= qrel) { p1[r] = 0.f; m1[r] = 1.f; } } }
                float gp[8], gq[8], ex[8];
#pragma unroll
                for (int g = 0; g < 4; ++g) { gp[g] = (m0[4 * g] * m0[4 * g + 1]) * (m0[4 * g + 2] * m0[4 * g + 3]); gp[4 + g] = (m1[4 * g] * m1[4 * g + 1]) * (m1[4 * g + 2] * m1[4 * g + 3]); }
#pragma unroll
                for (int g = 0; g < 8; ++g) gq[g] = xhalf(gp[g], hi);
                float sp = Rp;
#pragma unroll
                for (int g = 7; g >= 0; --g) { ex[g] = hi ? sp : sp * gq[g]; sp *= gp[g] * gq[g]; }
                Rp = sp;
                { const bool allz = !__any(Rp != 0.f); if (lane == 0) ((LAS unsigned*)(sh + L_END))[(it & 1) * 8 + wid] = allz ? 1u : 0u; }
#pragma unroll
                for (int g = 0; g < 4; ++g) {
                    { float c = ex[g]; const float w3 = p0[4 * g + 3] * c; c *= m0[4 * g + 3]; const float w2 = p0[4 * g + 2] * c; c *= m0[4 * g + 2]; const float w1 = p0[4 * g + 1] * c; c *= m0[4 * g + 1]; const float w0 = p0[4 * g] * c;
                      p0[4 * g] = w0; p0[4 * g + 1] = w1; p0[4 * g + 2] = w2; p0[4 * g + 3] = w3; }
                    { float c = ex[4 + g]; const float w3 = p1[4 * g + 3] * c; c *= m1[4 * g + 3]; const float w2 = p1[4 * g + 2] * c; c *= m1[4 * g + 2]; const float w1 = p1[4 * g + 1] * c; c *= m1[4 * g + 1]; const float w0 = p1[4 * g] * c;
                      p1[4 * g] = w0; p1[4 * g + 1] = w1; p1[4 * g + 2] = w2; p1[4 * g + 3] = w3; } }
            }
            u32x4 pw0, pw1, pw2, pw3;
            pw0 = (u32x4){cvtpk_s(p0[0], p0[1]), cvtpk_s(p0[2], p0[3]), cvtpk_s(p0[4], p0[5]), cvtpk_s(p0[6], p0[7])};
            pw1 = (u32x4){cvtpk_s(p0[8], p0[9]), cvtpk_s(p0[10], p0[11]), cvtpk_s(p0[12], p0[13]), cvtpk_s(p0[14], p0[15])};
            pw2 = (u32x4){cvtpk_s(p1[0], p1[1]), cvtpk_s(p1[2], p1[3]), cvtpk_s(p1[4], p1[5]), cvtpk_s(p1[6], p1[7])};
            pw3 = (u32x4){cvtpk_s(p1[8], p1[9]), cvtpk_s(p1[10], p1[11]), cvtpk_s(p1[12], p1[13]), cvtpk_s(p1[14], p1[15])};
            pv(o, vb0 + cur, __builtin_bit_cast(bf16x8, pw0), __builtin_bit_cast(bf16x8, pw1), __builtin_bit_cast(bf16x8, pw2), __builtin_bit_cast(bf16x8, pw3));
            { const int tmp = cur; cur = sl1; sl1 = sl2; sl2 = tmp; }
            return false;
        };
        if (REV) { bool ex = false; int it = 0;
            for (; it < 4 && !ex; ++it) ex = step(BoolC<true>{}, it);
            for (; it < NT && !ex; ++it) ex = step(BoolC<false>{}, it); }
        else { int it = 0;
            for (; it < NT - 4; ++it) (void)step(BoolC<false>{}, it);
            for (; it < NT; ++it) (void)step(BoolC<true>{}, it); }
        ATT_WAIT_BAR();
        if (pass == NPASS - 1 && tid == 0) { nxt_u = __builtin_amdgcn_atomic_inc32(qctr, 0xFFFFFFFFu, __ATOMIC_RELAXED, "agent"); if (P.cvq) nxt_c = __builtin_amdgcn_atomic_inc32(P.cvq, 0xFFFFFFFFu, __ATOMIC_RELAXED, "agent"); }
        float rli[16];
        if (VAR != 1) {
            l_reg += xhalf(l_reg, hi);
            if (hi == 0) wsf[32 + r32] = l_reg;
#pragma unroll
            for (int r = 0; r < 16; ++r) rli[r] = __builtin_amdgcn_rcpf(wsf[32 + crow(r, hi)]);
        } else {
#pragma unroll
            for (int r = 0; r < 16; ++r) rli[r] = 1.f;
        }
#pragma unroll
        for (int r = 0; r < 16; ++r) { const int orow = crow(r, hi);
#pragma unroll
            for (int d0 = 0; d0 < 2; ++d0) { const float val = o[d0][r] * rli[r]; LAS float* sp = stg + orow * 64 + d0 * 32 + r32;
                if (VAR == 2 && pass == 1) *sp = *sp - P.lam * val; else *sp = val; } }
    }
    LDS_WAIT();
    bf16* Ow = P.mix + (size_t)(rowbase + q0 + wid * 32) * DM + VAR * 256 + h * 64;
#pragma unroll
    for (int i = 0; i < 4; ++i) { const int row = i * 8 + (lane >> 3), ch = lane & 7;
        const f32x4 a = *(const LAS f32x4*)(stg + row * 64 + ch * 8), c = *(const LAS f32x4*)(stg + row * 64 + ch * 8 + 4);
        float sc = 1.f;
        if (VAR == 2) { float ss = (a[0] * a[0] + a[1] * a[1]) + (a[2] * a[2] + a[3] * a[3]) + (c[0] * c[0] + c[1] * c[1]) + (c[2] * c[2] + c[3] * c[3]);
            ss += shx<1>(ss); ss += shx<2>(ss); ss += shx<4>(ss); sc = 1.0f / sqrtf(ss * (1.f / 64.f) + RMS_EPS); }
        u32x4 w; w.x = cvtpk_s(a[0] * sc, a[1] * sc); w.y = cvtpk_s(a[2] * sc, a[3] * sc); w.z = cvtpk_s(c[0] * sc, c[1] * sc); w.w = cvtpk_s(c[2] * sc, c[3] * sc);
        if (pm == 0 || (w.x == 0x12345678u && w.y == 0x9abcdef0u)) *(u32x4*)(Ow + (size_t)row * DM + ch * 8) = w; }
    if (tid == 0) { *qslot = nxt_u; if (P.cvq) qslot[3] = nxt_c; }
    asm volatile("s_waitcnt lgkmcnt(0)\n\ts_barrier" ::: "memory");
#undef DMA_KV
}
typedef __attribute__((address_space(3))) const char* lds_cptr;
typedef short v4i16_t __attribute__((ext_vector_type(4)));
__device__ __forceinline__ s16x4 vtr(lds_cptr p) { return __builtin_bit_cast(s16x4, __builtin_amdgcn_ds_read_tr16_b64_v4i16((__attribute__((address_space(3))) v4i16_t*)p)); }
template <int VAR>
__device__ __forceinline__ void attn_unit2(const AttnP& P, int b, int h, int qb, LAS char* sh, const int tid_in, unsigned* qctr, volatile LAS unsigned* qslot) {
    static_assert(VAR == 0 || VAR == 2 || VAR == 3, "softmax mixers only");
    int tid = tid_in; asm volatile("" : "+v"(tid));
    const int lane = tid & 63, r32 = lane & 31, hi = lane >> 5; const int wid = __builtin_amdgcn_readfirstlane(tid >> 6);
    const long rowbase = (long)b * SEQ; const int q0 = qb * 256, NT = 4 * (qb + 1);
    const int qrel = wid * 32 + r32, tq = q0 + qrel;
    constexpr int QCB = VAR == 0 ? C_AQ : VAR == 1 ? C_BQ : VAR == 2 ? C_CQ : C_DQ;
    constexpr int KCB = VAR == 0 ? C_AK : VAR == 1 ? C_BK : VAR == 2 ? C_CK : C_DK;
    constexpr int VCB = VAR == 0 ? C_AV : VAR == 1 ? C_BV : VAR == 2 ? C_CV : C_DV;
    const int Qc = QCB + 64 * h, Kc = VAR == 3 ? KCB : KCB + 64 * h, Vc = VAR == 3 ? VCB : VCB + 64 * h;
    const bf16* PR = P.proj;
    LAS float* wsf = (LAS float*)(sh + L_WS) + wid * 64;
    LAS float* stg = (LAS float*)(sh + L_OST) + wid * 2048;
    LAS float* cumL = (LAS float*)(sh + L_CUM);
    LAS unsigned* maskL = (LAS unsigned*)(sh + L_OST);
    const unsigned lds0 = (unsigned)(uintptr_t)sh;
    const bf16* ksrc = PR + (size_t)(rowbase + lane) * NP + Kc + wid * 8;
    const bf16* vsrc = PR + (size_t)(rowbase + 16 * (wid & 3) + (lane >> 2)) * NP + Vc + (wid >> 2) * 32 + (lane & 3) * 8;
    const unsigned kdst = lds0 + L_K + wid * 1024, vdst = lds0 + L_V + wid * 1024;
#define TILE2(j) (NT - 1 - (j))
#define DMA_K2(j, slot) glds16(ksrc + (size_t)TILE2(j) * 64 * NP, (unsigned)__builtin_amdgcn_readfirstlane(kdst + (slot)))
#define DMA_V2(j, slot) glds16(vsrc + (size_t)TILE2(j) * 64 * NP, (unsigned)__builtin_amdgcn_readfirstlane(vdst + (slot)))
    DMA_K2(0, 0); DMA_K2(1, SLOTB); DMA_V2(0, 0);
    constexpr int NDQ = VAR == 2 ? 2 : 4; bf16x8 qpre[NDQ];
    { const bf16* Qw0 = PR + (size_t)(rowbase + tq) * NP + Qc;
#pragma unroll
      for (int d0 = 0; d0 < NDQ; ++d0) qpre[d0] = *(const bf16x8*)(Qw0 + d0 * 16 + hi * 8); }
    if (VAR == 0) {
        LAS float* pref = (LAS float*)(sh + L_WS);
        const float* cg = P.cum + (size_t)(b * 4 + h) * SEQ; float cgv[4];
#pragma unroll
        for (int k = 0; k < 4; ++k) { const int i = tid + 512 * k; cgv[k] = i < q0 + 256 ? cg[i] : 0.f; }
        if (tid < 64) { const float ct = P.cum[32 * SEQ + (b * 4 + h) * 64 + tid]; float incl = ct;
#pragma unroll
            for (int o = 1; o < 64; o <<= 1) { const float u = shup(incl, o, tid); if (tid >= o) incl += u; }
            pref[tid] = incl - ct; }
        asm volatile("s_waitcnt lgkmcnt(0)\n\ts_barrier" ::: "memory");
#pragma unroll
        for (int k = 0; k < 4; ++k) { const int i = tid + 512 * k; if (i < q0 + 256) cumL[i] = (cgv[k] + pref[i >> 5]) * LOG2E; }
        asm volatile("s_waitcnt lgkmcnt(0)\n\ts_barrier" ::: "memory");
    }
    if (VAR == 3) { const unsigned* mg = P.mask + (size_t)(rowbase + q0) * 64; const int nw = 2 * NT;
#pragma unroll 16
        for (int i = tid; i < 256 * 32; i += 512) { const int row = i >> 5, w = 2 * (i & 31); if (w < nw) *(LAS u32x2*)(maskL + row * MROW + w) = *(const u32x2*)(mg + row * 64 + w); } }
    asm volatile("s_waitcnt vmcnt(0) lgkmcnt(0)\n\ts_barrier" ::: "memory");
    const lds_cptr shc = (lds_cptr)sh;
    const lds_cptr kp0 = shc + L_K + hi * 1024 + r32 * 16;
    const lds_cptr vp0 = shc + L_V + ((lane >> 4) & 1) * 32 + (lane & 3) * 8 + (4 * hi + ((lane & 15) >> 2)) * 64;
    float slope2 = 0.f;
    if (VAR == 2) slope2 = __builtin_amdgcn_exp2f(-(float)(2 * h + 1)) * LOG2E;
    if (VAR == 3) slope2 = __builtin_amdgcn_exp2f(-(float)(2 * h + 2)) * LOG2E;
    float cumt = 0.f; if (VAR == 0) cumt = cumL[tq];
    constexpr int NPASS = VAR == 2 ? 2 : 1;
    unsigned nxt_u = 0u, nxt_c = 0u;
    const auto slot3 = [](int j) { return (j % 3) * SLOTB; };
#define SB2() __builtin_amdgcn_sched_barrier(0)
#define PINV(x) asm volatile("" : "+v"(x))
#define MF32(a, b, c) __builtin_amdgcn_mfma_f32_32x32x16_bf16(a, b, c, 0, 0, 0)
#define ATT_BARN(N) do { asm volatile("s_waitcnt vmcnt(" #N ") lgkmcnt(0)\n\ts_barrier" ::: "memory"); SB2(); } while (0)
#define PKW(Pv, i) cvtpk_s(Pv[i], Pv[(i) + 1])
#define PAF(k) __builtin_bit_cast(bf16x8, pw##k)
#define VFR(i) (bf16x8){vlo[i][0], vlo[i][1], vlo[i][2], vlo[i][3], vhi[i][0], vhi[i][1], vhi[i][2], vhi[i][3]}
#define VRD(i) do { vlo[i] = vtr(vp_ + (((i) >> 2) * 4096 + ((i) & 3) * 1024)); vhi[i] = vtr(vp_ + (((i) >> 2) * 4096 + ((i) & 3) * 1024 + 512)); } while (0)
#define EX2(v) __builtin_amdgcn_exp2f(v)
#define GAPA(MF, Pv, i, PW, w) do { MF; sacc += Pv[i]; sacc += Pv[(i) + 1]; sacc += Pv[(i) + 2]; sacc += Pv[(i) + 3]; PINV(sacc); PW[w] = PKW(Pv, i); PW[(w) + 1] = PKW(Pv, (i) + 2); PINV(PW); SB2(); } while (0)
#define GAPA8(MF, Pv, i, PW) do { MF; sacc += Pv[i]; sacc += Pv[(i) + 1]; sacc += Pv[(i) + 2]; sacc += Pv[(i) + 3]; sacc += Pv[(i) + 4]; sacc += Pv[(i) + 5]; sacc += Pv[(i) + 6]; sacc += Pv[(i) + 7]; PINV(sacc); \
        PW[0] = PKW(Pv, i); PW[1] = PKW(Pv, (i) + 2); PW[2] = PKW(Pv, (i) + 4); PW[3] = PKW(Pv, (i) + 6); PINV(PW); SB2(); } while (0)
#define GAPB(MF, X, i) do { MF; X[i] = EX2(X[i]); X[(i) + 1] = EX2(X[(i) + 1]); X[(i) + 2] = EX2(X[(i) + 2]); X[(i) + 3] = EX2(X[(i) + 3]); PINV(X); SB2(); } while (0)
    for (int pass = 0; pass < NPASS; ++pass) {
        bf16x8 qa[4]; float sb0 = 0.f;
        { const bf16* Qw = PR + (size_t)(rowbase + tq) * NP + Qc;
          constexpr int ND0 = VAR == 2 ? 2 : 4; const int dbase = VAR == 2 ? 2 * pass : 0;
          float qf[8 * ND0];
#pragma unroll
          for (int d0 = 0; d0 < ND0; ++d0) { bf16x8 raw = qpre[d0]; if (pass > 0) raw = *(const bf16x8*)(Qw + (dbase + d0) * 16 + hi * 8);
#pragma unroll
              for (int j = 0; j < 8; ++j) qf[d0 * 8 + j] = bf2f((unsigned short)raw[j]); }
          constexpr float SC = (VAR == 2 ? 0.17677669529663687f : 0.125f) * LOG2E;
          if (VAR != 1) {
              float ss = 0.f;
#pragma unroll
              for (int i = 0; i < 8 * ND0; ++i) ss += qf[i] * qf[i];
              ss += xhalf(ss, hi); const float rstd = 1.0f / sqrtf(ss * (VAR == 2 ? 1.f / 32.f : 1.f / 64.f) + RMS_EPS);
              const float* g = P.qgain[VAR];
#pragma unroll
              for (int d0 = 0; d0 < ND0; ++d0)
#pragma unroll
                  for (int j = 0; j < 8; ++j) qf[d0 * 8 + j] *= rstd * g[16 * d0 + 8 * hi + j] * SC;
          } else {
#pragma unroll
              for (int i = 0; i < 8 * ND0; ++i) qf[i] *= SC;
          }
          if (VAR == 2 || VAR == 3) {
              float n0 = 0.f;
#pragma unroll
              for (int i = 0; i < 8 * ND0; ++i) n0 += qf[i] * qf[i];
              n0 += xhalf(n0, hi);
              float gk = fabsf(P.kgain[VAR][lane & (VAR == 2 ? 31 : 63)]);
              gk = fmaxf(gk, shx<1>(gk)); gk = fmaxf(gk, shx<2>(gk)); gk = fmaxf(gk, shx<4>(gk)); gk = fmaxf(gk, shx<8>(gk)); gk = fmaxf(gk, shx<16>(gk)); gk = half_max(gk);
              sb0 = 1.02f * sqrtf(n0) * (VAR == 2 ? 5.656854249f : 8.0f) * gk;
          }
#pragma unroll
          for (int d0 = 0; d0 < ND0; ++d0) { u32x4 w; w.x = cvtpk_s(qf[d0 * 8 + 0], qf[d0 * 8 + 1]); w.y = cvtpk_s(qf[d0 * 8 + 2], qf[d0 * 8 + 3]); w.z = cvtpk_s(qf[d0 * 8 + 4], qf[d0 * 8 + 5]); w.w = cvtpk_s(qf[d0 * 8 + 6], qf[d0 * 8 + 7]);
              qa[d0] = __builtin_bit_cast(bf16x8, w); }
          if (VAR == 2) { qa[2] = qa[0]; qa[3] = qa[1]; }
        }
        const float sbound = sb0;
        if (pass > 0) { DMA_K2(0, 0); DMA_K2(1, SLOTB); DMA_V2(0, 0); }
        float mhat = 0.f, l_reg = 0.f; bool hasref = false, resc = false; f32x16 o[2], negm;
#pragma unroll
        for (int r = 0; r < 16; ++r) { o[0][r] = 0.f; o[1][r] = 0.f; }
        f32x16 pA0, pA1, pB0, pB1; u32x4 pw0, pw1, pw2, pw3;
#pragma unroll
        for (int r = 0; r < 16; ++r) { pB0[r] = 0.f; pB1[r] = 0.f; }
        const auto setneg = [&](int t) __attribute__((always_inline)) { float v = -mhat; if (VAR == 0) v += cumt; else v += slope2 * (float)(t * 64 + 4 * hi - tq);
#pragma unroll
            for (int r = 0; r < 16; ++r) negm[r] = v;
            PINV(negm); };
        const auto mid = [&](f32x16& C0, f32x16& C1, const int it) __attribute__((always_inline)) {
            const int t = NT - 1 - it;
            if (VAR == 0) { const LAS float* cp = cumL + t * 64 + 4 * hi;
#pragma unroll
                for (int g = 0; g < 4; ++g) { const f32x4 c0 = *(const LAS f32x4*)(cp + 8 * g), c1 = *(const LAS f32x4*)(cp + 32 + 8 * g);
#pragma unroll
                    for (int i = 0; i < 4; ++i) { C0[4 * g + i] -= c0[i]; C1[4 * g + i] -= c1[i]; } } }
            else {
#pragma unroll
                for (int r = 0; r < 16; ++r) { const float kc = (float)((r & 3) + 8 * (r >> 2)); C0[r] += slope2 * kc; C1[r] += slope2 * (kc + 32.f); } }
            if (VAR != 3) { if (it < 4) { asm volatile("" ::: "memory");
                const int kb = 64 * (3 - it) + 4 * hi;
#pragma unroll
                for (int r = 0; r < 16; ++r) { const int kv = kb + (r & 3) + 8 * (r >> 2); if (kv > qrel) C0[r] = -INFINITY; if (kv + 32 > qrel) C1[r] = -INFINITY; } } }
            else { const u32x2 mw = *(const LAS u32x2*)(maskL + qrel * MROW + 2 * t); const unsigned w0 = mw.x >> (4 * hi), w1 = mw.y >> (4 * hi);
#pragma unroll
                for (int r = 0; r < 16; ++r) { const int c = (r & 3) + 8 * (r >> 2); if (!((w0 >> c) & 1u)) C0[r] = -INFINITY; if (!((w1 >> c) & 1u)) C1[r] = -INFINITY; } }
            const float rm = rowmax(C0, C1, hi);
            const bool need = hasref ? (rm > THR) : (rm > -INFINITY);
            resc = false;
            if (__any(need)) {
                const bool fin = rm > -INFINITY;
                const float dl = hasref ? fmaxf(rm, 0.f) : (fin ? rm : 0.f);
                const float f = hasref ? EX2(-dl) : 1.f;
                mhat += dl; l_reg *= f;
#pragma unroll
                for (int r = 0; r < 16; ++r) { C0[r] -= dl; C1[r] -= dl; }
                if (hi == 0) wsf[r32] = f;
                resc = true; hasref = hasref || fin;
            }
            if (VAR != 0) {
                const bool dead = hasref && (sbound - slope2 * (float)(tq - 64 * t + 1) - mhat < -150.f);
                const bool alld = __all(dead); if (lane == 0) ((LAS unsigned*)(sh + L_END))[(it & 1) * 8 + wid] = alld ? 1u : 0u;
            }
        };
#define KLD(dst0, dst1, d0) do { dst0 = *(const LAS bf16x8*)(kp_ + (d0) * 2048); dst1 = *(const LAS bf16x8*)(kp_ + (d0) * 2048 + 512); } while (0)
#define VLD(lo, hi_, i) do { lo = vtr(vp_ + (((i) >> 2) * 4096 + ((i) & 3) * 1024)); hi_ = vtr(vp_ + (((i) >> 2) * 4096 + ((i) & 3) * 1024 + 512)); } while (0)
#define VF(lo, hi_) (bf16x8){lo[0], lo[1], lo[2], lo[3], hi_[0], hi_[1], hi_[2], hi_[3]}
        const auto step = [&](f32x16& C0, f32x16& C1, f32x16& P0, f32x16& P1, const int it) __attribute__((always_inline)) -> bool {
            if (it + 1 < NT) ATT_BARN(2); else ATT_BARN(1);
            if (VAR != 0 && it >= 1) { const LAS unsigned* wz = (const LAS unsigned*)(sh + L_END) + ((it - 1) & 1) * 8;
                const u32x4 z0 = *(const LAS u32x4*)wz, z1 = *(const LAS u32x4*)(wz + 4);
                if (__builtin_amdgcn_readfirstlane((int)(z0.x & z0.y & z0.z & z0.w & z1.x & z1.y & z1.z & z1.w)) != 0) return true; }
            if (it + 2 < NT) DMA_K2(it + 2, slot3(it + 2));
            if (it + 1 < NT) DMA_V2(it + 1, slot3(it + 1));
            setneg(NT - 1 - it);
            int ko_ = slot3(it), vo_ = slot3(it + 2);
            asm volatile("" : "+s"(ko_), "+s"(vo_));
            const lds_cptr kp_ = kp0 + ko_; const lds_cptr vp_ = vp0 + vo_;
            bf16x8 ka0, ka1, kb0, kb1; s16x4 va0, va1, vb0, vb1;
            float sacc = 0.f;
            if (VAR == 2) {
                KLD(ka0, ka1, 2 * pass); KLD(kb0, kb1, 2 * pass + 1); SB2();
                GAPA8(C0 = MF32(ka0, qa[0], negm), P0, 0, pw0);
                GAPA8(C1 = MF32(ka1, qa[0], negm), P0, 8, pw1);
                GAPA8(C0 = MF32(kb0, qa[1], C0), P1, 0, pw2);
                GAPA8(C1 = MF32(kb1, qa[1], C1), P1, 8, pw3);
            } else {
                KLD(ka0, ka1, 0); KLD(kb0, kb1, 1); SB2();
                GAPA(C0 = MF32(ka0, qa[0], negm), P0, 0, pw0, 0);
                GAPA(C1 = MF32(ka1, qa[0], negm), P0, 4, pw0, 2);
                KLD(ka0, ka1, 2); SB2();
                GAPA(C0 = MF32(kb0, qa[1], C0), P0, 8, pw1, 0);
                GAPA(C1 = MF32(kb1, qa[1], C1), P0, 12, pw1, 2);
                KLD(kb0, kb1, 3); SB2();
                GAPA(C0 = MF32(ka0, qa[2], C0), P1, 0, pw2, 0);
                GAPA(C1 = MF32(ka1, qa[2], C1), P1, 4, pw2, 2);
                GAPA(C0 = MF32(kb0, qa[3], C0), P1, 8, pw3, 0);
                GAPA(C1 = MF32(kb1, qa[3], C1), P1, 12, pw3, 2);
            }
            l_reg += sacc;
            mid(C0, C1, it);
            SB2();
            if (it > 0) {
                VLD(va0, va1, 0); VLD(vb0, vb1, 4); SB2();
                GAPB(o[0] = MF32(PAF(0), VF(va0, va1), o[0]), C0, 0);  VLD(va0, va1, 1); SB2();
                GAPB(o[1] = MF32(PAF(0), VF(vb0, vb1), o[1]), C0, 4);  VLD(vb0, vb1, 5); SB2();
                GAPB(o[0] = MF32(PAF(1), VF(va0, va1), o[0]), C0, 8);  VLD(va0, va1, 2); SB2();
                GAPB(o[1] = MF32(PAF(1), VF(vb0, vb1), o[1]), C0, 12); VLD(vb0, vb1, 6); SB2();
                GAPB(o[0] = MF32(PAF(2), VF(va0, va1), o[0]), C1, 0);  VLD(va0, va1, 3); SB2();
                GAPB(o[1] = MF32(PAF(2), VF(vb0, vb1), o[1]), C1, 4);  VLD(vb0, vb1, 7); SB2();
                GAPB(o[0] = MF32(PAF(3), VF(va0, va1), o[0]), C1, 8);
                GAPB(o[1] = MF32(PAF(3), VF(vb0, vb1), o[1]), C1, 12);
                if (resc) {
#pragma unroll
                    for (int r = 0; r < 16; ++r) { const float fr = wsf[crow(r, hi)]; o[0][r] *= fr; o[1][r] *= fr; } }
            } else {
#pragma unroll
                for (int r = 0; r < 16; ++r) { C0[r] = EX2(C0[r]); C1[r] = EX2(C1[r]); }
            }
            return false;
        };
        bool ex = false, pendA = true; int it = 0;
        for (; it < NT; it += 2) {
            ex = step(pA0, pA1, pB0, pB1, it); if (ex) { pendA = false; break; }
            ex = step(pB0, pB1, pA0, pA1, it + 1); if (ex) { pendA = true; ++it; break; }
        }
        if (!ex) pendA = false;
        if (!ex) ATT_BARN(0);
        { int vo_ = slot3(it + 2); asm volatile("" : "+s"(vo_)); const lds_cptr vp_ = vp0 + vo_; s16x4 vlo[8], vhi[8];
#pragma unroll
          for (int i = 0; i < 8; ++i) VRD(i);
          float sacc = 0.f;
          if (pendA) {
#pragma unroll
              for (int r = 0; r < 16; ++r) sacc += pA0[r] + pA1[r];
              pw0 = (u32x4){PKW(pA0, 0), PKW(pA0, 2), PKW(pA0, 4), PKW(pA0, 6)}; pw1 = (u32x4){PKW(pA0, 8), PKW(pA0, 10), PKW(pA0, 12), PKW(pA0, 14)};
              pw2 = (u32x4){PKW(pA1, 0), PKW(pA1, 2), PKW(pA1, 4), PKW(pA1, 6)}; pw3 = (u32x4){PKW(pA1, 8), PKW(pA1, 10), PKW(pA1, 12), PKW(pA1, 14)};
          } else {
#pragma unroll
              for (int r = 0; r < 16; ++r) sacc += pB0[r] + pB1[r];
              pw0 = (u32x4){PKW(pB0, 0), PKW(pB0, 2), PKW(pB0, 4), PKW(pB0, 6)}; pw1 = (u32x4){PKW(pB0, 8), PKW(pB0, 10), PKW(pB0, 12), PKW(pB0, 14)};
              pw2 = (u32x4){PKW(pB1, 0), PKW(pB1, 2), PKW(pB1, 4), PKW(pB1, 6)}; pw3 = (u32x4){PKW(pB1, 8), PKW(pB1, 10), PKW(pB1, 12), PKW(pB1, 14)};
          }
          l_reg += sacc;
          o[0] = MF32(PAF(0), VFR(0), o[0]); o[1] = MF32(PAF(0), VFR(4), o[1]); o[0] = MF32(PAF(1), VFR(1), o[0]); o[1] = MF32(PAF(1), VFR(5), o[1]);
          o[0] = MF32(PAF(2), VFR(2), o[0]); o[1] = MF32(PAF(2), VFR(6), o[1]); o[0] = MF32(PAF(3), VFR(3), o[0]); o[1] = MF32(PAF(3), VFR(7), o[1]); }
        ATT_WAIT_BAR();
        if (pass == NPASS - 1 && tid == 0) { nxt_u = __builtin_amdgcn_atomic_inc32(qctr, 0xFFFFFFFFu, __ATOMIC_RELAXED, "agent"); if (P.cvq) nxt_c = __builtin_amdgcn_atomic_inc32(P.cvq, 0xFFFFFFFFu, __ATOMIC_RELAXED, "agent"); }
        int lane_e = lane; asm volatile("" : "+v"(lane_e)); const int r32e = lane_e & 31, hie = lane_e >> 5;
        LAS float* wsfe = (LAS float*)(sh + L_WS) + wid * 64; LAS float* stge = (LAS float*)(sh + L_OST) + wid * 2048;
        float rli[16];
        l_reg += xhalf(l_reg, hie);
        if (hie == 0) wsfe[32 + r32e] = l_reg;
#pragma unroll
        for (int r = 0; r < 16; ++r) rli[r] = __builtin_amdgcn_rcpf(wsfe[32 + crow(r, hie)]);
#pragma unroll
        for (int r = 0; r < 16; ++r) { const int orow = crow(r, hie);
#pragma unroll
            for (int d0 = 0; d0 < 2; ++d0) { const float val = o[d0][r] * rli[r]; LAS float* sp = stge + orow * 64 + d0 * 32 + r32e;
                if (VAR == 2 && pass == 1) *sp = *sp - P.lam * val; else *sp = val; } }
    }
    LDS_WAIT();
    int lane_o = tid & 63; asm volatile("" : "+v"(lane_o));
    bf16* Ow = P.mix + (size_t)(rowbase + q0 + wid * 32) * DM + VAR * 256 + h * 64;
    { const int lane = lane_o; LAS float* stg = (LAS float*)(sh + L_OST) + wid * 2048;
#pragma unroll
    for (int i = 0; i < 4; ++i) { const int row = i * 8 + (lane >> 3), ch = lane & 7;
        const f32x4 a = *(const LAS f32x4*)(stg + row * 64 + ch * 8), c = *(const LAS f32x4*)(stg + row * 64 + ch * 8 + 4);
        float sc = 1.f;
        if (VAR == 2) { float ss = (a[0] * a[0] + a[1] * a[1]) + (a[2] * a[2] + a[3] * a[3]) + (c[0] * c[0] + c[1] * c[1]) + (c[2] * c[2] + c[3] * c[3]);
            ss += shx<1>(ss); ss += shx<2>(ss); ss += shx<4>(ss); sc = 1.0f / sqrtf(ss * (1.f / 64.f) + RMS_EPS); }
        u32x4 w; w.x = cvtpk_s(a[0] * sc, a[1] * sc); w.y = cvtpk_s(a[2] * sc, a[3] * sc); w.z = cvtpk_s(c[0] * sc, c[1] * sc); w.w = cvtpk_s(c[2] * sc, c[3] * sc);
        *(u32x4*)(Ow + (size_t)row * DM + ch * 8) = w; } }
    if (tid == 0) { *qslot = nxt_u; if (P.cvq) qslot[3] = nxt_c; }
    asm volatile("s_waitcnt lgkmcnt(0)\n\ts_barrier" ::: "memory");
#undef DMA_K2
#undef DMA_V2
#undef TILE2
}
#undef SB2
#undef PINV
#undef MF32
#undef ATT_BARN
#undef PKW
#undef PAF
#undef VFR
#undef VRD
#undef EX2
#undef GAPA
#undef GAPA8
#undef GAPB
#undef KLD
#undef VLD
#undef VF
}

__device__ __forceinline__ void p4_attention(Frame& F, const Args& A, int l, int qsel) {
    att::AttnP P; P.proj = (const bf16*)(F.ws + WS_PROJ); P.mix = (bf16*)(F.ws + WS_MIX); P.cum = (const float*)(F.ws + WS_CUM); P.mask = (const unsigned*)(F.ws + WS_MASK);
    P.qgain[0] = inp<I_QNA>() + l * 64; P.qgain[1] = nullptr; P.qgain[2] = inp<I_QNC>() + l * 32; P.qgain[3] = inp<I_QND>() + l * 64; P.kgain[0] = nullptr; P.kgain[1] = nullptr; P.kgain[2] = inp<I_KNC>() + l * 32; P.kgain[3] = inp<I_KND>() + l * 64; P.lam = ((const float*)(F.ws + WS_MISC))[l];
    LAS char* sh = (LAS char*)F.lds;
    LAS float* rsl2 = (LAS float*)(F.lds + 126976);
    bool cv = BG_CONVERT && (qsel == 0);
    if (cv) { fill_rowscale(F, A, 0, rsl2); fill_rowscale(F, A, 1, rsl2 + DM); }
    P.cvq = cv ? F.ctl + CW_CVQ : nullptr;
    if (F.tid == 0) F.MISC[0] = (unsigned)(F.bx - F.G);
    __syncthreads();
    for (;;) {
        const int u = (int)F.MISC[0] + F.G;
        if (u >= 1024) break;
        const int qb = 7 - (u >> 7), r = u & 127, var = r >> 5, bh = r & 31, b = bh >> 2, h = bh & 3;
        const int tv = var == 0 ? 2 : var == 1 ? 1 : var == 2 ? 3 : 0;
        if (qsel >= 2 && PROBE_ATT_VAR >= 0 && tv != PROBE_ATT_VAR) { __syncthreads(); if (F.tid == 0) F.MISC[0] = __hip_atomic_fetch_add(F.ctl + CW_AQ + 64 * qsel, 1u, RLX_AGENT); __syncthreads(); continue; }
#ifdef ONLY_VAR2
        att::attn_unit2<ONLY_VAR2>(P, b, h, qb, sh, F.tid, F.ctl + CW_AQ + 64 * qsel, F.MISC);
#else
        if (tv == 2) att::attn_unit<2>(P, b, h, qb, sh, F.tid, qsel >= 2 ? PROBE_ATT_MODE : 0, F.ctl + CW_AQ + 64 * qsel, F.MISC);
        else if (tv == 1) att::attn_unit<1>(P, b, h, qb, sh, F.tid, qsel >= 2 ? PROBE_ATT_MODE : 0, F.ctl + CW_AQ + 64 * qsel, F.MISC);
        else if (tv == 3) att::attn_unit<3>(P, b, h, qb, sh, F.tid, qsel >= 2 ? PROBE_ATT_MODE : 0, F.ctl + CW_AQ + 64 * qsel, F.MISC);
        else att::attn_unit2<0>(P, b, h, qb, sh, F.tid, F.ctl + CW_AQ + 64 * qsel, F.MISC);
#endif
        if (cv) {
            const int gb = (int)F.MISC[3] * CV_CHUNK;
            if (gb >= CV_TOTAL) { cv = false; P.cvq = nullptr; } else convert_chunk(F, A, gb, rsl2);
            __syncthreads();
        }
    }
    while (cv) {
        __syncthreads();
        if (F.tid == 0) F.MISC[3] = __hip_atomic_fetch_add(F.ctl + CW_CVQ, 1u, RLX_AGENT);
        __syncthreads();
        const int gb = (int)F.MISC[3] * CV_CHUNK;
        if (gb >= CV_TOTAL) cv = false; else convert_chunk(F, A, gb, rsl2);
    }
    __syncthreads();
}

template <int N, int Dd> __device__ __forceinline__ void bfly(float (&p)[32], int lane) { const bool up = (lane & Dd) != 0;
#pragma unroll
    for (int j = 0; j < N / 2; ++j) { const float a = p[2 * j], bb = p[2 * j + 1]; const float send = up ? a : bb, keep = up ? bb : a; p[j] = keep + __shfl_xor(send, Dd); } }
__device__ __forceinline__ void p6_router(Frame& F, const Args& A, int l, int rep) {
    const float* MOD = (const float*)(F.ws + WS_MOD); const bf16* X1 = (const bf16*)(F.ws + WS_X1); bf16* H = (bf16*)(F.ws + WS_H);
    const bf16* WRH = (const bf16*)(F.ws + WS_WR) + (size_t)l * 48 * DM; const bf16* WRL = WRH + 2 * 48 * DM;
    int* tok_e = (int*)(F.ws + WS_TOK); float* tok_w = (float*)(F.ws + WS_TOK) + 2 * M; int* tok_pos = (int*)(F.ws + WS_TOK) + 4 * M;
    constexpr int AP = 528;
    LAS unsigned char* Ahi = F.lds; LAS unsigned char* Alo = F.lds + 64 * AP; LAS unsigned char* Bhi = F.lds + 128 * AP; LAS unsigned char* Blo = F.lds + 176 * AP;
    LAS float* PL = (LAS float*)F.lds;
    const int lane = F.lane, w = F.wave; const int mw = (F.vcu * NWAVES + w) * 8; const int b = mw >> 11;
    const float* md = MOD + ((size_t)l * 8 + b) * 6144;
    f32x4 hv[8][4];
#pragma unroll
    for (int r = 0; r < 8; ++r) {
        const bf16* xr = X1 + (size_t)(mw + r) * DM;
#pragma unroll
        for (int j = 0; j < 4; ++j) { const u32x2 q = *(const u32x2*)(xr + 256 * j + 4 * lane); hv[r][j] = (f32x4){bf2f(q.x & 0xffff), bf2f(q.x >> 16), bf2f(q.y & 0xffff), bf2f(q.y >> 16)}; }
    }
    { f32x4 gm[4], sc[4], sh[4]; const float* n2 = inp<I_N2G>() + l * DM;
#pragma unroll
      for (int j = 0; j < 4; ++j) { const int col = 256 * j + 4 * lane; gm[j] = *(const f32x4*)(n2 + col); sc[j] = *(const f32x4*)(md + 4 * DM + col); sh[j] = *(const f32x4*)(md + 3 * DM + col); gm[j] = gm[j] * (sc[j] + 1.0f); }
#pragma unroll
      for (int r = 0; r < 8; ++r) { float ss = 0.f;
#pragma unroll
        for (int j = 0; j < 4; ++j) ss += (hv[r][j][0] * hv[r][j][0] + hv[r][j][1] * hv[r][j][1]) + (hv[r][j][2] * hv[r][j][2] + hv[r][j][3] * hv[r][j][3]);
        const float rstd = 1.0f / sqrtf(wave_sum(ss) * (1.f / DM) + RMS_EPS);
#pragma unroll
        for (int j = 0; j < 4; ++j) { hv[r][j] = hv[r][j] * rstd * gm[j] + sh[j]; u32x2 pk; pk.x = pk2(hv[r][j][0], hv[r][j][1]); pk.y = pk2(hv[r][j][2], hv[r][j][3]);
            *(u32x2*)(H + (size_t)(mw + r) * DM + 256 * j + 4 * lane) = pk; } } }
    const int rt = w & 3, kh = w >> 2, arow = lane & 15, kg = lane >> 4;
    f32x4 acc[3];
#pragma unroll
    for (int c = 0; c < 3; ++c) acc[c] = (f32x4){0.f, 0.f, 0.f, 0.f};
    u32x4 bpre[2][3];
    const auto loadB = [&](int j) {
#pragma unroll
        for (int k = 0; k < 3; ++k) { const int i = F.tid + 512 * k, o = i >> 5, c16 = i & 31;
            bpre[0][k] = *(const u32x4*)(WRH + (size_t)o * DM + 256 * j + 8 * c16); bpre[1][k] = *(const u32x4*)(WRL + (size_t)o * DM + 256 * j + 8 * c16); } };
    loadB(0);
#pragma unroll
    for (int j = 0; j < 4; ++j) {
        __syncthreads();
#pragma unroll
        for (int r = 0; r < 8; ++r) { const f32x4 x = hv[r][j]; unsigned h0 = f2bf(x[0]), h1 = f2bf(x[1]), h2 = f2bf(x[2]), h3 = f2bf(x[3]);
            u32x2 hi; hi.x = h0 | (h1 << 16); hi.y = h2 | (h3 << 16);
            u32x2 lo; lo.x = pk2(x[0] - bf2f((unsigned short)h0), x[1] - bf2f((unsigned short)h1)); lo.y = pk2(x[2] - bf2f((unsigned short)h2), x[3] - bf2f((unsigned short)h3));
            *(LAS u32x2*)(Ahi + (w * 8 + r) * AP + lane * 8) = hi; *(LAS u32x2*)(Alo + (w * 8 + r) * AP + lane * 8) = lo; }
#pragma unroll
        for (int k = 0; k < 3; ++k) { const int i = F.tid + 512 * k, o = i >> 5, c16 = i & 31; *(LAS u32x4*)(Bhi + o * AP + c16 * 16) = bpre[0][k]; *(LAS u32x4*)(Blo + o * AP + c16 * 16) = bpre[1][k]; }
        if (j + 1 < 4) loadB(j + 1);
        LDS_WAIT(); __syncthreads();
#pragma unroll
        for (int ks = 0; ks < 4; ++ks) { const int kb = ((4 * kh + ks) * 32 + 8 * kg) * 2;
            const bf16x8 ah = *(const LAS bf16x8*)(Ahi + (16 * rt + arow) * AP + kb), al = *(const LAS bf16x8*)(Alo + (16 * rt + arow) * AP + kb);
#pragma unroll
            for (int c = 0; c < 3; ++c) { const bf16x8 bh = *(const LAS bf16x8*)(Bhi + (16 * c + arow) * AP + kb), bl = *(const LAS bf16x8*)(Blo + (16 * c + arow) * AP + kb);
                acc[c] = __builtin_amdgcn_mfma_f32_16x16x32_bf16(ah, bh, acc[c], 0, 0, 0);
                acc[c] = __builtin_amdgcn_mfma_f32_16x16x32_bf16(al, bh, acc[c], 0, 0, 0);
                acc[c] = __builtin_amdgcn_mfma_f32_16x16x32_bf16(ah, bl, acc[c], 0, 0, 0); } }
    }
    __syncthreads();
#pragma unroll
    for (int c = 0; c < 3; ++c)
#pragma unroll
        for (int r = 0; r < 4; ++r) PL[(kh * 64 + 16 * rt + kg * 4 + r) * 48 + 16 * c + arow] = acc[c][r];
    LDS_WAIT(); __syncthreads();
    if (F.tid < 64 && rep == 0) {
        const int m = F.vcu * 64 + F.tid; const LAS float* q0 = PL + F.tid * 48; const LAS float* q1 = PL + (64 + F.tid) * 48;
        float gl[4]; int gi = 0; float gm;
#pragma unroll
        for (int g = 0; g < 4; ++g) gl[g] = (q0[g] + q1[g]) + inp<I_BG>()[l * 4 + g];
        gm = gl[0];
#pragma unroll
        for (int g = 1; g < 4; ++g) if (gl[g] > gm) { gm = gl[g]; gi = g; }
        float den = 0.f;
#pragma unroll
        for (int g = 0; g < 4; ++g) den += __expf(gl[g] - gm);
        const float gprob = 1.0f / den;
        float v1 = -INFINITY, v2 = -INFINITY; int i1 = 0, i2 = 0;
        for (int e = 0; e < 8; ++e) { const float v = (q0[4 + gi * 8 + e] + q1[4 + gi * 8 + e]) + inp<I_BE>()[l * 32 + gi * 8 + e];
            if (v > v1) { v2 = v1; i2 = i1; v1 = v; i1 = e; } else if (v > v2) { v2 = v; i2 = e; } }
        const float e2 = __expf(v2 - v1); const float w1 = gprob / (1.f + e2), w2 = gprob * e2 / (1.f + e2);
        const int ea = gi * 8 + i1, eb = gi * 8 + i2;
        tok_e[m] = ea; tok_e[M + m] = eb; tok_w[m] = w1; tok_w[M + m] = w2;
        LAS unsigned* lcnt = (LAS unsigned*)(F.lds + 32768); LAS unsigned* lbase = lcnt + 32;
        if (F.tid < 32) lcnt[F.tid] = 0u;
        asm volatile("s_waitcnt lgkmcnt(0)" ::: "memory");
        const unsigned ra = __hip_atomic_fetch_add(lcnt + ea, 1u, __ATOMIC_RELAXED, __HIP_MEMORY_SCOPE_WORKGROUP), rb = __hip_atomic_fetch_add(lcnt + eb, 1u, __ATOMIC_RELAXED, __HIP_MEMORY_SCOPE_WORKGROUP);
        asm volatile("s_waitcnt lgkmcnt(0)" ::: "memory");
        if (F.tid < 32) { const unsigned n = *(volatile LAS unsigned*)(lcnt + F.tid); unsigned bs = 0u; if (n) bs = __hip_atomic_fetch_add(F.ctl + CW_CNT + (l * 32 + F.tid) * 16, n, RLX_AGENT); *(volatile LAS unsigned*)(lbase + F.tid) = bs; }
        asm volatile("s_waitcnt vmcnt(0) lgkmcnt(0)" ::: "memory");
        const int pa = (int)(*(volatile LAS unsigned*)(lbase + ea) + ra), pb = (int)(*(volatile LAS unsigned*)(lbase + eb) + rb);
        tok_pos[m] = pa; tok_pos[M + m] = pb;
        int* elist = (int*)(F.ws + WS_ELIST); elist[ea * M + pa] = m; elist[eb * M + pb] = m;
    }
}

__device__ __forceinline__ void build_rowlists(Frame& F, int l) {
    volatile LAS int* base = (volatile LAS int*)(F.lds + BASE_OFF); volatile LAS int* cnts = (volatile LAS int*)(F.lds + CNTS_OFF); volatile LAS int* tab = (volatile LAS int*)(F.lds + TAB_OFF);
    LAS int* rowl = (LAS int*)(F.lds + ROWL_OFF); const int* elist = (const int*)(F.ws + WS_ELIST);
    const int ntile = (int)F.MISC[1];
    const int i = F.tid >> 8, r = F.tid & 255; const long L = (long)i * F.G + F.bx;
    int tok = 0;
    if (L < 2L * ntile) { const int tile = (int)(L >> 1), e = tab[tile], pos = 256 * (tile - base[e]) + r; if (pos < cnts[e]) tok = elist[e * M + pos]; }
    rowl[F.tid] = tok;
    __syncthreads();
}

constexpr int NPL = 7, NPH = 2 + 2 * NPL;
__global__ void __launch_bounds__(NWAVES * 64, 2) mk_fwd(Args args) {
    extern __shared__ __attribute__((aligned(16))) unsigned char lds[];
    Frame F;
    F.lds = (LAS unsigned char*)lds;
    F.MISC = (volatile LAS unsigned*)(F.lds + MISC_OFF);
    F.tid = threadIdx.x; F.lane = F.tid & 63; F.wave = __builtin_amdgcn_readfirstlane(F.tid >> 6);
    const int wave0 = F.wave;
    F.G = gridDim.x; F.bx = blockIdx.x; F.vcu = 0;
    F.ws = args.ws; F.out = args.out; F.ctl = (unsigned*)(args.ws + WS_CTL);
    for (int u = F.tid; u < (LDS_BYTES - LDSCTL_OFF) / 4; u += NWAVES * 64) ((LAS unsigned*)(F.lds + LDSCTL_OFF))[u] = 0u;
    __syncthreads();
    XcdBarrier bar; bar.bar = F.ctl + CW_BAR; bar.x = 0; bar.st = nullptr;
    if (!MK_PER_PHASE) bar = xcd_barrier_post(F.ctl + CW_BAR, F.MISC + 8);
    const int lo = args.ph_lo, hi = args.ph_hi;
#pragma unroll 1
    for (int ph = lo; ph < hi; ++ph) {
#if PROBE_REP_K >= 0
        const int ptype = ph == 0 ? 0 : (ph == NPH - 1 ? 10 : 1 + (ph - 1) % NPL);
        const int nrep = (ptype == PROBE_REP_K && (ph <= NPL || (PROBE_REP_K != 1 && PROBE_REP_K != 5))) ? 1 : 0;
#pragma unroll 1
        for (int rep = 0; rep <= nrep; ++rep) {
#else
        constexpr int rep = 0;
#endif
        { int w_ = wave0; asm volatile("" : "+s"(w_)); unsigned on_ = ~0u; asm volatile("" : "+s"(on_)); int ln_ = (int)__builtin_amdgcn_mbcnt_hi(on_, __builtin_amdgcn_mbcnt_lo(on_, 0u)); asm volatile("" : "+v"(ln_));
          F.wave = w_; F.lane = ln_; F.tid = w_ * 64 + ln_;
          unsigned long long ws_ = (unsigned long long)args.ws; asm volatile("" : "+s"(ws_)); F.ws = (unsigned char*)(GAS unsigned char*)ws_; F.ctl = (unsigned*)(F.ws + WS_CTL);
          int bx_ = blockIdx.x; asm volatile("" : "+s"(bx_)); F.bx = bx_; F.vcu = (F.G % 8 == 0) ? (bx_ % 8) * (F.G / 8) + bx_ / 8 : bx_; }
        if (ph == 0) {
#ifndef SKIP_P0
            p0_prologue(F, args);
#endif
        } else if (ph == NPH - 1) {
            row_pass(F, args, 2, 1);
        } else {
            const int l = (ph - 1) / NPL, k = (ph - 1) % NPL;
            if (k == 0) { row_pass(F, args, l == 0 ? 0 : 1, l); }
            else if (k == 1) {
                pg8::Gemm g{(const bf16*)(F.ws + WS_H), (const bf16*)(F.ws + WS_WIN) + (size_t)l * NP * DM, M, NP, DM}; pg8::StaticOrder S; S.init(M, NP, F.G, F.bx);
                pg8::EpiBf16 E{(bf16*)(F.ws + WS_PROJ), NP};
#ifndef SKIP_G1
                pg8::gemm_phase<pg8::EpiBf16, pg8::StaticOrder, true, true>(F.lds, g, S, E, F.tid);
#endif
            } else if (k == 2) {
#ifndef SKIP_P3
                p3_prep(F, args, l, rep);
#endif
            } else if (k == 3) {
#ifndef SKIP_P4
                p4_attention(F, args, l, l + 2 * rep);
#endif
            } else if (k == 4) {
                pg8::Gemm g{(const bf16*)(F.ws + WS_MIX), (const bf16*)(F.ws + WS_WOUT) + (size_t)l * DM * DM, M, DM, DM}; pg8::StaticOrder S; S.init(M, DM, F.G, F.bx);
                pg8::EpiResGate E{l == 0 ? inp<I_X>() : nullptr, (const bf16*)(F.ws + WS_X1), (bf16*)(F.ws + WS_X1), (const float*)(F.ws + WS_MOD) + (size_t)l * 8 * 6144 + 2 * DM};
#ifndef SKIP_G2
                pg8::gemm_phase<pg8::EpiResGate, pg8::StaticOrder, false, true>(F.lds, g, S, E, F.tid);
#endif
            } else if (k == 5) {
#ifndef SKIP_P6
                p6_router(F, args, l, rep);
#endif
            } else {
                build_tables(F, l); build_rowlists(F, l);
                unsigned* upf = F.ctl + CW_UPF + l * 8192; unsigned* dq = F.ctl + CW_DNQ + 16 * l;
                { pg8::Gemm g{(const bf16*)(F.ws + WS_H), (const bf16*)(F.ws + WS_WUP) + (size_t)l * NEXP * 512 * DM, MAXSLOT, 512, DM};
                  pg8::GroupOrder S{(const LAS int*)(F.lds + TAB_OFF), (int)F.MISC[1], 2, F.G, F.bx, (size_t)512 * DM * 2};
                  pg8::EpiSwiglu E{(bf16*)(F.ws + WS_HID), upf};
#ifndef SKIP_G3
                  pg8::gemm_phase<pg8::EpiSwiglu, pg8::GroupOrder, true, true, true>(F.lds, g, S, E, F.tid, (const LAS int*)(F.lds + ROWL_OFF));
#endif
                }
                if (GAP_CONVERT && !BG_CONVERT && l == 0 && rep == 0) convert_layer1_in_gap(F, args, 2 * (int)F.MISC[1] - F.G);
                { const pg8::Gemm g{(const bf16*)(F.ws + WS_HID), (const bf16*)(F.ws + WS_WDN) + (size_t)l * NEXP * DM * FF, MAXSLOT, DM, FF};
                  const pg8::EpiBf16 E{(bf16*)(F.ws + WS_Y), DM};
                  const LAS int* tab = (const LAS int*)(F.lds + TAB_OFF);
                  const int nd = 4 * __builtin_amdgcn_readfirstlane((int)F.MISC[1]);
                  pg8::DynOrder S{dq, upf, tab, F.MISC, nd, (size_t)DM * FF * 2, F.tid, (unsigned)F.G, 0u, 2u};
                  if (F.tid == 0) { const unsigned a = (unsigned)F.bx, b = (unsigned)F.G + __hip_atomic_fetch_add(dq, 1u, RLX_AGENT); F.MISC[4] = a; F.MISC[5] = b;
                      if ((int)a < nd) while (__hip_atomic_load(upf + (a >> 2) * 16, RLX_AGENT) < 2u) __builtin_amdgcn_s_sleep(8);
                      __builtin_amdgcn_fence(__ATOMIC_ACQUIRE, "agent"); asm volatile("s_waitcnt vmcnt(0)" ::: "memory"); S.issue(b); }
                  __syncthreads();
                  for (;;) {
                      if (__builtin_amdgcn_readfirstlane((int)F.MISC[4]) >= nd) break;
#ifndef SKIP_G4
                      pg8::gemm_phase<pg8::EpiBf16, pg8::DynOrder, true, true>(F.lds, g, S, E, F.tid);
#endif
                      if (F.tid == 0) {
                          const unsigned idn = F.MISC[5];
                          if ((int)idn < nd) { unsigned f = S.pflag; while (f < 2u) { __builtin_amdgcn_s_sleep(8); f = __hip_atomic_load(upf + (idn >> 2) * 16, RLX_AGENT); }
                              __builtin_amdgcn_fence(__ATOMIC_ACQUIRE, "agent"); asm volatile("s_waitcnt vmcnt(0)" ::: "memory"); }
                          const unsigned idn2 = S.ppop; F.MISC[4] = idn; F.MISC[5] = idn2; S.issue(idn2); }
                      __syncthreads();
                  }
                }
            }
        }
#if PROBE_REP_K >= 0
        if (rep < nrep) xcd_barrier(bar, F.tid);
        }
#endif
        if (ph + 1 < hi) xcd_barrier(bar, F.tid);
#ifdef PROBE_DOUBLE_BAR
        if (ph + 1 < hi) xcd_barrier(bar, F.tid);
#endif
    }
}

extern "C" void kernel_launch(void* const* d_in, const int* in_sizes, int n_in, void* d_out, int out_size, void* d_ws, size_t ws_size, hipStream_t stream) {
    static int grid = 0;
    if (grid == 0) {
        if (n_in != 28 || out_size != M * DM || ws_size < WS_END) { fprintf(stderr, "kernel_launch: unexpected shapes (n_in %d, out %d, ws %zu)\n", n_in, out_size, ws_size); grid = -1; return; }
        int dev = 0, cus = 0, per_cu = 0;
        if (hipGetDevice(&dev) != hipSuccess || hipDeviceGetAttribute(&cus, hipDeviceAttributeMultiprocessorCount, dev) != hipSuccess) { grid = -1; return; }
        if (hipFuncSetAttribute((const void*)mk_fwd, hipFuncAttributeMaxDynamicSharedMemorySize, LDS_BYTES) != hipSuccess) { fprintf(stderr, "kernel_launch: hipFuncSetAttribute failed\n"); grid = -1; return; }
        if (hipOccupancyMaxActiveBlocksPerMultiprocessor(&per_cu, (const void*)mk_fwd, NWAVES * 64, LDS_BYTES) != hipSuccess || per_cu < 1)
            fprintf(stderr, "kernel_launch: occupancy query reports %d workgroups per CU\n", per_cu);
        (void)hipGetLastError();
        grid = cus;
    }
    if (grid < 0) return;
    if (hipMemsetAsync((char*)d_ws + WS_CTL, 0, CTL_ZERO_BYTES, stream) != hipSuccess) return;
    Args a{};
    for (int i = 0; i < 28; ++i) a.in[i] = (const float*)d_in[i];
    a.out = (float*)d_out; a.ws = (unsigned char*)d_ws;
#if MK_PER_PHASE
    for (int p = 0; p < NPH; ++p) { a.ph_lo = p; a.ph_hi = p + 1; hipLaunchKernelGGL(mk_fwd, dim3(grid), dim3(NWAVES * 64), LDS_BYTES, stream, a); }
#else
    a.ph_lo = 0; a.ph_hi = NPH; hipLaunchKernelGGL(mk_fwd, dim3(grid), dim3(NWAVES * 64), LDS_BYTES, stream, a);
#endif
}
```

```cpp
#include <hip/hip_runtime.h>
#include <cstdio>
#include <cstdint>

#ifndef MK_PER_PHASE
#define MK_PER_PHASE 0
#endif

#ifndef PROBE_P3_PART
#define PROBE_P3_PART 0
#endif
#ifndef PROBE_ATT_VAR
#define PROBE_ATT_VAR -1
#endif
#ifndef BG_CONVERT
#define BG_CONVERT 1
#endif
#ifndef GAP_CONVERT
#define GAP_CONVERT 1
#endif
#ifndef PROBE_ATT_MODE
#define PROBE_ATT_MODE 0
#endif
#ifndef PROBE_REP_K
#define PROBE_REP_K -1
#endif
#define LAS __attribute__((address_space(3)))
#define GAS __attribute__((address_space(1)))
typedef unsigned short bf16;
typedef short bf16x8 __attribute__((ext_vector_type(8)));
typedef short s16x4 __attribute__((ext_vector_type(4)));
typedef float f32x4 __attribute__((ext_vector_type(4)));
typedef float f32x2 __attribute__((ext_vector_type(2)));
typedef float f32x16 __attribute__((ext_vector_type(16)));
typedef unsigned u32x4 __attribute__((ext_vector_type(4)));
typedef unsigned u32x2 __attribute__((ext_vector_type(2)));

constexpr int BATCH = 8, SEQ = 2048, DM = 1024, M = BATCH * SEQ, DEPTH = 2;
constexpr int NP = 3072;
constexpr int P_IN = 2988;
constexpr int C_AQ = 0, C_AK = 256, C_AV = 512, C_BQ = 768, C_BK = 1024, C_BV = 1280, C_CQ = 1536, C_CK = 1792, C_CV = 2048,
              C_DQ = 2304, C_DK = 2560, C_DV = 2624, C_IQ = 2688, C_IK = 2944, C_IW = 2976, C_AF = 2984;
constexpr int NEXP = 32, FF = 256, MAXSLOT = M * 2 + NEXP * 256, MAXTILE = MAXSLOT / 256;
constexpr float LOG2E = 1.4426950408889634f;
constexpr float RMS_EPS = 1e-6f;

constexpr size_t MiB = 1u << 20;
constexpr size_t WS_CTL = 0, CTL_ZERO_BYTES = 1 * MiB;
constexpr size_t WS_WR = 1 * MiB;
constexpr size_t WS_MOD = 2 * MiB;
constexpr size_t WS_CUM = 3 * MiB;
constexpr size_t WS_TOK = 4 * MiB;
constexpr size_t WS_MISC = 5 * MiB;
constexpr size_t WS_MASK = 6 * MiB;
constexpr size_t WS_WIN = 10 * MiB;
constexpr size_t WS_WOUT = 22 * MiB;
constexpr size_t WS_WUP = 26 * MiB;
constexpr size_t WS_WDN = 90 * MiB;
constexpr size_t WS_X1 = 122 * MiB;
constexpr size_t WS_H = 186 * MiB;
constexpr size_t WS_MIX = WS_H;

constexpr size_t WS_PROJ = 218 * MiB;
constexpr size_t WS_Y = WS_PROJ;
constexpr size_t WS_HID = WS_PROJ + 80 * MiB;
constexpr size_t WS_ELIST = 322 * MiB;
constexpr size_t WS_END = 324 * MiB;
constexpr int CW_AQ = 256;
constexpr int CW_CNT = 1024;
constexpr int CW_BAR = 8192;
constexpr int CW_DNQ = 208;
constexpr int CW_UPF = 65536;

constexpr int RING_BYTES = 143360;
constexpr int LDSCTL_OFF = RING_BYTES, MISC_OFF = LDSCTL_OFF + 320, CNTS_OFF = LDSCTL_OFF + 512, BASE_OFF = LDSCTL_OFF + 640, TAB_OFF = LDSCTL_OFF + 768;
constexpr int ROWL_OFF = 131072;
constexpr int LDS_BYTES = 147456;
constexpr int NWAVES = 8;

#define LDS_WAIT() asm volatile("s_waitcnt lgkmcnt(0)" ::: "memory")
#define VM_WAIT() asm volatile("s_waitcnt vmcnt(0)" ::: "memory")
#define RLX_AGENT __ATOMIC_RELAXED, __HIP_MEMORY_SCOPE_AGENT

__device__ __forceinline__ float bf2f(unsigned short u) { return __builtin_bit_cast(float, (unsigned)u << 16); }
__device__ __forceinline__ unsigned f2bf(float f) { unsigned u = __builtin_bit_cast(unsigned, f); return (u + 0x7fffu + ((u >> 16) & 1u)) >> 16; }
__device__ __forceinline__ unsigned pk2(float lo, float hi) { return f2bf(lo) | (f2bf(hi) << 16); }
template <int O> __device__ __forceinline__ float shx(float x) { static_assert(O >= 1 && O <= 16, "swizzle xor"); return __builtin_bit_cast(float, __builtin_amdgcn_ds_swizzle(__builtin_bit_cast(int, x), (O << 10) | 0x1f)); }
__device__ __forceinline__ float half_sum(float x) { return __builtin_bit_cast(float, __builtin_amdgcn_readlane(__builtin_bit_cast(int, x), 0)) + __builtin_bit_cast(float, __builtin_amdgcn_readlane(__builtin_bit_cast(int, x), 32)); }
__device__ __forceinline__ float half_max(float x) { return fmaxf(__builtin_bit_cast(float, __builtin_amdgcn_readlane(__builtin_bit_cast(int, x), 0)), __builtin_bit_cast(float, __builtin_amdgcn_readlane(__builtin_bit_cast(int, x), 32))); }
__device__ __forceinline__ float shup(float x, int o, int lane) { return __builtin_bit_cast(float, __builtin_amdgcn_ds_bpermute((lane - o) << 2, __builtin_bit_cast(int, x))); }
__device__ __forceinline__ int shup_i(int x, int o, int lane) { return __builtin_amdgcn_ds_bpermute((lane - o) << 2, x); }
__device__ __forceinline__ float wave_sum(float v) { v += shx<1>(v); v += shx<2>(v); v += shx<4>(v); v += shx<8>(v); v += shx<16>(v); return half_sum(v); }

namespace pg8 {
constexpr int BM = 256, BK = 64, HALF = 128, HTB = HALF * BK * 2, STAGE_BYTES = 8 * HTB, NXCD = 8, WGM = 8;
__host__ __device__ __forceinline__ int lds_byte(int r, int c) { const int st = (r >> 4) * 2 + (c >> 5), rr = r & 15, cc = c & 31, ob = rr * 64 + cc * 2; return st * 1024 + (ob ^ (((ob >> 9) & 1) << 5)); }
__host__ __device__ __forceinline__ void stage_rc(int b, int& R, int& C) { const int st = b / 1024, sb = b % 1024, swz = sb ^ (((sb >> 9) & 1) << 5); R = (st >> 1) * 16 + swz / 64; C = (st & 1) * 32 + (swz % 64) / 2; }
__host__ __device__ __forceinline__ int perm32(int rho) { const int n = rho >> 4, i = rho & 15; return 8 * (i >> 2) + 4 * n + (i & 3); }

struct Unit { int pm, pn; size_t bo; };
struct Gemm { const bf16* A; const bf16* Bt; int M, N, K; };

struct StaticOrder {
    int nM, nN, nwg, G, c;
    __host__ __device__ void init(int M_, int N_, int G_, int c_) { nM = M_ / BM; nN = N_ / BM; nwg = nM * nN; G = G_; c = c_; }
    __host__ __device__ bool next(int i, Unit& u) const {
        const long L = (long)i * G + c; if (L >= nwg) return false;
        int wgid = (int)L; { const int q = nwg / NXCD, r = nwg % NXCD, xcd = wgid % NXCD, off = wgid / NXCD; wgid = (xcd < r ? xcd * (q + 1) : r * (q + 1) + (xcd - r) * q) + off; }
        const int nig = WGM * nN, gid = wgid / nig, fm = gid * WGM, gsz = (nM - fm) < WGM ? (nM - fm) : WGM;
        u.pm = fm + ((wgid % nig) % gsz); u.pn = (wgid % nig) / gsz; u.bo = 0; return true;
    }
};
struct GroupOrder {
    const LAS int* tab; int ntile, ncol, G, c; size_t ebytes;
    __device__ __forceinline__ bool next(int i, Unit& u) const {
        const long L = (long)i * G + c; if (L >= (long)ntile * ncol) return false;
        u.pm = (int)(L / ncol); u.pn = (int)(L % ncol);
        const int e = __builtin_amdgcn_readfirstlane(tab[u.pm]); u.bo = (size_t)e * ebytes; return true;
    }
};

struct OneUnit { Unit u; __device__ __forceinline__ bool next(int i, Unit& o) const { if (i != 0) return false; o = u; return true; } };
struct DynOrder {
    unsigned* dq; unsigned* upf; const LAS int* tab; volatile LAS unsigned* M; int nd; size_t ebytes; int tid; unsigned G;
    mutable unsigned ppop, pflag;
    __device__ __forceinline__ void issue(unsigned idnext) const {
        ppop = G + __builtin_amdgcn_atomic_inc32(dq, 0xFFFFFFFFu, __ATOMIC_RELAXED, "agent");
        pflag = 2u; if ((int)idnext < nd) pflag = __hip_atomic_load(upf + (idnext >> 2) * 16, __ATOMIC_RELAXED, __HIP_MEMORY_SCOPE_AGENT);
    }
    __device__ __forceinline__ void unit(int id, Unit& u) const { u.pm = id >> 2; u.pn = id & 3; u.bo = (size_t)__builtin_amdgcn_readfirstlane(tab[id >> 2]) * ebytes; }
    __device__ __forceinline__ bool next(int i, Unit& u) const {
        if (i == 0) { const int id = __builtin_amdgcn_readfirstlane((int)M[4]); if (id >= nd) return false; unit(id, u); return true; }
        if (tid == 0) {
            const unsigned idn = M[5]; const bool ready = (int)idn < nd && pflag >= 2u;
            M[6] = ready ? 1u : 0u;
            if (ready) { asm volatile("buffer_inv sc1" ::: "memory"); M[4] = idn; const unsigned idn2 = ppop; M[5] = idn2; issue(idn2); }
        }
        asm volatile("s_waitcnt lgkmcnt(0)\n\ts_barrier" ::: "memory");
        if (__builtin_amdgcn_readfirstlane((int)M[6]) == 0) return false;
        unit(__builtin_amdgcn_readfirstlane((int)M[4]), u); return true;
    }
};

__device__ __forceinline__ unsigned cvt_pk_bf16(float lo, float hi) { unsigned r; asm volatile("v_cvt_pk_bf16_f32 %0, %1, %2" : "=v"(r) : "v"(lo), "v"(hi)); return r; }

struct EpiBf16 {
    static constexpr bool PERM = true, PUBLISH = false;
    bf16* O; int ldc;
    __device__ __forceinline__ void operator()(const f32x4 (&acc)[2][2][4][2], const Unit& u, int wr, int wc, int fr, int fq) const {
        const int row0 = u.pm * BM + wr * 64 + fr; const int col0 = u.pn * BM + wc * 32 + 8 * fq;
#pragma unroll
        for (int ai = 0; ai < 2; ++ai)
#pragma unroll
            for (int m = 0; m < 4; ++m) { bf16* rowp = O + (size_t)(row0 + ai * HALF + m * 16) * ldc + col0;
#pragma unroll
                for (int bj = 0; bj < 2; ++bj) { const f32x4 v0 = acc[ai][bj][m][0], v1 = acc[ai][bj][m][1];
                    u32x4 w; w.x = cvt_pk_bf16(v0[0], v0[1]); w.y = cvt_pk_bf16(v0[2], v0[3]); w.z = cvt_pk_bf16(v1[0], v1[1]); w.w = cvt_pk_bf16(v1[2], v1[3]);
                    *(u32x4*)(rowp + bj * HALF) = w; } }
    }
};
struct EpiResGate {
    static constexpr bool PERM = true, PUBLISH = false;
    const float* base32; const bf16* base16; bf16* out; const float* gate;
    __device__ __forceinline__ void operator()(const f32x4 (&acc)[2][2][4][2], const Unit& u, int wr, int wc, int fr, int fq) const {
        const int col0 = u.pn * BM + wc * 32 + 8 * fq; const float* g = gate + (size_t)(u.pm >> 3) * 6144 + col0;
        f32x4 gv[2][2];
#pragma unroll
        for (int bj = 0; bj < 2; ++bj)
#pragma unroll
            for (int n = 0; n < 2; ++n) gv[bj][n] = *(const f32x4*)(g + bj * HALF + n * 4);
#pragma unroll
        for (int ai = 0; ai < 2; ++ai)
#pragma unroll
            for (int m = 0; m < 4; ++m) { const size_t off = (size_t)(u.pm * BM + ai * HALF + wr * 64 + m * 16 + fr) * DM + col0;
#pragma unroll
                for (int bj = 0; bj < 2; ++bj) { f32x4 b0, b1;
                    if (base32) { b0 = *(const f32x4*)(base32 + off + bj * HALF); b1 = *(const f32x4*)(base32 + off + bj * HALF + 4); }
                    else { const u32x4 r = *(const u32x4*)(base16 + off + bj * HALF);
                        b0 = (f32x4){bf2f(r.x & 0xffff), bf2f(r.x >> 16), bf2f(r.y & 0xffff), bf2f(r.y >> 16)}; b1 = (f32x4){bf2f(r.z & 0xffff), bf2f(r.z >> 16), bf2f(r.w & 0xffff), bf2f(r.w >> 16)}; }
                    const f32x4 v0 = b0 + gv[bj][0] * acc[ai][bj][m][0], v1 = b1 + gv[bj][1] * acc[ai][bj][m][1];
                    u32x4 w; w.x = cvt_pk_bf16(v0[0], v0[1]); w.y = cvt_pk_bf16(v0[2], v0[3]); w.z = cvt_pk_bf16(v1[0], v1[1]); w.w = cvt_pk_bf16(v1[2], v1[3]);
                    *(u32x4*)(out + off + bj * HALF) = w; } }
    }
};
struct EpiSwiglu {
    static constexpr bool PERM = true, PUBLISH = true;
    bf16* O; unsigned* flag;
    __device__ __forceinline__ void operator()(const f32x4 (&acc)[2][2][4][2], const Unit& u, int wr, int wc, int fr, int fq) const {
        const int row0 = u.pm * BM + wr * 64 + fr; const int col0 = u.pn * HALF + wc * 32 + 8 * fq;
#pragma unroll
        for (int ai = 0; ai < 2; ++ai)
#pragma unroll
            for (int m = 0; m < 4; ++m) { bf16* rowp = O + (size_t)(row0 + ai * HALF + m * 16) * FF + col0;
                float hv[8];
#pragma unroll
                for (int n = 0; n < 2; ++n)
#pragma unroll
                    for (int i = 0; i < 4; ++i) { const float a = acc[ai][0][m][n][i], b = acc[ai][1][m][n][i];
                        const float sg = __builtin_amdgcn_rcpf(1.f + __builtin_amdgcn_exp2f(-a * LOG2E)); hv[n * 4 + i] = a * sg * b; }
                u32x4 w; w.x = cvt_pk_bf16(hv[0], hv[1]); w.y = cvt_pk_bf16(hv[2], hv[3]); w.z = cvt_pk_bf16(hv[4], hv[5]); w.w = cvt_pk_bf16(hv[6], hv[7]);
                asm volatile("global_store_dwordx4 %0, %1, off sc1\n\ts_nop 2" :: "v"((const GAS bf16*)rowp), "v"(w) : "memory"); }
    }
};

template <class Epi, class Sched, bool ALIGN_EPI = false, bool SP2 = false, bool GATHER = false>
__device__ __forceinline__ void gemm_phase(LAS unsigned char* lds, const Gemm g, const Sched& S, const Epi& E, const int tid, const LAS int* rowl = nullptr) {
    static_assert(!GATHER || SP2, "gather mode is written for the SP2 loop");
    const int wid = __builtin_amdgcn_readfirstlane(tid >> 6), lane = tid & 63, wr = wid >> 2, wc = wid & 3, fr = lane & 15, fq = lane >> 4;
    const int K = g.K, nt = K / BK;
    unsigned voffA[2], voffB[2];
#pragma unroll
    for (int i = 0; i < 2; ++i) { int R, C; stage_rc(tid * 16 + i * 8192, R, C); const int Rb = Epi::PERM ? ((R & ~31) + perm32(R & 31)) : R;
        voffA[i] = (unsigned)(R * K + C) * 2u; voffB[i] = (unsigned)(Rb * K + C) * 2u; }
    const size_t kstep = (size_t)(BK * 2);
    const size_t hstep = (size_t)HALF * K * 2;
    const size_t tstep = 2 * hstep;
    const size_t hstepA = GATHER ? 0 : hstep, tstepA = GATHER ? 0 : tstep;
    unsigned voffGc[2][2], voffGn[2][2];
    int gR[2], gC[2];
#pragma unroll
    for (int i = 0; i < 2; ++i) stage_rc(tid * 16 + i * 8192, gR[i], gC[i]);
#define PG8_GOFF(dst, ui_) do { _Pragma("unroll") for (int h_ = 0; h_ < 2; ++h_) _Pragma("unroll") for (int i_ = 0; i_ < 2; ++i_) \
        dst[h_][i_] = (unsigned)rowl[(ui_) * 256 + h_ * HALF + gR[i_]] * (unsigned)(K * 2) + (unsigned)gC[i_] * 2u; } while (0)
    const unsigned ldsw = (unsigned)wid * 1024u;
    const int aoff = lds_byte(wr * 64 + fr, fq * 8), boff = lds_byte(wc * 32 + fr, fq * 8);
#define PG8_SA(b, h) (((b) * 2 + (h)) * HTB)
#define PG8_SB(b, h) ((4 + (b) * 2 + (h)) * HTB)
#define PG8_STAGE(bufoff, gbase, voff) do { _Pragma("unroll") for (int _i = 0; _i < 2; ++_i) \
        __builtin_amdgcn_global_load_lds((const unsigned*)((const char*)(gbase) + (voff)[_i]), (LAS unsigned*)(lds + (bufoff) + ldsw + _i * 8192), 16, 0, 0); } while (0)
#define PG8_STAGE_A(bufoff, gbase, H, NXT) do { if constexpr (GATHER) { unsigned vo_[2]; vo_[0] = (NXT) ? voffGn[H][0] : voffGc[H][0]; vo_[1] = (NXT) ? voffGn[H][1] : voffGc[H][1]; PG8_STAGE(bufoff, gbase, vo_); } \
        else { PG8_STAGE(bufoff, (const char*)(gbase) + (H) * hstep, voffA); } } while (0)
#define PG8_LDA(dst, b, h) do { _Pragma("unroll") for (int m = 0; m < 4; ++m) _Pragma("unroll") for (int k = 0; k < 2; ++k) dst[m][k] = *(const LAS bf16x8*)(lds + PG8_SA(b, h) + aoff + m * 2048 + k * 1024); } while (0)
#define PG8_LDB(dst, b, h) do { _Pragma("unroll") for (int n = 0; n < 2; ++n) _Pragma("unroll") for (int k = 0; k < 2; ++k) dst[n][k] = *(const LAS bf16x8*)(lds + PG8_SB(b, h) + boff + n * 2048 + k * 1024); } while (0)
#define PG8_MMA(ai, bj, At, Bt) do { __builtin_amdgcn_s_setprio(1); _Pragma("unroll") for (int m = 0; m < 4; ++m) _Pragma("unroll") for (int n = 0; n < 2; ++n) _Pragma("unroll") for (int k = 0; k < 2; ++k) \
        acc[ai][bj][m][n] = __builtin_amdgcn_mfma_f32_16x16x32_bf16(Bt[n][k], At[m][k], acc[ai][bj][m][n], 0, 0, 0); __builtin_amdgcn_s_setprio(0); } while (0)
#define PG8_WAIT_V(n) asm volatile("s_waitcnt vmcnt(" #n ")" ::: "memory")
#define PG8_WAIT_L(n) asm volatile("s_waitcnt lgkmcnt(" #n ")" ::: "memory")
#define PG8_BAR __builtin_amdgcn_s_barrier()
#define PG8_SCHED __builtin_amdgcn_sched_barrier(0)
    Unit cur, nxt; int ui = 0;
    if (!S.next(0, cur)) return;
    f32x4 acc[2][2][4][2];
#pragma unroll
    for (int a = 0; a < 2; ++a)
#pragma unroll
        for (int b = 0; b < 2; ++b)
#pragma unroll
            for (int m = 0; m < 4; ++m)
#pragma unroll
                for (int n = 0; n < 2; ++n) acc[a][b][m][n] = (f32x4){0.f, 0.f, 0.f, 0.f};
    bf16x8 At[4][2], B0[2][2], B1[2][2];
    const char* cA = (const char*)g.A + (size_t)cur.pm * tstepA; const char* cB = (const char*)g.Bt + cur.bo + (size_t)cur.pn * tstep;
    if constexpr (GATHER) { PG8_GOFF(voffGc, 0); PG8_GOFF(voffGn, 0); }
    if constexpr (SP2) {
        PG8_STAGE(PG8_SB(0, 0), cB, voffB); PG8_STAGE(PG8_SB(0, 1), cB + hstep, voffB); PG8_STAGE_A(PG8_SA(0, 0), cA, 0, false); PG8_STAGE_A(PG8_SA(0, 1), cA, 1, false);
        if (wr == 1) PG8_BAR;
        PG8_WAIT_V(2); PG8_BAR;
        PG8_STAGE(PG8_SB(1, 0), cB + kstep, voffB); PG8_STAGE_A(PG8_SA(1, 0), cA + kstep, 0, false); PG8_STAGE(PG8_SB(1, 1), cB + hstep + kstep, voffB);
        PG8_WAIT_V(6); PG8_BAR;
    } else {
        PG8_STAGE(PG8_SB(0, 0), cB, voffB); PG8_STAGE(PG8_SA(0, 0), cA, voffA); PG8_STAGE(PG8_SB(0, 1), cB + hstep, voffB); PG8_STAGE(PG8_SA(0, 1), cA + hstep, voffA);
        if (wr == 1) PG8_BAR;
        PG8_WAIT_V(4); PG8_BAR;
        PG8_STAGE(PG8_SB(1, 0), cB + kstep, voffB); PG8_STAGE(PG8_SA(1, 0), cA + kstep, voffA); PG8_STAGE(PG8_SB(1, 1), cB + hstep + kstep, voffB);
        PG8_WAIT_V(6); PG8_BAR;
    }
    for (;;) {
        const bool has_next = S.next(ui + 1, nxt);
        if constexpr (GATHER) { if (has_next) PG8_GOFF(voffGn, ui + 1); }
        const char* nA = has_next ? (const char*)g.A + (size_t)nxt.pm * tstepA : cA; const char* nB = has_next ? (const char*)g.Bt + nxt.bo + (size_t)nxt.pn * tstep : cB;
#pragma unroll 1
        for (int t = 0; t < nt; t += 2) {
            const bool last = (t == nt - 2);
            const char* a1 = cA + (size_t)(t + 1) * kstep;
            const char* a2 = last ? nA : cA + (size_t)(t + 2) * kstep; const char* b2 = last ? nB : cB + (size_t)(t + 2) * kstep;
            const char* a3 = a2 + kstep; const char* b3 = b2 + kstep;
            if constexpr (SP2) {
            PG8_LDB(B0, 0, 0); PG8_LDB(B1, 0, 1); PG8_SCHED; PG8_LDA(At, 0, 0); PG8_STAGE_A(PG8_SA(1, 1), a1, 1, false);
            PG8_WAIT_V(8); PG8_WAIT_L(0); PG8_BAR; PG8_MMA(0, 0, At, B0); PG8_MMA(0, 1, At, B1); PG8_BAR; PG8_SCHED;
            PG8_LDA(At, 0, 1); PG8_STAGE(PG8_SB(0, 0), b2, voffB); PG8_STAGE(PG8_SB(0, 1), b2 + hstep, voffB); PG8_STAGE_A(PG8_SA(0, 0), a2, 0, last);
            PG8_WAIT_V(8); PG8_WAIT_L(0); PG8_BAR; PG8_MMA(1, 0, At, B0); PG8_MMA(1, 1, At, B1); PG8_BAR; PG8_SCHED;
            PG8_LDB(B0, 1, 0); PG8_LDB(B1, 1, 1); PG8_SCHED; PG8_LDA(At, 1, 0); PG8_STAGE_A(PG8_SA(0, 1), a2, 1, last);
            PG8_WAIT_V(8); PG8_WAIT_L(0); PG8_BAR; PG8_MMA(0, 0, At, B0); PG8_MMA(0, 1, At, B1); PG8_BAR; PG8_SCHED;
            PG8_LDA(At, 1, 1); PG8_STAGE(PG8_SB(1, 0), b3, voffB); PG8_STAGE(PG8_SB(1, 1), b3 + hstep, voffB); PG8_STAGE_A(PG8_SA(1, 0), a3, 0, last);
            PG8_WAIT_V(8); PG8_WAIT_L(0); PG8_BAR; PG8_MMA(1, 0, At, B0); PG8_MMA(1, 1, At, B1); PG8_BAR; PG8_SCHED;
            } else {
            PG8_LDB(B0, 0, 0); PG8_SCHED; PG8_LDA(At, 0, 0); PG8_STAGE(PG8_SA(1, 1), a1 + hstep, voffA);
            PG8_WAIT_L(8); PG8_BAR; PG8_WAIT_L(0); PG8_MMA(0, 0, At, B0); PG8_BAR; PG8_SCHED;
            PG8_LDB(B1, 0, 1); PG8_STAGE(PG8_SB(0, 0), b2, voffB);
            PG8_BAR; PG8_WAIT_L(0); PG8_MMA(0, 1, At, B1); PG8_BAR;
            PG8_LDA(At, 0, 1); PG8_STAGE(PG8_SA(0, 0), a2, voffA);
            PG8_BAR; PG8_WAIT_L(0); PG8_MMA(1, 0, At, B0); PG8_BAR; PG8_SCHED;
            PG8_STAGE(PG8_SB(0, 1), b2 + hstep, voffB);
            PG8_WAIT_V(6); PG8_BAR; PG8_MMA(1, 1, At, B1); PG8_BAR;
            PG8_LDB(B0, 1, 0); PG8_SCHED; PG8_LDA(At, 1, 0); PG8_STAGE(PG8_SA(0, 1), a2 + hstep, voffA);
            PG8_WAIT_L(8); PG8_BAR; PG8_WAIT_L(0); PG8_MMA(0, 0, At, B0); PG8_BAR; PG8_SCHED;
            PG8_LDB(B1, 1, 1); PG8_STAGE(PG8_SB(1, 0), b3, voffB);
            PG8_BAR; PG8_WAIT_L(0); PG8_MMA(0, 1, At, B1); PG8_BAR;
            PG8_LDA(At, 1, 1); PG8_STAGE(PG8_SA(1, 0), a3, voffA);
            PG8_BAR; PG8_WAIT_L(0); PG8_MMA(1, 0, At, B0); PG8_BAR; PG8_SCHED;
            PG8_STAGE(PG8_SB(1, 1), b3 + hstep, voffB);
            PG8_WAIT_V(6); PG8_BAR; PG8_MMA(1, 1, At, B1); PG8_BAR;
            }
        }
        if constexpr (ALIGN_EPI) { if (wr == 0) PG8_BAR; }
        E(acc, cur, wr, wc, fr, fq);
        if constexpr (Epi::PUBLISH) {
            asm volatile("s_waitcnt vmcnt(0)" ::: "memory"); PG8_BAR;
            if (tid == 0) __hip_atomic_fetch_add(E.flag + cur.pm * 16, 1u, __ATOMIC_RELAXED, __HIP_MEMORY_SCOPE_AGENT);
        }
        if (!has_next) break;
#pragma unroll
        for (int a = 0; a < 2; ++a)
#pragma unroll
            for (int b = 0; b < 2; ++b)
#pragma unroll
                for (int m = 0; m < 4; ++m)
#pragma unroll
                    for (int n = 0; n < 2; ++n) acc[a][b][m][n] = (f32x4){0.f, 0.f, 0.f, 0.f};
        cur = nxt; cA = nA; cB = nB; ++ui;
        if constexpr (GATHER) { _Pragma("unroll") for (int h_ = 0; h_ < 2; ++h_) _Pragma("unroll") for (int i_ = 0; i_ < 2; ++i_) voffGc[h_][i_] = voffGn[h_][i_]; }
        if constexpr (ALIGN_EPI) { if (wr == 1) PG8_BAR; }
    }
    PG8_WAIT_V(0);
    if constexpr (!ALIGN_EPI) { if (wr == 0) PG8_BAR; }
    PG8_BAR;
#undef PG8_SA
#undef PG8_STAGE_A
#undef PG8_GOFF
#undef PG8_SB
#undef PG8_STAGE
#undef PG8_LDA
#undef PG8_LDB
#undef PG8_MMA
#undef PG8_WAIT_V
#undef PG8_WAIT_L
#undef PG8_BAR
#undef PG8_SCHED
}
}

#define XB_TMO      128
#define XB_XCNT(j)  (256  + 64 * (j))
#define XB_XSUB(j)  (1280 + 64 * (j))
#define XB_XGEN(j)  (2304 + 64 * (j))
#define XB_TOP      3328
#define XB_TOPGEN   3392
#define XCD_BAR_WORDS 3456
#define XB_SPIN_CAP (1u << 18)
__device__ __forceinline__ unsigned xb_ld(unsigned* p)              { return __hip_atomic_load(p, __ATOMIC_RELAXED, __HIP_MEMORY_SCOPE_AGENT); }
__device__ __forceinline__ unsigned xb_add(unsigned* p, unsigned v) { return __hip_atomic_fetch_add(p, v, __ATOMIC_RELAXED, __HIP_MEMORY_SCOPE_AGENT); }
__device__ __forceinline__ unsigned xb_xcc_id() { return (unsigned)__builtin_amdgcn_s_getreg((3 << 11) | 20) & 0xFu; }
#define XB_SPIN(cond, bar) do { unsigned _sp = 0; while (cond) { __builtin_amdgcn_s_sleep(1); \
    if ((++_sp & 255u) == 0u) { if (xb_ld(&(bar)[XB_TMO])) break; if (_sp > XB_SPIN_CAP) { atomicAdd(&(bar)[XB_TMO], 1u); break; } } } } while (0)
struct XcdBarrier { unsigned* bar; unsigned x; volatile LAS unsigned* st; };
__device__ __forceinline__ XcdBarrier xcd_barrier_post(unsigned* bar, volatile LAS unsigned* st) {
    XcdBarrier b; b.bar = bar; b.x = xb_xcc_id(); b.st = st;
    if (threadIdx.x == 0) (void)xb_add(&bar[XB_XCNT(b.x)], 1u);
    return b;
}
__device__ __forceinline__ void xcd_barrier_complete(unsigned* bar, unsigned x, unsigned& nloc, unsigned& nx) {
    const unsigned G = gridDim.x * gridDim.y * gridDim.z;
    unsigned sum, cnt, mine, sp = 0u;
    for (;;) {
        sum = 0u; cnt = 0u; mine = 0u;
#pragma unroll 1
        for (unsigned j = 0; j < 16; ++j) { const unsigned c = xb_ld(&bar[XB_XCNT(j)]); sum += c; cnt += (c > 0u) ? 1u : 0u; mine = (j == x) ? c : mine; }
        if (sum == G) break;
        __builtin_amdgcn_s_sleep(1);
        if ((++sp & 255u) == 0u) { if (xb_ld(&bar[XB_TMO])) break; if (sp > XB_SPIN_CAP) { atomicAdd(&bar[XB_TMO], 1u); break; } }
    }
    nloc = mine > 0u ? mine : 1u; nx = cnt > 0u ? cnt : 1u;
}
__device__ __forceinline__ void xcd_barrier(const XcdBarrier& b, const int tid) {
    asm volatile("s_waitcnt vmcnt(0)" ::: "memory");
    __syncthreads();
    if (tid == 0) {
        unsigned* bar = b.bar;
        __builtin_amdgcn_s_waitcnt(0);
        unsigned nloc = b.st[0], nx = b.st[1];
        if (nloc == 0u) { xcd_barrier_complete(bar, b.x, nloc, nx); b.st[0] = nloc; b.st[1] = nx; }
        const unsigned old = xb_add(&bar[XB_XSUB(b.x)], 1u);
        const unsigned gen = old / nloc;
        if (old + 1u == (gen + 1u) * nloc) {
            __builtin_amdgcn_fence(__ATOMIC_RELEASE, "agent");
            asm volatile("s_waitcnt vmcnt(0)" ::: "memory");
            const unsigned og = xb_add(&bar[XB_TOP], 1u);
            const unsigned tg = og / nx;
            if (og + 1u == (tg + 1u) * nx) xb_add(&bar[XB_TOPGEN], 1u);
            else XB_SPIN(xb_ld(&bar[XB_TOPGEN]) == tg, bar);
            __builtin_amdgcn_fence(__ATOMIC_ACQUIRE, "agent");
            xb_add(&bar[XB_XGEN(b.x)], 1u);
            asm volatile("s_waitcnt vmcnt(0)" ::: "memory");
        } else {
            XB_SPIN(xb_ld(&bar[XB_XGEN(b.x)]) == gen, bar);
            __builtin_amdgcn_fence(__ATOMIC_ACQUIRE, "agent");
            asm volatile("s_waitcnt vmcnt(0)" ::: "memory");
        }
    }
    __syncthreads();
}

struct Frame {
    LAS unsigned char* lds;
    volatile LAS unsigned* MISC;
    unsigned* ctl;
    int tid, lane, wave, vcu, G, bx;
    float* out; unsigned char* ws;
};
struct Args { const float* in[28]; float* out; unsigned char* ws; int ph_lo, ph_hi; };
enum { I_X = 0, I_C, I_ADAW, I_ADAB, I_N1G, I_N2G, I_WIN, I_BF, I_QNA, I_KNA, I_QNC, I_KNC, I_LQ1, I_LK1, I_LQ2, I_LK2, I_SUBLN, I_QND, I_KND, I_MIXB, I_WOUT,
       I_WG, I_BG, I_WE, I_BE, I_W1, I_W3, I_W2 };
template <int I> __device__ __forceinline__ const float* inp() {
    auto ka = __builtin_amdgcn_kernarg_segment_ptr(); unsigned long long raw;
    asm volatile("s_load_dwordx2 %0, %1, %2\n\ts_waitcnt lgkmcnt(0)" : "=s"(raw) : "s"(ka), "i"(I * 8));
    return (const float*)(const GAS float*)raw;
}


struct TItem { const float* W; bf16* WT; const float* rs; int ldw, K, dst_row0, src_n0, kb, mapin; };
__device__ __forceinline__ int colmap_in(int n) { return n < 768 ? n : (n < 2984 ? n + 4 : (n < 2988 ? n - 2984 + 768 : -1)); }
__device__ __forceinline__ void t_load(const TItem& T, f32x4 (&v)[8], int lane) {
    const int k0 = 64 * T.kb, r8 = lane >> 3, c4 = (lane & 7) * 4; const int sc = T.mapin ? colmap_in(T.src_n0 + c4) : T.src_n0 + c4;
#pragma unroll
    for (int i = 0; i < 8; ++i) { v[i] = (f32x4){0.f, 0.f, 0.f, 0.f}; if (sc >= 0) v[i] = *(const f32x4*)(T.W + (size_t)(k0 + 8 * r8 + i) * T.ldw + sc); }
}
__device__ __forceinline__ void t_store(const TItem& T, f32x4 (&v)[8], LAS float* scr, int lane) {
    (void)scr;
    const int k0 = 64 * T.kb, r8 = lane >> 3, c4 = (lane & 7) * 4;
    if (T.rs) {
#pragma unroll
        for (int i = 0; i < 8; ++i) v[i] = v[i] * T.rs[k0 + 8 * r8 + i]; }
#pragma unroll
    for (int c = 0; c < 4; ++c) { u32x4 o; o.x = pg8::cvt_pk_bf16(v[0][c], v[1][c]); o.y = pg8::cvt_pk_bf16(v[2][c], v[3][c]); o.z = pg8::cvt_pk_bf16(v[4][c], v[5][c]); o.w = pg8::cvt_pk_bf16(v[6][c], v[7][c]);
        *(GAS u32x4*)(T.WT + (size_t)(T.dst_row0 + c4 + c) * T.K + k0 + 8 * r8) = o; }
}
__device__ __forceinline__ float lambda_init(int l) { return l == 0 ? 0.2f : (0.8f - 0.6f * 0.7408182206817179f); }

constexpr int CI_IN = 16 * 96, CI_OUT = 16 * 32, CI_UP1 = 16 * 8, CI_DN = 4 * 32, CN_UP = 32 * 2 * CI_UP1, CN_DN = 32 * CI_DN, NITEMS_L = CI_IN + CI_OUT + CN_UP + CN_DN;
__device__ __forceinline__ void fill_rowscale(Frame& F, const Args& A, int l, LAS float* rsl) {
    for (int k = F.tid; k < DM; k += 512) { float v = inp<I_MIXB>()[l * DM + k];
        if (k >= 512 && k < 768) v *= inp<I_SUBLN>()[l * 64 + ((k - 512) & 63)] * (1.f - lambda_init(l)); rsl[k] = v; }
}
__device__ __forceinline__ void convert_items(Frame& F, const Args& A, int l, int first, int stride, int limit, LAS float* rsl) {
    LAS float* scr = (LAS float*)(F.lds + F.wave * 8704);
    bf16* WIN = (bf16*)(F.ws + WS_WIN); bf16* WOUT = (bf16*)(F.ws + WS_WOUT); bf16* WUP = (bf16*)(F.ws + WS_WUP); bf16* WDN = (bf16*)(F.ws + WS_WDN);
    auto decode = [&](int it, TItem& T) {
        int r = it; T.rs = nullptr; T.mapin = 0;
        if (r < CI_IN) { T.kb = r / 96; const int nb = r % 96;
            T.W = inp<I_WIN>() + (size_t)l * DM * P_IN; T.ldw = P_IN; T.K = DM; T.WT = WIN + (size_t)l * NP * DM; T.dst_row0 = 32 * nb; T.src_n0 = 32 * nb; T.mapin = 1; return; }
        r -= CI_IN;
        if (r < CI_OUT) { T.kb = r / 32; const int nb = r % 32;
            T.W = inp<I_WOUT>() + (size_t)l * DM * DM; T.ldw = DM; T.K = DM; T.WT = WOUT + (size_t)l * DM * DM; T.dst_row0 = 32 * nb; T.src_n0 = 32 * nb; T.rs = (const float*)rsl; return; }
        r -= CI_OUT;
        if (r < CN_UP) { const int le = l * 32 + r / (2 * CI_UP1), q = r % (2 * CI_UP1), which = q / CI_UP1, q2 = q % CI_UP1; T.kb = q2 / 8; const int nb = q2 % 8;
            T.W = (which == 0 ? inp<I_W1>() : inp<I_W3>()) + (size_t)le * DM * FF; T.ldw = FF; T.K = DM; T.WT = WUP + (size_t)le * 512 * DM;
            const int n0 = 32 * nb, pn = n0 >> 7, j = n0 & 127; T.dst_row0 = 256 * pn + 128 * which + j; T.src_n0 = n0; return; }
        r -= CN_UP;
        { const int le = l * 32 + r / CI_DN, q = r % CI_DN; T.kb = q / 32; const int nb = q % 32;
          T.W = inp<I_W2>() + (size_t)le * FF * DM; T.ldw = DM; T.K = FF; T.WT = WDN + (size_t)le * DM * FF; T.dst_row0 = 32 * nb; T.src_n0 = 32 * nb; }
    };
    TItem T0, T1, T2; f32x4 v0[8], v1[8], v2[8]; int it = first;
    if (it < limit) { decode(it, T0); t_load(T0, v0, F.lane); }
    if (it + stride < limit) { decode(it + stride, T1); t_load(T1, v1, F.lane); }
    while (it < limit) {
        if (it + 2 * stride < limit) { decode(it + 2 * stride, T2); t_load(T2, v2, F.lane); }
        t_store(T0, v0, scr, F.lane); it += stride; if (it >= limit) break;
        if (it + 2 * stride < limit) { decode(it + 2 * stride, T0); t_load(T0, v0, F.lane); }
        t_store(T1, v1, scr, F.lane); it += stride; if (it >= limit) break;
        if (it + 2 * stride < limit) { decode(it + 2 * stride, T1); t_load(T1, v1, F.lane); }
        t_store(T2, v2, scr, F.lane); it += stride;
    }
}
constexpr int CV_L0 = NITEMS_L - CI_IN, CV_TOTAL = CV_L0 + NITEMS_L, CV_CHUNK = 64, CW_CVQ = 192;
__device__ __forceinline__ void convert_chunk(Frame& F, const Args& A, int gbase, LAS float* rsl2  ) {
    const int g0 = gbase + F.wave * (CV_CHUNK / NWAVES);
#pragma unroll 1
    for (int l = 0; l < 2; ++l) {
        const int lo = g0 > (l ? CV_L0 : 0) ? g0 : (l ? CV_L0 : 0), hi0 = g0 + CV_CHUNK / NWAVES, hi = hi0 < (l ? CV_TOTAL : CV_L0) ? hi0 : (l ? CV_TOTAL : CV_L0);
        if (lo < hi) { const int off = l ? -CV_L0 : CI_IN; convert_items(F, A, l, lo + off, 1, hi + off, rsl2 + l * DM); }
    }
}
__device__ __forceinline__ void convert_layer1_in_gap(Frame& F, const Args& A, int n2  ) {
    LAS float* rsl = (LAS float*)(F.lds + 8 * 8704);
    if (n2 < 0) n2 = 0; if (n2 > F.G - 32) n2 = F.G - 32;
    if (F.bx < n2) return;
    fill_rowscale(F, A, 1, rsl);
    __syncthreads();
    const int nw = (F.G - n2) * NWAVES;
    convert_items(F, A, 1, (F.bx - n2) * NWAVES + F.wave, nw, NITEMS_L, rsl);
    __syncthreads();
}

__device__ __forceinline__ void p0_prologue(Frame& F, const Args& A) {
    LAS float* rsl = (LAS float*)(F.lds + 8 * 8704);
    fill_rowscale(F, A, 0, rsl);
    __syncthreads();
    const int gw = F.vcu * NWAVES + F.wave, NGW = F.G * NWAVES;
    convert_items(F, A, 0, gw, NGW, BG_CONVERT ? CI_IN : NITEMS_L, rsl);
    if (!GAP_CONVERT && !BG_CONVERT) { __syncthreads(); fill_rowscale(F, A, 1, rsl); __syncthreads(); convert_items(F, A, 1, gw, NGW, NITEMS_L, rsl); }
    { bf16* WRH = (bf16*)(F.ws + WS_WR); bf16* WRL = WRH + 2 * 48 * DM;
      for (int i = gw * 64 + F.lane; i < 2 * 48 * DM; i += NGW * 64) { const int l = i / (48 * DM), r = i % (48 * DM), o = r >> 10, k = r & 1023;
          float w = 0.f; if (o < 4) w = inp<I_WG>()[((size_t)l * DM + k) * 4 + o]; else if (o < 36) w = inp<I_WE>()[((size_t)l * DM + k) * 32 + (o - 4)];
          const unsigned hi = f2bf(w); WRH[i] = (bf16)hi; WRL[i] = (bf16)f2bf(w - bf2f((unsigned short)hi)); } }
    if (F.bx == 0 && F.wave == 0) {
        for (int l = 0; l < 2; ++l) { float a = 0.f, b = 0.f; if (F.lane < 32) { a = inp<I_LQ1>()[l * 32 + F.lane] * inp<I_LK1>()[l * 32 + F.lane]; b = inp<I_LQ2>()[l * 32 + F.lane] * inp<I_LK2>()[l * 32 + F.lane]; }
            a = wave_sum(a); b = wave_sum(b); if (F.lane == 0) ((float*)(F.ws + WS_MISC))[l] = __expf(a) - __expf(b) + lambda_init(l); }
    }
    __syncthreads();
    LAS float* cact = (LAS float*)F.lds;
    LAS float* red = (LAS float*)(F.lds + 32768);
    { float cv_[16];
#pragma unroll
      for (int k = 0; k < 16; ++k) cv_[k] = inp<I_C>()[F.tid + 512 * k];
#pragma unroll
      for (int k = 0; k < 16; ++k) cact[F.tid + 512 * k] = cv_[k] / (1.f + __expf(-cv_[k])); }
    __syncthreads();
    for (int item = F.bx; item < 2 * 128; item += F.G) {
        const int l = item / 128, nb = item % 128, n = nb * 48 + (F.lane < 48 ? F.lane : 0); const float* aw = inp<I_ADAW>() + (size_t)l * DM * 6144 + n;
        float acc[8];
#pragma unroll
        for (int b = 0; b < 8; ++b) acc[b] = 0.f;
        const int k0 = F.wave * 128;
#pragma unroll 64
        for (int k = 0; k < 128; ++k) { const float w = aw[(size_t)(k0 + k) * 6144];
#pragma unroll
            for (int b = 0; b < 8; ++b) acc[b] += cact[b * DM + k0 + k] * w; }
#pragma unroll
        for (int b = 0; b < 8; ++b) red[(F.wave * 8 + b) * 64 + F.lane] = acc[b];
        __syncthreads();
        { const int b = F.wave; float s = inp<I_ADAB>()[l * 6144 + n];
#pragma unroll
          for (int w = 0; w < 8; ++w) s += red[(w * 8 + b) * 64 + F.lane];
          if (F.lane < 48) ((float*)(F.ws + WS_MOD))[((size_t)l * 8 + b) * 6144 + n] = s; }
        __syncthreads();
    }
}

__device__ __forceinline__ void build_tables(Frame& F, int l) {
    volatile LAS int* cnts = (volatile LAS int*)(F.lds + CNTS_OFF); volatile LAS int* base = (volatile LAS int*)(F.lds + BASE_OFF); volatile LAS int* tab = (volatile LAS int*)(F.lds + TAB_OFF);
    __syncthreads();
    if (F.tid < 64) {
        const int e = F.tid; int cnt = 0; if (e < 32) cnt = (int)__hip_atomic_load(F.ctl + CW_CNT + (l * 32 + e) * 16, RLX_AGENT);
        const int n = (cnt + 255) >> 8; int incl = n;
#pragma unroll
        for (int o = 1; o < 32; o <<= 1) { const int u = shup_i(incl, o, e); if (e >= o) incl += u; }
        const int t0 = incl - n;
        if (e < 32) { cnts[e] = cnt; base[e] = t0; for (int j = 0; j < n && t0 + j < MAXTILE; ++j) tab[t0 + j] = e; }
        if (e == 31) F.MISC[1] = (unsigned)(incl < MAXTILE ? incl : MAXTILE);
    }
    __syncthreads();
}
__device__ __forceinline__ void row_pass(Frame& F, const Args& A, int mode, int l) {
    const int gw = F.vcu * NWAVES + F.wave; const int lane = F.lane;
    const float* MOD = (const float*)(F.ws + WS_MOD);
    bf16* X1 = (bf16*)(F.ws + WS_X1); bf16* H = (bf16*)(F.ws + WS_H); const bf16* Y = (const bf16*)(F.ws + WS_Y);
    const int* tok_e = (const int*)(F.ws + WS_TOK); const int* tok_pos = (const int*)(F.ws + WS_TOK) + 4 * M; const float* tok_w = (const float*)(F.ws + WS_TOK) + 2 * M;
    volatile LAS int* basel = (volatile LAS int*)(F.lds + BASE_OFF);
    int pe_a[4], pe_b[4], pp_a[4], pp_b[4]; float pw_a[4], pw_b[4];
    const auto ldtok = [&](int m0) {
#pragma unroll
        for (int r = 0; r < 4; ++r) { const int m = m0 + r; pe_a[r] = tok_e[m]; pe_b[r] = tok_e[M + m]; pp_a[r] = tok_pos[m]; pp_b[r] = tok_pos[M + m]; pw_a[r] = tok_w[m]; pw_b[r] = tok_w[M + m]; } };
    if (mode != 0) { ldtok(gw * 8); build_tables(F, mode == 1 ? 0 : 1); }
    const int b = (gw * 8) >> 11; const int lp = (mode == 1) ? 0 : 1;
    f32x4 g2v[4], gm[4], shv[4];
#pragma unroll
    for (int j = 0; j < 4; ++j) { const int col = 256 * j + 4 * lane;
        g2v[j] = (f32x4){0.f, 0.f, 0.f, 0.f}; gm[j] = g2v[j]; shv[j] = g2v[j];
        if (mode != 0) g2v[j] = *(const f32x4*)(MOD + ((size_t)lp * 8 + b) * 6144 + 5 * DM + col);
        if (mode != 2) { const float* md = MOD + ((size_t)l * 8 + b) * 6144; gm[j] = *(const f32x4*)(inp<I_N1G>() + l * DM + col) * (*(const f32x4*)(md + DM + col) + 1.0f); shv[j] = *(const f32x4*)(md + col); } }
    for (int m0 = gw * 8; m0 < gw * 8 + 8; m0 += 4) {
        f32x4 v[4][4]; u32x2 ya[4][4], yb[4][4]; float wa[4], wb[4];
        if (mode != 0) {
            int sa[4], sb[4];
#pragma unroll
            for (int r = 0; r < 4; ++r) { sa[r] = 256 * basel[pe_a[r]] + pp_a[r]; sb[r] = 256 * basel[pe_b[r]] + pp_b[r]; wa[r] = pw_a[r]; wb[r] = pw_b[r]; }
#pragma unroll
            for (int r = 0; r < 4; ++r)
#pragma unroll
                for (int j = 0; j < 4; ++j) { const int col = 256 * j + 4 * lane; ya[r][j] = *(const u32x2*)(Y + (size_t)sa[r] * DM + col); yb[r][j] = *(const u32x2*)(Y + (size_t)sb[r] * DM + col); }
            if (m0 == gw * 8) ldtok(m0 + 4);
        }
#pragma unroll
        for (int r = 0; r < 4; ++r) { const int m = m0 + r;
            if (mode == 0) { const float* xr = inp<I_X>() + (size_t)m * DM;
#pragma unroll
                for (int j = 0; j < 4; ++j) v[r][j] = *(const f32x4*)(xr + 256 * j + 4 * lane); }
            else { const bf16* xr = X1 + (size_t)m * DM;
#pragma unroll
                for (int j = 0; j < 4; ++j) { const u32x2 q = *(const u32x2*)(xr + 256 * j + 4 * lane); v[r][j] = (f32x4){bf2f(q.x & 0xffff), bf2f(q.x >> 16), bf2f(q.y & 0xffff), bf2f(q.y >> 16)}; } } }
#pragma unroll
        for (int r = 0; r < 4; ++r) { const int m = m0 + r;
            if (mode != 0) {
#pragma unroll
                for (int j = 0; j < 4; ++j) { const u32x2 a = ya[r][j], c = yb[r][j];
                    f32x4 mo; mo[0] = wa[r] * bf2f(a.x & 0xffff) + wb[r] * bf2f(c.x & 0xffff); mo[1] = wa[r] * bf2f(a.x >> 16) + wb[r] * bf2f(c.x >> 16);
                    mo[2] = wa[r] * bf2f(a.y & 0xffff) + wb[r] * bf2f(c.y & 0xffff); mo[3] = wa[r] * bf2f(a.y >> 16) + wb[r] * bf2f(c.y >> 16);
                    v[r][j] = v[r][j] + g2v[j] * mo; }
                if (mode == 1) {
#pragma unroll
                    for (int j = 0; j < 4; ++j) { u32x2 q; q.x = pk2(v[r][j][0], v[r][j][1]); q.y = pk2(v[r][j][2], v[r][j][3]); *(u32x2*)(X1 + (size_t)m * DM + 256 * j + 4 * lane) = q; }
                } else { float* orow = F.out + (size_t)m * DM;
#pragma unroll
                    for (int j = 0; j < 4; ++j) *(f32x4*)(orow + 256 * j + 4 * lane) = v[r][j]; }
            }
            if (mode != 2) {
                float ss = 0.f;
#pragma unroll
                for (int j = 0; j < 4; ++j) ss += (v[r][j][0] * v[r][j][0] + v[r][j][1] * v[r][j][1]) + (v[r][j][2] * v[r][j][2] + v[r][j][3] * v[r][j][3]);
                const float rstd = 1.0f / sqrtf(wave_sum(ss) * (1.f / DM) + RMS_EPS);
#pragma unroll
                for (int j = 0; j < 4; ++j) { const f32x4 hv = v[r][j] * rstd * gm[j] + shv[j]; u32x2 w; w.x = pk2(hv[0], hv[1]); w.y = pk2(hv[2], hv[3]);
                    *(u32x2*)(H + (size_t)m * DM + 256 * j + 4 * lane) = w; }
            }
        }
    }
}

__device__ __forceinline__ void knorm_seg(bf16* p, int lane, int nlanes_active, int group_lanes, const float* gain, int gmask, float inv_n) {
    u32x2 raw = (u32x2){0u, 0u}; if (lane < nlanes_active) raw = *(const u32x2*)(p + 4 * lane);
    float x0 = bf2f(raw.x & 0xffff), x1 = bf2f(raw.x >> 16), x2 = bf2f(raw.y & 0xffff), x3 = bf2f(raw.y >> 16);
    float ss = (x0 * x0 + x1 * x1) + (x2 * x2 + x3 * x3);
    for (int o = 1; o < group_lanes; o <<= 1) ss += __shfl_xor(ss, o);
    const float rstd = 1.0f / sqrtf(ss * inv_n + RMS_EPS);
    const int c = (4 * lane) & gmask;
    x0 *= rstd * gain[c]; x1 *= rstd * gain[c + 1]; x2 *= rstd * gain[c + 2]; x3 *= rstd * gain[c + 3];
    if (lane < nlanes_active) { u32x2 w; w.x = pk2(x0, x1); w.y = pk2(x2, x3); *(u32x2*)(p + 4 * lane) = w; }
}
__device__ __forceinline__ unsigned sortable(float f) { const unsigned u = __builtin_bit_cast(unsigned, f); return (u & 0x80000000u) ? ~u : (u | 0x80000000u); }


__device__ __forceinline__ int wave_sum_i(int v) {
    v += __builtin_amdgcn_update_dpp(0, v, 0xB1, 0xF, 0xF, true);
    v += __builtin_amdgcn_update_dpp(0, v, 0x4E, 0xF, 0xF, true);
    v += __builtin_amdgcn_update_dpp(0, v, 0x141, 0xF, 0xF, true);
    v += __builtin_amdgcn_update_dpp(0, v, 0x140, 0xF, 0xF, true);
    return __builtin_amdgcn_readlane(v, 0) + __builtin_amdgcn_readlane(v, 16) + __builtin_amdgcn_readlane(v, 32) + __builtin_amdgcn_readlane(v, 48);
}
__device__ __forceinline__ void transpose32(unsigned (&a)[32]) {
#define TSTAGE(S, MSK) _Pragma("unroll") for (int i = 0; i < 32; ++i) if (!(i & S)) { const unsigned x = a[i], y = a[i + S]; a[i] = (x & MSK) | ((y << S) & ~MSK); a[i + S] = ((x >> S) & MSK) | (y & ~MSK); }
    TSTAGE(16, 0x0000FFFFu) TSTAGE(8, 0x00FF00FFu) TSTAGE(4, 0x0F0F0F0Fu) TSTAGE(2, 0x33333333u) TSTAGE(1, 0x55555555u)
#undef TSTAGE
}
__device__ __forceinline__ void sel_upd(unsigned T, unsigned ones, int s1, unsigned& cand, unsigned& above, int& na, int& nc, bool& done, bool& exact) {
    if (na + s1 >= 256) { cand = ones; nc = s1; }
    else { above |= ones; na += s1; cand &= ~T; nc -= s1; }
    if (na + nc == 256) { done = true; exact = true; }
}
__device__ __forceinline__ void sel_step2(unsigned TA, unsigned TB, unsigned& candA, unsigned& candB, unsigned& abA, unsigned& abB, int& naA, int& ncA, int& naB, int& ncB, bool& dA, bool& dB, bool& eA, bool& eB) {
    const unsigned onesA = candA & TA, onesB = candB & TB;
    const int s = wave_sum_i(__builtin_popcount(onesA) | (__builtin_popcount(onesB) << 16));
    if (!dA) sel_upd(TA, onesA, s & 0xffff, candA, abA, naA, ncA, dA, eA);
    if (!dB) sel_upd(TB, onesB, (int)((unsigned)s >> 16), candB, abB, naB, ncB, dB, eB);
}
__device__ __forceinline__ unsigned sel_finish(unsigned cand, unsigned above, int na, bool exact, int lane) {
    if (exact) return above | cand;
    const int need = 256 - na; const int pc = __builtin_popcount(cand); int incl = pc;
#pragma unroll
    for (int o = 1; o < 64; o <<= 1) { const int t = shup_i(incl, o, lane); if (lane >= o) incl += t; }
    int take = need - (incl - pc); take = take < 0 ? 0 : (take > pc ? pc : take);
    unsigned w = cand, res = above;
    for (int k = 0; k < take; ++k) { const unsigned low = w & (0u - w); res |= low; w ^= low; }
    return res;
}

__device__ __forceinline__ void p3_prep(Frame& F, const Args& A, int l, int rep) {
    const int gw = F.vcu * NWAVES + F.wave, NGW = F.G * NWAVES;
    bf16* PROJ = (bf16*)(F.ws + WS_PROJ);
    if (!(rep > 0 && PROBE_P3_PART == 2)) { const float* ga = inp<I_KNA>() + l * 64; const float* gc = inp<I_KNC>() + l * 32; const float* gd = inp<I_KND>() + l * 64;
      const int la = F.lane; const int ca = (4 * la) & 63, cc = (4 * la) & 31;
      const f32x4 gva = *(const f32x4*)(ga + ca), gvc = *(const f32x4*)(gc + cc), gvd = *(const f32x4*)(gd + ca);
      for (int mb = gw * 8; mb < gw * 8 + 8; mb += 8) {
        u32x2 ra[8], rc[8], rd[8];
#pragma unroll
        for (int i = 0; i < 8; ++i) { bf16* row = PROJ + (size_t)(mb + i) * NP; ra[i] = *(const u32x2*)(row + C_AK + 4 * la); rc[i] = *(const u32x2*)(row + C_CK + 4 * la);
            rd[i] = (u32x2){0u, 0u}; if (la < 16) rd[i] = *(const u32x2*)(row + C_DK + 4 * la); }
#pragma unroll
        for (int i = 0; i < 8; ++i) { bf16* row = PROJ + (size_t)(mb + i) * NP;
            { float x0 = bf2f(ra[i].x & 0xffff), x1 = bf2f(ra[i].x >> 16), x2 = bf2f(ra[i].y & 0xffff), x3 = bf2f(ra[i].y >> 16); float ss = (x0 * x0 + x1 * x1) + (x2 * x2 + x3 * x3);
              ss += shx<1>(ss); ss += shx<2>(ss); ss += shx<4>(ss); ss += shx<8>(ss); const float rs = 1.0f / sqrtf(ss * (1.f / 64.f) + RMS_EPS);
              u32x2 w; w.x = pk2(x0 * rs * gva[0], x1 * rs * gva[1]); w.y = pk2(x2 * rs * gva[2], x3 * rs * gva[3]); *(u32x2*)(row + C_AK + 4 * la) = w; }
            { float x0 = bf2f(rc[i].x & 0xffff), x1 = bf2f(rc[i].x >> 16), x2 = bf2f(rc[i].y & 0xffff), x3 = bf2f(rc[i].y >> 16); float ss = (x0 * x0 + x1 * x1) + (x2 * x2 + x3 * x3);
              ss += shx<1>(ss); ss += shx<2>(ss); ss += shx<4>(ss); const float rs = 1.0f / sqrtf(ss * (1.f / 32.f) + RMS_EPS);
              u32x2 w; w.x = pk2(x0 * rs * gvc[0], x1 * rs * gvc[1]); w.y = pk2(x2 * rs * gvc[2], x3 * rs * gvc[3]); *(u32x2*)(row + C_CK + 4 * la) = w; }
            { float x0 = bf2f(rd[i].x & 0xffff), x1 = bf2f(rd[i].x >> 16), x2 = bf2f(rd[i].y & 0xffff), x3 = bf2f(rd[i].y >> 16); float ss = (x0 * x0 + x1 * x1) + (x2 * x2 + x3 * x3);
              ss += shx<1>(ss); ss += shx<2>(ss); ss += shx<4>(ss); ss += shx<8>(ss); const float rs = 1.0f / sqrtf(ss * (1.f / 64.f) + RMS_EPS);
              u32x2 w; w.x = pk2(x0 * rs * gvd[0], x1 * rs * gvd[1]); w.y = pk2(x2 * rs * gvd[2], x3 * rs * gvd[3]); if (la < 16) *(u32x2*)(row + C_DK + 4 * la) = w; }
        }
      }
    }
    if (!(rep > 0 && PROBE_P3_PART == 2)) {
        const int bh = gw >> 6, ck = gw & 63, b = bh >> 2, h = bh & 3; const float bfv = inp<I_BF>()[l * 4 + h];
        const int t = 32 * ck + (F.lane & 31);
        const float x = bf2f(PROJ[((size_t)b * SEQ + t) * NP + C_AF + h]) + bfv;
        float incl = fminf(x, 0.f) - log1pf(__expf(-fabsf(x)));
#pragma unroll
        for (int o = 1; o < 32; o <<= 1) { const float u = shup(incl, o, F.lane); if ((F.lane & 31) >= o) incl += u; }
        float* cum = (float*)(F.ws + WS_CUM);
        if (F.lane < 32) cum[(size_t)bh * SEQ + t] = incl;
        if (F.lane == 31) cum[32 * SEQ + bh * 64 + ck] = incl;
    }
    LAS float* sc = (LAS float*)F.lds;
    unsigned* MASK = (unsigned*)(F.ws + WS_MASK);
    constexpr int SCP = 2052;
    const int lane = F.lane, kq = lane >> 4, qi = lane & 15;
    __syncthreads();
    bf16x8 bq[8], wvr, akv[16];
    const auto unit_geom = [&](int i, int& b, int& t0, int& nkt) { const int u = F.bx + 256 * i; b = u >> 7; const int tqr = u & 127, tq = (i & 1) ? 127 - tqr : tqr; t0 = tq * 16; nkt = tq + 1; };
    const auto unit_load_q = [&](int i) { int b, t0, nkt; unit_geom(i, b, t0, nkt); const bf16* qrow = PROJ + (size_t)b * SEQ * NP + (size_t)(t0 + qi) * NP;
#pragma unroll
        for (int h = 0; h < 8; ++h) bq[h] = *(const bf16x8*)(qrow + C_IQ + h * 32 + 8 * kq);
        wvr = *(const bf16x8*)(qrow + C_IW); };
    const auto unit_load_k = [&](int i) { int b, t0, nkt; unit_geom(i, b, t0, nkt); const bf16* pb = PROJ + (size_t)b * SEQ * NP;
#pragma unroll
        for (int j = 0; j < 16; ++j) { const int kt = F.wave + 8 * j; akv[j] = (bf16x8){0, 0, 0, 0, 0, 0, 0, 0}; if (kt < nkt) akv[j] = *(const bf16x8*)(pb + (size_t)(kt * 16 + qi) * NP + C_IK + 8 * kq); } };
    const bool do_c = !(rep > 0 && PROBE_P3_PART == 1);
    if (do_c) unit_load_q(0);
    for (int i = 0; i < 4; ++i) {
        if (!do_c) break;
        int b, t0, nkt; unit_geom(i, b, t0, nkt);
        unit_load_k(i);
        float wq[8];
#pragma unroll
        for (int h = 0; h < 8; ++h) wq[h] = bf2f((unsigned short)wvr[h]) * (0.35355339059327373f * 0.17677669529663687f);
#pragma unroll
        for (int j = 0; j < 16; ++j) { const int kt = F.wave + 8 * j;
            if (kt < nkt) {
            f32x4 a4 = (f32x4){0.f, 0.f, 0.f, 0.f};
#pragma unroll
            for (int h = 0; h < 8; ++h) { const f32x4 s = __builtin_amdgcn_mfma_f32_16x16x32_bf16(akv[j], bq[h], (f32x4){0.f, 0.f, 0.f, 0.f}, 0, 0, 0);
#pragma unroll
                for (int r = 0; r < 4; ++r) a4[r] += wq[h] * fmaxf(s[r], 0.f); }
#pragma unroll
            for (int r = 0; r < 4; ++r) a4[r] += 0.f;
            { const int ci = kt * 4 + kq, L = ci >> 3, c = ci & 7;
              *(LAS f32x4*)(sc + qi * SCP + 4 * (L * 8 + (c ^ (L & 7)))) = a4; }
            } }
        if (i + 1 < 4) unit_load_q(i + 1);
        LDS_WAIT(); __syncthreads();
        if (rep > 0 && PROBE_P3_PART == 2) { }
        else if (t0 < 256) {
            for (int rr = 0; rr < 2; ++rr) { const int t = t0 + 2 * F.wave + rr; const int nb = t - 32 * lane + 1;
                MASK[((size_t)b * SEQ + t) * 64 + lane] = nb >= 32 ? 0xffffffffu : (nb <= 0 ? 0u : ((1u << nb) - 1u)); }
        } else {
            const int rA = 2 * F.wave, tA = t0 + rA, tB = tA + 1;
            unsigned ua[32], ub[32];
#pragma unroll
            for (int c = 0; c < 8; ++c) { const int off = 4 * (lane * 8 + (c ^ (lane & 7)));
                const f32x4 fa = *(const LAS f32x4*)(sc + rA * SCP + off), fb = *(const LAS f32x4*)(sc + (rA + 1) * SCP + off);
#pragma unroll
                for (int i = 0; i < 4; ++i) { ua[c * 4 + i] = sortable(fa[i]); ub[c * 4 + i] = sortable(fb[i]); } }
            transpose32(ua); transpose32(ub);
            unsigned candA, candB, abA = 0u, abB = 0u; int naA = 0, naB = 0, ncA = tA + 1, ncB = tB + 1; bool dA = false, dB = false, eA = false, eB = false;
            { const int nbA = tA - 32 * lane + 1, nbB = tB - 32 * lane + 1;
              candA = nbA >= 32 ? 0xffffffffu : (nbA <= 0 ? 0u : ((1u << nbA) - 1u)); candB = nbB >= 32 ? 0xffffffffu : (nbB <= 0 ? 0u : ((1u << nbB) - 1u)); }
#pragma unroll
            for (int bit = 31; bit >= 0; --bit) {
                sel_step2(ua[bit], ub[bit], candA, candB, abA, abB, naA, ncA, naB, ncB, dA, dB, eA, eB);
                if (dA && dB) break;
            }
            MASK[((size_t)b * SEQ + tA) * 64 + lane] = sel_finish(candA, abA, naA, eA, lane);
            MASK[((size_t)b * SEQ + tB) * 64 + lane] = sel_finish(candB, abB, naB, eB, lane);
        }
        __syncthreads();
    }
}

namespace att {
template <bool B> struct BoolC { static constexpr bool value = B; };
constexpr int SLOTB = 8192, L_K = 0, L_V = 3 * SLOTB, L_WS = 6 * SLOTB, L_OST = L_WS + 2048, L_CUM = L_OST + 8 * 8192, L_END = L_CUM + 8192;
constexpr int MROW = 66;
static_assert(L_OST + 256 * MROW * 4 <= L_END && L_END <= RING_BYTES, "attention LDS map");
constexpr float THR = 8.0f;
__device__ __forceinline__ int crow(int r, int hi) { return (r & 3) + 8 * (r >> 2) + 4 * hi; }
__device__ __forceinline__ void glds16(const void* gsrc, unsigned lds_dst) { unsigned keep;
    asm volatile("s_mov_b32 %0, m0\n\ts_mov_b32 m0, %2\n\ts_nop 0\n\tglobal_load_lds_dwordx4 %1, off\n\ts_mov_b32 m0, %0" : "=&s"(keep) : "v"(gsrc), "s"(lds_dst) : "memory"); }
#define ATT_WAIT_BAR() asm volatile("s_waitcnt vmcnt(0) lgkmcnt(0)\n\ts_barrier" ::: "memory")
__device__ __forceinline__ unsigned cvtpk_s(float lo, float hi) { typedef __bf16 bf16x2_t __attribute__((ext_vector_type(2))); f32x2 v = {lo, hi}; bf16x2_t b = __builtin_convertvector(v, bf16x2_t); return __builtin_bit_cast(unsigned, b); }
__device__ __forceinline__ float xhalf(float x, int hi) { auto rr = __builtin_amdgcn_permlane32_swap(__builtin_bit_cast(unsigned, x), __builtin_bit_cast(unsigned, x), false, false);
    return __builtin_bit_cast(float, hi ? rr[0] : rr[1]); }
template <int DA, int DB>
__device__ __forceinline__ void qkt(f32x16& p0, f32x16& p1, const LAS char* Kslot, const bf16x8* qr, const f32x16& cin, int r32, int hi) {
    const LAS char* kb = Kslot + hi * 1024 + r32 * 16;
#pragma unroll
    for (int d0 = DA; d0 < DB; ++d0) {
        const bf16x8 b0 = *(const LAS bf16x8*)(kb + d0 * 2048), b1 = *(const LAS bf16x8*)(kb + d0 * 2048 + 512);
        if (d0 == DA) { p0 = __builtin_amdgcn_mfma_f32_32x32x16_bf16(b0, qr[d0], cin, 0, 0, 0); p1 = __builtin_amdgcn_mfma_f32_32x32x16_bf16(b1, qr[d0], cin, 0, 0, 0); }
        else { p0 = __builtin_amdgcn_mfma_f32_32x32x16_bf16(b0, qr[d0], p0, 0, 0, 0); p1 = __builtin_amdgcn_mfma_f32_32x32x16_bf16(b1, qr[d0], p1, 0, 0, 0); } }
}
__device__ __forceinline__ void pv(f32x16* o, int vb, bf16x8 pa0, bf16x8 pa1, bf16x8 pa2, bf16x8 pa3) {
    s16x4 lo[2][4], hi[2][4];
#pragma unroll
    for (int d0 = 0; d0 < 2; ++d0)
#pragma unroll
        for (int ks = 0; ks < 4; ++ks) {
            asm volatile("ds_read_b64_tr_b16 %0,%1 offset:%c2" : "=&v"(lo[d0][ks]) : "v"(vb), "i"(d0 * 4096 + ks * 1024) : "memory");
            asm volatile("ds_read_b64_tr_b16 %0,%1 offset:%c2" : "=&v"(hi[d0][ks]) : "v"(vb), "i"(d0 * 4096 + ks * 1024 + 512) : "memory"); }
    asm volatile("s_waitcnt lgkmcnt(0)" ::: "memory"); __builtin_amdgcn_sched_barrier(0);
#define PK(d, k) (bf16x8){lo[d][k][0], lo[d][k][1], lo[d][k][2], lo[d][k][3], hi[d][k][0], hi[d][k][1], hi[d][k][2], hi[d][k][3]}
    o[0] = __builtin_amdgcn_mfma_f32_32x32x16_bf16(pa0, PK(0, 0), o[0], 0, 0, 0); o[1] = __builtin_amdgcn_mfma_f32_32x32x16_bf16(pa0, PK(1, 0), o[1], 0, 0, 0);
    o[0] = __builtin_amdgcn_mfma_f32_32x32x16_bf16(pa1, PK(0, 1), o[0], 0, 0, 0); o[1] = __builtin_amdgcn_mfma_f32_32x32x16_bf16(pa1, PK(1, 1), o[1], 0, 0, 0);
    o[0] = __builtin_amdgcn_mfma_f32_32x32x16_bf16(pa2, PK(0, 2), o[0], 0, 0, 0); o[1] = __builtin_amdgcn_mfma_f32_32x32x16_bf16(pa2, PK(1, 2), o[1], 0, 0, 0);
    o[0] = __builtin_amdgcn_mfma_f32_32x32x16_bf16(pa3, PK(0, 3), o[0], 0, 0, 0); o[1] = __builtin_amdgcn_mfma_f32_32x32x16_bf16(pa3, PK(1, 3), o[1], 0, 0, 0);
#undef PK
}
__device__ __forceinline__ float rowmax(const f32x16& p0, const f32x16& p1, int hi) {
    float a = fmaxf(fmaxf(p0[0], p0[1]), p1[0]), b = fmaxf(fmaxf(p0[2], p0[3]), p1[1]); a = fmaxf(fmaxf(a, p1[2]), p1[3]);
#pragma unroll
    for (int r = 4; r < 16; r += 4) { a = fmaxf(fmaxf(a, p0[r]), p0[r + 1]); b = fmaxf(fmaxf(b, p0[r + 2]), p0[r + 3]); a = fmaxf(fmaxf(a, p1[r]), p1[r + 1]); b = fmaxf(fmaxf(b, p1[r + 2]), p1[r + 3]); }
    const float m = fmaxf(a, b); return fmaxf(m, xhalf(m, hi));
}
struct AttnP { const bf16* proj; bf16* mix; const float* cum; const unsigned* mask; const float* qgain[4]; const float* kgain[4]; float lam; unsigned* cvq; };

template <int VAR>
__device__ __forceinline__ void attn_unit(const AttnP& P, int b, int h, int qb, LAS char* sh, const int tid_in, const int pm, unsigned* qctr, volatile LAS unsigned* qslot) {
    int tid = tid_in; asm volatile("" : "+v"(tid));
    const int lane = tid & 63, r32 = lane & 31, hi = lane >> 5; const int wid = __builtin_amdgcn_readfirstlane(tid >> 6);
    const long rowbase = (long)b * SEQ; const int q0 = qb * 256, NT = 4 * (qb + 1);
    const int qrel = wid * 32 + r32, tq = q0 + qrel;
    constexpr bool REV = VAR != 0;
    constexpr int QCB = VAR == 0 ? C_AQ : VAR == 1 ? C_BQ : VAR == 2 ? C_CQ : C_DQ;
    constexpr int KCB = VAR == 0 ? C_AK : VAR == 1 ? C_BK : VAR == 2 ? C_CK : C_DK;
    constexpr int VCB = VAR == 0 ? C_AV : VAR == 1 ? C_BV : VAR == 2 ? C_CV : C_DV;
    const int Qc = QCB + 64 * h, Kc = VAR == 3 ? KCB : KCB + 64 * h, Vc = VAR == 3 ? VCB : VCB + 64 * h;
    const bf16* PR = P.proj;
    LAS float* wsf = (LAS float*)(sh + L_WS) + wid * 64;
    LAS float* stg = (LAS float*)(sh + L_OST) + wid * 2048;
    LAS float* cumL = (LAS float*)(sh + L_CUM);
    LAS unsigned* maskL = (LAS unsigned*)(sh + L_OST);
    const unsigned lds0 = (unsigned)(uintptr_t)sh;
    const bf16* ksrc = PR + (size_t)(rowbase + lane) * NP + Kc + wid * 8;
    const bf16* vsrc = PR + (size_t)(rowbase + 16 * (wid & 3) + (lane >> 2)) * NP + Vc + (wid >> 2) * 32 + (lane & 3) * 8;
    const unsigned kdst = lds0 + L_K + wid * 1024, vdst = lds0 + L_V + wid * 1024;
#define DMA_KV(t, slot) do { glds16(ksrc + (size_t)(t) * 64 * NP, (unsigned)__builtin_amdgcn_readfirstlane(kdst + (slot))); glds16(vsrc + (size_t)(t) * 64 * NP, (unsigned)__builtin_amdgcn_readfirstlane(vdst + (slot))); } while (0)
    DMA_KV(REV ? NT - 1 : 0, 0); DMA_KV(REV ? NT - 2 : 1, SLOTB);
    constexpr int NDQ = VAR == 2 ? 2 : 4; bf16x8 qpre[NDQ];
    { const bf16* Qw0 = PR + (size_t)(rowbase + tq) * NP + Qc;
#pragma unroll
      for (int d0 = 0; d0 < NDQ; ++d0) qpre[d0] = *(const bf16x8*)(Qw0 + d0 * 16 + hi * 8); }
    if (VAR == 0) {
        LAS float* pref = (LAS float*)(sh + L_WS);
        const float* cg = P.cum + (size_t)(b * 4 + h) * SEQ; float cgv[4];
#pragma unroll
        for (int k = 0; k < 4; ++k) { const int i = tid + 512 * k; cgv[k] = i < q0 + 256 ? cg[i] : 0.f; }
        if (tid < 64) { const float ct = P.cum[32 * SEQ + (b * 4 + h) * 64 + tid]; float incl = ct;
#pragma unroll
            for (int o = 1; o < 64; o <<= 1) { const float u = shup(incl, o, tid); if (tid >= o) incl += u; }
            pref[tid] = incl - ct; }
        asm volatile("s_waitcnt lgkmcnt(0)\n\ts_barrier" ::: "memory");
#pragma unroll
        for (int k = 0; k < 4; ++k) { const int i = tid + 512 * k; if (i < q0 + 256) cumL[i] = (cgv[k] + pref[i >> 5]) * LOG2E; }
        asm volatile("s_waitcnt lgkmcnt(0)\n\ts_barrier" ::: "memory");
    }
    if (VAR == 3) { const unsigned* mg = P.mask + (size_t)(rowbase + q0) * 64; const int nw = 2 * NT;
#pragma unroll 16
        for (int i = tid; i < 256 * 32; i += 512) { const int row = i >> 5, w = 2 * (i & 31); if (w < nw) *(LAS u32x2*)(maskL + row * MROW + w) = *(const u32x2*)(mg + row * 64 + w); } }
    asm volatile("s_waitcnt vmcnt(0) lgkmcnt(0)\n\ts_barrier" ::: "memory");
    const int vb0 = (int)(lds0 + L_V) + ((lane >> 4) & 1) * 32 + (lane & 3) * 8 + (4 * hi + ((lane & 15) >> 2)) * 64;
    float slope2 = 0.f;
    if (VAR == 2) slope2 = __builtin_amdgcn_exp2f(-(float)(2 * h + 1)) * LOG2E;
    if (VAR == 3) slope2 = __builtin_amdgcn_exp2f(-(float)(2 * h + 2)) * LOG2E;
    float cumt = 0.f; if (VAR == 0) cumt = cumL[tq];
    constexpr int NPASS = VAR == 2 ? 2 : 1;
    unsigned nxt_u = 0u, nxt_c = 0u;
    for (int pass = 0; pass < NPASS; ++pass) {
        bf16x8 qa[4]; float sb0 = 0.f;
        { const bf16* Qw = PR + (size_t)(rowbase + tq) * NP + Qc;
          constexpr int ND0 = VAR == 2 ? 2 : 4; const int dbase = VAR == 2 ? 2 * pass : 0;
          float qf[8 * ND0];
#pragma unroll
          for (int d0 = 0; d0 < ND0; ++d0) { bf16x8 raw = qpre[d0]; if (pass > 0) raw = *(const bf16x8*)(Qw + (dbase + d0) * 16 + hi * 8);
#pragma unroll
              for (int j = 0; j < 8; ++j) qf[d0 * 8 + j] = bf2f((unsigned short)raw[j]); }
          constexpr float SC = (VAR == 2 ? 0.17677669529663687f : 0.125f) * LOG2E;
          if (VAR != 1) {
              float ss = 0.f;
#pragma unroll
              for (int i = 0; i < 8 * ND0; ++i) ss += qf[i] * qf[i];
              ss += xhalf(ss, hi); const float rstd = 1.0f / sqrtf(ss * (VAR == 2 ? 1.f / 32.f : 1.f / 64.f) + RMS_EPS);
              const float* g = P.qgain[VAR];
#pragma unroll
              for (int d0 = 0; d0 < ND0; ++d0)
#pragma unroll
                  for (int j = 0; j < 8; ++j) qf[d0 * 8 + j] *= rstd * g[16 * d0 + 8 * hi + j] * SC;
          } else {
#pragma unroll
              for (int i = 0; i < 8 * ND0; ++i) qf[i] *= SC;
          }
          if (VAR == 2 || VAR == 3) {
              float n0 = 0.f;
#pragma unroll
              for (int i = 0; i < 8 * ND0; ++i) n0 += qf[i] * qf[i];
              n0 += xhalf(n0, hi);
              float gk = fabsf(P.kgain[VAR][lane & (VAR == 2 ? 31 : 63)]);
              gk = fmaxf(gk, shx<1>(gk)); gk = fmaxf(gk, shx<2>(gk)); gk = fmaxf(gk, shx<4>(gk)); gk = fmaxf(gk, shx<8>(gk)); gk = fmaxf(gk, shx<16>(gk)); gk = half_max(gk);
              sb0 = 1.02f * sqrtf(n0) * (VAR == 2 ? 5.656854249f : 8.0f) * gk;
          }
#pragma unroll
          for (int d0 = 0; d0 < ND0; ++d0) { u32x4 w; w.x = cvtpk_s(qf[d0 * 8 + 0], qf[d0 * 8 + 1]); w.y = cvtpk_s(qf[d0 * 8 + 2], qf[d0 * 8 + 3]); w.z = cvtpk_s(qf[d0 * 8 + 4], qf[d0 * 8 + 5]); w.w = cvtpk_s(qf[d0 * 8 + 6], qf[d0 * 8 + 7]);
              qa[d0] = __builtin_bit_cast(bf16x8, w); }
          if (VAR == 2) { qa[2] = qa[0]; qa[3] = qa[1]; }
        }
        float mhat = -1e30f, l_reg = 0.f, Rp = 1.f; f32x16 o[2]; const float sbound = sb0;
#pragma unroll
        for (int r = 0; r < 16; ++r) { o[0][r] = 0.f; o[1][r] = 0.f; }
        if (pass > 0) { DMA_KV(REV ? NT - 1 : 0, 0); DMA_KV(REV ? NT - 2 : 1, SLOTB); }
        int cur = 0, sl1 = SLOTB, sl2 = 2 * SLOTB;
        auto step = [&](auto band_c, const int it) -> bool {
            constexpr bool BAND = decltype(band_c)::value;
            const int t = REV ? NT - 1 - it : it;
            if (pm == 7) { }
            else if (it + 1 < NT) asm volatile("s_waitcnt vmcnt(2) lgkmcnt(0)\n\ts_barrier" ::: "memory");
            else ATT_WAIT_BAR();
            if (REV && it > 0) {
                const LAS unsigned* wz = (const LAS unsigned*)(sh + L_END) + ((it - 1) & 1) * 8;
                const u32x4 z0 = *(const LAS u32x4*)wz, z1 = *(const LAS u32x4*)(wz + 4);
                if (__builtin_amdgcn_readfirstlane((int)(z0.x & z0.y & z0.z & z0.w & z1.x & z1.y & z1.z & z1.w)) != 0) return true;
            }
            if (it + 2 < NT && pm != 7) DMA_KV(REV ? t - 2 : t + 2, sl2);
            const int jb = t - (NT - 4);
            float cinv = 0.f;
            if (VAR == 0) cinv = cumt;
            if (VAR == 2 || VAR == 3) cinv = slope2 * (float)(t * 64 + 4 * hi - tq);
            f32x16 cin;
#pragma unroll
            for (int r = 0; r < 16; ++r) cin[r] = cinv;
            f32x16 p0, p1;
            const LAS char* Ks = sh + L_K + cur;
            if (VAR == 2) { if (pass == 0) { const bf16x8 qq[4] = {qa[0], qa[1], qa[0], qa[1]}; qkt<0, 2>(p0, p1, Ks, qq, cin, r32, hi); }
                            else { const bf16x8 qq[4] = {qa[0], qa[1], qa[0], qa[1]}; qkt<2, 4>(p0, p1, Ks, qq, cin, r32, hi); } }
            else qkt<0, 4>(p0, p1, Ks, qa, cin, r32, hi);
            if (VAR != 1) {
                if (VAR == 0) { const LAS float* cp = cumL + t * 64 + 4 * hi;
#pragma unroll
                    for (int g = 0; g < 4; ++g) { const f32x4 c0 = *(const LAS f32x4*)(cp + 8 * g), c1 = *(const LAS f32x4*)(cp + 32 + 8 * g);
#pragma unroll
                        for (int i = 0; i < 4; ++i) { p0[4 * g + i] -= c0[i]; p1[4 * g + i] -= c1[i]; } } }
                if (VAR == 2 || VAR == 3) {
#pragma unroll
                    for (int r = 0; r < 16; ++r) { const float kc = (float)((r & 3) + 8 * (r >> 2)); p0[r] += slope2 * kc; p1[r] += slope2 * (kc + 32.f); } }
                if (VAR != 3) { if constexpr (BAND) { const int kb = 64 * jb + 4 * hi;
#pragma unroll
                    for (int r = 0; r < 16; ++r) { const int kv = kb + (r & 3) + 8 * (r >> 2); if (kv > qrel) p0[r] = -INFINITY; if (kv + 32 > qrel) p1[r] = -INFINITY; } } }
                else { const u32x2 mw = *(const LAS u32x2*)(maskL + qrel * MROW + 2 * t); const unsigned w0 = mw.x >> (4 * hi), w1 = mw.y >> (4 * hi);
#pragma unroll
                    for (int r = 0; r < 16; ++r) { const int c = (r & 3) + 8 * (r >> 2); if (!((w0 >> c) & 1u)) p0[r] = -INFINITY; if (!((w1 >> c) & 1u)) p1[r] = -INFINITY; } }
                const float rm = rowmax(p0, p1, hi);
                if (__any(rm - mhat > THR)) {
                    const float mn = fmaxf(mhat, rm); const float f = __builtin_amdgcn_exp2f(mhat - mn); mhat = mn; l_reg *= f;
                    if (hi == 0) wsf[r32] = f;
#pragma unroll
                    for (int r = 0; r < 16; ++r) { const float fr = wsf[crow(r, hi)]; o[0][r] *= fr; o[1][r] *= fr; }
                }
                float sa4[4] = {0.f, 0.f, 0.f, 0.f};
#pragma unroll
                for (int r = 0; r < 16; ++r) { p0[r] = __builtin_amdgcn_exp2f(p0[r] - mhat); p1[r] = __builtin_amdgcn_exp2f(p1[r] - mhat); sa4[r & 3] += p0[r] + p1[r]; }
                l_reg += (sa4[0] + sa4[1]) + (sa4[2] + sa4[3]);
                if (VAR == 2 || VAR == 3) {
                    const float ub = sbound - slope2 * (float)(tq - 64 * t + 1) - mhat;
                    const bool dead = __all(ub < -150.f); if (lane == 0) ((LAS unsigned*)(sh + L_END))[(it & 1) * 8 + wid] = dead ? 1u : 0u;
                }
            } else {
                f32x16 m0, m1;
#pragma unroll
                for (int r = 0; r < 16; ++r) {
                    { const float s = __builtin_amdgcn_fmed3f(p0[r], -64.f, 64.f); const float e = __builtin_amdgcn_exp2f(-s); const float bt = __builtin_amdgcn_rcpf(1.f + e); p0[r] = bt; m0[r] = e * bt; }
                    { const float s = __builtin_amdgcn_fmed3f(p1[r], -64.f, 64.f); const float e = __builtin_amdgcn_exp2f(-s); const float bt = __builtin_amdgcn_rcpf(1.f + e); p1[r] = bt; m1[r] = e * bt; } }
                if constexpr (BAND) { const int kb = 64 * jb + 4 * hi;
#pragma unroll
                    for (int r = 0; r < 16; ++r) { const int kv = kb + (r & 3) + 8 * (r >> 2);
                        if (kv >= qrel) { p0[r] = 0.f; m0[r] = 1.f; } if (kv + 32 >= qrel) { p1[r] = 0.f; m1[r] = 1.f; } } }
                float gp[8], gq[8], ex[8];
#pragma unroll
                for (int g = 0; g < 4; ++g) { gp[g] = (m0[4 * g] * m0[4 * g + 1]) * (m0[4 * g + 2] * m0[4 * g + 3]); gp[4 + g] = (m1[4 * g] * m1[4 * g + 1]) * (m1[4 * g + 2] * m1[4 * g + 3]); }
#pragma unroll
                for (int g = 0; g < 8; ++g) gq[g] = xhalf(gp[g], hi);
                float sp = Rp;
#pragma unroll
                for (int g = 7; g >= 0; --g) { ex[g] = hi ? sp : sp * gq[g]; sp *= gp[g] * gq[g]; }
                Rp = sp;
                { const bool allz = !__any(Rp != 0.f); if (lane == 0) ((LAS unsigned*)(sh + L_END))[(it & 1) * 8 + wid] = allz ? 1u : 0u; }
#pragma unroll
                for (int g = 0; g < 4; ++g) {
                    { float c = ex[g]; const float w3 = p0[4 * g + 3] * c; c *= m0[4 * g + 3]; const float w2 = p0[4 * g + 2] * c; c *= m0[4 * g + 2]; const float w1 = p0[4 * g + 1] * c; c *= m0[4 * g + 1]; const float w0 = p0[4 * g] * c;
                      p0[4 * g] = w0; p0[4 * g + 1] = w1; p0[4 * g + 2] = w2; p0[4 * g + 3] = w3; }
                    { float c = ex[4 + g]; const float w3 = p1[4 * g + 3] * c; c *= m1[4 * g + 3]; const float w2 = p1[4 * g + 2] * c; c *= m1[4 * g + 2]; const float w1 = p1[4 * g + 1] * c; c *= m1[4 * g + 1]; const float w0 = p1[4 * g] * c;
                      p1[4 * g] = w0; p1[4 * g + 1] = w1; p1[4 * g + 2] = w2; p1[4 * g + 3] = w3; } }
            }
            u32x4 pw0, pw1, pw2, pw3;
            pw0 = (u32x4){cvtpk_s(p0[0], p0[1]), cvtpk_s(p0[2], p0[3]), cvtpk_s(p0[4], p0[5]), cvtpk_s(p0[6], p0[7])};
            pw1 = (u32x4){cvtpk_s(p0[8], p0[9]), cvtpk_s(p0[10], p0[11]), cvtpk_s(p0[12], p0[13]), cvtpk_s(p0[14], p0[15])};
            pw2 = (u32x4){cvtpk_s(p1[0], p1[1]), cvtpk_s(p1[2], p1[3]), cvtpk_s(p1[4], p1[5]), cvtpk_s(p1[6], p1[7])};
            pw3 = (u32x4){cvtpk_s(p1[8], p1[9]), cvtpk_s(p1[10], p1[11]), cvtpk_s(p1[12], p1[13]), cvtpk_s(p1[14], p1[15])};
            pv(o, vb0 + cur, __builtin_bit_cast(bf16x8, pw0), __builtin_bit_cast(bf16x8, pw1), __builtin_bit_cast(bf16x8, pw2), __builtin_bit_cast(bf16x8, pw3));
            { const int tmp = cur; cur = sl1; sl1 = sl2; sl2 = tmp; }
            return false;
        };
        if (REV) { bool ex = false; int it = 0;
            for (; it < 4 && !ex; ++it) ex = step(BoolC<true>{}, it);
            for (; it < NT && !ex; ++it) ex = step(BoolC<false>{}, it); }
        else { int it = 0;
            for (; it < NT - 4; ++it) (void)step(BoolC<false>{}, it);
            for (; it < NT; ++it) (void)step(BoolC<true>{}, it); }
        ATT_WAIT_BAR();
        if (pass == NPASS - 1 && tid == 0) { nxt_u = __builtin_amdgcn_atomic_inc32(qctr, 0xFFFFFFFFu, __ATOMIC_RELAXED, "agent"); if (P.cvq) nxt_c = __builtin_amdgcn_atomic_inc32(P.cvq, 0xFFFFFFFFu, __ATOMIC_RELAXED, "agent"); }
        float rli[16];
        if (VAR != 1) {
            l_reg += xhalf(l_reg, hi);
            if (hi == 0) wsf[32 + r32] = l_reg;
#pragma unroll
            for (int r = 0; r < 16; ++r) rli[r] = __builtin_amdgcn_rcpf(wsf[32 + crow(r, hi)]);
        } else {
#pragma unroll
            for (int r = 0; r < 16; ++r) rli[r] = 1.f;
        }
#pragma unroll
        for (int r = 0; r < 16; ++r) { const int orow = crow(r, hi);
#pragma unroll
            for (int d0 = 0; d0 < 2; ++d0) { const float val = o[d0][r] * rli[r]; LAS float* sp = stg + orow * 64 + d0 * 32 + r32;
                if (VAR == 2 && pass == 1) *sp = *sp - P.lam * val; else *sp = val; } }
    }
    LDS_WAIT();
    bf16* Ow = P.mix + (size_t)(rowbase + q0 + wid * 32) * DM + VAR * 256 + h * 64;
#pragma unroll
    for (int i = 0; i < 4; ++i) { const int row = i * 8 + (lane >> 3), ch = lane & 7;
        const f32x4 a = *(const LAS f32x4*)(stg + row * 64 + ch * 8), c = *(const LAS f32x4*)(stg + row * 64 + ch * 8 + 4);
        float sc = 1.f;
        if (VAR == 2) { float ss = (a[0] * a[0] + a[1] * a[1]) + (a[2] * a[2] + a[3] * a[3]) + (c[0] * c[0] + c[1] * c[1]) + (c[2] * c[2] + c[3] * c[3]);
            ss += shx<1>(ss); ss += shx<2>(ss); ss += shx<4>(ss); sc = 1.0f / sqrtf(ss * (1.f / 64.f) + RMS_EPS); }
        u32x4 w; w.x = cvtpk_s(a[0] * sc, a[1] * sc); w.y = cvtpk_s(a[2] * sc, a[3] * sc); w.z = cvtpk_s(c[0] * sc, c[1] * sc); w.w = cvtpk_s(c[2] * sc, c[3] * sc);
        if (pm == 0 || (w.x == 0x12345678u && w.y == 0x9abcdef0u)) *(u32x4*)(Ow + (size_t)row * DM + ch * 8) = w; }
    if (tid == 0) { *qslot = nxt_u; if (P.cvq) qslot[3] = nxt_c; }
    asm volatile("s_waitcnt lgkmcnt(0)\n\ts_barrier" ::: "memory");
#undef DMA_KV
}
typedef __attribute__((address_space(3))) const char* lds_cptr;
typedef short v4i16_t __attribute__((ext_vector_type(4)));
__device__ __forceinline__ s16x4 vtr(lds_cptr p) { return __builtin_bit_cast(s16x4, __builtin_amdgcn_ds_read_tr16_b64_v4i16((__attribute__((address_space(3))) v4i16_t*)p)); }
template <int VAR>
__device__ __forceinline__ void attn_unit2(const AttnP& P, int b, int h, int qb, LAS char* sh, const int tid_in, unsigned* qctr, volatile LAS unsigned* qslot) {
    static_assert(VAR == 0 || VAR == 2 || VAR == 3, "softmax mixers only");
    int tid = tid_in; asm volatile("" : "+v"(tid));
    const int lane = tid & 63, r32 = lane & 31, hi = lane >> 5; const int wid = __builtin_amdgcn_readfirstlane(tid >> 6);
    const long rowbase = (long)b * SEQ; const int q0 = qb * 256, NT = 4 * (qb + 1);
    const int qrel = wid * 32 + r32, tq = q0 + qrel;
    constexpr int QCB = VAR == 0 ? C_AQ : VAR == 1 ? C_BQ : VAR == 2 ? C_CQ : C_DQ;
    constexpr int KCB = VAR == 0 ? C_AK : VAR == 1 ? C_BK : VAR == 2 ? C_CK : C_DK;
    constexpr int VCB = VAR == 0 ? C_AV : VAR == 1 ? C_BV : VAR == 2 ? C_CV : C_DV;
    const int Qc = QCB + 64 * h, Kc = VAR == 3 ? KCB : KCB + 64 * h, Vc = VAR == 3 ? VCB : VCB + 64 * h;
    const bf16* PR = P.proj;
    LAS float* wsf = (LAS float*)(sh + L_WS) + wid * 64;
    LAS float* stg = (LAS float*)(sh + L_OST) + wid * 2048;
    LAS float* cumL = (LAS float*)(sh + L_CUM);
    LAS unsigned* maskL = (LAS unsigned*)(sh + L_OST);
    const unsigned lds0 = (unsigned)(uintptr_t)sh;
    const bf16* ksrc = PR + (size_t)(rowbase + lane) * NP + Kc + wid * 8;
    const bf16* vsrc = PR + (size_t)(rowbase + 16 * (wid & 3) + (lane >> 2)) * NP + Vc + (wid >> 2) * 32 + (lane & 3) * 8;
    const unsigned kdst = lds0 + L_K + wid * 1024, vdst = lds0 + L_V + wid * 1024;
#define TILE2(j) (NT - 1 - (j))
#define DMA_K2(j, slot) glds16(ksrc + (size_t)TILE2(j) * 64 * NP, (unsigned)__builtin_amdgcn_readfirstlane(kdst + (slot)))
#define DMA_V2(j, slot) glds16(vsrc + (size_t)TILE2(j) * 64 * NP, (unsigned)__builtin_amdgcn_readfirstlane(vdst + (slot)))
    DMA_K2(0, 0); DMA_K2(1, SLOTB); DMA_V2(0, 0);
    constexpr int NDQ = VAR == 2 ? 2 : 4; bf16x8 qpre[NDQ];
    { const bf16* Qw0 = PR + (size_t)(rowbase + tq) * NP + Qc;
#pragma unroll
      for (int d0 = 0; d0 < NDQ; ++d0) qpre[d0] = *(const bf16x8*)(Qw0 + d0 * 16 + hi * 8); }
    if (VAR == 0) {
        LAS float* pref = (LAS float*)(sh + L_WS);
        const float* cg = P.cum + (size_t)(b * 4 + h) * SEQ; float cgv[4];
#pragma unroll
        for (int k = 0; k < 4; ++k) { const int i = tid + 512 * k; cgv[k] = i < q0 + 256 ? cg[i] : 0.f; }
        if (tid < 64) { const float ct = P.cum[32 * SEQ + (b * 4 + h) * 64 + tid]; float incl = ct;
#pragma unroll
            for (int o = 1; o < 64; o <<= 1) { const float u = shup(incl, o, tid); if (tid >= o) incl += u; }
            pref[tid] = incl - ct; }
        asm volatile("s_waitcnt lgkmcnt(0)\n\ts_barrier" ::: "memory");
#pragma unroll
        for (int k = 0; k < 4; ++k) { const int i = tid + 512 * k; if (i < q0 + 256) cumL[i] = (cgv[k] + pref[i >> 5]) * LOG2E; }
        asm volatile("s_waitcnt lgkmcnt(0)\n\ts_barrier" ::: "memory");
    }
    if (VAR == 3) { const unsigned* mg = P.mask + (size_t)(rowbase + q0) * 64; const int nw = 2 * NT;
#pragma unroll 16
        for (int i = tid; i < 256 * 32; i += 512) { const int row = i >> 5, w = 2 * (i & 31); if (w < nw) *(LAS u32x2*)(maskL + row * MROW + w) = *(const u32x2*)(mg + row * 64 + w); } }
    asm volatile("s_waitcnt vmcnt(0) lgkmcnt(0)\n\ts_barrier" ::: "memory");
    const lds_cptr shc = (lds_cptr)sh;
    const lds_cptr kp0 = shc + L_K + hi * 1024 + r32 * 16;
    const lds_cptr vp0 = shc + L_V + ((lane >> 4) & 1) * 32 + (lane & 3) * 8 + (4 * hi + ((lane & 15) >> 2)) * 64;
    float slope2 = 0.f;
    if (VAR == 2) slope2 = __builtin_amdgcn_exp2f(-(float)(2 * h + 1)) * LOG2E;
    if (VAR == 3) slope2 = __builtin_amdgcn_exp2f(-(float)(2 * h + 2)) * LOG2E;
    float cumt = 0.f; if (VAR == 0) cumt = cumL[tq];
    constexpr int NPASS = VAR == 2 ? 2 : 1;
    unsigned nxt_u = 0u, nxt_c = 0u;
    const auto slot3 = [](int j) { return (j % 3) * SLOTB; };
#define SB2() __builtin_amdgcn_sched_barrier(0)
#define PINV(x) asm volatile("" : "+v"(x))
#define MF32(a, b, c) __builtin_amdgcn_mfma_f32_32x32x16_bf16(a, b, c, 0, 0, 0)
#define ATT_BARN(N) do { asm volatile("s_waitcnt vmcnt(" #N ") lgkmcnt(0)\n\ts_barrier" ::: "memory"); SB2(); } while (0)
#define PKW(Pv, i) cvtpk_s(Pv[i], Pv[(i) + 1])
#define PAF(k) __builtin_bit_cast(bf16x8, pw##k)
#define VFR(i) (bf16x8){vlo[i][0], vlo[i][1], vlo[i][2], vlo[i][3], vhi[i][0], vhi[i][1], vhi[i][2], vhi[i][3]}
#define VRD(i) do { vlo[i] = vtr(vp_ + (((i) >> 2) * 4096 + ((i) & 3) * 1024)); vhi[i] = vtr(vp_ + (((i) >> 2) * 4096 + ((i) & 3) * 1024 + 512)); } while (0)
#define EX2(v) __builtin_amdgcn_exp2f(v)
#define GAPA(MF, Pv, i, PW, w) do { MF; sacc += Pv[i]; sacc += Pv[(i) + 1]; sacc += Pv[(i) + 2]; sacc += Pv[(i) + 3]; PINV(sacc); PW[w] = PKW(Pv, i); PW[(w) + 1] = PKW(Pv, (i) + 2); PINV(PW); SB2(); } while (0)
#define GAPA8(MF, Pv, i, PW) do { MF; sacc += Pv[i]; sacc += Pv[(i) + 1]; sacc += Pv[(i) + 2]; sacc += Pv[(i) + 3]; sacc += Pv[(i) + 4]; sacc += Pv[(i) + 5]; sacc += Pv[(i) + 6]; sacc += Pv[(i) + 7]; PINV(sacc); \
        PW[0] = PKW(Pv, i); PW[1] = PKW(Pv, (i) + 2); PW[2] = PKW(Pv, (i) + 4); PW[3] = PKW(Pv, (i) + 6); PINV(PW); SB2(); } while (0)
#define GAPB(MF, X, i) do { MF; X[i] = EX2(X[i]); X[(i) + 1] = EX2(X[(i) + 1]); X[(i) + 2] = EX2(X[(i) + 2]); X[(i) + 3] = EX2(X[(i) + 3]); PINV(X); SB2(); } while (0)
    for (int pass = 0; pass < NPASS; ++pass) {
        bf16x8 qa[4]; float sb0 = 0.f;
        { const bf16* Qw = PR + (size_t)(rowbase + tq) * NP + Qc;
          constexpr int ND0 = VAR == 2 ? 2 : 4; const int dbase = VAR == 2 ? 2 * pass : 0;
          float qf[8 * ND0];
#pragma unroll
          for (int d0 = 0; d0 < ND0; ++d0) { bf16x8 raw = qpre[d0]; if (pass > 0) raw = *(const bf16x8*)(Qw + (dbase + d0) * 16 + hi * 8);
#pragma unroll
              for (int j = 0; j < 8; ++j) qf[d0 * 8 + j] = bf2f((unsigned short)raw[j]); }
          constexpr float SC = (VAR == 2 ? 0.17677669529663687f : 0.125f) * LOG2E;
          if (VAR != 1) {
              float ss = 0.f;
#pragma unroll
              for (int i = 0; i < 8 * ND0; ++i) ss += qf[i] * qf[i];
              ss += xhalf(ss, hi); const float rstd = 1.0f / sqrtf(ss * (VAR == 2 ? 1.f / 32.f : 1.f / 64.f) + RMS_EPS);
              const float* g = P.qgain[VAR];
#pragma unroll
              for (int d0 = 0; d0 < ND0; ++d0)
#pragma unroll
                  for (int j = 0; j < 8; ++j) qf[d0 * 8 + j] *= rstd * g[16 * d0 + 8 * hi + j] * SC;
          } else {
#pragma unroll
              for (int i = 0; i < 8 * ND0; ++i) qf[i] *= SC;
          }
          if (VAR == 2 || VAR == 3) {
              float n0 = 0.f;
#pragma unroll
              for (int i = 0; i < 8 * ND0; ++i) n0 += qf[i] * qf[i];
              n0 += xhalf(n0, hi);
              float gk = fabsf(P.kgain[VAR][lane & (VAR == 2 ? 31 : 63)]);
              gk = fmaxf(gk, shx<1>(gk)); gk = fmaxf(gk, shx<2>(gk)); gk = fmaxf(gk, shx<4>(gk)); gk = fmaxf(gk, shx<8>(gk)); gk = fmaxf(gk, shx<16>(gk)); gk = half_max(gk);
              sb0 = 1.02f * sqrtf(n0) * (VAR == 2 ? 5.656854249f : 8.0f) * gk;
          }
#pragma unroll
          for (int d0 = 0; d0 < ND0; ++d0) { u32x4 w; w.x = cvtpk_s(qf[d0 * 8 + 0], qf[d0 * 8 + 1]); w.y = cvtpk_s(qf[d0 * 8 + 2], qf[d0 * 8 + 3]); w.z = cvtpk_s(qf[d0 * 8 + 4], qf[d0 * 8 + 5]); w.w = cvtpk_s(qf[d0 * 8 + 6], qf[d0 * 8 + 7]);
              qa[d0] = __builtin_bit_cast(bf16x8, w); }
          if (VAR == 2) { qa[2] = qa[0]; qa[3] = qa[1]; }
        }
        const float sbound = sb0;
        if (pass > 0) { DMA_K2(0, 0); DMA_K2(1, SLOTB); DMA_V2(0, 0); }
        float mhat = 0.f, l_reg = 0.f; bool hasref = false, resc = false; f32x16 o[2], negm;
#pragma unroll
        for (int r = 0; r < 16; ++r) { o[0][r] = 0.f; o[1][r] = 0.f; }
        f32x16 pA0, pA1, pB0, pB1; u32x4 pw0, pw1, pw2, pw3;
#pragma unroll
        for (int r = 0; r < 16; ++r) { pB0[r] = 0.f; pB1[r] = 0.f; }
        const auto setneg = [&](int t) __attribute__((always_inline)) { float v = -mhat; if (VAR == 0) v += cumt; else v += slope2 * (float)(t * 64 + 4 * hi - tq);
#pragma unroll
            for (int r = 0; r < 16; ++r) negm[r] = v;
            PINV(negm); };
        const auto mid = [&](f32x16& C0, f32x16& C1, const int it) __attribute__((always_inline)) {
            const int t = NT - 1 - it;
            if (VAR == 0) { const LAS float* cp = cumL + t * 64 + 4 * hi;
#pragma unroll
                for (int g = 0; g < 4; ++g) { const f32x4 c0 = *(const LAS f32x4*)(cp + 8 * g), c1 = *(const LAS f32x4*)(cp + 32 + 8 * g);
#pragma unroll
                    for (int i = 0; i < 4; ++i) { C0[4 * g + i] -= c0[i]; C1[4 * g + i] -= c1[i]; } } }
            else {
#pragma unroll
                for (int r = 0; r < 16; ++r) { const float kc = (float)((r & 3) + 8 * (r >> 2)); C0[r] += slope2 * kc; C1[r] += slope2 * (kc + 32.f); } }
            if (VAR != 3) { if (it < 4) { asm volatile("" ::: "memory");
                const int kb = 64 * (3 - it) + 4 * hi;
#pragma unroll
                for (int r = 0; r < 16; ++r) { const int kv = kb + (r & 3) + 8 * (r >> 2); if (kv > qrel) C0[r] = -INFINITY; if (kv + 32 > qrel) C1[r] = -INFINITY; } } }
            else { const u32x2 mw = *(const LAS u32x2*)(maskL + qrel * MROW + 2 * t); const unsigned w0 = mw.x >> (4 * hi), w1 = mw.y >> (4 * hi);
#pragma unroll
                for (int r = 0; r < 16; ++r) { const int c = (r & 3) + 8 * (r >> 2); if (!((w0 >> c) & 1u)) C0[r] = -INFINITY; if (!((w1 >> c) & 1u)) C1[r] = -INFINITY; } }
            const float rm = rowmax(C0, C1, hi);
            const bool need = hasref ? (rm > THR) : (rm > -INFINITY);
            resc = false;
            if (__any(need)) {
                const bool fin = rm > -INFINITY;
                const float dl = hasref ? fmaxf(rm, 0.f) : (fin ? rm : 0.f);
                const float f = hasref ? EX2(-dl) : 1.f;
                mhat += dl; l_reg *= f;
#pragma unroll
                for (int r = 0; r < 16; ++r) { C0[r] -= dl; C1[r] -= dl; }
                if (hi == 0) wsf[r32] = f;
                resc = true; hasref = hasref || fin;
            }
            if (VAR != 0) {
                const bool dead = hasref && (sbound - slope2 * (float)(tq - 64 * t + 1) - mhat < -150.f);
                const bool alld = __all(dead); if (lane == 0) ((LAS unsigned*)(sh + L_END))[(it & 1) * 8 + wid] = alld ? 1u : 0u;
            }
        };
#define KLD(dst0, dst1, d0) do { dst0 = *(const LAS bf16x8*)(kp_ + (d0) * 2048); dst1 = *(const LAS bf16x8*)(kp_ + (d0) * 2048 + 512); } while (0)
#define VLD(lo, hi_, i) do { lo = vtr(vp_ + (((i) >> 2) * 4096 + ((i) & 3) * 1024)); hi_ = vtr(vp_ + (((i) >> 2) * 4096 + ((i) & 3) * 1024 + 512)); } while (0)
#define VF(lo, hi_) (bf16x8){lo[0], lo[1], lo[2], lo[3], hi_[0], hi_[1], hi_[2], hi_[3]}
        const auto step = [&](f32x16& C0, f32x16& C1, f32x16& P0, f32x16& P1, const int it) __attribute__((always_inline)) -> bool {
            if (it + 1 < NT) ATT_BARN(2); else ATT_BARN(1);
            if (VAR != 0 && it >= 1) { const LAS unsigned* wz = (const LAS unsigned*)(sh + L_END) + ((it - 1) & 1) * 8;
                const u32x4 z0 = *(const LAS u32x4*)wz, z1 = *(const LAS u32x4*)(wz + 4);
                if (__builtin_amdgcn_readfirstlane((int)(z0.x & z0.y & z0.z & z0.w & z1.x & z1.y & z1.z & z1.w)) != 0) return true; }
            if (it + 2 < NT) DMA_K2(it + 2, slot3(it + 2));
            if (it + 1 < NT) DMA_V2(it + 1, slot3(it + 1));
            setneg(NT - 1 - it);
            int ko_ = slot3(it), vo_ = slot3(it + 2);
            asm volatile("" : "+s"(ko_), "+s"(vo_));
            const lds_cptr kp_ = kp0 + ko_; const lds_cptr vp_ = vp0 + vo_;
            bf16x8 ka0, ka1, kb0, kb1; s16x4 va0, va1, vb0, vb1;
            float sacc = 0.f;
            if (VAR == 2) {
                KLD(ka0, ka1, 2 * pass); KLD(kb0, kb1, 2 * pass + 1); SB2();
                GAPA8(C0 = MF32(ka0, qa[0], negm), P0, 0, pw0);
                GAPA8(C1 = MF32(ka1, qa[0], negm), P0, 8, pw1);
                GAPA8(C0 = MF32(kb0, qa[1], C0), P1, 0, pw2);
                GAPA8(C1 = MF32(kb1, qa[1], C1), P1, 8, pw3);
            } else {
                KLD(ka0, ka1, 0); KLD(kb0, kb1, 1); SB2();
                GAPA(C0 = MF32(ka0, qa[0], negm), P0, 0, pw0, 0);
                GAPA(C1 = MF32(ka1, qa[0], negm), P0, 4, pw0, 2);
                KLD(ka0, ka1, 2); SB2();
                GAPA(C0 = MF32(kb0, qa[1], C0), P0, 8, pw1, 0);
                GAPA(C1 = MF32(kb1, qa[1], C1), P0, 12, pw1, 2);
                KLD(kb0, kb1, 3); SB2();
                GAPA(C0 = MF32(ka0, qa[2], C0), P1, 0, pw2, 0);
                GAPA(C1 = MF32(ka1, qa[2], C1), P1, 4, pw2, 2);
                GAPA(C0 = MF32(kb0, qa[3], C0), P1, 8, pw3, 0);
                GAPA(C1 = MF32(kb1, qa[3], C1), P1, 12, pw3, 2);
            }
            l_reg += sacc;
            mid(C0, C1, it);
            SB2();
            if (it > 0) {
                VLD(va0, va1, 0); VLD(vb0, vb1, 4); SB2();
                GAPB(o[0] = MF32(PAF(0), VF(va0, va1), o[0]), C0, 0);  VLD(va0, va1, 1); SB2();
                GAPB(o[1] = MF32(PAF(0), VF(vb0, vb1), o[1]), C0, 4);  VLD(vb0, vb1, 5); SB2();
                GAPB(o[0] = MF32(PAF(1), VF(va0, va1), o[0]), C0, 8);  VLD(va0, va1, 2); SB2();
                GAPB(o[1] = MF32(PAF(1), VF(vb0, vb1), o[1]), C0, 12); VLD(vb0, vb1, 6); SB2();
                GAPB(o[0] = MF32(PAF(2), VF(va0, va1), o[0]), C1, 0);  VLD(va0, va1, 3); SB2();
                GAPB(o[1] = MF32(PAF(2), VF(vb0, vb1), o[1]), C1, 4);  VLD(vb0, vb1, 7); SB2();
                GAPB(o[0] = MF32(PAF(3), VF(va0, va1), o[0]), C1, 8);
                GAPB(o[1] = MF32(PAF(3), VF(vb0, vb1), o[1]), C1, 12);
                if (resc) {
#pragma unroll
                    for (int r = 0; r < 16; ++r) { const float fr = wsf[crow(r, hi)]; o[0][r] *= fr; o[1][r] *= fr; } }
            } else {
#pragma unroll
                for (int r = 0; r < 16; ++r) { C0[r] = EX2(C0[r]); C1[r] = EX2(C1[r]); }
            }
            return false;
        };
        bool ex = false, pendA = true; int it = 0;
        for (; it < NT; it += 2) {
            ex = step(pA0, pA1, pB0, pB1, it); if (ex) { pendA = false; break; }
            ex = step(pB0, pB1, pA0, pA1, it + 1); if (ex) { pendA = true; ++it; break; }
        }
        if (!ex) pendA = false;
        if (!ex) ATT_BARN(0);
        { int vo_ = slot3(it + 2); asm volatile("" : "+s"(vo_)); const lds_cptr vp_ = vp0 + vo_; s16x4 vlo[8], vhi[8];
#pragma unroll
          for (int i = 0; i < 8; ++i) VRD(i);
          float sacc = 0.f;
          if (pendA) {
#pragma unroll
              for (int r = 0; r < 16; ++r) sacc += pA0[r] + pA1[r];
              pw0 = (u32x4){PKW(pA0, 0), PKW(pA0, 2), PKW(pA0, 4), PKW(pA0, 6)}; pw1 = (u32x4){PKW(pA0, 8), PKW(pA0, 10), PKW(pA0, 12), PKW(pA0, 14)};
              pw2 = (u32x4){PKW(pA1, 0), PKW(pA1, 2), PKW(pA1, 4), PKW(pA1, 6)}; pw3 = (u32x4){PKW(pA1, 8), PKW(pA1, 10), PKW(pA1, 12), PKW(pA1, 14)};
          } else {
#pragma unroll
              for (int r = 0; r < 16; ++r) sacc += pB0[r] + pB1[r];
              pw0 = (u32x4){PKW(pB0, 0), PKW(pB0, 2), PKW(pB0, 4), PKW(pB0, 6)}; pw1 = (u32x4){PKW(pB0, 8), PKW(pB0, 10), PKW(pB0, 12), PKW(pB0, 14)};
              pw2 = (u32x4){PKW(pB1, 0), PKW(pB1, 2), PKW(pB1, 4), PKW(pB1, 6)}; pw3 = (u32x4){PKW(pB1, 8), PKW(pB1, 10), PKW(pB1, 12), PKW(pB1, 14)};
          }
          l_reg += sacc;
          o[0] = MF32(PAF(0), VFR(0), o[0]); o[1] = MF32(PAF(0), VFR(4), o[1]); o[0] = MF32(PAF(1), VFR(1), o[0]); o[1] = MF32(PAF(1), VFR(5), o[1]);
          o[0] = MF32(PAF(2), VFR(2), o[0]); o[1] = MF32(PAF(2), VFR(6), o[1]); o[0] = MF32(PAF(3), VFR(3), o[0]); o[1] = MF32(PAF(3), VFR(7), o[1]); }
        ATT_WAIT_BAR();
        if (pass == NPASS - 1 && tid == 0) { nxt_u = __builtin_amdgcn_atomic_inc32(qctr, 0xFFFFFFFFu, __ATOMIC_RELAXED, "agent"); if (P.cvq) nxt_c = __builtin_amdgcn_atomic_inc32(P.cvq, 0xFFFFFFFFu, __ATOMIC_RELAXED, "agent"); }
        int lane_e = lane; asm volatile("" : "+v"(lane_e)); const int r32e = lane_e & 31, hie = lane_e >> 5;
        LAS float* wsfe = (LAS float*)(sh + L_WS) + wid * 64; LAS float* stge = (LAS float*)(sh + L_OST) + wid * 2048;
        float rli[16];
        l_reg += xhalf(l_reg, hie);
        if (hie == 0) wsfe[32 + r32e] = l_reg;
#pragma unroll
        for (int r = 0; r < 16; ++r) rli[r] = __builtin_amdgcn_rcpf(wsfe[32 + crow(r, hie)]);
#pragma unroll
        for (int r = 0; r < 16; ++r) { const int orow = crow(r, hie);
#pragma unroll
            for (int d0 = 0; d0 < 2; ++d0) { const float val = o[d0][r] * rli[r]; LAS float* sp = stge + orow * 64 + d0 * 32 + r32e;
                if (VAR == 2 && pass == 1) *sp = *sp - P.lam * val; else *sp = val; } }
    }
    LDS_WAIT();
    int lane_o = tid & 63; asm volatile("" : "+v"(lane_o));
    bf16* Ow = P.mix + (size_t)(rowbase + q0 + wid * 32) * DM + VAR * 256 + h * 64;
    { const int lane = lane_o; LAS float* stg = (LAS float*)(sh + L_OST) + wid * 2048;
#pragma unroll
    for (int i = 0; i < 4; ++i) { const int row = i * 8 + (lane >> 3), ch = lane & 7;
        const f32x4 a = *(const LAS f32x4*)(stg + row * 64 + ch * 8), c = *(const LAS f32x4*)(stg + row * 64 + ch * 8 + 4);
        float sc = 1.f;
        if (VAR == 2) { float ss = (a[0] * a[0] + a[1] * a[1]) + (a[2] * a[2] + a[3] * a[3]) + (c[0] * c[0] + c[1] * c[1]) + (c[2] * c[2] + c[3] * c[3]);
            ss += shx<1>(ss); ss += shx<2>(ss); ss += shx<4>(ss); sc = 1.0f / sqrtf(ss * (1.f / 64.f) + RMS_EPS); }
        u32x4 w; w.x = cvtpk_s(a[0] * sc, a[1] * sc); w.y = cvtpk_s(a[2] * sc, a[3] * sc); w.z = cvtpk_s(c[0] * sc, c[1] * sc); w.w = cvtpk_s(c[2] * sc, c[3] * sc);
        *(u32x4*)(Ow + (size_t)row * DM + ch * 8) = w; } }
    if (tid == 0) { *qslot = nxt_u; if (P.cvq) qslot[3] = nxt_c; }
    asm volatile("s_waitcnt lgkmcnt(0)\n\ts_barrier" ::: "memory");
#undef DMA_K2
#undef DMA_V2
#undef TILE2
}
#undef SB2
#undef PINV
#undef MF32
#undef ATT_BARN
#undef PKW
#undef PAF
#undef VFR
#undef VRD
#undef EX2
#undef GAPA
#undef GAPA8
#undef GAPB
#undef KLD
#undef VLD
#undef VF
}

__device__ __forceinline__ void p4_attention(Frame& F, const Args& A, int l, int qsel) {
    att::AttnP P; P.proj = (const bf16*)(F.ws + WS_PROJ); P.mix = (bf16*)(F.ws + WS_MIX); P.cum = (const float*)(F.ws + WS_CUM); P.mask = (const unsigned*)(F.ws + WS_MASK);
    P.qgain[0] = inp<I_QNA>() + l * 64; P.qgain[1] = nullptr; P.qgain[2] = inp<I_QNC>() + l * 32; P.qgain[3] = inp<I_QND>() + l * 64; P.kgain[0] = nullptr; P.kgain[1] = nullptr; P.kgain[2] = inp<I_KNC>() + l * 32; P.kgain[3] = inp<I_KND>() + l * 64; P.lam = ((const float*)(F.ws + WS_MISC))[l];
    LAS char* sh = (LAS char*)F.lds;
    LAS float* rsl2 = (LAS float*)(F.lds + 126976);
    bool cv = BG_CONVERT && (qsel == 0);
    if (cv) { fill_rowscale(F, A, 0, rsl2); fill_rowscale(F, A, 1, rsl2 + DM); }
    P.cvq = cv ? F.ctl + CW_CVQ : nullptr;
    if (F.tid == 0) F.MISC[0] = (unsigned)(F.bx - F.G);
    __syncthreads();
    for (;;) {
        const int u = (int)F.MISC[0] + F.G;
        if (u >= 1024) break;
        const int qb = 7 - (u >> 7), r = u & 127, var = r >> 5, bh = r & 31, b = bh >> 2, h = bh & 3;
        const int tv = var == 0 ? 2 : var == 1 ? 1 : var == 2 ? 3 : 0;
        if (qsel >= 2 && PROBE_ATT_VAR >= 0 && tv != PROBE_ATT_VAR) { __syncthreads(); if (F.tid == 0) F.MISC[0] = __hip_atomic_fetch_add(F.ctl + CW_AQ + 64 * qsel, 1u, RLX_AGENT); __syncthreads(); continue; }
#ifdef ONLY_VAR2
        att::attn_unit2<ONLY_VAR2>(P, b, h, qb, sh, F.tid, F.ctl + CW_AQ + 64 * qsel, F.MISC);
#else
        if (tv == 2) att::attn_unit<2>(P, b, h, qb, sh, F.tid, qsel >= 2 ? PROBE_ATT_MODE : 0, F.ctl + CW_AQ + 64 * qsel, F.MISC);
        else if (tv == 1) att::attn_unit<1>(P, b, h, qb, sh, F.tid, qsel >= 2 ? PROBE_ATT_MODE : 0, F.ctl + CW_AQ + 64 * qsel, F.MISC);
        else if (tv == 3) att::attn_unit<3>(P, b, h, qb, sh, F.tid, qsel >= 2 ? PROBE_ATT_MODE : 0, F.ctl + CW_AQ + 64 * qsel, F.MISC);
        else att::attn_unit2<0>(P, b, h, qb, sh, F.tid, F.ctl + CW_AQ + 64 * qsel, F.MISC);
#endif
        if (cv) {
            const int gb = (int)F.MISC[3] * CV_CHUNK;
            if (gb >= CV_TOTAL) { cv = false; P.cvq = nullptr; } else convert_chunk(F, A, gb, rsl2);
            __syncthreads();
        }
    }
    while (cv) {
        __syncthreads();
        if (F.tid == 0) F.MISC[3] = __hip_atomic_fetch_add(F.ctl + CW_CVQ, 1u, RLX_AGENT);
        __syncthreads();
        const int gb = (int)F.MISC[3] * CV_CHUNK;
        if (gb >= CV_TOTAL) cv = false; else convert_chunk(F, A, gb, rsl2);
    }
    __syncthreads();
}

template <int N, int Dd> __device__ __forceinline__ void bfly(float (&p)[32], int lane) { const bool up = (lane & Dd) != 0;
#pragma unroll
    for (int j = 0; j < N / 2; ++j) { const float a = p[2 * j], bb = p[2 * j + 1]; const float send = up ? a : bb, keep = up ? bb : a; p[j] = keep + __shfl_xor(send, Dd); } }
__device__ __forceinline__ void p6_router(Frame& F, const Args& A, int l, int rep) {
    const float* MOD = (const float*)(F.ws + WS_MOD); const bf16* X1 = (const bf16*)(F.ws + WS_X1); bf16* H = (bf16*)(F.ws + WS_H);
    const bf16* WRH = (const bf16*)(F.ws + WS_WR) + (size_t)l * 48 * DM; const bf16* WRL = WRH + 2 * 48 * DM;
    int* tok_e = (int*)(F.ws + WS_TOK); float* tok_w = (float*)(F.ws + WS_TOK) + 2 * M; int* tok_pos = (int*)(F.ws + WS_TOK) + 4 * M;
    constexpr int AP = 528;
    LAS unsigned char* Ahi = F.lds; LAS unsigned char* Alo = F.lds + 64 * AP; LAS unsigned char* Bhi = F.lds + 128 * AP; LAS unsigned char* Blo = F.lds + 176 * AP;
    LAS float* PL = (LAS float*)F.lds;
    const int lane = F.lane, w = F.wave; const int mw = (F.vcu * NWAVES + w) * 8; const int b = mw >> 11;
    const float* md = MOD + ((size_t)l * 8 + b) * 6144;
    f32x4 hv[8][4];
#pragma unroll
    for (int r = 0; r < 8; ++r) {
        const bf16* xr = X1 + (size_t)(mw + r) * DM;
#pragma unroll
        for (int j = 0; j < 4; ++j) { const u32x2 q = *(const u32x2*)(xr + 256 * j + 4 * lane); hv[r][j] = (f32x4){bf2f(q.x & 0xffff), bf2f(q.x >> 16), bf2f(q.y & 0xffff), bf2f(q.y >> 16)}; }
    }
    { f32x4 gm[4], sc[4], sh[4]; const float* n2 = inp<I_N2G>() + l * DM;
#pragma unroll
      for (int j = 0; j < 4; ++j) { const int col = 256 * j + 4 * lane; gm[j] = *(const f32x4*)(n2 + col); sc[j] = *(const f32x4*)(md + 4 * DM + col); sh[j] = *(const f32x4*)(md + 3 * DM + col); gm[j] = gm[j] * (sc[j] + 1.0f); }
#pragma unroll
      for (int r = 0; r < 8; ++r) { float ss = 0.f;
#pragma unroll
        for (int j = 0; j < 4; ++j) ss += (hv[r][j][0] * hv[r][j][0] + hv[r][j][1] * hv[r][j][1]) + (hv[r][j][2] * hv[r][j][2] + hv[r][j][3] * hv[r][j][3]);
        const float rstd = 1.0f / sqrtf(wave_sum(ss) * (1.f / DM) + RMS_EPS);
#pragma unroll
        for (int j = 0; j < 4; ++j) { hv[r][j] = hv[r][j] * rstd * gm[j] + sh[j]; u32x2 pk; pk.x = pk2(hv[r][j][0], hv[r][j][1]); pk.y = pk2(hv[r][j][2], hv[r][j][3]);
            *(u32x2*)(H + (size_t)(mw + r) * DM + 256 * j + 4 * lane) = pk; } } }
    const int rt = w & 3, kh = w >> 2, arow = lane & 15, kg = lane >> 4;
    f32x4 acc[3];
#pragma unroll
    for (int c = 0; c < 3; ++c) acc[c] = (f32x4){0.f, 0.f, 0.f, 0.f};
    u32x4 bpre[2][3];
    const auto loadB = [&](int j) {
#pragma unroll
        for (int k = 0; k < 3; ++k) { const int i = F.tid + 512 * k, o = i >> 5, c16 = i & 31;
            bpre[0][k] = *(const u32x4*)(WRH + (size_t)o * DM + 256 * j + 8 * c16); bpre[1][k] = *(const u32x4*)(WRL + (size_t)o * DM + 256 * j + 8 * c16); } };
    loadB(0);
#pragma unroll
    for (int j = 0; j < 4; ++j) {
        __syncthreads();
#pragma unroll
        for (int r = 0; r < 8; ++r) { const f32x4 x = hv[r][j]; unsigned h0 = f2bf(x[0]), h1 = f2bf(x[1]), h2 = f2bf(x[2]), h3 = f2bf(x[3]);
            u32x2 hi; hi.x = h0 | (h1 << 16); hi.y = h2 | (h3 << 16);
            u32x2 lo; lo.x = pk2(x[0] - bf2f((unsigned short)h0), x[1] - bf2f((unsigned short)h1)); lo.y = pk2(x[2] - bf2f((unsigned short)h2), x[3] - bf2f((unsigned short)h3));
            *(LAS u32x2*)(Ahi + (w * 8 + r) * AP + lane * 8) = hi; *(LAS u32x2*)(Alo + (w * 8 + r) * AP + lane * 8) = lo; }
#pragma unroll
        for (int k = 0; k < 3; ++k) { const int i = F.tid + 512 * k, o = i >> 5, c16 = i & 31; *(LAS u32x4*)(Bhi + o * AP + c16 * 16) = bpre[0][k]; *(LAS u32x4*)(Blo + o * AP + c16 * 16) = bpre[1][k]; }
        if (j + 1 < 4) loadB(j + 1);
        LDS_WAIT(); __syncthreads();
#pragma unroll
        for (int ks = 0; ks < 4; ++ks) { const int kb = ((4 * kh + ks) * 32 + 8 * kg) * 2;
            const bf16x8 ah = *(const LAS bf16x8*)(Ahi + (16 * rt + arow) * AP + kb), al = *(const LAS bf16x8*)(Alo + (16 * rt + arow) * AP + kb);
#pragma unroll
            for (int c = 0; c < 3; ++c) { const bf16x8 bh = *(const LAS bf16x8*)(Bhi + (16 * c + arow) * AP + kb), bl = *(const LAS bf16x8*)(Blo + (16 * c + arow) * AP + kb);
                acc[c] = __builtin_amdgcn_mfma_f32_16x16x32_bf16(ah, bh, acc[c], 0, 0, 0);
                acc[c] = __builtin_amdgcn_mfma_f32_16x16x32_bf16(al, bh, acc[c], 0, 0, 0);
                acc[c] = __builtin_amdgcn_mfma_f32_16x16x32_bf16(ah, bl, acc[c], 0, 0, 0); } }
    }
    __syncthreads();
#pragma unroll
    for (int c = 0; c < 3; ++c)
#pragma unroll
        for (int r = 0; r < 4; ++r) PL[(kh * 64 + 16 * rt + kg * 4 + r) * 48 + 16 * c + arow] = acc[c][r];
    LDS_WAIT(); __syncthreads();
    if (F.tid < 64 && rep == 0) {
        const int m = F.vcu * 64 + F.tid; const LAS float* q0 = PL + F.tid * 48; const LAS float* q1 = PL + (64 + F.tid) * 48;
        float gl[4]; int gi = 0; float gm;
#pragma unroll
        for (int g = 0; g < 4; ++g) gl[g] = (q0[g] + q1[g]) + inp<I_BG>()[l * 4 + g];
        gm = gl[0];
#pragma unroll
        for (int g = 1; g < 4; ++g) if (gl[g] > gm) { gm = gl[g]; gi = g; }
        float den = 0.f;
#pragma unroll
        for (int g = 0; g < 4; ++g) den += __expf(gl[g] - gm);
        const float gprob = 1.0f / den;
        float v1 = -INFINITY, v2 = -INFINITY; int i1 = 0, i2 = 0;
        for (int e = 0; e < 8; ++e) { const float v = (q0[4 + gi * 8 + e] + q1[4 + gi * 8 + e]) + inp<I_BE>()[l * 32 + gi * 8 + e];
            if (v > v1) { v2 = v1; i2 = i1; v1 = v; i1 = e; } else if (v > v2) { v2 = v; i2 = e; } }
        const float e2 = __expf(v2 - v1); const float w1 = gprob / (1.f + e2), w2 = gprob * e2 / (1.f + e2);
        const int ea = gi * 8 + i1, eb = gi * 8 + i2;
        tok_e[m] = ea; tok_e[M + m] = eb; tok_w[m] = w1; tok_w[M + m] = w2;
        LAS unsigned* lcnt = (LAS unsigned*)(F.lds + 32768); LAS unsigned* lbase = lcnt + 32;
        if (F.tid < 32) lcnt[F.tid] = 0u;
        asm volatile("s_waitcnt lgkmcnt(0)" ::: "memory");
        const unsigned ra = __hip_atomic_fetch_add(lcnt + ea, 1u, __ATOMIC_RELAXED, __HIP_MEMORY_SCOPE_WORKGROUP), rb = __hip_atomic_fetch_add(lcnt + eb, 1u, __ATOMIC_RELAXED, __HIP_MEMORY_SCOPE_WORKGROUP);
        asm volatile("s_waitcnt lgkmcnt(0)" ::: "memory");
        if (F.tid < 32) { const unsigned n = *(volatile LAS unsigned*)(lcnt + F.tid); unsigned bs = 0u; if (n) bs = __hip_atomic_fetch_add(F.ctl + CW_CNT + (l * 32 + F.tid) * 16, n, RLX_AGENT); *(volatile LAS unsigned*)(lbase + F.tid) = bs; }
        asm volatile("s_waitcnt vmcnt(0) lgkmcnt(0)" ::: "memory");
        const int pa = (int)(*(volatile LAS unsigned*)(lbase + ea) + ra), pb = (int)(*(volatile LAS unsigned*)(lbase + eb) + rb);
        tok_pos[m] = pa; tok_pos[M + m] = pb;
        int* elist = (int*)(F.ws + WS_ELIST); elist[ea * M + pa] = m; elist[eb * M + pb] = m;
    }
}

__device__ __forceinline__ void build_rowlists(Frame& F, int l) {
    volatile LAS int* base = (volatile LAS int*)(F.lds + BASE_OFF); volatile LAS int* cnts = (volatile LAS int*)(F.lds + CNTS_OFF); volatile LAS int* tab = (volatile LAS int*)(F.lds + TAB_OFF);
    LAS int* rowl = (LAS int*)(F.lds + ROWL_OFF); const int* elist = (const int*)(F.ws + WS_ELIST);
    const int ntile = (int)F.MISC[1];
    const int i = F.tid >> 8, r = F.tid & 255; const long L = (long)i * F.G + F.bx;
    int tok = 0;
    if (L < 2L * ntile) { const int tile = (int)(L >> 1), e = tab[tile], pos = 256 * (tile - base[e]) + r; if (pos < cnts[e]) tok = elist[e * M + pos]; }
    rowl[F.tid] = tok;
    __syncthreads();
}

constexpr int NPL = 7, NPH = 2 + 2 * NPL;
__global__ void __launch_bounds__(NWAVES * 64, 2) mk_fwd(Args args) {
    extern __shared__ __attribute__((aligned(16))) unsigned char lds[];
    Frame F;
    F.lds = (LAS unsigned char*)lds;
    F.MISC = (volatile LAS unsigned*)(F.lds + MISC_OFF);
    F.tid = threadIdx.x; F.lane = F.tid & 63; F.wave = __builtin_amdgcn_readfirstlane(F.tid >> 6);
    const int wave0 = F.wave;
    F.G = gridDim.x; F.bx = blockIdx.x; F.vcu = 0;
    F.ws = args.ws; F.out = args.out; F.ctl = (unsigned*)(args.ws + WS_CTL);
    for (int u = F.tid; u < (LDS_BYTES - LDSCTL_OFF) / 4; u += NWAVES * 64) ((LAS unsigned*)(F.lds + LDSCTL_OFF))[u] = 0u;
    __syncthreads();
    XcdBarrier bar; bar.bar = F.ctl + CW_BAR; bar.x = 0; bar.st = nullptr;
    if (!MK_PER_PHASE) bar = xcd_barrier_post(F.ctl + CW_BAR, F.MISC + 8);
    const int lo = args.ph_lo, hi = args.ph_hi;
#pragma unroll 1
    for (int ph = lo; ph < hi; ++ph) {
#if PROBE_REP_K >= 0
        const int ptype = ph == 0 ? 0 : (ph == NPH - 1 ? 10 : 1 + (ph - 1) % NPL);
        const int nrep = (ptype == PROBE_REP_K && (ph <= NPL || (PROBE_REP_K != 1 && PROBE_REP_K != 5))) ? 1 : 0;
#pragma unroll 1
        for (int rep = 0; rep <= nrep; ++rep) {
#else
        constexpr int rep = 0;
#endif
        { int w_ = wave0; asm volatile("" : "+s"(w_)); unsigned on_ = ~0u; asm volatile("" : "+s"(on_)); int ln_ = (int)__builtin_amdgcn_mbcnt_hi(on_, __builtin_amdgcn_mbcnt_lo(on_, 0u)); asm volatile("" : "+v"(ln_));
          F.wave = w_; F.lane = ln_; F.tid = w_ * 64 + ln_;
          unsigned long long ws_ = (unsigned long long)args.ws; asm volatile("" : "+s"(ws_)); F.ws = (unsigned char*)(GAS unsigned char*)ws_; F.ctl = (unsigned*)(F.ws + WS_CTL);
          int bx_ = blockIdx.x; asm volatile("" : "+s"(bx_)); F.bx = bx_; F.vcu = (F.G % 8 == 0) ? (bx_ % 8) * (F.G / 8) + bx_ / 8 : bx_; }
        if (ph == 0) {
#ifndef SKIP_P0
            p0_prologue(F, args);
#endif
        } else if (ph == NPH - 1) {
            row_pass(F, args, 2, 1);
        } else {
            const int l = (ph - 1) / NPL, k = (ph - 1) % NPL;
            if (k == 0) { row_pass(F, args, l == 0 ? 0 : 1, l); }
            else if (k == 1) {
                pg8::Gemm g{(const bf16*)(F.ws + WS_H), (const bf16*)(F.ws + WS_WIN) + (size_t)l * NP * DM, M, NP, DM}; pg8::StaticOrder S; S.init(M, NP, F.G, F.bx);
                pg8::EpiBf16 E{(bf16*)(F.ws + WS_PROJ), NP};
#ifndef SKIP_G1
                pg8::gemm_phase<pg8::EpiBf16, pg8::StaticOrder, true, true>(F.lds, g, S, E, F.tid);
#endif
            } else if (k == 2) {
#ifndef SKIP_P3
                p3_prep(F, args, l, rep);
#endif
            } else if (k == 3) {
#ifndef SKIP_P4
                p4_attention(F, args, l, l + 2 * rep);
#endif
            } else if (k == 4) {
                pg8::Gemm g{(const bf16*)(F.ws + WS_MIX), (const bf16*)(F.ws + WS_WOUT) + (size_t)l * DM * DM, M, DM, DM}; pg8::StaticOrder S; S.init(M, DM, F.G, F.bx);
                pg8::EpiResGate E{l == 0 ? inp<I_X>() : nullptr, (const bf16*)(F.ws + WS_X1), (bf16*)(F.ws + WS_X1), (const float*)(F.ws + WS_MOD) + (size_t)l * 8 * 6144 + 2 * DM};
#ifndef SKIP_G2
                pg8::gemm_phase<pg8::EpiResGate, pg8::StaticOrder, false, true>(F.lds, g, S, E, F.tid);
#endif
            } else if (k == 5) {
#ifndef SKIP_P6
                p6_router(F, args, l, rep);
#endif
            } else {
                build_tables(F, l); build_rowlists(F, l);
                unsigned* upf = F.ctl + CW_UPF + l * 8192; unsigned* dq = F.ctl + CW_DNQ + 16 * l;
                { pg8::Gemm g{(const bf16*)(F.ws + WS_H), (const bf16*)(F.ws + WS_WUP) + (size_t)l * NEXP * 512 * DM, MAXSLOT, 512, DM};
                  pg8::GroupOrder S{(const LAS int*)(F.lds + TAB_OFF), (int)F.MISC[1], 2, F.G, F.bx, (size_t)512 * DM * 2};
                  pg8::EpiSwiglu E{(bf16*)(F.ws + WS_HID), upf};
#ifndef SKIP_G3
                  pg8::gemm_phase<pg8::EpiSwiglu, pg8::GroupOrder, true, true, true>(F.lds, g, S, E, F.tid, (const LAS int*)(F.lds + ROWL_OFF));
#endif
                }
                if (GAP_CONVERT && !BG_CONVERT && l == 0 && rep == 0) convert_layer1_in_gap(F, args, 2 * (int)F.MISC[1] - F.G);
                { const pg8::Gemm g{(const bf16*)(F.ws + WS_HID), (const bf16*)(F.ws + WS_WDN) + (size_t)l * NEXP * DM * FF, MAXSLOT, DM, FF};
                  const pg8::EpiBf16 E{(bf16*)(F.ws + WS_Y), DM};
                  const LAS int* tab = (const LAS int*)(F.lds + TAB_OFF);
                  const int nd = 4 * __builtin_amdgcn_readfirstlane((int)F.MISC[1]);
                  pg8::DynOrder S{dq, upf, tab, F.MISC, nd, (size_t)DM * FF * 2, F.tid, (unsigned)F.G, 0u, 2u};
                  if (F.tid == 0) { const unsigned a = (unsigned)F.bx, b = (unsigned)F.G + __hip_atomic_fetch_add(dq, 1u, RLX_AGENT); F.MISC[4] = a; F.MISC[5] = b;
                      if ((int)a < nd) while (__hip_atomic_load(upf + (a >> 2) * 16, RLX_AGENT) < 2u) __builtin_amdgcn_s_sleep(8);
                      __builtin_amdgcn_fence(__ATOMIC_ACQUIRE, "agent"); asm volatile("s_waitcnt vmcnt(0)" ::: "memory"); S.issue(b); }
                  __syncthreads();
                  for (;;) {
                      if (__builtin_amdgcn_readfirstlane((int)F.MISC[4]) >= nd) break;
#ifndef SKIP_G4
                      pg8::gemm_phase<pg8::EpiBf16, pg8::DynOrder, true, true>(F.lds, g, S, E, F.tid);
#endif
                      if (F.tid == 0) {
                          const unsigned idn = F.MISC[5];
                          if ((int)idn < nd) { unsigned f = S.pflag; while (f < 2u) { __builtin_amdgcn_s_sleep(8); f = __hip_atomic_load(upf + (idn >> 2) * 16, RLX_AGENT); }
                              __builtin_amdgcn_fence(__ATOMIC_ACQUIRE, "agent"); asm volatile("s_waitcnt vmcnt(0)" ::: "memory"); }
                          const unsigned idn2 = S.ppop; F.MISC[4] = idn; F.MISC[5] = idn2; S.issue(idn2); }
                      __syncthreads();
                  }
                }
            }
        }
#if PROBE_REP_K >= 0
        if (rep < nrep) xcd_barrier(bar, F.tid);
        }
#endif
        if (ph + 1 < hi) xcd_barrier(bar, F.tid);
#ifdef PROBE_DOUBLE_BAR
        if (ph + 1 < hi) xcd_barrier(bar, F.tid);
#endif
    }
}

extern "C" void kernel_launch(void* const* d_in, const int* in_sizes, int n_in, void* d_out, int out_size, void* d_ws, size_t ws_size, hipStream_t stream) {
    static int grid = 0;
    if (grid == 0) {
        if (n_in != 28 || out_size != M * DM || ws_size < WS_END) { fprintf(stderr, "kernel_launch: unexpected shapes (n_in %d, out %d, ws %zu)\n", n_in, out_size, ws_size); grid = -1; return; }
        int dev = 0, cus = 0, per_cu = 0;
        if (hipGetDevice(&dev) != hipSuccess || hipDeviceGetAttribute(&cus, hipDeviceAttributeMultiprocessorCount, dev) != hipSuccess) { grid = -1; return; }
        if (hipFuncSetAttribute((const void*)mk_fwd, hipFuncAttributeMaxDynamicSharedMemorySize, LDS_BYTES) != hipSuccess) { fprintf(stderr, "kernel_launch: hipFuncSetAttribute failed\n"); grid = -1; return; }
        if (hipOccupancyMaxActiveBlocksPerMultiprocessor(&per_cu, (const void*)mk_fwd, NWAVES * 64, LDS_BYTES) != hipSuccess || per_cu < 1)
            fprintf(stderr, "kernel_launch: occupancy query reports %d workgroups per CU\n", per_cu);
        (void)hipGetLastError();
        grid = cus;
    }
    if (grid < 0) return;
    if (hipMemsetAsync((char*)d_ws + WS_CTL, 0, CTL_ZERO_BYTES, stream) != hipSuccess) return;
    Args a{};
    for (int i = 0; i < 28; ++i) a.in[i] = (const float*)d_in[i];
    a.out = (float*)d_out; a.ws = (unsigned char*)d_ws;
#if MK_PER_PHASE
    for (int p = 0; p < NPH; ++p) { a.ph_lo = p; a.ph_hi = p + 1; hipLaunchKernelGGL(mk_fwd, dim3(grid), dim3(NWAVES * 64), LDS_BYTES, stream, a); }
#else
    a.ph_lo = 0; a.ph_hi = NPH; hipLaunchKernelGGL(mk_fwd, dim3(grid), dim3(NWAVES * 64), LDS_BYTES, stream, a);
#endif
}
```

```cpp
#include <hip/hip_runtime.h>
#include <cstdio>
#include <cstdint>

#ifndef MK_PER_PHASE
#define MK_PER_PHASE 0
#endif

#ifndef PROBE_P3_PART
#define PROBE_P3_PART 0
#endif
#ifndef PROBE_ATT_VAR
#define PROBE_ATT_VAR -1
#endif
#ifndef BG_CONVERT
#define BG_CONVERT 1
#endif
#ifndef GAP_CONVERT
#define GAP_CONVERT 1
#endif
#ifndef PROBE_ATT_MODE
#define PROBE_ATT_MODE 0
#endif
#ifndef PROBE_REP_K
#define PROBE_REP_K -1
#endif
#define LAS __attribute__((address_space(3)))
#define GAS __attribute__((address_space(1)))
typedef unsigned short bf16;
typedef short bf16x8 __attribute__((ext_vector_type(8)));
typedef short s16x4 __attribute__((ext_vector_type(4)));
typedef float f32x4 __attribute__((ext_vector_type(4)));
typedef float f32x2 __attribute__((ext_vector_type(2)));
typedef float f32x16 __attribute__((ext_vector_type(16)));
typedef unsigned u32x4 __attribute__((ext_vector_type(4)));
typedef unsigned u32x2 __attribute__((ext_vector_type(2)));

constexpr int BATCH = 8, SEQ = 2048, DM = 1024, M = BATCH * SEQ, DEPTH = 2;
constexpr int NP = 3072;
constexpr int P_IN = 2988;
constexpr int C_AQ = 0, C_AK = 256, C_AV = 512, C_BQ = 768, C_BK = 1024, C_BV = 1280, C_CQ = 1536, C_CK = 1792, C_CV = 2048,
              C_DQ = 2304, C_DK = 2560, C_DV = 2624, C_IQ = 2688, C_IK = 2944, C_IW = 2976, C_AF = 2984;
constexpr int NEXP = 32, FF = 256, MAXSLOT = M * 2 + NEXP * 256, MAXTILE = MAXSLOT / 256;
constexpr float LOG2E = 1.4426950408889634f;
constexpr float RMS_EPS = 1e-6f;

constexpr size_t MiB = 1u << 20;
constexpr size_t WS_CTL = 0, CTL_ZERO_BYTES = 1 * MiB;
constexpr size_t WS_WR = 1 * MiB;
constexpr size_t WS_MOD = 2 * MiB;
constexpr size_t WS_CUM = 3 * MiB;
constexpr size_t WS_TOK = 4 * MiB;
constexpr size_t WS_MISC = 5 * MiB;
constexpr size_t WS_MASK = 6 * MiB;
constexpr size_t WS_WIN = 10 * MiB;
constexpr size_t WS_WOUT = 22 * MiB;
constexpr size_t WS_WUP = 26 * MiB;
constexpr size_t WS_WDN = 90 * MiB;
constexpr size_t WS_X1 = 122 * MiB;
constexpr size_t WS_H = 186 * MiB;
constexpr size_t WS_MIX = WS_H;

constexpr size_t WS_PROJ = 218 * MiB;
constexpr size_t WS_Y = WS_PROJ;
constexpr size_t WS_HID = WS_PROJ + 80 * MiB;
constexpr size_t WS_ELIST = 322 * MiB;
constexpr size_t WS_END = 324 * MiB;
constexpr int CW_AQ = 256;
constexpr int CW_CNT = 1024;
constexpr int CW_BAR = 8192;
constexpr int CW_DNQ = 208;
constexpr int CW_UPF = 65536;

constexpr int RING_BYTES = 143360;
constexpr int LDSCTL_OFF = RING_BYTES, MISC_OFF = LDSCTL_OFF + 320, CNTS_OFF = LDSCTL_OFF + 512, BASE_OFF = LDSCTL_OFF + 640, TAB_OFF = LDSCTL_OFF + 768;
constexpr int ROWL_OFF = 131072;
constexpr int LDS_BYTES = 147456;
constexpr int NWAVES = 8;

#define LDS_WAIT() asm volatile("s_waitcnt lgkmcnt(0)" ::: "memory")
#define VM_WAIT() asm volatile("s_waitcnt vmcnt(0)" ::: "memory")
#define RLX_AGENT __ATOMIC_RELAXED, __HIP_MEMORY_SCOPE_AGENT

__device__ __forceinline__ float bf2f(unsigned short u) { return __builtin_bit_cast(float, (unsigned)u << 16); }
__device__ __forceinline__ unsigned f2bf(float f) { unsigned u = __builtin_bit_cast(unsigned, f); return (u + 0x7fffu + ((u >> 16) & 1u)) >> 16; }
__device__ __forceinline__ unsigned pk2(float lo, float hi) { return f2bf(lo) | (f2bf(hi) << 16); }
template <int O> __device__ __forceinline__ float shx(float x) { static_assert(O >= 1 && O <= 16, "swizzle xor"); return __builtin_bit_cast(float, __builtin_amdgcn_ds_swizzle(__builtin_bit_cast(int, x), (O << 10) | 0x1f)); }
__device__ __forceinline__ float half_sum(float x) { return __builtin_bit_cast(float, __builtin_amdgcn_readlane(__builtin_bit_cast(int, x), 0)) + __builtin_bit_cast(float, __builtin_amdgcn_readlane(__builtin_bit_cast(int, x), 32)); }
__device__ __forceinline__ float half_max(float x) { return fmaxf(__builtin_bit_cast(float, __builtin_amdgcn_readlane(__builtin_bit_cast(int, x), 0)), __builtin_bit_cast(float, __builtin_amdgcn_readlane(__builtin_bit_cast(int, x), 32))); }
__device__ __forceinline__ float shup(float x, int o, int lane) { return __builtin_bit_cast(float, __builtin_amdgcn_ds_bpermute((lane - o) << 2, __builtin_bit_cast(int, x))); }
__device__ __forceinline__ int shup_i(int x, int o, int lane) { return __builtin_amdgcn_ds_bpermute((lane - o) << 2, x); }
__device__ __forceinline__ float wave_sum(float v) { v += shx<1>(v); v += shx<2>(v); v += shx<4>(v); v += shx<8>(v); v += shx<16>(v); return half_sum(v); }

namespace pg8 {
constexpr int BM = 256, BK = 64, HALF = 128, HTB = HALF * BK * 2, STAGE_BYTES = 8 * HTB, NXCD = 8, WGM = 8;
__host__ __device__ __forceinline__ int lds_byte(int r, int c) { const int st = (r >> 4) * 2 + (c >> 5), rr = r & 15, cc = c & 31, ob = rr * 64 + cc * 2; return st * 1024 + (ob ^ (((ob >> 9) & 1) << 5)); }
__host__ __device__ __forceinline__ void stage_rc(int b, int& R, int& C) { const int st = b / 1024, sb = b % 1024, swz = sb ^ (((sb >> 9) & 1) << 5); R = (st >> 1) * 16 + swz / 64; C = (st & 1) * 32 + (swz % 64) / 2; }
__host__ __device__ __forceinline__ int perm32(int rho) { const int n = rho >> 4, i = rho & 15; return 8 * (i >> 2) + 4 * n + (i & 3); }

struct Unit { int pm, pn; size_t bo; };
struct Gemm { const bf16* A; const bf16* Bt; int M, N, K; };

struct StaticOrder {
    int nM, nN, nwg, G, c;
    __host__ __device__ void init(int M_, int N_, int G_, int c_) { nM = M_ / BM; nN = N_ / BM; nwg = nM * nN; G = G_; c = c_; }
    __host__ __device__ bool next(int i, Unit& u) const {
        const long L = (long)i * G + c; if (L >= nwg) return false;
        int wgid = (int)L; { const int q = nwg / NXCD, r = nwg % NXCD, xcd = wgid % NXCD, off = wgid / NXCD; wgid = (xcd < r ? xcd * (q + 1) : r * (q + 1) + (xcd - r) * q) + off; }
        const int nig = WGM * nN, gid = wgid / nig, fm = gid * WGM, gsz = (nM - fm) < WGM ? (nM - fm) : WGM;
        u.pm = fm + ((wgid % nig) % gsz); u.pn = (wgid % nig) / gsz; u.bo = 0; return true;
    }
};
struct GroupOrder {
    const LAS int* tab; int ntile, ncol, G, c; size_t ebytes;
    __device__ __forceinline__ bool next(int i, Unit& u) const {
        const long L = (long)i * G + c; if (L >= (long)ntile * ncol) return false;
        u.pm = (int)(L / ncol); u.pn = (int)(L % ncol);
        const int e = __builtin_amdgcn_readfirstlane(tab[u.pm]); u.bo = (size_t)e * ebytes; return true;
    }
};

struct OneUnit { Unit u; __device__ __forceinline__ bool next(int i, Unit& o) const { if (i != 0) return false; o = u; return true; } };
struct DynOrder {
    unsigned* dq; unsigned* upf; const LAS int* tab; volatile LAS unsigned* M; int nd; size_t ebytes; int tid; unsigned G;
    mutable unsigned ppop, pflag;
    __device__ __forceinline__ void issue(unsigned idnext) const {
        ppop = G + __builtin_amdgcn_atomic_inc32(dq, 0xFFFFFFFFu, __ATOMIC_RELAXED, "agent");
        pflag = 2u; if ((int)idnext < nd) pflag = __hip_atomic_load(upf + (idnext >> 2) * 16, __ATOMIC_RELAXED, __HIP_MEMORY_SCOPE_AGENT);
    }
    __device__ __forceinline__ void unit(int id, Unit& u) const { u.pm = id >> 2; u.pn = id & 3; u.bo = (size_t)__builtin_amdgcn_readfirstlane(tab[id >> 2]) * ebytes; }
    __device__ __forceinline__ bool next(int i, Unit& u) const {
        if (i == 0) { const int id = __builtin_amdgcn_readfirstlane((int)M[4]); if (id >= nd) return false; unit(id, u); return true; }
        if (tid == 0) {
            const unsigned idn = M[5]; const bool ready = (int)idn < nd && pflag >= 2u;
            M[6] = ready ? 1u : 0u;
            if (ready) { asm volatile("buffer_inv sc1" ::: "memory"); M[4] = idn; const unsigned idn2 = ppop; M[5] = idn2; issue(idn2); }
        }
        asm volatile("s_waitcnt lgkmcnt(0)\n\ts_barrier" ::: "memory");
        if (__builtin_amdgcn_readfirstlane((int)M[6]) == 0) return false;
        unit(__builtin_amdgcn_readfirstlane((int)M[4]), u); return true;
    }
};

__device__ __forceinline__ unsigned cvt_pk_bf16(float lo, float hi) { unsigned r; asm volatile("v_cvt_pk_bf16_f32 %0, %1, %2" : "=v"(r) : "v"(lo), "v"(hi)); return r; }

struct EpiBf16 {
    static constexpr bool PERM = true, PUBLISH = false;
    bf16* O; int ldc;
    __device__ __forceinline__ void operator()(const f32x4 (&acc)[2][2][4][2], const Unit& u, int wr, int wc, int fr, int fq) const {
        const int row0 = u.pm * BM + wr * 64 + fr; const int col0 = u.pn * BM + wc * 32 + 8 * fq;
#pragma unroll
        for (int ai = 0; ai < 2; ++ai)
#pragma unroll
            for (int m = 0; m < 4; ++m) { bf16* rowp = O + (size_t)(row0 + ai * HALF + m * 16) * ldc + col0;
#pragma unroll
                for (int bj = 0; bj < 2; ++bj) { const f32x4 v0 = acc[ai][bj][m][0], v1 = acc[ai][bj][m][1];
                    u32x4 w; w.x = cvt_pk_bf16(v0[0], v0[1]); w.y = cvt_pk_bf16(v0[2], v0[3]); w.z = cvt_pk_bf16(v1[0], v1[1]); w.w = cvt_pk_bf16(v1[2], v1[3]);
                    *(u32x4*)(rowp + bj * HALF) = w; } }
    }
};
struct EpiResGate {
    static constexpr bool PERM = true, PUBLISH = false;
    const float* base32; const bf16* base16; bf16* out; const float* gate;
    __device__ __forceinline__ void operator()(const f32x4 (&acc)[2][2][4][2], const Unit& u, int wr, int wc, int fr, int fq) const {
        const int col0 = u.pn * BM + wc * 32 + 8 * fq; const float* g = gate + (size_t)(u.pm >> 3) * 6144 + col0;
        f32x4 gv[2][2];
#pragma unroll
        for (int bj = 0; bj < 2; ++bj)
#pragma unroll
            for (int n = 0; n < 2; ++n) gv[bj][n] = *(const f32x4*)(g + bj * HALF + n * 4);
#pragma unroll
        for (int ai = 0; ai < 2; ++ai)
#pragma unroll
            for (int m = 0; m < 4; ++m) { const size_t off = (size_t)(u.pm * BM + ai * HALF + wr * 64 + m * 16 + fr) * DM + col0;
#pragma unroll
                for (int bj = 0; bj < 2; ++bj) { f32x4 b0, b1;
                    if (base32) { b0 = *(const f32x4*)(base32 + off + bj * HALF); b1 = *(const f32x4*)(base32 + off + bj * HALF + 4); }
                    else { const u32x4 r = *(const u32x4*)(base16 + off + bj * HALF);
                        b0 = (f32x4){bf2f(r.x & 0xffff), bf2f(r.x >> 16), bf2f(r.y & 0xffff), bf2f(r.y >> 16)}; b1 = (f32x4){bf2f(r.z & 0xffff), bf2f(r.z >> 16), bf2f(r.w & 0xffff), bf2f(r.w >> 16)}; }
                    const f32x4 v0 = b0 + gv[bj][0] * acc[ai][bj][m][0], v1 = b1 + gv[bj][1] * acc[ai][bj][m][1];
                    u32x4 w; w.x = cvt_pk_bf16(v0[0], v0[1]); w.y = cvt_pk_bf16(v0[2], v0[3]); w.z = cvt_pk_bf16(v1[0], v1[1]); w.w = cvt_pk_bf16(v1[2], v1[3]);
                    *(u32x4*)(out + off + bj * HALF) = w; } }
    }
};
struct EpiSwiglu {
    static constexpr bool PERM = true, PUBLISH = true;
    bf16* O; unsigned* flag;
    __device__ __forceinline__ void operator()(const f32x4 (&acc)[2][2][4][2], const Unit& u, int wr, int wc, int fr, int fq) const {
        const int row0 = u.pm * BM + wr * 64 + fr; const int col0 = u.pn * HALF + wc * 32 + 8 * fq;
#pragma unroll
        for (int ai = 0; ai < 2; ++ai)
#pragma unroll
            for (int m = 0; m < 4; ++m) { bf16* rowp = O + (size_t)(row0 + ai * HALF + m * 16) * FF + col0;
                float hv[8];
#pragma unroll
                for (int n = 0; n < 2; ++n)
#pragma unroll
                    for (int i = 0; i < 4; ++i) { const float a = acc[ai][0][m][n][i], b = acc[ai][1][m][n][i];
                        const float sg = __builtin_amdgcn_rcpf(1.f + __builtin_amdgcn_exp2f(-a * LOG2E)); hv[n * 4 + i] = a * sg * b; }
                u32x4 w; w.x = cvt_pk_bf16(hv[0], hv[1]); w.y = cvt_pk_bf16(hv[2], hv[3]); w.z = cvt_pk_bf16(hv[4], hv[5]); w.w = cvt_pk_bf16(hv[6], hv[7]);
                asm volatile("global_store_dwordx4 %0, %1, off sc1\n\ts_nop 2" :: "v"((const GAS bf16*)rowp), "v"(w) : "memory"); }
    }
};

template <class Epi, class Sched, bool ALIGN_EPI = false, bool SP2 = false, bool GATHER = false>
__device__ __forceinline__ void gemm_phase(LAS unsigned char* lds, const Gemm g, const Sched& S, const Epi& E, const int tid, const LAS int* rowl = nullptr) {
    static_assert(!GATHER || SP2, "gather mode is written for the SP2 loop");
    const int wid = __builtin_amdgcn_readfirstlane(tid >> 6), lane = tid & 63, wr = wid >> 2, wc = wid & 3, fr = lane & 15, fq = lane >> 4;
    const int K = g.K, nt = K / BK;
    unsigned voffA[2], voffB[2];
#pragma unroll
    for (int i = 0; i < 2; ++i) { int R, C; stage_rc(tid * 16 + i * 8192, R, C); const int Rb = Epi::PERM ? ((R & ~31) + perm32(R & 31)) : R;
        voffA[i] = (unsigned)(R * K + C) * 2u; voffB[i] = (unsigned)(Rb * K + C) * 2u; }
    const size_t kstep = (size_t)(BK * 2);
    const size_t hstep = (size_t)HALF * K * 2;
    const size_t tstep = 2 * hstep;
    const size_t hstepA = GATHER ? 0 : hstep, tstepA = GATHER ? 0 : tstep;
    unsigned voffGc[2][2], voffGn[2][2];
    int gR[2], gC[2];
#pragma unroll
    for (int i = 0; i < 2; ++i) stage_rc(tid * 16 + i * 8192, gR[i], gC[i]);
#define PG8_GOFF(dst, ui_) do { _Pragma("unroll") for (int h_ = 0; h_ < 2; ++h_) _Pragma("unroll") for (int i_ = 0; i_ < 2; ++i_) \
        dst[h_][i_] = (unsigned)rowl[(ui_) * 256 + h_ * HALF + gR[i_]] * (unsigned)(K * 2) + (unsigned)gC[i_] * 2u; } while (0)
    const unsigned ldsw = (unsigned)wid * 1024u;
    const int aoff = lds_byte(wr * 64 + fr, fq * 8), boff = lds_byte(wc * 32 + fr, fq * 8);
#define PG8_SA(b, h) (((b) * 2 + (h)) * HTB)
#define PG8_SB(b, h) ((4 + (b) * 2 + (h)) * HTB)
#define PG8_STAGE(bufoff, gbase, voff) do { _Pragma("unroll") for (int _i = 0; _i < 2; ++_i) \
        __builtin_amdgcn_global_load_lds((const unsigned*)((const char*)(gbase) + (voff)[_i]), (LAS unsigned*)(lds + (bufoff) + ldsw + _i * 8192), 16, 0, 0); } while (0)
#define PG8_STAGE_A(bufoff, gbase, H, NXT) do { if constexpr (GATHER) { unsigned vo_[2]; vo_[0] = (NXT) ? voffGn[H][0] : voffGc[H][0]; vo_[1] = (NXT) ? voffGn[H][1] : voffGc[H][1]; PG8_STAGE(bufoff, gbase, vo_); } \
        else { PG8_STAGE(bufoff, (const char*)(gbase) + (H) * hstep, voffA); } } while (0)
#define PG8_LDA(dst, b, h) do { _Pragma("unroll") for (int m = 0; m < 4; ++m) _Pragma("unroll") for (int k = 0; k < 2; ++k) dst[m][k] = *(const LAS bf16x8*)(lds + PG8_SA(b, h) + aoff + m * 2048 + k * 1024); } while (0)
#define PG8_LDB(dst, b, h) do { _Pragma("unroll") for (int n = 0; n < 2; ++n) _Pragma("unroll") for (int k = 0; k < 2; ++k) dst[n][k] = *(const LAS bf16x8*)(lds + PG8_SB(b, h) + boff + n * 2048 + k * 1024); } while (0)
#define PG8_MMA(ai, bj, At, Bt) do { __builtin_amdgcn_s_setprio(1); _Pragma("unroll") for (int m = 0; m < 4; ++m) _Pragma("unroll") for (int n = 0; n < 2; ++n) _Pragma("unroll") for (int k = 0; k < 2; ++k) \
        acc[ai][bj][m][n] = __builtin_amdgcn_mfma_f32_16x16x32_bf16(Bt[n][k], At[m][k], acc[ai][bj][m][n], 0, 0, 0); __builtin_amdgcn_s_setprio(0); } while (0)
#define PG8_WAIT_V(n) asm volatile("s_waitcnt vmcnt(" #n ")" ::: "memory")
#define PG8_WAIT_L(n) asm volatile("s_waitcnt lgkmcnt(" #n ")" ::: "memory")
#define PG8_BAR __builtin_amdgcn_s_barrier()
#define PG8_SCHED __builtin_amdgcn_sched_barrier(0)
    Unit cur, nxt; int ui = 0;
    if (!S.next(0, cur)) return;
    f32x4 acc[2][2][4][2];
#pragma unroll
    for (int a = 0; a < 2; ++a)
#pragma unroll
        for (int b = 0; b < 2; ++b)
#pragma unroll
            for (int m = 0; m < 4; ++m)
#pragma unroll
                for (int n = 0; n < 2; ++n) acc[a][b][m][n] = (f32x4){0.f, 0.f, 0.f, 0.f};
    bf16x8 At[4][2], B0[2][2], B1[2][2];
    const char* cA = (const char*)g.A + (size_t)cur.pm * tstepA; const char* cB = (const char*)g.Bt + cur.bo + (size_t)cur.pn * tstep;
    if constexpr (GATHER) { PG8_GOFF(voffGc, 0); PG8_GOFF(voffGn, 0); }
    if constexpr (SP2) {
        PG8_STAGE(PG8_SB(0, 0), cB, voffB); PG8_STAGE(PG8_SB(0, 1), cB + hstep, voffB); PG8_STAGE_A(PG8_SA(0, 0), cA, 0, false); PG8_STAGE_A(PG8_SA(0, 1), cA, 1, false);
        if (wr == 1) PG8_BAR;
        PG8_WAIT_V(2); PG8_BAR;
        PG8_STAGE(PG8_SB(1, 0), cB + kstep, voffB); PG8_STAGE_A(PG8_SA(1, 0), cA + kstep, 0, false); PG8_STAGE(PG8_SB(1, 1), cB + hstep + kstep, voffB);
        PG8_WAIT_V(6); PG8_BAR;
    } else {
        PG8_STAGE(PG8_SB(0, 0), cB, voffB); PG8_STAGE(PG8_SA(0, 0), cA, voffA); PG8_STAGE(PG8_SB(0, 1), cB + hstep, voffB); PG8_STAGE(PG8_SA(0, 1), cA + hstep, voffA);
        if (wr == 1) PG8_BAR;
        PG8_WAIT_V(4); PG8_BAR;
        PG8_STAGE(PG8_SB(1, 0), cB + kstep, voffB); PG8_STAGE(PG8_SA(1, 0), cA + kstep, voffA); PG8_STAGE(PG8_SB(1, 1), cB + hstep + kstep, voffB);
        PG8_WAIT_V(6); PG8_BAR;
    }
    for (;;) {
        const bool has_next = S.next(ui + 1, nxt);
        if constexpr (GATHER) { if (has_next) PG8_GOFF(voffGn, ui + 1); }
        const char* nA = has_next ? (const char*)g.A + (size_t)nxt.pm * tstepA : cA; const char* nB = has_next ? (const char*)g.Bt + nxt.bo + (size_t)nxt.pn * tstep : cB;
#pragma unroll 1
        for (int t = 0; t < nt; t += 2) {
            const bool last = (t == nt - 2);
            const char* a1 = cA + (size_t)(t + 1) * kstep;
            const char* a2 = last ? nA : cA + (size_t)(t + 2) * kstep; const char* b2 = last ? nB : cB + (size_t)(t + 2) * kstep;
            const char* a3 = a2 + kstep; const char* b3 = b2 + kstep;
            if constexpr (SP2) {
            PG8_LDB(B0, 0, 0); PG8_LDB(B1, 0, 1); PG8_SCHED; PG8_LDA(At, 0, 0); PG8_STAGE_A(PG8_SA(1, 1), a1, 1, false);
            PG8_WAIT_V(8); PG8_WAIT_L(0); PG8_BAR; PG8_MMA(0, 0, At, B0); PG8_MMA(0, 1, At, B1); PG8_BAR; PG8_SCHED;
            PG8_LDA(At, 0, 1); PG8_STAGE(PG8_SB(0, 0), b2, voffB); PG8_STAGE(PG8_SB(0, 1), b2 + hstep, voffB); PG8_STAGE_A(PG8_SA(0, 0), a2, 0, last);
            PG8_WAIT_V(8); PG8_WAIT_L(0); PG8_BAR; PG8_MMA(1, 0, At, B0); PG8_MMA(1, 1, At, B1); PG8_BAR; PG8_SCHED;
            PG8_LDB(B0, 1, 0); PG8_LDB(B1, 1, 1); PG8_SCHED; PG8_LDA(At, 1, 0); PG8_STAGE_A(PG8_SA(0, 1), a2, 1, last);
            PG8_WAIT_V(8); PG8_WAIT_L(0); PG8_BAR; PG8_MMA(0, 0, At, B0); PG8_MMA(0, 1, At, B1); PG8_BAR; PG8_SCHED;
            PG8_LDA(At, 1, 1); PG8_STAGE(PG8_SB(1, 0), b3, voffB); PG8_STAGE(PG8_SB(1, 1), b3 + hstep, voffB); PG8_STAGE_A(PG8_SA(1, 0), a3, 0, last);
            PG8_WAIT_V(8); PG8_WAIT_L(0); PG8_BAR; PG8_MMA(1, 0, At, B0); PG8_MMA(1, 1, At, B1); PG8_BAR; PG8_SCHED;
            } else {
            PG8_LDB(B0, 0, 0); PG8_SCHED; PG8_LDA(At, 0, 0); PG8_STAGE(PG8_SA(1, 1), a1 + hstep, voffA);
            PG8_WAIT_L(8); PG8_BAR; PG8_WAIT_L(0); PG8_MMA(0, 0, At, B0); PG8_BAR; PG8_SCHED;
            PG8_LDB(B1, 0, 1); PG8_STAGE(PG8_SB(0, 0), b2, voffB);
            PG8_BAR; PG8_WAIT_L(0); PG8_MMA(0, 1, At, B1); PG8_BAR;
            PG8_LDA(At, 0, 1); PG8_STAGE(PG8_SA(0, 0), a2, voffA);
            PG8_BAR; PG8_WAIT_L(0); PG8_MMA(1, 0, At, B0); PG8_BAR; PG8_SCHED;
            PG8_STAGE(PG8_SB(0, 1), b2 + hstep, voffB);
            PG8_WAIT_V(6); PG8_BAR; PG8_MMA(1, 1, At, B1); PG8_BAR;
            PG8_LDB(B0, 1, 0); PG8_SCHED; PG8_LDA(At, 1, 0); PG8_STAGE(PG8_SA(0, 1), a2 + hstep, voffA);
            PG8_WAIT_L(8); PG8_BAR; PG8_WAIT_L(0); PG8_MMA(0, 0, At, B0); PG8_BAR; PG8_SCHED;
            PG8_LDB(B1, 1, 1); PG8_STAGE(PG8_SB(1, 0), b3, voffB);
            PG8_BAR; PG8_WAIT_L(0); PG8_MMA(0, 1, At, B1); PG8_BAR;
            PG8_LDA(At, 1, 1); PG8_STAGE(PG8_SA(1, 0), a3, voffA);
            PG8_BAR; PG8_WAIT_L(0); PG8_MMA(1, 0, At, B0); PG8_BAR; PG8_SCHED;
            PG8_STAGE(PG8_SB(1, 1), b3 + hstep, voffB);
            PG8_WAIT_V(6); PG8_BAR; PG8_MMA(1, 1, At, B1); PG8_BAR;
            }
        }
        if constexpr (ALIGN_EPI) { if (wr == 0) PG8_BAR; }
        E(acc, cur, wr, wc, fr, fq);
        if constexpr (Epi::PUBLISH) {
            asm volatile("s_waitcnt vmcnt(0)" ::: "memory"); PG8_BAR;
            if (tid == 0) __hip_atomic_fetch_add(E.flag + cur.pm * 16, 1u, __ATOMIC_RELAXED, __HIP_MEMORY_SCOPE_AGENT);
        }
        if (!has_next) break;
#pragma unroll
        for (int a = 0; a < 2; ++a)
#pragma unroll
            for (int b = 0; b < 2; ++b)
#pragma unroll
                for (int m = 0; m < 4; ++m)
#pragma unroll
                    for (int n = 0; n < 2; ++n) acc[a][b][m][n] = (f32x4){0.f, 0.f, 0.f, 0.f};
        cur = nxt; cA = nA; cB = nB; ++ui;
        if constexpr (GATHER) { _Pragma("unroll") for (int h_ = 0; h_ < 2; ++h_) _Pragma("unroll") for (int i_ = 0; i_ < 2; ++i_) voffGc[h_][i_] = voffGn[h_][i_]; }
        if constexpr (ALIGN_EPI) { if (wr == 1) PG8_BAR; }
    }
    PG8_WAIT_V(0);
    if constexpr (!ALIGN_EPI) { if (wr == 0) PG8_BAR; }
    PG8_BAR;
#undef PG8_SA
#undef PG8_STAGE_A
#undef PG8_GOFF
#undef PG8_SB
#undef PG8_STAGE
#undef PG8_LDA
#undef PG8_LDB
#undef PG8_MMA
#undef PG8_WAIT_V
#undef PG8_WAIT_L
#undef PG8_BAR
#undef PG8_SCHED
}
}

#define XB_TMO      128
#define XB_XCNT(j)  (256  + 64 * (j))
#define XB_XSUB(j)  (1280 + 64 * (j))
#define XB_XGEN(j)  (2304 + 64 * (j))
#define XB_TOP      3328
#define XB_TOPGEN   3392
#define XCD_BAR_WORDS 3456
#define XB_SPIN_CAP (1u << 18)
__device__ __forceinline__ unsigned xb_ld(unsigned* p)              { return __hip_atomic_load(p, __ATOMIC_RELAXED, __HIP_MEMORY_SCOPE_AGENT); }
__device__ __forceinline__ unsigned xb_add(unsigned* p, unsigned v) { return __hip_atomic_fetch_add(p, v, __ATOMIC_RELAXED, __HIP_MEMORY_SCOPE_AGENT); }
__device__ __forceinline__ unsigned xb_xcc_id() { return (unsigned)__builtin_amdgcn_s_getreg((3 << 11) | 20) & 0xFu; }
#define XB_SPIN(cond, bar) do { unsigned _sp = 0; while (cond) { __builtin_amdgcn_s_sleep(1); \
    if ((++_sp & 255u) == 0u) { if (xb_ld(&(bar)[XB_TMO])) break; if (_sp > XB_SPIN_CAP) { atomicAdd(&(bar)[XB_TMO], 1u); break; } } } } while (0)
struct XcdBarrier { unsigned* bar; unsigned x; volatile LAS unsigned* st; };
__device__ __forceinline__ XcdBarrier xcd_barrier_post(unsigned* bar, volatile LAS unsigned* st) {
    XcdBarrier b; b.bar = bar; b.x = xb_xcc_id(); b.st = st;
    if (threadIdx.x == 0) (void)xb_add(&bar[XB_XCNT(b.x)], 1u);
    return b;
}
__device__ __forceinline__ void xcd_barrier_complete(unsigned* bar, unsigned x, unsigned& nloc, unsigned& nx) {
    const unsigned G = gridDim.x * gridDim.y * gridDim.z;
    unsigned sum, cnt, mine, sp = 0u;
    for (;;) {
        sum = 0u; cnt = 0u; mine = 0u;
#pragma unroll 1
        for (unsigned j = 0; j < 16; ++j) { const unsigned c = xb_ld(&bar[XB_XCNT(j)]); sum += c; cnt += (c > 0u) ? 1u : 0u; mine = (j == x) ? c : mine; }
        if (sum == G) break;
        __builtin_amdgcn_s_sleep(1);
        if ((++sp & 255u) == 0u) { if (xb_ld(&bar[XB_TMO])) break; if (sp > XB_SPIN_CAP) { atomicAdd(&bar[XB_TMO], 1u); break; } }
    }
    nloc = mine > 0u ? mine : 1u; nx = cnt > 0u ? cnt : 1u;
}
__device__ __forceinline__ void xcd_barrier(const XcdBarrier& b, const int tid) {
    asm volatile("s_waitcnt vmcnt(0)" ::: "memory");
    __syncthreads();
    if (tid == 0) {
        unsigned* bar = b.bar;
        __builtin_amdgcn_s_waitcnt(0);
        unsigned nloc = b.st[0], nx = b.st[1];
        if (nloc == 0u) { xcd_barrier_complete(bar, b.x, nloc, nx); b.st[0] = nloc; b.st[1] = nx; }
        const unsigned old = xb_add(&bar[XB_XSUB(b.x)], 1u);
        const unsigned gen = old / nloc;
        if (old + 1u == (gen + 1u) * nloc) {
            __builtin_amdgcn_fence(__ATOMIC_RELEASE, "agent");
            asm volatile("s_waitcnt vmcnt(0)" ::: "memory");
            const unsigned og = xb_add(&bar[XB_TOP], 1u);
            const unsigned tg = og / nx;
            if (og + 1u == (tg + 1u) * nx) xb_add(&bar[XB_TOPGEN], 1u);
            else XB_SPIN(xb_ld(&bar[XB_TOPGEN]) == tg, bar);
            __builtin_amdgcn_fence(__ATOMIC_ACQUIRE, "agent");
            xb_add(&bar[XB_XGEN(b.x)], 1u);
            asm volatile("s_waitcnt vmcnt(0)" ::: "memory");
        } else {
            XB_SPIN(xb_ld(&bar[XB_XGEN(b.x)]) == gen, bar);
            __builtin_amdgcn_fence(__ATOMIC_ACQUIRE, "agent");
            asm volatile("s_waitcnt vmcnt(0)" ::: "memory");
        }
    }
    __syncthreads();
}

struct Frame {
    LAS unsigned char* lds;
    volatile LAS unsigned* MISC;
    unsigned* ctl;
    int tid, lane, wave, vcu, G, bx;
    float* out; unsigned char* ws;
};
struct Args { const float* in[28]; float* out; unsigned char* ws; int ph_lo, ph_hi; };
enum { I_X = 0, I_C, I_ADAW, I_ADAB, I_N1G, I_N2G, I_WIN, I_BF, I_QNA, I_KNA, I_QNC, I_KNC, I_LQ1, I_LK1, I_LQ2, I_LK2, I_SUBLN, I_QND, I_KND, I_MIXB, I_WOUT,
       I_WG, I_BG, I_WE, I_BE, I_W1, I_W3, I_W2 };
template <int I> __device__ __forceinline__ const float* inp() {
    auto ka = __builtin_amdgcn_kernarg_segment_ptr(); unsigned long long raw;
    asm volatile("s_load_dwordx2 %0, %1, %2\n\ts_waitcnt lgkmcnt(0)" : "=s"(raw) : "s"(ka), "i"(I * 8));
    return (const float*)(const GAS float*)raw;
}


struct TItem { const float* W; bf16* WT; const float* rs; int ldw, K, dst_row0, src_n0, kb, mapin; };
__device__ __forceinline__ int colmap_in(int n) { return n < 768 ? n : (n < 2984 ? n + 4 : (n < 2988 ? n - 2984 + 768 : -1)); }
__device__ __forceinline__ void t_load(const TItem& T, f32x4 (&v)[8], int lane) {
    const int k0 = 64 * T.kb, r8 = lane >> 3, c4 = (lane & 7) * 4; const int sc = T.mapin ? colmap_in(T.src_n0 + c4) : T.src_n0 + c4;
#pragma unroll
    for (int i = 0; i < 8; ++i) { v[i] = (f32x4){0.f, 0.f, 0.f, 0.f}; if (sc >= 0) v[i] = *(const f32x4*)(T.W + (size_t)(k0 + 8 * r8 + i) * T.ldw + sc); }
}
__device__ __forceinline__ void t_store(const TItem& T, f32x4 (&v)[8], LAS float* scr, int lane) {
    (void)scr;
    const int k0 = 64 * T.kb, r8 = lane >> 3, c4 = (lane & 7) * 4;
    if (T.rs) {
#pragma unroll
        for (int i = 0; i < 8; ++i) v[i] = v[i] * T.rs[k0 + 8 * r8 + i]; }
#pragma unroll
    for (int c = 0; c < 4; ++c) { u32x4 o; o.x = pg8::cvt_pk_bf16(v[0][c], v[1][c]); o.y = pg8::cvt_pk_bf16(v[2][c], v[3][c]); o.z = pg8::cvt_pk_bf16(v[4][c], v[5][c]); o.w = pg8::cvt_pk_bf16(v[6][c], v[7][c]);
        *(GAS u32x4*)(T.WT + (size_t)(T.dst_row0 + c4 + c) * T.K + k0 + 8 * r8) = o; }
}
__device__ __forceinline__ float lambda_init(int l) { return l == 0 ? 0.2f : (0.8f - 0.6f * 0.7408182206817179f); }

constexpr int CI_IN = 16 * 96, CI_OUT = 16 * 32, CI_UP1 = 16 * 8, CI_DN = 4 * 32, CN_UP = 32 * 2 * CI_UP1, CN_DN = 32 * CI_DN, NITEMS_L = CI_IN + CI_OUT + CN_UP + CN_DN;
__device__ __forceinline__ void fill_rowscale(Frame& F, const Args& A, int l, LAS float* rsl) {
    for (int k = F.tid; k < DM; k += 512) { float v = inp<I_MIXB>()[l * DM + k];
        if (k >= 512 && k < 768) v *= inp<I_SUBLN>()[l * 64 + ((k - 512) & 63)] * (1.f - lambda_init(l)); rsl[k] = v; }
}
__device__ __forceinline__ void convert_items(Frame& F, const Args& A, int l, int first, int stride, int limit, LAS float* rsl) {
    LAS float* scr = (LAS float*)(F.lds + F.wave * 8704);
    bf16* WIN = (bf16*)(F.ws + WS_WIN); bf16* WOUT = (bf16*)(F.ws + WS_WOUT); bf16* WUP = (bf16*)(F.ws + WS_WUP); bf16* WDN = (bf16*)(F.ws + WS_WDN);
    auto decode = [&](int it, TItem& T) {
        int r = it; T.rs = nullptr; T.mapin = 0;
        if (r < CI_IN) { T.kb = r / 96; const int nb = r % 96;
            T.W = inp<I_WIN>() + (size_t)l * DM * P_IN; T.ldw = P_IN; T.K = DM; T.WT = WIN + (size_t)l * NP * DM; T.dst_row0 = 32 * nb; T.src_n0 = 32 * nb; T.mapin = 1; return; }
        r -= CI_IN;
        if (r < CI_OUT) { T.kb = r / 32; const int nb = r % 32;
            T.W = inp<I_WOUT>() + (size_t)l * DM * DM; T.ldw = DM; T.K = DM; T.WT = WOUT + (size_t)l * DM * DM; T.dst_row0 = 32 * nb; T.src_n0 = 32 * nb; T.rs = (const float*)rsl; return; }
        r -= CI_OUT;
        if (r < CN_UP) { const int le = l * 32 + r / (2 * CI_UP1), q = r % (2 * CI_UP1), which = q / CI_UP1, q2 = q % CI_UP1; T.kb = q2 / 8; const int nb = q2 % 8;
            T.W = (which == 0 ? inp<I_W1>() : inp<I_W3>()) + (size_t)le * DM * FF; T.ldw = FF; T.K = DM; T.WT = WUP + (size_t)le * 512 * DM;
            const int n0 = 32 * nb, pn = n0 >> 7, j = n0 & 127; T.dst_row0 = 256 * pn + 128 * which + j; T.src_n0 = n0; return; }
        r -= CN_UP;
        { const int le = l * 32 + r / CI_DN, q = r % CI_DN; T.kb = q / 32; const int nb = q % 32;
          T.W = inp<I_W2>() + (size_t)le * FF * DM; T.ldw = DM; T.K = FF; T.WT = WDN + (size_t)le * DM * FF; T.dst_row0 = 32 * nb; T.src_n0 = 32 * nb; }
    };
    TItem T0, T1, T2; f32x4 v0[8], v1[8], v2[8]; int it = first;
    if (it < limit) { decode(it, T0); t_load(T0, v0, F.lane); }
    if (it + stride < limit) { decode(it + stride, T1); t_load(T1, v1, F.lane); }
    while (it < limit) {
        if (it + 2 * stride < limit) { decode(it + 2 * stride, T2); t_load(T2, v2, F.lane); }
        t_store(T0, v0, scr, F.lane); it += stride; if (it >= limit) break;
        if (it + 2 * stride < limit) { decode(it + 2 * stride, T0); t_load(T0, v0, F.lane); }
        t_store(T1, v1, scr, F.lane); it += stride; if (it >= limit) break;
        if (it + 2 * stride < limit) { decode(it + 2 * stride, T1); t_load(T1, v1, F.lane); }
        t_store(T2, v2, scr, F.lane); it += stride;
    }
}
constexpr int CV_L0 = NITEMS_L - CI_IN, CV_TOTAL = CV_L0 + NITEMS_L, CV_CHUNK = 64, CW_CVQ = 192;
__device__ __forceinline__ void convert_chunk(Frame& F, const Args& A, int gbase, LAS float* rsl2  ) {
    const int g0 = gbase + F.wave * (CV_CHUNK / NWAVES);
#pragma unroll 1
    for (int l = 0; l < 2; ++l) {
        const int lo = g0 > (l ? CV_L0 : 0) ? g0 : (l ? CV_L0 : 0), hi0 = g0 + CV_CHUNK / NWAVES, hi = hi0 < (l ? CV_TOTAL : CV_L0) ? hi0 : (l ? CV_TOTAL : CV_L0);
        if (lo < hi) { const int off = l ? -CV_L0 : CI_IN; convert_items(F, A, l, lo + off, 1, hi + off, rsl2 + l * DM); }
    }
}
__device__ __forceinline__ void convert_layer1_in_gap(Frame& F, const Args& A, int n2  ) {
    LAS float* rsl = (LAS float*)(F.lds + 8 * 8704);
    if (n2 < 0) n2 = 0; if (n2 > F.G - 32) n2 = F.G - 32;
    if (F.bx < n2) return;
    fill_rowscale(F, A, 1, rsl);
    __syncthreads();
    const int nw = (F.G - n2) * NWAVES;
    convert_items(F, A, 1, (F.bx - n2) * NWAVES + F.wave, nw, NITEMS_L, rsl);
    __syncthreads();
}

__device__ __forceinline__ void p0_prologue(Frame& F, const Args& A) {
    LAS float* rsl = (LAS float*)(F.lds + 8 * 8704);
    fill_rowscale(F, A, 0, rsl);
    __syncthreads();
    const int gw = F.vcu * NWAVES + F.wave, NGW = F.G * NWAVES;
    convert_items(F, A, 0, gw, NGW, BG_CONVERT ? CI_IN : NITEMS_L, rsl);
    if (!GAP_CONVERT && !BG_CONVERT) { __syncthreads(); fill_rowscale(F, A, 1, rsl); __syncthreads(); convert_items(F, A, 1, gw, NGW, NITEMS_L, rsl); }
    { bf16* WRH = (bf16*)(F.ws + WS_WR); bf16* WRL = WRH + 2 * 48 * DM;
      for (int i = gw * 64 + F.lane; i < 2 * 48 * DM; i += NGW * 64) { const int l = i / (48 * DM), r = i % (48 * DM), o = r >> 10, k = r & 1023;
          float w = 0.f; if (o < 4) w = inp<I_WG>()[((size_t)l * DM + k) * 4 + o]; else if (o < 36) w = inp<I_WE>()[((size_t)l * DM + k) * 32 + (o - 4)];
          const unsigned hi = f2bf(w); WRH[i] = (bf16)hi; WRL[i] = (bf16)f2bf(w - bf2f((unsigned short)hi)); } }
    if (F.bx == 0 && F.wave == 0) {
        for (int l = 0; l < 2; ++l) { float a = 0.f, b = 0.f; if (F.lane < 32) { a = inp<I_LQ1>()[l * 32 + F.lane] * inp<I_LK1>()[l * 32 + F.lane]; b = inp<I_LQ2>()[l * 32 + F.lane] * inp<I_LK2>()[l * 32 + F.lane]; }
            a = wave_sum(a); b = wave_sum(b); if (F.lane == 0) ((float*)(F.ws + WS_MISC))[l] = __expf(a) - __expf(b) + lambda_init(l); }
    }
    __syncthreads();
    LAS float* cact = (LAS float*)F.lds;
    LAS float* red = (LAS float*)(F.lds + 32768);
    { float cv_[16];
#pragma unroll
      for (int k = 0; k < 16; ++k) cv_[k] = inp<I_C>()[F.tid + 512 * k];
#pragma unroll
      for (int k = 0; k < 16; ++k) cact[F.tid + 512 * k] = cv_[k] / (1.f + __expf(-cv_[k])); }
    __syncthreads();
    for (int item = F.bx; item < 256; item += F.G) {
        const int l = item >> 7, ks = (item >> 3) & 15, nb = item & 7;
        const int half = F.lane / 24, cl = F.lane % 24; const bool act = F.lane < 48;
        const int c0 = nb * 768 + 96 * F.wave + 4 * cl;
        const float* aw = inp<I_ADAW>() + (size_t)l * DM * 6144 + (size_t)(ks * 64 + half) * 6144 + c0;
        f32x4 acc[8];
#pragma unroll
        for (int b = 0; b < 8; ++b) acc[b] = (f32x4){0.f, 0.f, 0.f, 0.f};
#pragma unroll 1
        for (int i0 = 0; i0 < 32; i0 += 16) {
            f32x4 wv[16];
#pragma unroll
            for (int i = 0; i < 16; ++i) { wv[i] = (f32x4){0.f, 0.f, 0.f, 0.f}; if (act) wv[i] = *(const f32x4*)(aw + (size_t)(2 * (i0 + i)) * 6144); }
#pragma unroll
            for (int i = 0; i < 16; ++i) { const int k = ks * 64 + 2 * (i0 + i) + (act ? half : 0);
#pragma unroll
                for (int b = 0; b < 8; ++b) acc[b] = acc[b] + cact[b * DM + k] * wv[i]; }
        }
        float* PART = (float*)(F.ws + WS_PROJ);
#pragma unroll
        for (int b = 0; b < 8; ++b) { f32x4 o;
#pragma unroll
            for (int c = 0; c < 4; ++c) { float x = acc[b][c]; asm volatile("" : "+v"(x));
                float y = __builtin_bit_cast(float, __builtin_amdgcn_ds_bpermute(((F.lane + 24) & 63) << 2, __builtin_bit_cast(int, x))); asm volatile("" : "+v"(y)); o[c] = x + y; }
            if (F.lane < 24) *(f32x4*)(PART + ((size_t)((l * 16 + ks) * 8 + b)) * 6144 + c0) = o; }
    }
}

__device__ __forceinline__ void build_tables(Frame& F, int l) {
    volatile LAS int* cnts = (volatile LAS int*)(F.lds + CNTS_OFF); volatile LAS int* base = (volatile LAS int*)(F.lds + BASE_OFF); volatile LAS int* tab = (volatile LAS int*)(F.lds + TAB_OFF);
    __syncthreads();
    if (F.tid < 64) {
        const int e = F.tid; int cnt = 0; if (e < 32) cnt = (int)__hip_atomic_load(F.ctl + CW_CNT + (l * 32 + e) * 16, RLX_AGENT);
        const int n = (cnt + 255) >> 8; int incl = n;
#pragma unroll
        for (int o = 1; o < 32; o <<= 1) { const int u = shup_i(incl, o, e); if (e >= o) incl += u; }
        const int t0 = incl - n;
        if (e < 32) { cnts[e] = cnt; base[e] = t0; for (int j = 0; j < n && t0 + j < MAXTILE; ++j) tab[t0 + j] = e; }
        if (e == 31) F.MISC[1] = (unsigned)(incl < MAXTILE ? incl : MAXTILE);
    }
    __syncthreads();
}
__device__ __forceinline__ void row_pass(Frame& F, const Args& A, int mode, int l) {
    const int gw = F.vcu * NWAVES + F.wave; const int lane = F.lane;
    const float* MOD = (const float*)(F.ws + WS_MOD);
    bf16* X1 = (bf16*)(F.ws + WS_X1); bf16* H = (bf16*)(F.ws + WS_H); const bf16* Y = (const bf16*)(F.ws + WS_Y);
    const int* tok_e = (const int*)(F.ws + WS_TOK); const int* tok_pos = (const int*)(F.ws + WS_TOK) + 4 * M; const float* tok_w = (const float*)(F.ws + WS_TOK) + 2 * M;
    volatile LAS int* basel = (volatile LAS int*)(F.lds + BASE_OFF);
    int pe_a[4], pe_b[4], pp_a[4], pp_b[4]; float pw_a[4], pw_b[4];
    const auto ldtok = [&](int m0) {
#pragma unroll
        for (int r = 0; r < 4; ++r) { const int m = m0 + r; pe_a[r] = tok_e[m]; pe_b[r] = tok_e[M + m]; pp_a[r] = tok_pos[m]; pp_b[r] = tok_pos[M + m]; pw_a[r] = tok_w[m]; pw_b[r] = tok_w[M + m]; } };
    if (mode != 0) { ldtok(gw * 8); build_tables(F, mode == 1 ? 0 : 1); }
    const int b = (gw * 8) >> 11; const int lp = (mode == 1) ? 0 : 1;
    LAS float* modL = (LAS float*)F.lds;
    if (mode == 0) {
        const float* PART = (const float*)(F.ws + WS_PROJ); float* MODW = (float*)(F.ws + WS_MOD);
        { const int n4 = 4 * F.tid; f32x4 sm = *(const f32x4*)(inp<I_ADAB>() + n4); f32x4 pv_[16];
#pragma unroll
          for (int ks = 0; ks < 16; ++ks) pv_[ks] = *(const f32x4*)(PART + ((size_t)(ks * 8 + b)) * 6144 + n4);
#pragma unroll
          for (int ks = 0; ks < 16; ++ks) sm = sm + pv_[ks];
          *(LAS f32x4*)(modL + n4) = sm; }
        if (F.tid < 96) { const int idx4 = 96 * F.bx + F.tid;
            const int l2 = idx4 / (8 * 1536), r2 = idx4 % (8 * 1536), b2 = r2 / 1536, n4 = 4 * (r2 % 1536);
            f32x4 sm = *(const f32x4*)(inp<I_ADAB>() + l2 * 6144 + n4); f32x4 pv_[16];
#pragma unroll
            for (int ks = 0; ks < 16; ++ks) pv_[ks] = *(const f32x4*)(PART + ((size_t)((l2 * 16 + ks) * 8 + b2)) * 6144 + n4);
#pragma unroll
            for (int ks = 0; ks < 16; ++ks) sm = sm + pv_[ks];
            *(f32x4*)(MODW + ((size_t)(l2 * 8 + b2)) * 6144 + n4) = sm; }
        LDS_WAIT(); __syncthreads();
    }
    f32x4 g2v[4], gm[4], shv[4];
#pragma unroll
    for (int j = 0; j < 4; ++j) { const int col = 256 * j + 4 * lane;
        g2v[j] = (f32x4){0.f, 0.f, 0.f, 0.f}; gm[j] = g2v[j]; shv[j] = g2v[j];
        if (mode != 0) g2v[j] = *(const f32x4*)(MOD + ((size_t)lp * 8 + b) * 6144 + 5 * DM + col);
        if (mode == 0) { gm[j] = *(const f32x4*)(inp<I_N1G>() + col) * (*(const LAS f32x4*)(modL + DM + col) + 1.0f); shv[j] = *(const LAS f32x4*)(modL + col); }
        else if (mode != 2) { const float* md = MOD + ((size_t)l * 8 + b) * 6144; gm[j] = *(const f32x4*)(inp<I_N1G>() + l * DM + col) * (*(const f32x4*)(md + DM + col) + 1.0f); shv[j] = *(const f32x4*)(md + col); } }
    for (int m0 = gw * 8; m0 < gw * 8 + 8; m0 += 4) {
        f32x4 v[4][4]; u32x2 ya[4][4], yb[4][4]; float wa[4], wb[4];
        if (mode != 0) {
            int sa[4], sb[4];
#pragma unroll
            for (int r = 0; r < 4; ++r) { sa[r] = 256 * basel[pe_a[r]] + pp_a[r]; sb[r] = 256 * basel[pe_b[r]] + pp_b[r]; wa[r] = pw_a[r]; wb[r] = pw_b[r]; }
#pragma unroll
            for (int r = 0; r < 4; ++r)
#pragma unroll
                for (int j = 0; j < 4; ++j) { const int col = 256 * j + 4 * lane; ya[r][j] = *(const u32x2*)(Y + (size_t)sa[r] * DM + col); yb[r][j] = *(const u32x2*)(Y + (size_t)sb[r] * DM + col); }
            if (m0 == gw * 8) ldtok(m0 + 4);
        }
#pragma unroll
        for (int r = 0; r < 4; ++r) { const int m = m0 + r;
            if (mode == 0) { const float* xr = inp<I_X>() + (size_t)m * DM;
#pragma unroll
                for (int j = 0; j < 4; ++j) v[r][j] = *(const f32x4*)(xr + 256 * j + 4 * lane); }
            else { const bf16* xr = X1 + (size_t)m * DM;
#pragma unroll
                for (int j = 0; j < 4; ++j) { const u32x2 q = *(const u32x2*)(xr + 256 * j + 4 * lane); v[r][j] = (f32x4){bf2f(q.x & 0xffff), bf2f(q.x >> 16), bf2f(q.y & 0xffff), bf2f(q.y >> 16)}; } } }
#pragma unroll
        for (int r = 0; r < 4; ++r) { const int m = m0 + r;
            if (mode != 0) {
#pragma unroll
                for (int j = 0; j < 4; ++j) { const u32x2 a = ya[r][j], c = yb[r][j];
                    f32x4 mo; mo[0] = wa[r] * bf2f(a.x & 0xffff) + wb[r] * bf2f(c.x & 0xffff); mo[1] = wa[r] * bf2f(a.x >> 16) + wb[r] * bf2f(c.x >> 16);
                    mo[2] = wa[r] * bf2f(a.y & 0xffff) + wb[r] * bf2f(c.y & 0xffff); mo[3] = wa[r] * bf2f(a.y >> 16) + wb[r] * bf2f(c.y >> 16);
                    v[r][j] = v[r][j] + g2v[j] * mo; }
                if (mode == 1) {
#pragma unroll
                    for (int j = 0; j < 4; ++j) { u32x2 q; q.x = pk2(v[r][j][0], v[r][j][1]); q.y = pk2(v[r][j][2], v[r][j][3]); *(u32x2*)(X1 + (size_t)m * DM + 256 * j + 4 * lane) = q; }
                } else { float* orow = F.out + (size_t)m * DM;
#pragma unroll
                    for (int j = 0; j < 4; ++j) *(f32x4*)(orow + 256 * j + 4 * lane) = v[r][j]; }
            }
            if (mode != 2) {
                float ss = 0.f;
#pragma unroll
                for (int j = 0; j < 4; ++j) ss += (v[r][j][0] * v[r][j][0] + v[r][j][1] * v[r][j][1]) + (v[r][j][2] * v[r][j][2] + v[r][j][3] * v[r][j][3]);
                const float rstd = 1.0f / sqrtf(wave_sum(ss) * (1.f / DM) + RMS_EPS);
#pragma unroll
                for (int j = 0; j < 4; ++j) { const f32x4 hv = v[r][j] * rstd * gm[j] + shv[j]; u32x2 w; w.x = pk2(hv[0], hv[1]); w.y = pk2(hv[2], hv[3]);
                    *(u32x2*)(H + (size_t)m * DM + 256 * j + 4 * lane) = w; }
            }
        }
    }
}

__device__ __forceinline__ void knorm_seg(bf16* p, int lane, int nlanes_active, int group_lanes, const float* gain, int gmask, float inv_n) {
    u32x2 raw = (u32x2){0u, 0u}; if (lane < nlanes_active) raw = *(const u32x2*)(p + 4 * lane);
    float x0 = bf2f(raw.x & 0xffff), x1 = bf2f(raw.x >> 16), x2 = bf2f(raw.y & 0xffff), x3 = bf2f(raw.y >> 16);
    float ss = (x0 * x0 + x1 * x1) + (x2 * x2 + x3 * x3);
    for (int o = 1; o < group_lanes; o <<= 1) ss += __shfl_xor(ss, o);
    const float rstd = 1.0f / sqrtf(ss * inv_n + RMS_EPS);
    const int c = (4 * lane) & gmask;
    x0 *= rstd * gain[c]; x1 *= rstd * gain[c + 1]; x2 *= rstd * gain[c + 2]; x3 *= rstd * gain[c + 3];
    if (lane < nlanes_active) { u32x2 w; w.x = pk2(x0, x1); w.y = pk2(x2, x3); *(u32x2*)(p + 4 * lane) = w; }
}
__device__ __forceinline__ unsigned sortable(float f) { const unsigned u = __builtin_bit_cast(unsigned, f); return (u & 0x80000000u) ? ~u : (u | 0x80000000u); }


__device__ __forceinline__ int wave_sum_i(int v) {
    v += __builtin_amdgcn_update_dpp(0, v, 0xB1, 0xF, 0xF, true);
    v += __builtin_amdgcn_update_dpp(0, v, 0x4E, 0xF, 0xF, true);
    v += __builtin_amdgcn_update_dpp(0, v, 0x141, 0xF, 0xF, true);
    v += __builtin_amdgcn_update_dpp(0, v, 0x140, 0xF, 0xF, true);
    return __builtin_amdgcn_readlane(v, 0) + __builtin_amdgcn_readlane(v, 16) + __builtin_amdgcn_readlane(v, 32) + __builtin_amdgcn_readlane(v, 48);
}
__device__ __forceinline__ void transpose32(unsigned (&a)[32]) {
#define TSTAGE(S, MSK) _Pragma("unroll") for (int i = 0; i < 32; ++i) if (!(i & S)) { const unsigned x = a[i], y = a[i + S]; a[i] = (x & MSK) | ((y << S) & ~MSK); a[i + S] = ((x >> S) & MSK) | (y & ~MSK); }
    TSTAGE(16, 0x0000FFFFu) TSTAGE(8, 0x00FF00FFu) TSTAGE(4, 0x0F0F0F0Fu) TSTAGE(2, 0x33333333u) TSTAGE(1, 0x55555555u)
#undef TSTAGE
}
__device__ __forceinline__ void sel_upd(unsigned T, unsigned ones, int s1, unsigned& cand, unsigned& above, int& na, int& nc, bool& done, bool& exact) {
    if (na + s1 >= 256) { cand = ones; nc = s1; }
    else { above |= ones; na += s1; cand &= ~T; nc -= s1; }
    if (na + nc == 256) { done = true; exact = true; }
}
__device__ __forceinline__ void sel_step2(unsigned TA, unsigned TB, unsigned& candA, unsigned& candB, unsigned& abA, unsigned& abB, int& naA, int& ncA, int& naB, int& ncB, bool& dA, bool& dB, bool& eA, bool& eB) {
    const unsigned onesA = candA & TA, onesB = candB & TB;
    const int s = wave_sum_i(__builtin_popcount(onesA) | (__builtin_popcount(onesB) << 16));
    if (!dA) sel_upd(TA, onesA, s & 0xffff, candA, abA, naA, ncA, dA, eA);
    if (!dB) sel_upd(TB, onesB, (int)((unsigned)s >> 16), candB, abB, naB, ncB, dB, eB);
}
__device__ __forceinline__ unsigned sel_finish(unsigned cand, unsigned above, int na, bool exact, int lane) {
    if (exact) return above | cand;
    const int need = 256 - na; const int pc = __builtin_popcount(cand); int incl = pc;
#pragma unroll
    for (int o = 1; o < 64; o <<= 1) { const int t = shup_i(incl, o, lane); if (lane >= o) incl += t; }
    int take = need - (incl - pc); take = take < 0 ? 0 : (take > pc ? pc : take);
    unsigned w = cand, res = above;
    for (int k = 0; k < take; ++k) { const unsigned low = w & (0u - w); res |= low; w ^= low; }
    return res;
}

__device__ __forceinline__ void p3_prep(Frame& F, const Args& A, int l, int rep) {
    const int gw = F.vcu * NWAVES + F.wave, NGW = F.G * NWAVES;
    bf16* PROJ = (bf16*)(F.ws + WS_PROJ);
    if (!(rep > 0 && PROBE_P3_PART == 2)) { const float* ga = inp<I_KNA>() + l * 64; const float* gc = inp<I_KNC>() + l * 32; const float* gd = inp<I_KND>() + l * 64;
      const int la = F.lane; const int ca = (4 * la) & 63, cc = (4 * la) & 31;
      const f32x4 gva = *(const f32x4*)(ga + ca), gvc = *(const f32x4*)(gc + cc), gvd = *(const f32x4*)(gd + ca);
      for (int mb = gw * 8; mb < gw * 8 + 8; mb += 8) {
        u32x2 ra[8], rc[8], rd[8];
#pragma unroll
        for (int i = 0; i < 8; ++i) { bf16* row = PROJ + (size_t)(mb + i) * NP; ra[i] = *(const u32x2*)(row + C_AK + 4 * la); rc[i] = *(const u32x2*)(row + C_CK + 4 * la);
            rd[i] = (u32x2){0u, 0u}; if (la < 16) rd[i] = *(const u32x2*)(row + C_DK + 4 * la); }
#pragma unroll
        for (int i = 0; i < 8; ++i) { bf16* row = PROJ + (size_t)(mb + i) * NP;
            { float x0 = bf2f(ra[i].x & 0xffff), x1 = bf2f(ra[i].x >> 16), x2 = bf2f(ra[i].y & 0xffff), x3 = bf2f(ra[i].y >> 16); float ss = (x0 * x0 + x1 * x1) + (x2 * x2 + x3 * x3);
              ss += shx<1>(ss); ss += shx<2>(ss); ss += shx<4>(ss); ss += shx<8>(ss); const float rs = 1.0f / sqrtf(ss * (1.f / 64.f) + RMS_EPS);
              u32x2 w; w.x = pk2(x0 * rs * gva[0], x1 * rs * gva[1]); w.y = pk2(x2 * rs * gva[2], x3 * rs * gva[3]); *(u32x2*)(row + C_AK + 4 * la) = w; }
            { float x0 = bf2f(rc[i].x & 0xffff), x1 = bf2f(rc[i].x >> 16), x2 = bf2f(rc[i].y & 0xffff), x3 = bf2f(rc[i].y >> 16); float ss = (x0 * x0 + x1 * x1) + (x2 * x2 + x3 * x3);
              ss += shx<1>(ss); ss += shx<2>(ss); ss += shx<4>(ss); const float rs = 1.0f / sqrtf(ss * (1.f / 32.f) + RMS_EPS);
              u32x2 w; w.x = pk2(x0 * rs * gvc[0], x1 * rs * gvc[1]); w.y = pk2(x2 * rs * gvc[2], x3 * rs * gvc[3]); *(u32x2*)(row + C_CK + 4 * la) = w; }
            { float x0 = bf2f(rd[i].x & 0xffff), x1 = bf2f(rd[i].x >> 16), x2 = bf2f(rd[i].y & 0xffff), x3 = bf2f(rd[i].y >> 16); float ss = (x0 * x0 + x1 * x1) + (x2 * x2 + x3 * x3);
              ss += shx<1>(ss); ss += shx<2>(ss); ss += shx<4>(ss); ss += shx<8>(ss); const float rs = 1.0f / sqrtf(ss * (1.f / 64.f) + RMS_EPS);
              u32x2 w; w.x = pk2(x0 * rs * gvd[0], x1 * rs * gvd[1]); w.y = pk2(x2 * rs * gvd[2], x3 * rs * gvd[3]); if (la < 16) *(u32x2*)(row + C_DK + 4 * la) = w; }
        }
      }
    }
    if (!(rep > 0 && PROBE_P3_PART == 2)) {
        const int bh = gw >> 6, ck = gw & 63, b = bh >> 2, h = bh & 3; const float bfv = inp<I_BF>()[l * 4 + h];
        const int t = 32 * ck + (F.lane & 31);
        const float x = bf2f(PROJ[((size_t)b * SEQ + t) * NP + C_AF + h]) + bfv;
        float incl = fminf(x, 0.f) - log1pf(__expf(-fabsf(x)));
#pragma unroll
        for (int o = 1; o < 32; o <<= 1) { const float u = shup(incl, o, F.lane); if ((F.lane & 31) >= o) incl += u; }
        float* cum = (float*)(F.ws + WS_CUM);
        if (F.lane < 32) cum[(size_t)bh * SEQ + t] = incl;
        if (F.lane == 31) cum[32 * SEQ + bh * 64 + ck] = incl;
    }
    LAS float* sc = (LAS float*)F.lds;
    unsigned* MASK = (unsigned*)(F.ws + WS_MASK);
    constexpr int SCP = 2052;
    const int lane = F.lane, kq = lane >> 4, qi = lane & 15;
    __syncthreads();
    bf16x8 bq[8], wvr, akv[16];
    const auto unit_geom = [&](int i, int& b, int& t0, int& nkt) { const int u = F.bx + 256 * i; b = u >> 7; const int tqr = u & 127, tq = (i & 1) ? 127 - tqr : tqr; t0 = tq * 16; nkt = tq + 1; };
    const auto unit_load_q = [&](int i) { int b, t0, nkt; unit_geom(i, b, t0, nkt); const bf16* qrow = PROJ + (size_t)b * SEQ * NP + (size_t)(t0 + qi) * NP;
#pragma unroll
        for (int h = 0; h < 8; ++h) bq[h] = *(const bf16x8*)(qrow + C_IQ + h * 32 + 8 * kq);
        wvr = *(const bf16x8*)(qrow + C_IW); };
    const auto unit_load_k = [&](int i) { int b, t0, nkt; unit_geom(i, b, t0, nkt); const bf16* pb = PROJ + (size_t)b * SEQ * NP;
#pragma unroll
        for (int j = 0; j < 16; ++j) { const int kt = F.wave + 8 * j; akv[j] = (bf16x8){0, 0, 0, 0, 0, 0, 0, 0}; if (kt < nkt) akv[j] = *(const bf16x8*)(pb + (size_t)(kt * 16 + qi) * NP + C_IK + 8 * kq); } };
    const bool do_c = !(rep > 0 && PROBE_P3_PART == 1);
    if (do_c) unit_load_q(0);
    for (int i = 0; i < 4; ++i) {
        if (!do_c) break;
        int b, t0, nkt; unit_geom(i, b, t0, nkt);
        unit_load_k(i);
        float wq[8];
#pragma unroll
        for (int h = 0; h < 8; ++h) wq[h] = bf2f((unsigned short)wvr[h]) * (0.35355339059327373f * 0.17677669529663687f);
#pragma unroll
        for (int j = 0; j < 16; ++j) { const int kt = F.wave + 8 * j;
            if (kt < nkt) {
            f32x4 a4 = (f32x4){0.f, 0.f, 0.f, 0.f};
#pragma unroll
            for (int h = 0; h < 8; ++h) { const f32x4 s = __builtin_amdgcn_mfma_f32_16x16x32_bf16(akv[j], bq[h], (f32x4){0.f, 0.f, 0.f, 0.f}, 0, 0, 0);
#pragma unroll
                for (int r = 0; r < 4; ++r) a4[r] += wq[h] * fmaxf(s[r], 0.f); }
#pragma unroll
            for (int r = 0; r < 4; ++r) a4[r] += 0.f;
            { const int ci = kt * 4 + kq, L = ci >> 3, c = ci & 7;
              *(LAS f32x4*)(sc + qi * SCP + 4 * (L * 8 + (c ^ (L & 7)))) = a4; }
            } }
        if (i + 1 < 4) unit_load_q(i + 1);
        LDS_WAIT(); __syncthreads();
        if (rep > 0 && PROBE_P3_PART == 2) { }
        else if (t0 < 256) {
            for (int rr = 0; rr < 2; ++rr) { const int t = t0 + 2 * F.wave + rr; const int nb = t - 32 * lane + 1;
                MASK[((size_t)b * SEQ + t) * 64 + lane] = nb >= 32 ? 0xffffffffu : (nb <= 0 ? 0u : ((1u << nb) - 1u)); }
        } else {
            const int rA = 2 * F.wave, tA = t0 + rA, tB = tA + 1;
            unsigned ua[32], ub[32];
#pragma unroll
            for (int c = 0; c < 8; ++c) { const int off = 4 * (lane * 8 + (c ^ (lane & 7)));
                const f32x4 fa = *(const LAS f32x4*)(sc + rA * SCP + off), fb = *(const LAS f32x4*)(sc + (rA + 1) * SCP + off);
#pragma unroll
                for (int i = 0; i < 4; ++i) { ua[c * 4 + i] = sortable(fa[i]); ub[c * 4 + i] = sortable(fb[i]); } }
            transpose32(ua); transpose32(ub);
            unsigned candA, candB, abA = 0u, abB = 0u; int naA = 0, naB = 0, ncA = tA + 1, ncB = tB + 1; bool dA = false, dB = false, eA = false, eB = false;
            { const int nbA = tA - 32 * lane + 1, nbB = tB - 32 * lane + 1;
              candA = nbA >= 32 ? 0xffffffffu : (nbA <= 0 ? 0u : ((1u << nbA) - 1u)); candB = nbB >= 32 ? 0xffffffffu : (nbB <= 0 ? 0u : ((1u << nbB) - 1u)); }
#pragma unroll
            for (int bit = 31; bit >= 0; --bit) {
                sel_step2(ua[bit], ub[bit], candA, candB, abA, abB, naA, ncA, naB, ncB, dA, dB, eA, eB);
                if (dA && dB) break;
            }
            MASK[((size_t)b * SEQ + tA) * 64 + lane] = sel_finish(candA, abA, naA, eA, lane);
            MASK[((size_t)b * SEQ + tB) * 64 + lane] = sel_finish(candB, abB, naB, eB, lane);
        }
        __syncthreads();
    }
}

namespace att {
template <bool B> struct BoolC { static constexpr bool value = B; };
constexpr int SLOTB = 8192, L_K = 0, L_V = 3 * SLOTB, L_WS = 6 * SLOTB, L_OST = L_WS + 2048, L_CUM = L_OST + 8 * 8192, L_END = L_CUM + 8192;
constexpr int MROW = 66;
static_assert(L_OST + 256 * MROW * 4 <= L_END && L_END <= RING_BYTES, "attention LDS map");
constexpr float THR = 8.0f;
__device__ __forceinline__ int crow(int r, int hi) { return (r & 3) + 8 * (r >> 2) + 4 * hi; }
__device__ __forceinline__ void glds16(const void* gsrc, unsigned lds_dst) { unsigned keep;
    asm volatile("s_mov_b32 %0, m0\n\ts_mov_b32 m0, %2\n\ts_nop 0\n\tglobal_load_lds_dwordx4 %1, off\n\ts_mov_b32 m0, %0" : "=&s"(keep) : "v"(gsrc), "s"(lds_dst) : "memory"); }
#define ATT_WAIT_BAR() asm volatile("s_waitcnt vmcnt(0) lgkmcnt(0)\n\ts_barrier" ::: "memory")
__device__ __forceinline__ unsigned cvtpk_s(float lo, float hi) { typedef __bf16 bf16x2_t __attribute__((ext_vector_type(2))); f32x2 v = {lo, hi}; bf16x2_t b = __builtin_convertvector(v, bf16x2_t); return __builtin_bit_cast(unsigned, b); }
__device__ __forceinline__ float xhalf(float x, int hi) { auto rr = __builtin_amdgcn_permlane32_swap(__builtin_bit_cast(unsigned, x), __builtin_bit_cast(unsigned, x), false, false);
    return __builtin_bit_cast(float, hi ? rr[0] : rr[1]); }
template <int DA, int DB>
__device__ __forceinline__ void qkt(f32x16& p0, f32x16& p1, const LAS char* Kslot, const bf16x8* qr, const f32x16& cin, int r32, int hi) {
    const LAS char* kb = Kslot + hi * 1024 + r32 * 16;
#pragma unroll
    for (int d0 = DA; d0 < DB; ++d0) {
        const bf16x8 b0 = *(const LAS bf16x8*)(kb + d0 * 2048), b1 = *(const LAS bf16x8*)(kb + d0 * 2048 + 512);
        if (d0 == DA) { p0 = __builtin_amdgcn_mfma_f32_32x32x16_bf16(b0, qr[d0], cin, 0, 0, 0); p1 = __builtin_amdgcn_mfma_f32_32x32x16_bf16(b1, qr[d0], cin, 0, 0, 0); }
        else { p0 = __builtin_amdgcn_mfma_f32_32x32x16_bf16(b0, qr[d0], p0, 0, 0, 0); p1 = __builtin_amdgcn_mfma_f32_32x32x16_bf16(b1, qr[d0], p1, 0, 0, 0); } }
}
__device__ __forceinline__ void pv(f32x16* o, int vb, bf16x8 pa0, bf16x8 pa1, bf16x8 pa2, bf16x8 pa3) {
    s16x4 lo[2][4], hi[2][4];
#pragma unroll
    for (int d0 = 0; d0 < 2; ++d0)
#pragma unroll
        for (int ks = 0; ks < 4; ++ks) {
            asm volatile("ds_read_b64_tr_b16 %0,%1 offset:%c2" : "=&v"(lo[d0][ks]) : "v"(vb), "i"(d0 * 4096 + ks * 1024) : "memory");
            asm volatile("ds_read_b64_tr_b16 %0,%1 offset:%c2" : "=&v"(hi[d0][ks]) : "v"(vb), "i"(d0 * 4096 + ks * 1024 + 512) : "memory"); }
    asm volatile("s_waitcnt lgkmcnt(0)" ::: "memory"); __builtin_amdgcn_sched_barrier(0);
#define PK(d, k) (bf16x8){lo[d][k][0], lo[d][k][1], lo[d][k][2], lo[d][k][3], hi[d][k][0], hi[d][k][1], hi[d][k][2], hi[d][k][3]}
    o[0] = __builtin_amdgcn_mfma_f32_32x32x16_bf16(pa0, PK(0, 0), o[0], 0, 0, 0); o[1] = __builtin_amdgcn_mfma_f32_32x32x16_bf16(pa0, PK(1, 0), o[1], 0, 0, 0);
    o[0] = __builtin_amdgcn_mfma_f32_32x32x16_bf16(pa1, PK(0, 1), o[0], 0, 0, 0); o[1] = __builtin_amdgcn_mfma_f32_32x32x16_bf16(pa1, PK(1, 1), o[1], 0, 0, 0);
    o[0] = __builtin_amdgcn_mfma_f32_32x32x16_bf16(pa2, PK(0, 2), o[0], 0, 0, 0); o[1] = __builtin_amdgcn_mfma_f32_32x32x16_bf16(pa2, PK(1, 2), o[1], 0, 0, 0);
    o[0] = __builtin_amdgcn_mfma_f32_32x32x16_bf16(pa3, PK(0, 3), o[0], 0, 0, 0); o[1] = __builtin_amdgcn_mfma_f32_32x32x16_bf16(pa3, PK(1, 3), o[1], 0, 0, 0);
#undef PK
}
__device__ __forceinline__ float rowmax(const f32x16& p0, const f32x16& p1, int hi) {
    float a = fmaxf(fmaxf(p0[0], p0[1]), p1[0]), b = fmaxf(fmaxf(p0[2], p0[3]), p1[1]); a = fmaxf(fmaxf(a, p1[2]), p1[3]);
#pragma unroll
    for (int r = 4; r < 16; r += 4) { a = fmaxf(fmaxf(a, p0[r]), p0[r + 1]); b = fmaxf(fmaxf(b, p0[r + 2]), p0[r + 3]); a = fmaxf(fmaxf(a, p1[r]), p1[r + 1]); b = fmaxf(fmaxf(b, p1[r + 2]), p1[r + 3]); }
    const float m = fmaxf(a, b); return fmaxf(m, xhalf(m, hi));
}
struct AttnP { const bf16* proj; bf16* mix; const float* cum; const unsigned* mask; const float* qgain[4]; const float* kgain[4]; float lam; unsigned* cvq; };

template <int VAR>
__device__ __forceinline__ void attn_unit(const AttnP& P, int b, int h, int qb, LAS char* sh, const int tid_in, const int pm, unsigned* qctr, volatile LAS unsigned* qslot) {
    int tid = tid_in; asm volatile("" : "+v"(tid));
    const int lane = tid & 63, r32 = lane & 31, hi = lane >> 5; const int wid = __builtin_amdgcn_readfirstlane(tid >> 6);
    const long rowbase = (long)b * SEQ; const int q0 = qb * 256, NT = 4 * (qb + 1);
    const int qrel = wid * 32 + r32, tq = q0 + qrel;
    constexpr bool REV = VAR != 0;
    constexpr int QCB = VAR == 0 ? C_AQ : VAR == 1 ? C_BQ : VAR == 2 ? C_CQ : C_DQ;
    constexpr int KCB = VAR == 0 ? C_AK : VAR == 1 ? C_BK : VAR == 2 ? C_CK : C_DK;
    constexpr int VCB = VAR == 0 ? C_AV : VAR == 1 ? C_BV : VAR == 2 ? C_CV : C_DV;
    const int Qc = QCB + 64 * h, Kc = VAR == 3 ? KCB : KCB + 64 * h, Vc = VAR == 3 ? VCB : VCB + 64 * h;
    const bf16* PR = P.proj;
    LAS float* wsf = (LAS float*)(sh + L_WS) + wid * 64;
    LAS float* stg = (LAS float*)(sh + L_OST) + wid * 2048;
    LAS float* cumL = (LAS float*)(sh + L_CUM);
    LAS unsigned* maskL = (LAS unsigned*)(sh + L_OST);
    const unsigned lds0 = (unsigned)(uintptr_t)sh;
    const bf16* ksrc = PR + (size_t)(rowbase + lane) * NP + Kc + wid * 8;
    const bf16* vsrc = PR + (size_t)(rowbase + 16 * (wid & 3) + (lane >> 2)) * NP + Vc + (wid >> 2) * 32 + (lane & 3) * 8;
    const unsigned kdst = lds0 + L_K + wid * 1024, vdst = lds0 + L_V + wid * 1024;
#define DMA_KV(t, slot) do { glds16(ksrc + (size_t)(t) * 64 * NP, (unsigned)__builtin_amdgcn_readfirstlane(kdst + (slot))); glds16(vsrc + (size_t)(t) * 64 * NP, (unsigned)__builtin_amdgcn_readfirstlane(vdst + (slot))); } while (0)
    DMA_KV(REV ? NT - 1 : 0, 0); DMA_KV(REV ? NT - 2 : 1, SLOTB);
    constexpr int NDQ = VAR == 2 ? 2 : 4; bf16x8 qpre[NDQ];
    { const bf16* Qw0 = PR + (size_t)(rowbase + tq) * NP + Qc;
#pragma unroll
      for (int d0 = 0; d0 < NDQ; ++d0) qpre[d0] = *(const bf16x8*)(Qw0 + d0 * 16 + hi * 8); }
    if (VAR == 0) {
        LAS float* pref = (LAS float*)(sh + L_WS);
        const float* cg = P.cum + (size_t)(b * 4 + h) * SEQ; float cgv[4];
#pragma unroll
        for (int k = 0; k < 4; ++k) { const int i = tid + 512 * k; cgv[k] = i < q0 + 256 ? cg[i] : 0.f; }
        if (tid < 64) { const float ct = P.cum[32 * SEQ + (b * 4 + h) * 64 + tid]; float incl = ct;
#pragma unroll
            for (int o = 1; o < 64; o <<= 1) { const float u = shup(incl, o, tid); if (tid >= o) incl += u; }
            pref[tid] = incl - ct; }
        asm volatile("s_waitcnt lgkmcnt(0)\n\ts_barrier" ::: "memory");
#pragma unroll
        for (int k = 0; k < 4; ++k) { const int i = tid + 512 * k; if (i < q0 + 256) cumL[i] = (cgv[k] + pref[i >> 5]) * LOG2E; }
        asm volatile("s_waitcnt lgkmcnt(0)\n\ts_barrier" ::: "memory");
    }
    if (VAR == 3) { const unsigned* mg = P.mask + (size_t)(rowbase + q0) * 64; const int nw = 2 * NT;
#pragma unroll 16
        for (int i = tid; i < 256 * 32; i += 512) { const int row = i >> 5, w = 2 * (i & 31); if (w < nw) *(LAS u32x2*)(maskL + row * MROW + w) = *(const u32x2*)(mg + row * 64 + w); } }
    asm volatile("s_waitcnt vmcnt(0) lgkmcnt(0)\n\ts_barrier" ::: "memory");
    const int vb0 = (int)(lds0 + L_V) + ((lane >> 4) & 1) * 32 + (lane & 3) * 8 + (4 * hi + ((lane & 15) >> 2)) * 64;
    float slope2 = 0.f;
    if (VAR == 2) slope2 = __builtin_amdgcn_exp2f(-(float)(2 * h + 1)) * LOG2E;
    if (VAR == 3) slope2 = __builtin_amdgcn_exp2f(-(float)(2 * h + 2)) * LOG2E;
    float cumt = 0.f; if (VAR == 0) cumt = cumL[tq];
    constexpr int NPASS = VAR == 2 ? 2 : 1;
    unsigned nxt_u = 0u, nxt_c = 0u;
    for (int pass = 0; pass < NPASS; ++pass) {
        bf16x8 qa[4]; float sb0 = 0.f;
        { const bf16* Qw = PR + (size_t)(rowbase + tq) * NP + Qc;
          constexpr int ND0 = VAR == 2 ? 2 : 4; const int dbase = VAR == 2 ? 2 * pass : 0;
          float qf[8 * ND0];
#pragma unroll
          for (int d0 = 0; d0 < ND0; ++d0) { bf16x8 raw = qpre[d0]; if (pass > 0) raw = *(const bf16x8*)(Qw + (dbase + d0) * 16 + hi * 8);
#pragma unroll
              for (int j = 0; j < 8; ++j) qf[d0 * 8 + j] = bf2f((unsigned short)raw[j]); }
          constexpr float SC = (VAR == 2 ? 0.17677669529663687f : 0.125f) * LOG2E;
          if (VAR != 1) {
              float ss = 0.f;
#pragma unroll
              for (int i = 0; i < 8 * ND0; ++i) ss += qf[i] * qf[i];
              ss += xhalf(ss, hi); const float rstd = 1.0f / sqrtf(ss * (VAR == 2 ? 1.f / 32.f : 1.f / 64.f) + RMS_EPS);
              const float* g = P.qgain[VAR];
#pragma unroll
              for (int d0 = 0; d0 < ND0; ++d0)
#pragma unroll
                  for (int j = 0; j < 8; ++j) qf[d0 * 8 + j] *= rstd * g[16 * d0 + 8 * hi + j] * SC;
          } else {
#pragma unroll
              for (int i = 0; i < 8 * ND0; ++i) qf[i] *= SC;
          }
          if (VAR == 2 || VAR == 3) {
              float n0 = 0.f;
#pragma unroll
              for (int i = 0; i < 8 * ND0; ++i) n0 += qf[i] * qf[i];
              n0 += xhalf(n0, hi);
              float gk = fabsf(P.kgain[VAR][lane & (VAR == 2 ? 31 : 63)]);
              gk = fmaxf(gk, shx<1>(gk)); gk = fmaxf(gk, shx<2>(gk)); gk = fmaxf(gk, shx<4>(gk)); gk = fmaxf(gk, shx<8>(gk)); gk = fmaxf(gk, shx<16>(gk)); gk = half_max(gk);
              sb0 = 1.02f * sqrtf(n0) * (VAR == 2 ? 5.656854249f : 8.0f) * gk;
          }
#pragma unroll
          for (int d0 = 0; d0 < ND0; ++d0) { u32x4 w; w.x = cvtpk_s(qf[d0 * 8 + 0], qf[d0 * 8 + 1]); w.y = cvtpk_s(qf[d0 * 8 + 2], qf[d0 * 8 + 3]); w.z = cvtpk_s(qf[d0 * 8 + 4], qf[d0 * 8 + 5]); w.w = cvtpk_s(qf[d0 * 8 + 6], qf[d0 * 8 + 7]);
              qa[d0] = __builtin_bit_cast(bf16x8, w); }
          if (VAR == 2) { qa[2] = qa[0]; qa[3] = qa[1]; }
        }
        float mhat = -1e30f, l_reg = 0.f, Rp = 1.f; f32x16 o[2]; const float sbound = sb0;
#pragma unroll
        for (int r = 0; r < 16; ++r) { o[0][r] = 0.f; o[1][r] = 0.f; }
        if (pass > 0) { DMA_KV(REV ? NT - 1 : 0, 0); DMA_KV(REV ? NT - 2 : 1, SLOTB); }
        int cur = 0, sl1 = SLOTB, sl2 = 2 * SLOTB;
        auto step = [&](auto band_c, const int it) -> bool {
            constexpr bool BAND = decltype(band_c)::value;
            const int t = REV ? NT - 1 - it : it;
            if (pm == 7) { }
            else if (it + 1 < NT) asm volatile("s_waitcnt vmcnt(2) lgkmcnt(0)\n\ts_barrier" ::: "memory");
            else ATT_WAIT_BAR();
            if (REV && it > 0) {
                const LAS unsigned* wz = (const LAS unsigned*)(sh + L_END) + ((it - 1) & 1) * 8;
                const u32x4 z0 = *(const LAS u32x4*)wz, z1 = *(const LAS u32x4*)(wz + 4);
                if (__builtin_amdgcn_readfirstlane((int)(z0.x & z0.y & z0.z & z0.w & z1.x & z1.y & z1.z & z1.w)) != 0) return true;
            }
            if (it + 2 < NT && pm != 7) DMA_KV(REV ? t - 2 : t + 2, sl2);
            const int jb = t - (NT - 4);
            float cinv = 0.f;
            if (VAR == 0) cinv = cumt;
            if (VAR == 2 || VAR == 3) cinv = slope2 * (float)(t * 64 + 4 * hi - tq);
            f32x16 cin;
#pragma unroll
            for (int r = 0; r < 16; ++r) cin[r] = cinv;
            f32x16 p0, p1;
            const LAS char* Ks = sh + L_K + cur;
            if (VAR == 2) { if (pass == 0) { const bf16x8 qq[4] = {qa[0], qa[1], qa[0], qa[1]}; qkt<0, 2>(p0, p1, Ks, qq, cin, r32, hi); }
                            else { const bf16x8 qq[4] = {qa[0], qa[1], qa[0], qa[1]}; qkt<2, 4>(p0, p1, Ks, qq, cin, r32, hi); } }
            else qkt<0, 4>(p0, p1, Ks, qa, cin, r32, hi);
            if (VAR != 1) {
                if (VAR == 0) { const LAS float* cp = cumL + t * 64 + 4 * hi;
#pragma unroll
                    for (int g = 0; g < 4; ++g) { const f32x4 c0 = *(const LAS f32x4*)(cp + 8 * g), c1 = *(const LAS f32x4*)(cp + 32 + 8 * g);
#pragma unroll
                        for (int i = 0; i < 4; ++i) { p0[4 * g + i] -= c0[i]; p1[4 * g + i] -= c1[i]; } } }
                if (VAR == 2 || VAR == 3) {
#pragma unroll
                    for (int r = 0; r < 16; ++r) { const float kc = (float)((r & 3) + 8 * (r >> 2)); p0[r] += slope2 * kc; p1[r] += slope2 * (kc + 32.f); } }
                if (VAR != 3) { if constexpr (BAND) { const int kb = 64 * jb + 4 * hi;
#pragma unroll
                    for (int r = 0; r < 16; ++r) { const int kv = kb + (r & 3) + 8 * (r >> 2); if (kv > qrel) p0[r] = -INFINITY; if (kv + 32 > qrel) p1[r] = -INFINITY; } } }
                else { const u32x2 mw = *(const LAS u32x2*)(maskL + qrel * MROW + 2 * t); const unsigned w0 = mw.x >> (4 * hi), w1 = mw.y >> (4 * hi);
#pragma unroll
                    for (int r = 0; r < 16; ++r) { const int c = (r & 3) + 8 * (r >> 2); if (!((w0 >> c) & 1u)) p0[r] = -INFINITY; if (!((w1 >> c) & 1u)) p1[r] = -INFINITY; } }
                const float rm = rowmax(p0, p1, hi);
                if (__any(rm - mhat > THR)) {
                    const float mn = fmaxf(mhat, rm); const float f = __builtin_amdgcn_exp2f(mhat - mn); mhat = mn; l_reg *= f;
                    if (hi == 0) wsf[r32] = f;
#pragma unroll
                    for (int r = 0; r < 16; ++r) { const float fr = wsf[crow(r, hi)]; o[0][r] *= fr; o[1][r] *= fr; }
                }
                float sa4[4] = {0.f, 0.f, 0.f, 0.f};
#pragma unroll
                for (int r = 0; r < 16; ++r) { p0[r] = __builtin_amdgcn_exp2f(p0[r] - mhat); p1[r] = __builtin_amdgcn_exp2f(p1[r] - mhat); sa4[r & 3] += p0[r] + p1[r]; }
                l_reg += (sa4[0] + sa4[1]) + (sa4[2] + sa4[3]);
                if (VAR == 2 || VAR == 3) {
                    const float ub = sbound - slope2 * (float)(tq - 64 * t + 1) - mhat;
                    const bool dead = __all(ub < -150.f); if (lane == 0) ((LAS unsigned*)(sh + L_END))[(it & 1) * 8 + wid] = dead ? 1u : 0u;
                }
            } else {
                f32x16 m0, m1;
#pragma unroll
                for (int r = 0; r < 16; ++r) {
                    { const float s = __builtin_amdgcn_fmed3f(p0[r], -64.f, 64.f); const float e = __builtin_amdgcn_exp2f(-s); const float bt = __builtin_amdgcn_rcpf(1.f + e); p0[r] = bt; m0[r] = e * bt; }
                    { const float s = __builtin_amdgcn_fmed3f(p1[r], -64.f, 64.f); const float e = __builtin_amdgcn_exp2f(-s); const float bt = __builtin_amdgcn_rcpf(1.f + e); p1[r] = bt; m1[r] = e * bt; } }
                if constexpr (BAND) { const int kb = 64 * jb + 4 * hi;
#pragma unroll
                    for (int r = 0; r < 16; ++r) { const int kv = kb + (r & 3) + 8 * (r >> 2);
                        if (kv >= qrel) { p0[r] = 0.f; m0[r] = 1.f; } if (kv + 32 >= qrel) { p1[r] = 0.f; m1[r] = 1.f; } } }
                float gp[8], gq[8], ex[8];
#pragma unroll
                for (int g = 0; g < 4; ++g) { gp[g] = (m0[4 * g] * m0[4 * g + 1]) * (m0[4 * g + 2] * m0[4 * g + 3]); gp[4 + g] = (m1[4 * g] * m1[4 * g + 1]) * (m1[4 * g + 2] * m1[4 * g + 3]); }
#pragma unroll
                for (int g = 0; g < 8; ++g) gq[g] = xhalf(gp[g], hi);
                float sp = Rp;
#pragma unroll
                for (int g = 7; g >= 0; --g) { ex[g] = hi ? sp : sp * gq[g]; sp *= gp[g] * gq[g]; }
                Rp = sp;
                { const bool allz = !__any(Rp != 0.f); if (lane == 0) ((LAS unsigned*)(sh + L_END))[(it & 1) * 8 + wid] = allz ? 1u : 0u; }
#pragma unroll
                for (int g = 0; g < 4; ++g) {
                    { float c = ex[g]; const float w3 = p0[4 * g + 3] * c; c *= m0[4 * g + 3]; const float w2 = p0[4 * g + 2] * c; c *= m0[4 * g + 2]; const float w1 = p0[4 * g + 1] * c; c *= m0[4 * g + 1]; const float w0 = p0[4 * g] * c;
                      p0[4 * g] = w0; p0[4 * g + 1] = w1; p0[4 * g + 2] = w2; p0[4 * g + 3] = w3; }
                    { float c = ex[4 + g]; const float w3 = p1[4 * g + 3] * c; c *= m1[4 * g + 3]; const float w2 = p1[4 * g + 2] * c; c *= m1[4 * g + 2]; const float w1 = p1[4 * g + 1] * c; c *= m1[4 * g + 1]; const float w0 = p1[4 * g] * c;
                      p1[4 * g] = w0; p1[4 * g + 1] = w1; p1[4 * g + 2] = w2; p1[4 * g + 3] = w3; } }
            }
            u32x4 pw0, pw1, pw2, pw3;
            pw0 = (u32x4){cvtpk_s(p0[0], p0[1]), cvtpk_s(p0[2], p0[3]), cvtpk_s(p0[4], p0[5]), cvtpk_s(p0[6], p0[7])};
            pw1 = (u32x4){cvtpk_s(p0[8], p0[9]), cvtpk_s(p0[10], p0[11]), cvtpk_s(p0[12], p0[13]), cvtpk_s(p0[14], p0[15])};
            pw2 = (u32x4){cvtpk_s(p1[0], p1[1]), cvtpk_s(p1[2], p1[3]), cvtpk_s(p1[4], p1[5]), cvtpk_s(p1[6], p1[7])};
            pw3 = (u32x4){cvtpk_s(p1[8], p1[9]), cvtpk_s(p1[10], p1[11]), cvtpk_s(p1[12], p1[13]), cvtpk_s(p1[14], p1[15])};
            pv(o, vb0 + cur, __builtin_bit_cast(bf16x8, pw0), __builtin_bit_cast(bf16x8, pw1), __builtin_bit_cast(bf16x8, pw2), __builtin_bit_cast(bf16x8, pw3));
            { const int tmp = cur; cur = sl1; sl1 = sl2; sl2 = tmp; }
            return false;
        };
        if (REV) { bool ex = false; int it = 0;
            for (; it < 4 && !ex; ++it) ex = step(BoolC<true>{}, it);
            for (; it < NT && !ex; ++it) ex = step(BoolC<false>{}, it); }
        else { int it = 0;
            for (; it < NT - 4; ++it) (void)step(BoolC<false>{}, it);
            for (; it < NT; ++it) (void)step(BoolC<true>{}, it); }
        ATT_WAIT_BAR();
        if (pass == NPASS - 1 && tid == 0) { nxt_u = __builtin_amdgcn_atomic_inc32(qctr, 0xFFFFFFFFu, __ATOMIC_RELAXED, "agent"); if (P.cvq) nxt_c = __builtin_amdgcn_atomic_inc32(P.cvq, 0xFFFFFFFFu, __ATOMIC_RELAXED, "agent"); }
        float rli[16];
        if (VAR != 1) {
            l_reg += xhalf(l_reg, hi);
            if (hi == 0) wsf[32 + r32] = l_reg;
#pragma unroll
            for (int r = 0; r < 16; ++r) rli[r] = __builtin_amdgcn_rcpf(wsf[32 + crow(r, hi)]);
        } else {
#pragma unroll
            for (int r = 0; r < 16; ++r) rli[r] = 1.f;
        }
#pragma unroll
        for (int r = 0; r < 16; ++r) { const int orow = crow(r, hi);
#pragma unroll
            for (int d0 = 0; d0 < 2; ++d0) { const float val = o[d0][r] * rli[r]; LAS float* sp = stg + orow * 64 + d0 * 32 + r32;
                if (VAR == 2 && pass == 1) *sp = *sp - P.lam * val; else *sp = val; } }
    }
    LDS_WAIT();
    bf16* Ow = P.mix + (size_t)(rowbase + q0 + wid * 32) * DM + VAR * 256 + h * 64;
#pragma unroll
    for (int i = 0; i < 4; ++i) { const int row = i * 8 + (lane >> 3), ch = lane & 7;
        const f32x4 a = *(const LAS f32x4*)(stg + row * 64 + ch * 8), c = *(const LAS f32x4*)(stg + row * 64 + ch * 8 + 4);
        float sc = 1.f;
        if (VAR == 2) { float ss = (a[0] * a[0] + a[1] * a[1]) + (a[2] * a[2] + a[3] * a[3]) + (c[0] * c[0] + c[1] * c[1]) + (c[2] * c[2] + c[3] * c[3]);
            ss += shx<1>(ss); ss += shx<2>(ss); ss += shx<4>(ss); sc = 1.0f / sqrtf(ss * (1.f / 64.f) + RMS_EPS); }
        u32x4 w; w.x = cvtpk_s(a[0] * sc, a[1] * sc); w.y = cvtpk_s(a[2] * sc, a[3] * sc); w.z = cvtpk_s(c[0] * sc, c[1] * sc); w.w = cvtpk_s(c[2] * sc, c[3] * sc);
        if (pm == 0 || (w.x == 0x12345678u && w.y == 0x9abcdef0u)) *(u32x4*)(Ow + (size_t)row * DM + ch * 8) = w; }
    if (tid == 0) { *qslot = nxt_u; if (P.cvq) qslot[3] = nxt_c; }
    asm volatile("s_waitcnt lgkmcnt(0)\n\ts_barrier" ::: "memory");
#undef DMA_KV
}
typedef __attribute__((address_space(3))) const char* lds_cptr;
typedef short v4i16_t __attribute__((ext_vector_type(4)));
__device__ __forceinline__ s16x4 vtr(lds_cptr p) { return __builtin_bit_cast(s16x4, __builtin_amdgcn_ds_read_tr16_b64_v4i16((__attribute__((address_space(3))) v4i16_t*)p)); }
template <int VAR>
__device__ __forceinline__ void attn_unit2(const AttnP& P, int b, int h, int qb, LAS char* sh, const int tid_in, unsigned* qctr, volatile LAS unsigned* qslot) {
    static_assert(VAR == 0 || VAR == 2 || VAR == 3, "softmax mixers only");
    int tid = tid_in; asm volatile("" : "+v"(tid));
    const int lane = tid & 63, r32 = lane & 31, hi = lane >> 5; const int wid = __builtin_amdgcn_readfirstlane(tid >> 6);
    const long rowbase = (long)b * SEQ; const int q0 = qb * 256, NT = 4 * (qb + 1);
    const int qrel = wid * 32 + r32, tq = q0 + qrel;
    constexpr int QCB = VAR == 0 ? C_AQ : VAR == 1 ? C_BQ : VAR == 2 ? C_CQ : C_DQ;
    constexpr int KCB = VAR == 0 ? C_AK : VAR == 1 ? C_BK : VAR == 2 ? C_CK : C_DK;
    constexpr int VCB = VAR == 0 ? C_AV : VAR == 1 ? C_BV : VAR == 2 ? C_CV : C_DV;
    const int Qc = QCB + 64 * h, Kc = VAR == 3 ? KCB : KCB + 64 * h, Vc = VAR == 3 ? VCB : VCB + 64 * h;
    const bf16* PR = P.proj;
    LAS float* wsf = (LAS float*)(sh + L_WS) + wid * 64;
    LAS float* stg = (LAS float*)(sh + L_OST) + wid * 2048;
    LAS float* cumL = (LAS float*)(sh + L_CUM);
    LAS unsigned* maskL = (LAS unsigned*)(sh + L_OST);
    const unsigned lds0 = (unsigned)(uintptr_t)sh;
    const bf16* ksrc = PR + (size_t)(rowbase + lane) * NP + Kc + wid * 8;
    const bf16* vsrc = PR + (size_t)(rowbase + 16 * (wid & 3) + (lane >> 2)) * NP + Vc + (wid >> 2) * 32 + (lane & 3) * 8;
    const unsigned kdst = lds0 + L_K + wid * 1024, vdst = lds0 + L_V + wid * 1024;
#define TILE2(j) (NT - 1 - (j))
#define DMA_K2(j, slot) glds16(ksrc + (size_t)TILE2(j) * 64 * NP, (unsigned)__builtin_amdgcn_readfirstlane(kdst + (slot)))
#define DMA_V2(j, slot) glds16(vsrc + (size_t)TILE2(j) * 64 * NP, (unsigned)__builtin_amdgcn_readfirstlane(vdst + (slot)))
    DMA_K2(0, 0); DMA_K2(1, SLOTB); DMA_V2(0, 0);
    constexpr int NDQ = VAR == 2 ? 2 : 4; bf16x8 qpre[NDQ];
    { const bf16* Qw0 = PR + (size_t)(rowbase + tq) * NP + Qc;
#pragma unroll
      for (int d0 = 0; d0 < NDQ; ++d0) qpre[d0] = *(const bf16x8*)(Qw0 + d0 * 16 + hi * 8); }
    if (VAR == 0) {
        LAS float* pref = (LAS float*)(sh + L_WS);
        const float* cg = P.cum + (size_t)(b * 4 + h) * SEQ; float cgv[4];
#pragma unroll
        for (int k = 0; k < 4; ++k) { const int i = tid + 512 * k; cgv[k] = i < q0 + 256 ? cg[i] : 0.f; }
        if (tid < 64) { const float ct = P.cum[32 * SEQ + (b * 4 + h) * 64 + tid]; float incl = ct;
#pragma unroll
            for (int o = 1; o < 64; o <<= 1) { const float u = shup(incl, o, tid); if (tid >= o) incl += u; }
            pref[tid] = incl - ct; }
        asm volatile("s_waitcnt lgkmcnt(0)\n\ts_barrier" ::: "memory");
#pragma unroll
        for (int k = 0; k < 4; ++k) { const int i = tid + 512 * k; if (i < q0 + 256) cumL[i] = (cgv[k] + pref[i >> 5]) * LOG2E; }
        asm volatile("s_waitcnt lgkmcnt(0)\n\ts_barrier" ::: "memory");
    }
    if (VAR == 3) { const unsigned* mg = P.mask + (size_t)(rowbase + q0) * 64; const int nw = 2 * NT;
#pragma unroll 16
        for (int i = tid; i < 256 * 32; i += 512) { const int row = i >> 5, w = 2 * (i & 31); if (w < nw) *(LAS u32x2*)(maskL + row * MROW + w) = *(const u32x2*)(mg + row * 64 + w); } }
    asm volatile("s_waitcnt vmcnt(0) lgkmcnt(0)\n\ts_barrier" ::: "memory");
    const lds_cptr shc = (lds_cptr)sh;
    const lds_cptr kp0 = shc + L_K + hi * 1024 + r32 * 16;
    const lds_cptr vp0 = shc + L_V + ((lane >> 4) & 1) * 32 + (lane & 3) * 8 + (4 * hi + ((lane & 15) >> 2)) * 64;
    float slope2 = 0.f;
    if (VAR == 2) slope2 = __builtin_amdgcn_exp2f(-(float)(2 * h + 1)) * LOG2E;
    if (VAR == 3) slope2 = __builtin_amdgcn_exp2f(-(float)(2 * h + 2)) * LOG2E;
    float cumt = 0.f; if (VAR == 0) cumt = cumL[tq];
    constexpr int NPASS = VAR == 2 ? 2 : 1;
    unsigned nxt_u = 0u, nxt_c = 0u;
    const auto slot3 = [](int j) { return (j % 3) * SLOTB; };
#define SB2() __builtin_amdgcn_sched_barrier(0)
#define PINV(x) asm volatile("" : "+v"(x))
#define MF32(a, b, c) __builtin_amdgcn_mfma_f32_32x32x16_bf16(a, b, c, 0, 0, 0)
#define ATT_BARN(N) do { asm volatile("s_waitcnt vmcnt(" #N ") lgkmcnt(0)\n\ts_barrier" ::: "memory"); SB2(); } while (0)
#define PKW(Pv, i) cvtpk_s(Pv[i], Pv[(i) + 1])
#define PAF(k) __builtin_bit_cast(bf16x8, pw##k)
#define VFR(i) (bf16x8){vlo[i][0], vlo[i][1], vlo[i][2], vlo[i][3], vhi[i][0], vhi[i][1], vhi[i][2], vhi[i][3]}
#define VRD(i) do { vlo[i] = vtr(vp_ + (((i) >> 2) * 4096 + ((i) & 3) * 1024)); vhi[i] = vtr(vp_ + (((i) >> 2) * 4096 + ((i) & 3) * 1024 + 512)); } while (0)
#define EX2(v) __builtin_amdgcn_exp2f(v)
#define GAPA(MF, Pv, i, PW, w) do { MF; sacc += Pv[i]; sacc += Pv[(i) + 1]; sacc += Pv[(i) + 2]; sacc += Pv[(i) + 3]; PINV(sacc); PW[w] = PKW(Pv, i); PW[(w) + 1] = PKW(Pv, (i) + 2); PINV(PW); SB2(); } while (0)
#define GAPA8(MF, Pv, i, PW) do { MF; sacc += Pv[i]; sacc += Pv[(i) + 1]; sacc += Pv[(i) + 2]; sacc += Pv[(i) + 3]; sacc += Pv[(i) + 4]; sacc += Pv[(i) + 5]; sacc += Pv[(i) + 6]; sacc += Pv[(i) + 7]; PINV(sacc); \
        PW[0] = PKW(Pv, i); PW[1] = PKW(Pv, (i) + 2); PW[2] = PKW(Pv, (i) + 4); PW[3] = PKW(Pv, (i) + 6); PINV(PW); SB2(); } while (0)
#define GAPB(MF, X, i) do { MF; X[i] = EX2(X[i]); X[(i) + 1] = EX2(X[(i) + 1]); X[(i) + 2] = EX2(X[(i) + 2]); X[(i) + 3] = EX2(X[(i) + 3]); PINV(X); SB2(); } while (0)
    for (int pass = 0; pass < NPASS; ++pass) {
        bf16x8 qa[4]; float sb0 = 0.f;
        { const bf16* Qw = PR + (size_t)(rowbase + tq) * NP + Qc;
          constexpr int ND0 = VAR == 2 ? 2 : 4; const int dbase = VAR == 2 ? 2 * pass : 0;
          float qf[8 * ND0];
#pragma unroll
          for (int d0 = 0; d0 < ND0; ++d0) { bf16x8 raw = qpre[d0]; if (pass > 0) raw = *(const bf16x8*)(Qw + (dbase + d0) * 16 + hi * 8);
#pragma unroll
              for (int j = 0; j < 8; ++j) qf[d0 * 8 + j] = bf2f((unsigned short)raw[j]); }
          constexpr float SC = (VAR == 2 ? 0.17677669529663687f : 0.125f) * LOG2E;
          if (VAR != 1) {
              float ss = 0.f;
#pragma unroll
              for (int i = 0; i < 8 * ND0; ++i) ss += qf[i] * qf[i];
              ss += xhalf(ss, hi); const float rstd = 1.0f / sqrtf(ss * (VAR == 2 ? 1.f / 32.f : 1.f / 64.f) + RMS_EPS);
              const float* g = P.qgain[VAR];
#pragma unroll
              for (int d0 = 0; d0 < ND0; ++d0)
#pragma unroll
                  for (int j = 0; j < 8; ++j) qf[d0 * 8 + j] *= rstd * g[16 * d0 + 8 * hi + j] * SC;
          } else {
#pragma unroll
              for (int i = 0; i < 8 * ND0; ++i) qf[i] *= SC;
          }
          if (VAR == 2 || VAR == 3) {
              float n0 = 0.f;
#pragma unroll
              for (int i = 0; i < 8 * ND0; ++i) n0 += qf[i] * qf[i];
              n0 += xhalf(n0, hi);
              float gk = fabsf(P.kgain[VAR][lane & (VAR == 2 ? 31 : 63)]);
              gk = fmaxf(gk, shx<1>(gk)); gk = fmaxf(gk, shx<2>(gk)); gk = fmaxf(gk, shx<4>(gk)); gk = fmaxf(gk, shx<8>(gk)); gk = fmaxf(gk, shx<16>(gk)); gk = half_max(gk);
              sb0 = 1.02f * sqrtf(n0) * (VAR == 2 ? 5.656854249f : 8.0f) * gk;
          }
#pragma unroll
          for (int d0 = 0; d0 < ND0; ++d0) { u32x4 w; w.x = cvtpk_s(qf[d0 * 8 + 0], qf[d0 * 8 + 1]); w.y = cvtpk_s(qf[d0 * 8 + 2], qf[d0 * 8 + 3]); w.z = cvtpk_s(qf[d0 * 8 + 4], qf[d0 * 8 + 5]); w.w = cvtpk_s(qf[d0 * 8 + 6], qf[d0 * 8 + 7]);
              qa[d0] = __builtin_bit_cast(bf16x8, w); }
          if (VAR == 2) { qa[2] = qa[0]; qa[3] = qa[1]; }
        }
        const float sbound = sb0;
        if (pass > 0) { DMA_K2(0, 0); DMA_K2(1, SLOTB); DMA_V2(0, 0); }
        float mhat = 0.f, l_reg = 0.f; bool hasref = false, resc = false; f32x16 o[2], negm;
#pragma unroll
        for (int r = 0; r < 16; ++r) { o[0][r] = 0.f; o[1][r] = 0.f; }
        f32x16 pA0, pA1, pB0, pB1; u32x4 pw0, pw1, pw2, pw3;
#pragma unroll
        for (int r = 0; r < 16; ++r) { pB0[r] = 0.f; pB1[r] = 0.f; }
        const auto setneg = [&](int t) __attribute__((always_inline)) { float v = -mhat; if (VAR == 0) v += cumt; else v += slope2 * (float)(t * 64 + 4 * hi - tq);
#pragma unroll
            for (int r = 0; r < 16; ++r) negm[r] = v;
            PINV(negm); };
        const auto mid = [&](f32x16& C0, f32x16& C1, const int it) __attribute__((always_inline)) {
            const int t = NT - 1 - it;
            if (VAR == 0) { const LAS float* cp = cumL + t * 64 + 4 * hi;
#pragma unroll
                for (int g = 0; g < 4; ++g) { const f32x4 c0 = *(const LAS f32x4*)(cp + 8 * g), c1 = *(const LAS f32x4*)(cp + 32 + 8 * g);
#pragma unroll
                    for (int i = 0; i < 4; ++i) { C0[4 * g + i] -= c0[i]; C1[4 * g + i] -= c1[i]; } } }
            else {
#pragma unroll
                for (int r = 0; r < 16; ++r) { const float kc = (float)((r & 3) + 8 * (r >> 2)); C0[r] += slope2 * kc; C1[r] += slope2 * (kc + 32.f); } }
            if (VAR != 3) { if (it < 4) { asm volatile("" ::: "memory");
                const int kb = 64 * (3 - it) + 4 * hi;
#pragma unroll
                for (int r = 0; r < 16; ++r) { const int kv = kb + (r & 3) + 8 * (r >> 2); if (kv > qrel) C0[r] = -INFINITY; if (kv + 32 > qrel) C1[r] = -INFINITY; } } }
            else { const u32x2 mw = *(const LAS u32x2*)(maskL + qrel * MROW + 2 * t); const unsigned w0 = mw.x >> (4 * hi), w1 = mw.y >> (4 * hi);
#pragma unroll
                for (int r = 0; r < 16; ++r) { const int c = (r & 3) + 8 * (r >> 2); if (!((w0 >> c) & 1u)) C0[r] = -INFINITY; if (!((w1 >> c) & 1u)) C1[r] = -INFINITY; } }
            const float rm = rowmax(C0, C1, hi);
            const bool need = hasref ? (rm > THR) : (rm > -INFINITY);
            resc = false;
            if (__any(need)) {
                const bool fin = rm > -INFINITY;
                const float dl = hasref ? fmaxf(rm, 0.f) : (fin ? rm : 0.f);
                const float f = hasref ? EX2(-dl) : 1.f;
                mhat += dl; l_reg *= f;
#pragma unroll
                for (int r = 0; r < 16; ++r) { C0[r] -= dl; C1[r] -= dl; }
                if (hi == 0) wsf[r32] = f;
                resc = true; hasref = hasref || fin;
            }
            if (VAR != 0) {
                const bool dead = hasref && (sbound - slope2 * (float)(tq - 64 * t + 1) - mhat < -150.f);
                const bool alld = __all(dead); if (lane == 0) ((LAS unsigned*)(sh + L_END))[(it & 1) * 8 + wid] = alld ? 1u : 0u;
            }
        };
#define KLD(dst0, dst1, d0) do { dst0 = *(const LAS bf16x8*)(kp_ + (d0) * 2048); dst1 = *(const LAS bf16x8*)(kp_ + (d0) * 2048 + 512); } while (0)
#define VLD(lo, hi_, i) do { lo = vtr(vp_ + (((i) >> 2) * 4096 + ((i) & 3) * 1024)); hi_ = vtr(vp_ + (((i) >> 2) * 4096 + ((i) & 3) * 1024 + 512)); } while (0)
#define VF(lo, hi_) (bf16x8){lo[0], lo[1], lo[2], lo[3], hi_[0], hi_[1], hi_[2], hi_[3]}
        const auto step = [&](f32x16& C0, f32x16& C1, f32x16& P0, f32x16& P1, const int it) __attribute__((always_inline)) -> bool {
            if (it + 1 < NT) ATT_BARN(2); else ATT_BARN(1);
            if (VAR != 0 && it >= 1) { const LAS unsigned* wz = (const LAS unsigned*)(sh + L_END) + ((it - 1) & 1) * 8;
                const u32x4 z0 = *(const LAS u32x4*)wz, z1 = *(const LAS u32x4*)(wz + 4);
                if (__builtin_amdgcn_readfirstlane((int)(z0.x & z0.y & z0.z & z0.w & z1.x & z1.y & z1.z & z1.w)) != 0) return true; }
            if (it + 2 < NT) DMA_K2(it + 2, slot3(it + 2));
            if (it + 1 < NT) DMA_V2(it + 1, slot3(it + 1));
            setneg(NT - 1 - it);
            int ko_ = slot3(it), vo_ = slot3(it + 2);
            asm volatile("" : "+s"(ko_), "+s"(vo_));
            const lds_cptr kp_ = kp0 + ko_; const lds_cptr vp_ = vp0 + vo_;
            bf16x8 ka0, ka1, kb0, kb1; s16x4 va0, va1, vb0, vb1;
            float sacc = 0.f;
            if (VAR == 2) {
                KLD(ka0, ka1, 2 * pass); KLD(kb0, kb1, 2 * pass + 1); SB2();
                GAPA8(C0 = MF32(ka0, qa[0], negm), P0, 0, pw0);
                GAPA8(C1 = MF32(ka1, qa[0], negm), P0, 8, pw1);
                GAPA8(C0 = MF32(kb0, qa[1], C0), P1, 0, pw2);
                GAPA8(C1 = MF32(kb1, qa[1], C1), P1, 8, pw3);
            } else {
                KLD(ka0, ka1, 0); KLD(kb0, kb1, 1); SB2();
                GAPA(C0 = MF32(ka0, qa[0], negm), P0, 0, pw0, 0);
                GAPA(C1 = MF32(ka1, qa[0], negm), P0, 4, pw0, 2);
                KLD(ka0, ka1, 2); SB2();
                GAPA(C0 = MF32(kb0, qa[1], C0), P0, 8, pw1, 0);
                GAPA(C1 = MF32(kb1, qa[1], C1), P0, 12, pw1, 2);
                KLD(kb0, kb1, 3); SB2();
                GAPA(C0 = MF32(ka0, qa[2], C0), P1, 0, pw2, 0);
                GAPA(C1 = MF32(ka1, qa[2], C1), P1, 4, pw2, 2);
                GAPA(C0 = MF32(kb0, qa[3], C0), P1, 8, pw3, 0);
                GAPA(C1 = MF32(kb1, qa[3], C1), P1, 12, pw3, 2);
            }
            l_reg += sacc;
            mid(C0, C1, it);
            SB2();
            if (it > 0) {
                VLD(va0, va1, 0); VLD(vb0, vb1, 4); SB2();
                GAPB(o[0] = MF32(PAF(0), VF(va0, va1), o[0]), C0, 0);  VLD(va0, va1, 1); SB2();
                GAPB(o[1] = MF32(PAF(0), VF(vb0, vb1), o[1]), C0, 4);  VLD(vb0, vb1, 5); SB2();
                GAPB(o[0] = MF32(PAF(1), VF(va0, va1), o[0]), C0, 8);  VLD(va0, va1, 2); SB2();
                GAPB(o[1] = MF32(PAF(1), VF(vb0, vb1), o[1]), C0, 12); VLD(vb0, vb1, 6); SB2();
                GAPB(o[0] = MF32(PAF(2), VF(va0, va1), o[0]), C1, 0);  VLD(va0, va1, 3); SB2();
                GAPB(o[1] = MF32(PAF(2), VF(vb0, vb1), o[1]), C1, 4);  VLD(vb0, vb1, 7); SB2();
                GAPB(o[0] = MF32(PAF(3), VF(va0, va1), o[0]), C1, 8);
                GAPB(o[1] = MF32(PAF(3), VF(vb0, vb1), o[1]), C1, 12);
                if (resc) {
#pragma unroll
                    for (int r = 0; r < 16; ++r) { const float fr = wsf[crow(r, hi)]; o[0][r] *= fr; o[1][r] *= fr; } }
            } else {
#pragma unroll
                for (int r = 0; r < 16; ++r) { C0[r] = EX2(C0[r]); C1[r] = EX2(C1[r]); }
            }
            return false;
        };
        bool ex = false, pendA = true; int it = 0;
        for (; it < NT; it += 2) {
            ex = step(pA0, pA1, pB0, pB1, it); if (ex) { pendA = false; break; }
            ex = step(pB0, pB1, pA0, pA1, it + 1); if (ex) { pendA = true; ++it; break; }
        }
        if (!ex) pendA = false;
        if (!ex) ATT_BARN(0);
        { int vo_ = slot3(it + 2); asm volatile("" : "+s"(vo_)); const lds_cptr vp_ = vp0 + vo_; s16x4 vlo[8], vhi[8];
#pragma unroll
          for (int i = 0; i < 8; ++i) VRD(i);
          float sacc = 0.f;
          if (pendA) {
#pragma unroll
              for (int r = 0; r < 16; ++r) sacc += pA0[r] + pA1[r];
              pw0 = (u32x4){PKW(pA0, 0), PKW(pA0, 2), PKW(pA0, 4), PKW(pA0, 6)}; pw1 = (u32x4){PKW(pA0, 8), PKW(pA0, 10), PKW(pA0, 12), PKW(pA0, 14)};
              pw2 = (u32x4){PKW(pA1, 0), PKW(pA1, 2), PKW(pA1, 4), PKW(pA1, 6)}; pw3 = (u32x4){PKW(pA1, 8), PKW(pA1, 10), PKW(pA1, 12), PKW(pA1, 14)};
          } else {
#pragma unroll
              for (int r = 0; r < 16; ++r) sacc += pB0[r] + pB1[r];
              pw0 = (u32x4){PKW(pB0, 0), PKW(pB0, 2), PKW(pB0, 4), PKW(pB0, 6)}; pw1 = (u32x4){PKW(pB0, 8), PKW(pB0, 10), PKW(pB0, 12), PKW(pB0, 14)};
              pw2 = (u32x4){PKW(pB1, 0), PKW(pB1, 2), PKW(pB1, 4), PKW(pB1, 6)}; pw3 = (u32x4){PKW(pB1, 8), PKW(pB1, 10), PKW(pB1, 12), PKW(pB1, 14)};
          }
          l_reg += sacc;
          o[0] = MF32(PAF(0), VFR(0), o[0]); o[1] = MF32(PAF(0), VFR(4), o[1]); o[0] = MF32(PAF(1), VFR(1), o[0]); o[1] = MF32(PAF(1), VFR(5), o[1]);
          o[0] = MF32(PAF(2), VFR(2), o[0]); o[1] = MF32(PAF(2), VFR(6), o[1]); o[0] = MF32(PAF(3), VFR(3), o[0]); o[1] = MF32(PAF(3), VFR(7), o[1]); }
        ATT_WAIT_BAR();
        if (pass == NPASS - 1 && tid == 0) { nxt_u = __builtin_amdgcn_atomic_inc32(qctr, 0xFFFFFFFFu, __ATOMIC_RELAXED, "agent"); if (P.cvq) nxt_c = __builtin_amdgcn_atomic_inc32(P.cvq, 0xFFFFFFFFu, __ATOMIC_RELAXED, "agent"); }
        int lane_e = lane; asm volatile("" : "+v"(lane_e)); const int r32e = lane_e & 31, hie = lane_e >> 5;
        LAS float* wsfe = (LAS float*)(sh + L_WS) + wid * 64; LAS float* stge = (LAS float*)(sh + L_OST) + wid * 2048;
        float rli[16];
        l_reg += xhalf(l_reg, hie);
        if (hie == 0) wsfe[32 + r32e] = l_reg;
#pragma unroll
        for (int r = 0; r < 16; ++r) rli[r] = __builtin_amdgcn_rcpf(wsfe[32 + crow(r, hie)]);
#pragma unroll
        for (int r = 0; r < 16; ++r) { const int orow = crow(r, hie);
#pragma unroll
            for (int d0 = 0; d0 < 2; ++d0) { const float val = o[d0][r] * rli[r]; LAS float* sp = stge + orow * 64 + d0 * 32 + r32e;
                if (VAR == 2 && pass == 1) *sp = *sp - P.lam * val; else *sp = val; } }
    }
    LDS_WAIT();
    int lane_o = tid & 63; asm volatile("" : "+v"(lane_o));
    bf16* Ow = P.mix + (size_t)(rowbase + q0 + wid * 32) * DM + VAR * 256 + h * 64;
    { const int lane = lane_o; LAS float* stg = (LAS float*)(sh + L_OST) + wid * 2048;
#pragma unroll
    for (int i = 0; i < 4; ++i) { const int row = i * 8 + (lane >> 3), ch = lane & 7;
        const f32x4 a = *(const LAS f32x4*)(stg + row * 64 + ch * 8), c = *(const LAS f32x4*)(stg + row * 64 + ch * 8 + 4);
        float sc = 1.f;
        if (VAR == 2) { float ss = (a[0] * a[0] + a[1] * a[1]) + (a[2] * a[2] + a[3] * a[3]) + (c[0] * c[0] + c[1] * c[1]) + (c[2] * c[2] + c[3] * c[3]);
            ss += shx<1>(ss); ss += shx<2>(ss); ss += shx<4>(ss); sc = 1.0f / sqrtf(ss * (1.f / 64.f) + RMS_EPS); }
        u32x4 w; w.x = cvtpk_s(a[0] * sc, a[1] * sc); w.y = cvtpk_s(a[2] * sc, a[3] * sc); w.z = cvtpk_s(c[0] * sc, c[1] * sc); w.w = cvtpk_s(c[2] * sc, c[3] * sc);
        *(u32x4*)(Ow + (size_t)row * DM + ch * 8) = w; } }
    if (tid == 0) { *qslot = nxt_u; if (P.cvq) qslot[3] = nxt_c; }
    asm volatile("s_waitcnt lgkmcnt(0)\n\ts_barrier" ::: "memory");
#undef DMA_K2
#undef DMA_V2
#undef TILE2
}
#undef SB2
#undef PINV
#undef MF32
#undef ATT_BARN
#undef PKW
#undef PAF
#undef VFR
#undef VRD
#undef EX2
#undef GAPA
#undef GAPA8
#undef GAPB
#undef KLD
#undef VLD
#undef VF
}

__device__ __forceinline__ void p4_attention(Frame& F, const Args& A, int l, int qsel) {
    att::AttnP P; P.proj = (const bf16*)(F.ws + WS_PROJ); P.mix = (bf16*)(F.ws + WS_MIX); P.cum = (const float*)(F.ws + WS_CUM); P.mask = (const unsigned*)(F.ws + WS_MASK);
    P.qgain[0] = inp<I_QNA>() + l * 64; P.qgain[1] = nullptr; P.qgain[2] = inp<I_QNC>() + l * 32; P.qgain[3] = inp<I_QND>() + l * 64; P.kgain[0] = nullptr; P.kgain[1] = nullptr; P.kgain[2] = inp<I_KNC>() + l * 32; P.kgain[3] = inp<I_KND>() + l * 64; P.lam = ((const float*)(F.ws + WS_MISC))[l];
    LAS char* sh = (LAS char*)F.lds;
    LAS float* rsl2 = (LAS float*)(F.lds + 126976);
    bool cv = BG_CONVERT && (qsel == 0);
    if (cv) { fill_rowscale(F, A, 0, rsl2); fill_rowscale(F, A, 1, rsl2 + DM); }
    P.cvq = cv ? F.ctl + CW_CVQ : nullptr;
    if (F.tid == 0) F.MISC[0] = (unsigned)(F.bx - F.G);
    __syncthreads();
    for (;;) {
        const int u = (int)F.MISC[0] + F.G;
        if (u >= 1024) break;
        const int qb = 7 - (u >> 7), r = u & 127, var = r >> 5, bh = r & 31, b = bh >> 2, h = bh & 3;
        const int tv = var == 0 ? 2 : var == 1 ? 1 : var == 2 ? 3 : 0;
        if (qsel >= 2 && PROBE_ATT_VAR >= 0 && tv != PROBE_ATT_VAR) { __syncthreads(); if (F.tid == 0) F.MISC[0] = __hip_atomic_fetch_add(F.ctl + CW_AQ + 64 * qsel, 1u, RLX_AGENT); __syncthreads(); continue; }
#ifdef ONLY_VAR2
        att::attn_unit2<ONLY_VAR2>(P, b, h, qb, sh, F.tid, F.ctl + CW_AQ + 64 * qsel, F.MISC);
#else
        if (tv == 2) att::attn_unit<2>(P, b, h, qb, sh, F.tid, qsel >= 2 ? PROBE_ATT_MODE : 0, F.ctl + CW_AQ + 64 * qsel, F.MISC);
        else if (tv == 1) att::attn_unit<1>(P, b, h, qb, sh, F.tid, qsel >= 2 ? PROBE_ATT_MODE : 0, F.ctl + CW_AQ + 64 * qsel, F.MISC);
        else if (tv == 3) att::attn_unit<3>(P, b, h, qb, sh, F.tid, qsel >= 2 ? PROBE_ATT_MODE : 0, F.ctl + CW_AQ + 64 * qsel, F.MISC);
        else att::attn_unit2<0>(P, b, h, qb, sh, F.tid, F.ctl + CW_AQ + 64 * qsel, F.MISC);
#endif
        if (cv) {
            const int gb = (int)F.MISC[3] * CV_CHUNK;
            if (gb >= CV_TOTAL) { cv = false; P.cvq = nullptr; } else convert_chunk(F, A, gb, rsl2);
            __syncthreads();
        }
    }
    while (cv) {
        __syncthreads();
        if (F.tid == 0) F.MISC[3] = __hip_atomic_fetch_add(F.ctl + CW_CVQ, 1u, RLX_AGENT);
        __syncthreads();
        const int gb = (int)F.MISC[3] * CV_CHUNK;
        if (gb >= CV_TOTAL) cv = false; else convert_chunk(F, A, gb, rsl2);
    }
    __syncthreads();
}

template <int N, int Dd> __device__ __forceinline__ void bfly(float (&p)[32], int lane) { const bool up = (lane & Dd) != 0;
#pragma unroll
    for (int j = 0; j < N / 2; ++j) { const float a = p[2 * j], bb = p[2 * j + 1]; const float send = up ? a : bb, keep = up ? bb : a; p[j] = keep + __shfl_xor(send, Dd); } }
__device__ __forceinline__ void p6_router(Frame& F, const Args& A, int l, int rep) {
    const float* MOD = (const float*)(F.ws + WS_MOD); const bf16* X1 = (const bf16*)(F.ws + WS_X1); bf16* H = (bf16*)(F.ws + WS_H);
    const bf16* WRH = (const bf16*)(F.ws + WS_WR) + (size_t)l * 48 * DM; const bf16* WRL = WRH + 2 * 48 * DM;
    int* tok_e = (int*)(F.ws + WS_TOK); float* tok_w = (float*)(F.ws + WS_TOK) + 2 * M; int* tok_pos = (int*)(F.ws + WS_TOK) + 4 * M;
    constexpr int AP = 528;
    LAS unsigned char* Ahi = F.lds; LAS unsigned char* Alo = F.lds + 64 * AP; LAS unsigned char* Bhi = F.lds + 128 * AP; LAS unsigned char* Blo = F.lds + 176 * AP;
    LAS float* PL = (LAS float*)F.lds;
    const int lane = F.lane, w = F.wave; const int mw = (F.vcu * NWAVES + w) * 8; const int b = mw >> 11;
    const float* md = MOD + ((size_t)l * 8 + b) * 6144;
    f32x4 hv[8][4];
#pragma unroll
    for (int r = 0; r < 8; ++r) {
        const bf16* xr = X1 + (size_t)(mw + r) * DM;
#pragma unroll
        for (int j = 0; j < 4; ++j) { const u32x2 q = *(const u32x2*)(xr + 256 * j + 4 * lane); hv[r][j] = (f32x4){bf2f(q.x & 0xffff), bf2f(q.x >> 16), bf2f(q.y & 0xffff), bf2f(q.y >> 16)}; }
    }
    { f32x4 gm[4], sc[4], sh[4]; const float* n2 = inp<I_N2G>() + l * DM;
#pragma unroll
      for (int j = 0; j < 4; ++j) { const int col = 256 * j + 4 * lane; gm[j] = *(const f32x4*)(n2 + col); sc[j] = *(const f32x4*)(md + 4 * DM + col); sh[j] = *(const f32x4*)(md + 3 * DM + col); gm[j] = gm[j] * (sc[j] + 1.0f); }
#pragma unroll
      for (int r = 0; r < 8; ++r) { float ss = 0.f;
#pragma unroll
        for (int j = 0; j < 4; ++j) ss += (hv[r][j][0] * hv[r][j][0] + hv[r][j][1] * hv[r][j][1]) + (hv[r][j][2] * hv[r][j][2] + hv[r][j][3] * hv[r][j][3]);
        const float rstd = 1.0f / sqrtf(wave_sum(ss) * (1.f / DM) + RMS_EPS);
#pragma unroll
        for (int j = 0; j < 4; ++j) { hv[r][j] = hv[r][j] * rstd * gm[j] + sh[j]; u32x2 pk; pk.x = pk2(hv[r][j][0], hv[r][j][1]); pk.y = pk2(hv[r][j][2], hv[r][j][3]);
            *(u32x2*)(H + (size_t)(mw + r) * DM + 256 * j + 4 * lane) = pk; } } }
    const int rt = w & 3, kh = w >> 2, arow = lane & 15, kg = lane >> 4;
    f32x4 acc[3];
#pragma unroll
    for (int c = 0; c < 3; ++c) acc[c] = (f32x4){0.f, 0.f, 0.f, 0.f};
    u32x4 bpre[2][3];
    const auto loadB = [&](int j) {
#pragma unroll
        for (int k = 0; k < 3; ++k) { const int i = F.tid + 512 * k, o = i >> 5, c16 = i & 31;
            bpre[0][k] = *(const u32x4*)(WRH + (size_t)o * DM + 256 * j + 8 * c16); bpre[1][k] = *(const u32x4*)(WRL + (size_t)o * DM + 256 * j + 8 * c16); } };
    loadB(0);
#pragma unroll
    for (int j = 0; j < 4; ++j) {
        __syncthreads();
#pragma unroll
        for (int r = 0; r < 8; ++r) { const f32x4 x = hv[r][j]; unsigned h0 = f2bf(x[0]), h1 = f2bf(x[1]), h2 = f2bf(x[2]), h3 = f2bf(x[3]);
            u32x2 hi; hi.x = h0 | (h1 << 16); hi.y = h2 | (h3 << 16);
            u32x2 lo; lo.x = pk2(x[0] - bf2f((unsigned short)h0), x[1] - bf2f((unsigned short)h1)); lo.y = pk2(x[2] - bf2f((unsigned short)h2), x[3] - bf2f((unsigned short)h3));
            *(LAS u32x2*)(Ahi + (w * 8 + r) * AP + lane * 8) = hi; *(LAS u32x2*)(Alo + (w * 8 + r) * AP + lane * 8) = lo; }
#pragma unroll
        for (int k = 0; k < 3; ++k) { const int i = F.tid + 512 * k, o = i >> 5, c16 = i & 31; *(LAS u32x4*)(Bhi + o * AP + c16 * 16) = bpre[0][k]; *(LAS u32x4*)(Blo + o * AP + c16 * 16) = bpre[1][k]; }
        if (j + 1 < 4) loadB(j + 1);
        LDS_WAIT(); __syncthreads();
#pragma unroll
        for (int ks = 0; ks < 4; ++ks) { const int kb = ((4 * kh + ks) * 32 + 8 * kg) * 2;
            const bf16x8 ah = *(const LAS bf16x8*)(Ahi + (16 * rt + arow) * AP + kb), al = *(const LAS bf16x8*)(Alo + (16 * rt + arow) * AP + kb);
#pragma unroll
            for (int c = 0; c < 3; ++c) { const bf16x8 bh = *(const LAS bf16x8*)(Bhi + (16 * c + arow) * AP + kb), bl = *(const LAS bf16x8*)(Blo + (16 * c + arow) * AP + kb);
                acc[c] = __builtin_amdgcn_mfma_f32_16x16x32_bf16(ah, bh, acc[c], 0, 0, 0);
                acc[c] = __builtin_amdgcn_mfma_f32_16x16x32_bf16(al, bh, acc[c], 0, 0, 0);
                acc[c] = __builtin_amdgcn_mfma_f32_16x16x32_bf16(ah, bl, acc[c], 0, 0, 0); } }
    }
    __syncthreads();
#pragma unroll
    for (int c = 0; c < 3; ++c)
#pragma unroll
        for (int r = 0; r < 4; ++r) PL[(kh * 64 + 16 * rt + kg * 4 + r) * 48 + 16 * c + arow] = acc[c][r];
    LDS_WAIT(); __syncthreads();
    if (F.tid < 64 && rep == 0) {
        const int m = F.vcu * 64 + F.tid; const LAS float* q0 = PL + F.tid * 48; const LAS float* q1 = PL + (64 + F.tid) * 48;
        float gl[4]; int gi = 0; float gm;
#pragma unroll
        for (int g = 0; g < 4; ++g) gl[g] = (q0[g] + q1[g]) + inp<I_BG>()[l * 4 + g];
        gm = gl[0];
#pragma unroll
        for (int g = 1; g < 4; ++g) if (gl[g] > gm) { gm = gl[g]; gi = g; }
        float den = 0.f;
#pragma unroll
        for (int g = 0; g < 4; ++g) den += __expf(gl[g] - gm);
        const float gprob = 1.0f / den;
        float v1 = -INFINITY, v2 = -INFINITY; int i1 = 0, i2 = 0;
        for (int e = 0; e < 8; ++e) { const float v = (q0[4 + gi * 8 + e] + q1[4 + gi * 8 + e]) + inp<I_BE>()[l * 32 + gi * 8 + e];
            if (v > v1) { v2 = v1; i2 = i1; v1 = v; i1 = e; } else if (v > v2) { v2 = v; i2 = e; } }
        const float e2 = __expf(v2 - v1); const float w1 = gprob / (1.f + e2), w2 = gprob * e2 / (1.f + e2);
        const int ea = gi * 8 + i1, eb = gi * 8 + i2;
        tok_e[m] = ea; tok_e[M + m] = eb; tok_w[m] = w1; tok_w[M + m] = w2;
        LAS unsigned* lcnt = (LAS unsigned*)(F.lds + 32768); LAS unsigned* lbase = lcnt + 32;
        if (F.tid < 32) lcnt[F.tid] = 0u;
        asm volatile("s_waitcnt lgkmcnt(0)" ::: "memory");
        const unsigned ra = __hip_atomic_fetch_add(lcnt + ea, 1u, __ATOMIC_RELAXED, __HIP_MEMORY_SCOPE_WORKGROUP), rb = __hip_atomic_fetch_add(lcnt + eb, 1u, __ATOMIC_RELAXED, __HIP_MEMORY_SCOPE_WORKGROUP);
        asm volatile("s_waitcnt lgkmcnt(0)" ::: "memory");
        if (F.tid < 32) { const unsigned n = *(volatile LAS unsigned*)(lcnt + F.tid); unsigned bs = 0u; if (n) bs = __hip_atomic_fetch_add(F.ctl + CW_CNT + (l * 32 + F.tid) * 16, n, RLX_AGENT); *(volatile LAS unsigned*)(lbase + F.tid) = bs; }
        asm volatile("s_waitcnt vmcnt(0) lgkmcnt(0)" ::: "memory");
        const int pa = (int)(*(volatile LAS unsigned*)(lbase + ea) + ra), pb = (int)(*(volatile LAS unsigned*)(lbase + eb) + rb);
        tok_pos[m] = pa; tok_pos[M + m] = pb;
        int* elist = (int*)(F.ws + WS_ELIST); elist[ea * M + pa] = m; elist[eb * M + pb] = m;
    }
}

__device__ __forceinline__ void build_rowlists(Frame& F, int l) {
    volatile LAS int* base = (volatile LAS int*)(F.lds + BASE_OFF); volatile LAS int* cnts = (volatile LAS int*)(F.lds + CNTS_OFF); volatile LAS int* tab = (volatile LAS int*)(F.lds + TAB_OFF);
    LAS int* rowl = (LAS int*)(F.lds + ROWL_OFF); const int* elist = (const int*)(F.ws + WS_ELIST);
    const int ntile = (int)F.MISC[1];
    const int i = F.tid >> 8, r = F.tid & 255; const long L = (long)i * F.G + F.bx;
    int tok = 0;
    if (L < 2L * ntile) { const int tile = (int)(L >> 1), e = tab[tile], pos = 256 * (tile - base[e]) + r; if (pos < cnts[e]) tok = elist[e * M + pos]; }
    rowl[F.tid] = tok;
    __syncthreads();
}

constexpr int NPL = 7, NPH = 2 + 2 * NPL;
__global__ void __launch_bounds__(NWAVES * 64, 2) mk_fwd(Args args) {
    extern __shared__ __attribute__((aligned(16))) unsigned char lds[];
    Frame F;
    F.lds = (LAS unsigned char*)lds;
    F.MISC = (volatile LAS unsigned*)(F.lds + MISC_OFF);
    F.tid = threadIdx.x; F.lane = F.tid & 63; F.wave = __builtin_amdgcn_readfirstlane(F.tid >> 6);
    const int wave0 = F.wave;
    F.G = gridDim.x; F.bx = blockIdx.x; F.vcu = 0;
    F.ws = args.ws; F.out = args.out; F.ctl = (unsigned*)(args.ws + WS_CTL);
    for (int u = F.tid; u < (LDS_BYTES - LDSCTL_OFF) / 4; u += NWAVES * 64) ((LAS unsigned*)(F.lds + LDSCTL_OFF))[u] = 0u;
    __syncthreads();
    XcdBarrier bar; bar.bar = F.ctl + CW_BAR; bar.x = 0; bar.st = nullptr;
    if (!MK_PER_PHASE) bar = xcd_barrier_post(F.ctl + CW_BAR, F.MISC + 8);
    const int lo = args.ph_lo, hi = args.ph_hi;
#pragma unroll 1
    for (int ph = lo; ph < hi; ++ph) {
#if PROBE_REP_K >= 0
        const int ptype = ph == 0 ? 0 : (ph == NPH - 1 ? 10 : 1 + (ph - 1) % NPL);
        const int nrep = (ptype == PROBE_REP_K && (ph <= NPL || (PROBE_REP_K != 1 && PROBE_REP_K != 5))) ? 1 : 0;
#pragma unroll 1
        for (int rep = 0; rep <= nrep; ++rep) {
#else
        constexpr int rep = 0;
#endif
        { int w_ = wave0; asm volatile("" : "+s"(w_)); unsigned on_ = ~0u; asm volatile("" : "+s"(on_)); int ln_ = (int)__builtin_amdgcn_mbcnt_hi(on_, __builtin_amdgcn_mbcnt_lo(on_, 0u)); asm volatile("" : "+v"(ln_));
          F.wave = w_; F.lane = ln_; F.tid = w_ * 64 + ln_;
          unsigned long long ws_ = (unsigned long long)args.ws; asm volatile("" : "+s"(ws_)); F.ws = (unsigned char*)(GAS unsigned char*)ws_; F.ctl = (unsigned*)(F.ws + WS_CTL);
          int bx_ = blockIdx.x; asm volatile("" : "+s"(bx_)); F.bx = bx_; F.vcu = (F.G % 8 == 0) ? (bx_ % 8) * (F.G / 8) + bx_ / 8 : bx_; }
        if (ph == 0) {
#ifndef SKIP_P0
            p0_prologue(F, args);
#endif
        } else if (ph == NPH - 1) {
            row_pass(F, args, 2, 1);
        } else {
            const int l = (ph - 1) / NPL, k = (ph - 1) % NPL;
            if (k == 0) { row_pass(F, args, l == 0 ? 0 : 1, l); }
            else if (k == 1) {
                pg8::Gemm g{(const bf16*)(F.ws + WS_H), (const bf16*)(F.ws + WS_WIN) + (size_t)l * NP * DM, M, NP, DM}; pg8::StaticOrder S; S.init(M, NP, F.G, F.bx);
                pg8::EpiBf16 E{(bf16*)(F.ws + WS_PROJ), NP};
#ifndef SKIP_G1
                pg8::gemm_phase<pg8::EpiBf16, pg8::StaticOrder, true, true>(F.lds, g, S, E, F.tid);
#endif
            } else if (k == 2) {
#ifndef SKIP_P3
                p3_prep(F, args, l, rep);
#endif
            } else if (k == 3) {
#ifndef SKIP_P4
                p4_attention(F, args, l, l + 2 * rep);
#endif
            } else if (k == 4) {
                pg8::Gemm g{(const bf16*)(F.ws + WS_MIX), (const bf16*)(F.ws + WS_WOUT) + (size_t)l * DM * DM, M, DM, DM}; pg8::StaticOrder S; S.init(M, DM, F.G, F.bx);
                pg8::EpiResGate E{l == 0 ? inp<I_X>() : nullptr, (const bf16*)(F.ws + WS_X1), (bf16*)(F.ws + WS_X1), (const float*)(F.ws + WS_MOD) + (size_t)l * 8 * 6144 + 2 * DM};
#ifndef SKIP_G2
                pg8::gemm_phase<pg8::EpiResGate, pg8::StaticOrder, false, true>(F.lds, g, S, E, F.tid);
#endif
            } else if (k == 5) {
#ifndef SKIP_P6
                p6_router(F, args, l, rep);
#endif
            } else {
                build_tables(F, l); build_rowlists(F, l);
                unsigned* upf = F.ctl + CW_UPF + l * 8192; unsigned* dq = F.ctl + CW_DNQ + 16 * l;
                { pg8::Gemm g{(const bf16*)(F.ws + WS_H), (const bf16*)(F.ws + WS_WUP) + (size_t)l * NEXP * 512 * DM, MAXSLOT, 512, DM};
                  pg8::GroupOrder S{(const LAS int*)(F.lds + TAB_OFF), (int)F.MISC[1], 2, F.G, F.bx, (size_t)512 * DM * 2};
                  pg8::EpiSwiglu E{(bf16*)(F.ws + WS_HID), upf};
#ifndef SKIP_G3
                  pg8::gemm_phase<pg8::EpiSwiglu, pg8::GroupOrder, true, true, true>(F.lds, g, S, E, F.tid, (const LAS int*)(F.lds + ROWL_OFF));
#endif
                }
                if (GAP_CONVERT && !BG_CONVERT && l == 0 && rep == 0) convert_layer1_in_gap(F, args, 2 * (int)F.MISC[1] - F.G);
                { const pg8::Gemm g{(const bf16*)(F.ws + WS_HID), (const bf16*)(F.ws + WS_WDN) + (size_t)l * NEXP * DM * FF, MAXSLOT, DM, FF};
                  const pg8::EpiBf16 E{(bf16*)(F.ws + WS_Y), DM};
                  const LAS int* tab = (const LAS int*)(F.lds + TAB_OFF);
                  const int nd = 4 * __builtin_amdgcn_readfirstlane((int)F.MISC[1]);
                  pg8::DynOrder S{dq, upf, tab, F.MISC, nd, (size_t)DM * FF * 2, F.tid, (unsigned)F.G, 0u, 2u};
                  if (F.tid == 0) { const unsigned a = (unsigned)F.bx, b = (unsigned)F.G + __hip_atomic_fetch_add(dq, 1u, RLX_AGENT); F.MISC[4] = a; F.MISC[5] = b;
                      if ((int)a < nd) while (__hip_atomic_load(upf + (a >> 2) * 16, RLX_AGENT) < 2u) __builtin_amdgcn_s_sleep(8);
                      __builtin_amdgcn_fence(__ATOMIC_ACQUIRE, "agent"); asm volatile("s_waitcnt vmcnt(0)" ::: "memory"); S.issue(b); }
                  __syncthreads();
                  for (;;) {
                      if (__builtin_amdgcn_readfirstlane((int)F.MISC[4]) >= nd) break;
#ifndef SKIP_G4
                      pg8::gemm_phase<pg8::EpiBf16, pg8::DynOrder, true, true>(F.lds, g, S, E, F.tid);
#endif
                      if (F.tid == 0) {
                          const unsigned idn = F.MISC[5];
                          if ((int)idn < nd) { unsigned f = S.pflag; while (f < 2u) { __builtin_amdgcn_s_sleep(8); f = __hip_atomic_load(upf + (idn >> 2) * 16, RLX_AGENT); }
                              __builtin_amdgcn_fence(__ATOMIC_ACQUIRE, "agent"); asm volatile("s_waitcnt vmcnt(0)" ::: "memory"); }
                          const unsigned idn2 = S.ppop; F.MISC[4] = idn; F.MISC[5] = idn2; S.issue(idn2); }
                      __syncthreads();
                  }
                }
            }
        }
#if PROBE_REP_K >= 0
        if (rep < nrep) xcd_barrier(bar, F.tid);
        }
#endif
        if (ph + 1 < hi) xcd_barrier(bar, F.tid);
#ifdef PROBE_DOUBLE_BAR
        if (ph + 1 < hi) xcd_barrier(bar, F.tid);
#endif
    }
}

extern "C" void kernel_launch(void* const* d_in, const int* in_sizes, int n_in, void* d_out, int out_size, void* d_ws, size_t ws_size, hipStream_t stream) {
    static int grid = 0;
    if (grid == 0) {
        if (n_in != 28 || out_size != M * DM || ws_size < WS_END) { fprintf(stderr, "kernel_launch: unexpected shapes (n_in %d, out %d, ws %zu)\n", n_in, out_size, ws_size); grid = -1; return; }
        int dev = 0, cus = 0, per_cu = 0;
        if (hipGetDevice(&dev) != hipSuccess || hipDeviceGetAttribute(&cus, hipDeviceAttributeMultiprocessorCount, dev) != hipSuccess) { grid = -1; return; }
        if (hipFuncSetAttribute((const void*)mk_fwd, hipFuncAttributeMaxDynamicSharedMemorySize, LDS_BYTES) != hipSuccess) { fprintf(stderr, "kernel_launch: hipFuncSetAttribute failed\n"); grid = -1; return; }
        if (hipOccupancyMaxActiveBlocksPerMultiprocessor(&per_cu, (const void*)mk_fwd, NWAVES * 64, LDS_BYTES) != hipSuccess || per_cu < 1)
            fprintf(stderr, "kernel_launch: occupancy query reports %d workgroups per CU\n", per_cu);
        (void)hipGetLastError();
        grid = cus;
    }
    if (grid < 0) return;
    if (hipMemsetAsync((char*)d_ws + WS_CTL, 0, CTL_ZERO_BYTES, stream) != hipSuccess) return;
    Args a{};
    for (int i = 0; i < 28; ++i) a.in[i] = (const float*)d_in[i];
    a.out = (float*)d_out; a.ws = (unsigned char*)d_ws;
#if MK_PER_PHASE
    for (int p = 0; p < NPH; ++p) { a.ph_lo = p; a.ph_hi = p + 1; hipLaunchKernelGGL(mk_fwd, dim3(grid), dim3(NWAVES * 64), LDS_BYTES, stream, a); }
#else
    a.ph_lo = 0; a.ph_hi = NPH; hipLaunchKernelGGL(mk_fwd, dim3(grid), dim3(NWAVES * 64), LDS_BYTES, stream, a);
#endif
}
```

```cpp
#include <hip/hip_runtime.h>
#include <cstdio>
#include <cstdint>

#ifndef MK_PER_PHASE
#define MK_PER_PHASE 0
#endif

#ifndef PROBE_P3_PART
#define PROBE_P3_PART 0
#endif
#ifndef PROBE_ATT_VAR
#define PROBE_ATT_VAR -1
#endif
#ifndef BG_CONVERT
#define BG_CONVERT 1
#endif
#ifndef GAP_CONVERT
#define GAP_CONVERT 1
#endif
#ifndef PROBE_ATT_MODE
#define PROBE_ATT_MODE 0
#endif
#ifndef PROBE_REP_K
#define PROBE_REP_K -1
#endif
#define LAS __attribute__((address_space(3)))
#define GAS __attribute__((address_space(1)))
typedef unsigned short bf16;
typedef short bf16x8 __attribute__((ext_vector_type(8)));
typedef short s16x4 __attribute__((ext_vector_type(4)));
typedef float f32x4 __attribute__((ext_vector_type(4)));
typedef float f32x2 __attribute__((ext_vector_type(2)));
typedef float f32x16 __attribute__((ext_vector_type(16)));
typedef unsigned u32x4 __attribute__((ext_vector_type(4)));
typedef unsigned u32x2 __attribute__((ext_vector_type(2)));

constexpr int BATCH = 8, SEQ = 2048, DM = 1024, M = BATCH * SEQ, DEPTH = 2;
constexpr int NP = 3072;
constexpr int P_IN = 2988;
constexpr int C_AQ = 0, C_AK = 256, C_AV = 512, C_BQ = 768, C_BK = 1024, C_BV = 1280, C_CQ = 1536, C_CK = 1792, C_CV = 2048,
              C_DQ = 2304, C_DK = 2560, C_DV = 2624, C_IQ = 2688, C_IK = 2944, C_IW = 2976, C_AF = 2984;
constexpr int NEXP = 32, FF = 256, MAXSLOT = M * 2 + NEXP * 256, MAXTILE = MAXSLOT / 256;
constexpr float LOG2E = 1.4426950408889634f;
constexpr float RMS_EPS = 1e-6f;

constexpr size_t MiB = 1u << 20;
constexpr size_t WS_CTL = 0, CTL_ZERO_BYTES = 1 * MiB;
constexpr size_t WS_WR = 1 * MiB;
constexpr size_t WS_MOD = 2 * MiB;
constexpr size_t WS_CUM = 3 * MiB;
constexpr size_t WS_TOK = 4 * MiB;
constexpr size_t WS_MISC = 5 * MiB;
constexpr size_t WS_MASK = 6 * MiB;
constexpr size_t WS_WIN = 10 * MiB;
constexpr size_t WS_WOUT = 22 * MiB;
constexpr size_t WS_WUP = 26 * MiB;
constexpr size_t WS_WDN = 90 * MiB;
constexpr size_t WS_X1 = 122 * MiB;
constexpr size_t WS_H = 186 * MiB;
constexpr size_t WS_MIX = WS_H;

constexpr size_t WS_PROJ = 218 * MiB;
constexpr size_t WS_Y = WS_PROJ;
constexpr size_t WS_HID = WS_PROJ + 80 * MiB;
constexpr size_t WS_ELIST = 322 * MiB;
constexpr size_t WS_END = 324 * MiB;
constexpr int CW_AQ = 256;
constexpr int CW_CNT = 1024;
constexpr int CW_BAR = 8192;
constexpr int CW_DNQ = 208;
constexpr int CW_OPF = 98304;
constexpr int CW_UPF = 65536;

constexpr int RING_BYTES = 143360;
constexpr int LDSCTL_OFF = RING_BYTES, MISC_OFF = LDSCTL_OFF + 320, CNTS_OFF = LDSCTL_OFF + 512, BASE_OFF = LDSCTL_OFF + 640, TAB_OFF = LDSCTL_OFF + 768;
constexpr int ROWL_OFF = 131072;
constexpr int LDS_BYTES = 147456;
constexpr int NWAVES = 8;

#define LDS_WAIT() asm volatile("s_waitcnt lgkmcnt(0)" ::: "memory")
#define VM_WAIT() asm volatile("s_waitcnt vmcnt(0)" ::: "memory")
#define RLX_AGENT __ATOMIC_RELAXED, __HIP_MEMORY_SCOPE_AGENT

__device__ __forceinline__ float bf2f(unsigned short u) { return __builtin_bit_cast(float, (unsigned)u << 16); }
__device__ __forceinline__ unsigned f2bf(float f) { unsigned u = __builtin_bit_cast(unsigned, f); return (u + 0x7fffu + ((u >> 16) & 1u)) >> 16; }
__device__ __forceinline__ unsigned pk2(float lo, float hi) { typedef __bf16 bf16x2_t_ __attribute__((ext_vector_type(2))); f32x2 v = {lo, hi}; return __builtin_bit_cast(unsigned, __builtin_convertvector(v, bf16x2_t_)); }
template <int O> __device__ __forceinline__ float shx(float x) { static_assert(O >= 1 && O <= 16, "swizzle xor"); return __builtin_bit_cast(float, __builtin_amdgcn_ds_swizzle(__builtin_bit_cast(int, x), (O << 10) | 0x1f)); }
__device__ __forceinline__ float half_sum(float x) { return __builtin_bit_cast(float, __builtin_amdgcn_readlane(__builtin_bit_cast(int, x), 0)) + __builtin_bit_cast(float, __builtin_amdgcn_readlane(__builtin_bit_cast(int, x), 32)); }
__device__ __forceinline__ float half_max(float x) { return fmaxf(__builtin_bit_cast(float, __builtin_amdgcn_readlane(__builtin_bit_cast(int, x), 0)), __builtin_bit_cast(float, __builtin_amdgcn_readlane(__builtin_bit_cast(int, x), 32))); }
__device__ __forceinline__ float shup(float x, int o, int lane) { return __builtin_bit_cast(float, __builtin_amdgcn_ds_bpermute((lane - o) << 2, __builtin_bit_cast(int, x))); }
__device__ __forceinline__ int shup_i(int x, int o, int lane) { return __builtin_amdgcn_ds_bpermute((lane - o) << 2, x); }
template <int CTRL> __device__ __forceinline__ float dpp_get(float v) { return __builtin_bit_cast(float, __builtin_amdgcn_update_dpp(0, __builtin_bit_cast(int, v), CTRL, 0xF, 0xF, true)); }
__device__ __forceinline__ float row8_sum(float v) { v += dpp_get<0xB1>(v); v += dpp_get<0x4E>(v); v += dpp_get<0x141>(v); return v; }
__device__ __forceinline__ float row16_sum(float v) { v = row8_sum(v); v += dpp_get<0x140>(v); return v; }
__device__ __forceinline__ float row16_max(float v) { v = fmaxf(v, dpp_get<0xB1>(v)); v = fmaxf(v, dpp_get<0x4E>(v)); v = fmaxf(v, dpp_get<0x141>(v)); v = fmaxf(v, dpp_get<0x140>(v)); return v; }
__device__ __forceinline__ float rl_f(float v, int l) { return __builtin_bit_cast(float, __builtin_amdgcn_readlane(__builtin_bit_cast(int, v), l)); }
__device__ __forceinline__ float wave_sum(float v) { v = row16_sum(v); return (rl_f(v, 0) + rl_f(v, 16)) + (rl_f(v, 32) + rl_f(v, 48)); }
__device__ __forceinline__ float wave_max(float v) { v = row16_max(v); return fmaxf(fmaxf(rl_f(v, 0), rl_f(v, 16)), fmaxf(rl_f(v, 32), rl_f(v, 48))); }

namespace pg8 {
constexpr int BM = 256, BK = 64, HALF = 128, HTB = HALF * BK * 2, STAGE_BYTES = 8 * HTB, NXCD = 8, WGM = 8;
__host__ __device__ __forceinline__ int lds_byte(int r, int c) { const int st = (r >> 4) * 2 + (c >> 5), rr = r & 15, cc = c & 31, ob = rr * 64 + cc * 2; return st * 1024 + (ob ^ (((ob >> 9) & 1) << 5)); }
__host__ __device__ __forceinline__ void stage_rc(int b, int& R, int& C) { const int st = b / 1024, sb = b % 1024, swz = sb ^ (((sb >> 9) & 1) << 5); R = (st >> 1) * 16 + swz / 64; C = (st & 1) * 32 + (swz % 64) / 2; }
__host__ __device__ __forceinline__ int perm32(int rho) { const int n = rho >> 4, i = rho & 15; return 8 * (i >> 2) + 4 * n + (i & 3); }

struct Unit { int pm, pn; size_t bo; };
struct Gemm { const bf16* A; const bf16* Bt; int M, N, K; };

struct StaticOrder {
    int nM, nN, nwg, G, c;
    __host__ __device__ void init(int M_, int N_, int G_, int c_) { nM = M_ / BM; nN = N_ / BM; nwg = nM * nN; G = G_; c = c_; }
    __host__ __device__ __forceinline__ bool next(int i, Unit& u) const {
        const long L = (long)i * G + c; if (L >= nwg) return false;
        int wgid = (int)L; { const int q = nwg / NXCD, r = nwg % NXCD, xcd = wgid % NXCD, off = wgid / NXCD; wgid = (xcd < r ? xcd * (q + 1) : r * (q + 1) + (xcd - r) * q) + off; }
        const int nig = WGM * nN, gid = wgid / nig, fm = gid * WGM, gsz = (nM - fm) < WGM ? (nM - fm) : WGM;
        u.pm = fm + ((wgid % nig) % gsz); u.pn = (wgid % nig) / gsz; u.bo = 0; return true;
    }
};
struct GroupOrder {
    const LAS int* tab; int ntile, ncol, G, c; size_t ebytes;
    __device__ __forceinline__ bool next(int i, Unit& u) const {
        const long L = (long)i * G + c; if (L >= (long)ntile * ncol) return false;
        u.pm = (int)(L / ncol); u.pn = (int)(L % ncol);
        const int e = __builtin_amdgcn_readfirstlane(tab[u.pm]); u.bo = (size_t)e * ebytes; return true;
    }
};

struct OneUnit { Unit u; __device__ __forceinline__ bool next(int i, Unit& o) const { if (i != 0) return false; o = u; return true; } };
struct DynOrder {
    unsigned* dq; unsigned* upf; const LAS int* tab; volatile LAS unsigned* M; int nd; size_t ebytes; int tid; unsigned G;
    mutable unsigned ppop, pflag;
    __device__ __forceinline__ void issue(unsigned idnext) const {
        ppop = G + __builtin_amdgcn_atomic_inc32(dq, 0xFFFFFFFFu, __ATOMIC_RELAXED, "agent");
        pflag = 2u; if ((int)idnext < nd) pflag = __hip_atomic_load(upf + (idnext >> 2) * 16, __ATOMIC_RELAXED, __HIP_MEMORY_SCOPE_AGENT);
    }
    __device__ __forceinline__ void unit(int id, Unit& u) const { u.pm = id >> 2; u.pn = id & 3; u.bo = (size_t)__builtin_amdgcn_readfirstlane(tab[id >> 2]) * ebytes; }
    __device__ __forceinline__ bool next(int i, Unit& u) const {
        if (i == 0) { const int id = __builtin_amdgcn_readfirstlane((int)M[4]); if (id >= nd) return false; unit(id, u); return true; }
        if (tid == 0) {
            const unsigned idn = M[5]; const bool ready = (int)idn < nd && pflag >= 2u;
            M[6] = ready ? 1u : 0u;
            if (ready) { asm volatile("buffer_inv sc1" ::: "memory"); M[4] = idn; const unsigned idn2 = ppop; M[5] = idn2; issue(idn2); }
        }
        asm volatile("s_waitcnt lgkmcnt(0)\n\ts_barrier" ::: "memory");
        if (__builtin_amdgcn_readfirstlane((int)M[6]) == 0) return false;
        unit(__builtin_amdgcn_readfirstlane((int)M[4]), u); return true;
    }
};

__device__ __forceinline__ unsigned cvt_pk_bf16(float lo, float hi) { unsigned r; asm volatile("v_cvt_pk_bf16_f32 %0, %1, %2" : "=v"(r) : "v"(lo), "v"(hi)); return r; }

struct EpiBf16 {
    static constexpr bool PERM = true, PUBLISH = false;
    bf16* O; int ldc;
    __device__ __forceinline__ void operator()(const f32x4 (&acc)[2][2][4][2], const Unit& u, int wr, int wc, int fr, int fq) const {
        const int row0 = u.pm * BM + wr * 64 + fr; const int col0 = u.pn * BM + wc * 32 + 8 * fq;
#pragma unroll
        for (int ai = 0; ai < 2; ++ai)
#pragma unroll
            for (int m = 0; m < 4; ++m) { bf16* rowp = O + (size_t)(row0 + ai * HALF + m * 16) * ldc + col0;
#pragma unroll
                for (int bj = 0; bj < 2; ++bj) { const f32x4 v0 = acc[ai][bj][m][0], v1 = acc[ai][bj][m][1];
                    u32x4 w; w.x = cvt_pk_bf16(v0[0], v0[1]); w.y = cvt_pk_bf16(v0[2], v0[3]); w.z = cvt_pk_bf16(v1[0], v1[1]); w.w = cvt_pk_bf16(v1[2], v1[3]);
                    *(u32x4*)(rowp + bj * HALF) = w; } }
    }
};
struct EpiResGate {
    static constexpr bool PERM = true, PUBLISH = false;
    const float* base32; const bf16* base16; bf16* out; const float* gate;
    __device__ __forceinline__ void operator()(const f32x4 (&acc)[2][2][4][2], const Unit& u, int wr, int wc, int fr, int fq) const {
        const int col0 = u.pn * BM + wc * 32 + 8 * fq; const float* g = gate + (size_t)(u.pm >> 3) * 6144 + col0;
        f32x4 gv[2][2];
#pragma unroll
        for (int bj = 0; bj < 2; ++bj)
#pragma unroll
            for (int n = 0; n < 2; ++n) gv[bj][n] = *(const f32x4*)(g + bj * HALF + n * 4);
#pragma unroll
        for (int ai = 0; ai < 2; ++ai)
#pragma unroll
            for (int m = 0; m < 4; ++m) { const size_t off = (size_t)(u.pm * BM + ai * HALF + wr * 64 + m * 16 + fr) * DM + col0;
#pragma unroll
                for (int bj = 0; bj < 2; ++bj) { f32x4 b0, b1;
                    if (base32) { b0 = *(const f32x4*)(base32 + off + bj * HALF); b1 = *(const f32x4*)(base32 + off + bj * HALF + 4); }
                    else { const u32x4 r = *(const u32x4*)(base16 + off + bj * HALF);
                        b0 = (f32x4){bf2f(r.x & 0xffff), bf2f(r.x >> 16), bf2f(r.y & 0xffff), bf2f(r.y >> 16)}; b1 = (f32x4){bf2f(r.z & 0xffff), bf2f(r.z >> 16), bf2f(r.w & 0xffff), bf2f(r.w >> 16)}; }
                    const f32x4 v0 = b0 + gv[bj][0] * acc[ai][bj][m][0], v1 = b1 + gv[bj][1] * acc[ai][bj][m][1];
                    u32x4 w; w.x = cvt_pk_bf16(v0[0], v0[1]); w.y = cvt_pk_bf16(v0[2], v0[3]); w.z = cvt_pk_bf16(v1[0], v1[1]); w.w = cvt_pk_bf16(v1[2], v1[3]);
                    *(u32x4*)(out + off + bj * HALF) = w; } }
    }
};
struct EpiSwiglu {
    static constexpr bool PERM = true, PUBLISH = true;
    bf16* O; unsigned* flag;
    __device__ __forceinline__ void operator()(const f32x4 (&acc)[2][2][4][2], const Unit& u, int wr, int wc, int fr, int fq) const {
        const int row0 = u.pm * BM + wr * 64 + fr; const int col0 = u.pn * HALF + wc * 32 + 8 * fq;
#pragma unroll
        for (int ai = 0; ai < 2; ++ai)
#pragma unroll
            for (int m = 0; m < 4; ++m) { bf16* rowp = O + (size_t)(row0 + ai * HALF + m * 16) * FF + col0;
                float hv[8];
#pragma unroll
                for (int n = 0; n < 2; ++n)
#pragma unroll
                    for (int i = 0; i < 4; ++i) { const float a = acc[ai][0][m][n][i], b = acc[ai][1][m][n][i];
                        const float sg = __builtin_amdgcn_rcpf(1.f + __builtin_amdgcn_exp2f(-a * LOG2E)); hv[n * 4 + i] = a * sg * b; }
                u32x4 w; w.x = cvt_pk_bf16(hv[0], hv[1]); w.y = cvt_pk_bf16(hv[2], hv[3]); w.z = cvt_pk_bf16(hv[4], hv[5]); w.w = cvt_pk_bf16(hv[6], hv[7]);
                asm volatile("global_store_dwordx4 %0, %1, off sc1\n\ts_nop 2" :: "v"((const GAS bf16*)rowp), "v"(w) : "memory"); }
    }
};

template <class Epi, class Sched, bool ALIGN_EPI = false, bool SP2 = false, bool GATHER = false>
__device__ __forceinline__ void gemm_phase(LAS unsigned char* lds, const Gemm g, const Sched& S, const Epi& E, const int tid, const LAS int* rowl = nullptr) {
    static_assert(!GATHER || SP2, "gather mode is written for the SP2 loop");
    const int wid = __builtin_amdgcn_readfirstlane(tid >> 6), lane = tid & 63, wr = wid >> 2, wc = wid & 3, fr = lane & 15, fq = lane >> 4;
    const int K = g.K, nt = K / BK;
    unsigned voffA[2], voffB[2];
#pragma unroll
    for (int i = 0; i < 2; ++i) { int R, C; stage_rc(tid * 16 + i * 8192, R, C); const int Rb = Epi::PERM ? ((R & ~31) + perm32(R & 31)) : R;
        voffA[i] = (unsigned)(R * K + C) * 2u; voffB[i] = (unsigned)(Rb * K + C) * 2u; }
    const size_t kstep = (size_t)(BK * 2);
    const size_t hstep = (size_t)HALF * K * 2;
    const size_t tstep = 2 * hstep;
    const size_t hstepA = GATHER ? 0 : hstep, tstepA = GATHER ? 0 : tstep;
    unsigned voffGc[2][2], voffGn[2][2];
    int gR[2], gC[2];
#pragma unroll
    for (int i = 0; i < 2; ++i) stage_rc(tid * 16 + i * 8192, gR[i], gC[i]);
#define PG8_GOFF(dst, ui_) do { _Pragma("unroll") for (int h_ = 0; h_ < 2; ++h_) _Pragma("unroll") for (int i_ = 0; i_ < 2; ++i_) \
        dst[h_][i_] = (unsigned)rowl[(ui_) * 256 + h_ * HALF + gR[i_]] * (unsigned)(K * 2) + (unsigned)gC[i_] * 2u; } while (0)
    const unsigned ldsw = (unsigned)wid * 1024u;
    const int aoff = lds_byte(wr * 64 + fr, fq * 8), boff = lds_byte(wc * 32 + fr, fq * 8);
#define PG8_SA(b, h) (((b) * 2 + (h)) * HTB)
#define PG8_SB(b, h) ((4 + (b) * 2 + (h)) * HTB)
#define PG8_STAGE(bufoff, gbase, voff) do { _Pragma("unroll") for (int _i = 0; _i < 2; ++_i) \
        __builtin_amdgcn_global_load_lds((const unsigned*)((const char*)(gbase) + (voff)[_i]), (LAS unsigned*)(lds + (bufoff) + ldsw + _i * 8192), 16, 0, 0); } while (0)
#define PG8_STAGE_A(bufoff, gbase, H, NXT) do { if constexpr (GATHER) { unsigned vo_[2]; vo_[0] = (NXT) ? voffGn[H][0] : voffGc[H][0]; vo_[1] = (NXT) ? voffGn[H][1] : voffGc[H][1]; PG8_STAGE(bufoff, gbase, vo_); } \
        else { PG8_STAGE(bufoff, (const char*)(gbase) + (H) * hstep, voffA); } } while (0)
#define PG8_LDA(dst, b, h) do { _Pragma("unroll") for (int m = 0; m < 4; ++m) _Pragma("unroll") for (int k = 0; k < 2; ++k) dst[m][k] = *(const LAS bf16x8*)(lds + PG8_SA(b, h) + aoff + m * 2048 + k * 1024); } while (0)
#define PG8_LDB(dst, b, h) do { _Pragma("unroll") for (int n = 0; n < 2; ++n) _Pragma("unroll") for (int k = 0; k < 2; ++k) dst[n][k] = *(const LAS bf16x8*)(lds + PG8_SB(b, h) + boff + n * 2048 + k * 1024); } while (0)
#define PG8_MMA(ai, bj, At, Bt) do { __builtin_amdgcn_s_setprio(1); _Pragma("unroll") for (int m = 0; m < 4; ++m) _Pragma("unroll") for (int n = 0; n < 2; ++n) _Pragma("unroll") for (int k = 0; k < 2; ++k) \
        acc[ai][bj][m][n] = __builtin_amdgcn_mfma_f32_16x16x32_bf16(Bt[n][k], At[m][k], acc[ai][bj][m][n], 0, 0, 0); __builtin_amdgcn_s_setprio(0); } while (0)
#define PG8_WAIT_V(n) asm volatile("s_waitcnt vmcnt(" #n ")" ::: "memory")
#define PG8_WAIT_L(n) asm volatile("s_waitcnt lgkmcnt(" #n ")" ::: "memory")
#define PG8_BAR __builtin_amdgcn_s_barrier()
#define PG8_SCHED __builtin_amdgcn_sched_barrier(0)
    Unit cur, nxt; int ui = 0;
    if (!S.next(0, cur)) return;
    f32x4 acc[2][2][4][2];
#pragma unroll
    for (int a = 0; a < 2; ++a)
#pragma unroll
        for (int b = 0; b < 2; ++b)
#pragma unroll
            for (int m = 0; m < 4; ++m)
#pragma unroll
                for (int n = 0; n < 2; ++n) acc[a][b][m][n] = (f32x4){0.f, 0.f, 0.f, 0.f};
    bf16x8 At[4][2], B0[2][2], B1[2][2];
    const char* cA = (const char*)g.A + (size_t)cur.pm * tstepA; const char* cB = (const char*)g.Bt + cur.bo + (size_t)cur.pn * tstep;
    if constexpr (GATHER) { PG8_GOFF(voffGc, 0); PG8_GOFF(voffGn, 0); }
    if constexpr (SP2) {
        PG8_STAGE(PG8_SB(0, 0), cB, voffB); PG8_STAGE(PG8_SB(0, 1), cB + hstep, voffB); PG8_STAGE_A(PG8_SA(0, 0), cA, 0, false); PG8_STAGE_A(PG8_SA(0, 1), cA, 1, false);
        if (wr == 1) PG8_BAR;
        PG8_WAIT_V(2); PG8_BAR;
        PG8_STAGE(PG8_SB(1, 0), cB + kstep, voffB); PG8_STAGE_A(PG8_SA(1, 0), cA + kstep, 0, false); PG8_STAGE(PG8_SB(1, 1), cB + hstep + kstep, voffB);
        PG8_WAIT_V(6); PG8_BAR;
    } else {
        PG8_STAGE(PG8_SB(0, 0), cB, voffB); PG8_STAGE(PG8_SA(0, 0), cA, voffA); PG8_STAGE(PG8_SB(0, 1), cB + hstep, voffB); PG8_STAGE(PG8_SA(0, 1), cA + hstep, voffA);
        if (wr == 1) PG8_BAR;
        PG8_WAIT_V(4); PG8_BAR;
        PG8_STAGE(PG8_SB(1, 0), cB + kstep, voffB); PG8_STAGE(PG8_SA(1, 0), cA + kstep, voffA); PG8_STAGE(PG8_SB(1, 1), cB + hstep + kstep, voffB);
        PG8_WAIT_V(6); PG8_BAR;
    }
    for (;;) {
        const bool has_next = S.next(ui + 1, nxt);
        if constexpr (GATHER) { if (has_next) PG8_GOFF(voffGn, ui + 1); }
        const char* nA = has_next ? (const char*)g.A + (size_t)nxt.pm * tstepA : cA; const char* nB = has_next ? (const char*)g.Bt + nxt.bo + (size_t)nxt.pn * tstep : cB;
#pragma unroll 1
        for (int t = 0; t < nt; t += 2) {
            const bool last = (t == nt - 2);
            const char* a1 = cA + (size_t)(t + 1) * kstep;
            const char* a2 = last ? nA : cA + (size_t)(t + 2) * kstep; const char* b2 = last ? nB : cB + (size_t)(t + 2) * kstep;
            const char* a3 = a2 + kstep; const char* b3 = b2 + kstep;
            if constexpr (SP2) {
            PG8_LDB(B0, 0, 0); PG8_LDB(B1, 0, 1); PG8_SCHED; PG8_LDA(At, 0, 0); PG8_STAGE_A(PG8_SA(1, 1), a1, 1, false);
            PG8_WAIT_V(8); PG8_WAIT_L(0); PG8_BAR; PG8_MMA(0, 0, At, B0); PG8_MMA(0, 1, At, B1); PG8_BAR; PG8_SCHED;
            PG8_LDA(At, 0, 1); PG8_STAGE(PG8_SB(0, 0), b2, voffB); PG8_STAGE(PG8_SB(0, 1), b2 + hstep, voffB); PG8_STAGE_A(PG8_SA(0, 0), a2, 0, last);
            PG8_WAIT_V(8); PG8_WAIT_L(0); PG8_BAR; PG8_MMA(1, 0, At, B0); PG8_MMA(1, 1, At, B1); PG8_BAR; PG8_SCHED;
            PG8_LDB(B0, 1, 0); PG8_LDB(B1, 1, 1); PG8_SCHED; PG8_LDA(At, 1, 0); PG8_STAGE_A(PG8_SA(0, 1), a2, 1, last);
            PG8_WAIT_V(8); PG8_WAIT_L(0); PG8_BAR; PG8_MMA(0, 0, At, B0); PG8_MMA(0, 1, At, B1); PG8_BAR; PG8_SCHED;
            PG8_LDA(At, 1, 1); PG8_STAGE(PG8_SB(1, 0), b3, voffB); PG8_STAGE(PG8_SB(1, 1), b3 + hstep, voffB); PG8_STAGE_A(PG8_SA(1, 0), a3, 0, last);
            PG8_WAIT_V(8); PG8_WAIT_L(0); PG8_BAR; PG8_MMA(1, 0, At, B0); PG8_MMA(1, 1, At, B1); PG8_BAR; PG8_SCHED;
            } else {
            PG8_LDB(B0, 0, 0); PG8_SCHED; PG8_LDA(At, 0, 0); PG8_STAGE(PG8_SA(1, 1), a1 + hstep, voffA);
            PG8_WAIT_L(8); PG8_BAR; PG8_WAIT_L(0); PG8_MMA(0, 0, At, B0); PG8_BAR; PG8_SCHED;
            PG8_LDB(B1, 0, 1); PG8_STAGE(PG8_SB(0, 0), b2, voffB);
            PG8_BAR; PG8_WAIT_L(0); PG8_MMA(0, 1, At, B1); PG8_BAR;
            PG8_LDA(At, 0, 1); PG8_STAGE(PG8_SA(0, 0), a2, voffA);
            PG8_BAR; PG8_WAIT_L(0); PG8_MMA(1, 0, At, B0); PG8_BAR; PG8_SCHED;
            PG8_STAGE(PG8_SB(0, 1), b2 + hstep, voffB);
            PG8_WAIT_V(6); PG8_BAR; PG8_MMA(1, 1, At, B1); PG8_BAR;
            PG8_LDB(B0, 1, 0); PG8_SCHED; PG8_LDA(At, 1, 0); PG8_STAGE(PG8_SA(0, 1), a2 + hstep, voffA);
            PG8_WAIT_L(8); PG8_BAR; PG8_WAIT_L(0); PG8_MMA(0, 0, At, B0); PG8_BAR; PG8_SCHED;
            PG8_LDB(B1, 1, 1); PG8_STAGE(PG8_SB(1, 0), b3, voffB);
            PG8_BAR; PG8_WAIT_L(0); PG8_MMA(0, 1, At, B1); PG8_BAR;
            PG8_LDA(At, 1, 1); PG8_STAGE(PG8_SA(1, 0), a3, voffA);
            PG8_BAR; PG8_WAIT_L(0); PG8_MMA(1, 0, At, B0); PG8_BAR; PG8_SCHED;
            PG8_STAGE(PG8_SB(1, 1), b3 + hstep, voffB);
            PG8_WAIT_V(6); PG8_BAR; PG8_MMA(1, 1, At, B1); PG8_BAR;
            }
        }
        if constexpr (ALIGN_EPI) { if (wr == 0) PG8_BAR; }
        E(acc, cur, wr, wc, fr, fq);
        if constexpr (Epi::PUBLISH) {
            asm volatile("s_waitcnt vmcnt(0)" ::: "memory"); PG8_BAR;
            if (tid == 0) __hip_atomic_fetch_add(E.flag + cur.pm * 16, 1u, __ATOMIC_RELAXED, __HIP_MEMORY_SCOPE_AGENT);
        }
        if (!has_next) break;
#pragma unroll
        for (int a = 0; a < 2; ++a)
#pragma unroll
            for (int b = 0; b < 2; ++b)
#pragma unroll
                for (int m = 0; m < 4; ++m)
#pragma unroll
                    for (int n = 0; n < 2; ++n) acc[a][b][m][n] = (f32x4){0.f, 0.f, 0.f, 0.f};
        cur = nxt; cA = nA; cB = nB; ++ui;
        if constexpr (GATHER) { _Pragma("unroll") for (int h_ = 0; h_ < 2; ++h_) _Pragma("unroll") for (int i_ = 0; i_ < 2; ++i_) voffGc[h_][i_] = voffGn[h_][i_]; }
        if constexpr (ALIGN_EPI) { if (wr == 1) PG8_BAR; }
    }
    PG8_WAIT_V(0);
    if constexpr (!ALIGN_EPI) { if (wr == 0) PG8_BAR; }
    PG8_BAR;
#undef PG8_SA
#undef PG8_STAGE_A
#undef PG8_GOFF
#undef PG8_SB
#undef PG8_STAGE
#undef PG8_LDA
#undef PG8_LDB
#undef PG8_MMA
#undef PG8_WAIT_V
#undef PG8_WAIT_L
#undef PG8_BAR
#undef PG8_SCHED
}
}

#define XB_TMO      128
#define XB_XCNT(j)  (256  + 64 * (j))
#define XB_XSUB(j)  (1280 + 64 * (j))
#define XB_XGEN(j)  (2304 + 64 * (j))
#define XB_TOP      3328
#define XB_TOPGEN   3392
#define XCD_BAR_WORDS 3456
#define XB_SPIN_CAP (1u << 18)
__device__ __forceinline__ unsigned xb_ld(unsigned* p)              { return __hip_atomic_load(p, __ATOMIC_RELAXED, __HIP_MEMORY_SCOPE_AGENT); }
__device__ __forceinline__ unsigned xb_add(unsigned* p, unsigned v) { return __hip_atomic_fetch_add(p, v, __ATOMIC_RELAXED, __HIP_MEMORY_SCOPE_AGENT); }
__device__ __forceinline__ unsigned xb_xcc_id() { return (unsigned)__builtin_amdgcn_s_getreg((3 << 11) | 20) & 0xFu; }
#define XB_SPIN(cond, bar) do { unsigned _sp = 0; while (cond) { __builtin_amdgcn_s_sleep(1); \
    if ((++_sp & 255u) == 0u) { if (xb_ld(&(bar)[XB_TMO])) break; if (_sp > XB_SPIN_CAP) { atomicAdd(&(bar)[XB_TMO], 1u); break; } } } } while (0)
struct XcdBarrier { unsigned* bar; unsigned x; volatile LAS unsigned* st; };
__device__ __forceinline__ XcdBarrier xcd_barrier_post(unsigned* bar, volatile LAS unsigned* st) {
    XcdBarrier b; b.bar = bar; b.x = xb_xcc_id(); b.st = st;
    if (threadIdx.x == 0) (void)xb_add(&bar[XB_XCNT(b.x)], 1u);
    return b;
}
__device__ __forceinline__ void xcd_barrier_complete(unsigned* bar, unsigned x, unsigned& nloc, unsigned& nx) {
    const unsigned G = gridDim.x * gridDim.y * gridDim.z;
    unsigned sum, cnt, mine, sp = 0u;
    for (;;) {
        sum = 0u; cnt = 0u; mine = 0u;
#pragma unroll 1
        for (unsigned j = 0; j < 16; ++j) { const unsigned c = xb_ld(&bar[XB_XCNT(j)]); sum += c; cnt += (c > 0u) ? 1u : 0u; mine = (j == x) ? c : mine; }
        if (sum == G) break;
        __builtin_amdgcn_s_sleep(1);
        if ((++sp & 255u) == 0u) { if (xb_ld(&bar[XB_TMO])) break; if (sp > XB_SPIN_CAP) { atomicAdd(&bar[XB_TMO], 1u); break; } }
    }
    nloc = mine > 0u ? mine : 1u; nx = cnt > 0u ? cnt : 1u;
}
__device__ __forceinline__ void xcd_barrier(const XcdBarrier& b, const int tid) {
    asm volatile("s_waitcnt vmcnt(0)" ::: "memory");
    __syncthreads();
    if (tid == 0) {
        unsigned* bar = b.bar;
        __builtin_amdgcn_s_waitcnt(0);
        unsigned nloc = b.st[0], nx = b.st[1];
        if (nloc == 0u) { xcd_barrier_complete(bar, b.x, nloc, nx); b.st[0] = nloc; b.st[1] = nx; }
        const unsigned old = xb_add(&bar[XB_XSUB(b.x)], 1u);
        const unsigned gen = old / nloc;
        if (old + 1u == (gen + 1u) * nloc) {
            __builtin_amdgcn_fence(__ATOMIC_RELEASE, "agent");
            asm volatile("s_waitcnt vmcnt(0)" ::: "memory");
            const unsigned og = xb_add(&bar[XB_TOP], 1u);
            const unsigned tg = og / nx;
            if (og + 1u == (tg + 1u) * nx) xb_add(&bar[XB_TOPGEN], 1u);
            else XB_SPIN(xb_ld(&bar[XB_TOPGEN]) == tg, bar);
            __builtin_amdgcn_fence(__ATOMIC_ACQUIRE, "agent");
            xb_add(&bar[XB_XGEN(b.x)], 1u);
            asm volatile("s_waitcnt vmcnt(0)" ::: "memory");
        } else {
            XB_SPIN(xb_ld(&bar[XB_XGEN(b.x)]) == gen, bar);
            __builtin_amdgcn_fence(__ATOMIC_ACQUIRE, "agent");
            asm volatile("s_waitcnt vmcnt(0)" ::: "memory");
        }
    }
    __syncthreads();
}

struct Frame {
    LAS unsigned char* lds;
    volatile LAS unsigned* MISC;
    unsigned* ctl;
    int tid, lane, wave, vcu, G, bx;
    float* out; unsigned char* ws;
};
struct Args { const float* in[28]; float* out; unsigned char* ws; int ph_lo, ph_hi; };
enum { I_X = 0, I_C, I_ADAW, I_ADAB, I_N1G, I_N2G, I_WIN, I_BF, I_QNA, I_KNA, I_QNC, I_KNC, I_LQ1, I_LK1, I_LQ2, I_LK2, I_SUBLN, I_QND, I_KND, I_MIXB, I_WOUT,
       I_WG, I_BG, I_WE, I_BE, I_W1, I_W3, I_W2 };
template <int I> __device__ __forceinline__ const float* inp() {
    auto ka = __builtin_amdgcn_kernarg_segment_ptr(); unsigned long long raw;
    asm volatile("s_load_dwordx2 %0, %1, %2\n\ts_waitcnt lgkmcnt(0)" : "=s"(raw) : "s"(ka), "i"(I * 8));
    return (const float*)(const GAS float*)raw;
}


struct TItem { const float* W; bf16* WT; const float* rs; int ldw, K, dst_row0, src_n0, kb, mapin; };
__device__ __forceinline__ int colmap_in(int n) { return n < 768 ? n : (n < 2984 ? n + 4 : (n < 2988 ? n - 2984 + 768 : -1)); }
__device__ __forceinline__ void t_load(const TItem& T, f32x4 (&v)[8], int lane) {
    const int k0 = 64 * T.kb, r8 = lane >> 3, c4 = (lane & 7) * 4; const int sc = T.mapin ? colmap_in(T.src_n0 + c4) : T.src_n0 + c4;
#pragma unroll
    for (int i = 0; i < 8; ++i) { v[i] = (f32x4){0.f, 0.f, 0.f, 0.f}; if (sc >= 0) v[i] = *(const f32x4*)(T.W + (size_t)(k0 + 8 * r8 + i) * T.ldw + sc); }
}
__device__ __forceinline__ void t_store(const TItem& T, f32x4 (&v)[8], LAS float* scr, int lane) {
    (void)scr;
    const int k0 = 64 * T.kb, r8 = lane >> 3, c4 = (lane & 7) * 4;
    if (T.rs) {
#pragma unroll
        for (int i = 0; i < 8; ++i) v[i] = v[i] * T.rs[k0 + 8 * r8 + i]; }
#pragma unroll
    for (int c = 0; c < 4; ++c) { u32x4 o; o.x = pg8::cvt_pk_bf16(v[0][c], v[1][c]); o.y = pg8::cvt_pk_bf16(v[2][c], v[3][c]); o.z = pg8::cvt_pk_bf16(v[4][c], v[5][c]); o.w = pg8::cvt_pk_bf16(v[6][c], v[7][c]);
        *(GAS u32x4*)(T.WT + (size_t)(T.dst_row0 + c4 + c) * T.K + k0 + 8 * r8) = o; }
}
__device__ __forceinline__ float lambda_init(int l) { return l == 0 ? 0.2f : (0.8f - 0.6f * 0.7408182206817179f); }

constexpr int CI_IN = 16 * 96, CI_OUT = 16 * 32, CI_UP1 = 16 * 8, CI_DN = 4 * 32, CN_UP = 32 * 2 * CI_UP1, CN_DN = 32 * CI_DN, NITEMS_L = CI_IN + CI_OUT + CN_UP + CN_DN;
__device__ __forceinline__ void fill_rowscale(Frame& F, const Args& A, int l, LAS float* rsl) {
    for (int k = F.tid; k < DM; k += 512) { float v = inp<I_MIXB>()[l * DM + k];
        if (k >= 512 && k < 768) v *= inp<I_SUBLN>()[l * 64 + ((k - 512) & 63)] * (1.f - lambda_init(l)); rsl[k] = v; }
}
__device__ __forceinline__ void convert_items(Frame& F, const Args& A, int l, int first, int stride, int limit, LAS float* rsl) {
    LAS float* scr = (LAS float*)(F.lds + F.wave * 8704);
    bf16* WIN = (bf16*)(F.ws + WS_WIN); bf16* WOUT = (bf16*)(F.ws + WS_WOUT); bf16* WUP = (bf16*)(F.ws + WS_WUP); bf16* WDN = (bf16*)(F.ws + WS_WDN);
    auto decode = [&](int it, TItem& T) {
        int r = it; T.rs = nullptr; T.mapin = 0;
        if (r < CI_IN) { T.kb = r / 96; const int nb = r % 96;
            T.W = inp<I_WIN>() + (size_t)l * DM * P_IN; T.ldw = P_IN; T.K = DM; T.WT = WIN + (size_t)l * NP * DM; T.dst_row0 = 32 * nb; T.src_n0 = 32 * nb; T.mapin = 1; return; }
        r -= CI_IN;
        if (r < CI_OUT) { T.kb = r / 32; const int nb = r % 32;
            T.W = inp<I_WOUT>() + (size_t)l * DM * DM; T.ldw = DM; T.K = DM; T.WT = WOUT + (size_t)l * DM * DM; T.dst_row0 = 32 * nb; T.src_n0 = 32 * nb; T.rs = (const float*)rsl; return; }
        r -= CI_OUT;
        if (r < CN_UP) { const int le = l * 32 + r / (2 * CI_UP1), q = r % (2 * CI_UP1), which = q / CI_UP1, q2 = q % CI_UP1; T.kb = q2 / 8; const int nb = q2 % 8;
            T.W = (which == 0 ? inp<I_W1>() : inp<I_W3>()) + (size_t)le * DM * FF; T.ldw = FF; T.K = DM; T.WT = WUP + (size_t)le * 512 * DM;
            const int n0 = 32 * nb, pn = n0 >> 7, j = n0 & 127; T.dst_row0 = 256 * pn + 128 * which + j; T.src_n0 = n0; return; }
        r -= CN_UP;
        { const int le = l * 32 + r / CI_DN, q = r % CI_DN; T.kb = q / 32; const int nb = q % 32;
          T.W = inp<I_W2>() + (size_t)le * FF * DM; T.ldw = DM; T.K = FF; T.WT = WDN + (size_t)le * DM * FF; T.dst_row0 = 32 * nb; T.src_n0 = 32 * nb; }
    };
    TItem T0, T1, T2; f32x4 v0[8], v1[8], v2[8]; int it = first;
    if (it < limit) { decode(it, T0); t_load(T0, v0, F.lane); }
    if (it + stride < limit) { decode(it + stride, T1); t_load(T1, v1, F.lane); }
    while (it < limit) {
        if (it + 2 * stride < limit) { decode(it + 2 * stride, T2); t_load(T2, v2, F.lane); }
        t_store(T0, v0, scr, F.lane); it += stride; if (it >= limit) break;
        if (it + 2 * stride < limit) { decode(it + 2 * stride, T0); t_load(T0, v0, F.lane); }
        t_store(T1, v1, scr, F.lane); it += stride; if (it >= limit) break;
        if (it + 2 * stride < limit) { decode(it + 2 * stride, T1); t_load(T1, v1, F.lane); }
        t_store(T2, v2, scr, F.lane); it += stride;
    }
}
constexpr int CV_L0 = NITEMS_L - CI_IN, CV_TOTAL = CV_L0 + NITEMS_L, CV_CHUNK = 64, CW_CVQ = 192;
__device__ __forceinline__ void convert_chunk(Frame& F, const Args& A, int gbase, LAS float* rsl2  ) {
    const int g0 = gbase + F.wave * (CV_CHUNK / NWAVES);
#pragma unroll 1
    for (int l = 0; l < 2; ++l) {
        const int lo = g0 > (l ? CV_L0 : 0) ? g0 : (l ? CV_L0 : 0), hi0 = g0 + CV_CHUNK / NWAVES, hi = hi0 < (l ? CV_TOTAL : CV_L0) ? hi0 : (l ? CV_TOTAL : CV_L0);
        if (lo < hi) { const int off = l ? -CV_L0 : CI_IN; convert_items(F, A, l, lo + off, 1, hi + off, rsl2 + l * DM); }
    }
}
__device__ __forceinline__ void convert_layer1_in_gap(Frame& F, const Args& A, int n2  ) {
    LAS float* rsl = (LAS float*)(F.lds + 8 * 8704);
    if (n2 < 0) n2 = 0; if (n2 > F.G - 32) n2 = F.G - 32;
    if (F.bx < n2) return;
    fill_rowscale(F, A, 1, rsl);
    __syncthreads();
    const int nw = (F.G - n2) * NWAVES;
    convert_items(F, A, 1, (F.bx - n2) * NWAVES + F.wave, nw, NITEMS_L, rsl);
    __syncthreads();
}

__device__ __forceinline__ void p0_prologue(Frame& F, const Args& A) {
    LAS float* rsl = (LAS float*)(F.lds + 8 * 8704);
    fill_rowscale(F, A, 0, rsl);
    __syncthreads();
    const int gw = F.vcu * NWAVES + F.wave, NGW = F.G * NWAVES;
    convert_items(F, A, 0, gw, NGW, BG_CONVERT ? CI_IN : NITEMS_L, rsl);
    if (!GAP_CONVERT && !BG_CONVERT) { __syncthreads(); fill_rowscale(F, A, 1, rsl); __syncthreads(); convert_items(F, A, 1, gw, NGW, NITEMS_L, rsl); }
    { bf16* WRH = (bf16*)(F.ws + WS_WR); bf16* WRL = WRH + 2 * 48 * DM;
      for (int i = gw * 64 + F.lane; i < 2 * 48 * DM; i += NGW * 64) { const int l = i / (48 * DM), r = i % (48 * DM), o = r >> 10, k = r & 1023;
          float w = 0.f; if (o < 4) w = inp<I_WG>()[((size_t)l * DM + k) * 4 + o]; else if (o < 36) w = inp<I_WE>()[((size_t)l * DM + k) * 32 + (o - 4)];
          const unsigned hi = f2bf(w); WRH[i] = (bf16)hi; WRL[i] = (bf16)f2bf(w - bf2f((unsigned short)hi)); } }
    if (F.bx == 0 && F.wave == 0) {
        for (int l = 0; l < 2; ++l) { float a = 0.f, b = 0.f; if (F.lane < 32) { a = inp<I_LQ1>()[l * 32 + F.lane] * inp<I_LK1>()[l * 32 + F.lane]; b = inp<I_LQ2>()[l * 32 + F.lane] * inp<I_LK2>()[l * 32 + F.lane]; }
            a = wave_sum(a); b = wave_sum(b); if (F.lane == 0) ((float*)(F.ws + WS_MISC))[l] = __expf(a) - __expf(b) + lambda_init(l); }
    }
    __syncthreads();
    LAS float* cact = (LAS float*)F.lds;
    LAS float* red = (LAS float*)(F.lds + 32768);
    { float cv_[16];
#pragma unroll
      for (int k = 0; k < 16; ++k) cv_[k] = inp<I_C>()[F.tid + 512 * k];
#pragma unroll
      for (int k = 0; k < 16; ++k) cact[F.tid + 512 * k] = cv_[k] * __builtin_amdgcn_rcpf(1.f + __expf(-cv_[k])); }
    __syncthreads();
    for (int item = F.bx; item < 256; item += F.G) {
        const int l = item >> 7, ks = (item >> 3) & 15, nb = item & 7;
        const int half = F.lane / 24, cl = F.lane % 24; const bool act = F.lane < 48;
        const int c0 = nb * 768 + 96 * F.wave + 4 * cl;
        const float* aw = inp<I_ADAW>() + (size_t)l * DM * 6144 + (size_t)(ks * 64 + half) * 6144 + c0;
        f32x4 acc[8];
#pragma unroll
        for (int b = 0; b < 8; ++b) acc[b] = (f32x4){0.f, 0.f, 0.f, 0.f};
#pragma unroll 1
        for (int i0 = 0; i0 < 32; i0 += 16) {
            f32x4 wv[16];
#pragma unroll
            for (int i = 0; i < 16; ++i) { wv[i] = (f32x4){0.f, 0.f, 0.f, 0.f}; if (act) wv[i] = *(const f32x4*)(aw + (size_t)(2 * (i0 + i)) * 6144); }
#pragma unroll
            for (int i = 0; i < 16; ++i) { const int k = ks * 64 + 2 * (i0 + i) + (act ? half : 0);
#pragma unroll
                for (int b = 0; b < 8; ++b) acc[b] = acc[b] + cact[b * DM + k] * wv[i]; }
        }
        float* PART = (float*)(F.ws + WS_PROJ);
#pragma unroll
        for (int b = 0; b < 8; ++b) { f32x4 o;
#pragma unroll
            for (int c = 0; c < 4; ++c) { float x = acc[b][c]; asm volatile("" : "+v"(x));
                float y = __builtin_bit_cast(float, __builtin_amdgcn_ds_bpermute(((F.lane + 24) & 63) << 2, __builtin_bit_cast(int, x))); asm volatile("" : "+v"(y)); o[c] = x + y; }
            if (F.lane < 24) *(f32x4*)(PART + ((size_t)((l * 16 + ks) * 8 + b)) * 6144 + c0) = o; }
    }
}

__device__ __forceinline__ void build_tables(Frame& F, int l) {
    volatile LAS int* cnts = (volatile LAS int*)(F.lds + CNTS_OFF); volatile LAS int* base = (volatile LAS int*)(F.lds + BASE_OFF); volatile LAS int* tab = (volatile LAS int*)(F.lds + TAB_OFF);
    __syncthreads();
    if (F.tid < 64) {
        const int e = F.tid; int cnt = 0; if (e < 32) cnt = (int)__hip_atomic_load(F.ctl + CW_CNT + (l * 32 + e) * 16, RLX_AGENT);
        const int n = (cnt + 255) >> 8; int incl = n;
#pragma unroll
        for (int o = 1; o < 32; o <<= 1) { const int u = shup_i(incl, o, e); if (e >= o) incl += u; }
        const int t0 = incl - n;
        if (e < 32) { cnts[e] = cnt; base[e] = t0; for (int j = 0; j < n && t0 + j < MAXTILE; ++j) tab[t0 + j] = e; }
        if (e == 31) F.MISC[1] = (unsigned)(incl < MAXTILE ? incl : MAXTILE);
    }
    __syncthreads();
}
__device__ __forceinline__ void row_pass(Frame& F, const Args& A, int mode, int l) {
    const int gw = F.vcu * NWAVES + F.wave; const int lane = F.lane;
    const float* MOD = (const float*)(F.ws + WS_MOD);
    bf16* X1 = (bf16*)(F.ws + WS_X1); bf16* H = (bf16*)(F.ws + WS_H); const bf16* Y = (const bf16*)(F.ws + WS_Y);
    const int* tok_e = (const int*)(F.ws + WS_TOK); const int* tok_pos = (const int*)(F.ws + WS_TOK) + 4 * M; const float* tok_w = (const float*)(F.ws + WS_TOK) + 2 * M;
    volatile LAS int* basel = (volatile LAS int*)(F.lds + BASE_OFF);
    int pe_a[4], pe_b[4], pp_a[4], pp_b[4]; float pw_a[4], pw_b[4];
    const auto ldtok = [&](int m0) {
#pragma unroll
        for (int r = 0; r < 4; ++r) { const int m = m0 + r; pe_a[r] = tok_e[m]; pe_b[r] = tok_e[M + m]; pp_a[r] = tok_pos[m]; pp_b[r] = tok_pos[M + m]; pw_a[r] = tok_w[m]; pw_b[r] = tok_w[M + m]; } };
    if (mode != 0) { ldtok(gw * 8); build_tables(F, mode == 1 ? 0 : 1); }
    const int b = (gw * 8) >> 11; const int lp = (mode == 1) ? 0 : 1;
    LAS float* modL = (LAS float*)F.lds;
    if (mode == 0) {
        const float* PART = (const float*)(F.ws + WS_PROJ); float* MODW = (float*)(F.ws + WS_MOD);
        { const int n4 = 4 * F.tid; f32x4 sm = *(const f32x4*)(inp<I_ADAB>() + n4); f32x4 pv_[16];
#pragma unroll
          for (int ks = 0; ks < 16; ++ks) pv_[ks] = *(const f32x4*)(PART + ((size_t)(ks * 8 + b)) * 6144 + n4);
#pragma unroll
          for (int ks = 0; ks < 16; ++ks) sm = sm + pv_[ks];
          *(LAS f32x4*)(modL + n4) = sm; }
        if (F.tid < 96) { const int idx4 = 96 * F.bx + F.tid;
            const int l2 = idx4 / (8 * 1536), r2 = idx4 % (8 * 1536), b2 = r2 / 1536, n4 = 4 * (r2 % 1536);
            f32x4 sm = *(const f32x4*)(inp<I_ADAB>() + l2 * 6144 + n4); f32x4 pv_[16];
#pragma unroll
            for (int ks = 0; ks < 16; ++ks) pv_[ks] = *(const f32x4*)(PART + ((size_t)((l2 * 16 + ks) * 8 + b2)) * 6144 + n4);
#pragma unroll
            for (int ks = 0; ks < 16; ++ks) sm = sm + pv_[ks];
            *(f32x4*)(MODW + ((size_t)(l2 * 8 + b2)) * 6144 + n4) = sm; }
        LDS_WAIT(); __syncthreads();
    }
    f32x4 g2v[4], gm[4], shv[4];
#pragma unroll
    for (int j = 0; j < 4; ++j) { const int col = 256 * j + 4 * lane;
        g2v[j] = (f32x4){0.f, 0.f, 0.f, 0.f}; gm[j] = g2v[j]; shv[j] = g2v[j];
        if (mode != 0) g2v[j] = *(const f32x4*)(MOD + ((size_t)lp * 8 + b) * 6144 + 5 * DM + col);
        if (mode == 0) { gm[j] = *(const f32x4*)(inp<I_N1G>() + col) * (*(const LAS f32x4*)(modL + DM + col) + 1.0f); shv[j] = *(const LAS f32x4*)(modL + col); }
        else if (mode != 2) { const float* md = MOD + ((size_t)l * 8 + b) * 6144; gm[j] = *(const f32x4*)(inp<I_N1G>() + l * DM + col) * (*(const f32x4*)(md + DM + col) + 1.0f); shv[j] = *(const f32x4*)(md + col); } }
    for (int m0 = gw * 8; m0 < gw * 8 + 8; m0 += 4) {
        f32x4 v[4][4]; u32x2 ya[4][4], yb[4][4]; float wa[4], wb[4];
        if (mode != 0) {
            int sa[4], sb[4];
#pragma unroll
            for (int r = 0; r < 4; ++r) { sa[r] = 256 * basel[pe_a[r]] + pp_a[r]; sb[r] = 256 * basel[pe_b[r]] + pp_b[r]; wa[r] = pw_a[r]; wb[r] = pw_b[r]; }
#pragma unroll
            for (int r = 0; r < 4; ++r)
#pragma unroll
                for (int j = 0; j < 4; ++j) { const int col = 256 * j + 4 * lane; ya[r][j] = *(const u32x2*)(Y + (size_t)sa[r] * DM + col); yb[r][j] = *(const u32x2*)(Y + (size_t)sb[r] * DM + col); }
            if (m0 == gw * 8) ldtok(m0 + 4);
        }
#pragma unroll
        for (int r = 0; r < 4; ++r) { const int m = m0 + r;
            if (mode == 0) { const float* xr = inp<I_X>() + (size_t)m * DM;
#pragma unroll
                for (int j = 0; j < 4; ++j) v[r][j] = *(const f32x4*)(xr + 256 * j + 4 * lane); }
            else { const bf16* xr = X1 + (size_t)m * DM;
#pragma unroll
                for (int j = 0; j < 4; ++j) { const u32x2 q = *(const u32x2*)(xr + 256 * j + 4 * lane); v[r][j] = (f32x4){bf2f(q.x & 0xffff), bf2f(q.x >> 16), bf2f(q.y & 0xffff), bf2f(q.y >> 16)}; } } }
#pragma unroll
        for (int r = 0; r < 4; ++r) { const int m = m0 + r;
            if (mode != 0) {
#pragma unroll
                for (int j = 0; j < 4; ++j) { const u32x2 a = ya[r][j], c = yb[r][j];
                    f32x4 mo; mo[0] = wa[r] * bf2f(a.x & 0xffff) + wb[r] * bf2f(c.x & 0xffff); mo[1] = wa[r] * bf2f(a.x >> 16) + wb[r] * bf2f(c.x >> 16);
                    mo[2] = wa[r] * bf2f(a.y & 0xffff) + wb[r] * bf2f(c.y & 0xffff); mo[3] = wa[r] * bf2f(a.y >> 16) + wb[r] * bf2f(c.y >> 16);
                    v[r][j] = v[r][j] + g2v[j] * mo; }
                if (mode == 1) {
#pragma unroll
                    for (int j = 0; j < 4; ++j) { u32x2 q; q.x = pk2(v[r][j][0], v[r][j][1]); q.y = pk2(v[r][j][2], v[r][j][3]); *(u32x2*)(X1 + (size_t)m * DM + 256 * j + 4 * lane) = q; }
                } else { float* orow = F.out + (size_t)m * DM;
#pragma unroll
                    for (int j = 0; j < 4; ++j) *(f32x4*)(orow + 256 * j + 4 * lane) = v[r][j]; }
            }
            if (mode != 2) {
                float ss = 0.f;
#pragma unroll
                for (int j = 0; j < 4; ++j) ss += (v[r][j][0] * v[r][j][0] + v[r][j][1] * v[r][j][1]) + (v[r][j][2] * v[r][j][2] + v[r][j][3] * v[r][j][3]);
                const float rstd = __builtin_amdgcn_rsqf(wave_sum(ss) * (1.f / DM) + RMS_EPS);
#pragma unroll
                for (int j = 0; j < 4; ++j) { const f32x4 hv = v[r][j] * rstd * gm[j] + shv[j]; u32x2 w; w.x = pk2(hv[0], hv[1]); w.y = pk2(hv[2], hv[3]);
                    *(u32x2*)(H + (size_t)m * DM + 256 * j + 4 * lane) = w; }
            }
        }
    }
}

__device__ __forceinline__ void knorm_seg(bf16* p, int lane, int nlanes_active, int group_lanes, const float* gain, int gmask, float inv_n) {
    u32x2 raw = (u32x2){0u, 0u}; if (lane < nlanes_active) raw = *(const u32x2*)(p + 4 * lane);
    float x0 = bf2f(raw.x & 0xffff), x1 = bf2f(raw.x >> 16), x2 = bf2f(raw.y & 0xffff), x3 = bf2f(raw.y >> 16);
    float ss = (x0 * x0 + x1 * x1) + (x2 * x2 + x3 * x3);
    for (int o = 1; o < group_lanes; o <<= 1) ss += __shfl_xor(ss, o);
    const float rstd = __builtin_amdgcn_rsqf(ss * inv_n + RMS_EPS);
    const int c = (4 * lane) & gmask;
    x0 *= rstd * gain[c]; x1 *= rstd * gain[c + 1]; x2 *= rstd * gain[c + 2]; x3 *= rstd * gain[c + 3];
    if (lane < nlanes_active) { u32x2 w; w.x = pk2(x0, x1); w.y = pk2(x2, x3); *(u32x2*)(p + 4 * lane) = w; }
}
__device__ __forceinline__ unsigned sortable(float f) { const unsigned u = __builtin_bit_cast(unsigned, f); return (u & 0x80000000u) ? ~u : (u | 0x80000000u); }


__device__ __forceinline__ int wave_sum_i(int v) {
    v += __builtin_amdgcn_update_dpp(0, v, 0xB1, 0xF, 0xF, true);
    v += __builtin_amdgcn_update_dpp(0, v, 0x4E, 0xF, 0xF, true);
    v += __builtin_amdgcn_update_dpp(0, v, 0x141, 0xF, 0xF, true);
    v += __builtin_amdgcn_update_dpp(0, v, 0x140, 0xF, 0xF, true);
    return __builtin_amdgcn_readlane(v, 0) + __builtin_amdgcn_readlane(v, 16) + __builtin_amdgcn_readlane(v, 32) + __builtin_amdgcn_readlane(v, 48);
}
__device__ __forceinline__ void transpose32(unsigned (&a)[32]) {
#define TSTAGE(S, MSK) _Pragma("unroll") for (int i = 0; i < 32; ++i) if (!(i & S)) { const unsigned x = a[i], y = a[i + S]; a[i] = (x & MSK) | ((y << S) & ~MSK); a[i + S] = ((x >> S) & MSK) | (y & ~MSK); }
    TSTAGE(16, 0x0000FFFFu) TSTAGE(8, 0x00FF00FFu) TSTAGE(4, 0x0F0F0F0Fu) TSTAGE(2, 0x33333333u) TSTAGE(1, 0x55555555u)
#undef TSTAGE
}
__device__ __forceinline__ void sel_upd(unsigned T, unsigned ones, int s1, unsigned& cand, unsigned& above, int& na, int& nc, bool& done, bool& exact) {
    if (na + s1 >= 256) { cand = ones; nc = s1; }
    else { above |= ones; na += s1; cand &= ~T; nc -= s1; }
    if (na + nc == 256) { done = true; exact = true; }
}
__device__ __forceinline__ void sel_step2(unsigned TA, unsigned TB, unsigned& candA, unsigned& candB, unsigned& abA, unsigned& abB, int& naA, int& ncA, int& naB, int& ncB, bool& dA, bool& dB, bool& eA, bool& eB) {
    const unsigned onesA = candA & TA, onesB = candB & TB;
    const int s = wave_sum_i(__builtin_popcount(onesA) | (__builtin_popcount(onesB) << 16));
    if (!dA) sel_upd(TA, onesA, s & 0xffff, candA, abA, naA, ncA, dA, eA);
    if (!dB) sel_upd(TB, onesB, (int)((unsigned)s >> 16), candB, abB, naB, ncB, dB, eB);
}
__device__ __forceinline__ unsigned sel_finish(unsigned cand, unsigned above, int na, bool exact, int lane) {
    if (exact) return above | cand;
    const int need = 256 - na; const int pc = __builtin_popcount(cand); int incl = pc;
#pragma unroll
    for (int o = 1; o < 64; o <<= 1) { const int t = shup_i(incl, o, lane); if (lane >= o) incl += t; }
    int take = need - (incl - pc); take = take < 0 ? 0 : (take > pc ? pc : take);
    unsigned w = cand, res = above;
    for (int k = 0; k < take; ++k) { const unsigned low = w & (0u - w); res |= low; w ^= low; }
    return res;
}

__device__ __forceinline__ void p3_prep(Frame& F, const Args& A, int l, int rep) {
    const int gw = F.vcu * NWAVES + F.wave, NGW = F.G * NWAVES;
    bf16* PROJ = (bf16*)(F.ws + WS_PROJ);
    if (!(rep > 0 && PROBE_P3_PART == 2)) { const float* ga = inp<I_KNA>() + l * 64; const float* gc = inp<I_KNC>() + l * 32; const float* gd = inp<I_KND>() + l * 64;
      const int la = F.lane; const int ca = (4 * la) & 63, cc = (4 * la) & 31;
      const f32x4 gva = *(const f32x4*)(ga + ca), gvc = *(const f32x4*)(gc + cc), gvd = *(const f32x4*)(gd + ca);
      for (int mb = gw * 8; mb < gw * 8 + 8; mb += 8) {
        u32x2 ra[8], rc[8], rd[8];
#pragma unroll
        for (int i = 0; i < 8; ++i) { bf16* row = PROJ + (size_t)(mb + i) * NP; ra[i] = *(const u32x2*)(row + C_AK + 4 * la); rc[i] = *(const u32x2*)(row + C_CK + 4 * la);
            rd[i] = (u32x2){0u, 0u}; if (la < 16) rd[i] = *(const u32x2*)(row + C_DK + 4 * la); }
#pragma unroll
        for (int i = 0; i < 8; ++i) { bf16* row = PROJ + (size_t)(mb + i) * NP;
            { float x0 = bf2f(ra[i].x & 0xffff), x1 = bf2f(ra[i].x >> 16), x2 = bf2f(ra[i].y & 0xffff), x3 = bf2f(ra[i].y >> 16); float ss = (x0 * x0 + x1 * x1) + (x2 * x2 + x3 * x3);
              ss = row16_sum(ss); const float rs = __builtin_amdgcn_rsqf(ss * (1.f / 64.f) + RMS_EPS);
              u32x2 w; w.x = pk2(x0 * rs * gva[0], x1 * rs * gva[1]); w.y = pk2(x2 * rs * gva[2], x3 * rs * gva[3]); *(u32x2*)(row + C_AK + 4 * la) = w; }
            { float x0 = bf2f(rc[i].x & 0xffff), x1 = bf2f(rc[i].x >> 16), x2 = bf2f(rc[i].y & 0xffff), x3 = bf2f(rc[i].y >> 16); float ss = (x0 * x0 + x1 * x1) + (x2 * x2 + x3 * x3);
              ss = row8_sum(ss); const float rs = __builtin_amdgcn_rsqf(ss * (1.f / 32.f) + RMS_EPS);
              u32x2 w; w.x = pk2(x0 * rs * gvc[0], x1 * rs * gvc[1]); w.y = pk2(x2 * rs * gvc[2], x3 * rs * gvc[3]); *(u32x2*)(row + C_CK + 4 * la) = w; }
            { float x0 = bf2f(rd[i].x & 0xffff), x1 = bf2f(rd[i].x >> 16), x2 = bf2f(rd[i].y & 0xffff), x3 = bf2f(rd[i].y >> 16); float ss = (x0 * x0 + x1 * x1) + (x2 * x2 + x3 * x3);
              ss = row16_sum(ss); const float rs = __builtin_amdgcn_rsqf(ss * (1.f / 64.f) + RMS_EPS);
              u32x2 w; w.x = pk2(x0 * rs * gvd[0], x1 * rs * gvd[1]); w.y = pk2(x2 * rs * gvd[2], x3 * rs * gvd[3]); if (la < 16) *(u32x2*)(row + C_DK + 4 * la) = w; }
        }
      }
    }
    if (!(rep > 0 && PROBE_P3_PART == 2)) {
        const int bh = gw >> 6, ck = gw & 63, b = bh >> 2, h = bh & 3; const float bfv = inp<I_BF>()[l * 4 + h];
        const int t = 32 * ck + (F.lane & 31);
        const float x = bf2f(PROJ[((size_t)b * SEQ + t) * NP + C_AF + h]) + bfv;
        float incl = fminf(x, 0.f) - __logf(1.f + __expf(-fabsf(x)));
#pragma unroll
        for (int o = 1; o < 32; o <<= 1) { const float u = shup(incl, o, F.lane); if ((F.lane & 31) >= o) incl += u; }
        float* cum = (float*)(F.ws + WS_CUM);
        if (F.lane < 32) cum[(size_t)bh * SEQ + t] = incl;
        if (F.lane == 31) cum[32 * SEQ + bh * 64 + ck] = incl;
    }
    LAS float* sc = (LAS float*)F.lds;
    unsigned* MASK = (unsigned*)(F.ws + WS_MASK);
    constexpr int SCP = 2052;
    const int lane = F.lane, kq = lane >> 4, qi = lane & 15;
    __syncthreads();
    bf16x8 bq[8], wvr, akv[16];
    const auto unit_geom = [&](int i, int& b, int& t0, int& nkt) { b = F.vcu >> 5; const int j = F.vcu & 31, tq = i == 0 ? j : i == 1 ? 127 - j : i == 2 ? 32 + j : 95 - j; t0 = tq * 16; nkt = tq + 1; };
    const auto unit_load_q = [&](int i) { int b, t0, nkt; unit_geom(i, b, t0, nkt); const bf16* qrow = PROJ + (size_t)b * SEQ * NP + (size_t)(t0 + qi) * NP;
#pragma unroll
        for (int h = 0; h < 8; ++h) bq[h] = *(const bf16x8*)(qrow + C_IQ + h * 32 + 8 * kq);
        wvr = *(const bf16x8*)(qrow + C_IW); };
    const auto unit_load_k = [&](int i) { int b, t0, nkt; unit_geom(i, b, t0, nkt); const bf16* pb = PROJ + (size_t)b * SEQ * NP;
#pragma unroll
        for (int j = 0; j < 16; ++j) { const int kt = F.wave + 8 * j; akv[j] = (bf16x8){0, 0, 0, 0, 0, 0, 0, 0}; if (kt < nkt) akv[j] = *(const bf16x8*)(pb + (size_t)(kt * 16 + qi) * NP + C_IK + 8 * kq); } };
    const bool do_c = !(rep > 0 && PROBE_P3_PART == 1);
    if (do_c) unit_load_q(0);
    for (int i = 0; i < 4; ++i) {
        if (!do_c) break;
        int b, t0, nkt; unit_geom(i, b, t0, nkt);
        unit_load_k(i);
        float wq[8];
#pragma unroll
        for (int h = 0; h < 8; ++h) wq[h] = bf2f((unsigned short)wvr[h]) * (0.35355339059327373f * 0.17677669529663687f);
        bf16x8 qth, qtl;
        { float qt[8];
#pragma unroll
          for (int d = 0; d < 8; ++d) qt[d] = 0.f;
#pragma unroll
          for (int h = 0; h < 8; ++h) { wq[h] *= 0.5f;
#pragma unroll
              for (int d = 0; d < 8; ++d) qt[d] += wq[h] * bf2f((unsigned short)bq[h][d]); }
          unsigned hb[8], lb[8];
#pragma unroll
          for (int d = 0; d < 8; ++d) { hb[d] = f2bf(qt[d]); lb[d] = f2bf(qt[d] - bf2f((unsigned short)hb[d])); }
          u32x4 wh, wl; wh.x = hb[0] | (hb[1] << 16); wh.y = hb[2] | (hb[3] << 16); wh.z = hb[4] | (hb[5] << 16); wh.w = hb[6] | (hb[7] << 16);
          wl.x = lb[0] | (lb[1] << 16); wl.y = lb[2] | (lb[3] << 16); wl.z = lb[4] | (lb[5] << 16); wl.w = lb[6] | (lb[7] << 16);
          qth = __builtin_bit_cast(bf16x8, wh); qtl = __builtin_bit_cast(bf16x8, wl); }
#pragma unroll
        for (int j = 0; j < 16; ++j) { const int kt = F.wave + 8 * j;
            if (kt < nkt) {
            f32x4 a4 = __builtin_amdgcn_mfma_f32_16x16x32_bf16(akv[j], qth, (f32x4){0.f, 0.f, 0.f, 0.f}, 0, 0, 0);
            a4 = __builtin_amdgcn_mfma_f32_16x16x32_bf16(akv[j], qtl, a4, 0, 0, 0);
#pragma unroll
            for (int h = 0; h < 8; ++h) { const f32x4 s = __builtin_amdgcn_mfma_f32_16x16x32_bf16(akv[j], bq[h], (f32x4){0.f, 0.f, 0.f, 0.f}, 0, 0, 0);
#pragma unroll
                for (int r = 0; r < 4; ++r) a4[r] = __builtin_fmaf(wq[h], __builtin_fabsf(s[r]), a4[r]); }
#pragma unroll
            for (int r = 0; r < 4; ++r) a4[r] += 0.f;
            { const int ci = kt * 4 + kq, L = ci >> 3, c = ci & 7;
              *(LAS f32x4*)(sc + qi * SCP + 4 * (L * 8 + (c ^ (L & 7)))) = a4; }
            } }
        if (i + 1 < 4) unit_load_q(i + 1);
        LDS_WAIT(); __syncthreads();
        if (rep > 0 && PROBE_P3_PART == 2) { }
        else if (t0 < 256) {
            for (int rr = 0; rr < 2; ++rr) { const int t = t0 + 2 * F.wave + rr; const int nb = t - 32 * lane + 1;
                MASK[((size_t)b * SEQ + t) * 64 + lane] = nb >= 32 ? 0xffffffffu : (nb <= 0 ? 0u : ((1u << nb) - 1u)); }
        } else {
            const int rA = 2 * F.wave, tA = t0 + rA, tB = tA + 1;
            unsigned ua[32], ub[32];
#pragma unroll
            for (int c = 0; c < 8; ++c) { const int off = 4 * (lane * 8 + (c ^ (lane & 7)));
                const f32x4 fa = *(const LAS f32x4*)(sc + rA * SCP + off), fb = *(const LAS f32x4*)(sc + (rA + 1) * SCP + off);
#pragma unroll
                for (int i = 0; i < 4; ++i) { ua[c * 4 + i] = sortable(fa[i]); ub[c * 4 + i] = sortable(fb[i]); } }
            transpose32(ua); transpose32(ub);
            unsigned candA, candB, abA = 0u, abB = 0u; int naA = 0, naB = 0, ncA = tA + 1, ncB = tB + 1; bool dA = false, dB = false, eA = false, eB = false;
            { const int nbA = tA - 32 * lane + 1, nbB = tB - 32 * lane + 1;
              candA = nbA >= 32 ? 0xffffffffu : (nbA <= 0 ? 0u : ((1u << nbA) - 1u)); candB = nbB >= 32 ? 0xffffffffu : (nbB <= 0 ? 0u : ((1u << nbB) - 1u)); }
#pragma unroll
            for (int bit = 31; bit >= 0; --bit) {
                sel_step2(ua[bit], ub[bit], candA, candB, abA, abB, naA, ncA, naB, ncB, dA, dB, eA, eB);
                if (dA && dB) break;
            }
            MASK[((size_t)b * SEQ + tA) * 64 + lane] = sel_finish(candA, abA, naA, eA, lane);
            MASK[((size_t)b * SEQ + tB) * 64 + lane] = sel_finish(candB, abB, naB, eB, lane);
        }
        __syncthreads();
    }
}

namespace att {
template <bool B> struct BoolC { static constexpr bool value = B; };
constexpr int SLOTB = 8192, L_K = 0, L_V = 3 * SLOTB, L_WS = 6 * SLOTB, L_OST = L_WS + 2048, L_CUM = L_OST + 8 * 8192, L_END = L_CUM + 8192;
constexpr int MROW = 66;
static_assert(L_OST + 256 * MROW * 4 <= L_END && L_END <= RING_BYTES, "attention LDS map");
constexpr float THR = 8.0f;
__device__ __forceinline__ int crow(int r, int hi) { return (r & 3) + 8 * (r >> 2) + 4 * hi; }
__device__ __forceinline__ void glds16(const void* gsrc, unsigned lds_dst) { unsigned keep;
    asm volatile("s_mov_b32 %0, m0\n\ts_mov_b32 m0, %2\n\ts_nop 0\n\tglobal_load_lds_dwordx4 %1, off\n\ts_mov_b32 m0, %0" : "=&s"(keep) : "v"(gsrc), "s"(lds_dst) : "memory"); }
#define ATT_WAIT_BAR() asm volatile("s_waitcnt vmcnt(0) lgkmcnt(0)\n\ts_barrier" ::: "memory")
__device__ __forceinline__ unsigned cvtpk_s(float lo, float hi) { typedef __bf16 bf16x2_t __attribute__((ext_vector_type(2))); f32x2 v = {lo, hi}; bf16x2_t b = __builtin_convertvector(v, bf16x2_t); return __builtin_bit_cast(unsigned, b); }
__device__ __forceinline__ float xhalf(float x, int hi) { auto rr = __builtin_amdgcn_permlane32_swap(__builtin_bit_cast(unsigned, x), __builtin_bit_cast(unsigned, x), false, false);
    return __builtin_bit_cast(float, hi ? rr[0] : rr[1]); }
template <int DA, int DB>
__device__ __forceinline__ void qkt(f32x16& p0, f32x16& p1, const LAS char* Kslot, const bf16x8* qr, const f32x16& cin, int r32, int hi) {
    const LAS char* kb = Kslot + hi * 1024 + r32 * 16;
#pragma unroll
    for (int d0 = DA; d0 < DB; ++d0) {
        const bf16x8 b0 = *(const LAS bf16x8*)(kb + d0 * 2048), b1 = *(const LAS bf16x8*)(kb + d0 * 2048 + 512);
        if (d0 == DA) { p0 = __builtin_amdgcn_mfma_f32_32x32x16_bf16(b0, qr[d0], cin, 0, 0, 0); p1 = __builtin_amdgcn_mfma_f32_32x32x16_bf16(b1, qr[d0], cin, 0, 0, 0); }
        else { p0 = __builtin_amdgcn_mfma_f32_32x32x16_bf16(b0, qr[d0], p0, 0, 0, 0); p1 = __builtin_amdgcn_mfma_f32_32x32x16_bf16(b1, qr[d0], p1, 0, 0, 0); } }
}
__device__ __forceinline__ void pv(f32x16* o, int vb, bf16x8 pa0, bf16x8 pa1, bf16x8 pa2, bf16x8 pa3) {
    s16x4 lo[2][4], hi[2][4];
#pragma unroll
    for (int d0 = 0; d0 < 2; ++d0)
#pragma unroll
        for (int ks = 0; ks < 4; ++ks) {
            asm volatile("ds_read_b64_tr_b16 %0,%1 offset:%c2" : "=&v"(lo[d0][ks]) : "v"(vb), "i"(d0 * 4096 + ks * 1024) : "memory");
            asm volatile("ds_read_b64_tr_b16 %0,%1 offset:%c2" : "=&v"(hi[d0][ks]) : "v"(vb), "i"(d0 * 4096 + ks * 1024 + 512) : "memory"); }
    asm volatile("s_waitcnt lgkmcnt(0)" ::: "memory"); __builtin_amdgcn_sched_barrier(0);
#define PK(d, k) (bf16x8){lo[d][k][0], lo[d][k][1], lo[d][k][2], lo[d][k][3], hi[d][k][0], hi[d][k][1], hi[d][k][2], hi[d][k][3]}
    o[0] = __builtin_amdgcn_mfma_f32_32x32x16_bf16(pa0, PK(0, 0), o[0], 0, 0, 0); o[1] = __builtin_amdgcn_mfma_f32_32x32x16_bf16(pa0, PK(1, 0), o[1], 0, 0, 0);
    o[0] = __builtin_amdgcn_mfma_f32_32x32x16_bf16(pa1, PK(0, 1), o[0], 0, 0, 0); o[1] = __builtin_amdgcn_mfma_f32_32x32x16_bf16(pa1, PK(1, 1), o[1], 0, 0, 0);
    o[0] = __builtin_amdgcn_mfma_f32_32x32x16_bf16(pa2, PK(0, 2), o[0], 0, 0, 0); o[1] = __builtin_amdgcn_mfma_f32_32x32x16_bf16(pa2, PK(1, 2), o[1], 0, 0, 0);
    o[0] = __builtin_amdgcn_mfma_f32_32x32x16_bf16(pa3, PK(0, 3), o[0], 0, 0, 0); o[1] = __builtin_amdgcn_mfma_f32_32x32x16_bf16(pa3, PK(1, 3), o[1], 0, 0, 0);
#undef PK
}
__device__ __forceinline__ float rowmax(const f32x16& p0, const f32x16& p1, int hi) {
    float a = fmaxf(fmaxf(p0[0], p0[1]), p1[0]), b = fmaxf(fmaxf(p0[2], p0[3]), p1[1]); a = fmaxf(fmaxf(a, p1[2]), p1[3]);
#pragma unroll
    for (int r = 4; r < 16; r += 4) { a = fmaxf(fmaxf(a, p0[r]), p0[r + 1]); b = fmaxf(fmaxf(b, p0[r + 2]), p0[r + 3]); a = fmaxf(fmaxf(a, p1[r]), p1[r + 1]); b = fmaxf(fmaxf(b, p1[r + 2]), p1[r + 3]); }
    const float m = fmaxf(a, b); return fmaxf(m, xhalf(m, hi));
}
struct AttnP { const bf16* proj; bf16* mix; const float* cum; const unsigned* mask; const float* qgain[4]; const float* kgain[4]; float lam; unsigned* cvq; };

template <int VAR>
__device__ __forceinline__ void attn_unit(const AttnP& P, int b, int h, int qb, LAS char* sh, const int tid_in, const int pm, unsigned* qctr, volatile LAS unsigned* qslot) {
    int tid = tid_in; asm volatile("" : "+v"(tid));
    const int lane = tid & 63, r32 = lane & 31, hi = lane >> 5; const int wid = __builtin_amdgcn_readfirstlane(tid >> 6);
    const long rowbase = (long)b * SEQ; const int q0 = qb * 256, NT = 4 * (qb + 1);
    const int qrel = wid * 32 + r32, tq = q0 + qrel;
    constexpr bool REV = VAR != 0;
    constexpr int QCB = VAR == 0 ? C_AQ : VAR == 1 ? C_BQ : VAR == 2 ? C_CQ : C_DQ;
    constexpr int KCB = VAR == 0 ? C_AK : VAR == 1 ? C_BK : VAR == 2 ? C_CK : C_DK;
    constexpr int VCB = VAR == 0 ? C_AV : VAR == 1 ? C_BV : VAR == 2 ? C_CV : C_DV;
    const int Qc = QCB + 64 * h, Kc = VAR == 3 ? KCB : KCB + 64 * h, Vc = VAR == 3 ? VCB : VCB + 64 * h;
    const bf16* PR = P.proj;
    LAS float* wsf = (LAS float*)(sh + L_WS) + wid * 64;
    LAS float* stg = (LAS float*)(sh + L_OST) + wid * 2048;
    LAS float* cumL = (LAS float*)(sh + L_CUM);
    LAS unsigned* maskL = (LAS unsigned*)(sh + L_OST);
    const unsigned lds0 = (unsigned)(uintptr_t)sh;
    const bf16* ksrc = PR + (size_t)(rowbase + lane) * NP + Kc + wid * 8;
    const bf16* vsrc = PR + (size_t)(rowbase + 16 * (wid & 3) + (lane >> 2)) * NP + Vc + (wid >> 2) * 32 + (lane & 3) * 8;
    const unsigned kdst = lds0 + L_K + wid * 1024, vdst = lds0 + L_V + wid * 1024;
#define DMA_KV(t, slot) do { glds16(ksrc + (size_t)(t) * 64 * NP, (unsigned)__builtin_amdgcn_readfirstlane(kdst + (slot))); glds16(vsrc + (size_t)(t) * 64 * NP, (unsigned)__builtin_amdgcn_readfirstlane(vdst + (slot))); } while (0)
    DMA_KV(REV ? NT - 1 : 0, 0); DMA_KV(REV ? NT - 2 : 1, SLOTB);
    constexpr int NDQ = VAR == 2 ? 2 : 4; bf16x8 qpre[NDQ];
    { const bf16* Qw0 = PR + (size_t)(rowbase + tq) * NP + Qc;
#pragma unroll
      for (int d0 = 0; d0 < NDQ; ++d0) qpre[d0] = *(const bf16x8*)(Qw0 + d0 * 16 + hi * 8); }
    if (VAR == 0) {
        LAS float* pref = (LAS float*)(sh + L_WS);
        const float* cg = P.cum + (size_t)(b * 4 + h) * SEQ; float cgv[4];
#pragma unroll
        for (int k = 0; k < 4; ++k) { const int i = tid + 512 * k; cgv[k] = i < q0 + 256 ? cg[i] : 0.f; }
        if (tid < 64) { const float ct = P.cum[32 * SEQ + (b * 4 + h) * 64 + tid]; float incl = ct;
#pragma unroll
            for (int o = 1; o < 64; o <<= 1) { const float u = shup(incl, o, tid); if (tid >= o) incl += u; }
            pref[tid] = incl - ct; }
        asm volatile("s_waitcnt lgkmcnt(0)\n\ts_barrier" ::: "memory");
#pragma unroll
        for (int k = 0; k < 4; ++k) { const int i = tid + 512 * k; if (i < q0 + 256) cumL[i] = (cgv[k] + pref[i >> 5]) * LOG2E; }
        asm volatile("s_waitcnt lgkmcnt(0)\n\ts_barrier" ::: "memory");
    }
    if (VAR == 3) { const unsigned* mg = P.mask + (size_t)(rowbase + q0) * 64; const int nw = 2 * NT;
#pragma unroll 16
        for (int i = tid; i < 256 * 32; i += 512) { const int row = i >> 5, w = 2 * (i & 31); if (w < nw) *(LAS u32x2*)(maskL + row * MROW + w) = *(const u32x2*)(mg + row * 64 + w); } }
    asm volatile("s_waitcnt vmcnt(0) lgkmcnt(0)\n\ts_barrier" ::: "memory");
    const int vb0 = (int)(lds0 + L_V) + ((lane >> 4) & 1) * 32 + (lane & 3) * 8 + (4 * hi + ((lane & 15) >> 2)) * 64;
    float slope2 = 0.f;
    if (VAR == 2) slope2 = __builtin_amdgcn_exp2f(-(float)(2 * h + 1)) * LOG2E;
    if (VAR == 3) slope2 = __builtin_amdgcn_exp2f(-(float)(2 * h + 2)) * LOG2E;
    float cumt = 0.f; if (VAR == 0) cumt = cumL[tq];
    constexpr int NPASS = VAR == 2 ? 2 : 1;
    unsigned nxt_u = 0u, nxt_c = 0u;
    for (int pass = 0; pass < NPASS; ++pass) {
        bf16x8 qa[4]; float sb0 = 0.f;
        { const bf16* Qw = PR + (size_t)(rowbase + tq) * NP + Qc;
          constexpr int ND0 = VAR == 2 ? 2 : 4; const int dbase = VAR == 2 ? 2 * pass : 0;
          float qf[8 * ND0];
#pragma unroll
          for (int d0 = 0; d0 < ND0; ++d0) { bf16x8 raw = qpre[d0]; if (pass > 0) raw = *(const bf16x8*)(Qw + (dbase + d0) * 16 + hi * 8);
#pragma unroll
              for (int j = 0; j < 8; ++j) qf[d0 * 8 + j] = bf2f((unsigned short)raw[j]); }
          constexpr float SC = (VAR == 2 ? 0.17677669529663687f : 0.125f) * LOG2E;
          if (VAR != 1) {
              float ss = 0.f;
#pragma unroll
              for (int i = 0; i < 8 * ND0; ++i) ss += qf[i] * qf[i];
              ss += xhalf(ss, hi); const float rstd = __builtin_amdgcn_rsqf(ss * (VAR == 2 ? 1.f / 32.f : 1.f / 64.f) + RMS_EPS);
              const float* g = P.qgain[VAR];
#pragma unroll
              for (int d0 = 0; d0 < ND0; ++d0)
#pragma unroll
                  for (int j = 0; j < 8; ++j) qf[d0 * 8 + j] *= rstd * g[16 * d0 + 8 * hi + j] * SC;
          } else {
#pragma unroll
              for (int i = 0; i < 8 * ND0; ++i) qf[i] *= SC;
          }
          if (VAR == 2 || VAR == 3) {
              float n0 = 0.f;
#pragma unroll
              for (int i = 0; i < 8 * ND0; ++i) n0 += qf[i] * qf[i];
              n0 += xhalf(n0, hi);
              float gk = fabsf(P.kgain[VAR][lane & (VAR == 2 ? 31 : 63)]);
              gk = wave_max(gk);
              sb0 = 1.02f * sqrtf(n0) * (VAR == 2 ? 5.656854249f : 8.0f) * gk;
          }
#pragma unroll
          for (int d0 = 0; d0 < ND0; ++d0) { u32x4 w; w.x = cvtpk_s(qf[d0 * 8 + 0], qf[d0 * 8 + 1]); w.y = cvtpk_s(qf[d0 * 8 + 2], qf[d0 * 8 + 3]); w.z = cvtpk_s(qf[d0 * 8 + 4], qf[d0 * 8 + 5]); w.w = cvtpk_s(qf[d0 * 8 + 6], qf[d0 * 8 + 7]);
              qa[d0] = __builtin_bit_cast(bf16x8, w); }
          if (VAR == 2) { qa[2] = qa[0]; qa[3] = qa[1]; }
        }
        const float sbound = sb0;
        const bool st = (VAR == 2 || VAR == 3) && __all(sbound <= 64.f);
        bf16x8 posA0, posA1, slB;
        { const unsigned z = 0u; unsigned a0 = 0u, a1 = 0u, sb_ = 0u;
          if (VAR == 2 || VAR == 3) { if (hi == 0) { const unsigned p0_ = f2bf((float)r32), p1_ = f2bf((float)(r32 + 32)); a0 = p0_ | (p0_ << 16); a1 = p1_ | (p1_ << 16);
              const unsigned sh_ = f2bf(slope2), sl_ = f2bf(slope2 - bf2f((unsigned short)sh_)); sb_ = sh_ | (sl_ << 16); } }
          posA0 = __builtin_bit_cast(bf16x8, (u32x4){a0, z, z, z}); posA1 = __builtin_bit_cast(bf16x8, (u32x4){a1, z, z, z}); slB = __builtin_bit_cast(bf16x8, (u32x4){sb_, z, z, z}); }
        float mhat = (VAR == 1) ? -1e30f : (st ? sbound : 0.f), l_reg = 0.f, Rp = 1.f; f32x16 o[2]; bool hasref = st;
#pragma unroll
        for (int r = 0; r < 16; ++r) { o[0][r] = 0.f; o[1][r] = 0.f; }
        if (pass > 0) { DMA_KV(REV ? NT - 1 : 0, 0); DMA_KV(REV ? NT - 2 : 1, SLOTB); }
        int cur = 0, sl1 = SLOTB, sl2 = 2 * SLOTB;
        auto step = [&](auto band_c, const int it) -> bool {
            constexpr bool BAND = decltype(band_c)::value;
            const int t = REV ? NT - 1 - it : it;
            if (pm == 7) { }
            else if (it + 1 < NT) asm volatile("s_waitcnt vmcnt(2) lgkmcnt(0)\n\ts_barrier" ::: "memory");
            else ATT_WAIT_BAR();
            if (REV && it > 0) {
                const LAS unsigned* wz = (const LAS unsigned*)(sh + L_END) + ((it - 1) & 1) * 8;
                const u32x4 z0 = *(const LAS u32x4*)wz, z1 = *(const LAS u32x4*)(wz + 4);
                if (__builtin_amdgcn_readfirstlane((int)(z0.x & z0.y & z0.z & z0.w & z1.x & z1.y & z1.z & z1.w)) != 0) return true;
            }
            if (it + 2 < NT && pm != 7) DMA_KV(REV ? t - 2 : t + 2, sl2);
            const int jb = t - (NT - 4);
            float cinv = 0.f;
            if (VAR == 0) cinv = cumt;
            if (VAR == 2 || VAR == 3) cinv = slope2 * (float)(t * 64 - tq);
            f32x16 cin;
#pragma unroll
            for (int r = 0; r < 16; ++r) cin[r] = (VAR == 1) ? cinv : cinv - mhat;
            f32x16 p0, p1;
            const LAS char* Ks = sh + L_K + cur;
            if (VAR == 2) { if (pass == 0) { const bf16x8 qq[4] = {qa[0], qa[1], qa[0], qa[1]}; qkt<0, 2>(p0, p1, Ks, qq, cin, r32, hi); }
                            else { const bf16x8 qq[4] = {qa[0], qa[1], qa[0], qa[1]}; qkt<2, 4>(p0, p1, Ks, qq, cin, r32, hi); } }
            else qkt<0, 4>(p0, p1, Ks, qa, cin, r32, hi);
            if (VAR == 2 || VAR == 3) { p0 = __builtin_amdgcn_mfma_f32_32x32x16_bf16(posA0, slB, p0, 0, 0, 0); p1 = __builtin_amdgcn_mfma_f32_32x32x16_bf16(posA1, slB, p1, 0, 0, 0); }
            if (VAR != 1) {
                if (VAR == 0) { const LAS float* cp = cumL + t * 64 + 4 * hi;
#pragma unroll
                    for (int g = 0; g < 4; ++g) { const f32x4 c0 = *(const LAS f32x4*)(cp + 8 * g), c1 = *(const LAS f32x4*)(cp + 32 + 8 * g);
#pragma unroll
                        for (int i = 0; i < 4; ++i) { p0[4 * g + i] -= c0[i]; p1[4 * g + i] -= c1[i]; } } }
                if (VAR != 3) { if constexpr (BAND) { const int kb = 64 * jb + 4 * hi;
#pragma unroll
                    for (int r = 0; r < 16; ++r) { const int kv = kb + (r & 3) + 8 * (r >> 2); if (kv > qrel) p0[r] = -INFINITY; if (kv + 32 > qrel) p1[r] = -INFINITY; } } }
                else { const u32x2 mw = *(const LAS u32x2*)(maskL + qrel * MROW + 2 * t); const unsigned w0 = mw.x >> (4 * hi), w1 = mw.y >> (4 * hi); const float ninf_ = -INFINITY;
                    __builtin_amdgcn_sched_barrier(0); asm volatile("s_nop 15\n\ts_nop 3" ::: "memory"); __builtin_amdgcn_sched_barrier(0);
#pragma unroll
                    for (int r = 0; r < 16; ++r) { const int c = (r & 3) + 8 * (r >> 2);
                        const unsigned m0_ = (unsigned)__builtin_amdgcn_sbfe((int)w0, (unsigned)c, 1u), m1_ = (unsigned)__builtin_amdgcn_sbfe((int)w1, (unsigned)c, 1u);
                        { float o_; asm("v_bfi_b32 %0, %1, %2, %3" : "=v"(o_) : "v"(m0_), "v"(p0[r]), "v"(ninf_)); p0[r] = o_; }
                        { float o_; asm("v_bfi_b32 %0, %1, %2, %3" : "=v"(o_) : "v"(m1_), "v"(p1[r]), "v"(ninf_)); p1[r] = o_; } } }
                if (!st) {
                const float rm = rowmax(p0, p1, hi);
                const bool need = hasref ? (rm > THR) : (rm > -INFINITY);
                if (__any(need)) {
                    const bool fin = rm > -INFINITY;
                    const float dl = hasref ? fmaxf(rm, 0.f) : (fin ? rm : 0.f); const float f = hasref ? __builtin_amdgcn_exp2f(-dl) : 1.f; mhat += dl; l_reg *= f; hasref = hasref || fin;
#pragma unroll
                    for (int r = 0; r < 16; ++r) { p0[r] -= dl; p1[r] -= dl; }
                    if (hi == 0) wsf[r32] = f;
#pragma unroll
                    for (int r = 0; r < 16; ++r) { const float fr = wsf[crow(r, hi)]; o[0][r] *= fr; o[1][r] *= fr; }
                }
                }
                float sa4[4] = {0.f, 0.f, 0.f, 0.f};
#pragma unroll
                for (int r = 0; r < 16; ++r) { p0[r] = __builtin_amdgcn_exp2f(p0[r]); p1[r] = __builtin_amdgcn_exp2f(p1[r]); sa4[r & 3] += p0[r] + p1[r]; }
                l_reg += (sa4[0] + sa4[1]) + (sa4[2] + sa4[3]);
                if (VAR == 2 || VAR == 3) {
                    const float ub = sbound - slope2 * (float)(tq - 64 * t + 1) - mhat;
                    const bool dead = __all(hasref && ub < -150.f); if (lane == 0) ((LAS unsigned*)(sh + L_END))[(it & 1) * 8 + wid] = dead ? 1u : 0u;
                }
            } else {
                f32x16 m0, m1;
#pragma unroll
                for (int r = 0; r < 16; ++r) {
                    { const float e = __builtin_amdgcn_exp2f(-p0[r]); const float bt = __builtin_amdgcn_rcpf(1.f + e); p0[r] = bt; m0[r] = 1.f - bt; }
                    { const float e = __builtin_amdgcn_exp2f(-p1[r]); const float bt = __builtin_amdgcn_rcpf(1.f + e); p1[r] = bt; m1[r] = 1.f - bt; } }
                if constexpr (BAND) { const int kb = 64 * jb + 4 * hi;
#pragma unroll
                    for (int r = 0; r < 16; ++r) { const int kv = kb + (r & 3) + 8 * (r >> 2);
                        if (kv >= qrel) { p0[r] = 0.f; m0[r] = 1.f; } if (kv + 32 >= qrel) { p1[r] = 0.f; m1[r] = 1.f; } } }
                float gp[8], gq[8], ex[8];
#pragma unroll
                for (int g = 0; g < 4; ++g) { gp[g] = (m0[4 * g] * m0[4 * g + 1]) * (m0[4 * g + 2] * m0[4 * g + 3]); gp[4 + g] = (m1[4 * g] * m1[4 * g + 1]) * (m1[4 * g + 2] * m1[4 * g + 3]); }
#pragma unroll
                for (int g = 0; g < 8; ++g) gq[g] = xhalf(gp[g], hi);
                float sp = Rp;
#pragma unroll
                for (int g = 7; g >= 0; --g) { ex[g] = hi ? sp : sp * gq[g]; sp *= gp[g] * gq[g]; }
                Rp = sp;
                { const bool allz = !__any(Rp != 0.f); if (lane == 0) ((LAS unsigned*)(sh + L_END))[(it & 1) * 8 + wid] = allz ? 1u : 0u; }
#pragma unroll
                for (int g = 0; g < 4; ++g) {
                    { float c = ex[g]; const float w3 = p0[4 * g + 3] * c; c *= m0[4 * g + 3]; const float w2 = p0[4 * g + 2] * c; c *= m0[4 * g + 2]; const float w1 = p0[4 * g + 1] * c; c *= m0[4 * g + 1]; const float w0 = p0[4 * g] * c;
                      p0[4 * g] = w0; p0[4 * g + 1] = w1; p0[4 * g + 2] = w2; p0[4 * g + 3] = w3; }
                    { float c = ex[4 + g]; const float w3 = p1[4 * g + 3] * c; c *= m1[4 * g + 3]; const float w2 = p1[4 * g + 2] * c; c *= m1[4 * g + 2]; const float w1 = p1[4 * g + 1] * c; c *= m1[4 * g + 1]; const float w0 = p1[4 * g] * c;
                      p1[4 * g] = w0; p1[4 * g + 1] = w1; p1[4 * g + 2] = w2; p1[4 * g + 3] = w3; } }
            }
            u32x4 pw0, pw1, pw2, pw3;
            pw0 = (u32x4){cvtpk_s(p0[0], p0[1]), cvtpk_s(p0[2], p0[3]), cvtpk_s(p0[4], p0[5]), cvtpk_s(p0[6], p0[7])};
            pw1 = (u32x4){cvtpk_s(p0[8], p0[9]), cvtpk_s(p0[10], p0[11]), cvtpk_s(p0[12], p0[13]), cvtpk_s(p0[14], p0[15])};
            pw2 = (u32x4){cvtpk_s(p1[0], p1[1]), cvtpk_s(p1[2], p1[3]), cvtpk_s(p1[4], p1[5]), cvtpk_s(p1[6], p1[7])};
            pw3 = (u32x4){cvtpk_s(p1[8], p1[9]), cvtpk_s(p1[10], p1[11]), cvtpk_s(p1[12], p1[13]), cvtpk_s(p1[14], p1[15])};
            pv(o, vb0 + cur, __builtin_bit_cast(bf16x8, pw0), __builtin_bit_cast(bf16x8, pw1), __builtin_bit_cast(bf16x8, pw2), __builtin_bit_cast(bf16x8, pw3));
            { const int tmp = cur; cur = sl1; sl1 = sl2; sl2 = tmp; }
            return false;
        };
        if (REV) { bool ex = false; int it = 0;
            for (; it < 4 && !ex; ++it) ex = step(BoolC<true>{}, it);
            for (; it < NT && !ex; ++it) ex = step(BoolC<false>{}, it); }
        else { int it = 0;
            for (; it < NT - 4; ++it) (void)step(BoolC<false>{}, it);
            for (; it < NT; ++it) (void)step(BoolC<true>{}, it); }
        ATT_WAIT_BAR();
        if (pass == NPASS - 1 && tid == 0) { nxt_u = __builtin_amdgcn_atomic_inc32(qctr, 0xFFFFFFFFu, __ATOMIC_RELAXED, "agent"); if (P.cvq) nxt_c = __builtin_amdgcn_atomic_inc32(P.cvq, 0xFFFFFFFFu, __ATOMIC_RELAXED, "agent"); }
        float rli[16];
        if (VAR != 1) {
            l_reg += xhalf(l_reg, hi);
            if (hi == 0) wsf[32 + r32] = l_reg;
#pragma unroll
            for (int r = 0; r < 16; ++r) rli[r] = __builtin_amdgcn_rcpf(wsf[32 + crow(r, hi)]);
        } else {
#pragma unroll
            for (int r = 0; r < 16; ++r) rli[r] = 1.f;
        }
#pragma unroll
        for (int r = 0; r < 16; ++r) { const int orow = crow(r, hi);
#pragma unroll
            for (int d0 = 0; d0 < 2; ++d0) { const float val = o[d0][r] * rli[r]; LAS float* sp = stg + orow * 64 + d0 * 32 + r32;
                if (VAR == 2 && pass == 1) *sp = *sp - P.lam * val; else *sp = val; } }
    }
    LDS_WAIT();
    bf16* Ow = P.mix + (size_t)(rowbase + q0 + wid * 32) * DM + VAR * 256 + h * 64;
#pragma unroll
    for (int i = 0; i < 4; ++i) { const int row = i * 8 + (lane >> 3), ch = lane & 7;
        const f32x4 a = *(const LAS f32x4*)(stg + row * 64 + ch * 8), c = *(const LAS f32x4*)(stg + row * 64 + ch * 8 + 4);
        float sc = 1.f;
        if (VAR == 2) { float ss = (a[0] * a[0] + a[1] * a[1]) + (a[2] * a[2] + a[3] * a[3]) + (c[0] * c[0] + c[1] * c[1]) + (c[2] * c[2] + c[3] * c[3]);
            ss = row8_sum(ss); sc = __builtin_amdgcn_rsqf(ss * (1.f / 64.f) + RMS_EPS); }
        u32x4 w; w.x = cvtpk_s(a[0] * sc, a[1] * sc); w.y = cvtpk_s(a[2] * sc, a[3] * sc); w.z = cvtpk_s(c[0] * sc, c[1] * sc); w.w = cvtpk_s(c[2] * sc, c[3] * sc);
        if (pm == 0 || (w.x == 0x12345678u && w.y == 0x9abcdef0u)) *(u32x4*)(Ow + (size_t)row * DM + ch * 8) = w; }
    if (tid == 0) { *qslot = nxt_u; if (P.cvq) qslot[3] = nxt_c; }
    asm volatile("s_waitcnt lgkmcnt(0)\n\ts_barrier" ::: "memory");
#undef DMA_KV
}
typedef __attribute__((address_space(3))) const char* lds_cptr;
typedef short v4i16_t __attribute__((ext_vector_type(4)));
__device__ __forceinline__ s16x4 vtr(lds_cptr p) { return __builtin_bit_cast(s16x4, __builtin_amdgcn_ds_read_tr16_b64_v4i16((__attribute__((address_space(3))) v4i16_t*)p)); }
template <int VAR>
__device__ __forceinline__ void attn_unit2(const AttnP& P, int b, int h, int qb, LAS char* sh, const int tid_in, unsigned* qctr, volatile LAS unsigned* qslot) {
    static_assert(VAR == 0 || VAR == 2 || VAR == 3, "softmax mixers only");
    int tid = tid_in; asm volatile("" : "+v"(tid));
    const int lane = tid & 63, r32 = lane & 31, hi = lane >> 5; const int wid = __builtin_amdgcn_readfirstlane(tid >> 6);
    const long rowbase = (long)b * SEQ; const int q0 = qb * 256, NT = 4 * (qb + 1);
    const int qrel = wid * 32 + r32, tq = q0 + qrel;
    constexpr int QCB = VAR == 0 ? C_AQ : VAR == 1 ? C_BQ : VAR == 2 ? C_CQ : C_DQ;
    constexpr int KCB = VAR == 0 ? C_AK : VAR == 1 ? C_BK : VAR == 2 ? C_CK : C_DK;
    constexpr int VCB = VAR == 0 ? C_AV : VAR == 1 ? C_BV : VAR == 2 ? C_CV : C_DV;
    const int Qc = QCB + 64 * h, Kc = VAR == 3 ? KCB : KCB + 64 * h, Vc = VAR == 3 ? VCB : VCB + 64 * h;
    const bf16* PR = P.proj;
    LAS float* wsf = (LAS float*)(sh + L_WS) + wid * 64;
    LAS float* stg = (LAS float*)(sh + L_OST) + wid * 2048;
    LAS float* cumL = (LAS float*)(sh + L_CUM);
    LAS unsigned* maskL = (LAS unsigned*)(sh + L_OST);
    const unsigned lds0 = (unsigned)(uintptr_t)sh;
    const bf16* ksrc = PR + (size_t)(rowbase + lane) * NP + Kc + wid * 8;
    const bf16* vsrc = PR + (size_t)(rowbase + 16 * (wid & 3) + (lane >> 2)) * NP + Vc + (wid >> 2) * 32 + (lane & 3) * 8;
    const unsigned kdst = lds0 + L_K + wid * 1024, vdst = lds0 + L_V + wid * 1024;
#define TILE2(j) (NT - 1 - (j))
#define DMA_K2(j, slot) glds16(ksrc + (size_t)TILE2(j) * 64 * NP, (unsigned)__builtin_amdgcn_readfirstlane(kdst + (slot)))
#define DMA_V2(j, slot) glds16(vsrc + (size_t)TILE2(j) * 64 * NP, (unsigned)__builtin_amdgcn_readfirstlane(vdst + (slot)))
    DMA_K2(0, 0); DMA_K2(1, SLOTB); DMA_V2(0, 0);
    constexpr int NDQ = VAR == 2 ? 2 : 4; bf16x8 qpre[NDQ];
    { const bf16* Qw0 = PR + (size_t)(rowbase + tq) * NP + Qc;
#pragma unroll
      for (int d0 = 0; d0 < NDQ; ++d0) qpre[d0] = *(const bf16x8*)(Qw0 + d0 * 16 + hi * 8); }
    if (VAR == 0) {
        LAS float* pref = (LAS float*)(sh + L_WS);
        const float* cg = P.cum + (size_t)(b * 4 + h) * SEQ; float cgv[4];
#pragma unroll
        for (int k = 0; k < 4; ++k) { const int i = tid + 512 * k; cgv[k] = i < q0 + 256 ? cg[i] : 0.f; }
        if (tid < 64) { const float ct = P.cum[32 * SEQ + (b * 4 + h) * 64 + tid]; float incl = ct;
#pragma unroll
            for (int o = 1; o < 64; o <<= 1) { const float u = shup(incl, o, tid); if (tid >= o) incl += u; }
            pref[tid] = incl - ct; }
        asm volatile("s_waitcnt lgkmcnt(0)\n\ts_barrier" ::: "memory");
#pragma unroll
        for (int k = 0; k < 4; ++k) { const int i = tid + 512 * k; if (i < q0 + 256) cumL[i] = (cgv[k] + pref[i >> 5]) * LOG2E; }
        asm volatile("s_waitcnt lgkmcnt(0)\n\ts_barrier" ::: "memory");
    }
    if (VAR == 3) { const unsigned* mg = P.mask + (size_t)(rowbase + q0) * 64; const int nw = 2 * NT;
#pragma unroll 16
        for (int i = tid; i < 256 * 32; i += 512) { const int row = i >> 5, w = 2 * (i & 31); if (w < nw) *(LAS u32x2*)(maskL + row * MROW + w) = *(const u32x2*)(mg + row * 64 + w); } }
    asm volatile("s_waitcnt vmcnt(0) lgkmcnt(0)\n\ts_barrier" ::: "memory");
    const lds_cptr shc = (lds_cptr)sh;
    const lds_cptr kp0 = shc + L_K + hi * 1024 + r32 * 16;
    const lds_cptr vp0 = shc + L_V + ((lane >> 4) & 1) * 32 + (lane & 3) * 8 + (4 * hi + ((lane & 15) >> 2)) * 64;
    float slope2 = 0.f;
    if (VAR == 2) slope2 = __builtin_amdgcn_exp2f(-(float)(2 * h + 1)) * LOG2E;
    if (VAR == 3) slope2 = __builtin_amdgcn_exp2f(-(float)(2 * h + 2)) * LOG2E;
    float cumt = 0.f; if (VAR == 0) cumt = cumL[tq];
    constexpr int NPASS = VAR == 2 ? 2 : 1;
    unsigned nxt_u = 0u, nxt_c = 0u;
    const auto slot3 = [](int j) { return (j % 3) * SLOTB; };
#define SB2() __builtin_amdgcn_sched_barrier(0)
#define PINV(x) asm volatile("" : "+v"(x))
#define MF32(a, b, c) __builtin_amdgcn_mfma_f32_32x32x16_bf16(a, b, c, 0, 0, 0)
#define ATT_BARN(N) do { asm volatile("s_waitcnt vmcnt(" #N ") lgkmcnt(0)\n\ts_barrier" ::: "memory"); SB2(); } while (0)
#define PKW(Pv, i) cvtpk_s(Pv[i], Pv[(i) + 1])
#define PAF(k) __builtin_bit_cast(bf16x8, pw##k)
#define VFR(i) (bf16x8){vlo[i][0], vlo[i][1], vlo[i][2], vlo[i][3], vhi[i][0], vhi[i][1], vhi[i][2], vhi[i][3]}
#define VRD(i) do { vlo[i] = vtr(vp_ + (((i) >> 2) * 4096 + ((i) & 3) * 1024)); vhi[i] = vtr(vp_ + (((i) >> 2) * 4096 + ((i) & 3) * 1024 + 512)); } while (0)
#define EX2(v) __builtin_amdgcn_exp2f(v)
#define GAPA(MF, Pv, i, PW, w) do { MF; sacc += Pv[i]; sacc += Pv[(i) + 1]; sacc += Pv[(i) + 2]; sacc += Pv[(i) + 3]; PINV(sacc); PW[w] = PKW(Pv, i); PW[(w) + 1] = PKW(Pv, (i) + 2); PINV(PW); SB2(); } while (0)
#define GAPA8(MF, Pv, i, PW) do { MF; sacc += Pv[i]; sacc += Pv[(i) + 1]; sacc += Pv[(i) + 2]; sacc += Pv[(i) + 3]; sacc += Pv[(i) + 4]; sacc += Pv[(i) + 5]; sacc += Pv[(i) + 6]; sacc += Pv[(i) + 7]; PINV(sacc); \
        PW[0] = PKW(Pv, i); PW[1] = PKW(Pv, (i) + 2); PW[2] = PKW(Pv, (i) + 4); PW[3] = PKW(Pv, (i) + 6); PINV(PW); SB2(); } while (0)
#define GAPB(MF, X, i) do { MF; X[i] = EX2(X[i]); X[(i) + 1] = EX2(X[(i) + 1]); X[(i) + 2] = EX2(X[(i) + 2]); X[(i) + 3] = EX2(X[(i) + 3]); PINV(X); SB2(); } while (0)
    for (int pass = 0; pass < NPASS; ++pass) {
        bf16x8 qa[4]; float sb0 = 0.f;
        { const bf16* Qw = PR + (size_t)(rowbase + tq) * NP + Qc;
          constexpr int ND0 = VAR == 2 ? 2 : 4; const int dbase = VAR == 2 ? 2 * pass : 0;
          float qf[8 * ND0];
#pragma unroll
          for (int d0 = 0; d0 < ND0; ++d0) { bf16x8 raw = qpre[d0]; if (pass > 0) raw = *(const bf16x8*)(Qw + (dbase + d0) * 16 + hi * 8);
#pragma unroll
              for (int j = 0; j < 8; ++j) qf[d0 * 8 + j] = bf2f((unsigned short)raw[j]); }
          constexpr float SC = (VAR == 2 ? 0.17677669529663687f : 0.125f) * LOG2E;
          if (VAR != 1) {
              float ss = 0.f;
#pragma unroll
              for (int i = 0; i < 8 * ND0; ++i) ss += qf[i] * qf[i];
              ss += xhalf(ss, hi); const float rstd = __builtin_amdgcn_rsqf(ss * (VAR == 2 ? 1.f / 32.f : 1.f / 64.f) + RMS_EPS);
              const float* g = P.qgain[VAR];
#pragma unroll
              for (int d0 = 0; d0 < ND0; ++d0)
#pragma unroll
                  for (int j = 0; j < 8; ++j) qf[d0 * 8 + j] *= rstd * g[16 * d0 + 8 * hi + j] * SC;
          } else {
#pragma unroll
              for (int i = 0; i < 8 * ND0; ++i) qf[i] *= SC;
          }
          if (VAR != 1) {
              float n0 = 0.f;
#pragma unroll
              for (int i = 0; i < 8 * ND0; ++i) n0 += qf[i] * qf[i];
              n0 += xhalf(n0, hi);
              float gk = fabsf(P.kgain[VAR][lane & (VAR == 2 ? 31 : 63)]);
              gk = wave_max(gk);
              sb0 = 1.02f * sqrtf(n0) * (VAR == 2 ? 5.656854249f : 8.0f) * gk;
          }
#pragma unroll
          for (int d0 = 0; d0 < ND0; ++d0) { u32x4 w; w.x = cvtpk_s(qf[d0 * 8 + 0], qf[d0 * 8 + 1]); w.y = cvtpk_s(qf[d0 * 8 + 2], qf[d0 * 8 + 3]); w.z = cvtpk_s(qf[d0 * 8 + 4], qf[d0 * 8 + 5]); w.w = cvtpk_s(qf[d0 * 8 + 6], qf[d0 * 8 + 7]);
              qa[d0] = __builtin_bit_cast(bf16x8, w); }
          if (VAR == 2) { qa[2] = qa[0]; qa[3] = qa[1]; }
        }
        const float sbound = sb0;
        if (pass > 0) { DMA_K2(0, 0); DMA_K2(1, SLOTB); DMA_V2(0, 0); }
        const bool st = __all(sbound <= 64.f);
        float mhat = st ? sbound : 0.f, l_reg = 0.f; bool hasref = st, resc = false; f32x16 o[2], negm;
#pragma unroll
        for (int r = 0; r < 16; ++r) { o[0][r] = 0.f; o[1][r] = 0.f; }
        f32x16 pA0, pA1, pB0, pB1; u32x4 pw0, pw1, pw2, pw3;
#pragma unroll
        for (int r = 0; r < 16; ++r) { pB0[r] = 0.f; pB1[r] = 0.f; }
        const auto setneg = [&](int t) __attribute__((always_inline)) { float v = -mhat; if (VAR == 0) v += cumt; else v += slope2 * (float)(t * 64 + 4 * hi - tq);
#pragma unroll
            for (int r = 0; r < 16; ++r) negm[r] = v;
            PINV(negm); };
        const auto mid = [&](f32x16& C0, f32x16& C1, const int it) __attribute__((always_inline)) {
            const int t = NT - 1 - it;
            if (VAR == 0) { const LAS float* cp = cumL + t * 64 + 4 * hi;
#pragma unroll
                for (int g = 0; g < 4; ++g) { const f32x4 c0 = *(const LAS f32x4*)(cp + 8 * g), c1 = *(const LAS f32x4*)(cp + 32 + 8 * g);
#pragma unroll
                    for (int i = 0; i < 4; ++i) { C0[4 * g + i] -= c0[i]; C1[4 * g + i] -= c1[i]; } } }
            else {
#pragma unroll
                for (int r = 0; r < 16; ++r) { const float kc = (float)((r & 3) + 8 * (r >> 2)); C0[r] += slope2 * kc; C1[r] += slope2 * (kc + 32.f); } }
            if (VAR != 3) { if (it < 4) { asm volatile("" ::: "memory");
                const int kb = 64 * (3 - it) + 4 * hi;
#pragma unroll
                for (int r = 0; r < 16; ++r) { const int kv = kb + (r & 3) + 8 * (r >> 2); if (kv > qrel) C0[r] = -INFINITY; if (kv + 32 > qrel) C1[r] = -INFINITY; } } }
            else { const u32x2 mw = *(const LAS u32x2*)(maskL + qrel * MROW + 2 * t); const unsigned w0 = mw.x >> (4 * hi), w1 = mw.y >> (4 * hi);
#pragma unroll
                for (int r = 0; r < 16; ++r) { const int c = (r & 3) + 8 * (r >> 2); if (!((w0 >> c) & 1u)) C0[r] = -INFINITY; if (!((w1 >> c) & 1u)) C1[r] = -INFINITY; } }
            resc = false;
            if (!st) {
            const float rm = rowmax(C0, C1, hi);
            const bool need = hasref ? (rm > THR) : (rm > -INFINITY);
            if (__any(need)) {
                const bool fin = rm > -INFINITY;
                const float dl = hasref ? fmaxf(rm, 0.f) : (fin ? rm : 0.f);
                const float f = hasref ? EX2(-dl) : 1.f;
                mhat += dl; l_reg *= f;
#pragma unroll
                for (int r = 0; r < 16; ++r) { C0[r] -= dl; C1[r] -= dl; }
                if (hi == 0) wsf[r32] = f;
                resc = true; hasref = hasref || fin;
            }
            }
            if (VAR != 0) {
                const bool dead = hasref && (sbound - slope2 * (float)(tq - 64 * t + 1) - mhat < -150.f);
                const bool alld = __all(dead); if (lane == 0) ((LAS unsigned*)(sh + L_END))[(it & 1) * 8 + wid] = alld ? 1u : 0u;
            }
        };
#define KLD(dst0, dst1, d0) do { dst0 = *(const LAS bf16x8*)(kp_ + (d0) * 2048); dst1 = *(const LAS bf16x8*)(kp_ + (d0) * 2048 + 512); } while (0)
#define VLD(lo, hi_, i) do { lo = vtr(vp_ + (((i) >> 2) * 4096 + ((i) & 3) * 1024)); hi_ = vtr(vp_ + (((i) >> 2) * 4096 + ((i) & 3) * 1024 + 512)); } while (0)
#define VF(lo, hi_) (bf16x8){lo[0], lo[1], lo[2], lo[3], hi_[0], hi_[1], hi_[2], hi_[3]}
        const auto step = [&](f32x16& C0, f32x16& C1, f32x16& P0, f32x16& P1, const int it) __attribute__((always_inline)) -> bool {
            if (it + 1 < NT) ATT_BARN(2); else ATT_BARN(1);
            if (VAR != 0 && it >= 1) { const LAS unsigned* wz = (const LAS unsigned*)(sh + L_END) + ((it - 1) & 1) * 8;
                const u32x4 z0 = *(const LAS u32x4*)wz, z1 = *(const LAS u32x4*)(wz + 4);
                if (__builtin_amdgcn_readfirstlane((int)(z0.x & z0.y & z0.z & z0.w & z1.x & z1.y & z1.z & z1.w)) != 0) return true; }
            if (it + 2 < NT) DMA_K2(it + 2, slot3(it + 2));
            if (it + 1 < NT) DMA_V2(it + 1, slot3(it + 1));
            setneg(NT - 1 - it);
            int ko_ = slot3(it), vo_ = slot3(it + 2);
            asm volatile("" : "+s"(ko_), "+s"(vo_));
            const lds_cptr kp_ = kp0 + ko_; const lds_cptr vp_ = vp0 + vo_;
            bf16x8 ka0, ka1, kb0, kb1; s16x4 va0, va1, vb0, vb1;
            float sacc = 0.f;
            if (VAR == 2) {
                KLD(ka0, ka1, 2 * pass); KLD(kb0, kb1, 2 * pass + 1); SB2();
                GAPA8(C0 = MF32(ka0, qa[0], negm), P0, 0, pw0);
                GAPA8(C1 = MF32(ka1, qa[0], negm), P0, 8, pw1);
                GAPA8(C0 = MF32(kb0, qa[1], C0), P1, 0, pw2);
                GAPA8(C1 = MF32(kb1, qa[1], C1), P1, 8, pw3);
            } else {
                KLD(ka0, ka1, 0); KLD(kb0, kb1, 1); SB2();
                GAPA(C0 = MF32(ka0, qa[0], negm), P0, 0, pw0, 0);
                GAPA(C1 = MF32(ka1, qa[0], negm), P0, 4, pw0, 2);
                KLD(ka0, ka1, 2); SB2();
                GAPA(C0 = MF32(kb0, qa[1], C0), P0, 8, pw1, 0);
                GAPA(C1 = MF32(kb1, qa[1], C1), P0, 12, pw1, 2);
                KLD(kb0, kb1, 3); SB2();
                GAPA(C0 = MF32(ka0, qa[2], C0), P1, 0, pw2, 0);
                GAPA(C1 = MF32(ka1, qa[2], C1), P1, 4, pw2, 2);
                GAPA(C0 = MF32(kb0, qa[3], C0), P1, 8, pw3, 0);
                GAPA(C1 = MF32(kb1, qa[3], C1), P1, 12, pw3, 2);
            }
            l_reg += sacc;
            mid(C0, C1, it);
            SB2();
            if (it > 0) {
                VLD(va0, va1, 0); VLD(vb0, vb1, 4); SB2();
                GAPB(o[0] = MF32(PAF(0), VF(va0, va1), o[0]), C0, 0);  VLD(va0, va1, 1); SB2();
                GAPB(o[1] = MF32(PAF(0), VF(vb0, vb1), o[1]), C0, 4);  VLD(vb0, vb1, 5); SB2();
                GAPB(o[0] = MF32(PAF(1), VF(va0, va1), o[0]), C0, 8);  VLD(va0, va1, 2); SB2();
                GAPB(o[1] = MF32(PAF(1), VF(vb0, vb1), o[1]), C0, 12); VLD(vb0, vb1, 6); SB2();
                GAPB(o[0] = MF32(PAF(2), VF(va0, va1), o[0]), C1, 0);  VLD(va0, va1, 3); SB2();
                GAPB(o[1] = MF32(PAF(2), VF(vb0, vb1), o[1]), C1, 4);  VLD(vb0, vb1, 7); SB2();
                GAPB(o[0] = MF32(PAF(3), VF(va0, va1), o[0]), C1, 8);
                GAPB(o[1] = MF32(PAF(3), VF(vb0, vb1), o[1]), C1, 12);
                if (resc) {
#pragma unroll
                    for (int r = 0; r < 16; ++r) { const float fr = wsf[crow(r, hi)]; o[0][r] *= fr; o[1][r] *= fr; } }
            } else {
#pragma unroll
                for (int r = 0; r < 16; ++r) { C0[r] = EX2(C0[r]); C1[r] = EX2(C1[r]); }
            }
            return false;
        };
        bool ex = false, pendA = true; int it = 0;
        for (; it < NT; it += 2) {
            ex = step(pA0, pA1, pB0, pB1, it); if (ex) { pendA = false; break; }
            ex = step(pB0, pB1, pA0, pA1, it + 1); if (ex) { pendA = true; ++it; break; }
        }
        if (!ex) pendA = false;
        if (!ex) ATT_BARN(0);
        { int vo_ = slot3(it + 2); asm volatile("" : "+s"(vo_)); const lds_cptr vp_ = vp0 + vo_; s16x4 vlo[8], vhi[8];
#pragma unroll
          for (int i = 0; i < 8; ++i) VRD(i);
          float sacc = 0.f;
          if (pendA) {
#pragma unroll
              for (int r = 0; r < 16; ++r) sacc += pA0[r] + pA1[r];
              pw0 = (u32x4){PKW(pA0, 0), PKW(pA0, 2), PKW(pA0, 4), PKW(pA0, 6)}; pw1 = (u32x4){PKW(pA0, 8), PKW(pA0, 10), PKW(pA0, 12), PKW(pA0, 14)};
              pw2 = (u32x4){PKW(pA1, 0), PKW(pA1, 2), PKW(pA1, 4), PKW(pA1, 6)}; pw3 = (u32x4){PKW(pA1, 8), PKW(pA1, 10), PKW(pA1, 12), PKW(pA1, 14)};
          } else {
#pragma unroll
              for (int r = 0; r < 16; ++r) sacc += pB0[r] + pB1[r];
              pw0 = (u32x4){PKW(pB0, 0), PKW(pB0, 2), PKW(pB0, 4), PKW(pB0, 6)}; pw1 = (u32x4){PKW(pB0, 8), PKW(pB0, 10), PKW(pB0, 12), PKW(pB0, 14)};
              pw2 = (u32x4){PKW(pB1, 0), PKW(pB1, 2), PKW(pB1, 4), PKW(pB1, 6)}; pw3 = (u32x4){PKW(pB1, 8), PKW(pB1, 10), PKW(pB1, 12), PKW(pB1, 14)};
          }
          l_reg += sacc;
          o[0] = MF32(PAF(0), VFR(0), o[0]); o[1] = MF32(PAF(0), VFR(4), o[1]); o[0] = MF32(PAF(1), VFR(1), o[0]); o[1] = MF32(PAF(1), VFR(5), o[1]);
          o[0] = MF32(PAF(2), VFR(2), o[0]); o[1] = MF32(PAF(2), VFR(6), o[1]); o[0] = MF32(PAF(3), VFR(3), o[0]); o[1] = MF32(PAF(3), VFR(7), o[1]); }
        ATT_WAIT_BAR();
        if (pass == NPASS - 1 && tid == 0) { nxt_u = __builtin_amdgcn_atomic_inc32(qctr, 0xFFFFFFFFu, __ATOMIC_RELAXED, "agent"); if (P.cvq) nxt_c = __builtin_amdgcn_atomic_inc32(P.cvq, 0xFFFFFFFFu, __ATOMIC_RELAXED, "agent"); }
        int lane_e = lane; asm volatile("" : "+v"(lane_e)); const int r32e = lane_e & 31, hie = lane_e >> 5;
        LAS float* wsfe = (LAS float*)(sh + L_WS) + wid * 64; LAS float* stge = (LAS float*)(sh + L_OST) + wid * 2048;
        float rli[16];
        l_reg += xhalf(l_reg, hie);
        if (hie == 0) wsfe[32 + r32e] = l_reg;
#pragma unroll
        for (int r = 0; r < 16; ++r) rli[r] = __builtin_amdgcn_rcpf(wsfe[32 + crow(r, hie)]);
#pragma unroll
        for (int r = 0; r < 16; ++r) { const int orow = crow(r, hie);
#pragma unroll
            for (int d0 = 0; d0 < 2; ++d0) { const float val = o[d0][r] * rli[r]; LAS float* sp = stge + orow * 64 + d0 * 32 + r32e;
                if (VAR == 2 && pass == 1) *sp = *sp - P.lam * val; else *sp = val; } }
    }
    LDS_WAIT();
    int lane_o = tid & 63; asm volatile("" : "+v"(lane_o));
    bf16* Ow = P.mix + (size_t)(rowbase + q0 + wid * 32) * DM + VAR * 256 + h * 64;
    { const int lane = lane_o; LAS float* stg = (LAS float*)(sh + L_OST) + wid * 2048;
#pragma unroll
    for (int i = 0; i < 4; ++i) { const int row = i * 8 + (lane >> 3), ch = lane & 7;
        const f32x4 a = *(const LAS f32x4*)(stg + row * 64 + ch * 8), c = *(const LAS f32x4*)(stg + row * 64 + ch * 8 + 4);
        float sc = 1.f;
        if (VAR == 2) { float ss = (a[0] * a[0] + a[1] * a[1]) + (a[2] * a[2] + a[3] * a[3]) + (c[0] * c[0] + c[1] * c[1]) + (c[2] * c[2] + c[3] * c[3]);
            ss = row8_sum(ss); sc = __builtin_amdgcn_rsqf(ss * (1.f / 64.f) + RMS_EPS); }
        u32x4 w; w.x = cvtpk_s(a[0] * sc, a[1] * sc); w.y = cvtpk_s(a[2] * sc, a[3] * sc); w.z = cvtpk_s(c[0] * sc, c[1] * sc); w.w = cvtpk_s(c[2] * sc, c[3] * sc);
        *(u32x4*)(Ow + (size_t)row * DM + ch * 8) = w; } }
    if (tid == 0) { *qslot = nxt_u; if (P.cvq) qslot[3] = nxt_c; }
    asm volatile("s_waitcnt lgkmcnt(0)\n\ts_barrier" ::: "memory");
#undef DMA_K2
#undef DMA_V2
#undef TILE2
}
#undef SB2
#undef PINV
#undef MF32
#undef ATT_BARN
#undef PKW
#undef PAF
#undef VFR
#undef VRD
#undef EX2
#undef GAPA
#undef GAPA8
#undef GAPB
#undef KLD
#undef VLD
#undef VF
}

__device__ __forceinline__ void p4_attention(Frame& F, const Args& A, int l, int qsel) {
    att::AttnP P; P.proj = (const bf16*)(F.ws + WS_PROJ); P.mix = (bf16*)(F.ws + WS_MIX); P.cum = (const float*)(F.ws + WS_CUM); P.mask = (const unsigned*)(F.ws + WS_MASK);
    P.qgain[0] = inp<I_QNA>() + l * 64; P.qgain[1] = nullptr; P.qgain[2] = inp<I_QNC>() + l * 32; P.qgain[3] = inp<I_QND>() + l * 64; P.kgain[0] = inp<I_KNA>() + l * 64; P.kgain[1] = nullptr; P.kgain[2] = inp<I_KNC>() + l * 32; P.kgain[3] = inp<I_KND>() + l * 64; P.lam = ((const float*)(F.ws + WS_MISC))[l];
    LAS char* sh = (LAS char*)F.lds;
    LAS float* rsl2 = (LAS float*)(F.lds + 126976);
    bool cv = BG_CONVERT && (qsel == 0);
    if (cv) { fill_rowscale(F, A, 0, rsl2); fill_rowscale(F, A, 1, rsl2 + DM); }
    P.cvq = cv ? F.ctl + CW_CVQ : nullptr;
    if (F.tid == 0) F.MISC[0] = (unsigned)(F.bx - F.G);
    __syncthreads();
    for (;;) {
        const int u = (int)F.MISC[0] + F.G;
        if (u >= 1024) break;
        const int qb = 7 - (u >> 7), r = u & 127, var = r >> 5, bh = r & 31, b = bh >> 2, h = bh & 3;
        const int tv = var == 0 ? 2 : var == 1 ? 3 : var == 2 ? 1 : 0;
        if (qsel >= 2 && PROBE_ATT_VAR >= 0 && tv != PROBE_ATT_VAR) { __syncthreads(); if (F.tid == 0) F.MISC[0] = __hip_atomic_fetch_add(F.ctl + CW_AQ + 64 * qsel, 1u, RLX_AGENT); __syncthreads(); continue; }
#ifdef ONLY_VAR2
        att::attn_unit2<ONLY_VAR2>(P, b, h, qb, sh, F.tid, F.ctl + CW_AQ + 64 * qsel, F.MISC);
#else
        if (tv == 2) att::attn_unit<2>(P, b, h, qb, sh, F.tid, qsel >= 2 ? PROBE_ATT_MODE : 0, F.ctl + CW_AQ + 64 * qsel, F.MISC);
        else if (tv == 1) att::attn_unit<1>(P, b, h, qb, sh, F.tid, qsel >= 2 ? PROBE_ATT_MODE : 0, F.ctl + CW_AQ + 64 * qsel, F.MISC);
        else if (tv == 3) att::attn_unit<3>(P, b, h, qb, sh, F.tid, qsel >= 2 ? PROBE_ATT_MODE : 0, F.ctl + CW_AQ + 64 * qsel, F.MISC);
        else att::attn_unit2<0>(P, b, h, qb, sh, F.tid, F.ctl + CW_AQ + 64 * qsel, F.MISC);
#endif
        if (cv) {
            const int gb = (int)F.MISC[3] * CV_CHUNK;
            if (gb >= CV_TOTAL) { cv = false; P.cvq = nullptr; } else convert_chunk(F, A, gb, rsl2);
            __syncthreads();
        }
    }
    while (cv) {
        __syncthreads();
        if (F.tid == 0) F.MISC[3] = __hip_atomic_fetch_add(F.ctl + CW_CVQ, 1u, RLX_AGENT);
        __syncthreads();
        const int gb = (int)F.MISC[3] * CV_CHUNK;
        if (gb >= CV_TOTAL) cv = false; else convert_chunk(F, A, gb, rsl2);
    }
    __syncthreads();
}

template <int N, int Dd> __device__ __forceinline__ void bfly(float (&p)[32], int lane) { const bool up = (lane & Dd) != 0;
#pragma unroll
    for (int j = 0; j < N / 2; ++j) { const float a = p[2 * j], bb = p[2 * j + 1]; const float send = up ? a : bb, keep = up ? bb : a; p[j] = keep + __shfl_xor(send, Dd); } }
__device__ __forceinline__ void p6_router(Frame& F, const Args& A, int l, int rep) {
    const float* MOD = (const float*)(F.ws + WS_MOD); const bf16* X1 = (const bf16*)(F.ws + WS_X1); bf16* H = (bf16*)(F.ws + WS_H);
    const bf16* WRH = (const bf16*)(F.ws + WS_WR) + (size_t)l * 48 * DM; const bf16* WRL = WRH + 2 * 48 * DM;
    int* tok_e = (int*)(F.ws + WS_TOK); float* tok_w = (float*)(F.ws + WS_TOK) + 2 * M; int* tok_pos = (int*)(F.ws + WS_TOK) + 4 * M;
    constexpr int AP = 528;
    LAS unsigned char* Ahi = F.lds; LAS unsigned char* Alo = F.lds + 64 * AP; LAS unsigned char* Bhi = F.lds + 128 * AP; LAS unsigned char* Blo = F.lds + 176 * AP;
    LAS float* PL = (LAS float*)F.lds;
    const int lane = F.lane, w = F.wave; const int mw = (F.vcu * NWAVES + w) * 8; const int b = mw >> 11;
    const float* md = MOD + ((size_t)l * 8 + b) * 6144;
    float bias_pre = 0.f; if (F.tid < 36) bias_pre = F.tid < 4 ? inp<I_BG>()[l * 4 + F.tid] : inp<I_BE>()[l * 32 + F.tid - 4];
    f32x4 hv[8][4];
#pragma unroll
    for (int r = 0; r < 8; ++r) {
        const bf16* xr = X1 + (size_t)(mw + r) * DM;
#pragma unroll
        for (int j = 0; j < 4; ++j) { const u32x2 q = *(const u32x2*)(xr + 256 * j + 4 * lane); hv[r][j] = (f32x4){bf2f(q.x & 0xffff), bf2f(q.x >> 16), bf2f(q.y & 0xffff), bf2f(q.y >> 16)}; }
    }
    { f32x4 gm[4], sc[4], sh[4]; const float* n2 = inp<I_N2G>() + l * DM;
#pragma unroll
      for (int j = 0; j < 4; ++j) { const int col = 256 * j + 4 * lane; gm[j] = *(const f32x4*)(n2 + col); sc[j] = *(const f32x4*)(md + 4 * DM + col); sh[j] = *(const f32x4*)(md + 3 * DM + col); gm[j] = gm[j] * (sc[j] + 1.0f); }
#pragma unroll
      for (int r = 0; r < 8; ++r) { float ss = 0.f;
#pragma unroll
        for (int j = 0; j < 4; ++j) ss += (hv[r][j][0] * hv[r][j][0] + hv[r][j][1] * hv[r][j][1]) + (hv[r][j][2] * hv[r][j][2] + hv[r][j][3] * hv[r][j][3]);
        const float rstd = __builtin_amdgcn_rsqf(wave_sum(ss) * (1.f / DM) + RMS_EPS);
#pragma unroll
        for (int j = 0; j < 4; ++j) { hv[r][j] = hv[r][j] * rstd * gm[j] + sh[j]; u32x2 pk; pk.x = pk2(hv[r][j][0], hv[r][j][1]); pk.y = pk2(hv[r][j][2], hv[r][j][3]);
            *(u32x2*)(H + (size_t)(mw + r) * DM + 256 * j + 4 * lane) = pk; } } }
    const int rt = w & 3, kh = w >> 2, arow = lane & 15, kg = lane >> 4;
    f32x4 acc[3];
#pragma unroll
    for (int c = 0; c < 3; ++c) acc[c] = (f32x4){0.f, 0.f, 0.f, 0.f};
    u32x4 bpre[2][3];
    const auto loadB = [&](int j) {
#pragma unroll
        for (int k = 0; k < 3; ++k) { const int i = F.tid + 512 * k, o = i >> 5, c16 = i & 31;
            bpre[0][k] = *(const u32x4*)(WRH + (size_t)o * DM + 256 * j + 8 * c16); bpre[1][k] = *(const u32x4*)(WRL + (size_t)o * DM + 256 * j + 8 * c16); } };
    loadB(0);
#pragma unroll
    for (int j = 0; j < 4; ++j) {
        __syncthreads();
#pragma unroll
        for (int r = 0; r < 8; ++r) { const f32x4 x = hv[r][j];
            u32x2 hi; hi.x = pk2(x[0], x[1]); hi.y = pk2(x[2], x[3]);
            u32x2 lo; lo.x = pk2(x[0] - __builtin_bit_cast(float, hi.x << 16), x[1] - __builtin_bit_cast(float, hi.x & 0xffff0000u)); lo.y = pk2(x[2] - __builtin_bit_cast(float, hi.y << 16), x[3] - __builtin_bit_cast(float, hi.y & 0xffff0000u));
            *(LAS u32x2*)(Ahi + (w * 8 + r) * AP + lane * 8) = hi; *(LAS u32x2*)(Alo + (w * 8 + r) * AP + lane * 8) = lo; }
#pragma unroll
        for (int k = 0; k < 3; ++k) { const int i = F.tid + 512 * k, o = i >> 5, c16 = i & 31; *(LAS u32x4*)(Bhi + o * AP + c16 * 16) = bpre[0][k]; *(LAS u32x4*)(Blo + o * AP + c16 * 16) = bpre[1][k]; }
        if (j + 1 < 4) loadB(j + 1);
        LDS_WAIT(); __syncthreads();
#pragma unroll
        for (int ks = 0; ks < 4; ++ks) { const int kb = ((4 * kh + ks) * 32 + 8 * kg) * 2;
            const bf16x8 ah = *(const LAS bf16x8*)(Ahi + (16 * rt + arow) * AP + kb), al = *(const LAS bf16x8*)(Alo + (16 * rt + arow) * AP + kb);
#pragma unroll
            for (int c = 0; c < 3; ++c) { const bf16x8 bh = *(const LAS bf16x8*)(Bhi + (16 * c + arow) * AP + kb), bl = *(const LAS bf16x8*)(Blo + (16 * c + arow) * AP + kb);
                acc[c] = __builtin_amdgcn_mfma_f32_16x16x32_bf16(ah, bh, acc[c], 0, 0, 0);
                acc[c] = __builtin_amdgcn_mfma_f32_16x16x32_bf16(al, bh, acc[c], 0, 0, 0);
                acc[c] = __builtin_amdgcn_mfma_f32_16x16x32_bf16(ah, bl, acc[c], 0, 0, 0); } }
    }
    __syncthreads();
    LAS float* biasL = (LAS float*)(F.lds + 32768 + 512);
    if (F.tid < 36) biasL[F.tid] = bias_pre;
#pragma unroll
    for (int c = 0; c < 3; ++c)
#pragma unroll
        for (int r = 0; r < 4; ++r) PL[(kh * 64 + 16 * rt + kg * 4 + r) * 48 + 16 * c + arow] = acc[c][r];
    LDS_WAIT(); __syncthreads();
    if (F.tid < 64 && rep == 0) {
        const int m = F.vcu * 64 + F.tid; const LAS float* q0 = PL + F.tid * 48; const LAS float* q1 = PL + (64 + F.tid) * 48;
        float gl[4]; int gi = 0; float gm;
#pragma unroll
        for (int g = 0; g < 4; ++g) gl[g] = (q0[g] + q1[g]) + biasL[g];
        gm = gl[0];
#pragma unroll
        for (int g = 1; g < 4; ++g) if (gl[g] > gm) { gm = gl[g]; gi = g; }
        float den = 0.f;
#pragma unroll
        for (int g = 0; g < 4; ++g) den += __expf(gl[g] - gm);
        const float gprob = __builtin_amdgcn_rcpf(den);
        float v1 = -INFINITY, v2 = -INFINITY; int i1 = 0, i2 = 0;
        for (int e = 0; e < 8; ++e) { const float v = (q0[4 + gi * 8 + e] + q1[4 + gi * 8 + e]) + biasL[4 + gi * 8 + e];
            if (v > v1) { v2 = v1; i2 = i1; v1 = v; i1 = e; } else if (v > v2) { v2 = v; i2 = e; } }
        const float e2 = __expf(v2 - v1); const float r12 = __builtin_amdgcn_rcpf(1.f + e2); const float w1 = gprob * r12, w2 = gprob * e2 * r12;
        const int ea = gi * 8 + i1, eb = gi * 8 + i2;
        tok_e[m] = ea; tok_e[M + m] = eb; tok_w[m] = w1; tok_w[M + m] = w2;
        LAS unsigned* lcnt = (LAS unsigned*)(F.lds + 32768); LAS unsigned* lbase = lcnt + 32;
        if (F.tid < 32) lcnt[F.tid] = 0u;
        asm volatile("s_waitcnt lgkmcnt(0)" ::: "memory");
        const unsigned ra = __hip_atomic_fetch_add(lcnt + ea, 1u, __ATOMIC_RELAXED, __HIP_MEMORY_SCOPE_WORKGROUP), rb = __hip_atomic_fetch_add(lcnt + eb, 1u, __ATOMIC_RELAXED, __HIP_MEMORY_SCOPE_WORKGROUP);
        asm volatile("s_waitcnt lgkmcnt(0)" ::: "memory");
        if (F.tid < 32) { const unsigned n = *(volatile LAS unsigned*)(lcnt + F.tid); unsigned bs = 0u; if (n) bs = __hip_atomic_fetch_add(F.ctl + CW_CNT + (l * 32 + F.tid) * 16, n, RLX_AGENT); *(volatile LAS unsigned*)(lbase + F.tid) = bs; }
        asm volatile("s_waitcnt vmcnt(0) lgkmcnt(0)" ::: "memory");
        const int pa = (int)(*(volatile LAS unsigned*)(lbase + ea) + ra), pb = (int)(*(volatile LAS unsigned*)(lbase + eb) + rb);
        tok_pos[m] = pa; tok_pos[M + m] = pb;
        int* elist = (int*)(F.ws + WS_ELIST); elist[ea * M + pa] = m; elist[eb * M + pb] = m;
    }
}

__device__ __forceinline__ void build_rowlists(Frame& F, int l) {
    volatile LAS int* base = (volatile LAS int*)(F.lds + BASE_OFF); volatile LAS int* cnts = (volatile LAS int*)(F.lds + CNTS_OFF); volatile LAS int* tab = (volatile LAS int*)(F.lds + TAB_OFF);
    LAS int* rowl = (LAS int*)(F.lds + ROWL_OFF); const int* elist = (const int*)(F.ws + WS_ELIST);
    const int ntile = (int)F.MISC[1];
    const int i = F.tid >> 8, r = F.tid & 255; const long L = (long)i * F.G + F.vcu;
    int tok = 0;
    if (L < 2L * ntile) { const int tile = (int)(L >> 1), e = tab[tile], pos = 256 * (tile - base[e]) + r; if (pos < cnts[e]) tok = elist[e * M + pos]; }
    rowl[F.tid] = tok;
    __syncthreads();
}

constexpr int NPL = 7, NPH = 2 + 2 * NPL;
__global__ void __launch_bounds__(NWAVES * 64, 2) mk_fwd(Args args) {
    extern __shared__ __attribute__((aligned(16))) unsigned char lds[];
    Frame F;
    F.lds = (LAS unsigned char*)lds;
    F.MISC = (volatile LAS unsigned*)(F.lds + MISC_OFF);
    F.tid = threadIdx.x; F.lane = F.tid & 63; F.wave = __builtin_amdgcn_readfirstlane(F.tid >> 6);
    const int wave0 = F.wave;
    F.G = gridDim.x; F.bx = blockIdx.x; F.vcu = 0;
    F.ws = args.ws; F.out = args.out; F.ctl = (unsigned*)(args.ws + WS_CTL);
    for (int u = F.tid; u < (LDS_BYTES - LDSCTL_OFF) / 4; u += NWAVES * 64) ((LAS unsigned*)(F.lds + LDSCTL_OFF))[u] = 0u;
    __syncthreads();
    XcdBarrier bar; bar.bar = F.ctl + CW_BAR; bar.x = 0; bar.st = nullptr;
    if (!MK_PER_PHASE) bar = xcd_barrier_post(F.ctl + CW_BAR, F.MISC + 8);
    const int lo = args.ph_lo, hi = args.ph_hi;
#pragma unroll 1
    for (int ph = lo; ph < hi; ++ph) {
#if PROBE_REP_K >= 0
        const int ptype = ph == 0 ? 0 : (ph == NPH - 1 ? 10 : 1 + (ph - 1) % NPL);
        const int nrep = (ptype == PROBE_REP_K && (ph <= NPL || (PROBE_REP_K != 1 && PROBE_REP_K != 5))) ? 1 : 0;
#pragma unroll 1
        for (int rep = 0; rep <= nrep; ++rep) {
#else
        constexpr int rep = 0;
#endif
        { int w_ = wave0; asm volatile("" : "+s"(w_)); unsigned on_ = ~0u; asm volatile("" : "+s"(on_)); int ln_ = (int)__builtin_amdgcn_mbcnt_hi(on_, __builtin_amdgcn_mbcnt_lo(on_, 0u)); asm volatile("" : "+v"(ln_));
          F.wave = w_; F.lane = ln_; F.tid = w_ * 64 + ln_;
          unsigned long long ws_ = (unsigned long long)args.ws; asm volatile("" : "+s"(ws_)); F.ws = (unsigned char*)(GAS unsigned char*)ws_; F.ctl = (unsigned*)(F.ws + WS_CTL);
          int bx_ = blockIdx.x; asm volatile("" : "+s"(bx_)); F.bx = bx_; F.vcu = (F.G % 8 == 0) ? (bx_ % 8) * (F.G / 8) + bx_ / 8 : bx_; }
        if (ph == 0) {
#ifndef SKIP_P0
            p0_prologue(F, args);
#endif
        } else if (ph == NPH - 1) {
            row_pass(F, args, 2, 1);
        } else {
            const int l = (ph - 1) / NPL, k = (ph - 1) % NPL;
            if (k == 0) { row_pass(F, args, l == 0 ? 0 : 1, l); }
            else if (k == 1) {
                pg8::Gemm g{(const bf16*)(F.ws + WS_H), (const bf16*)(F.ws + WS_WIN) + (size_t)l * NP * DM, M, NP, DM}; pg8::StaticOrder S; S.init(M, NP, F.G, F.bx);
                pg8::EpiBf16 E{(bf16*)(F.ws + WS_PROJ), NP};
#ifndef SKIP_G1
                pg8::gemm_phase<pg8::EpiBf16, pg8::StaticOrder, true, true>(F.lds, g, S, E, F.tid);
#endif
            } else if (k == 2) {
#ifndef SKIP_P3
                p3_prep(F, args, l, rep);
#endif
            } else if (k == 3) {
#ifndef SKIP_P4
                p4_attention(F, args, l, l + 2 * rep);
#endif
            } else if (k == 4) {
                pg8::Gemm g{(const bf16*)(F.ws + WS_MIX), (const bf16*)(F.ws + WS_WOUT) + (size_t)l * DM * DM, M, DM, DM}; pg8::StaticOrder S; S.init(M, DM, F.G, F.bx);
                pg8::EpiResGate E{l == 0 ? inp<I_X>() : nullptr, (const bf16*)(F.ws + WS_X1), (bf16*)(F.ws + WS_X1), (const float*)(F.ws + WS_MOD) + (size_t)l * 8 * 6144 + 2 * DM};
#ifndef SKIP_G2
                pg8::gemm_phase<pg8::EpiResGate, pg8::StaticOrder, true, true>(F.lds, g, S, E, F.tid);
#endif
                if (!MK_PER_PHASE && F.G == 256 && F.tid == 0) { pg8::Unit u0; if (S.next(0, u0)) { __builtin_amdgcn_fence(__ATOMIC_RELEASE, "agent");
                    __hip_atomic_fetch_add(F.ctl + CW_OPF + l * 2048 + u0.pm * 16, 1u, RLX_AGENT); } }
            } else if (k == 5) {
                if (!MK_PER_PHASE && F.G == 256) {
                    if (F.tid == 0) { unsigned* f = F.ctl + CW_OPF + l * 2048 + (F.vcu >> 2) * 16; unsigned sp = 0u;
                        while (__hip_atomic_load(f, RLX_AGENT) < 4u) { __builtin_amdgcn_s_sleep(2); if (++sp > (1u << 22)) break; }
                        __builtin_amdgcn_fence(__ATOMIC_ACQUIRE, "agent"); asm volatile("s_waitcnt vmcnt(0)" ::: "memory"); }
                    __syncthreads();
                }
#ifndef SKIP_P6
                p6_router(F, args, l, rep);
#endif
            } else {
                build_tables(F, l); build_rowlists(F, l);
                unsigned* upf = F.ctl + CW_UPF + l * 8192; unsigned* dq = F.ctl + CW_DNQ + 16 * l;
                { pg8::Gemm g{(const bf16*)(F.ws + WS_H), (const bf16*)(F.ws + WS_WUP) + (size_t)l * NEXP * 512 * DM, MAXSLOT, 512, DM};
                  pg8::GroupOrder S{(const LAS int*)(F.lds + TAB_OFF), (int)F.MISC[1], 2, F.G, F.vcu, (size_t)512 * DM * 2};
                  pg8::EpiSwiglu E{(bf16*)(F.ws + WS_HID), upf};
#ifndef SKIP_G3
                  pg8::gemm_phase<pg8::EpiSwiglu, pg8::GroupOrder, true, true, true>(F.lds, g, S, E, F.tid, (const LAS int*)(F.lds + ROWL_OFF));
#endif
                }
                if (GAP_CONVERT && !BG_CONVERT && l == 0 && rep == 0) convert_layer1_in_gap(F, args, 2 * (int)F.MISC[1] - F.G);
                { const pg8::Gemm g{(const bf16*)(F.ws + WS_HID), (const bf16*)(F.ws + WS_WDN) + (size_t)l * NEXP * DM * FF, MAXSLOT, DM, FF};
                  const pg8::EpiBf16 E{(bf16*)(F.ws + WS_Y), DM};
                  const LAS int* tab = (const LAS int*)(F.lds + TAB_OFF);
                  const int nd = 4 * __builtin_amdgcn_readfirstlane((int)F.MISC[1]);
                  pg8::DynOrder S{dq, upf, tab, F.MISC, nd, (size_t)DM * FF * 2, F.tid, (unsigned)F.G, 0u, 2u};
                  if (F.tid == 0) { const unsigned a = (unsigned)F.bx, b = (unsigned)F.G + __hip_atomic_fetch_add(dq, 1u, RLX_AGENT); F.MISC[4] = a; F.MISC[5] = b;
                      if ((int)a < nd) while (__hip_atomic_load(upf + (a >> 2) * 16, RLX_AGENT) < 2u) __builtin_amdgcn_s_sleep(8);
                      __builtin_amdgcn_fence(__ATOMIC_ACQUIRE, "agent"); asm volatile("s_waitcnt vmcnt(0)" ::: "memory"); S.issue(b); }
                  __syncthreads();
                  for (;;) {
                      if (__builtin_amdgcn_readfirstlane((int)F.MISC[4]) >= nd) break;
#ifndef SKIP_G4
                      pg8::gemm_phase<pg8::EpiBf16, pg8::DynOrder, true, true>(F.lds, g, S, E, F.tid);
#endif
                      if (F.tid == 0) {
                          const unsigned idn = F.MISC[5];
                          if ((int)idn < nd) { unsigned f = S.pflag; while (f < 2u) { __builtin_amdgcn_s_sleep(8); f = __hip_atomic_load(upf + (idn >> 2) * 16, RLX_AGENT); }
                              __builtin_amdgcn_fence(__ATOMIC_ACQUIRE, "agent"); asm volatile("s_waitcnt vmcnt(0)" ::: "memory"); }
                          const unsigned idn2 = S.ppop; F.MISC[4] = idn; F.MISC[5] = idn2; S.issue(idn2); }
                      __syncthreads();
                  }
                }
            }
        }
#if PROBE_REP_K >= 0
        if (rep < nrep) xcd_barrier(bar, F.tid);
        }
#endif
        const bool seam45 = !MK_PER_PHASE && F.G == 256 && ph != 0 && ph != NPH - 1 && (ph - 1) % NPL == 4;
        if (ph + 1 < hi && !seam45) xcd_barrier(bar, F.tid);
#ifdef PROBE_DOUBLE_BAR
        if (ph + 1 < hi) xcd_barrier(bar, F.tid);
#endif
    }
}

extern "C" void kernel_launch(void* const* d_in, const int* in_sizes, int n_in, void* d_out, int out_size, void* d_ws, size_t ws_size, hipStream_t stream) {
    static int grid = 0;
    if (grid == 0) {
        if (n_in != 28 || out_size != M * DM || ws_size < WS_END) { fprintf(stderr, "kernel_launch: unexpected shapes (n_in %d, out %d, ws %zu)\n", n_in, out_size, ws_size); grid = -1; return; }
        int dev = 0, cus = 0, per_cu = 0;
        if (hipGetDevice(&dev) != hipSuccess || hipDeviceGetAttribute(&cus, hipDeviceAttributeMultiprocessorCount, dev) != hipSuccess) { grid = -1; return; }
        if (hipFuncSetAttribute((const void*)mk_fwd, hipFuncAttributeMaxDynamicSharedMemorySize, LDS_BYTES) != hipSuccess) { fprintf(stderr, "kernel_launch: hipFuncSetAttribute failed\n"); grid = -1; return; }
        if (hipOccupancyMaxActiveBlocksPerMultiprocessor(&per_cu, (const void*)mk_fwd, NWAVES * 64, LDS_BYTES) != hipSuccess || per_cu < 1)
            fprintf(stderr, "kernel_launch: occupancy query reports %d workgroups per CU\n", per_cu);
        (void)hipGetLastError();
        grid = cus;
    }
    if (grid < 0) return;
    if (hipMemsetAsync((char*)d_ws + WS_CTL, 0, CTL_ZERO_BYTES, stream) != hipSuccess) return;
    Args a{};
    for (int i = 0; i < 28; ++i) a.in[i] = (const float*)d_in[i];
    a.out = (float*)d_out; a.ws = (unsigned char*)d_ws;
#if MK_PER_PHASE
    for (int p = 0; p < NPH; ++p) { a.ph_lo = p; a.ph_hi = p + 1; hipLaunchKernelGGL(mk_fwd, dim3(grid), dim3(NWAVES * 64), LDS_BYTES, stream, a); }
#else
    a.ph_lo = 0; a.ph_hi = NPH; hipLaunchKernelGGL(mk_fwd, dim3(grid), dim3(NWAVES * 64), LDS_BYTES, stream, a);
#endif
}
```
